# Optimizing an MI355X kernel written in HIP

```python
import math
import jax, jax.numpy as jnp
from jax import lax
import numpy as np

D_MODEL = 1024
BATCH = 2
SEQ = 8192
DEPTH = 1

HEAD_DIM = 64
A_Q_HEADS = D_MODEL // HEAD_DIM
A_KV_HEADS = A_Q_HEADS // 4
A_HALF_WINDOW = 128
B_GROUPS = ((128, 1), (512, 4), (2048, 16))
B_HEADS_PER_GROUP = 4
B_N_HEADS = B_HEADS_PER_GROUP * len(B_GROUPS)
TOTAL_BIAS_HEADS = A_Q_HEADS + B_N_HEADS
N_BUCKETS = 32
MAX_DISTANCE = 1024
N_EXPERTS = 32
TOP_K = 4
D_FF = D_MODEL
SWIGLU_LIMIT = 7.0
SWIGLU_ALPHA = 1.702
EPS = 1e-5
NEG_INF = -1e30

A_Q_W = A_Q_HEADS * HEAD_DIM
A_KV_W = A_KV_HEADS * HEAD_DIM
B_QKV_W = B_N_HEADS * HEAD_DIM
B_OUT_W = B_HEADS_PER_GROUP * HEAD_DIM
IN_WIDTHS = (A_Q_W, A_KV_W, A_KV_W, B_QKV_W, B_QKV_W, B_QKV_W, D_MODEL, D_MODEL)
IN_WIDTH = sum(IN_WIDTHS)

kernel_name = "hybrid_gated_window_dilated_attn_moe"


def rmsnorm(x, g):
    xf = x.astype(jnp.float32)
    y = xf * lax.rsqrt(jnp.mean(xf * xf, axis=-1, keepdims=True) + EPS)
    return (y * g.astype(jnp.float32)).astype(x.dtype)


def t5_buckets(rel):
    half = N_BUCKETS // 2
    max_exact = half // 2
    ret = np.where(rel > 0, half, 0)
    n = np.abs(rel)
    large = max_exact + (np.log(np.maximum(n, 1) / max_exact)
                         / np.log(MAX_DISTANCE / max_exact) * (half - max_exact)).astype(np.int32)
    large = np.minimum(large, half - 1)
    return (ret + np.where(n < max_exact, n, large)).astype(np.int32)


def banded_attention(q, k, v, half_window, dilation, bias_table, sink, valid_len):
    n, L, hkv, g, dh = q.shape
    W = half_window
    nb = L // W
    qb = q.reshape(n, nb, W, hkv, g, dh)

    def band(t):
        tp = jnp.pad(t, ((0, 0), (W, W), (0, 0), (0, 0))).reshape(n, nb + 2, W, hkv, dh)
        return jnp.concatenate([tp[:, :-2], tp[:, 1:-1], tp[:, 2:]], axis=2)

    kb, vb = band(k), band(v)
    off = np.arange(3 * W)[None, :] - W - np.arange(W)[:, None]
    kpos = np.arange(nb)[:, None] * W + np.arange(3 * W)[None, :] - W
    mask = (np.abs(off) <= W)[None] & ((kpos >= 0) & (kpos < valid_len))[:, None, :]
    bias = bias_table[t5_buckets(off * dilation)].astype(jnp.float32)
    bias = jnp.transpose(bias, (2, 0, 1)).reshape(hkv, g, 1, W, 3 * W)

    s = jnp.einsum('nbqhgd,nbkhd->nhgbqk', qb, kb).astype(jnp.float32) * (dh ** -0.5) + bias
    s = jnp.where(mask, s, NEG_INF)
    m = jnp.max(s, axis=-1, keepdims=True)
    if sink is not None:
        sk = sink.astype(jnp.float32).reshape(hkv, g, 1, 1, 1)
        m = jnp.maximum(m, sk)
    p = jnp.exp(s - m)
    denom = jnp.sum(p, axis=-1, keepdims=True)
    if sink is not None:
        denom = denom + jnp.exp(sk - m)
    out = jnp.einsum('nhgbqk,nbkhd->nbqhgd', p / denom, vb.astype(jnp.float32)).astype(q.dtype)
    lse = (m + jnp.log(denom))[..., 0]
    return out.reshape(n, L, hkv, g, dh), lse.reshape(n, hkv, g, L)


def windowed_gqa(q, k, v, sinks, rel_bias):
    b, s = q.shape[:2]
    qg = q.reshape(b, s, A_KV_HEADS, A_Q_HEADS // A_KV_HEADS, HEAD_DIM)
    out, _ = banded_attention(qg, k, v, A_HALF_WINDOW, 1, rel_bias[:, :A_Q_HEADS], sinks, s)
    return out.reshape(b, s, A_Q_W)


def dilated_attention(q, k, v, rel_bias):
    b, s = q.shape[:2]
    H = B_HEADS_PER_GROUP
    outs, lses = [], []
    for gi, (window, dil) in enumerate(B_GROUPS):
        hw = window // (2 * dil)
        L = s // dil
        Lp = -(-L // hw) * hw

        def to_sub(t):
            t = t.reshape(b, L, dil, H, HEAD_DIM).transpose(0, 2, 1, 3, 4).reshape(b * dil, L, H, HEAD_DIM)
            return jnp.pad(t, ((0, 0), (0, Lp - L), (0, 0), (0, 0)))

        c0 = A_Q_HEADS + gi * H
        o, l = banded_attention(to_sub(q[:, :, gi])[:, :, :, None], to_sub(k[:, :, gi]), to_sub(v[:, :, gi]),
                                hw, dil, rel_bias[:, c0:c0 + H], None, L)
        o = o[:, :L, :, 0].reshape(b, dil, L, H, HEAD_DIM).transpose(0, 2, 1, 3, 4).reshape(b, s, H, HEAD_DIM)
        l = l[:, :, 0, :L].reshape(b, dil, H, L).transpose(0, 3, 1, 2).reshape(b, s, H)
        outs.append(o)
        lses.append(l)
    w = jax.nn.softmax(jnp.stack(lses, axis=0), axis=0)
    y = jnp.sum(w[..., None] * jnp.stack(outs, axis=0).astype(jnp.float32), axis=0)
    return y.astype(q.dtype).reshape(b, s, B_OUT_W)


def moe(h, router_w, router_b, w_gate, b_gate, w_up, b_up, w_down, b_down):
    b, s, d = h.shape
    hf = h.reshape(b * s, d)
    logits = (hf @ router_w + router_b).astype(jnp.float32)
    top_val, top_idx = lax.top_k(logits, TOP_K)
    probs = jax.nn.softmax(top_val, axis=-1)
    combine = jnp.sum(jax.nn.one_hot(top_idx, N_EXPERTS, dtype=jnp.float32) * probs[..., None], axis=1)
    y = jnp.zeros((b * s, d), jnp.float32)
    for e in range(N_EXPERTS):
        gate = jnp.minimum(hf @ w_gate[e] + b_gate[e], SWIGLU_LIMIT)
        up = jnp.clip(hf @ w_up[e] + b_up[e], -SWIGLU_LIMIT, SWIGLU_LIMIT)
        act = gate * jax.nn.sigmoid(SWIGLU_ALPHA * gate) * (up + 1.0)
        y = y + combine[:, e:e + 1] * (act @ w_down[e] + b_down[e])
    return y.astype(h.dtype).reshape(b, s, d)


def setup_inputs(seed: int = 0) -> dict:
    key = jax.random.key(seed)
    ks = jax.random.split(key, 20)
    nrm = jax.random.normal
    f32 = jnp.float32
    Ly = DEPTH
    return {
        "x": nrm(ks[0], (BATCH, SEQ, D_MODEL), f32),
        "norm_mix": 1.0 + 0.02 * nrm(ks[1], (Ly, D_MODEL), f32),
        "w_in": nrm(ks[2], (Ly, D_MODEL, IN_WIDTH), f32) * D_MODEL ** -0.5,
        "b_in": 0.02 * nrm(ks[3], (Ly, IN_WIDTH), f32),
        "sinks": 0.5 * nrm(ks[4], (Ly, A_Q_HEADS), f32),
        "rel_bias": 0.2 * nrm(ks[5], (N_BUCKETS, TOTAL_BIAS_HEADS), f32),
        "w_branch_a": nrm(ks[6], (Ly, A_Q_W, D_MODEL), f32) * A_Q_W ** -0.5,
        "w_branch_b": nrm(ks[7], (Ly, B_OUT_W, D_MODEL), f32) * B_OUT_W ** -0.5,
        "w_out": nrm(ks[8], (Ly, D_MODEL, D_MODEL), f32) * D_MODEL ** -0.5,
        "norm_ffn": 1.0 + 0.02 * nrm(ks[9], (Ly, D_MODEL), f32),
        "router_w": nrm(ks[10], (Ly, D_MODEL, N_EXPERTS), f32) * D_MODEL ** -0.5,
        "router_b": 0.01 * nrm(ks[11], (Ly, N_EXPERTS), f32),
        "w_gate": nrm(ks[12], (Ly, N_EXPERTS, D_MODEL, D_FF), f32) * D_MODEL ** -0.5,
        "b_gate": 0.01 * nrm(ks[13], (Ly, N_EXPERTS, D_FF), f32),
        "w_up": nrm(ks[14], (Ly, N_EXPERTS, D_MODEL, D_FF), f32) * D_MODEL ** -0.5,
        "b_up": 0.01 * nrm(ks[15], (Ly, N_EXPERTS, D_FF), f32),
        "w_down": nrm(ks[16], (Ly, N_EXPERTS, D_FF, D_MODEL), f32) * D_FF ** -0.5,
        "b_down": 0.01 * nrm(ks[17], (Ly, N_EXPERTS, D_MODEL), f32),
        "norm_final": 1.0 + 0.02 * nrm(ks[18], (D_MODEL,), f32),
    }


def reference(x, norm_mix, w_in, b_in, sinks, rel_bias, w_branch_a, w_branch_b, w_out,
              norm_ffn, router_w, router_b, w_gate, b_gate, w_up, b_up, w_down, b_down, norm_final):
    b, s, _ = x.shape
    split_points = [int(c) for c in np.cumsum(IN_WIDTHS)[:-1]]
    for layer in range(DEPTH):
        h = rmsnorm(x, norm_mix[layer])
        proj = h @ w_in[layer] + b_in[layer]
        qa, ka, va, qb, kb, vb, ga, gb = jnp.split(proj, split_points, axis=-1)
        ya = windowed_gqa(qa.reshape(b, s, A_Q_HEADS, HEAD_DIM),
                          ka.reshape(b, s, A_KV_HEADS, HEAD_DIM),
                          va.reshape(b, s, A_KV_HEADS, HEAD_DIM),
                          sinks[layer], rel_bias)
        grp = (b, s, len(B_GROUPS), B_HEADS_PER_GROUP, HEAD_DIM)
        yb = dilated_attention(qb.reshape(grp), kb.reshape(grp), vb.reshape(grp), rel_bias)
        merged = (jax.nn.sigmoid(ga) * (ya @ w_branch_a[layer])
                  + jax.nn.sigmoid(gb) * (yb @ w_branch_b[layer]))
        x = x + merged @ w_out[layer]
        h2 = rmsnorm(x, norm_ffn[layer])
        x = x + moe(h2, router_w[layer], router_b[layer], w_gate[layer], b_gate[layer],
                    w_up[layer], b_up[layer], w_down[layer], b_down[layer])
    return rmsnorm(x, norm_final)
```

```cpp
#include <hip/hip_runtime.h>
#include <stdint.h>
#include <stdio.h>

typedef unsigned short bf16;
typedef short bf16x8 __attribute__((ext_vector_type(8)));
typedef float f32x4 __attribute__((ext_vector_type(4)));
typedef unsigned u32x4 __attribute__((ext_vector_type(4)));

constexpr int T = 16384, S = 8192, D = 1024, NPROJ = 5888, NQKV = 3840, NGATE = 2048, NE = 32, TOPK = 4;
constexpr int C_QA = 0, C_KA = 1024, C_VA = 1280, C_QB = 1536, C_KB = 2304, C_VB = 3072;
constexpr float EPS = 1e-5f;
constexpr size_t MiB = 1u << 20;
constexpr size_t WS_CTL = 0;
constexpr size_t WS_TAB = 1 * MiB;
constexpr size_t WS_RT = 19 * MiB;
constexpr size_t WS_XN = 216 * MiB;
constexpr size_t WS_QKV = 248 * MiB;
constexpr size_t WS_GATES = 368 * MiB;
constexpr size_t WS_YA = 432 * MiB;
constexpr size_t WS_YB = 464 * MiB;
constexpr size_t WS_MERGED = 472 * MiB;
constexpr size_t WS_YS = 248 * MiB;
constexpr size_t WS_ACT = 377 * MiB;
constexpr size_t WS_END = 506 * MiB;

__device__ const unsigned char BKT_A[257] = {12,12,12,12,12,12,12,12,12,12,12,12,12,12,12,12,12,12,12,12,12,12,12,12,12,12,12,12,12,12,12,12,12,12,12,12,12,12,11,11,11,11,11,11,11,11,11,11,11,11,11,11,11,11,11,11,11,11,11,11,11,11,11,11,11,11,11,11,11,11,11,11,11,11,11,11,11,11,11,10,10,10,10,10,10,10,10,10,10,10,10,10,10,10,10,10,10,10,10,10,10,10,9,9,9,9,9,9,9,9,9,9,9,9,8,8,8,8,8,8,8,7,6,5,4,3,2,1,0,17,18,19,20,21,22,23,24,24,24,24,24,24,24,25,25,25,25,25,25,25,25,25,25,25,25,26,26,26,26,26,26,26,26,26,26,26,26,26,26,26,26,26,26,26,26,26,26,26,27,27,27,27,27,27,27,27,27,27,27,27,27,27,27,27,27,27,27,27,27,27,27,27,27,27,27,27,27,27,27,27,27,27,27,27,27,27,27,27,27,28,28,28,28,28,28,28,28,28,28,28,28,28,28,28,28,28,28,28,28,28,28,28,28,28,28,28,28,28,28,28,28,28,28,28,28,28,28};
__device__ const unsigned char BKT_B[3][129] = {
 {11,11,11,11,11,11,11,11,11,11,11,11,11,11,11,10,10,10,10,10,10,10,10,10,10,10,10,10,10,10,10,10,10,10,10,10,10,10,9,9,9,9,9,9,9,9,9,9,9,9,8,8,8,8,8,8,8,7,6,5,4,3,2,1,0,17,18,19,20,21,22,23,24,24,24,24,24,24,24,25,25,25,25,25,25,25,25,25,25,25,25,26,26,26,26,26,26,26,26,26,26,26,26,26,26,26,26,26,26,26,26,26,26,26,27,27,27,27,27,27,27,27,27,27,27,27,27,27,27},
 {13,13,13,13,13,13,13,13,13,13,13,13,13,13,13,13,13,13,13,13,13,13,13,12,12,12,12,12,12,12,12,12,12,12,12,12,12,12,12,12,12,12,11,11,11,11,11,11,11,11,11,11,10,10,10,10,10,10,9,9,9,8,8,4,0,20,24,24,25,25,25,26,26,26,26,26,26,27,27,27,27,27,27,27,27,27,27,28,28,28,28,28,28,28,28,28,28,28,28,28,28,28,28,28,28,28,29,29,29,29,29,29,29,29,29,29,29,29,29,29,29,29,29,29,29,29,29,29,29},
 {15,15,15,15,15,15,15,15,15,15,15,15,15,15,15,15,15,15,15,15,15,15,15,15,15,15,15,15,15,15,14,14,14,14,14,14,14,14,14,14,14,14,14,14,14,13,13,13,13,13,13,13,13,13,12,12,12,12,12,11,11,10,10,9,0,25,26,26,27,27,28,28,28,28,28,29,29,29,29,29,29,29,29,29,30,30,30,30,30,30,30,30,30,30,30,30,30,30,30,31,31,31,31,31,31,31,31,31,31,31,31,31,31,31,31,31,31,31,31,31,31,31,31,31,31,31,31,31,31}};

__device__ __forceinline__ unsigned f2bf(float f) { unsigned u = __builtin_bit_cast(unsigned, f); return (u + 0x7fffu + ((u >> 16) & 1u)) >> 16; }
__device__ __forceinline__ float bf2f(unsigned b) { return __builtin_bit_cast(float, b << 16); }
__device__ __forceinline__ float wave_sum(float v) {
#pragma unroll
    for (int o = 1; o < 64; o <<= 1) v += __shfl_xor(v, o);
    return v;
}
__device__ __forceinline__ float sigmoidf_(float x) { return 1.f / (1.f + __expf(-x)); }

struct Tabs { float biasA[16][257]; float biasB[3][4][129]; int off[NE + 1]; };

__global__ void k_prep(const float* rel_bias, Tabs* tb) {
    const int i = blockIdx.x * blockDim.x + threadIdx.x;
    if (i < 16 * 257) { const int h = i / 257, r = i % 257; tb->biasA[h][r] = rel_bias[BKT_A[r] * 28 + h]; }
    if (i < 12 * 129) { const int g = i / (4 * 129), hs = (i / 129) % 4, r = i % 129; tb->biasB[g][hs][r] = rel_bias[BKT_B[g][r] * 28 + 16 + 4 * g + hs]; }
}
__global__ void k_rmsnorm(const float* x, const float* g, bf16* out) {
    const int gw = (blockIdx.x * blockDim.x + threadIdx.x) >> 6, lane = threadIdx.x & 63, NGW = (gridDim.x * blockDim.x) >> 6;
    for (int m = gw; m < T; m += NGW) {
        const f32x4* xr = (const f32x4*)(x + (size_t)m * D) + lane; f32x4 v[4]; float s = 0.f;
#pragma unroll
        for (int j = 0; j < 4; ++j) { v[j] = xr[64 * j]; s += v[j].x * v[j].x + v[j].y * v[j].y + v[j].z * v[j].z + v[j].w * v[j].w; }
        const float rstd = 1.f / sqrtf(wave_sum(s) * (1.f / D) + EPS);
        unsigned long long* o8 = (unsigned long long*)(out + (size_t)m * D) + lane;
#pragma unroll
        for (int j = 0; j < 4; ++j) { const f32x4 gg = ((const f32x4*)g)[lane + 64 * j];
            const unsigned lo = f2bf(v[j].x * rstd * gg.x) | (f2bf(v[j].y * rstd * gg.y) << 16), hi = f2bf(v[j].z * rstd * gg.z) | (f2bf(v[j].w * rstd * gg.w) << 16);
            o8[64 * j] = (unsigned long long)lo | ((unsigned long long)hi << 32); }
    }
}
enum { EPI_PROJ = 0, EPI_M1 = 1, EPI_MERGE = 2, EPI_X1 = 3, EPI_GATEUP = 4, EPI_DOWN = 5 };
struct GArgs {
    const bf16* A; int lda; const int* rowidx;
    const float* W; const float* W2; int ldw; size_t wstride;
    int M, N, K;
    const int* off;
    const float* bias; const float* bias2;
    const bf16* gates; const float* x; bf16* o16; bf16* o16b; float* o32;
};
template <int EPI> __global__ void __launch_bounds__(256) k_gemm(GArgs g) {
    __shared__ bf16 sA[64][40]; __shared__ bf16 sB[64][40]; __shared__ bf16 sB2[64][40];
    const int tid = threadIdx.x, lane = tid & 63, w = tid >> 6, fr = lane & 15, fq = lane >> 4;
    int row0 = blockIdx.y * 64, Mv = g.M; const int col0 = blockIdx.x * 64;
    const float* W = g.W; const float* W2 = g.W2; const float* bias = g.bias; const float* bias2 = g.bias2;
    if (g.off) { const int e = blockIdx.z; const int o0 = g.off[e], cnt = g.off[e + 1] - o0; if (row0 >= cnt) return; Mv = o0 + cnt; row0 += o0;
        W += (size_t)e * g.wstride; if (W2) W2 += (size_t)e * g.wstride; if (bias) bias += (size_t)e * g.N; if (bias2) bias2 += (size_t)e * g.N; }
    f32x4 acc[4], acc2[4];
#pragma unroll
    for (int n = 0; n < 4; ++n) { acc[n] = (f32x4){0, 0, 0, 0}; acc2[n] = (f32x4){0, 0, 0, 0}; }
    const int ar = tid >> 2, ac = (tid & 3) * 8; int arow = row0 + ar; if (arow >= Mv) arow = Mv - 1; if (g.rowidx) arow = g.rowidx[arow];
    const bf16* ap = g.A + (size_t)arow * g.lda + ac;
    const int bk = tid >> 3, bn = (tid & 7) * 8;
    for (int k0 = 0; k0 < g.K; k0 += 32) {
        *(u32x4*)&sA[ar][ac] = *(const u32x4*)(ap + k0);
        { const float* wp = W + (size_t)(k0 + bk) * g.ldw + col0 + bn; const f32x4 v0 = *(const f32x4*)wp, v1 = *(const f32x4*)(wp + 4);
          sB[bn + 0][bk] = f2bf(v0.x); sB[bn + 1][bk] = f2bf(v0.y); sB[bn + 2][bk] = f2bf(v0.z); sB[bn + 3][bk] = f2bf(v0.w);
          sB[bn + 4][bk] = f2bf(v1.x); sB[bn + 5][bk] = f2bf(v1.y); sB[bn + 6][bk] = f2bf(v1.z); sB[bn + 7][bk] = f2bf(v1.w); }
        if (EPI == EPI_GATEUP) { const float* wp = W2 + (size_t)(k0 + bk) * g.ldw + col0 + bn; const f32x4 v0 = *(const f32x4*)wp, v1 = *(const f32x4*)(wp + 4);
          sB2[bn + 0][bk] = f2bf(v0.x); sB2[bn + 1][bk] = f2bf(v0.y); sB2[bn + 2][bk] = f2bf(v0.z); sB2[bn + 3][bk] = f2bf(v0.w);
          sB2[bn + 4][bk] = f2bf(v1.x); sB2[bn + 5][bk] = f2bf(v1.y); sB2[bn + 6][bk] = f2bf(v1.z); sB2[bn + 7][bk] = f2bf(v1.w); }
        __syncthreads();
        const bf16x8 a = *(const bf16x8*)&sA[16 * w + fr][8 * fq];
#pragma unroll
        for (int n = 0; n < 4; ++n) { const bf16x8 b = *(const bf16x8*)&sB[16 * n + fr][8 * fq]; acc[n] = __builtin_amdgcn_mfma_f32_16x16x32_bf16(a, b, acc[n], 0, 0, 0);
            if (EPI == EPI_GATEUP) { const bf16x8 b2 = *(const bf16x8*)&sB2[16 * n + fr][8 * fq]; acc2[n] = __builtin_amdgcn_mfma_f32_16x16x32_bf16(a, b2, acc2[n], 0, 0, 0); } }
        __syncthreads();
    }
#pragma unroll
    for (int n = 0; n < 4; ++n)
#pragma unroll
        for (int j = 0; j < 4; ++j) {
            const int row = row0 + 16 * w + 4 * fq + j, col = col0 + 16 * n + fr; if (row >= Mv) continue;
            float v = acc[n][j];
            if (EPI == EPI_PROJ) { v += bias[col]; if (col < NQKV) g.o16[(size_t)row * NQKV + col] = (bf16)f2bf(v); else g.o16b[(size_t)row * NGATE + (col - NQKV)] = (bf16)f2bf(v); }
            if (EPI == EPI_M1) { const float gb = bf2f(g.gates[(size_t)row * NGATE + 1024 + col]); g.o16[(size_t)row * D + col] = (bf16)f2bf(sigmoidf_(gb) * v); }
            if (EPI == EPI_MERGE) { const float ga = bf2f(g.gates[(size_t)row * NGATE + col]); const float m1 = bf2f(g.o16[(size_t)row * D + col]); g.o16[(size_t)row * D + col] = (bf16)f2bf(sigmoidf_(ga) * v + m1); }
            if (EPI == EPI_X1) { g.o32[(size_t)row * D + col] = g.x[(size_t)row * D + col] + v; }
            if (EPI == EPI_GATEUP) { float gt = fminf(v + bias[col], 7.f); float up = fminf(fmaxf(acc2[n][j] + bias2[col], -7.f), 7.f);
                g.o16[(size_t)row * D + col] = (bf16)f2bf(gt * sigmoidf_(1.702f * gt) * (up + 1.f)); }
            if (EPI == EPI_DOWN) { g.o16[(size_t)row * D + col] = (bf16)f2bf(v + bias[col]); }
        }
}
__device__ __forceinline__ void ld_row64(const bf16* p, float* f) {
#pragma unroll
    for (int c = 0; c < 8; ++c) { const u32x4 v = *(const u32x4*)(p + 8 * c);
        f[8 * c + 0] = bf2f(v.x & 0xffff); f[8 * c + 1] = bf2f(v.x >> 16); f[8 * c + 2] = bf2f(v.y & 0xffff); f[8 * c + 3] = bf2f(v.y >> 16);
        f[8 * c + 4] = bf2f(v.z & 0xffff); f[8 * c + 5] = bf2f(v.z >> 16); f[8 * c + 6] = bf2f(v.w & 0xffff); f[8 * c + 7] = bf2f(v.w >> 16); }
}
struct SoftAcc { float m, l; float o[64]; };
__device__ __forceinline__ void att_key(SoftAcc& a, const float* q, const bf16* kp, const bf16* vp, float bias) {
    float s = 0.f;
#pragma unroll
    for (int c = 0; c < 8; ++c) { const u32x4 v = *(const u32x4*)(kp + 8 * c);
        s += q[8 * c + 0] * bf2f(v.x & 0xffff) + q[8 * c + 1] * bf2f(v.x >> 16) + q[8 * c + 2] * bf2f(v.y & 0xffff) + q[8 * c + 3] * bf2f(v.y >> 16)
           + q[8 * c + 4] * bf2f(v.z & 0xffff) + q[8 * c + 5] * bf2f(v.z >> 16) + q[8 * c + 6] * bf2f(v.w & 0xffff) + q[8 * c + 7] * bf2f(v.w >> 16); }
    s = s * 0.125f + bias;
    const float mn = fmaxf(a.m, s), al = __expf(a.m - mn), p = __expf(s - mn);
    a.m = mn; a.l = a.l * al + p;
#pragma unroll
    for (int c = 0; c < 8; ++c) { const u32x4 v = *(const u32x4*)(vp + 8 * c);
        a.o[8 * c + 0] = a.o[8 * c + 0] * al + p * bf2f(v.x & 0xffff); a.o[8 * c + 1] = a.o[8 * c + 1] * al + p * bf2f(v.x >> 16);
        a.o[8 * c + 2] = a.o[8 * c + 2] * al + p * bf2f(v.y & 0xffff); a.o[8 * c + 3] = a.o[8 * c + 3] * al + p * bf2f(v.y >> 16);
        a.o[8 * c + 4] = a.o[8 * c + 4] * al + p * bf2f(v.z & 0xffff); a.o[8 * c + 5] = a.o[8 * c + 5] * al + p * bf2f(v.z >> 16);
        a.o[8 * c + 6] = a.o[8 * c + 6] * al + p * bf2f(v.w & 0xffff); a.o[8 * c + 7] = a.o[8 * c + 7] * al + p * bf2f(v.w >> 16); }
}
__device__ __forceinline__ void st_row64(bf16* p, const float* o, float inv) {
#pragma unroll
    for (int c = 0; c < 8; ++c) { u32x4 v;
        v.x = f2bf(o[8 * c + 0] * inv) | (f2bf(o[8 * c + 1] * inv) << 16); v.y = f2bf(o[8 * c + 2] * inv) | (f2bf(o[8 * c + 3] * inv) << 16);
        v.z = f2bf(o[8 * c + 4] * inv) | (f2bf(o[8 * c + 5] * inv) << 16); v.w = f2bf(o[8 * c + 6] * inv) | (f2bf(o[8 * c + 7] * inv) << 16);
        *(u32x4*)(p + 8 * c) = v; }
}
__global__ void __launch_bounds__(64) k_attnA(const bf16* qkv, const float* sinks, const Tabs* tb, bf16* ya) {
    const int t = blockIdx.x * 64 + threadIdx.x, h = blockIdx.y, b = t / S, i = t % S;
    float q[64]; ld_row64(qkv + (size_t)t * NQKV + C_QA + h * 64, q);
    SoftAcc a; a.m = sinks[h]; a.l = 1.f;
#pragma unroll
    for (int d = 0; d < 64; ++d) a.o[d] = 0.f;
    const int kvh = h >> 2;
    for (int off = -128; off <= 128; ++off) { const int j = i + off; if (j < 0 || j >= S) continue;
        const bf16* kr = qkv + (size_t)(b * S + j) * NQKV;
        att_key(a, q, kr + C_KA + kvh * 64, kr + C_VA + kvh * 64, tb->biasA[h][off + 128]); }
    st_row64(ya + (size_t)t * D + h * 64, a.o, 1.f / a.l);
}
__global__ void __launch_bounds__(64) k_attnB(const bf16* qkv, const Tabs* tb, bf16* yb) {
    const int t = blockIdx.x * 64 + threadIdx.x, hs = blockIdx.y, b = t / S, i = t % S;
    SoftAcc a; a.m = -1e30f; a.l = 0.f;
#pragma unroll
    for (int d = 0; d < 64; ++d) a.o[d] = 0.f;
    for (int g = 0; g < 3; ++g) { const int dil = (g == 0) ? 1 : (g == 1 ? 4 : 16);
        float q[64]; ld_row64(qkv + (size_t)t * NQKV + C_QB + g * 256 + hs * 64, q);
        for (int off = -64; off <= 64; ++off) { const int j = i + off * dil; if (j < 0 || j >= S) continue;
            const bf16* kr = qkv + (size_t)(b * S + j) * NQKV;
            att_key(a, q, kr + C_KB + g * 256 + hs * 64, kr + C_VB + g * 256 + hs * 64, tb->biasB[g][hs][off + 64]); } }
    st_row64(yb + (size_t)t * 256 + hs * 64, a.o, 1.f / a.l);
}
__global__ void __launch_bounds__(256) k_router(const float* x1, const float* g, const float* rw, const float* rb, bf16* h2, int* topi, float* topp, int* pos, int* cnt) {
    __shared__ float sh[4][D];
    const int w = threadIdx.x >> 6, lane = threadIdx.x & 63, gw = blockIdx.x * 4 + w, NGW = gridDim.x * 4;
    for (int m = gw; m < T; m += NGW) {
        const f32x4* xr = (const f32x4*)(x1 + (size_t)m * D) + lane; f32x4 v[4]; float s = 0.f;
#pragma unroll
        for (int j = 0; j < 4; ++j) { v[j] = xr[64 * j]; s += v[j].x * v[j].x + v[j].y * v[j].y + v[j].z * v[j].z + v[j].w * v[j].w; }
        const float rstd = 1.f / sqrtf(wave_sum(s) * (1.f / D) + EPS);
        unsigned long long* o8 = (unsigned long long*)(h2 + (size_t)m * D) + lane;
#pragma unroll
        for (int j = 0; j < 4; ++j) { const f32x4 gg = ((const f32x4*)g)[lane + 64 * j]; f32x4 y; y.x = v[j].x * rstd * gg.x; y.y = v[j].y * rstd * gg.y; y.z = v[j].z * rstd * gg.z; y.w = v[j].w * rstd * gg.w;
            *(f32x4*)&sh[w][4 * (lane + 64 * j)] = y;
            o8[64 * j] = (unsigned long long)(f2bf(y.x) | (f2bf(y.y) << 16)) | ((unsigned long long)(f2bf(y.z) | (f2bf(y.w) << 16)) << 32); }
        __builtin_amdgcn_s_waitcnt(0);
        const int e = lane & 31, kh = lane >> 5; float acc = 0.f;
        for (int k = kh * 512; k < kh * 512 + 512; ++k) acc += sh[w][k] * rw[(size_t)k * NE + e];
        acc += __shfl_xor(acc, 32); acc += rb[e];
        float val = acc; int myrank = -1; float tv[4]; int ti[4];
#pragma unroll
        for (int r = 0; r < 4; ++r) {
            float bv = val; int bi = e;
#pragma unroll
            for (int o = 1; o < 32; o <<= 1) { const float ov = __shfl_xor(bv, o); const int oi = __shfl_xor(bi, o); if (ov > bv || (ov == bv && oi < bi)) { bv = ov; bi = oi; } }
            tv[r] = bv; ti[r] = bi; if (bi == e) { val = -3.0e38f; myrank = r; }
        }
        (void)myrank;
        const float e0 = 1.f, e1 = __expf(tv[1] - tv[0]), e2 = __expf(tv[2] - tv[0]), e3 = __expf(tv[3] - tv[0]); const float inv = 1.f / (e0 + e1 + e2 + e3);
        if (lane < 4) { const float p = (lane == 0 ? e0 : lane == 1 ? e1 : lane == 2 ? e2 : e3) * inv; const int ex = (lane == 0 ? ti[0] : lane == 1 ? ti[1] : lane == 2 ? ti[2] : ti[3]);
            topi[m * 4 + lane] = ex; topp[m * 4 + lane] = p; pos[m * 4 + lane] = atomicAdd(&cnt[ex], 1); }
        __builtin_amdgcn_s_waitcnt(0);
    }
}
__global__ void k_offsets(const int* cnt, Tabs* tb) { if (threadIdx.x == 0) { int a = 0; for (int e = 0; e < NE; ++e) { tb->off[e] = a; a += cnt[e]; } tb->off[NE] = a; } }
__global__ void k_scatter(const int* topi, const int* pos, const Tabs* tb, int* rowtok, int* slot) {
    const int i = blockIdx.x * blockDim.x + threadIdx.x; if (i >= T * 4) return;
    const int row = tb->off[topi[i]] + pos[i]; rowtok[row] = i >> 2; slot[i] = row;
}
__global__ void k_final(float* out, const bf16* ys, const int* slot, const float* topp, const float* g) {
    const int gw = (blockIdx.x * blockDim.x + threadIdx.x) >> 6, lane = threadIdx.x & 63, NGW = (gridDim.x * blockDim.x) >> 6;
    for (int m = gw; m < T; m += NGW) {
        f32x4* xr = (f32x4*)(out + (size_t)m * D) + lane; f32x4 v[4];
#pragma unroll
        for (int j = 0; j < 4; ++j) v[j] = xr[64 * j];
#pragma unroll
        for (int k = 0; k < 4; ++k) { const int r = slot[m * 4 + k]; const float p = topp[m * 4 + k]; const unsigned long long* yr = (const unsigned long long*)(ys + (size_t)r * D) + lane;
#pragma unroll
            for (int j = 0; j < 4; ++j) { const unsigned long long u = yr[64 * j]; const unsigned lo = (unsigned)u, hi = (unsigned)(u >> 32);
                v[j].x += p * bf2f(lo & 0xffff); v[j].y += p * bf2f(lo >> 16); v[j].z += p * bf2f(hi & 0xffff); v[j].w += p * bf2f(hi >> 16); } }
        float s = 0.f;
#pragma unroll
        for (int j = 0; j < 4; ++j) s += v[j].x * v[j].x + v[j].y * v[j].y + v[j].z * v[j].z + v[j].w * v[j].w;
        const float rstd = 1.f / sqrtf(wave_sum(s) * (1.f / D) + EPS);
#pragma unroll
        for (int j = 0; j < 4; ++j) { const f32x4 gg = ((const f32x4*)g)[lane + 64 * j]; f32x4 y; y.x = v[j].x * rstd * gg.x; y.y = v[j].y * rstd * gg.y; y.z = v[j].z * rstd * gg.z; y.w = v[j].w * rstd * gg.w; xr[64 * j] = y; }
    }
}

extern "C" void kernel_launch(void* const* d_in, const int* in_sizes, int n_in, void* d_out, int out_size, void* d_ws, size_t ws_size, hipStream_t stream) {
    if (n_in != 19 || in_sizes[0] != T * D || out_size != T * D || ws_size < WS_END) { fprintf(stderr, "kernel_launch: unexpected shapes (n_in %d, ws %zu)\n", n_in, ws_size); return; }
    const float* x = (const float*)d_in[0]; const float* norm_mix = (const float*)d_in[1]; const float* w_in = (const float*)d_in[2]; const float* b_in = (const float*)d_in[3];
    const float* sinks = (const float*)d_in[4]; const float* rel_bias = (const float*)d_in[5]; const float* w_a = (const float*)d_in[6]; const float* w_b = (const float*)d_in[7];
    const float* w_out = (const float*)d_in[8]; const float* norm_ffn = (const float*)d_in[9]; const float* router_w = (const float*)d_in[10]; const float* router_b = (const float*)d_in[11];
    const float* w_gate = (const float*)d_in[12]; const float* b_gate = (const float*)d_in[13]; const float* w_up = (const float*)d_in[14]; const float* b_up = (const float*)d_in[15];
    const float* w_down = (const float*)d_in[16]; const float* b_down = (const float*)d_in[17]; const float* norm_final = (const float*)d_in[18];
    unsigned char* ws = (unsigned char*)d_ws; float* out = (float*)d_out;
    int* cnt = (int*)(ws + WS_CTL); Tabs* tb = (Tabs*)(ws + WS_TAB);
    int* topi = (int*)(ws + WS_RT); float* topp = (float*)(ws + WS_RT + 256 * 1024); int* slot = (int*)(ws + WS_RT + 512 * 1024); int* pos = (int*)(ws + WS_RT + 768 * 1024); int* rowtok = (int*)(ws + WS_RT + 1024 * 1024);
    bf16* XN = (bf16*)(ws + WS_XN); bf16* QKV = (bf16*)(ws + WS_QKV); bf16* GATES = (bf16*)(ws + WS_GATES); bf16* YA = (bf16*)(ws + WS_YA); bf16* YB = (bf16*)(ws + WS_YB);
    bf16* MERGED = (bf16*)(ws + WS_MERGED); bf16* YS = (bf16*)(ws + WS_YS); bf16* ACT = (bf16*)(ws + WS_ACT);
    hipMemsetAsync(ws + WS_CTL, 0, 1 * MiB, stream);
    k_prep<<<17, 256, 0, stream>>>(rel_bias, tb);
    k_rmsnorm<<<1024, 256, 0, stream>>>(x, norm_mix, XN);
    { GArgs g{}; g.A = XN; g.lda = D; g.W = w_in; g.ldw = NPROJ; g.M = T; g.N = NPROJ; g.K = D; g.bias = b_in; g.o16 = QKV; g.o16b = GATES;
      k_gemm<EPI_PROJ><<<dim3(NPROJ / 64, T / 64, 1), 256, 0, stream>>>(g); }
    k_attnA<<<dim3(T / 64, 16), 64, 0, stream>>>(QKV, sinks, tb, YA);
    k_attnB<<<dim3(T / 64, 4), 64, 0, stream>>>(QKV, tb, YB);
    { GArgs g{}; g.A = YB; g.lda = 256; g.W = w_b; g.ldw = D; g.M = T; g.N = D; g.K = 256; g.gates = GATES; g.o16 = MERGED;
      k_gemm<EPI_M1><<<dim3(D / 64, T / 64, 1), 256, 0, stream>>>(g); }
    { GArgs g{}; g.A = YA; g.lda = D; g.W = w_a; g.ldw = D; g.M = T; g.N = D; g.K = D; g.gates = GATES; g.o16 = MERGED;
      k_gemm<EPI_MERGE><<<dim3(D / 64, T / 64, 1), 256, 0, stream>>>(g); }
    { GArgs g{}; g.A = MERGED; g.lda = D; g.W = w_out; g.ldw = D; g.M = T; g.N = D; g.K = D; g.x = x; g.o32 = out;
      k_gemm<EPI_X1><<<dim3(D / 64, T / 64, 1), 256, 0, stream>>>(g); }
    k_router<<<1024, 256, 0, stream>>>(out, norm_ffn, router_w, router_b, XN, topi, topp, pos, cnt);
    k_offsets<<<1, 64, 0, stream>>>(cnt, tb);
    k_scatter<<<T * 4 / 256, 256, 0, stream>>>(topi, pos, tb, rowtok, slot);
    { GArgs g{}; g.A = XN; g.lda = D; g.rowidx = rowtok; g.W = w_gate; g.W2 = w_up; g.ldw = D; g.wstride = (size_t)D * D; g.M = 0; g.N = D; g.K = D; g.off = tb->off; g.bias = b_gate; g.bias2 = b_up; g.o16 = ACT;
      k_gemm<EPI_GATEUP><<<dim3(D / 64, T / 64, NE), 256, 0, stream>>>(g); }
    { GArgs g{}; g.A = ACT; g.lda = D; g.W = w_down; g.ldw = D; g.wstride = (size_t)D * D; g.M = 0; g.N = D; g.K = D; g.off = tb->off; g.bias = b_down; g.o16 = YS;
      k_gemm<EPI_DOWN><<<dim3(D / 64, T / 64, NE), 256, 0, stream>>>(g); }
    k_final<<<1024, 256, 0, stream>>>(out, YS, slot, topp, norm_final);
}
```

```cpp
#include <hip/hip_runtime.h>
#include <stdint.h>
#include <stdio.h>

#ifndef MK_MODE
#define MK_MODE 2
#endif

typedef unsigned short bf16;
typedef short bf16x8 __attribute__((ext_vector_type(8)));
typedef float f32x4 __attribute__((ext_vector_type(4)));
typedef float f32x2 __attribute__((ext_vector_type(2)));
typedef unsigned u32x4 __attribute__((ext_vector_type(4)));
typedef unsigned u32x2 __attribute__((ext_vector_type(2)));
#define GAS __attribute__((address_space(1)))
#define LAS __attribute__((address_space(3)))
typedef GAS unsigned gu32;

constexpr int T = 16384, S = 8192, D = 1024, NPROJ = 5888, NQKV = 3840, NGATE = 2048, NE = 32, TOPK = 4;
constexpr int C_QA = 0, C_KA = 1024, C_VA = 1280, C_QB = 1536, C_KB = 2304, C_VB = 3072;
constexpr float EPS = 1e-5f;
constexpr size_t MiB = 1u << 20;
constexpr size_t WS_CTL = 0, CTL_ZERO_BYTES = 1 * MiB;
constexpr size_t WS_TAB = 1 * MiB;
constexpr size_t WS_WIN = 2 * MiB;
constexpr size_t WS_WA = 14 * MiB;
constexpr size_t WS_WB = 16 * MiB;
constexpr size_t WS_WOUT = 17 * MiB;
constexpr size_t WS_RT = 19 * MiB;
constexpr size_t WS_WGU = 24 * MiB;
constexpr size_t WS_WD = 152 * MiB;
constexpr size_t WS_XN = 216 * MiB;
constexpr size_t WS_QKV = 248 * MiB;
constexpr size_t WS_GATES = 368 * MiB;
constexpr size_t WS_YA = 432 * MiB;
constexpr size_t WS_YB = 464 * MiB;
constexpr size_t WS_MERGED = 472 * MiB;
constexpr size_t WS_HS = 248 * MiB;
constexpr size_t WS_ACT = 377 * MiB;
constexpr size_t WS_END = 506 * MiB;
constexpr int CW_CNT = 0;
constexpr int CW_BAR = 4096;

__device__ const unsigned char BKT_A[257] = {12,12,12,12,12,12,12,12,12,12,12,12,12,12,12,12,12,12,12,12,12,12,12,12,12,12,12,12,12,12,12,12,12,12,12,12,12,12,11,11,11,11,11,11,11,11,11,11,11,11,11,11,11,11,11,11,11,11,11,11,11,11,11,11,11,11,11,11,11,11,11,11,11,11,11,11,11,11,11,10,10,10,10,10,10,10,10,10,10,10,10,10,10,10,10,10,10,10,10,10,10,10,9,9,9,9,9,9,9,9,9,9,9,9,8,8,8,8,8,8,8,7,6,5,4,3,2,1,0,17,18,19,20,21,22,23,24,24,24,24,24,24,24,25,25,25,25,25,25,25,25,25,25,25,25,26,26,26,26,26,26,26,26,26,26,26,26,26,26,26,26,26,26,26,26,26,26,26,27,27,27,27,27,27,27,27,27,27,27,27,27,27,27,27,27,27,27,27,27,27,27,27,27,27,27,27,27,27,27,27,27,27,27,27,27,27,27,27,27,28,28,28,28,28,28,28,28,28,28,28,28,28,28,28,28,28,28,28,28,28,28,28,28,28,28,28,28,28,28,28,28,28,28,28,28,28,28};
__device__ const unsigned char BKT_B[3][129] = {
 {11,11,11,11,11,11,11,11,11,11,11,11,11,11,11,10,10,10,10,10,10,10,10,10,10,10,10,10,10,10,10,10,10,10,10,10,10,10,9,9,9,9,9,9,9,9,9,9,9,9,8,8,8,8,8,8,8,7,6,5,4,3,2,1,0,17,18,19,20,21,22,23,24,24,24,24,24,24,24,25,25,25,25,25,25,25,25,25,25,25,25,26,26,26,26,26,26,26,26,26,26,26,26,26,26,26,26,26,26,26,26,26,26,26,27,27,27,27,27,27,27,27,27,27,27,27,27,27,27},
 {13,13,13,13,13,13,13,13,13,13,13,13,13,13,13,13,13,13,13,13,13,13,13,12,12,12,12,12,12,12,12,12,12,12,12,12,12,12,12,12,12,12,11,11,11,11,11,11,11,11,11,11,10,10,10,10,10,10,9,9,9,8,8,4,0,20,24,24,25,25,25,26,26,26,26,26,26,27,27,27,27,27,27,27,27,27,27,28,28,28,28,28,28,28,28,28,28,28,28,28,28,28,28,28,28,28,29,29,29,29,29,29,29,29,29,29,29,29,29,29,29,29,29,29,29,29,29,29,29},
 {15,15,15,15,15,15,15,15,15,15,15,15,15,15,15,15,15,15,15,15,15,15,15,15,15,15,15,15,15,15,14,14,14,14,14,14,14,14,14,14,14,14,14,14,14,13,13,13,13,13,13,13,13,13,12,12,12,12,12,11,11,10,10,9,0,25,26,26,27,27,28,28,28,28,28,29,29,29,29,29,29,29,29,29,30,30,30,30,30,30,30,30,30,30,30,30,30,30,30,31,31,31,31,31,31,31,31,31,31,31,31,31,31,31,31,31,31,31,31,31,31,31,31,31,31,31,31,31,31}};

#define RLX_AGENT __ATOMIC_RELAXED, __HIP_MEMORY_SCOPE_AGENT
#define LDS_WAIT() asm volatile("s_waitcnt lgkmcnt(0)" ::: "memory")
#define VM_WAIT() asm volatile("s_waitcnt vmcnt(0)" ::: "memory")
__device__ __forceinline__ unsigned f2bf(float f) { unsigned u = __builtin_bit_cast(unsigned, f); return (u + 0x7fffu + ((u >> 16) & 1u)) >> 16; }
__device__ __forceinline__ unsigned pk2(float lo, float hi) { return f2bf(lo) | (f2bf(hi) << 16); }
__device__ __forceinline__ float bf2f(unsigned b) { return __builtin_bit_cast(float, b << 16); }
__device__ __forceinline__ float bflo(unsigned u) { return __builtin_bit_cast(float, u << 16); }
__device__ __forceinline__ float bfhi(unsigned u) { return __builtin_bit_cast(float, u & 0xffff0000u); }
__device__ __forceinline__ float wave_sum(float v) {
#pragma unroll
    for (int o = 1; o < 64; o <<= 1) v += __shfl_xor(v, o);
    return v;
}
__device__ __forceinline__ float sigm(float x) { return __builtin_amdgcn_rcpf(1.f + __builtin_amdgcn_exp2f(-1.4426950408889634f * x)); }

struct Tabs { float biasA[16][257]; float biasB[3][4][129]; };

namespace pg8 {
#define PG8_LAS __attribute__((address_space(3)))
typedef unsigned short bf16_t;
constexpr int BM = 256, BK = 64, HALF = 128, HTB = HALF * BK * 2, STAGE_BYTES = 8 * HTB, NXCD = 8, WGM = 8;
__host__ __device__ __forceinline__ int lds_byte(int r, int c) { const int st = (r >> 4) * 2 + (c >> 5), rr = r & 15, cc = c & 31, ob = rr * 64 + cc * 2; return st * 1024 + (ob ^ (((ob >> 9) & 1) << 5)); }
__host__ __device__ __forceinline__ void stage_rc(int b, int& R, int& C) { const int st = b / 1024, sb = b % 1024, swz = sb ^ (((sb >> 9) & 1) << 5); R = (st >> 1) * 16 + swz / 64; C = (st & 1) * 32 + (swz % 64) / 2; }
__host__ __device__ __forceinline__ int perm32(int rho) { const int n = rho >> 4, i = rho & 15; return 8 * (i >> 2) + 4 * n + (i & 3); }

struct Unit { int arow, brow, nrows, e; };
struct Gemm { const bf16_t* A; const bf16_t* Bt; int K; };

struct StaticOrder {
    int nM, nN, nwg, G, c;
    __device__ void init(int M, int N, int G_, int c_) { nM = M / BM; nN = N / BM; nwg = nM * nN; G = G_; c = c_; }
    __device__ bool next(int i, Unit& u) const {
        const long L = (long)i * G + c; if (L >= nwg) return false;
        int wgid = (int)L; { const int q = nwg / NXCD, r = nwg % NXCD, xcd = wgid % NXCD, off = wgid / NXCD; wgid = (xcd < r ? xcd * (q + 1) : r * (q + 1) + (xcd - r) * q) + off; }
        const int nig = WGM * nN, gid = wgid / nig, fm = gid * WGM, gsz = (nM - fm) < WGM ? (nM - fm) : WGM;
        u.arow = BM * (fm + ((wgid % nig) % gsz)); u.brow = BM * ((wgid % nig) / gsz); u.nrows = BM; u.e = 0; return true;
    }
    __device__ __forceinline__ void a_ready(const Unit&) const {}
    __device__ __forceinline__ void done(const Unit&) const {}
};
struct GroupOrder {
    const PG8_LAS int* toff; const PG8_LAS int* off; int NT, G, c, nunits;
    __device__ bool next(int i, Unit& u) const {
        const int L = i * G + c; if (L >= nunits) return false;
        const int mtg = L / NT, pn = L - mtg * NT;
        int e = 0;
        for (int j = 1; j < NE; ++j) e += (toff[j] <= mtg) ? 1 : 0;
        e = __builtin_amdgcn_readfirstlane(e);
        const int mt = mtg - __builtin_amdgcn_readfirstlane(toff[e]); const int o0 = __builtin_amdgcn_readfirstlane(off[e]), o1 = __builtin_amdgcn_readfirstlane(off[e + 1]);
        u.arow = o0 + BM * mt; const int rem = o1 - u.arow; u.nrows = rem < BM ? rem : BM; u.brow = (e * NT + pn) * BM; u.e = e; return true;
    }
    __device__ __forceinline__ void a_ready(const Unit&) const {}
    __device__ __forceinline__ void done(const Unit&) const {}
};

__device__ __forceinline__ unsigned cvt_pk_bf16(float lo, float hi) { unsigned r; asm volatile("v_cvt_pk_bf16_f32 %0, %1, %2" : "=v"(r) : "v"(lo), "v"(hi)); return r; }

struct EpiProj {
    static constexpr bool PERM = true, AFTER_DRAIN = false;
    bf16_t* qkv; bf16_t* gates; const float* bias;
    __device__ __forceinline__ void operator()(const f32x4 (&acc)[2][2][4][2], const Unit& u, int wr, int wc, int fr, int fq) const {
        const int colt = u.brow; const bool isq = colt < NQKV; bf16_t* base = isq ? qkv : gates; const int ldc = isq ? NQKV : NGATE; const int cb = isq ? colt : colt - NQKV;
        const int row0 = u.arow + wr * 64 + fr, col0 = cb + wc * 32 + 8 * fq, bcol0 = colt + wc * 32 + 8 * fq;
        f32x4 bv[2][2];
#pragma unroll
        for (int bj = 0; bj < 2; ++bj)
#pragma unroll
            for (int n = 0; n < 2; ++n) bv[bj][n] = *(const f32x4*)(bias + bcol0 + bj * HALF + 4 * n);
#pragma unroll
        for (int ai = 0; ai < 2; ++ai)
#pragma unroll
            for (int m = 0; m < 4; ++m) { bf16_t* rowp = base + (size_t)(row0 + ai * HALF + m * 16) * ldc + col0;
#pragma unroll
                for (int bj = 0; bj < 2; ++bj) { const f32x4 v0 = acc[ai][bj][m][0] + bv[bj][0], v1 = acc[ai][bj][m][1] + bv[bj][1];
                    u32x4 w; w.x = cvt_pk_bf16(v0[0], v0[1]); w.y = cvt_pk_bf16(v0[2], v0[3]); w.z = cvt_pk_bf16(v1[0], v1[1]); w.w = cvt_pk_bf16(v1[2], v1[3]);
                    *(u32x4*)(rowp + bj * HALF) = w; } }
    }
};
template <int MODE> struct EpiGate {
    static constexpr bool PERM = true, AFTER_DRAIN = false;
    bf16_t* out; const bf16_t* gates; int gcol0;
    __device__ __forceinline__ void operator()(const f32x4 (&acc)[2][2][4][2], const Unit& u, int wr, int wc, int fr, int fq) const {
        const int row0 = u.arow + wr * 64 + fr, col0 = u.brow + wc * 32 + 8 * fq;
#pragma unroll
        for (int ai = 0; ai < 2; ++ai)
#pragma unroll
            for (int m = 0; m < 4; ++m) { const size_t r = (size_t)(row0 + ai * HALF + m * 16);
#pragma unroll
                for (int bj = 0; bj < 2; ++bj) { const int c = col0 + bj * HALF;
                    const u32x4 gv = *(const u32x4*)(gates + r * NGATE + gcol0 + c); const f32x4 a0 = acc[ai][bj][m][0], a1 = acc[ai][bj][m][1];
                    float o[8]; o[0] = sigm(bflo(gv.x)) * a0[0]; o[1] = sigm(bfhi(gv.x)) * a0[1]; o[2] = sigm(bflo(gv.y)) * a0[2]; o[3] = sigm(bfhi(gv.y)) * a0[3];
                    o[4] = sigm(bflo(gv.z)) * a1[0]; o[5] = sigm(bfhi(gv.z)) * a1[1]; o[6] = sigm(bflo(gv.w)) * a1[2]; o[7] = sigm(bfhi(gv.w)) * a1[3];
                    if (MODE == 1) { const u32x4 mv = *(const u32x4*)(out + r * D + c);
                        o[0] += bflo(mv.x); o[1] += bfhi(mv.x); o[2] += bflo(mv.y); o[3] += bfhi(mv.y); o[4] += bflo(mv.z); o[5] += bfhi(mv.z); o[6] += bflo(mv.w); o[7] += bfhi(mv.w); }
                    u32x4 w; w.x = cvt_pk_bf16(o[0], o[1]); w.y = cvt_pk_bf16(o[2], o[3]); w.z = cvt_pk_bf16(o[4], o[5]); w.w = cvt_pk_bf16(o[6], o[7]);
                    *(u32x4*)(out + r * D + c) = w; }
                asm volatile("" ::: "memory"); }
    }
};
struct EpiX1 {
    static constexpr bool PERM = true, AFTER_DRAIN = false;
    const float* x; float* out;
    __device__ __forceinline__ void operator()(const f32x4 (&acc)[2][2][4][2], const Unit& u, int wr, int wc, int fr, int fq) const {
        const int row0 = u.arow + wr * 64 + fr, col0 = u.brow + wc * 32 + 8 * fq;
#pragma unroll
        for (int ai = 0; ai < 2; ++ai)
#pragma unroll
            for (int m = 0; m < 4; ++m) { const size_t r = (size_t)(row0 + ai * HALF + m * 16);
#pragma unroll
                for (int bj = 0; bj < 2; ++bj) { const size_t o = r * D + col0 + bj * HALF;
                    const f32x4 x0 = *(const f32x4*)(x + o), x1 = *(const f32x4*)(x + o + 4);
                    *(f32x4*)(out + o) = x0 + acc[ai][bj][m][0]; *(f32x4*)(out + o + 4) = x1 + acc[ai][bj][m][1]; }
                asm volatile("" ::: "memory"); }
    }
};
struct EpiSwiglu {
    static constexpr bool PERM = true, AFTER_DRAIN = false;
    bf16_t* act; const float* bg; const float* bu;
    __device__ __forceinline__ void operator()(const f32x4 (&acc)[2][2][4][2], const Unit& u, int wr, int wc, int fr, int fq) const {
        const int pn = (u.brow >> 8) & 7; const int col0 = pn * HALF + wc * 32 + 8 * fq; const int rl0 = wr * 64 + fr;
        const f32x4 g0 = *(const f32x4*)(bg + (size_t)u.e * D + col0), g1 = *(const f32x4*)(bg + (size_t)u.e * D + col0 + 4);
        const f32x4 u0 = *(const f32x4*)(bu + (size_t)u.e * D + col0), u1 = *(const f32x4*)(bu + (size_t)u.e * D + col0 + 4);
#pragma unroll
        for (int ai = 0; ai < 2; ++ai)
#pragma unroll
            for (int m = 0; m < 4; ++m) { const int rl = rl0 + ai * HALF + m * 16;
                const f32x4 ga = acc[ai][0][m][0] + g0, gb = acc[ai][0][m][1] + g1, ua = acc[ai][1][m][0] + u0, ub = acc[ai][1][m][1] + u1;
                float o[8];
#pragma unroll
                for (int j = 0; j < 4; ++j) { const float gt = fminf(ga[j], 7.f), up = fminf(fmaxf(ua[j], -7.f), 7.f); o[j] = gt * sigm(1.702f * gt) * (up + 1.f);
                    const float gt2 = fminf(gb[j], 7.f), up2 = fminf(fmaxf(ub[j], -7.f), 7.f); o[4 + j] = gt2 * sigm(1.702f * gt2) * (up2 + 1.f); }
                u32x4 w; w.x = cvt_pk_bf16(o[0], o[1]); w.y = cvt_pk_bf16(o[2], o[3]); w.z = cvt_pk_bf16(o[4], o[5]); w.w = cvt_pk_bf16(o[6], o[7]);
                if (rl < u.nrows) *(u32x4*)(act + (size_t)(u.arow + rl) * D + col0) = w; }
    }
};
struct EpiDown {
    static constexpr bool PERM = true, AFTER_DRAIN = false;
    bf16_t* ys; const float* bd;
    __device__ __forceinline__ void operator()(const f32x4 (&acc)[2][2][4][2], const Unit& u, int wr, int wc, int fr, int fq) const {
        const int pn = (u.brow >> 8) & 3; const int col0 = pn * BM + wc * 32 + 8 * fq; const int rl0 = wr * 64 + fr;
        f32x4 bv[2][2];
#pragma unroll
        for (int bj = 0; bj < 2; ++bj)
#pragma unroll
            for (int n = 0; n < 2; ++n) bv[bj][n] = *(const f32x4*)(bd + (size_t)u.e * D + col0 + bj * HALF + 4 * n);
#pragma unroll
        for (int ai = 0; ai < 2; ++ai)
#pragma unroll
            for (int m = 0; m < 4; ++m) { const int rl = rl0 + ai * HALF + m * 16; bf16_t* rowp = ys + (size_t)(u.arow + rl) * D + col0;
#pragma unroll
                for (int bj = 0; bj < 2; ++bj) { const f32x4 v0 = acc[ai][bj][m][0] + bv[bj][0], v1 = acc[ai][bj][m][1] + bv[bj][1];
                    u32x4 w; w.x = cvt_pk_bf16(v0[0], v0[1]); w.y = cvt_pk_bf16(v0[2], v0[3]); w.z = cvt_pk_bf16(v1[0], v1[1]); w.w = cvt_pk_bf16(v1[2], v1[3]);
                    if (rl < u.nrows) *(u32x4*)(rowp + bj * HALF) = w; } }
    }
};

template <class Epi, class Sched, bool ALIGN_EPI = false, bool SP2 = false>
__device__ __forceinline__ void gemm_phase(PG8_LAS unsigned char* lds, const Gemm g, const Sched& S, const Epi& E) {
    const int tid = threadIdx.x, wid = __builtin_amdgcn_readfirstlane(tid >> 6), lane = tid & 63, wr = wid >> 2, wc = wid & 3, fr = lane & 15, fq = lane >> 4;
    const int K = g.K, nt = K / BK;
    unsigned voffA[2], voffB[2];
#pragma unroll
    for (int i = 0; i < 2; ++i) { int R, C; stage_rc(tid * 16 + i * 8192, R, C); const int Rb = Epi::PERM ? ((R & ~31) + perm32(R & 31)) : R;
        voffA[i] = (unsigned)(R * K + C) * 2u; voffB[i] = (unsigned)(Rb * K + C) * 2u; }
    const size_t kstep = (size_t)(BK * 2);
    const size_t hstep = (size_t)HALF * K * 2;
    const size_t rowb = (size_t)K * 2;
    const unsigned ldsw = (unsigned)wid * 1024u;
    const int aoff = lds_byte(wr * 64 + fr, fq * 8), boff = lds_byte(wc * 32 + fr, fq * 8);
#define PG8_SA(b, h) (((b) * 2 + (h)) * HTB)
#define PG8_SB(b, h) ((4 + (b) * 2 + (h)) * HTB)
#define PG8_STAGE(bufoff, gbase, voff) do { _Pragma("unroll") for (int _i = 0; _i < 2; ++_i) \
        __builtin_amdgcn_global_load_lds((const unsigned*)((const char*)(gbase) + (voff)[_i]), (PG8_LAS unsigned*)(lds + (bufoff) + ldsw + _i * 8192), 16, 0, 0); } while (0)
#define PG8_LDA(dst, b, h) do { _Pragma("unroll") for (int m = 0; m < 4; ++m) _Pragma("unroll") for (int k = 0; k < 2; ++k) dst[m][k] = *(const PG8_LAS bf16x8*)(lds + PG8_SA(b, h) + aoff + m * 2048 + k * 1024); } while (0)
#define PG8_LDB(dst, b, h) do { _Pragma("unroll") for (int n = 0; n < 2; ++n) _Pragma("unroll") for (int k = 0; k < 2; ++k) dst[n][k] = *(const PG8_LAS bf16x8*)(lds + PG8_SB(b, h) + boff + n * 2048 + k * 1024); } while (0)
#define PG8_MMA(ai, bj, At, Bt) do { __builtin_amdgcn_s_setprio(1); _Pragma("unroll") for (int m = 0; m < 4; ++m) _Pragma("unroll") for (int n = 0; n < 2; ++n) _Pragma("unroll") for (int k = 0; k < 2; ++k) \
        acc[ai][bj][m][n] = __builtin_amdgcn_mfma_f32_16x16x32_bf16(Bt[n][k], At[m][k], acc[ai][bj][m][n], 0, 0, 0); __builtin_amdgcn_s_setprio(0); } while (0)
#define PG8_WAIT_V(n) asm volatile("s_waitcnt vmcnt(" #n ")" ::: "memory")
#define PG8_WAIT_L(n) asm volatile("s_waitcnt lgkmcnt(" #n ")" ::: "memory")
#define PG8_BAR __builtin_amdgcn_s_barrier()
#define PG8_SCHED __builtin_amdgcn_sched_barrier(0)
    Unit cur, nxt; int ui = 0;
    if (!S.next(0, cur)) return;
    f32x4 acc[2][2][4][2];
#pragma unroll
    for (int a = 0; a < 2; ++a)
#pragma unroll
        for (int b = 0; b < 2; ++b)
#pragma unroll
            for (int m = 0; m < 4; ++m)
#pragma unroll
                for (int n = 0; n < 2; ++n) acc[a][b][m][n] = (f32x4){0.f, 0.f, 0.f, 0.f};
    bf16x8 At[4][2], B0[2][2], B1[2][2];
    const char* cA = (const char*)g.A + (size_t)cur.arow * rowb; const char* cB = (const char*)g.Bt + (size_t)cur.brow * rowb;
    S.a_ready(cur);
    if constexpr (SP2) {
        PG8_STAGE(PG8_SB(0, 0), cB, voffB); PG8_STAGE(PG8_SB(0, 1), cB + hstep, voffB); PG8_STAGE(PG8_SA(0, 0), cA, voffA); PG8_STAGE(PG8_SA(0, 1), cA + hstep, voffA);
        if (wr == 1) PG8_BAR;
        PG8_WAIT_V(2); PG8_BAR;
        PG8_STAGE(PG8_SB(1, 0), cB + kstep, voffB); PG8_STAGE(PG8_SA(1, 0), cA + kstep, voffA); PG8_STAGE(PG8_SB(1, 1), cB + hstep + kstep, voffB);
        PG8_WAIT_V(6); PG8_BAR;
    } else {
        PG8_STAGE(PG8_SB(0, 0), cB, voffB); PG8_STAGE(PG8_SA(0, 0), cA, voffA); PG8_STAGE(PG8_SB(0, 1), cB + hstep, voffB); PG8_STAGE(PG8_SA(0, 1), cA + hstep, voffA);
        if (wr == 1) PG8_BAR;
        PG8_WAIT_V(4); PG8_BAR;
        PG8_STAGE(PG8_SB(1, 0), cB + kstep, voffB); PG8_STAGE(PG8_SA(1, 0), cA + kstep, voffA); PG8_STAGE(PG8_SB(1, 1), cB + hstep + kstep, voffB);
        PG8_WAIT_V(6); PG8_BAR;
    }
    for (;;) {
        const bool has_next = S.next(ui + 1, nxt);
        const char* nA = has_next ? (const char*)g.A + (size_t)nxt.arow * rowb : cA; const char* nB = has_next ? (const char*)g.Bt + (size_t)nxt.brow * rowb : cB;
        for (int t = 0; t < nt; t += 2) {
            const bool last = (t == nt - 2);
            const char* a1 = cA + (size_t)(t + 1) * kstep;
            const char* a2 = last ? nA : cA + (size_t)(t + 2) * kstep; const char* b2 = last ? nB : cB + (size_t)(t + 2) * kstep;
            const char* a3 = a2 + kstep; const char* b3 = b2 + kstep;
            if (last && has_next) S.a_ready(nxt);
            if constexpr (SP2) {
            PG8_LDB(B0, 0, 0); PG8_LDB(B1, 0, 1); PG8_SCHED; PG8_LDA(At, 0, 0); PG8_STAGE(PG8_SA(1, 1), a1 + hstep, voffA);
            PG8_WAIT_V(8); PG8_WAIT_L(0); PG8_BAR; PG8_MMA(0, 0, At, B0); PG8_MMA(0, 1, At, B1); PG8_BAR; PG8_SCHED;
            PG8_LDA(At, 0, 1); PG8_STAGE(PG8_SB(0, 0), b2, voffB); PG8_STAGE(PG8_SB(0, 1), b2 + hstep, voffB); PG8_STAGE(PG8_SA(0, 0), a2, voffA);
            PG8_WAIT_V(8); PG8_WAIT_L(0); PG8_BAR; PG8_MMA(1, 0, At, B0); PG8_MMA(1, 1, At, B1); PG8_BAR; PG8_SCHED;
            PG8_LDB(B0, 1, 0); PG8_LDB(B1, 1, 1); PG8_SCHED; PG8_LDA(At, 1, 0); PG8_STAGE(PG8_SA(0, 1), a2 + hstep, voffA);
            PG8_WAIT_V(8); PG8_WAIT_L(0); PG8_BAR; PG8_MMA(0, 0, At, B0); PG8_MMA(0, 1, At, B1); PG8_BAR; PG8_SCHED;
            PG8_LDA(At, 1, 1); PG8_STAGE(PG8_SB(1, 0), b3, voffB); PG8_STAGE(PG8_SB(1, 1), b3 + hstep, voffB); PG8_STAGE(PG8_SA(1, 0), a3, voffA);
            PG8_WAIT_V(8); PG8_WAIT_L(0); PG8_BAR; PG8_MMA(1, 0, At, B0); PG8_MMA(1, 1, At, B1); PG8_BAR; PG8_SCHED;
            } else {
            PG8_LDB(B0, 0, 0); PG8_SCHED; PG8_LDA(At, 0, 0); PG8_STAGE(PG8_SA(1, 1), a1 + hstep, voffA);
            PG8_WAIT_L(8); PG8_BAR; PG8_WAIT_L(0); PG8_MMA(0, 0, At, B0); PG8_BAR; PG8_SCHED;
            PG8_LDB(B1, 0, 1); PG8_STAGE(PG8_SB(0, 0), b2, voffB);
            PG8_BAR; PG8_WAIT_L(0); PG8_MMA(0, 1, At, B1); PG8_BAR;
            PG8_LDA(At, 0, 1); PG8_STAGE(PG8_SA(0, 0), a2, voffA);
            PG8_BAR; PG8_WAIT_L(0); PG8_MMA(1, 0, At, B0); PG8_BAR; PG8_SCHED;
            PG8_STAGE(PG8_SB(0, 1), b2 + hstep, voffB);
            PG8_WAIT_V(6); PG8_BAR; PG8_MMA(1, 1, At, B1); PG8_BAR;
            PG8_LDB(B0, 1, 0); PG8_SCHED; PG8_LDA(At, 1, 0); PG8_STAGE(PG8_SA(0, 1), a2 + hstep, voffA);
            PG8_WAIT_L(8); PG8_BAR; PG8_WAIT_L(0); PG8_MMA(0, 0, At, B0); PG8_BAR; PG8_SCHED;
            PG8_LDB(B1, 1, 1); PG8_STAGE(PG8_SB(1, 0), b3, voffB);
            PG8_BAR; PG8_WAIT_L(0); PG8_MMA(0, 1, At, B1); PG8_BAR;
            PG8_LDA(At, 1, 1); PG8_STAGE(PG8_SA(1, 0), a3, voffA);
            PG8_BAR; PG8_WAIT_L(0); PG8_MMA(1, 0, At, B0); PG8_BAR; PG8_SCHED;
            PG8_STAGE(PG8_SB(1, 1), b3 + hstep, voffB);
            PG8_WAIT_V(6); PG8_BAR; PG8_MMA(1, 1, At, B1); PG8_BAR;
            }
        }
        if constexpr (ALIGN_EPI) { if (wr == 0) PG8_BAR; }
        if constexpr (!Epi::AFTER_DRAIN) { E(acc, cur, wr, wc, fr, fq); S.done(cur); }
        if (!has_next) break;
#pragma unroll
        for (int a = 0; a < 2; ++a)
#pragma unroll
            for (int b = 0; b < 2; ++b)
#pragma unroll
                for (int m = 0; m < 4; ++m)
#pragma unroll
                    for (int n = 0; n < 2; ++n) acc[a][b][m][n] = (f32x4){0.f, 0.f, 0.f, 0.f};
        cur = nxt; cA = nA; cB = nB; ++ui;
        if constexpr (ALIGN_EPI) { if (wr == 1) PG8_BAR; }
    }
    PG8_WAIT_V(0);
    if constexpr (!ALIGN_EPI) { if (wr == 0) PG8_BAR; }
    PG8_BAR;
    if constexpr (Epi::AFTER_DRAIN) { E.fused(acc, cur, wr, wc, fr, fq, lds, wid, lane); S.done(cur); }
#undef PG8_SA
#undef PG8_SB
#undef PG8_STAGE
#undef PG8_LDA
#undef PG8_LDB
#undef PG8_MMA
#undef PG8_WAIT_V
#undef PG8_WAIT_L
#undef PG8_BAR
#undef PG8_SCHED
}

}

#define XB_TMO      128
#define XB_XCNT(j)  (256  + 64 * (j))
#define XB_XSUB(j)  (1280 + 64 * (j))
#define XB_XGEN(j)  (2304 + 64 * (j))
#define XB_TOP      3328
#define XB_TOPGEN   3392
#define XCD_BAR_WORDS 3456
#define XB_SPIN_CAP (1u << 18)
__device__ __forceinline__ unsigned xb_ld(unsigned* p)              { return __hip_atomic_load(p, __ATOMIC_RELAXED, __HIP_MEMORY_SCOPE_AGENT); }
__device__ __forceinline__ unsigned xb_add(unsigned* p, unsigned v) { return __hip_atomic_fetch_add(p, v, __ATOMIC_RELAXED, __HIP_MEMORY_SCOPE_AGENT); }
__device__ __forceinline__ unsigned xb_xcc_id() { return (unsigned)__builtin_amdgcn_s_getreg((3 << 11) | 20) & 0xFu; }
#define XB_SPIN(cond, bar) do { unsigned _sp = 0; while (cond) { __builtin_amdgcn_s_sleep(1); \
    if ((++_sp & 255u) == 0u) { if (xb_ld(&(bar)[XB_TMO])) break; if (_sp > XB_SPIN_CAP) { atomicAdd(&(bar)[XB_TMO], 1u); break; } } } } while (0)
struct XcdBarrier { unsigned* bar; unsigned x; volatile LAS unsigned* st; };
__device__ __forceinline__ XcdBarrier xcd_barrier_post(unsigned* bar, volatile LAS unsigned* st) {
    XcdBarrier b; b.bar = bar; b.x = xb_xcc_id(); b.st = st;
    if (threadIdx.x == 0) (void)xb_add(&bar[XB_XCNT(b.x)], 1u);
    return b;
}
__device__ __forceinline__ void xcd_barrier_complete(unsigned* bar, unsigned x, unsigned& nloc, unsigned& nx) {
    const unsigned G = gridDim.x * gridDim.y * gridDim.z;
    unsigned sum, cnt, mine, sp = 0u;
    for (;;) {
        sum = 0u; cnt = 0u; mine = 0u;
#pragma unroll
        for (unsigned j = 0; j < 16; ++j) { const unsigned c = xb_ld(&bar[XB_XCNT(j)]); sum += c; cnt += (c > 0u) ? 1u : 0u; mine = (j == x) ? c : mine; }
        if (sum == G) break;
        __builtin_amdgcn_s_sleep(1);
        if ((++sp & 255u) == 0u) { if (xb_ld(&bar[XB_TMO])) break; if (sp > XB_SPIN_CAP) { atomicAdd(&bar[XB_TMO], 1u); break; } }
    }
    nloc = mine > 0u ? mine : 1u; nx = cnt > 0u ? cnt : 1u;
}
__device__ __forceinline__ void xcd_barrier(const XcdBarrier& b) {
    asm volatile("s_waitcnt vmcnt(0)" ::: "memory");
    __syncthreads();
    if (threadIdx.x == 0) {
        unsigned* bar = b.bar;
        __builtin_amdgcn_s_waitcnt(0);
        unsigned nloc = b.st[0], nx = b.st[1];
        if (nloc == 0u) { xcd_barrier_complete(bar, b.x, nloc, nx); b.st[0] = nloc; b.st[1] = nx; }
        const unsigned old = xb_add(&bar[XB_XSUB(b.x)], 1u);
        const unsigned gen = old / nloc;
        if (old + 1u == (gen + 1u) * nloc) {
            __builtin_amdgcn_fence(__ATOMIC_RELEASE, "agent");
            asm volatile("s_waitcnt vmcnt(0)" ::: "memory");
            const unsigned og = xb_add(&bar[XB_TOP], 1u);
            const unsigned tg = og / nx;
            if (og + 1u == (tg + 1u) * nx) xb_add(&bar[XB_TOPGEN], 1u);
            else XB_SPIN(xb_ld(&bar[XB_TOPGEN]) == tg, bar);
            __builtin_amdgcn_fence(__ATOMIC_ACQUIRE, "agent");
            xb_add(&bar[XB_XGEN(b.x)], 1u);
            asm volatile("s_waitcnt vmcnt(0)" ::: "memory");
        } else {
            XB_SPIN(xb_ld(&bar[XB_XGEN(b.x)]) == gen, bar);
            __builtin_amdgcn_fence(__ATOMIC_ACQUIRE, "agent");
            asm volatile("s_waitcnt vmcnt(0)" ::: "memory");
        }
    }
    __syncthreads();
}

constexpr int NWAVES = 8;
constexpr int RING_OFF = 0, RING_BYTES = 131072;
constexpr int LDSCTL_OFF = RING_BYTES, MISC_OFF = LDSCTL_OFF + 320;
constexpr int TBL_OFF = LDSCTL_OFF + 1024;
constexpr int LDS_BYTES = 147456;

struct Frame {
    LAS unsigned char* lds; volatile LAS unsigned* MISC; LAS int* tbl; gu32* ctl;
    int tid, lane, wave, vcu, G;
};

__device__ __forceinline__ void p0_transpose_item(const float* W, int K, int N, bf16* WT, int k0, int n0, int orow0, LAS float* scr, int lane) {
#pragma unroll 8
    for (int i = 0; i < 32; ++i) { const int kk = 2 * i + (lane >> 5); scr[kk * 33 + (lane & 31)] = W[(size_t)(k0 + kk) * N + n0 + (lane & 31)]; }
    LDS_WAIT(); asm volatile("" ::: "memory");
    const int c = lane & 7;
#pragma unroll
    for (int j = 0; j < 4; ++j) { const int n = (lane >> 3) + 8 * j; const LAS float* s = scr + (8 * c) * 33 + n;
        u32x4 o; o.x = pk2(s[0 * 33], s[1 * 33]); o.y = pk2(s[2 * 33], s[3 * 33]); o.z = pk2(s[4 * 33], s[5 * 33]); o.w = pk2(s[6 * 33], s[7 * 33]);
        *(GAS u32x4*)(WT + (size_t)(orow0 + n) * K + k0 + 8 * c) = o; }
    LDS_WAIT(); asm volatile("" ::: "memory");
}
__device__ __forceinline__ void rms_row_to_bf16(const float* xrow, const float* g, bf16* orow, int lane) {
    const GAS f32x4* xr = (const GAS f32x4*)xrow + lane; f32x4 v[4]; float s = 0.f;
#pragma unroll
    for (int j = 0; j < 4; ++j) { v[j] = xr[64 * j]; s += (v[j].x * v[j].x + v[j].y * v[j].y) + (v[j].z * v[j].z + v[j].w * v[j].w); }
    const float rstd = 1.f / sqrtf(wave_sum(s) * (1.f / D) + EPS);
    GAS unsigned long long* o8 = (GAS unsigned long long*)orow + lane;
#pragma unroll
    for (int j = 0; j < 4; ++j) { const f32x4 gg = ((const GAS f32x4*)g)[lane + 64 * j];
        o8[64 * j] = (unsigned long long)pk2(v[j].x * rstd * gg.x, v[j].y * rstd * gg.y) | ((unsigned long long)pk2(v[j].z * rstd * gg.z, v[j].w * rstd * gg.w) << 32); }
}

__device__ __forceinline__ void ld_row64(const bf16* p, float* f) {
#pragma unroll
    for (int c = 0; c < 8; ++c) { const u32x4 v = *(const u32x4*)(p + 8 * c);
        f[8 * c + 0] = bflo(v.x); f[8 * c + 1] = bfhi(v.x); f[8 * c + 2] = bflo(v.y); f[8 * c + 3] = bfhi(v.y);
        f[8 * c + 4] = bflo(v.z); f[8 * c + 5] = bfhi(v.z); f[8 * c + 6] = bflo(v.w); f[8 * c + 7] = bfhi(v.w); }
}
struct SoftAcc { float m, l; float o[64]; };
__device__ __forceinline__ void att_key(SoftAcc& a, const float* q, const bf16* kp, const bf16* vp, float bias) {
    float s = 0.f;
#pragma unroll
    for (int c = 0; c < 8; ++c) { const u32x4 v = *(const u32x4*)(kp + 8 * c);
        s += q[8 * c + 0] * bflo(v.x) + q[8 * c + 1] * bfhi(v.x) + q[8 * c + 2] * bflo(v.y) + q[8 * c + 3] * bfhi(v.y)
           + q[8 * c + 4] * bflo(v.z) + q[8 * c + 5] * bfhi(v.z) + q[8 * c + 6] * bflo(v.w) + q[8 * c + 7] * bfhi(v.w); }
    s = s * 0.125f + bias;
    const float mn = fmaxf(a.m, s), al = __expf(a.m - mn), p = __expf(s - mn);
    a.m = mn; a.l = a.l * al + p;
#pragma unroll
    for (int c = 0; c < 8; ++c) { const u32x4 v = *(const u32x4*)(vp + 8 * c);
        a.o[8 * c + 0] = a.o[8 * c + 0] * al + p * bflo(v.x); a.o[8 * c + 1] = a.o[8 * c + 1] * al + p * bfhi(v.x);
        a.o[8 * c + 2] = a.o[8 * c + 2] * al + p * bflo(v.y); a.o[8 * c + 3] = a.o[8 * c + 3] * al + p * bfhi(v.y);
        a.o[8 * c + 4] = a.o[8 * c + 4] * al + p * bflo(v.z); a.o[8 * c + 5] = a.o[8 * c + 5] * al + p * bfhi(v.z);
        a.o[8 * c + 6] = a.o[8 * c + 6] * al + p * bflo(v.w); a.o[8 * c + 7] = a.o[8 * c + 7] * al + p * bfhi(v.w); }
}
__device__ __forceinline__ void st_row64(bf16* p, const float* o, float inv) {
#pragma unroll
    for (int c = 0; c < 8; ++c) { u32x4 v;
        v.x = pk2(o[8 * c + 0] * inv, o[8 * c + 1] * inv); v.y = pk2(o[8 * c + 2] * inv, o[8 * c + 3] * inv);
        v.z = pk2(o[8 * c + 4] * inv, o[8 * c + 5] * inv); v.w = pk2(o[8 * c + 6] * inv, o[8 * c + 7] * inv);
        *(u32x4*)(p + 8 * c) = v; }
}
__device__ __forceinline__ void attn_naive_A(const bf16* qkv, const float* sinks, const Tabs* tb, bf16* ya, int t, int h) {
    const int b = t / S, i = t % S;
    float q[64]; ld_row64(qkv + (size_t)t * NQKV + C_QA + h * 64, q);
    SoftAcc a; a.m = sinks[h]; a.l = 1.f;
#pragma unroll
    for (int d = 0; d < 64; ++d) a.o[d] = 0.f;
    const int kvh = h >> 2;
    for (int off = -128; off <= 128; ++off) { const int j = i + off; if (j < 0 || j >= S) continue;
        const bf16* kr = qkv + (size_t)(b * S + j) * NQKV;
        att_key(a, q, kr + C_KA + kvh * 64, kr + C_VA + kvh * 64, tb->biasA[h][off + 128]); }
    st_row64(ya + (size_t)t * D + h * 64, a.o, 1.f / a.l);
}
__device__ __forceinline__ void attn_naive_B(const bf16* qkv, const Tabs* tb, bf16* yb, int t, int hs) {
    const int b = t / S, i = t % S;
    SoftAcc a; a.m = -1e30f; a.l = 0.f;
#pragma unroll
    for (int d = 0; d < 64; ++d) a.o[d] = 0.f;
    for (int g = 0; g < 3; ++g) { const int dil = (g == 0) ? 1 : (g == 1 ? 4 : 16);
        float q[64]; ld_row64(qkv + (size_t)t * NQKV + C_QB + g * 256 + hs * 64, q);
        for (int off = -64; off <= 64; ++off) { const int j = i + off * dil; if (j < 0 || j >= S) continue;
            const bf16* kr = qkv + (size_t)(b * S + j) * NQKV;
            att_key(a, q, kr + C_KB + g * 256 + hs * 64, kr + C_VB + g * 256 + hs * 64, tb->biasB[g][hs][off + 64]); } }
    st_row64(yb + (size_t)t * 256 + hs * 64, a.o, 1.f / a.l);
}

struct Args { const float* in[19]; float* out; unsigned char* ws; int ph_lo, ph_hi, li, pad; };
constexpr int NPHASE = 10;

__global__ void __launch_bounds__(NWAVES * 64, 2) mk_fwd(Args args) {
    extern __shared__ __attribute__((aligned(16))) unsigned char lds[];
    Frame F;
    F.lds = (LAS unsigned char*)lds; F.MISC = (volatile LAS unsigned*)(F.lds + MISC_OFF); F.tbl = (LAS int*)(F.lds + TBL_OFF);
    F.tid = threadIdx.x; F.lane = F.tid & 63; F.wave = __builtin_amdgcn_readfirstlane(F.tid >> 6);
    F.G = gridDim.x; { const int bx = blockIdx.x; F.vcu = (F.G % 8 == 0) ? (bx % 8) * (F.G / 8) + bx / 8 : bx; }
    unsigned char* ws = args.ws; F.ctl = (gu32*)(ws + WS_CTL);
    const float* x = args.in[0]; const float* norm_mix = args.in[1]; const float* w_in = args.in[2]; const float* b_in = args.in[3];
    const float* sinks = args.in[4]; const float* rel_bias = args.in[5]; const float* w_a = args.in[6]; const float* w_b = args.in[7];
    const float* w_out = args.in[8]; const float* norm_ffn = args.in[9]; const float* router_w = args.in[10]; const float* router_b = args.in[11];
    const float* w_gate = args.in[12]; const float* b_gate = args.in[13]; const float* w_up = args.in[14]; const float* b_up = args.in[15];
    const float* w_down = args.in[16]; const float* b_down = args.in[17]; const float* norm_final = args.in[18];
    float* out = args.out;
    Tabs* tb = (Tabs*)(ws + WS_TAB);
    bf16* Win_t = (bf16*)(ws + WS_WIN); bf16* Wa_t = (bf16*)(ws + WS_WA); bf16* Wb_t = (bf16*)(ws + WS_WB); bf16* Wout_t = (bf16*)(ws + WS_WOUT);
    bf16* Wgu_t = (bf16*)(ws + WS_WGU); bf16* Wd_t = (bf16*)(ws + WS_WD);
    int* topi = (int*)(ws + WS_RT); float* topp = (float*)(ws + WS_RT + 256 * 1024); int* slot = (int*)(ws + WS_RT + 512 * 1024); int* pos = (int*)(ws + WS_RT + 768 * 1024);
    bf16* XN = (bf16*)(ws + WS_XN); bf16* QKV = (bf16*)(ws + WS_QKV); bf16* GATES = (bf16*)(ws + WS_GATES); bf16* YA = (bf16*)(ws + WS_YA); bf16* YB = (bf16*)(ws + WS_YB);
    bf16* MERGED = (bf16*)(ws + WS_MERGED); bf16* HS = (bf16*)(ws + WS_HS); bf16* ACT = (bf16*)(ws + WS_ACT);
    gu32* cnt = F.ctl + CW_CNT;

    for (int u = F.tid; u < (LDS_BYTES - LDSCTL_OFF) / 4; u += NWAVES * 64) ((LAS unsigned*)(F.lds + LDSCTL_OFF))[u] = 0u;
    __syncthreads();
    XcdBarrier bar = xcd_barrier_post((unsigned*)(F.ctl + CW_BAR) + args.li * XCD_BAR_WORDS, F.MISC + 8);
    const int lo = args.ph_lo, hi = args.ph_hi;
#ifndef MK_SKIP
#define MK_SKIP 0
#endif
#define IN(k) (!((MK_SKIP >> (k)) & 1) && lo <= (k) && (k) < hi)
#define SEAM(k) do { if (IN(k) && IN((k) + 1)) xcd_barrier(bar); } while (0)
    const int gw = F.vcu * NWAVES + F.wave, NGW = F.G * NWAVES;

    if (IN(0)) {
        { const int i = blockIdx.x * (NWAVES * 64) + F.tid;
          if (i < 16 * 257) { const int h = i / 257, r = i % 257; tb->biasA[h][r] = rel_bias[BKT_A[r] * 28 + h]; }
          if (i < 12 * 129) { const int g = i / (4 * 129), hs = (i / 129) % 4, r = i % 129; tb->biasB[g][hs][r] = rel_bias[BKT_B[g][r] * 28 + 16 + 4 * g + hs]; } }
        LAS float* scr = (LAS float*)(F.lds + RING_OFF + F.wave * 16384);
        constexpr int I_IN = (D / 64) * (NPROJ / 32), I_A = (D / 64) * (D / 32), I_B = (256 / 64) * (D / 32), I_E = (D / 64) * (D / 32);
        constexpr int NITEMS = I_IN + 2 * I_A + I_B + 3 * NE * I_E;
        for (int it = gw; it < NITEMS; it += NGW) {
            int r = it;
            if (r < I_IN) { const int nb = NPROJ / 32; p0_transpose_item(w_in, D, NPROJ, Win_t, 64 * (r / nb), 32 * (r % nb), 32 * (r % nb), scr, F.lane); continue; } r -= I_IN;
            if (r < I_A) { const int nb = D / 32; p0_transpose_item(w_a, D, D, Wa_t, 64 * (r / nb), 32 * (r % nb), 32 * (r % nb), scr, F.lane); continue; } r -= I_A;
            if (r < I_A) { const int nb = D / 32; p0_transpose_item(w_out, D, D, Wout_t, 64 * (r / nb), 32 * (r % nb), 32 * (r % nb), scr, F.lane); continue; } r -= I_A;
            if (r < I_B) { const int nb = D / 32; p0_transpose_item(w_b, 256, D, Wb_t, 64 * (r / nb), 32 * (r % nb), 32 * (r % nb), scr, F.lane); continue; } r -= I_B;
            { const int e = r / (3 * I_E), q = r % (3 * I_E), which = q / I_E, ii = q % I_E, nb = D / 32, k0 = 64 * (ii / nb), n0 = 32 * (ii % nb);
              if (which == 0) p0_transpose_item(w_gate + (size_t)e * D * D, D, D, Wgu_t, k0, n0, e * 2048 + (n0 >> 7) * 256 + (n0 & 127), scr, F.lane);
              else if (which == 1) p0_transpose_item(w_up + (size_t)e * D * D, D, D, Wgu_t, k0, n0, e * 2048 + (n0 >> 7) * 256 + 128 + (n0 & 127), scr, F.lane);
              else p0_transpose_item(w_down + (size_t)e * D * D, D, D, Wd_t, k0, n0, e * 1024 + n0, scr, F.lane); }
        }
        for (int m = gw; m < T; m += NGW) rms_row_to_bf16(x + (size_t)m * D, norm_mix, XN + (size_t)m * D, F.lane);
    }
    SEAM(0);
    if (IN(1)) {
        pg8::Gemm g{XN, Win_t, D}; pg8::StaticOrder So; So.init(T, NPROJ, F.G, (int)blockIdx.x);
        pg8::EpiProj E{QKV, GATES, b_in};
        pg8::gemm_phase<pg8::EpiProj, pg8::StaticOrder, true, true>(F.lds + RING_OFF, g, So, E);
    }
    SEAM(1);
    if (IN(2)) {
        for (int it = gw; it < 256 * 20; it += NGW) {
            if (it < 256 * 16) attn_naive_A(QKV, sinks, tb, YA, (it >> 4) * 64 + F.lane, it & 15);
            else { const int j = it - 256 * 16; attn_naive_B(QKV, tb, YB, (j >> 2) * 64 + F.lane, j & 3); }
        }
    }
    SEAM(2);
    if (IN(3)) {
#ifndef NO_P3A
        { int k256 = 256; asm volatile("" : "+s"(k256)); pg8::Gemm g{YB, Wb_t, k256}; pg8::StaticOrder So; So.init(T, D, F.G, (int)blockIdx.x);
          pg8::EpiGate<0> E{MERGED, GATES, 1024};
          pg8::gemm_phase<pg8::EpiGate<0>, pg8::StaticOrder, true, true>(F.lds + RING_OFF, g, So, E); }
#endif
        VM_WAIT(); __syncthreads();
#ifndef NO_P3B
        { pg8::Gemm g{YA, Wa_t, D}; pg8::StaticOrder So; So.init(T, D, F.G, (int)blockIdx.x);
          pg8::EpiGate<1> E{MERGED, GATES, 0};
          pg8::gemm_phase<pg8::EpiGate<1>, pg8::StaticOrder, true, true>(F.lds + RING_OFF, g, So, E); }
#endif
    }
    SEAM(3);
    if (IN(4)) {
        pg8::Gemm g{MERGED, Wout_t, D}; pg8::StaticOrder So; So.init(T, D, F.G, (int)blockIdx.x);
        pg8::EpiX1 E{x, out};
        pg8::gemm_phase<pg8::EpiX1, pg8::StaticOrder, true, true>(F.lds + RING_OFF, g, So, E);
    }
    SEAM(4);
    if (IN(5)) {
        LAS int* lcnt = F.tbl + 72; LAS int* lbase = F.tbl + 104; LAS int* ebuf = F.tbl + 136; LAS int* pbuf = F.tbl + 392;
        LAS float* sh = (LAS float*)(F.lds + RING_OFF) + F.wave * 4096;
        for (int tblk = F.vcu; tblk < T / 64; tblk += F.G) {
            if (F.tid < 32) lcnt[F.tid] = 0;
            __syncthreads();
            for (int pass = 0; pass < 2; ++pass) {
                const int m0 = tblk * 64 + F.wave * 8 + pass * 4;
#pragma unroll
                for (int tk = 0; tk < 4; ++tk) {
                    const GAS f32x4* xr = (const GAS f32x4*)(out + (size_t)(m0 + tk) * D) + F.lane; f32x4 v[4]; float s = 0.f;
#pragma unroll
                    for (int j = 0; j < 4; ++j) { v[j] = xr[64 * j]; s += (v[j].x * v[j].x + v[j].y * v[j].y) + (v[j].z * v[j].z + v[j].w * v[j].w); }
                    const float rstd = 1.f / sqrtf(wave_sum(s) * (1.f / D) + EPS);
                    GAS unsigned long long* o8 = (GAS unsigned long long*)(XN + (size_t)(m0 + tk) * D) + F.lane;
#pragma unroll
                    for (int j = 0; j < 4; ++j) { const f32x4 gg = ((const GAS f32x4*)norm_ffn)[F.lane + 64 * j]; f32x4 y; y.x = v[j].x * rstd * gg.x; y.y = v[j].y * rstd * gg.y; y.z = v[j].z * rstd * gg.z; y.w = v[j].w * rstd * gg.w;
                        *(LAS f32x4*)(sh + tk * 1024 + 4 * (F.lane + 64 * j)) = y;
                        o8[64 * j] = (unsigned long long)pk2(y.x, y.y) | ((unsigned long long)pk2(y.z, y.w) << 32); }
                }
                LDS_WAIT(); asm volatile("" ::: "memory");
                const int e = F.lane & 31, kh = F.lane >> 5; float acc[4] = {0.f, 0.f, 0.f, 0.f};
                for (int k = kh * 512; k < kh * 512 + 512; k += 4) {
                    const float w0 = router_w[(size_t)(k + 0) * NE + e], w1 = router_w[(size_t)(k + 1) * NE + e], w2 = router_w[(size_t)(k + 2) * NE + e], w3 = router_w[(size_t)(k + 3) * NE + e];
#pragma unroll
                    for (int tk = 0; tk < 4; ++tk) { const f32x4 hv = *(const LAS f32x4*)(sh + tk * 1024 + k); acc[tk] += hv.x * w0; acc[tk] += hv.y * w1; acc[tk] += hv.z * w2; acc[tk] += hv.w * w3; }
                }
                const float rbv = router_b[e];
#pragma unroll
                for (int tk = 0; tk < 4; ++tk) {
                    float val = acc[tk] + __shfl_xor(acc[tk], 32) + rbv; float tv[4]; int ti[4];
#pragma unroll
                    for (int r = 0; r < 4; ++r) {
                        float bv = val; int bi = e;
#pragma unroll
                        for (int o = 1; o < 32; o <<= 1) { const float ov = __shfl_xor(bv, o); const int oi = __shfl_xor(bi, o); if (ov > bv || (ov == bv && oi < bi)) { bv = ov; bi = oi; } }
                        tv[r] = bv; ti[r] = bi; if (bi == e) val = -3.0e38f;
                    }
                    const float e1 = __expf(tv[1] - tv[0]), e2 = __expf(tv[2] - tv[0]), e3 = __expf(tv[3] - tv[0]); const float inv = 1.f / (1.f + e1 + e2 + e3);
                    if (F.lane < 4) { const float p = (F.lane == 0 ? 1.f : F.lane == 1 ? e1 : F.lane == 2 ? e2 : e3) * inv; const int ex = (F.lane == 0 ? ti[0] : F.lane == 1 ? ti[1] : F.lane == 2 ? ti[2] : ti[3]);
                        const int m = m0 + tk; topi[m * 4 + F.lane] = ex; topp[m * 4 + F.lane] = p;
                        const int li = (F.wave * 8 + pass * 4 + tk) * 4 + F.lane; ebuf[li] = ex; pbuf[li] = __hip_atomic_fetch_add(&lcnt[ex], 1, __ATOMIC_RELAXED, __HIP_MEMORY_SCOPE_WORKGROUP); }
                }
                LDS_WAIT(); asm volatile("" ::: "memory");
            }
            __syncthreads();
            if (F.tid < 32) lbase[F.tid] = (int)__hip_atomic_fetch_add(cnt + F.tid, (unsigned)lcnt[F.tid], RLX_AGENT);
            __syncthreads();
            if (F.tid < 256) pos[tblk * 256 + F.tid] = lbase[ebuf[F.tid]] + pbuf[F.tid];
            __syncthreads();
        }
    }
    SEAM(5);
    if (IN(6) || IN(7) || IN(8)) {
        LAS int* loff = F.tbl; LAS int* ltoff = F.tbl + 36; LAS int* lc = F.tbl + 72;
        if (F.tid < 32) lc[F.tid] = (int)__hip_atomic_load(cnt + F.tid, RLX_AGENT);
        __syncthreads();
        if (F.tid == 0) { int a = 0, ta = 0; for (int e = 0; e < NE; ++e) { loff[e] = a; ltoff[e] = ta; const int c = lc[e]; a += c; ta += (c + 255) >> 8; } loff[NE] = a; ltoff[NE] = ta; }
        __syncthreads();
    }
    if (IN(6)) {
        const LAS int* loff = F.tbl;
        for (int p = gw; p < T * 4; p += NGW) {
            const int e = topi[p], row = loff[e] + pos[p];
            if (F.lane == 0) slot[p] = row;
            const GAS u32x4* src = (const GAS u32x4*)(XN + (size_t)(p >> 2) * D) + F.lane; GAS u32x4* dst = (GAS u32x4*)(HS + (size_t)row * D) + F.lane;
            const u32x4 a = src[0], b = src[64]; dst[0] = a; dst[64] = b;
        }
    }
    SEAM(6);
    if (IN(7)) {
        pg8::Gemm g{HS, Wgu_t, D}; pg8::GroupOrder So{F.tbl + 36, F.tbl, 8, F.G, (int)blockIdx.x, 0}; So.nunits = __builtin_amdgcn_readfirstlane(F.tbl[36 + NE]) * 8;
        pg8::EpiSwiglu E{ACT, b_gate, b_up};
        pg8::gemm_phase<pg8::EpiSwiglu, pg8::GroupOrder, true, true>(F.lds + RING_OFF, g, So, E);
    }
    SEAM(7);
    if (IN(8)) {
        pg8::Gemm g{ACT, Wd_t, D}; pg8::GroupOrder So{F.tbl + 36, F.tbl, 4, F.G, (int)blockIdx.x, 0}; So.nunits = __builtin_amdgcn_readfirstlane(F.tbl[36 + NE]) * 4;
        pg8::EpiDown E{HS, b_down};
        pg8::gemm_phase<pg8::EpiDown, pg8::GroupOrder, true, true>(F.lds + RING_OFF, g, So, E);
    }
    SEAM(8);
    if (IN(9)) {
        const bf16* ys = HS;
        for (int m = gw; m < T; m += NGW) {
            GAS f32x4* xr = (GAS f32x4*)(out + (size_t)m * D) + F.lane; f32x4 v[4];
#pragma unroll
            for (int j = 0; j < 4; ++j) v[j] = xr[64 * j];
#pragma unroll
            for (int k = 0; k < 4; ++k) { const int r = slot[m * 4 + k]; const float p = topp[m * 4 + k]; const GAS unsigned long long* yr = (const GAS unsigned long long*)(ys + (size_t)r * D) + F.lane;
#pragma unroll
                for (int j = 0; j < 4; ++j) { const unsigned long long u = yr[64 * j]; const unsigned l32 = (unsigned)u, h32 = (unsigned)(u >> 32);
                    v[j].x += p * bflo(l32); v[j].y += p * bfhi(l32); v[j].z += p * bflo(h32); v[j].w += p * bfhi(h32); } }
            float s = 0.f;
#pragma unroll
            for (int j = 0; j < 4; ++j) s += (v[j].x * v[j].x + v[j].y * v[j].y) + (v[j].z * v[j].z + v[j].w * v[j].w);
            const float rstd = 1.f / sqrtf(wave_sum(s) * (1.f / D) + EPS);
#pragma unroll
            for (int j = 0; j < 4; ++j) { const f32x4 gg = ((const GAS f32x4*)norm_final)[F.lane + 64 * j]; f32x4 y; y.x = v[j].x * rstd * gg.x; y.y = v[j].y * rstd * gg.y; y.z = v[j].z * rstd * gg.z; y.w = v[j].w * rstd * gg.w; xr[64 * j] = y; }
        }
    }
#undef IN
#undef SEAM
}

extern "C" void kernel_launch(void* const* d_in, const int* in_sizes, int n_in, void* d_out, int out_size, void* d_ws, size_t ws_size, hipStream_t stream) {
    static int grid = 0;
    if (grid == 0) {
        if (n_in != 19 || in_sizes[0] != T * D || out_size != T * D || ws_size < WS_END) { fprintf(stderr, "kernel_launch: unexpected shapes (n_in %d, ws %zu); nothing launched\n", n_in, ws_size); grid = -1; return; }
        int dev = 0, cus = 0, per_cu = 0;
        if (hipGetDevice(&dev) != hipSuccess || hipDeviceGetAttribute(&cus, hipDeviceAttributeMultiprocessorCount, dev) != hipSuccess) { grid = -1; return; }
        if (hipFuncSetAttribute((const void*)mk_fwd, hipFuncAttributeMaxDynamicSharedMemorySize, LDS_BYTES) != hipSuccess) { fprintf(stderr, "kernel_launch: hipFuncSetAttribute failed\n"); grid = -1; return; }
        if (hipOccupancyMaxActiveBlocksPerMultiprocessor(&per_cu, (const void*)mk_fwd, NWAVES * 64, LDS_BYTES) != hipSuccess || per_cu < 1) { fprintf(stderr, "kernel_launch: occupancy query says %d blocks per CU\n", per_cu); }
        (void)hipGetLastError();
        grid = cus;
        if (grid != 256) fprintf(stderr, "kernel_launch: %d CUs (built and tuned for 256)\n", grid);
    }
    if (grid < 0) return;
    if (hipMemsetAsync((char*)d_ws + WS_CTL, 0, CTL_ZERO_BYTES, stream) != hipSuccess) return;
    Args a{};
    for (int i = 0; i < 19; ++i) a.in[i] = (const float*)d_in[i];
    a.out = (float*)d_out; a.ws = (unsigned char*)d_ws;
#if MK_MODE == 2
    a.ph_lo = 0; a.ph_hi = NPHASE; a.li = 0;
    hipLaunchKernelGGL(mk_fwd, dim3(grid), dim3(NWAVES * 64), LDS_BYTES, stream, a);
#else
    for (int ph = 0; ph < NPHASE; ++ph) { a.ph_lo = ph; a.ph_hi = ph + 1; a.li = ph; hipLaunchKernelGGL(mk_fwd, dim3(grid), dim3(NWAVES * 64), LDS_BYTES, stream, a); }
#endif
}
```

```cpp
#include <hip/hip_runtime.h>
#include <stdint.h>
#include <stdio.h>

#ifndef MK_MODE
#define MK_MODE 2
#endif

typedef unsigned short bf16;
typedef short bf16x8 __attribute__((ext_vector_type(8)));
typedef float f32x4 __attribute__((ext_vector_type(4)));
typedef float f32x2 __attribute__((ext_vector_type(2)));
typedef unsigned u32x4 __attribute__((ext_vector_type(4)));
typedef unsigned u32x2 __attribute__((ext_vector_type(2)));
#define GAS __attribute__((address_space(1)))
#define LAS __attribute__((address_space(3)))
typedef GAS unsigned gu32;

constexpr int T = 16384, S = 8192, D = 1024, NPROJ = 5888, NQKV = 3840, NGATE = 2048, NE = 32, TOPK = 4;
constexpr int C_QA = 0, C_KA = 1024, C_VA = 1280, C_QB = 1536, C_KB = 2304, C_VB = 3072;
constexpr float EPS = 1e-5f;
constexpr size_t MiB = 1u << 20;
constexpr size_t WS_CTL = 0, CTL_ZERO_BYTES = 1 * MiB;
constexpr size_t WS_TAB = 1 * MiB;
constexpr size_t WS_WIN = 2 * MiB;
constexpr size_t WS_WA = 14 * MiB;
constexpr size_t WS_WB = 16 * MiB;
constexpr size_t WS_WOUT = 17 * MiB;
constexpr size_t WS_RT = 19 * MiB;
constexpr size_t WS_WGU = 24 * MiB;
constexpr size_t WS_WD = 152 * MiB;
constexpr size_t WS_XN = 216 * MiB;
constexpr size_t WS_QKV = 248 * MiB;
constexpr size_t WS_GATES = 368 * MiB;
constexpr size_t WS_YA = 432 * MiB;
constexpr size_t WS_YB = 464 * MiB;
constexpr size_t WS_MERGED = 472 * MiB;
constexpr size_t WS_VT = 472 * MiB;
constexpr size_t WS_HS = 248 * MiB;
constexpr size_t WS_ACT = 377 * MiB;
constexpr size_t WS_END = 506 * MiB;
constexpr int CW_CNT = 0;
constexpr int CW_BAR = 4096;

__device__ const unsigned char BKT_A[257] = {12,12,12,12,12,12,12,12,12,12,12,12,12,12,12,12,12,12,12,12,12,12,12,12,12,12,12,12,12,12,12,12,12,12,12,12,12,12,11,11,11,11,11,11,11,11,11,11,11,11,11,11,11,11,11,11,11,11,11,11,11,11,11,11,11,11,11,11,11,11,11,11,11,11,11,11,11,11,11,10,10,10,10,10,10,10,10,10,10,10,10,10,10,10,10,10,10,10,10,10,10,10,9,9,9,9,9,9,9,9,9,9,9,9,8,8,8,8,8,8,8,7,6,5,4,3,2,1,0,17,18,19,20,21,22,23,24,24,24,24,24,24,24,25,25,25,25,25,25,25,25,25,25,25,25,26,26,26,26,26,26,26,26,26,26,26,26,26,26,26,26,26,26,26,26,26,26,26,27,27,27,27,27,27,27,27,27,27,27,27,27,27,27,27,27,27,27,27,27,27,27,27,27,27,27,27,27,27,27,27,27,27,27,27,27,27,27,27,27,28,28,28,28,28,28,28,28,28,28,28,28,28,28,28,28,28,28,28,28,28,28,28,28,28,28,28,28,28,28,28,28,28,28,28,28,28,28};
__device__ const unsigned char BKT_B[3][129] = {
 {11,11,11,11,11,11,11,11,11,11,11,11,11,11,11,10,10,10,10,10,10,10,10,10,10,10,10,10,10,10,10,10,10,10,10,10,10,10,9,9,9,9,9,9,9,9,9,9,9,9,8,8,8,8,8,8,8,7,6,5,4,3,2,1,0,17,18,19,20,21,22,23,24,24,24,24,24,24,24,25,25,25,25,25,25,25,25,25,25,25,25,26,26,26,26,26,26,26,26,26,26,26,26,26,26,26,26,26,26,26,26,26,26,26,27,27,27,27,27,27,27,27,27,27,27,27,27,27,27},
 {13,13,13,13,13,13,13,13,13,13,13,13,13,13,13,13,13,13,13,13,13,13,13,12,12,12,12,12,12,12,12,12,12,12,12,12,12,12,12,12,12,12,11,11,11,11,11,11,11,11,11,11,10,10,10,10,10,10,9,9,9,8,8,4,0,20,24,24,25,25,25,26,26,26,26,26,26,27,27,27,27,27,27,27,27,27,27,28,28,28,28,28,28,28,28,28,28,28,28,28,28,28,28,28,28,28,29,29,29,29,29,29,29,29,29,29,29,29,29,29,29,29,29,29,29,29,29,29,29},
 {15,15,15,15,15,15,15,15,15,15,15,15,15,15,15,15,15,15,15,15,15,15,15,15,15,15,15,15,15,15,14,14,14,14,14,14,14,14,14,14,14,14,14,14,14,13,13,13,13,13,13,13,13,13,12,12,12,12,12,11,11,10,10,9,0,25,26,26,27,27,28,28,28,28,28,29,29,29,29,29,29,29,29,29,30,30,30,30,30,30,30,30,30,30,30,30,30,30,30,31,31,31,31,31,31,31,31,31,31,31,31,31,31,31,31,31,31,31,31,31,31,31,31,31,31,31,31,31,31}};

#define RLX_AGENT __ATOMIC_RELAXED, __HIP_MEMORY_SCOPE_AGENT
#define LDS_WAIT() asm volatile("s_waitcnt lgkmcnt(0)" ::: "memory")
#define VM_WAIT() asm volatile("s_waitcnt vmcnt(0)" ::: "memory")
__device__ __forceinline__ unsigned f2bf(float f) { unsigned u = __builtin_bit_cast(unsigned, f); return (u + 0x7fffu + ((u >> 16) & 1u)) >> 16; }
__device__ __forceinline__ unsigned pk2(float lo, float hi) { return f2bf(lo) | (f2bf(hi) << 16); }
__device__ __forceinline__ float bf2f(unsigned b) { return __builtin_bit_cast(float, b << 16); }
__device__ __forceinline__ float bflo(unsigned u) { return __builtin_bit_cast(float, u << 16); }
__device__ __forceinline__ float bfhi(unsigned u) { return __builtin_bit_cast(float, u & 0xffff0000u); }
__device__ __forceinline__ float wave_sum(float v) {
#pragma unroll
    for (int o = 1; o < 64; o <<= 1) v += __shfl_xor(v, o);
    return v;
}
__device__ __forceinline__ float sigm(float x) { return __builtin_amdgcn_rcpf(1.f + __builtin_amdgcn_exp2f(-1.4426950408889634f * x)); }

struct Tabs { float biasA[16][257]; float biasB[3][4][129]; };

namespace pg8 {
#define PG8_LAS __attribute__((address_space(3)))
typedef unsigned short bf16_t;
constexpr int BM = 256, BK = 64, HALF = 128, HTB = HALF * BK * 2, STAGE_BYTES = 8 * HTB, NXCD = 8, WGM = 8;
__host__ __device__ __forceinline__ int lds_byte(int r, int c) { const int st = (r >> 4) * 2 + (c >> 5), rr = r & 15, cc = c & 31, ob = rr * 64 + cc * 2; return st * 1024 + (ob ^ (((ob >> 9) & 1) << 5)); }
__host__ __device__ __forceinline__ void stage_rc(int b, int& R, int& C) { const int st = b / 1024, sb = b % 1024, swz = sb ^ (((sb >> 9) & 1) << 5); R = (st >> 1) * 16 + swz / 64; C = (st & 1) * 32 + (swz % 64) / 2; }
__host__ __device__ __forceinline__ int perm32(int rho) { const int n = rho >> 4, i = rho & 15; return 8 * (i >> 2) + 4 * n + (i & 3); }

struct Unit { int arow, brow, nrows, e; };
struct Gemm { const bf16_t* A; const bf16_t* Bt; int K; };

struct StaticOrder {
    int nM, nN, nwg, G, c;
    __device__ void init(int M, int N, int G_, int c_) { nM = M / BM; nN = N / BM; nwg = nM * nN; G = G_; c = c_; }
    __device__ bool next(int i, Unit& u) const {
        const long L = (long)i * G + c; if (L >= nwg) return false;
        int wgid = (int)L; { const int q = nwg / NXCD, r = nwg % NXCD, xcd = wgid % NXCD, off = wgid / NXCD; wgid = (xcd < r ? xcd * (q + 1) : r * (q + 1) + (xcd - r) * q) + off; }
        const int nig = WGM * nN, gid = wgid / nig, fm = gid * WGM, gsz = (nM - fm) < WGM ? (nM - fm) : WGM;
        u.arow = BM * (fm + ((wgid % nig) % gsz)); u.brow = BM * ((wgid % nig) / gsz); u.nrows = BM; u.e = 0; return true;
    }
    __device__ __forceinline__ void a_ready(const Unit&) const {}
    __device__ __forceinline__ void done(const Unit&) const {}
};
struct GroupOrder {
    const PG8_LAS int* toff; const PG8_LAS int* off; int NT, G, c, nunits;
    __device__ bool next(int i, Unit& u) const {
        const int L = i * G + c; if (L >= nunits) return false;
        const int mtg = L / NT, pn = L - mtg * NT;
        int e = 0;
        for (int j = 1; j < NE; ++j) e += (toff[j] <= mtg) ? 1 : 0;
        e = __builtin_amdgcn_readfirstlane(e);
        const int mt = mtg - __builtin_amdgcn_readfirstlane(toff[e]); const int o0 = __builtin_amdgcn_readfirstlane(off[e]), o1 = __builtin_amdgcn_readfirstlane(off[e + 1]);
        u.arow = o0 + BM * mt; const int rem = o1 - u.arow; u.nrows = rem < BM ? rem : BM; u.brow = (e * NT + pn) * BM; u.e = e; return true;
    }
    __device__ __forceinline__ void a_ready(const Unit&) const {}
    __device__ __forceinline__ void done(const Unit&) const {}
};

__device__ __forceinline__ unsigned cvt_pk_bf16(float lo, float hi) { unsigned r; asm volatile("v_cvt_pk_bf16_f32 %0, %1, %2" : "=v"(r) : "v"(lo), "v"(hi)); return r; }

struct EpiProj {
    static constexpr bool PERM = true, AFTER_DRAIN = false;
    bf16_t* qkv; bf16_t* gates; const float* bias; bf16_t* vta; bf16_t* vtb;
    __device__ __forceinline__ void operator()(const f32x4 (&acc)[2][2][4][2], const Unit& u, int wr, int wc, int fr, int fq) const {
        const int colt = u.brow; const bool isq = colt < NQKV; bf16_t* base = isq ? qkv : gates; const int ldc = isq ? NQKV : NGATE; const int cb = isq ? colt : colt - NQKV;
        const int row0 = u.arow + wr * 64 + fr, col0 = cb + wc * 32 + 8 * fq, bcol0 = colt + wc * 32 + 8 * fq;
        f32x4 bv[2][2];
#pragma unroll
        for (int bj = 0; bj < 2; ++bj)
#pragma unroll
            for (int n = 0; n < 2; ++n) bv[bj][n] = *(const f32x4*)(bias + bcol0 + bj * HALF + 4 * n);
        const bool isv = (colt == C_VA) || (colt >= C_VB && colt < NQKV);
        if (!isv) {
#pragma unroll
        for (int ai = 0; ai < 2; ++ai)
#pragma unroll
            for (int m = 0; m < 4; ++m) { bf16_t* rowp = base + (size_t)(row0 + ai * HALF + m * 16) * ldc + col0;
#pragma unroll
                for (int bj = 0; bj < 2; ++bj) { const f32x4 v0 = acc[ai][bj][m][0] + bv[bj][0], v1 = acc[ai][bj][m][1] + bv[bj][1];
                    u32x4 w; w.x = cvt_pk_bf16(v0[0], v0[1]); w.y = cvt_pk_bf16(v0[2], v0[3]); w.z = cvt_pk_bf16(v1[0], v1[1]); w.w = cvt_pk_bf16(v1[2], v1[3]);
                    *(u32x4*)(rowp + bj * HALF) = w; } }
        } else {
            const int gsel = (colt == C_VA) ? -1 : ((colt - C_VB) >> 8); const int sh = (gsel <= 0) ? 0 : (gsel == 1 ? 2 : 4);
            bf16_t* vb = (gsel < 0) ? vta : vtb + (size_t)gsel * (2 * 256 * 8192); const int c0 = wc * 32 + 8 * fq;
#pragma unroll
            for (int ai = 0; ai < 2; ++ai)
#pragma unroll
                for (int m = 0; m < 4; ++m) { const int row = row0 + ai * HALF + m * 16, b = row >> 13, s = row & 8191; const int pos = ((s & ((1 << sh) - 1)) << (13 - sh)) + (s >> sh);
                    bf16_t* vp = vb + (size_t)(b * 256 + c0) * 8192 + pos;
#pragma unroll
                    for (int bj = 0; bj < 2; ++bj)
#pragma unroll
                        for (int n = 0; n < 2; ++n) { const f32x4 v = acc[ai][bj][m][n] + bv[bj][n]; const unsigned w0 = cvt_pk_bf16(v[0], v[1]), w1 = cvt_pk_bf16(v[2], v[3]);
                            bf16_t* q = vp + (size_t)(bj * HALF + 4 * n) * 8192;
                            q[0] = (bf16_t)(w0 & 0xffffu); q[8192] = (bf16_t)(w0 >> 16); q[2 * 8192] = (bf16_t)(w1 & 0xffffu); q[3 * 8192] = (bf16_t)(w1 >> 16); } }
        }
    }
};
template <int MODE> struct EpiGate {
    static constexpr bool PERM = true, AFTER_DRAIN = false;
    bf16_t* out; const bf16_t* gates; int gcol0;
    __device__ __forceinline__ void operator()(const f32x4 (&acc)[2][2][4][2], const Unit& u, int wr, int wc, int fr, int fq) const {
        const int row0 = u.arow + wr * 64 + fr, col0 = u.brow + wc * 32 + 8 * fq;
#pragma unroll
        for (int ai = 0; ai < 2; ++ai)
#pragma unroll
            for (int m = 0; m < 4; ++m) { const size_t r = (size_t)(row0 + ai * HALF + m * 16);
#pragma unroll
                for (int bj = 0; bj < 2; ++bj) { const int c = col0 + bj * HALF;
                    const u32x4 gv = *(const u32x4*)(gates + r * NGATE + gcol0 + c); const f32x4 a0 = acc[ai][bj][m][0], a1 = acc[ai][bj][m][1];
                    float o[8]; o[0] = sigm(bflo(gv.x)) * a0[0]; o[1] = sigm(bfhi(gv.x)) * a0[1]; o[2] = sigm(bflo(gv.y)) * a0[2]; o[3] = sigm(bfhi(gv.y)) * a0[3];
                    o[4] = sigm(bflo(gv.z)) * a1[0]; o[5] = sigm(bfhi(gv.z)) * a1[1]; o[6] = sigm(bflo(gv.w)) * a1[2]; o[7] = sigm(bfhi(gv.w)) * a1[3];
                    if (MODE == 1) { const u32x4 mv = *(const u32x4*)(out + r * D + c);
                        o[0] += bflo(mv.x); o[1] += bfhi(mv.x); o[2] += bflo(mv.y); o[3] += bfhi(mv.y); o[4] += bflo(mv.z); o[5] += bfhi(mv.z); o[6] += bflo(mv.w); o[7] += bfhi(mv.w); }
                    u32x4 w; w.x = cvt_pk_bf16(o[0], o[1]); w.y = cvt_pk_bf16(o[2], o[3]); w.z = cvt_pk_bf16(o[4], o[5]); w.w = cvt_pk_bf16(o[6], o[7]);
                    *(u32x4*)(out + r * D + c) = w; }
                asm volatile("" ::: "memory"); }
    }
};
struct EpiX1 {
    static constexpr bool PERM = true, AFTER_DRAIN = false;
    const float* x; float* out;
    __device__ __forceinline__ void operator()(const f32x4 (&acc)[2][2][4][2], const Unit& u, int wr, int wc, int fr, int fq) const {
        const int row0 = u.arow + wr * 64 + fr, col0 = u.brow + wc * 32 + 8 * fq;
#pragma unroll
        for (int ai = 0; ai < 2; ++ai)
#pragma unroll
            for (int m = 0; m < 4; ++m) { const size_t r = (size_t)(row0 + ai * HALF + m * 16);
#pragma unroll
                for (int bj = 0; bj < 2; ++bj) { const size_t o = r * D + col0 + bj * HALF;
                    const f32x4 x0 = *(const f32x4*)(x + o), x1 = *(const f32x4*)(x + o + 4);
                    *(f32x4*)(out + o) = x0 + acc[ai][bj][m][0]; *(f32x4*)(out + o + 4) = x1 + acc[ai][bj][m][1]; }
                asm volatile("" ::: "memory"); }
    }
};
struct EpiSwiglu {
    static constexpr bool PERM = true, AFTER_DRAIN = false;
    bf16_t* act; const float* bg; const float* bu;
    __device__ __forceinline__ void operator()(const f32x4 (&acc)[2][2][4][2], const Unit& u, int wr, int wc, int fr, int fq) const {
        const int pn = (u.brow >> 8) & 7; const int col0 = pn * HALF + wc * 32 + 8 * fq; const int rl0 = wr * 64 + fr;
        const f32x4 g0 = *(const f32x4*)(bg + (size_t)u.e * D + col0), g1 = *(const f32x4*)(bg + (size_t)u.e * D + col0 + 4);
        const f32x4 u0 = *(const f32x4*)(bu + (size_t)u.e * D + col0), u1 = *(const f32x4*)(bu + (size_t)u.e * D + col0 + 4);
#pragma unroll
        for (int ai = 0; ai < 2; ++ai)
#pragma unroll
            for (int m = 0; m < 4; ++m) { const int rl = rl0 + ai * HALF + m * 16;
                const f32x4 ga = acc[ai][0][m][0] + g0, gb = acc[ai][0][m][1] + g1, ua = acc[ai][1][m][0] + u0, ub = acc[ai][1][m][1] + u1;
                float o[8];
#pragma unroll
                for (int j = 0; j < 4; ++j) { const float gt = fminf(ga[j], 7.f), up = fminf(fmaxf(ua[j], -7.f), 7.f); o[j] = gt * sigm(1.702f * gt) * (up + 1.f);
                    const float gt2 = fminf(gb[j], 7.f), up2 = fminf(fmaxf(ub[j], -7.f), 7.f); o[4 + j] = gt2 * sigm(1.702f * gt2) * (up2 + 1.f); }
                u32x4 w; w.x = cvt_pk_bf16(o[0], o[1]); w.y = cvt_pk_bf16(o[2], o[3]); w.z = cvt_pk_bf16(o[4], o[5]); w.w = cvt_pk_bf16(o[6], o[7]);
                if (rl < u.nrows) *(u32x4*)(act + (size_t)(u.arow + rl) * D + col0) = w; }
    }
};
struct EpiDown {
    static constexpr bool PERM = true, AFTER_DRAIN = false;
    bf16_t* ys; const float* bd;
    __device__ __forceinline__ void operator()(const f32x4 (&acc)[2][2][4][2], const Unit& u, int wr, int wc, int fr, int fq) const {
        const int pn = (u.brow >> 8) & 3; const int col0 = pn * BM + wc * 32 + 8 * fq; const int rl0 = wr * 64 + fr;
        f32x4 bv[2][2];
#pragma unroll
        for (int bj = 0; bj < 2; ++bj)
#pragma unroll
            for (int n = 0; n < 2; ++n) bv[bj][n] = *(const f32x4*)(bd + (size_t)u.e * D + col0 + bj * HALF + 4 * n);
#pragma unroll
        for (int ai = 0; ai < 2; ++ai)
#pragma unroll
            for (int m = 0; m < 4; ++m) { const int rl = rl0 + ai * HALF + m * 16; bf16_t* rowp = ys + (size_t)(u.arow + rl) * D + col0;
#pragma unroll
                for (int bj = 0; bj < 2; ++bj) { const f32x4 v0 = acc[ai][bj][m][0] + bv[bj][0], v1 = acc[ai][bj][m][1] + bv[bj][1];
                    u32x4 w; w.x = cvt_pk_bf16(v0[0], v0[1]); w.y = cvt_pk_bf16(v0[2], v0[3]); w.z = cvt_pk_bf16(v1[0], v1[1]); w.w = cvt_pk_bf16(v1[2], v1[3]);
                    if (rl < u.nrows) *(u32x4*)(rowp + bj * HALF) = w; } }
    }
};

template <class Epi, class Sched, bool ALIGN_EPI = false, bool SP2 = false>
__device__ __forceinline__ void gemm_phase(PG8_LAS unsigned char* lds, const Gemm g, const Sched& S, const Epi& E) {
    const int tid = threadIdx.x, wid = __builtin_amdgcn_readfirstlane(tid >> 6), lane = tid & 63, wr = wid >> 2, wc = wid & 3, fr = lane & 15, fq = lane >> 4;
    const int K = g.K, nt = K / BK;
    unsigned voffA[2], voffB[2];
#pragma unroll
    for (int i = 0; i < 2; ++i) { int R, C; stage_rc(tid * 16 + i * 8192, R, C); const int Rb = Epi::PERM ? ((R & ~31) + perm32(R & 31)) : R;
        voffA[i] = (unsigned)(R * K + C) * 2u; voffB[i] = (unsigned)(Rb * K + C) * 2u; }
    const size_t kstep = (size_t)(BK * 2);
    const size_t hstep = (size_t)HALF * K * 2;
    const size_t rowb = (size_t)K * 2;
    const unsigned ldsw = (unsigned)wid * 1024u;
    const int aoff = lds_byte(wr * 64 + fr, fq * 8), boff = lds_byte(wc * 32 + fr, fq * 8);
#define PG8_SA(b, h) (((b) * 2 + (h)) * HTB)
#define PG8_SB(b, h) ((4 + (b) * 2 + (h)) * HTB)
#define PG8_STAGE(bufoff, gbase, voff) do { _Pragma("unroll") for (int _i = 0; _i < 2; ++_i) \
        __builtin_amdgcn_global_load_lds((const unsigned*)((const char*)(gbase) + (voff)[_i]), (PG8_LAS unsigned*)(lds + (bufoff) + ldsw + _i * 8192), 16, 0, 0); } while (0)
#define PG8_LDA(dst, b, h) do { _Pragma("unroll") for (int m = 0; m < 4; ++m) _Pragma("unroll") for (int k = 0; k < 2; ++k) dst[m][k] = *(const PG8_LAS bf16x8*)(lds + PG8_SA(b, h) + aoff + m * 2048 + k * 1024); } while (0)
#define PG8_LDB(dst, b, h) do { _Pragma("unroll") for (int n = 0; n < 2; ++n) _Pragma("unroll") for (int k = 0; k < 2; ++k) dst[n][k] = *(const PG8_LAS bf16x8*)(lds + PG8_SB(b, h) + boff + n * 2048 + k * 1024); } while (0)
#define PG8_MMA(ai, bj, At, Bt) do { __builtin_amdgcn_s_setprio(1); _Pragma("unroll") for (int m = 0; m < 4; ++m) _Pragma("unroll") for (int n = 0; n < 2; ++n) _Pragma("unroll") for (int k = 0; k < 2; ++k) \
        acc[ai][bj][m][n] = __builtin_amdgcn_mfma_f32_16x16x32_bf16(Bt[n][k], At[m][k], acc[ai][bj][m][n], 0, 0, 0); __builtin_amdgcn_s_setprio(0); } while (0)
#define PG8_WAIT_V(n) asm volatile("s_waitcnt vmcnt(" #n ")" ::: "memory")
#define PG8_WAIT_L(n) asm volatile("s_waitcnt lgkmcnt(" #n ")" ::: "memory")
#define PG8_BAR __builtin_amdgcn_s_barrier()
#define PG8_SCHED __builtin_amdgcn_sched_barrier(0)
    Unit cur, nxt; int ui = 0;
    if (!S.next(0, cur)) return;
    f32x4 acc[2][2][4][2];
#pragma unroll
    for (int a = 0; a < 2; ++a)
#pragma unroll
        for (int b = 0; b < 2; ++b)
#pragma unroll
            for (int m = 0; m < 4; ++m)
#pragma unroll
                for (int n = 0; n < 2; ++n) acc[a][b][m][n] = (f32x4){0.f, 0.f, 0.f, 0.f};
    bf16x8 At[4][2], B0[2][2], B1[2][2];
    const char* cA = (const char*)g.A + (size_t)cur.arow * rowb; const char* cB = (const char*)g.Bt + (size_t)cur.brow * rowb;
    S.a_ready(cur);
    if constexpr (SP2) {
        PG8_STAGE(PG8_SB(0, 0), cB, voffB); PG8_STAGE(PG8_SB(0, 1), cB + hstep, voffB); PG8_STAGE(PG8_SA(0, 0), cA, voffA); PG8_STAGE(PG8_SA(0, 1), cA + hstep, voffA);
        if (wr == 1) PG8_BAR;
        PG8_WAIT_V(2); PG8_BAR;
        PG8_STAGE(PG8_SB(1, 0), cB + kstep, voffB); PG8_STAGE(PG8_SA(1, 0), cA + kstep, voffA); PG8_STAGE(PG8_SB(1, 1), cB + hstep + kstep, voffB);
        PG8_WAIT_V(6); PG8_BAR;
    } else {
        PG8_STAGE(PG8_SB(0, 0), cB, voffB); PG8_STAGE(PG8_SA(0, 0), cA, voffA); PG8_STAGE(PG8_SB(0, 1), cB + hstep, voffB); PG8_STAGE(PG8_SA(0, 1), cA + hstep, voffA);
        if (wr == 1) PG8_BAR;
        PG8_WAIT_V(4); PG8_BAR;
        PG8_STAGE(PG8_SB(1, 0), cB + kstep, voffB); PG8_STAGE(PG8_SA(1, 0), cA + kstep, voffA); PG8_STAGE(PG8_SB(1, 1), cB + hstep + kstep, voffB);
        PG8_WAIT_V(6); PG8_BAR;
    }
    for (;;) {
        const bool has_next = S.next(ui + 1, nxt);
        const char* nA = has_next ? (const char*)g.A + (size_t)nxt.arow * rowb : cA; const char* nB = has_next ? (const char*)g.Bt + (size_t)nxt.brow * rowb : cB;
        for (int t = 0; t < nt; t += 2) {
            const bool last = (t == nt - 2);
            const char* a1 = cA + (size_t)(t + 1) * kstep;
            const char* a2 = last ? nA : cA + (size_t)(t + 2) * kstep; const char* b2 = last ? nB : cB + (size_t)(t + 2) * kstep;
            const char* a3 = a2 + kstep; const char* b3 = b2 + kstep;
            if (last && has_next) S.a_ready(nxt);
            if constexpr (SP2) {
            PG8_LDB(B0, 0, 0); PG8_LDB(B1, 0, 1); PG8_SCHED; PG8_LDA(At, 0, 0); PG8_STAGE(PG8_SA(1, 1), a1 + hstep, voffA);
            PG8_WAIT_V(8); PG8_WAIT_L(0); PG8_BAR; PG8_MMA(0, 0, At, B0); PG8_MMA(0, 1, At, B1); PG8_BAR; PG8_SCHED;
            PG8_LDA(At, 0, 1); PG8_STAGE(PG8_SB(0, 0), b2, voffB); PG8_STAGE(PG8_SB(0, 1), b2 + hstep, voffB); PG8_STAGE(PG8_SA(0, 0), a2, voffA);
            PG8_WAIT_V(8); PG8_WAIT_L(0); PG8_BAR; PG8_MMA(1, 0, At, B0); PG8_MMA(1, 1, At, B1); PG8_BAR; PG8_SCHED;
            PG8_LDB(B0, 1, 0); PG8_LDB(B1, 1, 1); PG8_SCHED; PG8_LDA(At, 1, 0); PG8_STAGE(PG8_SA(0, 1), a2 + hstep, voffA);
            PG8_WAIT_V(8); PG8_WAIT_L(0); PG8_BAR; PG8_MMA(0, 0, At, B0); PG8_MMA(0, 1, At, B1); PG8_BAR; PG8_SCHED;
            PG8_LDA(At, 1, 1); PG8_STAGE(PG8_SB(1, 0), b3, voffB); PG8_STAGE(PG8_SB(1, 1), b3 + hstep, voffB); PG8_STAGE(PG8_SA(1, 0), a3, voffA);
            PG8_WAIT_V(8); PG8_WAIT_L(0); PG8_BAR; PG8_MMA(1, 0, At, B0); PG8_MMA(1, 1, At, B1); PG8_BAR; PG8_SCHED;
            } else {
            PG8_LDB(B0, 0, 0); PG8_SCHED; PG8_LDA(At, 0, 0); PG8_STAGE(PG8_SA(1, 1), a1 + hstep, voffA);
            PG8_WAIT_L(8); PG8_BAR; PG8_WAIT_L(0); PG8_MMA(0, 0, At, B0); PG8_BAR; PG8_SCHED;
            PG8_LDB(B1, 0, 1); PG8_STAGE(PG8_SB(0, 0), b2, voffB);
            PG8_BAR; PG8_WAIT_L(0); PG8_MMA(0, 1, At, B1); PG8_BAR;
            PG8_LDA(At, 0, 1); PG8_STAGE(PG8_SA(0, 0), a2, voffA);
            PG8_BAR; PG8_WAIT_L(0); PG8_MMA(1, 0, At, B0); PG8_BAR; PG8_SCHED;
            PG8_STAGE(PG8_SB(0, 1), b2 + hstep, voffB);
            PG8_WAIT_V(6); PG8_BAR; PG8_MMA(1, 1, At, B1); PG8_BAR;
            PG8_LDB(B0, 1, 0); PG8_SCHED; PG8_LDA(At, 1, 0); PG8_STAGE(PG8_SA(0, 1), a2 + hstep, voffA);
            PG8_WAIT_L(8); PG8_BAR; PG8_WAIT_L(0); PG8_MMA(0, 0, At, B0); PG8_BAR; PG8_SCHED;
            PG8_LDB(B1, 1, 1); PG8_STAGE(PG8_SB(1, 0), b3, voffB);
            PG8_BAR; PG8_WAIT_L(0); PG8_MMA(0, 1, At, B1); PG8_BAR;
            PG8_LDA(At, 1, 1); PG8_STAGE(PG8_SA(1, 0), a3, voffA);
            PG8_BAR; PG8_WAIT_L(0); PG8_MMA(1, 0, At, B0); PG8_BAR; PG8_SCHED;
            PG8_STAGE(PG8_SB(1, 1), b3 + hstep, voffB);
            PG8_WAIT_V(6); PG8_BAR; PG8_MMA(1, 1, At, B1); PG8_BAR;
            }
        }
        if constexpr (ALIGN_EPI) { if (wr == 0) PG8_BAR; }
        if constexpr (!Epi::AFTER_DRAIN) { E(acc, cur, wr, wc, fr, fq); S.done(cur); }
        if (!has_next) break;
#pragma unroll
        for (int a = 0; a < 2; ++a)
#pragma unroll
            for (int b = 0; b < 2; ++b)
#pragma unroll
                for (int m = 0; m < 4; ++m)
#pragma unroll
                    for (int n = 0; n < 2; ++n) acc[a][b][m][n] = (f32x4){0.f, 0.f, 0.f, 0.f};
        cur = nxt; cA = nA; cB = nB; ++ui;
        if constexpr (ALIGN_EPI) { if (wr == 1) PG8_BAR; }
    }
    PG8_WAIT_V(0);
    if constexpr (!ALIGN_EPI) { if (wr == 0) PG8_BAR; }
    PG8_BAR;
    if constexpr (Epi::AFTER_DRAIN) { E.fused(acc, cur, wr, wc, fr, fq, lds, wid, lane); S.done(cur); }
#undef PG8_SA
#undef PG8_SB
#undef PG8_STAGE
#undef PG8_LDA
#undef PG8_LDB
#undef PG8_MMA
#undef PG8_WAIT_V
#undef PG8_WAIT_L
#undef PG8_BAR
#undef PG8_SCHED
}

}

#define XB_TMO      128
#define XB_XCNT(j)  (256  + 64 * (j))
#define XB_XSUB(j)  (1280 + 64 * (j))
#define XB_XGEN(j)  (2304 + 64 * (j))
#define XB_TOP      3328
#define XB_TOPGEN   3392
#define XCD_BAR_WORDS 3456
#define XB_SPIN_CAP (1u << 18)
__device__ __forceinline__ unsigned xb_ld(unsigned* p)              { return __hip_atomic_load(p, __ATOMIC_RELAXED, __HIP_MEMORY_SCOPE_AGENT); }
__device__ __forceinline__ unsigned xb_add(unsigned* p, unsigned v) { return __hip_atomic_fetch_add(p, v, __ATOMIC_RELAXED, __HIP_MEMORY_SCOPE_AGENT); }
__device__ __forceinline__ unsigned xb_xcc_id() { return (unsigned)__builtin_amdgcn_s_getreg((3 << 11) | 20) & 0xFu; }
#define XB_SPIN(cond, bar) do { unsigned _sp = 0; while (cond) { __builtin_amdgcn_s_sleep(1); \
    if ((++_sp & 255u) == 0u) { if (xb_ld(&(bar)[XB_TMO])) break; if (_sp > XB_SPIN_CAP) { atomicAdd(&(bar)[XB_TMO], 1u); break; } } } } while (0)
struct XcdBarrier { unsigned* bar; unsigned x; volatile LAS unsigned* st; };
__device__ __forceinline__ XcdBarrier xcd_barrier_post(unsigned* bar, volatile LAS unsigned* st) {
    XcdBarrier b; b.bar = bar; b.x = xb_xcc_id(); b.st = st;
    if (threadIdx.x == 0) (void)xb_add(&bar[XB_XCNT(b.x)], 1u);
    return b;
}
__device__ __forceinline__ void xcd_barrier_complete(unsigned* bar, unsigned x, unsigned& nloc, unsigned& nx) {
    const unsigned G = gridDim.x * gridDim.y * gridDim.z;
    unsigned sum, cnt, mine, sp = 0u;
    for (;;) {
        sum = 0u; cnt = 0u; mine = 0u;
#pragma unroll
        for (unsigned j = 0; j < 16; ++j) { const unsigned c = xb_ld(&bar[XB_XCNT(j)]); sum += c; cnt += (c > 0u) ? 1u : 0u; mine = (j == x) ? c : mine; }
        if (sum == G) break;
        __builtin_amdgcn_s_sleep(1);
        if ((++sp & 255u) == 0u) { if (xb_ld(&bar[XB_TMO])) break; if (sp > XB_SPIN_CAP) { atomicAdd(&bar[XB_TMO], 1u); break; } }
    }
    nloc = mine > 0u ? mine : 1u; nx = cnt > 0u ? cnt : 1u;
}
__device__ __forceinline__ void xcd_barrier(const XcdBarrier& b) {
    asm volatile("s_waitcnt vmcnt(0)" ::: "memory");
    __syncthreads();
    if (threadIdx.x == 0) {
        unsigned* bar = b.bar;
        __builtin_amdgcn_s_waitcnt(0);
        unsigned nloc = b.st[0], nx = b.st[1];
        if (nloc == 0u) { xcd_barrier_complete(bar, b.x, nloc, nx); b.st[0] = nloc; b.st[1] = nx; }
        const unsigned old = xb_add(&bar[XB_XSUB(b.x)], 1u);
        const unsigned gen = old / nloc;
        if (old + 1u == (gen + 1u) * nloc) {
            __builtin_amdgcn_fence(__ATOMIC_RELEASE, "agent");
            asm volatile("s_waitcnt vmcnt(0)" ::: "memory");
            const unsigned og = xb_add(&bar[XB_TOP], 1u);
            const unsigned tg = og / nx;
            if (og + 1u == (tg + 1u) * nx) xb_add(&bar[XB_TOPGEN], 1u);
            else XB_SPIN(xb_ld(&bar[XB_TOPGEN]) == tg, bar);
            __builtin_amdgcn_fence(__ATOMIC_ACQUIRE, "agent");
            xb_add(&bar[XB_XGEN(b.x)], 1u);
            asm volatile("s_waitcnt vmcnt(0)" ::: "memory");
        } else {
            XB_SPIN(xb_ld(&bar[XB_XGEN(b.x)]) == gen, bar);
            __builtin_amdgcn_fence(__ATOMIC_ACQUIRE, "agent");
            asm volatile("s_waitcnt vmcnt(0)" ::: "memory");
        }
    }
    __syncthreads();
}

constexpr int NWAVES = 8;
constexpr int RING_OFF = 0, RING_BYTES = 131072;
constexpr int LDSCTL_OFF = RING_BYTES, MISC_OFF = LDSCTL_OFF + 320;
constexpr int TBL_OFF = LDSCTL_OFF + 1024;
constexpr int LDS_BYTES = 147456;

struct Frame {
    LAS unsigned char* lds; volatile LAS unsigned* MISC; LAS int* tbl; gu32* ctl;
    int tid, lane, wave, vcu, G;
};

__device__ __forceinline__ void p0_transpose_item(const float* W, int K, int N, bf16* WT, int k0, int n0, int orow0, LAS float* scr, int lane) {
#pragma unroll 8
    for (int i = 0; i < 32; ++i) { const int kk = 2 * i + (lane >> 5); scr[kk * 33 + (lane & 31)] = W[(size_t)(k0 + kk) * N + n0 + (lane & 31)]; }
    LDS_WAIT(); asm volatile("" ::: "memory");
    const int c = lane & 7;
#pragma unroll
    for (int j = 0; j < 4; ++j) { const int n = (lane >> 3) + 8 * j; const LAS float* s = scr + (8 * c) * 33 + n;
        u32x4 o; o.x = pk2(s[0 * 33], s[1 * 33]); o.y = pk2(s[2 * 33], s[3 * 33]); o.z = pk2(s[4 * 33], s[5 * 33]); o.w = pk2(s[6 * 33], s[7 * 33]);
        *(GAS u32x4*)(WT + (size_t)(orow0 + n) * K + k0 + 8 * c) = o; }
    LDS_WAIT(); asm volatile("" ::: "memory");
}
__device__ __forceinline__ void rms_row_to_bf16(const float* xrow, const float* g, bf16* orow, int lane) {
    const GAS f32x4* xr = (const GAS f32x4*)xrow + lane; f32x4 v[4]; float s = 0.f;
#pragma unroll
    for (int j = 0; j < 4; ++j) { v[j] = xr[64 * j]; s += (v[j].x * v[j].x + v[j].y * v[j].y) + (v[j].z * v[j].z + v[j].w * v[j].w); }
    const float rstd = 1.f / sqrtf(wave_sum(s) * (1.f / D) + EPS);
    GAS unsigned long long* o8 = (GAS unsigned long long*)orow + lane;
#pragma unroll
    for (int j = 0; j < 4; ++j) { const f32x4 gg = ((const GAS f32x4*)g)[lane + 64 * j];
        o8[64 * j] = (unsigned long long)pk2(v[j].x * rstd * gg.x, v[j].y * rstd * gg.y) | ((unsigned long long)pk2(v[j].z * rstd * gg.z, v[j].w * rstd * gg.w) << 32); }
}

constexpr float LOG2E = 1.4426950408889634f;
template <int NH, int HW>
__device__ __forceinline__ void band_group(f32x4 (&o)[NH][4], float (&mrun)[NH], float (&lrun)[NH], const bf16* qkvb, const int (&qcol)[NH], int kcol, const bf16* vt,
                                           int dil, int rho, int L, int mu0, int qstep, int kb_lo, int npairs, const LAS float* const (&bias)[NH], int lane) {
    const int t = lane & 15, g = lane >> 4;
    const int mu_t = mu0 + qstep * t;
    const bf16* qrow = qkvb + (size_t)(mu_t * dil + rho) * NQKV + 8 * g;
    bf16x8 qf[NH][2];
#pragma unroll
    for (int h = 0; h < NH; ++h) { qf[h][0] = *(const bf16x8*)(qrow + qcol[h]); qf[h][1] = *(const bf16x8*)(qrow + qcol[h] + 32); }
    const int nblk = L >> 4;
    const bf16* vtl = vt + (size_t)t * 8192 + (size_t)rho * L + 4 * g;
    for (int pp = 0; pp < npairs; ++pp) {
        const int kb0 = kb_lo + 2 * pp, kb1 = kb0 + 1;
        const int kc0 = min(max(kb0, 0), nblk - 1), kc1 = min(max(kb1, 0), nblk - 1);
        const bf16* k0p = qkvb + (size_t)((16 * kc0 + t) * dil + rho) * NQKV + kcol + 8 * g;
        const bf16* k1p = qkvb + (size_t)((16 * kc1 + t) * dil + rho) * NQKV + kcol + 8 * g;
        const bf16x8 kf0a = *(const bf16x8*)k0p, kf0b = *(const bf16x8*)(k0p + 32), kf1a = *(const bf16x8*)k1p, kf1b = *(const bf16x8*)(k1p + 32);
        bf16x8 vf[4];
#pragma unroll
        for (int db = 0; db < 4; ++db) { const u32x2 a = *(const u32x2*)(vtl + (size_t)(16 * db) * 8192 + 16 * kc0), b = *(const u32x2*)(vtl + (size_t)(16 * db) * 8192 + 16 * kc1);
            u32x4 w; w.x = a.x; w.y = a.y; w.z = b.x; w.w = b.y; vf[db] = __builtin_bit_cast(bf16x8, w); }
        const int rel0 = 16 * kb0 + 4 * g - mu_t;
        const int kap0 = 16 * kb0 + 4 * g;
#pragma unroll
        for (int h = 0; h < NH; ++h) {
            f32x4 s0 = (f32x4){0.f, 0.f, 0.f, 0.f}, s1 = (f32x4){0.f, 0.f, 0.f, 0.f};
            s0 = __builtin_amdgcn_mfma_f32_16x16x32_bf16(kf0a, qf[h][0], s0, 0, 0, 0); s0 = __builtin_amdgcn_mfma_f32_16x16x32_bf16(kf0b, qf[h][1], s0, 0, 0, 0);
            s1 = __builtin_amdgcn_mfma_f32_16x16x32_bf16(kf1a, qf[h][0], s1, 0, 0, 0); s1 = __builtin_amdgcn_mfma_f32_16x16x32_bf16(kf1b, qf[h][1], s1, 0, 0, 0);
            float sc[8]; bool vd[8];
#pragma unroll
            for (int j = 0; j < 8; ++j) { const int dj = (j < 4) ? j : 12 + j; const int rel = rel0 + dj, kap = kap0 + dj;
                vd[j] = (rel >= -HW) && (rel <= HW) && (kap >= 0) && (kap < L);
                const int idx = min(max(rel + HW, 0), 2 * HW);
                const float sv = (j < 4) ? s0[j & 3] : s1[j & 3];
                sc[j] = vd[j] ? (sv * (0.125f * LOG2E) + bias[h][idx]) : -3.0e38f; }
            float mx = fmaxf(fmaxf(fmaxf(sc[0], sc[1]), fmaxf(sc[2], sc[3])), fmaxf(fmaxf(sc[4], sc[5]), fmaxf(sc[6], sc[7])));
            mx = fmaxf(mx, __shfl_xor(mx, 16)); mx = fmaxf(mx, __shfl_xor(mx, 32));
            const float mn = fmaxf(mrun[h], mx), alpha = __builtin_amdgcn_exp2f(mrun[h] - mn); mrun[h] = mn;
            float p[8], ps = 0.f;
#pragma unroll
            for (int j = 0; j < 8; ++j) { p[j] = vd[j] ? __builtin_amdgcn_exp2f(sc[j] - mn) : 0.f; ps += p[j]; }
            lrun[h] = lrun[h] * alpha + ps;
            u32x4 pw; pw.x = pg8::cvt_pk_bf16(p[0], p[1]); pw.y = pg8::cvt_pk_bf16(p[2], p[3]); pw.z = pg8::cvt_pk_bf16(p[4], p[5]); pw.w = pg8::cvt_pk_bf16(p[6], p[7]);
            const bf16x8 pf = __builtin_bit_cast(bf16x8, pw);
#pragma unroll
            for (int db = 0; db < 4; ++db) { o[h][db] = o[h][db] * alpha; o[h][db] = __builtin_amdgcn_mfma_f32_16x16x32_bf16(vf[db], pf, o[h][db], 0, 0, 0); }
        }
    }
}
template <int NH>
__device__ __forceinline__ void band_store(const f32x4 (&o)[NH][4], const float (&lrun)[NH], bf16* yrow  , int hstride, int lane) {
    const int g = lane >> 4;
#pragma unroll
    for (int h = 0; h < NH; ++h) { float l = lrun[h]; l += __shfl_xor(l, 16); l += __shfl_xor(l, 32); const float inv = 1.f / l;
#pragma unroll
        for (int db = 0; db < 4; ++db) { u32x2 w; w.x = pg8::cvt_pk_bf16(o[h][db][0] * inv, o[h][db][1] * inv); w.y = pg8::cvt_pk_bf16(o[h][db][2] * inv, o[h][db][3] * inv);
            *(u32x2*)(yrow + h * hstride + 16 * db + 4 * g) = w; } }
}

struct Args { const float* in[19]; float* out; unsigned char* ws; int ph_lo, ph_hi, li, pad; };
constexpr int NPHASE = 10;

__global__ void __launch_bounds__(NWAVES * 64, 2) mk_fwd(Args args) {
    extern __shared__ __attribute__((aligned(16))) unsigned char lds[];
    Frame F;
    F.lds = (LAS unsigned char*)lds; F.MISC = (volatile LAS unsigned*)(F.lds + MISC_OFF); F.tbl = (LAS int*)(F.lds + TBL_OFF);
    F.tid = threadIdx.x; F.lane = F.tid & 63; F.wave = __builtin_amdgcn_readfirstlane(F.tid >> 6);
    F.G = gridDim.x; { const int bx = blockIdx.x; F.vcu = (F.G % 8 == 0) ? (bx % 8) * (F.G / 8) + bx / 8 : bx; }
    unsigned char* ws = args.ws; F.ctl = (gu32*)(ws + WS_CTL);
    const float* x = args.in[0]; const float* norm_mix = args.in[1]; const float* w_in = args.in[2]; const float* b_in = args.in[3];
    const float* sinks = args.in[4]; const float* rel_bias = args.in[5]; const float* w_a = args.in[6]; const float* w_b = args.in[7];
    const float* w_out = args.in[8]; const float* norm_ffn = args.in[9]; const float* router_w = args.in[10]; const float* router_b = args.in[11];
    const float* w_gate = args.in[12]; const float* b_gate = args.in[13]; const float* w_up = args.in[14]; const float* b_up = args.in[15];
    const float* w_down = args.in[16]; const float* b_down = args.in[17]; const float* norm_final = args.in[18];
    float* out = args.out;
    Tabs* tb = (Tabs*)(ws + WS_TAB);
    bf16* Win_t = (bf16*)(ws + WS_WIN); bf16* Wa_t = (bf16*)(ws + WS_WA); bf16* Wb_t = (bf16*)(ws + WS_WB); bf16* Wout_t = (bf16*)(ws + WS_WOUT);
    bf16* Wgu_t = (bf16*)(ws + WS_WGU); bf16* Wd_t = (bf16*)(ws + WS_WD);
    int* topi = (int*)(ws + WS_RT); float* topp = (float*)(ws + WS_RT + 256 * 1024); int* slot = (int*)(ws + WS_RT + 512 * 1024); int* pos = (int*)(ws + WS_RT + 768 * 1024);
    bf16* XN = (bf16*)(ws + WS_XN); bf16* QKV = (bf16*)(ws + WS_QKV); bf16* GATES = (bf16*)(ws + WS_GATES); bf16* YA = (bf16*)(ws + WS_YA); bf16* YB = (bf16*)(ws + WS_YB);
    bf16* MERGED = (bf16*)(ws + WS_MERGED); bf16* HS = (bf16*)(ws + WS_HS); bf16* ACT = (bf16*)(ws + WS_ACT);
    gu32* cnt = F.ctl + CW_CNT;

    for (int u = F.tid; u < (LDS_BYTES - LDSCTL_OFF) / 4; u += NWAVES * 64) ((LAS unsigned*)(F.lds + LDSCTL_OFF))[u] = 0u;
    __syncthreads();
    XcdBarrier bar = xcd_barrier_post((unsigned*)(F.ctl + CW_BAR) + args.li * XCD_BAR_WORDS, F.MISC + 8);
    const int lo = args.ph_lo, hi = args.ph_hi;
#ifndef MK_SKIP
#define MK_SKIP 0
#endif
#define IN(k) (!((MK_SKIP >> (k)) & 1) && lo <= (k) && (k) < hi)
#define SEAM(k) do { if (IN(k) && IN((k) + 1)) xcd_barrier(bar); } while (0)
    const int gw = F.vcu * NWAVES + F.wave, NGW = F.G * NWAVES;

    if (IN(0)) {
        { const int i = blockIdx.x * (NWAVES * 64) + F.tid;
          if (i < 16 * 257) { const int h = i / 257, r = i % 257; tb->biasA[h][r] = rel_bias[BKT_A[r] * 28 + h]; }
          if (i < 12 * 129) { const int g = i / (4 * 129), hs = (i / 129) % 4, r = i % 129; tb->biasB[g][hs][r] = rel_bias[BKT_B[g][r] * 28 + 16 + 4 * g + hs]; } }
        LAS float* scr = (LAS float*)(F.lds + RING_OFF + F.wave * 16384);
        constexpr int I_IN = (D / 64) * (NPROJ / 32), I_A = (D / 64) * (D / 32), I_B = (256 / 64) * (D / 32), I_E = (D / 64) * (D / 32);
        constexpr int NITEMS = I_IN + 2 * I_A + I_B + 3 * NE * I_E;
        for (int it = gw; it < NITEMS; it += NGW) {
            int r = it;
            if (r < I_IN) { const int nb = NPROJ / 32; p0_transpose_item(w_in, D, NPROJ, Win_t, 64 * (r / nb), 32 * (r % nb), 32 * (r % nb), scr, F.lane); continue; } r -= I_IN;
            if (r < I_A) { const int nb = D / 32; p0_transpose_item(w_a, D, D, Wa_t, 64 * (r / nb), 32 * (r % nb), 32 * (r % nb), scr, F.lane); continue; } r -= I_A;
            if (r < I_A) { const int nb = D / 32; p0_transpose_item(w_out, D, D, Wout_t, 64 * (r / nb), 32 * (r % nb), 32 * (r % nb), scr, F.lane); continue; } r -= I_A;
            if (r < I_B) { const int nb = D / 32; p0_transpose_item(w_b, 256, D, Wb_t, 64 * (r / nb), 32 * (r % nb), 32 * (r % nb), scr, F.lane); continue; } r -= I_B;
            { const int e = r / (3 * I_E), q = r % (3 * I_E), which = q / I_E, ii = q % I_E, nb = D / 32, k0 = 64 * (ii / nb), n0 = 32 * (ii % nb);
              if (which == 0) p0_transpose_item(w_gate + (size_t)e * D * D, D, D, Wgu_t, k0, n0, e * 2048 + (n0 >> 7) * 256 + (n0 & 127), scr, F.lane);
              else if (which == 1) p0_transpose_item(w_up + (size_t)e * D * D, D, D, Wgu_t, k0, n0, e * 2048 + (n0 >> 7) * 256 + 128 + (n0 & 127), scr, F.lane);
              else p0_transpose_item(w_down + (size_t)e * D * D, D, D, Wd_t, k0, n0, e * 1024 + n0, scr, F.lane); }
        }
        for (int m = gw; m < T; m += NGW) rms_row_to_bf16(x + (size_t)m * D, norm_mix, XN + (size_t)m * D, F.lane);
    }
    SEAM(0);
    if (IN(1)) {
        pg8::Gemm g{XN, Win_t, D}; pg8::StaticOrder So; So.init(T, NPROJ, F.G, (int)blockIdx.x);
        pg8::EpiProj E{QKV, GATES, b_in, (bf16*)(ws + WS_VT), (bf16*)(ws + WS_VT) + (size_t)2 * 4 * 64 * 8192};
        pg8::gemm_phase<pg8::EpiProj, pg8::StaticOrder, true, true>(F.lds + RING_OFF, g, So, E);
    }
    SEAM(1);
    if (IN(2)) {
        LAS float* lb = (LAS float*)(F.lds + RING_OFF);
        for (int i = F.tid; i < 4112 + 1548; i += NWAVES * 64) lb[i] = ((const float*)tb)[i] * LOG2E;
        __syncthreads();
        const bf16* VTA = (const bf16*)(ws + WS_VT); const bf16* VTB = VTA + (size_t)2 * 4 * 64 * 8192;
        for (int it = gw; it < 8192; it += NGW) {
            const int t = F.lane & 15;
            if (it < 4096) {
                const int b = it >> 11, kvh = (it >> 9) & 3, qb = it & 511;
                f32x4 o[4][4]; float mr[4], lr[4];
#pragma unroll
                for (int h = 0; h < 4; ++h) { mr[h] = sinks[kvh * 4 + h] * LOG2E; lr[h] = (F.lane < 16) ? 1.f : 0.f;
#pragma unroll
                    for (int db = 0; db < 4; ++db) o[h][db] = (f32x4){0.f, 0.f, 0.f, 0.f}; }
                const int qcol[4] = {C_QA + (kvh * 4 + 0) * 64, C_QA + (kvh * 4 + 1) * 64, C_QA + (kvh * 4 + 2) * 64, C_QA + (kvh * 4 + 3) * 64};
                const LAS float* const bias[4] = {lb + (kvh * 4 + 0) * 257, lb + (kvh * 4 + 1) * 257, lb + (kvh * 4 + 2) * 257, lb + (kvh * 4 + 3) * 257};
                band_group<4, 128>(o, mr, lr, QKV + (size_t)b * S * NQKV, qcol, C_KA + kvh * 64, VTA + (size_t)((b * 4 + kvh) * 64) * 8192, 1, 0, S, 16 * qb, 1, qb - 8, 9, bias, F.lane);
                band_store<4>(o, lr, YA + (size_t)(b * S + 16 * qb + t) * D + kvh * 256, 64, F.lane);
            } else {
                const int j = it - 4096, r = j & 15, un = j >> 4, blk = un & 31, hs = (un >> 5) & 3, b = un >> 7, i0 = blk * 256;
                f32x4 o[1][4]; float mr[1], lr[1]; mr[0] = -3.0e38f; lr[0] = 0.f;
#pragma unroll
                for (int db = 0; db < 4; ++db) o[0][db] = (f32x4){0.f, 0.f, 0.f, 0.f};
                const bf16* qb_ = QKV + (size_t)b * S * NQKV;
                { const int qcol[1] = {C_QB + 0 * 256 + hs * 64}; const LAS float* const bias[1] = {lb + 4112 + (0 * 4 + hs) * 129};
                  band_group<1, 64>(o, mr, lr, qb_, qcol, C_KB + 0 * 256 + hs * 64, VTB + (size_t)(((0 * 2 + b) * 4 + hs) * 64) * 8192, 1, 0, S, i0 + r, 16, (i0 >> 4) - 4, 12, bias, F.lane); }
                { const int qcol[1] = {C_QB + 1 * 256 + hs * 64}; const LAS float* const bias[1] = {lb + 4112 + (1 * 4 + hs) * 129};
                  band_group<1, 64>(o, mr, lr, qb_, qcol, C_KB + 1 * 256 + hs * 64, VTB + (size_t)(((1 * 2 + b) * 4 + hs) * 64) * 8192, 4, r & 3, S / 4, (i0 + r) >> 2, 4, (i0 >> 6) - 4, 6, bias, F.lane); }
                { const int qcol[1] = {C_QB + 2 * 256 + hs * 64}; const LAS float* const bias[1] = {lb + 4112 + (2 * 4 + hs) * 129};
                  band_group<1, 64>(o, mr, lr, qb_, qcol, C_KB + 2 * 256 + hs * 64, VTB + (size_t)(((2 * 2 + b) * 4 + hs) * 64) * 8192, 16, r, S / 16, i0 >> 4, 1, (i0 >> 8) - 4, 5, bias, F.lane); }
                band_store<1>(o, lr, YB + (size_t)(b * S + i0 + r + 16 * t) * 256 + hs * 64, 64, F.lane);
            }
        }
        __syncthreads();
    }
    SEAM(2);
    if (IN(3)) {
#ifndef NO_P3A
        { int k256 = 256; asm volatile("" : "+s"(k256)); pg8::Gemm g{YB, Wb_t, k256}; pg8::StaticOrder So; So.init(T, D, F.G, (int)blockIdx.x);
          pg8::EpiGate<0> E{MERGED, GATES, 1024};
          pg8::gemm_phase<pg8::EpiGate<0>, pg8::StaticOrder, true, true>(F.lds + RING_OFF, g, So, E); }
#endif
        VM_WAIT(); __syncthreads();
#ifndef NO_P3B
        { pg8::Gemm g{YA, Wa_t, D}; pg8::StaticOrder So; So.init(T, D, F.G, (int)blockIdx.x);
          pg8::EpiGate<1> E{MERGED, GATES, 0};
          pg8::gemm_phase<pg8::EpiGate<1>, pg8::StaticOrder, true, true>(F.lds + RING_OFF, g, So, E); }
#endif
    }
    SEAM(3);
    if (IN(4)) {
        pg8::Gemm g{MERGED, Wout_t, D}; pg8::StaticOrder So; So.init(T, D, F.G, (int)blockIdx.x);
        pg8::EpiX1 E{x, out};
        pg8::gemm_phase<pg8::EpiX1, pg8::StaticOrder, true, true>(F.lds + RING_OFF, g, So, E);
    }
    SEAM(4);
    if (IN(5)) {
        LAS int* lcnt = F.tbl + 72; LAS int* lbase = F.tbl + 104; LAS int* ebuf = F.tbl + 136; LAS int* pbuf = F.tbl + 392;
        LAS float* sh = (LAS float*)(F.lds + RING_OFF) + F.wave * 4096;
        for (int tblk = F.vcu; tblk < T / 64; tblk += F.G) {
            if (F.tid < 32) lcnt[F.tid] = 0;
            __syncthreads();
            for (int pass = 0; pass < 2; ++pass) {
                const int m0 = tblk * 64 + F.wave * 8 + pass * 4;
#pragma unroll
                for (int tk = 0; tk < 4; ++tk) {
                    const GAS f32x4* xr = (const GAS f32x4*)(out + (size_t)(m0 + tk) * D) + F.lane; f32x4 v[4]; float s = 0.f;
#pragma unroll
                    for (int j = 0; j < 4; ++j) { v[j] = xr[64 * j]; s += (v[j].x * v[j].x + v[j].y * v[j].y) + (v[j].z * v[j].z + v[j].w * v[j].w); }
                    const float rstd = 1.f / sqrtf(wave_sum(s) * (1.f / D) + EPS);
                    GAS unsigned long long* o8 = (GAS unsigned long long*)(XN + (size_t)(m0 + tk) * D) + F.lane;
#pragma unroll
                    for (int j = 0; j < 4; ++j) { const f32x4 gg = ((const GAS f32x4*)norm_ffn)[F.lane + 64 * j]; f32x4 y; y.x = v[j].x * rstd * gg.x; y.y = v[j].y * rstd * gg.y; y.z = v[j].z * rstd * gg.z; y.w = v[j].w * rstd * gg.w;
                        *(LAS f32x4*)(sh + tk * 1024 + 4 * (F.lane + 64 * j)) = y;
                        o8[64 * j] = (unsigned long long)pk2(y.x, y.y) | ((unsigned long long)pk2(y.z, y.w) << 32); }
                }
                LDS_WAIT(); asm volatile("" ::: "memory");
                const int e = F.lane & 31, kh = F.lane >> 5; float acc[4] = {0.f, 0.f, 0.f, 0.f};
                for (int k = kh * 512; k < kh * 512 + 512; k += 4) {
                    const float w0 = router_w[(size_t)(k + 0) * NE + e], w1 = router_w[(size_t)(k + 1) * NE + e], w2 = router_w[(size_t)(k + 2) * NE + e], w3 = router_w[(size_t)(k + 3) * NE + e];
#pragma unroll
                    for (int tk = 0; tk < 4; ++tk) { const f32x4 hv = *(const LAS f32x4*)(sh + tk * 1024 + k); acc[tk] += hv.x * w0; acc[tk] += hv.y * w1; acc[tk] += hv.z * w2; acc[tk] += hv.w * w3; }
                }
                const float rbv = router_b[e];
#pragma unroll
                for (int tk = 0; tk < 4; ++tk) {
                    float val = acc[tk] + __shfl_xor(acc[tk], 32) + rbv; float tv[4]; int ti[4];
#pragma unroll
                    for (int r = 0; r < 4; ++r) {
                        float bv = val; int bi = e;
#pragma unroll
                        for (int o = 1; o < 32; o <<= 1) { const float ov = __shfl_xor(bv, o); const int oi = __shfl_xor(bi, o); if (ov > bv || (ov == bv && oi < bi)) { bv = ov; bi = oi; } }
                        tv[r] = bv; ti[r] = bi; if (bi == e) val = -3.0e38f;
                    }
                    const float e1 = __expf(tv[1] - tv[0]), e2 = __expf(tv[2] - tv[0]), e3 = __expf(tv[3] - tv[0]); const float inv = 1.f / (1.f + e1 + e2 + e3);
                    if (F.lane < 4) { const float p = (F.lane == 0 ? 1.f : F.lane == 1 ? e1 : F.lane == 2 ? e2 : e3) * inv; const int ex = (F.lane == 0 ? ti[0] : F.lane == 1 ? ti[1] : F.lane == 2 ? ti[2] : ti[3]);
                        const int m = m0 + tk; topi[m * 4 + F.lane] = ex; topp[m * 4 + F.lane] = p;
                        const int li = (F.wave * 8 + pass * 4 + tk) * 4 + F.lane; ebuf[li] = ex; pbuf[li] = __hip_atomic_fetch_add(&lcnt[ex], 1, __ATOMIC_RELAXED, __HIP_MEMORY_SCOPE_WORKGROUP); }
                }
                LDS_WAIT(); asm volatile("" ::: "memory");
            }
            __syncthreads();
            if (F.tid < 32) lbase[F.tid] = (int)__hip_atomic_fetch_add(cnt + F.tid, (unsigned)lcnt[F.tid], RLX_AGENT);
            __syncthreads();
            if (F.tid < 256) pos[tblk * 256 + F.tid] = lbase[ebuf[F.tid]] + pbuf[F.tid];
            __syncthreads();
        }
    }
    SEAM(5);
    if (IN(6) || IN(7) || IN(8)) {
        LAS int* loff = F.tbl; LAS int* ltoff = F.tbl + 36; LAS int* lc = F.tbl + 72;
        if (F.tid < 32) lc[F.tid] = (int)__hip_atomic_load(cnt + F.tid, RLX_AGENT);
        __syncthreads();
        if (F.tid == 0) { int a = 0, ta = 0; for (int e = 0; e < NE; ++e) { loff[e] = a; ltoff[e] = ta; const int c = lc[e]; a += c; ta += (c + 255) >> 8; } loff[NE] = a; ltoff[NE] = ta; }
        __syncthreads();
    }
    if (IN(6)) {
        const LAS int* loff = F.tbl;
        for (int p = gw; p < T * 4; p += NGW) {
            const int e = topi[p], row = loff[e] + pos[p];
            if (F.lane == 0) slot[p] = row;
            const GAS u32x4* src = (const GAS u32x4*)(XN + (size_t)(p >> 2) * D) + F.lane; GAS u32x4* dst = (GAS u32x4*)(HS + (size_t)row * D) + F.lane;
            const u32x4 a = src[0], b = src[64]; dst[0] = a; dst[64] = b;
        }
    }
    SEAM(6);
    if (IN(7)) {
        pg8::Gemm g{HS, Wgu_t, D}; pg8::GroupOrder So{F.tbl + 36, F.tbl, 8, F.G, (int)blockIdx.x, 0}; So.nunits = __builtin_amdgcn_readfirstlane(F.tbl[36 + NE]) * 8;
        pg8::EpiSwiglu E{ACT, b_gate, b_up};
        pg8::gemm_phase<pg8::EpiSwiglu, pg8::GroupOrder, true, true>(F.lds + RING_OFF, g, So, E);
    }
    SEAM(7);
    if (IN(8)) {
        pg8::Gemm g{ACT, Wd_t, D}; pg8::GroupOrder So{F.tbl + 36, F.tbl, 4, F.G, (int)blockIdx.x, 0}; So.nunits = __builtin_amdgcn_readfirstlane(F.tbl[36 + NE]) * 4;
        pg8::EpiDown E{HS, b_down};
        pg8::gemm_phase<pg8::EpiDown, pg8::GroupOrder, true, true>(F.lds + RING_OFF, g, So, E);
    }
    SEAM(8);
    if (IN(9)) {
        const bf16* ys = HS;
        for (int m = gw; m < T; m += NGW) {
            GAS f32x4* xr = (GAS f32x4*)(out + (size_t)m * D) + F.lane; f32x4 v[4];
#pragma unroll
            for (int j = 0; j < 4; ++j) v[j] = xr[64 * j];
#pragma unroll
            for (int k = 0; k < 4; ++k) { const int r = slot[m * 4 + k]; const float p = topp[m * 4 + k]; const GAS unsigned long long* yr = (const GAS unsigned long long*)(ys + (size_t)r * D) + F.lane;
#pragma unroll
                for (int j = 0; j < 4; ++j) { const unsigned long long u = yr[64 * j]; const unsigned l32 = (unsigned)u, h32 = (unsigned)(u >> 32);
                    v[j].x += p * bflo(l32); v[j].y += p * bfhi(l32); v[j].z += p * bflo(h32); v[j].w += p * bfhi(h32); } }
            float s = 0.f;
#pragma unroll
            for (int j = 0; j < 4; ++j) s += (v[j].x * v[j].x + v[j].y * v[j].y) + (v[j].z * v[j].z + v[j].w * v[j].w);
            const float rstd = 1.f / sqrtf(wave_sum(s) * (1.f / D) + EPS);
#pragma unroll
            for (int j = 0; j < 4; ++j) { const f32x4 gg = ((const GAS f32x4*)norm_final)[F.lane + 64 * j]; f32x4 y; y.x = v[j].x * rstd * gg.x; y.y = v[j].y * rstd * gg.y; y.z = v[j].z * rstd * gg.z; y.w = v[j].w * rstd * gg.w; xr[64 * j] = y; }
        }
    }
#undef IN
#undef SEAM
}

extern "C" void kernel_launch(void* const* d_in, const int* in_sizes, int n_in, void* d_out, int out_size, void* d_ws, size_t ws_size, hipStream_t stream) {
    static int grid = 0;
    if (grid == 0) {
        if (n_in != 19 || in_sizes[0] != T * D || out_size != T * D || ws_size < WS_END) { fprintf(stderr, "kernel_launch: unexpected shapes (n_in %d, ws %zu); nothing launched\n", n_in, ws_size); grid = -1; return; }
        int dev = 0, cus = 0, per_cu = 0;
        if (hipGetDevice(&dev) != hipSuccess || hipDeviceGetAttribute(&cus, hipDeviceAttributeMultiprocessorCount, dev) != hipSuccess) { grid = -1; return; }
        if (hipFuncSetAttribute((const void*)mk_fwd, hipFuncAttributeMaxDynamicSharedMemorySize, LDS_BYTES) != hipSuccess) { fprintf(stderr, "kernel_launch: hipFuncSetAttribute failed\n"); grid = -1; return; }
        if (hipOccupancyMaxActiveBlocksPerMultiprocessor(&per_cu, (const void*)mk_fwd, NWAVES * 64, LDS_BYTES) != hipSuccess || per_cu < 1) { fprintf(stderr, "kernel_launch: occupancy query says %d blocks per CU\n", per_cu); }
        (void)hipGetLastError();
        grid = cus;
        if (grid != 256) fprintf(stderr, "kernel_launch: %d CUs (built and tuned for 256)\n", grid);
    }
    if (grid < 0) return;
    if (hipMemsetAsync((char*)d_ws + WS_CTL, 0, CTL_ZERO_BYTES, stream) != hipSuccess) return;
    Args a{};
    for (int i = 0; i < 19; ++i) a.in[i] = (const float*)d_in[i];
    a.out = (float*)d_out; a.ws = (unsigned char*)d_ws;
#if MK_MODE == 2
    a.ph_lo = 0; a.ph_hi = NPHASE; a.li = 0;
    hipLaunchKernelGGL(mk_fwd, dim3(grid), dim3(NWAVES * 64), LDS_BYTES, stream, a);
#else
    for (int ph = 0; ph < NPHASE; ++ph) { a.ph_lo = ph; a.ph_hi = ph + 1; a.li = ph; hipLaunchKernelGGL(mk_fwd, dim3(grid), dim3(NWAVES * 64), LDS_BYTES, stream, a); }
#endif
}
```

```cpp
#define MK_DUP 0
#include <hip/hip_runtime.h>
#include <stdint.h>
#include <stdio.h>

#ifndef MK_MODE
#define MK_MODE 2
#endif

typedef unsigned short bf16;
typedef short bf16x8 __attribute__((ext_vector_type(8)));
typedef float f32x4 __attribute__((ext_vector_type(4)));
typedef float f32x2 __attribute__((ext_vector_type(2)));
typedef unsigned u32x4 __attribute__((ext_vector_type(4)));
typedef unsigned u32x2 __attribute__((ext_vector_type(2)));
#define GAS __attribute__((address_space(1)))
#define LAS __attribute__((address_space(3)))
typedef GAS unsigned gu32;

constexpr int T = 16384, S = 8192, D = 1024, NPROJ = 5888, NQKV = 3840, NGATE = 2048, NE = 32, TOPK = 4;
constexpr int C_QA = 0, C_KA = 1024, C_VA = 1280, C_QB = 1536, C_KB = 2304, C_VB = 3072;
constexpr float EPS = 1e-5f;
constexpr size_t MiB = 1u << 20;
constexpr size_t WS_CTL = 0, CTL_ZERO_BYTES = 1 * MiB;
constexpr size_t WS_TAB = 1 * MiB;
constexpr size_t WS_WIN = 2 * MiB;
constexpr size_t WS_WA = 14 * MiB;
constexpr size_t WS_WB = 16 * MiB;
constexpr size_t WS_WOUT = 17 * MiB;
constexpr size_t WS_RT = 19 * MiB;
constexpr size_t WS_WGU = 24 * MiB;
constexpr size_t WS_WD = 152 * MiB;
constexpr size_t WS_XN = 216 * MiB;
constexpr size_t WS_QKV = 248 * MiB;
constexpr size_t WS_GATES = 368 * MiB;
constexpr size_t WS_YA = 432 * MiB;
constexpr size_t WS_YB = 464 * MiB;
constexpr size_t WS_MERGED = 472 * MiB;
constexpr size_t WS_VT = 472 * MiB;
constexpr size_t WS_HS = 248 * MiB;
constexpr size_t WS_ACT = 377 * MiB;
constexpr size_t WS_END = 506 * MiB;
constexpr int CW_CNT = 0;
constexpr int CW_BAR = 4096;

__device__ const unsigned char BKT_A[257] = {12,12,12,12,12,12,12,12,12,12,12,12,12,12,12,12,12,12,12,12,12,12,12,12,12,12,12,12,12,12,12,12,12,12,12,12,12,12,11,11,11,11,11,11,11,11,11,11,11,11,11,11,11,11,11,11,11,11,11,11,11,11,11,11,11,11,11,11,11,11,11,11,11,11,11,11,11,11,11,10,10,10,10,10,10,10,10,10,10,10,10,10,10,10,10,10,10,10,10,10,10,10,9,9,9,9,9,9,9,9,9,9,9,9,8,8,8,8,8,8,8,7,6,5,4,3,2,1,0,17,18,19,20,21,22,23,24,24,24,24,24,24,24,25,25,25,25,25,25,25,25,25,25,25,25,26,26,26,26,26,26,26,26,26,26,26,26,26,26,26,26,26,26,26,26,26,26,26,27,27,27,27,27,27,27,27,27,27,27,27,27,27,27,27,27,27,27,27,27,27,27,27,27,27,27,27,27,27,27,27,27,27,27,27,27,27,27,27,27,28,28,28,28,28,28,28,28,28,28,28,28,28,28,28,28,28,28,28,28,28,28,28,28,28,28,28,28,28,28,28,28,28,28,28,28,28,28};
__device__ const unsigned char BKT_B[3][129] = {
 {11,11,11,11,11,11,11,11,11,11,11,11,11,11,11,10,10,10,10,10,10,10,10,10,10,10,10,10,10,10,10,10,10,10,10,10,10,10,9,9,9,9,9,9,9,9,9,9,9,9,8,8,8,8,8,8,8,7,6,5,4,3,2,1,0,17,18,19,20,21,22,23,24,24,24,24,24,24,24,25,25,25,25,25,25,25,25,25,25,25,25,26,26,26,26,26,26,26,26,26,26,26,26,26,26,26,26,26,26,26,26,26,26,26,27,27,27,27,27,27,27,27,27,27,27,27,27,27,27},
 {13,13,13,13,13,13,13,13,13,13,13,13,13,13,13,13,13,13,13,13,13,13,13,12,12,12,12,12,12,12,12,12,12,12,12,12,12,12,12,12,12,12,11,11,11,11,11,11,11,11,11,11,10,10,10,10,10,10,9,9,9,8,8,4,0,20,24,24,25,25,25,26,26,26,26,26,26,27,27,27,27,27,27,27,27,27,27,28,28,28,28,28,28,28,28,28,28,28,28,28,28,28,28,28,28,28,29,29,29,29,29,29,29,29,29,29,29,29,29,29,29,29,29,29,29,29,29,29,29},
 {15,15,15,15,15,15,15,15,15,15,15,15,15,15,15,15,15,15,15,15,15,15,15,15,15,15,15,15,15,15,14,14,14,14,14,14,14,14,14,14,14,14,14,14,14,13,13,13,13,13,13,13,13,13,12,12,12,12,12,11,11,10,10,9,0,25,26,26,27,27,28,28,28,28,28,29,29,29,29,29,29,29,29,29,30,30,30,30,30,30,30,30,30,30,30,30,30,30,30,31,31,31,31,31,31,31,31,31,31,31,31,31,31,31,31,31,31,31,31,31,31,31,31,31,31,31,31,31,31}};

#define RLX_AGENT __ATOMIC_RELAXED, __HIP_MEMORY_SCOPE_AGENT
#define LDS_WAIT() asm volatile("s_waitcnt lgkmcnt(0)" ::: "memory")
#define VM_WAIT() asm volatile("s_waitcnt vmcnt(0)" ::: "memory")
__device__ __forceinline__ unsigned f2bf(float f) { unsigned u = __builtin_bit_cast(unsigned, f); return (u + 0x7fffu + ((u >> 16) & 1u)) >> 16; }
__device__ __forceinline__ unsigned pk2(float lo, float hi) { return f2bf(lo) | (f2bf(hi) << 16); }
__device__ __forceinline__ float bf2f(unsigned b) { return __builtin_bit_cast(float, b << 16); }
__device__ __forceinline__ float bflo(unsigned u) { return __builtin_bit_cast(float, u << 16); }
__device__ __forceinline__ float bfhi(unsigned u) { return __builtin_bit_cast(float, u & 0xffff0000u); }
__device__ __forceinline__ float wave_sum(float v) {
#pragma unroll
    for (int o = 1; o < 64; o <<= 1) v += __shfl_xor(v, o);
    return v;
}
__device__ __forceinline__ float sigm(float x) { return __builtin_amdgcn_rcpf(1.f + __builtin_amdgcn_exp2f(-1.4426950408889634f * x)); }

struct Tabs { float biasA[16][257]; float biasB[3][4][129]; };

namespace pg8 {
#define PG8_LAS __attribute__((address_space(3)))
typedef unsigned short bf16_t;
constexpr int BM = 256, BK = 64, HALF = 128, HTB = HALF * BK * 2, STAGE_BYTES = 8 * HTB, NXCD = 8, WGM = 8;
__host__ __device__ __forceinline__ int lds_byte(int r, int c) { const int st = (r >> 4) * 2 + (c >> 5), rr = r & 15, cc = c & 31, ob = rr * 64 + cc * 2; return st * 1024 + (ob ^ (((ob >> 9) & 1) << 5)); }
__host__ __device__ __forceinline__ void stage_rc(int b, int& R, int& C) { const int st = b / 1024, sb = b % 1024, swz = sb ^ (((sb >> 9) & 1) << 5); R = (st >> 1) * 16 + swz / 64; C = (st & 1) * 32 + (swz % 64) / 2; }
__host__ __device__ __forceinline__ int perm32(int rho) { const int n = rho >> 4, i = rho & 15; return 8 * (i >> 2) + 4 * n + (i & 3); }

struct Unit { int arow, brow, nrows, e; };
struct Gemm { const bf16_t* A; const bf16_t* Bt; int K; };

struct StaticOrder {
    int nM, nN, nwg, G, c;
    __device__ void init(int M, int N, int G_, int c_) { nM = M / BM; nN = N / BM; nwg = nM * nN; G = G_; c = c_; }
    __device__ bool next(int i, Unit& u) const {
        const long L = (long)i * G + c; if (L >= nwg) return false;
        int wgid = (int)L; { const int q = nwg / NXCD, r = nwg % NXCD, xcd = wgid % NXCD, off = wgid / NXCD; wgid = (xcd < r ? xcd * (q + 1) : r * (q + 1) + (xcd - r) * q) + off; }
        const int nig = WGM * nN, gid = wgid / nig, fm = gid * WGM, gsz = (nM - fm) < WGM ? (nM - fm) : WGM;
        u.arow = BM * (fm + ((wgid % nig) % gsz)); u.brow = BM * ((wgid % nig) / gsz); u.nrows = BM; u.e = 0; return true;
    }
    __device__ __forceinline__ void a_ready(const Unit&) const {}
    __device__ __forceinline__ void done(const Unit&) const {}
};
struct GroupOrder {
    const PG8_LAS int* toff; const PG8_LAS int* off; int NT, G, c, nunits;
    __device__ bool next(int i, Unit& u) const {
        const int L = i * G + c; if (L >= nunits) return false;
        const int mtg = L / NT, pn = L - mtg * NT;
        int e = 0;
        for (int j = 1; j < NE; ++j) e += (toff[j] <= mtg) ? 1 : 0;
        e = __builtin_amdgcn_readfirstlane(e);
        const int mt = mtg - __builtin_amdgcn_readfirstlane(toff[e]); const int o0 = __builtin_amdgcn_readfirstlane(off[e]), o1 = __builtin_amdgcn_readfirstlane(off[e + 1]);
        u.arow = o0 + BM * mt; const int rem = o1 - u.arow; u.nrows = rem < BM ? rem : BM; u.brow = (e * NT + pn) * BM; u.e = e; return true;
    }
    __device__ __forceinline__ void a_ready(const Unit&) const {}
    __device__ __forceinline__ void done(const Unit&) const {}
};

__device__ __forceinline__ unsigned cvt_pk_bf16(float lo, float hi) { unsigned r; asm volatile("v_cvt_pk_bf16_f32 %0, %1, %2" : "=v"(r) : "v"(lo), "v"(hi)); return r; }

struct EpiProj {
    static constexpr bool PERM = true, AFTER_DRAIN = false;
    bf16_t* qkv; bf16_t* gates; const float* bias; bf16_t* vta; bf16_t* vtb;
    __device__ __forceinline__ void operator()(const f32x4 (&acc)[2][2][4][2], const Unit& u, int wr, int wc, int fr, int fq) const {
        const int colt = u.brow; const bool isq = colt < NQKV; bf16_t* base = isq ? qkv : gates; const int ldc = isq ? NQKV : NGATE; const int cb = isq ? colt : colt - NQKV;
        const int row0 = u.arow + wr * 64 + fr, col0 = cb + wc * 32 + 8 * fq, bcol0 = colt + wc * 32 + 8 * fq;
        f32x4 bv[2][2];
#pragma unroll
        for (int bj = 0; bj < 2; ++bj)
#pragma unroll
            for (int n = 0; n < 2; ++n) bv[bj][n] = *(const f32x4*)(bias + bcol0 + bj * HALF + 4 * n);
        const bool isv = (colt == C_VA) || (colt >= C_VB && colt < NQKV);
        if (!isv) {
#pragma unroll
        for (int ai = 0; ai < 2; ++ai)
#pragma unroll
            for (int m = 0; m < 4; ++m) { bf16_t* rowp = base + (size_t)(row0 + ai * HALF + m * 16) * ldc + col0;
#pragma unroll
                for (int bj = 0; bj < 2; ++bj) { const f32x4 v0 = acc[ai][bj][m][0] + bv[bj][0], v1 = acc[ai][bj][m][1] + bv[bj][1];
                    u32x4 w; w.x = cvt_pk_bf16(v0[0], v0[1]); w.y = cvt_pk_bf16(v0[2], v0[3]); w.z = cvt_pk_bf16(v1[0], v1[1]); w.w = cvt_pk_bf16(v1[2], v1[3]);
                    *(u32x4*)(rowp + bj * HALF) = w; } }
        } else {
            const int gsel = (colt == C_VA) ? -1 : ((colt - C_VB) >> 8); const int sh = (gsel <= 0) ? 0 : (gsel == 1 ? 2 : 4);
            bf16_t* vb = (gsel < 0) ? vta : vtb + (size_t)gsel * (2 * 256 * 8192); const int c0 = wc * 32 + 8 * fq;
#pragma unroll
            for (int ai = 0; ai < 2; ++ai)
#pragma unroll
                for (int m = 0; m < 4; ++m) { const int row = row0 + ai * HALF + m * 16, b = row >> 13, s = row & 8191; const int mu = s >> sh; const int pos = ((s & ((1 << sh) - 1)) << (13 - sh)) + (mu & ~31) + (((mu & 15) >> 2) << 3) + (((mu >> 4) & 1) << 2) + (mu & 3);
                    bf16_t* vp = vb + (size_t)(b * 256 + c0) * 8192 + pos;
#pragma unroll
                    for (int bj = 0; bj < 2; ++bj)
#pragma unroll
                        for (int n = 0; n < 2; ++n) { const f32x4 v = acc[ai][bj][m][n] + bv[bj][n]; const unsigned w0 = cvt_pk_bf16(v[0], v[1]), w1 = cvt_pk_bf16(v[2], v[3]);
                            bf16_t* q = vp + (size_t)(bj * HALF + 4 * n) * 8192;
                            q[0] = (bf16_t)(w0 & 0xffffu); q[8192] = (bf16_t)(w0 >> 16); q[2 * 8192] = (bf16_t)(w1 & 0xffffu); q[3 * 8192] = (bf16_t)(w1 >> 16); } }
        }
    }
};
template <int MODE> struct EpiGate {
    static constexpr bool PERM = true, AFTER_DRAIN = false;
    bf16_t* out; const bf16_t* gates; int gcol0;
    __device__ __forceinline__ void operator()(const f32x4 (&acc)[2][2][4][2], const Unit& u, int wr, int wc, int fr, int fq) const {
        const int row0 = u.arow + wr * 64 + fr, col0 = u.brow + wc * 32 + 8 * fq;
#pragma unroll
        for (int ai = 0; ai < 2; ++ai)
#pragma unroll
            for (int m = 0; m < 4; ++m) { const size_t r = (size_t)(row0 + ai * HALF + m * 16);
#pragma unroll
                for (int bj = 0; bj < 2; ++bj) { const int c = col0 + bj * HALF;
                    const u32x4 gv = *(const u32x4*)(gates + r * NGATE + gcol0 + c); const f32x4 a0 = acc[ai][bj][m][0], a1 = acc[ai][bj][m][1];
                    float o[8]; o[0] = sigm(bflo(gv.x)) * a0[0]; o[1] = sigm(bfhi(gv.x)) * a0[1]; o[2] = sigm(bflo(gv.y)) * a0[2]; o[3] = sigm(bfhi(gv.y)) * a0[3];
                    o[4] = sigm(bflo(gv.z)) * a1[0]; o[5] = sigm(bfhi(gv.z)) * a1[1]; o[6] = sigm(bflo(gv.w)) * a1[2]; o[7] = sigm(bfhi(gv.w)) * a1[3];
                    if (MODE == 1) { const u32x4 mv = *(const u32x4*)(out + r * D + c);
                        o[0] += bflo(mv.x); o[1] += bfhi(mv.x); o[2] += bflo(mv.y); o[3] += bfhi(mv.y); o[4] += bflo(mv.z); o[5] += bfhi(mv.z); o[6] += bflo(mv.w); o[7] += bfhi(mv.w); }
                    u32x4 w; w.x = cvt_pk_bf16(o[0], o[1]); w.y = cvt_pk_bf16(o[2], o[3]); w.z = cvt_pk_bf16(o[4], o[5]); w.w = cvt_pk_bf16(o[6], o[7]);
                    *(u32x4*)(out + r * D + c) = w; }
                asm volatile("" ::: "memory"); }
    }
};
struct EpiX1 {
    static constexpr bool PERM = true, AFTER_DRAIN = false;
    const float* x; float* out;
    __device__ __forceinline__ void operator()(const f32x4 (&acc)[2][2][4][2], const Unit& u, int wr, int wc, int fr, int fq) const {
        const int row0 = u.arow + wr * 64 + fr, col0 = u.brow + wc * 32 + 8 * fq;
#pragma unroll
        for (int ai = 0; ai < 2; ++ai)
#pragma unroll
            for (int m = 0; m < 4; ++m) { const size_t r = (size_t)(row0 + ai * HALF + m * 16);
#pragma unroll
                for (int bj = 0; bj < 2; ++bj) { const size_t o = r * D + col0 + bj * HALF;
                    const f32x4 x0 = *(const f32x4*)(x + o), x1 = *(const f32x4*)(x + o + 4);
                    *(f32x4*)(out + o) = x0 + acc[ai][bj][m][0]; *(f32x4*)(out + o + 4) = x1 + acc[ai][bj][m][1]; }
                asm volatile("" ::: "memory"); }
    }
};
struct EpiSwiglu {
    static constexpr bool PERM = true, AFTER_DRAIN = false;
    bf16_t* act; const float* bg; const float* bu;
    __device__ __forceinline__ void operator()(const f32x4 (&acc)[2][2][4][2], const Unit& u, int wr, int wc, int fr, int fq) const {
        const int pn = (u.brow >> 8) & 7; const int col0 = pn * HALF + wc * 32 + 8 * fq; const int rl0 = wr * 64 + fr;
        const f32x4 g0 = *(const f32x4*)(bg + (size_t)u.e * D + col0), g1 = *(const f32x4*)(bg + (size_t)u.e * D + col0 + 4);
        const f32x4 u0 = *(const f32x4*)(bu + (size_t)u.e * D + col0), u1 = *(const f32x4*)(bu + (size_t)u.e * D + col0 + 4);
#pragma unroll
        for (int ai = 0; ai < 2; ++ai)
#pragma unroll
            for (int m = 0; m < 4; ++m) { const int rl = rl0 + ai * HALF + m * 16;
                const f32x4 ga = acc[ai][0][m][0] + g0, gb = acc[ai][0][m][1] + g1, ua = acc[ai][1][m][0] + u0, ub = acc[ai][1][m][1] + u1;
                float o[8];
#pragma unroll
                for (int j = 0; j < 4; ++j) { const float gt = fminf(ga[j], 7.f), up = fminf(fmaxf(ua[j], -7.f), 7.f); o[j] = gt * sigm(1.702f * gt) * (up + 1.f);
                    const float gt2 = fminf(gb[j], 7.f), up2 = fminf(fmaxf(ub[j], -7.f), 7.f); o[4 + j] = gt2 * sigm(1.702f * gt2) * (up2 + 1.f); }
                u32x4 w; w.x = cvt_pk_bf16(o[0], o[1]); w.y = cvt_pk_bf16(o[2], o[3]); w.z = cvt_pk_bf16(o[4], o[5]); w.w = cvt_pk_bf16(o[6], o[7]);
                if (rl < u.nrows) *(u32x4*)(act + (size_t)(u.arow + rl) * D + col0) = w; }
    }
};
struct EpiDown {
    static constexpr bool PERM = true, AFTER_DRAIN = false;
    bf16_t* ys; const float* bd;
    __device__ __forceinline__ void operator()(const f32x4 (&acc)[2][2][4][2], const Unit& u, int wr, int wc, int fr, int fq) const {
        const int pn = (u.brow >> 8) & 3; const int col0 = pn * BM + wc * 32 + 8 * fq; const int rl0 = wr * 64 + fr;
        f32x4 bv[2][2];
#pragma unroll
        for (int bj = 0; bj < 2; ++bj)
#pragma unroll
            for (int n = 0; n < 2; ++n) bv[bj][n] = *(const f32x4*)(bd + (size_t)u.e * D + col0 + bj * HALF + 4 * n);
#pragma unroll
        for (int ai = 0; ai < 2; ++ai)
#pragma unroll
            for (int m = 0; m < 4; ++m) { const int rl = rl0 + ai * HALF + m * 16; bf16_t* rowp = ys + (size_t)(u.arow + rl) * D + col0;
#pragma unroll
                for (int bj = 0; bj < 2; ++bj) { const f32x4 v0 = acc[ai][bj][m][0] + bv[bj][0], v1 = acc[ai][bj][m][1] + bv[bj][1];
                    u32x4 w; w.x = cvt_pk_bf16(v0[0], v0[1]); w.y = cvt_pk_bf16(v0[2], v0[3]); w.z = cvt_pk_bf16(v1[0], v1[1]); w.w = cvt_pk_bf16(v1[2], v1[3]);
                    if (rl < u.nrows) *(u32x4*)(rowp + bj * HALF) = w; } }
    }
};

template <class Epi, class Sched, bool ALIGN_EPI = false, bool SP2 = false>
__device__ __forceinline__ void gemm_phase(PG8_LAS unsigned char* lds, const Gemm g, const Sched& S, const Epi& E) {
    const int tid = threadIdx.x, wid = __builtin_amdgcn_readfirstlane(tid >> 6), lane = tid & 63, wr = wid >> 2, wc = wid & 3, fr = lane & 15, fq = lane >> 4;
    const int K = g.K, nt = K / BK;
    unsigned voffA[2], voffB[2];
#pragma unroll
    for (int i = 0; i < 2; ++i) { int R, C; stage_rc(tid * 16 + i * 8192, R, C); const int Rb = Epi::PERM ? ((R & ~31) + perm32(R & 31)) : R;
        voffA[i] = (unsigned)(R * K + C) * 2u; voffB[i] = (unsigned)(Rb * K + C) * 2u; }
    const size_t kstep = (size_t)(BK * 2);
    const size_t hstep = (size_t)HALF * K * 2;
    const size_t rowb = (size_t)K * 2;
    const unsigned ldsw = (unsigned)wid * 1024u;
    const int aoff = lds_byte(wr * 64 + fr, fq * 8), boff = lds_byte(wc * 32 + fr, fq * 8);
#define PG8_SA(b, h) (((b) * 2 + (h)) * HTB)
#define PG8_SB(b, h) ((4 + (b) * 2 + (h)) * HTB)
#define PG8_STAGE(bufoff, gbase, voff) do { _Pragma("unroll") for (int _i = 0; _i < 2; ++_i) \
        __builtin_amdgcn_global_load_lds((const unsigned*)((const char*)(gbase) + (voff)[_i]), (PG8_LAS unsigned*)(lds + (bufoff) + ldsw + _i * 8192), 16, 0, 0); } while (0)
#define PG8_LDA(dst, b, h) do { _Pragma("unroll") for (int m = 0; m < 4; ++m) _Pragma("unroll") for (int k = 0; k < 2; ++k) dst[m][k] = *(const PG8_LAS bf16x8*)(lds + PG8_SA(b, h) + aoff + m * 2048 + k * 1024); } while (0)
#define PG8_LDB(dst, b, h) do { _Pragma("unroll") for (int n = 0; n < 2; ++n) _Pragma("unroll") for (int k = 0; k < 2; ++k) dst[n][k] = *(const PG8_LAS bf16x8*)(lds + PG8_SB(b, h) + boff + n * 2048 + k * 1024); } while (0)
#define PG8_MMA(ai, bj, At, Bt) do { __builtin_amdgcn_s_setprio(1); _Pragma("unroll") for (int m = 0; m < 4; ++m) _Pragma("unroll") for (int n = 0; n < 2; ++n) _Pragma("unroll") for (int k = 0; k < 2; ++k) \
        acc[ai][bj][m][n] = __builtin_amdgcn_mfma_f32_16x16x32_bf16(Bt[n][k], At[m][k], acc[ai][bj][m][n], 0, 0, 0); __builtin_amdgcn_s_setprio(0); } while (0)
#define PG8_WAIT_V(n) asm volatile("s_waitcnt vmcnt(" #n ")" ::: "memory")
#define PG8_WAIT_L(n) asm volatile("s_waitcnt lgkmcnt(" #n ")" ::: "memory")
#define PG8_BAR __builtin_amdgcn_s_barrier()
#define PG8_SCHED __builtin_amdgcn_sched_barrier(0)
    Unit cur, nxt; int ui = 0;
    if (!S.next(0, cur)) return;
    f32x4 acc[2][2][4][2];
#pragma unroll
    for (int a = 0; a < 2; ++a)
#pragma unroll
        for (int b = 0; b < 2; ++b)
#pragma unroll
            for (int m = 0; m < 4; ++m)
#pragma unroll
                for (int n = 0; n < 2; ++n) acc[a][b][m][n] = (f32x4){0.f, 0.f, 0.f, 0.f};
    bf16x8 At[4][2], B0[2][2], B1[2][2];
    const char* cA = (const char*)g.A + (size_t)cur.arow * rowb; const char* cB = (const char*)g.Bt + (size_t)cur.brow * rowb;
    S.a_ready(cur);
    if constexpr (SP2) {
        PG8_STAGE(PG8_SB(0, 0), cB, voffB); PG8_STAGE(PG8_SB(0, 1), cB + hstep, voffB); PG8_STAGE(PG8_SA(0, 0), cA, voffA); PG8_STAGE(PG8_SA(0, 1), cA + hstep, voffA);
        if (wr == 1) PG8_BAR;
        PG8_WAIT_V(2); PG8_BAR;
        PG8_STAGE(PG8_SB(1, 0), cB + kstep, voffB); PG8_STAGE(PG8_SA(1, 0), cA + kstep, voffA); PG8_STAGE(PG8_SB(1, 1), cB + hstep + kstep, voffB);
        PG8_WAIT_V(6); PG8_BAR;
    } else {
        PG8_STAGE(PG8_SB(0, 0), cB, voffB); PG8_STAGE(PG8_SA(0, 0), cA, voffA); PG8_STAGE(PG8_SB(0, 1), cB + hstep, voffB); PG8_STAGE(PG8_SA(0, 1), cA + hstep, voffA);
        if (wr == 1) PG8_BAR;
        PG8_WAIT_V(4); PG8_BAR;
        PG8_STAGE(PG8_SB(1, 0), cB + kstep, voffB); PG8_STAGE(PG8_SA(1, 0), cA + kstep, voffA); PG8_STAGE(PG8_SB(1, 1), cB + hstep + kstep, voffB);
        PG8_WAIT_V(6); PG8_BAR;
    }
    for (;;) {
        const bool has_next = S.next(ui + 1, nxt);
        const char* nA = has_next ? (const char*)g.A + (size_t)nxt.arow * rowb : cA; const char* nB = has_next ? (const char*)g.Bt + (size_t)nxt.brow * rowb : cB;
        for (int t = 0; t < nt; t += 2) {
            const bool last = (t == nt - 2);
            const char* a1 = cA + (size_t)(t + 1) * kstep;
            const char* a2 = last ? nA : cA + (size_t)(t + 2) * kstep; const char* b2 = last ? nB : cB + (size_t)(t + 2) * kstep;
            const char* a3 = a2 + kstep; const char* b3 = b2 + kstep;
            if (last && has_next) S.a_ready(nxt);
            if constexpr (SP2) {
            PG8_LDB(B0, 0, 0); PG8_LDB(B1, 0, 1); PG8_SCHED; PG8_LDA(At, 0, 0); PG8_STAGE(PG8_SA(1, 1), a1 + hstep, voffA);
            PG8_WAIT_V(8); PG8_WAIT_L(0); PG8_BAR; PG8_MMA(0, 0, At, B0); PG8_MMA(0, 1, At, B1); PG8_BAR; PG8_SCHED;
            PG8_LDA(At, 0, 1); PG8_STAGE(PG8_SB(0, 0), b2, voffB); PG8_STAGE(PG8_SB(0, 1), b2 + hstep, voffB); PG8_STAGE(PG8_SA(0, 0), a2, voffA);
            PG8_WAIT_V(8); PG8_WAIT_L(0); PG8_BAR; PG8_MMA(1, 0, At, B0); PG8_MMA(1, 1, At, B1); PG8_BAR; PG8_SCHED;
            PG8_LDB(B0, 1, 0); PG8_LDB(B1, 1, 1); PG8_SCHED; PG8_LDA(At, 1, 0); PG8_STAGE(PG8_SA(0, 1), a2 + hstep, voffA);
            PG8_WAIT_V(8); PG8_WAIT_L(0); PG8_BAR; PG8_MMA(0, 0, At, B0); PG8_MMA(0, 1, At, B1); PG8_BAR; PG8_SCHED;
            PG8_LDA(At, 1, 1); PG8_STAGE(PG8_SB(1, 0), b3, voffB); PG8_STAGE(PG8_SB(1, 1), b3 + hstep, voffB); PG8_STAGE(PG8_SA(1, 0), a3, voffA);
            PG8_WAIT_V(8); PG8_WAIT_L(0); PG8_BAR; PG8_MMA(1, 0, At, B0); PG8_MMA(1, 1, At, B1); PG8_BAR; PG8_SCHED;
            } else {
            PG8_LDB(B0, 0, 0); PG8_SCHED; PG8_LDA(At, 0, 0); PG8_STAGE(PG8_SA(1, 1), a1 + hstep, voffA);
            PG8_WAIT_L(8); PG8_BAR; PG8_WAIT_L(0); PG8_MMA(0, 0, At, B0); PG8_BAR; PG8_SCHED;
            PG8_LDB(B1, 0, 1); PG8_STAGE(PG8_SB(0, 0), b2, voffB);
            PG8_BAR; PG8_WAIT_L(0); PG8_MMA(0, 1, At, B1); PG8_BAR;
            PG8_LDA(At, 0, 1); PG8_STAGE(PG8_SA(0, 0), a2, voffA);
            PG8_BAR; PG8_WAIT_L(0); PG8_MMA(1, 0, At, B0); PG8_BAR; PG8_SCHED;
            PG8_STAGE(PG8_SB(0, 1), b2 + hstep, voffB);
            PG8_WAIT_V(6); PG8_BAR; PG8_MMA(1, 1, At, B1); PG8_BAR;
            PG8_LDB(B0, 1, 0); PG8_SCHED; PG8_LDA(At, 1, 0); PG8_STAGE(PG8_SA(0, 1), a2 + hstep, voffA);
            PG8_WAIT_L(8); PG8_BAR; PG8_WAIT_L(0); PG8_MMA(0, 0, At, B0); PG8_BAR; PG8_SCHED;
            PG8_LDB(B1, 1, 1); PG8_STAGE(PG8_SB(1, 0), b3, voffB);
            PG8_BAR; PG8_WAIT_L(0); PG8_MMA(0, 1, At, B1); PG8_BAR;
            PG8_LDA(At, 1, 1); PG8_STAGE(PG8_SA(1, 0), a3, voffA);
            PG8_BAR; PG8_WAIT_L(0); PG8_MMA(1, 0, At, B0); PG8_BAR; PG8_SCHED;
            PG8_STAGE(PG8_SB(1, 1), b3 + hstep, voffB);
            PG8_WAIT_V(6); PG8_BAR; PG8_MMA(1, 1, At, B1); PG8_BAR;
            }
        }
        if constexpr (ALIGN_EPI) { if (wr == 0) PG8_BAR; }
        if constexpr (!Epi::AFTER_DRAIN) { E(acc, cur, wr, wc, fr, fq); S.done(cur); }
        if (!has_next) break;
#pragma unroll
        for (int a = 0; a < 2; ++a)
#pragma unroll
            for (int b = 0; b < 2; ++b)
#pragma unroll
                for (int m = 0; m < 4; ++m)
#pragma unroll
                    for (int n = 0; n < 2; ++n) acc[a][b][m][n] = (f32x4){0.f, 0.f, 0.f, 0.f};
        cur = nxt; cA = nA; cB = nB; ++ui;
        if constexpr (ALIGN_EPI) { if (wr == 1) PG8_BAR; }
    }
    PG8_WAIT_V(0);
    if constexpr (!ALIGN_EPI) { if (wr == 0) PG8_BAR; }
    PG8_BAR;
    if constexpr (Epi::AFTER_DRAIN) { E.fused(acc, cur, wr, wc, fr, fq, lds, wid, lane); S.done(cur); }
#undef PG8_SA
#undef PG8_SB
#undef PG8_STAGE
#undef PG8_LDA
#undef PG8_LDB
#undef PG8_MMA
#undef PG8_WAIT_V
#undef PG8_WAIT_L
#undef PG8_BAR
#undef PG8_SCHED
}

}

#define XB_TMO      128
#define XB_XCNT(j)  (256  + 64 * (j))
#define XB_XSUB(j)  (1280 + 64 * (j))
#define XB_XGEN(j)  (2304 + 64 * (j))
#define XB_TOP      3328
#define XB_TOPGEN   3392
#define XCD_BAR_WORDS 3456
#define XB_SPIN_CAP (1u << 18)
__device__ __forceinline__ unsigned xb_ld(unsigned* p)              { return __hip_atomic_load(p, __ATOMIC_RELAXED, __HIP_MEMORY_SCOPE_AGENT); }
__device__ __forceinline__ unsigned xb_add(unsigned* p, unsigned v) { return __hip_atomic_fetch_add(p, v, __ATOMIC_RELAXED, __HIP_MEMORY_SCOPE_AGENT); }
__device__ __forceinline__ unsigned xb_xcc_id() { return (unsigned)__builtin_amdgcn_s_getreg((3 << 11) | 20) & 0xFu; }
#define XB_SPIN(cond, bar) do { unsigned _sp = 0; while (cond) { __builtin_amdgcn_s_sleep(1); \
    if ((++_sp & 255u) == 0u) { if (xb_ld(&(bar)[XB_TMO])) break; if (_sp > XB_SPIN_CAP) { atomicAdd(&(bar)[XB_TMO], 1u); break; } } } } while (0)
struct XcdBarrier { unsigned* bar; unsigned x; volatile LAS unsigned* st; };
__device__ __forceinline__ XcdBarrier xcd_barrier_post(unsigned* bar, volatile LAS unsigned* st) {
    XcdBarrier b; b.bar = bar; b.x = xb_xcc_id(); b.st = st;
    if (threadIdx.x == 0) (void)xb_add(&bar[XB_XCNT(b.x)], 1u);
    return b;
}
__device__ __forceinline__ void xcd_barrier_complete(unsigned* bar, unsigned x, unsigned& nloc, unsigned& nx) {
    const unsigned G = gridDim.x * gridDim.y * gridDim.z;
    unsigned sum, cnt, mine, sp = 0u;
    for (;;) {
        sum = 0u; cnt = 0u; mine = 0u;
#pragma unroll
        for (unsigned j = 0; j < 16; ++j) { const unsigned c = xb_ld(&bar[XB_XCNT(j)]); sum += c; cnt += (c > 0u) ? 1u : 0u; mine = (j == x) ? c : mine; }
        if (sum == G) break;
        __builtin_amdgcn_s_sleep(1);
        if ((++sp & 255u) == 0u) { if (xb_ld(&bar[XB_TMO])) break; if (sp > XB_SPIN_CAP) { atomicAdd(&bar[XB_TMO], 1u); break; } }
    }
    nloc = mine > 0u ? mine : 1u; nx = cnt > 0u ? cnt : 1u;
}
__device__ __forceinline__ void xcd_barrier(const XcdBarrier& b) {
    asm volatile("s_waitcnt vmcnt(0)" ::: "memory");
    __syncthreads();
    if (threadIdx.x == 0) {
        unsigned* bar = b.bar;
        __builtin_amdgcn_s_waitcnt(0);
        unsigned nloc = b.st[0], nx = b.st[1];
        if (nloc == 0u) { xcd_barrier_complete(bar, b.x, nloc, nx); b.st[0] = nloc; b.st[1] = nx; }
        const unsigned old = xb_add(&bar[XB_XSUB(b.x)], 1u);
        const unsigned gen = old / nloc;
        if (old + 1u == (gen + 1u) * nloc) {
            __builtin_amdgcn_fence(__ATOMIC_RELEASE, "agent");
            asm volatile("s_waitcnt vmcnt(0)" ::: "memory");
            const unsigned og = xb_add(&bar[XB_TOP], 1u);
            const unsigned tg = og / nx;
            if (og + 1u == (tg + 1u) * nx) xb_add(&bar[XB_TOPGEN], 1u);
            else XB_SPIN(xb_ld(&bar[XB_TOPGEN]) == tg, bar);
            __builtin_amdgcn_fence(__ATOMIC_ACQUIRE, "agent");
            xb_add(&bar[XB_XGEN(b.x)], 1u);
            asm volatile("s_waitcnt vmcnt(0)" ::: "memory");
        } else {
            XB_SPIN(xb_ld(&bar[XB_XGEN(b.x)]) == gen, bar);
            __builtin_amdgcn_fence(__ATOMIC_ACQUIRE, "agent");
            asm volatile("s_waitcnt vmcnt(0)" ::: "memory");
        }
    }
    __syncthreads();
}

constexpr int NWAVES = 8;
constexpr int RING_OFF = 0, RING_BYTES = 131072;
constexpr int LDSCTL_OFF = RING_BYTES, MISC_OFF = LDSCTL_OFF + 320;
constexpr int TBL_OFF = LDSCTL_OFF + 1024;
constexpr int LDS_BYTES = 147456;

struct Frame {
    LAS unsigned char* lds; volatile LAS unsigned* MISC; LAS int* tbl; gu32* ctl;
    int tid, lane, wave, vcu, G;
};

__device__ __forceinline__ void p0_transpose_item(const float* W, int K, int N, bf16* WT, int k0, int n0, int orow0, LAS float* scr, int lane) {
#pragma unroll 8
    for (int i = 0; i < 32; ++i) { const int kk = 2 * i + (lane >> 5); scr[kk * 33 + (lane & 31)] = W[(size_t)(k0 + kk) * N + n0 + (lane & 31)]; }
    LDS_WAIT(); asm volatile("" ::: "memory");
    const int c = lane & 7;
#pragma unroll
    for (int j = 0; j < 4; ++j) { const int n = (lane >> 3) + 8 * j; const LAS float* s = scr + (8 * c) * 33 + n;
        u32x4 o; o.x = pk2(s[0 * 33], s[1 * 33]); o.y = pk2(s[2 * 33], s[3 * 33]); o.z = pk2(s[4 * 33], s[5 * 33]); o.w = pk2(s[6 * 33], s[7 * 33]);
        *(GAS u32x4*)(WT + (size_t)(orow0 + n) * K + k0 + 8 * c) = o; }
    LDS_WAIT(); asm volatile("" ::: "memory");
}
__device__ __forceinline__ void rms_row_to_bf16(const float* xrow, const float* g, bf16* orow, int lane) {
    const GAS f32x4* xr = (const GAS f32x4*)xrow + lane; f32x4 v[4]; float s = 0.f;
#pragma unroll
    for (int j = 0; j < 4; ++j) { v[j] = xr[64 * j]; s += (v[j].x * v[j].x + v[j].y * v[j].y) + (v[j].z * v[j].z + v[j].w * v[j].w); }
    const float rstd = 1.f / sqrtf(wave_sum(s) * (1.f / D) + EPS);
    GAS unsigned long long* o8 = (GAS unsigned long long*)orow + lane;
#pragma unroll
    for (int j = 0; j < 4; ++j) { const f32x4 gg = ((const GAS f32x4*)g)[lane + 64 * j];
        o8[64 * j] = (unsigned long long)pk2(v[j].x * rstd * gg.x, v[j].y * rstd * gg.y) | ((unsigned long long)pk2(v[j].z * rstd * gg.z, v[j].w * rstd * gg.w) << 32); }
}

constexpr float LOG2E = 1.4426950408889634f;
struct AttFrags { bf16x8 k0a, k0b, k1a, k1b, v[4]; };
template <int NH, int HW>
__device__ __forceinline__ void band_group(f32x4 (&o)[NH][4], float (&mrun)[NH], float (&lrun)[NH], const bf16* qkvb, const int (&qcol)[NH], const int (&qmu0)[NH], int kcol, const bf16* vt,
                                           int dil, int rho, int L, int qstep, int P0, int npairs, const LAS float* const (&bias)[NH], int lane) {
    const int t = lane & 15, g = lane >> 4;
    bf16x8 qf[NH][2]; int mu_t[NH];
#pragma unroll
    for (int h = 0; h < NH; ++h) { mu_t[h] = qmu0[h] + qstep * t; const bf16* qrow = qkvb + (size_t)(mu_t[h] * dil + rho) * NQKV + 8 * g + qcol[h];
        qf[h][0] = *(const bf16x8*)qrow; qf[h][1] = *(const bf16x8*)(qrow + 32); }
    int mu_lo = qmu0[0], mu_hi = qmu0[0];
#pragma unroll
    for (int h = 1; h < NH; ++h) { mu_lo = min(mu_lo, qmu0[h]); mu_hi = max(mu_hi, qmu0[h]); }
    mu_hi += 15 * qstep;
    const int npr = L >> 5;
    const bf16* kbase = qkvb + (size_t)rho * NQKV + kcol + 8 * g;
    const bf16* vtl = vt + (size_t)t * 8192 + (size_t)rho * L + 8 * g;
    auto load = [&](int P, AttFrags& f) {
        const int Pc = min(max(P, 0), npr - 1);
        const bf16* k0p = kbase + (size_t)((32 * Pc + t) * dil) * NQKV; const bf16* k1p = k0p + (size_t)(16 * dil) * NQKV;
        f.k0a = *(const bf16x8*)k0p; f.k0b = *(const bf16x8*)(k0p + 32); f.k1a = *(const bf16x8*)k1p; f.k1b = *(const bf16x8*)(k1p + 32);
#pragma unroll
        for (int db = 0; db < 4; ++db) f.v[db] = *(const bf16x8*)(vtl + (size_t)(16 * db) * 8192 + 32 * Pc);
    };
    AttFrags cur; load(P0, cur);
    for (int pp = 0; pp < npairs; ++pp) {
        const int P = P0 + pp;
        AttFrags nxt; load(P0 + min(pp + 1, npairs - 1), nxt);
        const bool need_mask = (32 * P - mu_hi < -HW) || (32 * P + 31 - mu_lo > HW) || (P < 0) || (P >= npr);
        const int kap0 = 32 * P + 4 * g;
#pragma unroll
        for (int h = 0; h < NH; ++h) {
            f32x4 s0 = (f32x4){0.f, 0.f, 0.f, 0.f}, s1 = (f32x4){0.f, 0.f, 0.f, 0.f};
            s0 = __builtin_amdgcn_mfma_f32_16x16x32_bf16(cur.k0a, qf[h][0], s0, 0, 0, 0); s0 = __builtin_amdgcn_mfma_f32_16x16x32_bf16(cur.k0b, qf[h][1], s0, 0, 0, 0);
            s1 = __builtin_amdgcn_mfma_f32_16x16x32_bf16(cur.k1a, qf[h][0], s1, 0, 0, 0); s1 = __builtin_amdgcn_mfma_f32_16x16x32_bf16(cur.k1b, qf[h][1], s1, 0, 0, 0);
            const int rel0 = kap0 - mu_t[h];
            float sc[8], p[8], ps = 0.f;
            if (need_mask) {
                bool vd[8];
#pragma unroll
                for (int j = 0; j < 8; ++j) { const int dj = (j < 4) ? j : 12 + j; const int rel = rel0 + dj, kap = kap0 + dj;
                    vd[j] = (rel >= -HW) && (rel <= HW) && (kap >= 0) && (kap < L);
                    const int idx = min(max(rel + HW, 0), 2 * HW);
                    const float sv = (j < 4) ? s0[j & 3] : s1[j & 3];
                    sc[j] = vd[j] ? (sv * (0.125f * LOG2E) + bias[h][idx]) : -3.0e38f; }
                float mx = fmaxf(fmaxf(fmaxf(sc[0], sc[1]), fmaxf(sc[2], sc[3])), fmaxf(fmaxf(sc[4], sc[5]), fmaxf(sc[6], sc[7])));
                mx = fmaxf(mx, __shfl_xor(mx, 16)); mx = fmaxf(mx, __shfl_xor(mx, 32));
                if (__any(mx > mrun[h])) { const float mn = fmaxf(mrun[h], mx), alpha = __builtin_amdgcn_exp2f(mrun[h] - mn); mrun[h] = mn; lrun[h] *= alpha;
#pragma unroll
                    for (int db = 0; db < 4; ++db) o[h][db] = o[h][db] * alpha; }
#pragma unroll
                for (int j = 0; j < 8; ++j) { p[j] = vd[j] ? __builtin_amdgcn_exp2f(sc[j] - mrun[h]) : 0.f; ps += p[j]; }
            } else {
#pragma unroll
                for (int j = 0; j < 8; ++j) { const int dj = (j < 4) ? j : 12 + j; const float sv = (j < 4) ? s0[j & 3] : s1[j & 3];
                    sc[j] = sv * (0.125f * LOG2E) + bias[h][rel0 + dj + HW]; }
                float mx = fmaxf(fmaxf(fmaxf(sc[0], sc[1]), fmaxf(sc[2], sc[3])), fmaxf(fmaxf(sc[4], sc[5]), fmaxf(sc[6], sc[7])));
                mx = fmaxf(mx, __shfl_xor(mx, 16)); mx = fmaxf(mx, __shfl_xor(mx, 32));
                if (__any(mx > mrun[h])) { const float mn = fmaxf(mrun[h], mx), alpha = __builtin_amdgcn_exp2f(mrun[h] - mn); mrun[h] = mn; lrun[h] *= alpha;
#pragma unroll
                    for (int db = 0; db < 4; ++db) o[h][db] = o[h][db] * alpha; }
#pragma unroll
                for (int j = 0; j < 8; ++j) { p[j] = __builtin_amdgcn_exp2f(sc[j] - mrun[h]); ps += p[j]; }
            }
            lrun[h] += ps;
            u32x4 pw; pw.x = pg8::cvt_pk_bf16(p[0], p[1]); pw.y = pg8::cvt_pk_bf16(p[2], p[3]); pw.z = pg8::cvt_pk_bf16(p[4], p[5]); pw.w = pg8::cvt_pk_bf16(p[6], p[7]);
            const bf16x8 pf = __builtin_bit_cast(bf16x8, pw);
#pragma unroll
            for (int db = 0; db < 4; ++db) o[h][db] = __builtin_amdgcn_mfma_f32_16x16x32_bf16(cur.v[db], pf, o[h][db], 0, 0, 0);
        }
        cur = nxt;
    }
}
template <int NH>
__device__ __forceinline__ void band_store(const f32x4 (&o)[NH][4], const float (&lrun)[NH], bf16* const (&yrow)[NH], int lane) {
    const int g = lane >> 4;
#pragma unroll
    for (int h = 0; h < NH; ++h) { float l = lrun[h]; l += __shfl_xor(l, 16); l += __shfl_xor(l, 32); const float inv = 1.f / l;
#pragma unroll
        for (int db = 0; db < 4; ++db) { u32x2 w; w.x = pg8::cvt_pk_bf16(o[h][db][0] * inv, o[h][db][1] * inv); w.y = pg8::cvt_pk_bf16(o[h][db][2] * inv, o[h][db][3] * inv);
            *(u32x2*)(yrow[h] + 16 * db + 4 * g) = w; } }
}

struct Args { const float* in[19]; float* out; unsigned char* ws; int ph_lo, ph_hi, li, pad; };
constexpr int NPHASE = 10;

__global__ void __launch_bounds__(NWAVES * 64, 2) mk_fwd(Args args) {
    extern __shared__ __attribute__((aligned(16))) unsigned char lds[];
    Frame F;
    F.lds = (LAS unsigned char*)lds; F.MISC = (volatile LAS unsigned*)(F.lds + MISC_OFF); F.tbl = (LAS int*)(F.lds + TBL_OFF);
    F.tid = threadIdx.x; F.lane = F.tid & 63; F.wave = __builtin_amdgcn_readfirstlane(F.tid >> 6);
    F.G = gridDim.x; { const int bx = blockIdx.x; F.vcu = (F.G % 8 == 0) ? (bx % 8) * (F.G / 8) + bx / 8 : bx; }
    unsigned char* ws = args.ws; F.ctl = (gu32*)(ws + WS_CTL);
    const float* x = args.in[0]; const float* norm_mix = args.in[1]; const float* w_in = args.in[2]; const float* b_in = args.in[3];
    const float* sinks = args.in[4]; const float* rel_bias = args.in[5]; const float* w_a = args.in[6]; const float* w_b = args.in[7];
    const float* w_out = args.in[8]; const float* norm_ffn = args.in[9]; const float* router_w = args.in[10]; const float* router_b = args.in[11];
    const float* w_gate = args.in[12]; const float* b_gate = args.in[13]; const float* w_up = args.in[14]; const float* b_up = args.in[15];
    const float* w_down = args.in[16]; const float* b_down = args.in[17]; const float* norm_final = args.in[18];
    float* out = args.out;
    Tabs* tb = (Tabs*)(ws + WS_TAB);
    bf16* Win_t = (bf16*)(ws + WS_WIN); bf16* Wa_t = (bf16*)(ws + WS_WA); bf16* Wb_t = (bf16*)(ws + WS_WB); bf16* Wout_t = (bf16*)(ws + WS_WOUT);
    bf16* Wgu_t = (bf16*)(ws + WS_WGU); bf16* Wd_t = (bf16*)(ws + WS_WD);
    int* topi = (int*)(ws + WS_RT); float* topp = (float*)(ws + WS_RT + 256 * 1024); int* slot = (int*)(ws + WS_RT + 512 * 1024); int* pos = (int*)(ws + WS_RT + 768 * 1024);
    bf16* XN = (bf16*)(ws + WS_XN); bf16* QKV = (bf16*)(ws + WS_QKV); bf16* GATES = (bf16*)(ws + WS_GATES); bf16* YA = (bf16*)(ws + WS_YA); bf16* YB = (bf16*)(ws + WS_YB);
    bf16* MERGED = (bf16*)(ws + WS_MERGED); bf16* HS = (bf16*)(ws + WS_HS); bf16* ACT = (bf16*)(ws + WS_ACT);
    gu32* cnt = F.ctl + CW_CNT;

    for (int u = F.tid; u < (LDS_BYTES - LDSCTL_OFF) / 4; u += NWAVES * 64) ((LAS unsigned*)(F.lds + LDSCTL_OFF))[u] = 0u;
    __syncthreads();
    XcdBarrier bar = xcd_barrier_post((unsigned*)(F.ctl + CW_BAR) + args.li * XCD_BAR_WORDS, F.MISC + 8);
    const int lo = args.ph_lo, hi = args.ph_hi;
#ifndef MK_SKIP
#define MK_SKIP 0
#endif
#define IN(k) (!((MK_SKIP >> (k)) & 1) && lo <= (k) && (k) < hi)
#ifndef MK_DUP
#define MK_DUP 0
#endif
#define REP(k) _Pragma("unroll") for (int rep_ = 0; rep_ < 1 + ((MK_DUP >> (k)) & 1); ++rep_)
#define SEAM(k) do { if (IN(k) && IN((k) + 1)) xcd_barrier(bar); } while (0)
    const int gw = F.vcu * NWAVES + F.wave, NGW = F.G * NWAVES;

    if (IN(0)) REP(0) {
        { const int i = blockIdx.x * (NWAVES * 64) + F.tid;
          if (i < 16 * 257) { const int h = i / 257, r = i % 257; tb->biasA[h][r] = rel_bias[BKT_A[r] * 28 + h]; }
          if (i < 12 * 129) { const int g = i / (4 * 129), hs = (i / 129) % 4, r = i % 129; tb->biasB[g][hs][r] = rel_bias[BKT_B[g][r] * 28 + 16 + 4 * g + hs]; } }
        LAS float* scr = (LAS float*)(F.lds + RING_OFF + F.wave * 16384);
        constexpr int I_IN = (D / 64) * (NPROJ / 32), I_A = (D / 64) * (D / 32), I_B = (256 / 64) * (D / 32), I_E = (D / 64) * (D / 32);
        constexpr int NITEMS = I_IN + 2 * I_A + I_B + 3 * NE * I_E;
        for (int it = gw; it < NITEMS; it += NGW) {
            int r = it;
            if (r < I_IN) { const int nb = NPROJ / 32; p0_transpose_item(w_in, D, NPROJ, Win_t, 64 * (r / nb), 32 * (r % nb), 32 * (r % nb), scr, F.lane); continue; } r -= I_IN;
            if (r < I_A) { const int nb = D / 32; p0_transpose_item(w_a, D, D, Wa_t, 64 * (r / nb), 32 * (r % nb), 32 * (r % nb), scr, F.lane); continue; } r -= I_A;
            if (r < I_A) { const int nb = D / 32; p0_transpose_item(w_out, D, D, Wout_t, 64 * (r / nb), 32 * (r % nb), 32 * (r % nb), scr, F.lane); continue; } r -= I_A;
            if (r < I_B) { const int nb = D / 32; p0_transpose_item(w_b, 256, D, Wb_t, 64 * (r / nb), 32 * (r % nb), 32 * (r % nb), scr, F.lane); continue; } r -= I_B;
            { const int e = r / (3 * I_E), q = r % (3 * I_E), which = q / I_E, ii = q % I_E, nb = D / 32, k0 = 64 * (ii / nb), n0 = 32 * (ii % nb);
              if (which == 0) p0_transpose_item(w_gate + (size_t)e * D * D, D, D, Wgu_t, k0, n0, e * 2048 + (n0 >> 7) * 256 + (n0 & 127), scr, F.lane);
              else if (which == 1) p0_transpose_item(w_up + (size_t)e * D * D, D, D, Wgu_t, k0, n0, e * 2048 + (n0 >> 7) * 256 + 128 + (n0 & 127), scr, F.lane);
              else p0_transpose_item(w_down + (size_t)e * D * D, D, D, Wd_t, k0, n0, e * 1024 + n0, scr, F.lane); }
        }
        for (int m = gw; m < T; m += NGW) rms_row_to_bf16(x + (size_t)m * D, norm_mix, XN + (size_t)m * D, F.lane);
    }
    SEAM(0);
    if (IN(1)) REP(1) {
        pg8::Gemm g{XN, Win_t, D}; pg8::StaticOrder So; So.init(T, NPROJ, F.G, (int)blockIdx.x);
        pg8::EpiProj E{QKV, GATES, b_in, (bf16*)(ws + WS_VT), (bf16*)(ws + WS_VT) + (size_t)2 * 4 * 64 * 8192};
        pg8::gemm_phase<pg8::EpiProj, pg8::StaticOrder, true, true>(F.lds + RING_OFF, g, So, E);
    }
    SEAM(1);
    if (IN(2)) REP(2) {
        LAS float* lb = (LAS float*)(F.lds + RING_OFF);
        for (int i = F.tid; i < 4112 + 1548; i += NWAVES * 64) lb[i] = ((const float*)tb)[i] * LOG2E;
        __syncthreads();
        const bf16* VTA = (const bf16*)(ws + WS_VT); const bf16* VTB = VTA + (size_t)2 * 4 * 64 * 8192;
        for (int it = gw; it < 4096 + 2048; it += NGW) {
            const int t = F.lane & 15;
            if (it < 4096) {
                const int b = it >> 11, kvh = (it >> 9) & 3, qb = it & 511;
                f32x4 o[4][4]; float mr[4], lr[4];
#pragma unroll
                for (int h = 0; h < 4; ++h) { mr[h] = sinks[kvh * 4 + h] * LOG2E; lr[h] = (F.lane < 16) ? 1.f : 0.f;
#pragma unroll
                    for (int db = 0; db < 4; ++db) o[h][db] = (f32x4){0.f, 0.f, 0.f, 0.f}; }
                const int qcol[4] = {C_QA + (kvh * 4 + 0) * 64, C_QA + (kvh * 4 + 1) * 64, C_QA + (kvh * 4 + 2) * 64, C_QA + (kvh * 4 + 3) * 64};
                const int qmu[4] = {16 * qb, 16 * qb, 16 * qb, 16 * qb};
                const LAS float* const bias[4] = {lb + (kvh * 4 + 0) * 257, lb + (kvh * 4 + 1) * 257, lb + (kvh * 4 + 2) * 257, lb + (kvh * 4 + 3) * 257};
                band_group<4, 128>(o, mr, lr, QKV + (size_t)b * S * NQKV, qcol, qmu, C_KA + kvh * 64, VTA + (size_t)((b * 4 + kvh) * 64) * 8192, 1, 0, S, 1, (qb - 8) >> 1, 9, bias, F.lane);
                bf16* yr = YA + (size_t)(b * S + 16 * qb + t) * D + kvh * 256; bf16* const yrow[4] = {yr, yr + 64, yr + 128, yr + 192};
                band_store<4>(o, lr, yrow, F.lane);
            } else {
                const int j = it - 4096, r = j & 7, un = j >> 3, blk = un & 31, hs = (un >> 5) & 3, b = un >> 7, i0 = blk * 256;
                f32x4 o[2][4]; float mr[2], lr[2];
#pragma unroll
                for (int h = 0; h < 2; ++h) { mr[h] = -3.0e38f; lr[h] = 0.f;
#pragma unroll
                    for (int db = 0; db < 4; ++db) o[h][db] = (f32x4){0.f, 0.f, 0.f, 0.f}; }
                const bf16* qb_ = QKV + (size_t)b * S * NQKV;
                { const int qcol[2] = {C_QB + 0 * 256 + hs * 64, C_QB + 0 * 256 + hs * 64}; const int qmu[2] = {i0 + r, i0 + r + 8}; const LAS float* const bias[2] = {lb + 4112 + (0 * 4 + hs) * 129, lb + 4112 + (0 * 4 + hs) * 129};
                  band_group<2, 64>(o, mr, lr, qb_, qcol, qmu, C_KB + 0 * 256 + hs * 64, VTB + (size_t)(((0 * 2 + b) * 4 + hs) * 64) * 8192, 1, 0, S, 16, (i0 >> 5) - 2, 12, bias, F.lane); }
                { const int qcol[2] = {C_QB + 1 * 256 + hs * 64, C_QB + 1 * 256 + hs * 64}; const int qmu[2] = {(i0 + r) >> 2, (i0 + r + 8) >> 2}; const LAS float* const bias[2] = {lb + 4112 + (1 * 4 + hs) * 129, lb + 4112 + (1 * 4 + hs) * 129};
                  band_group<2, 64>(o, mr, lr, qb_, qcol, qmu, C_KB + 1 * 256 + hs * 64, VTB + (size_t)(((1 * 2 + b) * 4 + hs) * 64) * 8192, 4, r & 3, S / 4, 4, (i0 >> 7) - 2, 6, bias, F.lane); }
#pragma unroll
                for (int h = 0; h < 2; ++h) { const int qcol[1] = {C_QB + 2 * 256 + hs * 64}; const int qmu[1] = {i0 >> 4}; const LAS float* const bias[1] = {lb + 4112 + (2 * 4 + hs) * 129};
                  band_group<1, 64>(*(f32x4(*)[1][4])&o[h], *(float(*)[1])&mr[h], *(float(*)[1])&lr[h], qb_, qcol, qmu, C_KB + 2 * 256 + hs * 64, VTB + (size_t)(((2 * 2 + b) * 4 + hs) * 64) * 8192,
                                    16, r + 8 * h, S / 16, 1, (blk - 4) >> 1, 5, bias, F.lane); }
                bf16* yr = YB + (size_t)(b * S + i0 + r + 16 * t) * 256 + hs * 64; bf16* const yrow[2] = {yr, yr + 8 * 256};
                band_store<2>(o, lr, yrow, F.lane);
            }
        }
        __syncthreads();
    }
    SEAM(2);
    if (IN(3)) REP(3) {
#ifndef NO_P3A
        { int k256 = 256; asm volatile("" : "+s"(k256)); pg8::Gemm g{YB, Wb_t, k256}; pg8::StaticOrder So; So.init(T, D, F.G, (int)blockIdx.x);
          pg8::EpiGate<0> E{MERGED, GATES, 1024};
          pg8::gemm_phase<pg8::EpiGate<0>, pg8::StaticOrder, true, true>(F.lds + RING_OFF, g, So, E); }
#endif
        VM_WAIT(); __syncthreads();
#ifndef NO_P3B
        { pg8::Gemm g{YA, Wa_t, D}; pg8::StaticOrder So; So.init(T, D, F.G, (int)blockIdx.x);
          pg8::EpiGate<1> E{MERGED, GATES, 0};
          pg8::gemm_phase<pg8::EpiGate<1>, pg8::StaticOrder, true, true>(F.lds + RING_OFF, g, So, E); }
#endif
    }
    SEAM(3);
    if (IN(4)) REP(4) {
        pg8::Gemm g{MERGED, Wout_t, D}; pg8::StaticOrder So; So.init(T, D, F.G, (int)blockIdx.x);
        pg8::EpiX1 E{x, out};
        pg8::gemm_phase<pg8::EpiX1, pg8::StaticOrder, true, true>(F.lds + RING_OFF, g, So, E);
    }
    SEAM(4);
    if (IN(5)) REP(5) {
        const bool lastrep5 = (rep_ + 1 == 1 + ((MK_DUP >> 5) & 1));
        LAS int* lcnt = F.tbl + 72; LAS int* lbase = F.tbl + 104; LAS int* ebuf = F.tbl + 136; LAS int* pbuf = F.tbl + 392;
        LAS float* plog = (LAS float*)(F.lds + RING_OFF);
        LAS float* psq = plog + 8 * 64 * 32;
        LAS float* rstd_s = psq + 512;
        const int g = F.lane >> 4, e16 = F.lane & 15, w = F.wave;
        float wB[32][2];
#pragma unroll
        for (int sc = 0; sc < 32; ++sc) { const int k = 128 * w + 32 * (sc >> 3) + 8 * g + (sc & 7); const float gm = norm_ffn[k];
            wB[sc][0] = gm * router_w[(size_t)k * NE + e16]; wB[sc][1] = gm * router_w[(size_t)k * NE + 16 + e16]; }
        for (int tblk = F.vcu; tblk < T / 64; tblk += F.G) {
            if (F.tid < 32) lcnt[F.tid] = 0;
#pragma unroll 1
            for (int tile = 0; tile < 4; ++tile) {
                const GAS float* xr = (const GAS float*)out + (size_t)(tblk * 64 + tile * 16 + e16) * D + 128 * w + 8 * g;
                f32x4 v[4][2]; float sq = 0.f;
#pragma unroll
                for (int s4 = 0; s4 < 4; ++s4) { v[s4][0] = *(const GAS f32x4*)(xr + 32 * s4); v[s4][1] = *(const GAS f32x4*)(xr + 32 * s4 + 4); }
#pragma unroll
                for (int s4 = 0; s4 < 4; ++s4) sq += (v[s4][0].x * v[s4][0].x + v[s4][0].y * v[s4][0].y) + (v[s4][0].z * v[s4][0].z + v[s4][0].w * v[s4][0].w)
                                                   + (v[s4][1].x * v[s4][1].x + v[s4][1].y * v[s4][1].y) + (v[s4][1].z * v[s4][1].z + v[s4][1].w * v[s4][1].w);
                sq += __shfl_xor(sq, 16); sq += __shfl_xor(sq, 32);
                if (g == 0) psq[w * 64 + tile * 16 + e16] = sq;
                f32x4 a0 = (f32x4){0.f, 0.f, 0.f, 0.f}, a1 = (f32x4){0.f, 0.f, 0.f, 0.f};
#pragma unroll
                for (int s4 = 0; s4 < 4; ++s4)
#pragma unroll
                    for (int c = 0; c < 8; ++c) { const float av = v[s4][c >> 2][c & 3];
                        a0 = __builtin_amdgcn_mfma_f32_16x16x4f32(av, wB[s4 * 8 + c][0], a0, 0, 0, 0); a1 = __builtin_amdgcn_mfma_f32_16x16x4f32(av, wB[s4 * 8 + c][1], a1, 0, 0, 0); }
#pragma unroll
                for (int r = 0; r < 4; ++r) { LAS float* pr = plog + (size_t)(w * 64 + tile * 16 + 4 * g + r) * 32 + e16; pr[0] = a0[r]; pr[16] = a1[r]; }
            }
            __syncthreads();
            if (F.tid < 64) { float s = 0.f;
#pragma unroll
                for (int ww = 0; ww < 8; ++ww) s += psq[ww * 64 + F.tid];
                rstd_s[F.tid] = 1.f / sqrtf(s * (1.f / D) + EPS); }
            __syncthreads();
            { const int e = F.tid & 31; const float rbv = router_b[e];
#pragma unroll 1
              for (int i = 0; i < 4; ++i) { const int tl = (F.tid >> 5) + 16 * i; float lg = 0.f;
#pragma unroll
                for (int ww = 0; ww < 8; ++ww) lg += plog[(size_t)(ww * 64 + tl) * 32 + e];
                float val = lg * rstd_s[tl] + rbv; float tv[4]; int ti[4];
#pragma unroll
                for (int r = 0; r < 4; ++r) {
                    float bv = val; int bi = e;
#pragma unroll
                    for (int o = 1; o < 32; o <<= 1) { const float ov = __shfl_xor(bv, o); const int oi = __shfl_xor(bi, o); if (ov > bv || (ov == bv && oi < bi)) { bv = ov; bi = oi; } }
                    tv[r] = bv; ti[r] = bi; if (bi == e) val = -3.0e38f;
                }
                const float e1 = __expf(tv[1] - tv[0]), e2 = __expf(tv[2] - tv[0]), e3 = __expf(tv[3] - tv[0]); const float inv = 1.f / (1.f + e1 + e2 + e3);
                if (e < 4) { const float p = (e == 0 ? 1.f : e == 1 ? e1 : e == 2 ? e2 : e3) * inv; const int ex = (e == 0 ? ti[0] : e == 1 ? ti[1] : e == 2 ? ti[2] : ti[3]);
                    const int m = tblk * 64 + tl; topi[m * 4 + e] = ex; topp[m * 4 + e] = p;
                    const int li = tl * 4 + e; ebuf[li] = ex; pbuf[li] = __hip_atomic_fetch_add(&lcnt[ex], 1, __ATOMIC_RELAXED, __HIP_MEMORY_SCOPE_WORKGROUP); } } }
#pragma unroll 1
            for (int r = 0; r < 8; ++r) { const int tl = w * 8 + r; const float rstd = rstd_s[tl]; const size_t m = (size_t)tblk * 64 + tl;
                const GAS f32x4* xr4 = (const GAS f32x4*)(out + m * D) + F.lane; GAS unsigned long long* o8 = (GAS unsigned long long*)(XN + m * D) + F.lane;
#pragma unroll
                for (int j = 0; j < 4; ++j) { const f32x4 xv = xr4[64 * j]; const f32x4 gg = ((const GAS f32x4*)norm_ffn)[F.lane + 64 * j];
                    o8[64 * j] = (unsigned long long)pk2(xv.x * rstd * gg.x, xv.y * rstd * gg.y) | ((unsigned long long)pk2(xv.z * rstd * gg.z, xv.w * rstd * gg.w) << 32); } }
            __syncthreads();
            if (F.tid < 32) lbase[F.tid] = lastrep5 ? (int)__hip_atomic_fetch_add(cnt + F.tid, (unsigned)lcnt[F.tid], RLX_AGENT) : 0;
            __syncthreads();
            if (F.tid < 256) pos[tblk * 256 + F.tid] = lbase[ebuf[F.tid]] + pbuf[F.tid];
            __syncthreads();
        }
    }
    SEAM(5);
    if (IN(6) || IN(7) || IN(8)) {
        LAS int* loff = F.tbl; LAS int* ltoff = F.tbl + 36; LAS int* lc = F.tbl + 72;
        if (F.tid < 32) lc[F.tid] = (int)__hip_atomic_load(cnt + F.tid, RLX_AGENT);
        __syncthreads();
        if (F.tid == 0) { int a = 0, ta = 0; for (int e = 0; e < NE; ++e) { loff[e] = a; ltoff[e] = ta; const int c = lc[e]; a += c; ta += (c + 255) >> 8; } loff[NE] = a; ltoff[NE] = ta; }
        __syncthreads();
    }
    if (IN(6)) REP(6) {
        const LAS int* loff = F.tbl;
        for (int p = gw; p < T * 4; p += NGW) {
            const int e = topi[p], row = loff[e] + pos[p];
            if (F.lane == 0) slot[p] = row;
            const GAS u32x4* src = (const GAS u32x4*)(XN + (size_t)(p >> 2) * D) + F.lane; GAS u32x4* dst = (GAS u32x4*)(HS + (size_t)row * D) + F.lane;
            const u32x4 a = src[0], b = src[64]; dst[0] = a; dst[64] = b;
        }
    }
    SEAM(6);
    if (IN(7)) REP(7) {
        pg8::Gemm g{HS, Wgu_t, D}; pg8::GroupOrder So{F.tbl + 36, F.tbl, 8, F.G, (int)blockIdx.x, 0}; So.nunits = __builtin_amdgcn_readfirstlane(F.tbl[36 + NE]) * 8;
        pg8::EpiSwiglu E{ACT, b_gate, b_up};
        pg8::gemm_phase<pg8::EpiSwiglu, pg8::GroupOrder, true, true>(F.lds + RING_OFF, g, So, E);
    }
    SEAM(7);
    if (IN(8)) REP(8) {
        pg8::Gemm g{ACT, Wd_t, D}; pg8::GroupOrder So{F.tbl + 36, F.tbl, 4, F.G, (int)blockIdx.x, 0}; So.nunits = __builtin_amdgcn_readfirstlane(F.tbl[36 + NE]) * 4;
        pg8::EpiDown E{HS, b_down};
        pg8::gemm_phase<pg8::EpiDown, pg8::GroupOrder, true, true>(F.lds + RING_OFF, g, So, E);
    }
    SEAM(8);
#ifdef MK_XBAR
    for (int xb_ = 0; xb_ < MK_XBAR; ++xb_) xcd_barrier(bar);
#endif
    if (IN(9)) REP(9) {
        const bf16* ys = HS;
        float* dst9 = (rep_ + 1 < 1 + ((MK_DUP >> 9) & 1)) ? (float*)(ws + WS_ACT) : out;
        for (int m = gw; m < T; m += NGW) {
            GAS f32x4* xr = (GAS f32x4*)(out + (size_t)m * D) + F.lane; f32x4 v[4];
#pragma unroll
            for (int j = 0; j < 4; ++j) v[j] = xr[64 * j];
#pragma unroll
            for (int k = 0; k < 4; ++k) { const int r = slot[m * 4 + k]; const float p = topp[m * 4 + k]; const GAS unsigned long long* yr = (const GAS unsigned long long*)(ys + (size_t)r * D) + F.lane;
#pragma unroll
                for (int j = 0; j < 4; ++j) { const unsigned long long u = yr[64 * j]; const unsigned l32 = (unsigned)u, h32 = (unsigned)(u >> 32);
                    v[j].x += p * bflo(l32); v[j].y += p * bfhi(l32); v[j].z += p * bflo(h32); v[j].w += p * bfhi(h32); } }
            float s = 0.f;
#pragma unroll
            for (int j = 0; j < 4; ++j) s += (v[j].x * v[j].x + v[j].y * v[j].y) + (v[j].z * v[j].z + v[j].w * v[j].w);
            const float rstd = 1.f / sqrtf(wave_sum(s) * (1.f / D) + EPS);
#pragma unroll
            for (int j = 0; j < 4; ++j) { const f32x4 gg = ((const GAS f32x4*)norm_final)[F.lane + 64 * j]; f32x4 y; y.x = v[j].x * rstd * gg.x; y.y = v[j].y * rstd * gg.y; y.z = v[j].z * rstd * gg.z; y.w = v[j].w * rstd * gg.w; ((GAS f32x4*)(dst9 + (size_t)m * D) + F.lane)[64 * j] = y; }
        }
    }
#undef IN
#undef SEAM
}

extern "C" void kernel_launch(void* const* d_in, const int* in_sizes, int n_in, void* d_out, int out_size, void* d_ws, size_t ws_size, hipStream_t stream) {
    static int grid = 0;
    if (grid == 0) {
        if (n_in != 19 || in_sizes[0] != T * D || out_size != T * D || ws_size < WS_END) { fprintf(stderr, "kernel_launch: unexpected shapes (n_in %d, ws %zu); nothing launched\n", n_in, ws_size); grid = -1; return; }
        int dev = 0, cus = 0, per_cu = 0;
        if (hipGetDevice(&dev) != hipSuccess || hipDeviceGetAttribute(&cus, hipDeviceAttributeMultiprocessorCount, dev) != hipSuccess) { grid = -1; return; }
        if (hipFuncSetAttribute((const void*)mk_fwd, hipFuncAttributeMaxDynamicSharedMemorySize, LDS_BYTES) != hipSuccess) { fprintf(stderr, "kernel_launch: hipFuncSetAttribute failed\n"); grid = -1; return; }
        if (hipOccupancyMaxActiveBlocksPerMultiprocessor(&per_cu, (const void*)mk_fwd, NWAVES * 64, LDS_BYTES) != hipSuccess || per_cu < 1) { fprintf(stderr, "kernel_launch: occupancy query says %d blocks per CU\n", per_cu); }
        (void)hipGetLastError();
        grid = cus;
        if (grid != 256) fprintf(stderr, "kernel_launch: %d CUs (built and tuned for 256)\n", grid);
    }
    if (grid < 0) return;
    if (hipMemsetAsync((char*)d_ws + WS_CTL, 0, CTL_ZERO_BYTES, stream) != hipSuccess) return;
    Args a{};
    for (int i = 0; i < 19; ++i) a.in[i] = (const float*)d_in[i];
    a.out = (float*)d_out; a.ws = (unsigned char*)d_ws;
#if MK_MODE == 2
    a.ph_lo = 0; a.ph_hi = NPHASE; a.li = 0;
    hipLaunchKernelGGL(mk_fwd, dim3(grid), dim3(NWAVES * 64), LDS_BYTES, stream, a);
#else
    for (int ph = 0; ph < NPHASE; ++ph) { a.ph_lo = ph; a.ph_hi = ph + 1; a.li = ph; hipLaunchKernelGGL(mk_fwd, dim3(grid), dim3(NWAVES * 64), LDS_BYTES, stream, a); }
#endif
}
```

```cpp
#define MK_DUP 0
#include <hip/hip_runtime.h>
#include <stdint.h>
#include <stdio.h>

#ifndef FP8_SP2
#define FP8_SP2 true
#endif
#ifndef MK_MODE
#define MK_MODE 2
#endif

typedef unsigned short bf16;
typedef short bf16x8 __attribute__((ext_vector_type(8)));
typedef float f32x4 __attribute__((ext_vector_type(4)));
typedef float f32x2 __attribute__((ext_vector_type(2)));
typedef unsigned u32x4 __attribute__((ext_vector_type(4)));
typedef unsigned u32x2 __attribute__((ext_vector_type(2)));
#define GAS __attribute__((address_space(1)))
#define LAS __attribute__((address_space(3)))
typedef GAS unsigned gu32;

constexpr int T = 16384, S = 8192, D = 1024, NPROJ = 5888, NQKV = 3840, NGATE = 2048, NE = 32, TOPK = 4;
constexpr int C_QA = 0, C_KA = 1024, C_VA = 1280, C_QB = 1536, C_KB = 2304, C_VB = 3072;
constexpr float EPS = 1e-5f;
constexpr size_t MiB = 1u << 20;
constexpr size_t WS_CTL = 0, CTL_ZERO_BYTES = 1 * MiB;
constexpr size_t WS_TAB = 1 * MiB;
constexpr size_t WS_WIN = 2 * MiB;
constexpr size_t WS_WA = 14 * MiB;
constexpr size_t WS_WB = 16 * MiB;
constexpr size_t WS_WOUT = 17 * MiB;
constexpr size_t WS_RT = 19 * MiB;
constexpr size_t WS_WGU = 24 * MiB;
constexpr size_t WS_WD = 88 * MiB;
constexpr size_t WS_H2 = 120 * MiB;
constexpr size_t WS_HS = 136 * MiB;
constexpr size_t WS_ACT = 201 * MiB;
constexpr size_t WS_YS = 272 * MiB;
constexpr size_t WS_XN = 216 * MiB;
constexpr size_t WS_QKV = 248 * MiB;
constexpr size_t WS_GATES = 368 * MiB;
constexpr size_t WS_YA = 432 * MiB;
constexpr size_t WS_YB = 464 * MiB;
constexpr size_t WS_MERGED = 472 * MiB;
constexpr size_t WS_VT = 472 * MiB;
constexpr size_t WS_END = 506 * MiB;
constexpr int CW_CNT = 0;
constexpr int CW_BAR = 4096;

__device__ const unsigned char BKT_A[257] = {12,12,12,12,12,12,12,12,12,12,12,12,12,12,12,12,12,12,12,12,12,12,12,12,12,12,12,12,12,12,12,12,12,12,12,12,12,12,11,11,11,11,11,11,11,11,11,11,11,11,11,11,11,11,11,11,11,11,11,11,11,11,11,11,11,11,11,11,11,11,11,11,11,11,11,11,11,11,11,10,10,10,10,10,10,10,10,10,10,10,10,10,10,10,10,10,10,10,10,10,10,10,9,9,9,9,9,9,9,9,9,9,9,9,8,8,8,8,8,8,8,7,6,5,4,3,2,1,0,17,18,19,20,21,22,23,24,24,24,24,24,24,24,25,25,25,25,25,25,25,25,25,25,25,25,26,26,26,26,26,26,26,26,26,26,26,26,26,26,26,26,26,26,26,26,26,26,26,27,27,27,27,27,27,27,27,27,27,27,27,27,27,27,27,27,27,27,27,27,27,27,27,27,27,27,27,27,27,27,27,27,27,27,27,27,27,27,27,27,28,28,28,28,28,28,28,28,28,28,28,28,28,28,28,28,28,28,28,28,28,28,28,28,28,28,28,28,28,28,28,28,28,28,28,28,28,28};
__device__ const unsigned char BKT_B[3][129] = {
 {11,11,11,11,11,11,11,11,11,11,11,11,11,11,11,10,10,10,10,10,10,10,10,10,10,10,10,10,10,10,10,10,10,10,10,10,10,10,9,9,9,9,9,9,9,9,9,9,9,9,8,8,8,8,8,8,8,7,6,5,4,3,2,1,0,17,18,19,20,21,22,23,24,24,24,24,24,24,24,25,25,25,25,25,25,25,25,25,25,25,25,26,26,26,26,26,26,26,26,26,26,26,26,26,26,26,26,26,26,26,26,26,26,26,27,27,27,27,27,27,27,27,27,27,27,27,27,27,27},
 {13,13,13,13,13,13,13,13,13,13,13,13,13,13,13,13,13,13,13,13,13,13,13,12,12,12,12,12,12,12,12,12,12,12,12,12,12,12,12,12,12,12,11,11,11,11,11,11,11,11,11,11,10,10,10,10,10,10,9,9,9,8,8,4,0,20,24,24,25,25,25,26,26,26,26,26,26,27,27,27,27,27,27,27,27,27,27,28,28,28,28,28,28,28,28,28,28,28,28,28,28,28,28,28,28,28,29,29,29,29,29,29,29,29,29,29,29,29,29,29,29,29,29,29,29,29,29,29,29},
 {15,15,15,15,15,15,15,15,15,15,15,15,15,15,15,15,15,15,15,15,15,15,15,15,15,15,15,15,15,15,14,14,14,14,14,14,14,14,14,14,14,14,14,14,14,13,13,13,13,13,13,13,13,13,12,12,12,12,12,11,11,10,10,9,0,25,26,26,27,27,28,28,28,28,28,29,29,29,29,29,29,29,29,29,30,30,30,30,30,30,30,30,30,30,30,30,30,30,30,31,31,31,31,31,31,31,31,31,31,31,31,31,31,31,31,31,31,31,31,31,31,31,31,31,31,31,31,31,31}};

#define RLX_AGENT __ATOMIC_RELAXED, __HIP_MEMORY_SCOPE_AGENT
#define LDS_WAIT() asm volatile("s_waitcnt lgkmcnt(0)" ::: "memory")
#define VM_WAIT() asm volatile("s_waitcnt vmcnt(0)" ::: "memory")
__device__ __forceinline__ unsigned f2bf(float f) { unsigned u = __builtin_bit_cast(unsigned, f); return (u + 0x7fffu + ((u >> 16) & 1u)) >> 16; }
__device__ __forceinline__ unsigned pk2(float lo, float hi) { return f2bf(lo) | (f2bf(hi) << 16); }
__device__ __forceinline__ unsigned pk4_fp8(float a, float b, float c, float d) { unsigned w = 0; w = __builtin_amdgcn_cvt_pk_fp8_f32(a, b, w, false); w = __builtin_amdgcn_cvt_pk_fp8_f32(c, d, w, true); return w; }
__device__ __forceinline__ float bf2f(unsigned b) { return __builtin_bit_cast(float, b << 16); }
__device__ __forceinline__ float bflo(unsigned u) { return __builtin_bit_cast(float, u << 16); }
__device__ __forceinline__ float bfhi(unsigned u) { return __builtin_bit_cast(float, u & 0xffff0000u); }
__device__ __forceinline__ float wave_sum(float v) {
#pragma unroll
    for (int o = 1; o < 64; o <<= 1) v += __shfl_xor(v, o);
    return v;
}
__device__ __forceinline__ float sigm(float x) { return __builtin_amdgcn_rcpf(1.f + __builtin_amdgcn_exp2f(-1.4426950408889634f * x)); }

struct Tabs { float biasA[16][257]; float biasB[3][4][129]; };

namespace pg8 {
#define PG8_LAS __attribute__((address_space(3)))
typedef unsigned short bf16_t;
constexpr int BM = 256, BK = 64, HALF = 128, HTB = HALF * BK * 2, STAGE_BYTES = 8 * HTB, NXCD = 8, WGM = 8;
__host__ __device__ __forceinline__ int lds_byte(int r, int c) { const int st = (r >> 4) * 2 + (c >> 5), rr = r & 15, cc = c & 31, ob = rr * 64 + cc * 2; return st * 1024 + (ob ^ (((ob >> 9) & 1) << 5)); }
__host__ __device__ __forceinline__ void stage_rc(int b, int& R, int& C) { const int st = b / 1024, sb = b % 1024, swz = sb ^ (((sb >> 9) & 1) << 5); R = (st >> 1) * 16 + swz / 64; C = (st & 1) * 32 + (swz % 64) / 2; }
__host__ __device__ __forceinline__ int perm32(int rho) { const int n = rho >> 4, i = rho & 15; return 8 * (i >> 2) + 4 * n + (i & 3); }

struct Unit { int arow, brow, nrows, e; };
struct Gemm { const bf16_t* A; const bf16_t* Bt; int K; };

struct StaticOrder {
    int nM, nN, nwg, G, c;
    __device__ void init(int M, int N, int G_, int c_) { nM = M / BM; nN = N / BM; nwg = nM * nN; G = G_; c = c_; }
    __device__ bool next(int i, Unit& u) const {
        const long L = (long)i * G + c; if (L >= nwg) return false;
        int wgid = (int)L; { const int q = nwg / NXCD, r = nwg % NXCD, xcd = wgid % NXCD, off = wgid / NXCD; wgid = (xcd < r ? xcd * (q + 1) : r * (q + 1) + (xcd - r) * q) + off; }
        const int nig = WGM * nN, gid = wgid / nig, fm = gid * WGM, gsz = (nM - fm) < WGM ? (nM - fm) : WGM;
        u.arow = BM * (fm + ((wgid % nig) % gsz)); u.brow = BM * ((wgid % nig) / gsz); u.nrows = BM; u.e = 0; return true;
    }
    __device__ __forceinline__ void a_ready(const Unit&) const {}
    __device__ __forceinline__ void done(const Unit&) const {}
};
struct GroupOrder {
    const PG8_LAS int* toff; const PG8_LAS int* off; int NT, G, c, nunits;
    __device__ bool next(int i, Unit& u) const {
        const int L = i * G + c; if (L >= nunits) return false;
        const int mtg = L / NT, pn = L - mtg * NT;
        int e = 0;
        for (int j = 1; j < NE; ++j) e += (toff[j] <= mtg) ? 1 : 0;
        e = __builtin_amdgcn_readfirstlane(e);
        const int mt = mtg - __builtin_amdgcn_readfirstlane(toff[e]); const int o0 = __builtin_amdgcn_readfirstlane(off[e]), o1 = __builtin_amdgcn_readfirstlane(off[e + 1]);
        u.arow = o0 + BM * mt; const int rem = o1 - u.arow; u.nrows = rem < BM ? rem : BM; u.brow = (e * NT + pn) * BM; u.e = e; return true;
    }
    __device__ __forceinline__ void a_ready(const Unit&) const {}
    __device__ __forceinline__ void done(const Unit&) const {}
};

__device__ __forceinline__ unsigned cvt_pk_bf16(float lo, float hi) { unsigned r; asm volatile("v_cvt_pk_bf16_f32 %0, %1, %2" : "=v"(r) : "v"(lo), "v"(hi)); return r; }

struct EpiProj {
    static constexpr bool PERM = true, AFTER_DRAIN = false;
    bf16_t* qkv; bf16_t* gates; const float* bias; bf16_t* vta; bf16_t* vtb;
    __device__ __forceinline__ void operator()(const f32x4 (&acc)[2][2][4][2], const Unit& u, int wr, int wc, int fr, int fq) const {
        const int colt = u.brow; const bool isq = colt < NQKV; bf16_t* base = isq ? qkv : gates; const int ldc = isq ? NQKV : NGATE; const int cb = isq ? colt : colt - NQKV;
        const int row0 = u.arow + wr * 64 + fr, col0 = cb + wc * 32 + 8 * fq, bcol0 = colt + wc * 32 + 8 * fq;
        f32x4 bv[2][2];
#pragma unroll
        for (int bj = 0; bj < 2; ++bj)
#pragma unroll
            for (int n = 0; n < 2; ++n) bv[bj][n] = *(const f32x4*)(bias + bcol0 + bj * HALF + 4 * n);
        const bool isv = (colt == C_VA) || (colt >= C_VB && colt < NQKV);
        if (!isv) {
#pragma unroll
        for (int ai = 0; ai < 2; ++ai)
#pragma unroll
            for (int m = 0; m < 4; ++m) { bf16_t* rowp = base + (size_t)(row0 + ai * HALF + m * 16) * ldc + col0;
#pragma unroll
                for (int bj = 0; bj < 2; ++bj) { const f32x4 v0 = acc[ai][bj][m][0] + bv[bj][0], v1 = acc[ai][bj][m][1] + bv[bj][1];
                    u32x4 w; w.x = cvt_pk_bf16(v0[0], v0[1]); w.y = cvt_pk_bf16(v0[2], v0[3]); w.z = cvt_pk_bf16(v1[0], v1[1]); w.w = cvt_pk_bf16(v1[2], v1[3]);
                    *(u32x4*)(rowp + bj * HALF) = w; } }
        } else {
            const int gsel = (colt == C_VA) ? -1 : ((colt - C_VB) >> 8); const int sh = (gsel <= 0) ? 0 : (gsel == 1 ? 2 : 4);
            bf16_t* vb = (gsel < 0) ? vta : vtb + (size_t)gsel * (2 * 256 * 8192); const int c0 = wc * 32 + 8 * fq;
#pragma unroll
            for (int ai = 0; ai < 2; ++ai)
#pragma unroll
                for (int m = 0; m < 4; ++m) { const int row = row0 + ai * HALF + m * 16, b = row >> 13, s = row & 8191; const int mu = s >> sh; const int pos = ((s & ((1 << sh) - 1)) << (13 - sh)) + (mu & ~31) + (((mu & 15) >> 2) << 3) + (((mu >> 4) & 1) << 2) + (mu & 3);
                    bf16_t* vp = vb + (size_t)(b * 256 + c0) * 8192 + pos;
#pragma unroll
                    for (int bj = 0; bj < 2; ++bj)
#pragma unroll
                        for (int n = 0; n < 2; ++n) { const f32x4 v = acc[ai][bj][m][n] + bv[bj][n]; const unsigned w0 = cvt_pk_bf16(v[0], v[1]), w1 = cvt_pk_bf16(v[2], v[3]);
                            bf16_t* q = vp + (size_t)(bj * HALF + 4 * n) * 8192;
                            q[0] = (bf16_t)(w0 & 0xffffu); q[8192] = (bf16_t)(w0 >> 16); q[2 * 8192] = (bf16_t)(w1 & 0xffffu); q[3 * 8192] = (bf16_t)(w1 >> 16); } }
        }
    }
};
template <int MODE> struct EpiGate {
    static constexpr bool PERM = true, AFTER_DRAIN = false;
    bf16_t* out; const bf16_t* gates; int gcol0;
    __device__ __forceinline__ void operator()(const f32x4 (&acc)[2][2][4][2], const Unit& u, int wr, int wc, int fr, int fq) const {
        const int row0 = u.arow + wr * 64 + fr, col0 = u.brow + wc * 32 + 8 * fq;
#pragma unroll
        for (int ai = 0; ai < 2; ++ai)
#pragma unroll
            for (int m = 0; m < 4; ++m) { const size_t r = (size_t)(row0 + ai * HALF + m * 16);
#pragma unroll
                for (int bj = 0; bj < 2; ++bj) { const int c = col0 + bj * HALF;
                    const u32x4 gv = *(const u32x4*)(gates + r * NGATE + gcol0 + c); const f32x4 a0 = acc[ai][bj][m][0], a1 = acc[ai][bj][m][1];
                    float o[8]; o[0] = sigm(bflo(gv.x)) * a0[0]; o[1] = sigm(bfhi(gv.x)) * a0[1]; o[2] = sigm(bflo(gv.y)) * a0[2]; o[3] = sigm(bfhi(gv.y)) * a0[3];
                    o[4] = sigm(bflo(gv.z)) * a1[0]; o[5] = sigm(bfhi(gv.z)) * a1[1]; o[6] = sigm(bflo(gv.w)) * a1[2]; o[7] = sigm(bfhi(gv.w)) * a1[3];
                    if (MODE == 1) { const u32x4 mv = *(const u32x4*)(out + r * D + c);
                        o[0] += bflo(mv.x); o[1] += bfhi(mv.x); o[2] += bflo(mv.y); o[3] += bfhi(mv.y); o[4] += bflo(mv.z); o[5] += bfhi(mv.z); o[6] += bflo(mv.w); o[7] += bfhi(mv.w); }
                    u32x4 w; w.x = cvt_pk_bf16(o[0], o[1]); w.y = cvt_pk_bf16(o[2], o[3]); w.z = cvt_pk_bf16(o[4], o[5]); w.w = cvt_pk_bf16(o[6], o[7]);
                    *(u32x4*)(out + r * D + c) = w; }
                asm volatile("" ::: "memory"); }
    }
};
struct EpiX1 {
    static constexpr bool PERM = true, AFTER_DRAIN = false;
    const float* x; float* out;
    __device__ __forceinline__ void operator()(const f32x4 (&acc)[2][2][4][2], const Unit& u, int wr, int wc, int fr, int fq) const {
        const int row0 = u.arow + wr * 64 + fr, col0 = u.brow + wc * 32 + 8 * fq;
#pragma unroll
        for (int ai = 0; ai < 2; ++ai)
#pragma unroll
            for (int m = 0; m < 4; ++m) { const size_t r = (size_t)(row0 + ai * HALF + m * 16);
#pragma unroll
                for (int bj = 0; bj < 2; ++bj) { const size_t o = r * D + col0 + bj * HALF;
                    const f32x4 x0 = *(const f32x4*)(x + o), x1 = *(const f32x4*)(x + o + 4);
                    *(f32x4*)(out + o) = x0 + acc[ai][bj][m][0]; *(f32x4*)(out + o + 4) = x1 + acc[ai][bj][m][1]; }
                asm volatile("" ::: "memory"); }
    }
};
struct EpiSwiglu {
    static constexpr bool PERM = true, AFTER_DRAIN = false;
    unsigned char* act; const float* bg; const float* bu;
    __device__ __forceinline__ void operator()(const f32x4 (&acc)[2][2][4][2], const Unit& u, int wr, int wc, int fr, int fq) const {
        const int pn = (u.brow >> 8) & 7; const int col0 = pn * HALF + wc * 32 + 8 * fq; const int rl0 = wr * 64 + fr;
        const f32x4 g0 = *(const f32x4*)(bg + (size_t)u.e * D + col0), g1 = *(const f32x4*)(bg + (size_t)u.e * D + col0 + 4);
        const f32x4 u0 = *(const f32x4*)(bu + (size_t)u.e * D + col0), u1 = *(const f32x4*)(bu + (size_t)u.e * D + col0 + 4);
#pragma unroll
        for (int ai = 0; ai < 2; ++ai)
#pragma unroll
            for (int m = 0; m < 4; ++m) { const int rl = rl0 + ai * HALF + m * 16;
                const f32x4 ga = acc[ai][0][m][0] + g0, gb = acc[ai][0][m][1] + g1, ua = acc[ai][1][m][0] + u0, ub = acc[ai][1][m][1] + u1;
                float o[8];
#pragma unroll
                for (int j = 0; j < 4; ++j) { const float gt = fminf(ga[j], 7.f), up = fminf(fmaxf(ua[j], -7.f), 7.f); o[j] = gt * sigm(1.702f * gt) * (up + 1.f);
                    const float gt2 = fminf(gb[j], 7.f), up2 = fminf(fmaxf(ub[j], -7.f), 7.f); o[4 + j] = gt2 * sigm(1.702f * gt2) * (up2 + 1.f); }
                u32x2 w; w.x = pk4_fp8(o[0], o[1], o[2], o[3]); w.y = pk4_fp8(o[4], o[5], o[6], o[7]);
                if (rl < u.nrows) *(u32x2*)(act + (size_t)(u.arow + rl) * D + col0) = w; }
    }
};
struct EpiDown {
    static constexpr bool PERM = true, AFTER_DRAIN = false;
    bf16_t* ys; const float* bd;
    __device__ __forceinline__ void operator()(const f32x4 (&acc)[2][2][4][2], const Unit& u, int wr, int wc, int fr, int fq) const {
        const int pn = (u.brow >> 8) & 3; const int col0 = pn * BM + wc * 32 + 8 * fq; const int rl0 = wr * 64 + fr;
        f32x4 bv[2][2];
#pragma unroll
        for (int bj = 0; bj < 2; ++bj)
#pragma unroll
            for (int n = 0; n < 2; ++n) bv[bj][n] = *(const f32x4*)(bd + (size_t)u.e * D + col0 + bj * HALF + 4 * n);
#pragma unroll
        for (int ai = 0; ai < 2; ++ai)
#pragma unroll
            for (int m = 0; m < 4; ++m) { const int rl = rl0 + ai * HALF + m * 16; bf16_t* rowp = ys + (size_t)(u.arow + rl) * D + col0;
#pragma unroll
                for (int bj = 0; bj < 2; ++bj) { const f32x4 v0 = acc[ai][bj][m][0] + bv[bj][0], v1 = acc[ai][bj][m][1] + bv[bj][1];
                    u32x4 w; w.x = cvt_pk_bf16(v0[0], v0[1]); w.y = cvt_pk_bf16(v0[2], v0[3]); w.z = cvt_pk_bf16(v1[0], v1[1]); w.w = cvt_pk_bf16(v1[2], v1[3]);
                    if (rl < u.nrows) *(u32x4*)(rowp + bj * HALF) = w; } }
    }
};

typedef int i32x4_t __attribute__((ext_vector_type(4))); typedef int i32x8_t __attribute__((ext_vector_type(8)));
template <bool FP8> struct Frag;
template <> struct Frag<false> { bf16x8 v[2];
    __device__ __forceinline__ void ld(const PG8_LAS unsigned char* p) { v[0] = *(const PG8_LAS bf16x8*)p; v[1] = *(const PG8_LAS bf16x8*)(p + 1024); } };
template <> struct Frag<true> { i32x8_t v;
    __device__ __forceinline__ void ld(const PG8_LAS unsigned char* p) { const i32x4_t lo = *(const PG8_LAS i32x4_t*)p, hi = *(const PG8_LAS i32x4_t*)(p + 1024); v = __builtin_shufflevector(lo, hi, 0, 1, 2, 3, 4, 5, 6, 7); } };
__device__ __forceinline__ f32x4 mma_frag(const Frag<false>& w, const Frag<false>& x, f32x4 c) {
    c = __builtin_amdgcn_mfma_f32_16x16x32_bf16(w.v[0], x.v[0], c, 0, 0, 0); return __builtin_amdgcn_mfma_f32_16x16x32_bf16(w.v[1], x.v[1], c, 0, 0, 0); }
__device__ __forceinline__ f32x4 mma_frag(const Frag<true>& w, const Frag<true>& x, f32x4 c) {
    const int sa = 0x7A7A7A7A, sb = 0x7F7F7F7F;
    asm volatile("v_mfma_scale_f32_16x16x128_f8f6f4 %0, %1, %2, %0, %3, %4 op_sel_hi:[0,0,0]" : "+v"(c) : "v"(w.v), "v"(x.v), "v"(sa), "v"(sb));
    return c; }
template <class Epi, class Sched, bool ALIGN_EPI = false, bool SP2 = false, bool FP8 = false>
__device__ __forceinline__ void gemm_phase(PG8_LAS unsigned char* lds, const Gemm g, const Sched& S, const Epi& E) {
    const int tid = threadIdx.x, wid = __builtin_amdgcn_readfirstlane(tid >> 6), lane = tid & 63, wr = wid >> 2, wc = wid & 3, fr = lane & 15, fq = lane >> 4;
    const int K = g.K, nt = K / BK;
    unsigned voffA[2], voffB[2];
#pragma unroll
    for (int i = 0; i < 2; ++i) { int R, C; stage_rc(tid * 16 + i * 8192, R, C); const int Rb = Epi::PERM ? ((R & ~31) + perm32(R & 31)) : R;
        voffA[i] = (unsigned)(R * K + C) * 2u; voffB[i] = (unsigned)(Rb * K + C) * 2u; }
    const size_t kstep = (size_t)(BK * 2);
    const size_t hstep = (size_t)HALF * K * 2;
    const size_t rowb = (size_t)K * 2;
    const unsigned ldsw = (unsigned)wid * 1024u;
    const int aoff = lds_byte(wr * 64 + fr, fq * 8), boff = lds_byte(wc * 32 + fr, fq * 8);
#define PG8_SA(b, h) (((b) * 2 + (h)) * HTB)
#define PG8_SB(b, h) ((4 + (b) * 2 + (h)) * HTB)
#define PG8_STAGE(bufoff, gbase, voff) do { _Pragma("unroll") for (int _i = 0; _i < 2; ++_i) \
        __builtin_amdgcn_global_load_lds((const unsigned*)((const char*)(gbase) + (voff)[_i]), (PG8_LAS unsigned*)(lds + (bufoff) + ldsw + _i * 8192), 16, 0, 0); } while (0)
#define PG8_LDA(dst, b, h) do { _Pragma("unroll") for (int m = 0; m < 4; ++m) dst[m].ld(lds + PG8_SA(b, h) + aoff + m * 2048); } while (0)
#define PG8_LDB(dst, b, h) do { _Pragma("unroll") for (int n = 0; n < 2; ++n) dst[n].ld(lds + PG8_SB(b, h) + boff + n * 2048); } while (0)
#define PG8_MMA(ai, bj, At, Bt) do { __builtin_amdgcn_s_setprio(1); _Pragma("unroll") for (int m = 0; m < 4; ++m) _Pragma("unroll") for (int n = 0; n < 2; ++n) \
        acc[ai][bj][m][n] = mma_frag(Bt[n], At[m], acc[ai][bj][m][n]); __builtin_amdgcn_s_setprio(0); } while (0)
#define PG8_WAIT_V(n) asm volatile("s_waitcnt vmcnt(" #n ")" ::: "memory")
#define PG8_WAIT_L(n) asm volatile("s_waitcnt lgkmcnt(" #n ")" ::: "memory")
#define PG8_BAR __builtin_amdgcn_s_barrier()
#define PG8_SCHED __builtin_amdgcn_sched_barrier(0)
    Unit cur, nxt; int ui = 0;
    if (!S.next(0, cur)) return;
    f32x4 acc[2][2][4][2];
#pragma unroll
    for (int a = 0; a < 2; ++a)
#pragma unroll
        for (int b = 0; b < 2; ++b)
#pragma unroll
            for (int m = 0; m < 4; ++m)
#pragma unroll
                for (int n = 0; n < 2; ++n) acc[a][b][m][n] = (f32x4){0.f, 0.f, 0.f, 0.f};
    Frag<FP8> At[4], B0[2], B1[2];
    const char* cA = (const char*)g.A + (size_t)cur.arow * rowb; const char* cB = (const char*)g.Bt + (size_t)cur.brow * rowb;
    S.a_ready(cur);
    if constexpr (SP2) {
        PG8_STAGE(PG8_SB(0, 0), cB, voffB); PG8_STAGE(PG8_SB(0, 1), cB + hstep, voffB); PG8_STAGE(PG8_SA(0, 0), cA, voffA); PG8_STAGE(PG8_SA(0, 1), cA + hstep, voffA);
        if (wr == 1) PG8_BAR;
        PG8_WAIT_V(2); PG8_BAR;
        PG8_STAGE(PG8_SB(1, 0), cB + kstep, voffB); PG8_STAGE(PG8_SA(1, 0), cA + kstep, voffA); PG8_STAGE(PG8_SB(1, 1), cB + hstep + kstep, voffB);
        PG8_WAIT_V(6); PG8_BAR;
    } else {
        PG8_STAGE(PG8_SB(0, 0), cB, voffB); PG8_STAGE(PG8_SA(0, 0), cA, voffA); PG8_STAGE(PG8_SB(0, 1), cB + hstep, voffB); PG8_STAGE(PG8_SA(0, 1), cA + hstep, voffA);
        if (wr == 1) PG8_BAR;
        PG8_WAIT_V(4); PG8_BAR;
        PG8_STAGE(PG8_SB(1, 0), cB + kstep, voffB); PG8_STAGE(PG8_SA(1, 0), cA + kstep, voffA); PG8_STAGE(PG8_SB(1, 1), cB + hstep + kstep, voffB);
        PG8_WAIT_V(6); PG8_BAR;
    }
    for (;;) {
        const bool has_next = S.next(ui + 1, nxt);
        const char* nA = has_next ? (const char*)g.A + (size_t)nxt.arow * rowb : cA; const char* nB = has_next ? (const char*)g.Bt + (size_t)nxt.brow * rowb : cB;
        for (int t = 0; t < nt; t += 2) {
            const bool last = (t == nt - 2);
            const char* a1 = cA + (size_t)(t + 1) * kstep;
            const char* a2 = last ? nA : cA + (size_t)(t + 2) * kstep; const char* b2 = last ? nB : cB + (size_t)(t + 2) * kstep;
            const char* a3 = a2 + kstep; const char* b3 = b2 + kstep;
            if (last && has_next) S.a_ready(nxt);
            if constexpr (SP2) {
            PG8_LDB(B0, 0, 0); PG8_LDB(B1, 0, 1); PG8_SCHED; PG8_LDA(At, 0, 0); PG8_STAGE(PG8_SA(1, 1), a1 + hstep, voffA);
            PG8_WAIT_V(8); PG8_WAIT_L(0); PG8_BAR; PG8_MMA(0, 0, At, B0); PG8_MMA(0, 1, At, B1); PG8_BAR; PG8_SCHED;
            PG8_LDA(At, 0, 1); PG8_STAGE(PG8_SB(0, 0), b2, voffB); PG8_STAGE(PG8_SB(0, 1), b2 + hstep, voffB); PG8_STAGE(PG8_SA(0, 0), a2, voffA);
            PG8_WAIT_V(8); PG8_WAIT_L(0); PG8_BAR; PG8_MMA(1, 0, At, B0); PG8_MMA(1, 1, At, B1); PG8_BAR; PG8_SCHED;
            PG8_LDB(B0, 1, 0); PG8_LDB(B1, 1, 1); PG8_SCHED; PG8_LDA(At, 1, 0); PG8_STAGE(PG8_SA(0, 1), a2 + hstep, voffA);
            PG8_WAIT_V(8); PG8_WAIT_L(0); PG8_BAR; PG8_MMA(0, 0, At, B0); PG8_MMA(0, 1, At, B1); PG8_BAR; PG8_SCHED;
            PG8_LDA(At, 1, 1); PG8_STAGE(PG8_SB(1, 0), b3, voffB); PG8_STAGE(PG8_SB(1, 1), b3 + hstep, voffB); PG8_STAGE(PG8_SA(1, 0), a3, voffA);
            PG8_WAIT_V(8); PG8_WAIT_L(0); PG8_BAR; PG8_MMA(1, 0, At, B0); PG8_MMA(1, 1, At, B1); PG8_BAR; PG8_SCHED;
            } else {
            PG8_LDB(B0, 0, 0); PG8_SCHED; PG8_LDA(At, 0, 0); PG8_STAGE(PG8_SA(1, 1), a1 + hstep, voffA);
            PG8_WAIT_L(8); PG8_BAR; PG8_WAIT_L(0); PG8_MMA(0, 0, At, B0); PG8_BAR; PG8_SCHED;
            PG8_LDB(B1, 0, 1); PG8_STAGE(PG8_SB(0, 0), b2, voffB);
            PG8_BAR; PG8_WAIT_L(0); PG8_MMA(0, 1, At, B1); PG8_BAR;
            PG8_LDA(At, 0, 1); PG8_STAGE(PG8_SA(0, 0), a2, voffA);
            PG8_BAR; PG8_WAIT_L(0); PG8_MMA(1, 0, At, B0); PG8_BAR; PG8_SCHED;
            PG8_STAGE(PG8_SB(0, 1), b2 + hstep, voffB);
            PG8_WAIT_V(6); PG8_BAR; PG8_MMA(1, 1, At, B1); PG8_BAR;
            PG8_LDB(B0, 1, 0); PG8_SCHED; PG8_LDA(At, 1, 0); PG8_STAGE(PG8_SA(0, 1), a2 + hstep, voffA);
            PG8_WAIT_L(8); PG8_BAR; PG8_WAIT_L(0); PG8_MMA(0, 0, At, B0); PG8_BAR; PG8_SCHED;
            PG8_LDB(B1, 1, 1); PG8_STAGE(PG8_SB(1, 0), b3, voffB);
            PG8_BAR; PG8_WAIT_L(0); PG8_MMA(0, 1, At, B1); PG8_BAR;
            PG8_LDA(At, 1, 1); PG8_STAGE(PG8_SA(1, 0), a3, voffA);
            PG8_BAR; PG8_WAIT_L(0); PG8_MMA(1, 0, At, B0); PG8_BAR; PG8_SCHED;
            PG8_STAGE(PG8_SB(1, 1), b3 + hstep, voffB);
            PG8_WAIT_V(6); PG8_BAR; PG8_MMA(1, 1, At, B1); PG8_BAR;
            }
        }
        if constexpr (ALIGN_EPI) { if (wr == 0) PG8_BAR; }
        if constexpr (FP8) asm volatile("s_nop 15\n\ts_nop 15" ::: "memory");
        if constexpr (!Epi::AFTER_DRAIN) { E(acc, cur, wr, wc, fr, fq); S.done(cur); }
        if (!has_next) break;
#pragma unroll
        for (int a = 0; a < 2; ++a)
#pragma unroll
            for (int b = 0; b < 2; ++b)
#pragma unroll
                for (int m = 0; m < 4; ++m)
#pragma unroll
                    for (int n = 0; n < 2; ++n) acc[a][b][m][n] = (f32x4){0.f, 0.f, 0.f, 0.f};
        cur = nxt; cA = nA; cB = nB; ++ui;
        if constexpr (ALIGN_EPI) { if (wr == 1) PG8_BAR; }
    }
    PG8_WAIT_V(0);
    if constexpr (!ALIGN_EPI) { if (wr == 0) PG8_BAR; }
    PG8_BAR;
    if constexpr (Epi::AFTER_DRAIN) { E.fused(acc, cur, wr, wc, fr, fq, lds, wid, lane); S.done(cur); }
#undef PG8_SA
#undef PG8_SB
#undef PG8_STAGE
#undef PG8_LDA
#undef PG8_LDB
#undef PG8_MMA
#undef PG8_WAIT_V
#undef PG8_WAIT_L
#undef PG8_BAR
#undef PG8_SCHED
}

}

#define XB_TMO      128
#define XB_XCNT(j)  (256  + 64 * (j))
#define XB_XSUB(j)  (1280 + 64 * (j))
#define XB_XGEN(j)  (2304 + 64 * (j))
#define XB_TOP      3328
#define XB_TOPGEN   3392
#define XCD_BAR_WORDS 3456
#define XB_SPIN_CAP (1u << 18)
__device__ __forceinline__ unsigned xb_ld(unsigned* p)              { return __hip_atomic_load(p, __ATOMIC_RELAXED, __HIP_MEMORY_SCOPE_AGENT); }
__device__ __forceinline__ unsigned xb_add(unsigned* p, unsigned v) { return __hip_atomic_fetch_add(p, v, __ATOMIC_RELAXED, __HIP_MEMORY_SCOPE_AGENT); }
__device__ __forceinline__ unsigned xb_xcc_id() { return (unsigned)__builtin_amdgcn_s_getreg((3 << 11) | 20) & 0xFu; }
#define XB_SPIN(cond, bar) do { unsigned _sp = 0; while (cond) { __builtin_amdgcn_s_sleep(1); \
    if ((++_sp & 255u) == 0u) { if (xb_ld(&(bar)[XB_TMO])) break; if (_sp > XB_SPIN_CAP) { atomicAdd(&(bar)[XB_TMO], 1u); break; } } } } while (0)
struct XcdBarrier { unsigned* bar; unsigned x; volatile LAS unsigned* st; };
__device__ __forceinline__ XcdBarrier xcd_barrier_post(unsigned* bar, volatile LAS unsigned* st) {
    XcdBarrier b; b.bar = bar; b.x = xb_xcc_id(); b.st = st;
    if (threadIdx.x == 0) (void)xb_add(&bar[XB_XCNT(b.x)], 1u);
    return b;
}
__device__ __forceinline__ void xcd_barrier_complete(unsigned* bar, unsigned x, unsigned& nloc, unsigned& nx) {
    const unsigned G = gridDim.x * gridDim.y * gridDim.z;
    unsigned sum, cnt, mine, sp = 0u;
    for (;;) {
        sum = 0u; cnt = 0u; mine = 0u;
#pragma unroll
        for (unsigned j = 0; j < 16; ++j) { const unsigned c = xb_ld(&bar[XB_XCNT(j)]); sum += c; cnt += (c > 0u) ? 1u : 0u; mine = (j == x) ? c : mine; }
        if (sum == G) break;
        __builtin_amdgcn_s_sleep(1);
        if ((++sp & 255u) == 0u) { if (xb_ld(&bar[XB_TMO])) break; if (sp > XB_SPIN_CAP) { atomicAdd(&bar[XB_TMO], 1u); break; } }
    }
    nloc = mine > 0u ? mine : 1u; nx = cnt > 0u ? cnt : 1u;
}
__device__ __forceinline__ void xcd_barrier(const XcdBarrier& b) {
    asm volatile("s_waitcnt vmcnt(0)" ::: "memory");
    __syncthreads();
    if (threadIdx.x == 0) {
        unsigned* bar = b.bar;
        __builtin_amdgcn_s_waitcnt(0);
        unsigned nloc = b.st[0], nx = b.st[1];
        if (nloc == 0u) { xcd_barrier_complete(bar, b.x, nloc, nx); b.st[0] = nloc; b.st[1] = nx; }
        const unsigned old = xb_add(&bar[XB_XSUB(b.x)], 1u);
        const unsigned gen = old / nloc;
        if (old + 1u == (gen + 1u) * nloc) {
            __builtin_amdgcn_fence(__ATOMIC_RELEASE, "agent");
            asm volatile("s_waitcnt vmcnt(0)" ::: "memory");
            const unsigned og = xb_add(&bar[XB_TOP], 1u);
            const unsigned tg = og / nx;
            if (og + 1u == (tg + 1u) * nx) xb_add(&bar[XB_TOPGEN], 1u);
            else XB_SPIN(xb_ld(&bar[XB_TOPGEN]) == tg, bar);
            __builtin_amdgcn_fence(__ATOMIC_ACQUIRE, "agent");
            xb_add(&bar[XB_XGEN(b.x)], 1u);
            asm volatile("s_waitcnt vmcnt(0)" ::: "memory");
        } else {
            XB_SPIN(xb_ld(&bar[XB_XGEN(b.x)]) == gen, bar);
            __builtin_amdgcn_fence(__ATOMIC_ACQUIRE, "agent");
            asm volatile("s_waitcnt vmcnt(0)" ::: "memory");
        }
    }
    __syncthreads();
}

constexpr int NWAVES = 8;
constexpr int RING_OFF = 0, RING_BYTES = 131072;
constexpr int LDSCTL_OFF = RING_BYTES, MISC_OFF = LDSCTL_OFF + 320;
constexpr int TBL_OFF = LDSCTL_OFF + 1024;
constexpr int LDS_BYTES = 147456;

struct Frame {
    LAS unsigned char* lds; volatile LAS unsigned* MISC; LAS int* tbl; gu32* ctl;
    int tid, lane, wave, vcu, G;
};

__device__ __forceinline__ void p0_transpose_item(const float* W, int K, int N, bf16* WT, int k0, int n0, int orow0, LAS float* scr, int lane) {
#pragma unroll 8
    for (int i = 0; i < 32; ++i) { const int kk = 2 * i + (lane >> 5); scr[kk * 33 + (lane & 31)] = W[(size_t)(k0 + kk) * N + n0 + (lane & 31)]; }
    LDS_WAIT(); asm volatile("" ::: "memory");
    const int c = lane & 7;
#pragma unroll
    for (int j = 0; j < 4; ++j) { const int n = (lane >> 3) + 8 * j; const LAS float* s = scr + (8 * c) * 33 + n;
        u32x4 o; o.x = pk2(s[0 * 33], s[1 * 33]); o.y = pk2(s[2 * 33], s[3 * 33]); o.z = pk2(s[4 * 33], s[5 * 33]); o.w = pk2(s[6 * 33], s[7 * 33]);
        *(GAS u32x4*)(WT + (size_t)(orow0 + n) * K + k0 + 8 * c) = o; }
    LDS_WAIT(); asm volatile("" ::: "memory");
}
__device__ __forceinline__ void p0_transpose_item_fp8(const float* W, int K, int N, unsigned char* WT, int k0, int n0, int orow0, LAS float* scr, int lane) {
#pragma unroll 8
    for (int i = 0; i < 32; ++i) { const int kk = 2 * i + (lane >> 5); scr[kk * 33 + (lane & 31)] = W[(size_t)(k0 + kk) * N + n0 + (lane & 31)]; }
    LDS_WAIT(); asm volatile("" ::: "memory");
    const int c = lane & 7;
#pragma unroll
    for (int j = 0; j < 4; ++j) { const int n = (lane >> 3) + 8 * j; const LAS float* sp = scr + (8 * c) * 33 + n;
        u32x2 o; o.x = pk4_fp8(sp[0 * 33] * 32.f, sp[1 * 33] * 32.f, sp[2 * 33] * 32.f, sp[3 * 33] * 32.f); o.y = pk4_fp8(sp[4 * 33] * 32.f, sp[5 * 33] * 32.f, sp[6 * 33] * 32.f, sp[7 * 33] * 32.f);
        *(GAS u32x2*)(WT + (size_t)(orow0 + n) * K + k0 + 8 * c) = o; }
    LDS_WAIT(); asm volatile("" ::: "memory");
}
__device__ __forceinline__ void rms_row_to_bf16(const float* xrow, const float* g, bf16* orow, int lane) {
    const GAS f32x4* xr = (const GAS f32x4*)xrow + lane; f32x4 v[4]; float s = 0.f;
#pragma unroll
    for (int j = 0; j < 4; ++j) { v[j] = xr[64 * j]; s += (v[j].x * v[j].x + v[j].y * v[j].y) + (v[j].z * v[j].z + v[j].w * v[j].w); }
    const float rstd = 1.f / sqrtf(wave_sum(s) * (1.f / D) + EPS);
    GAS unsigned long long* o8 = (GAS unsigned long long*)orow + lane;
#pragma unroll
    for (int j = 0; j < 4; ++j) { const f32x4 gg = ((const GAS f32x4*)g)[lane + 64 * j];
        o8[64 * j] = (unsigned long long)pk2(v[j].x * rstd * gg.x, v[j].y * rstd * gg.y) | ((unsigned long long)pk2(v[j].z * rstd * gg.z, v[j].w * rstd * gg.w) << 32); }
}

constexpr float LOG2E = 1.4426950408889634f;
struct AttFrags { bf16x8 k0a, k0b, k1a, k1b, v[4]; };
template <int NH, int HW>
__device__ __forceinline__ void band_group(f32x4 (&o)[NH][4], float (&mrun)[NH], float (&lrun)[NH], const bf16* qkvb, const int (&qcol)[NH], const int (&qmu0)[NH], int kcol, const bf16* vt,
                                           int dil, int rho, int L, int qstep, int P0, int npairs, const LAS float* const (&bias)[NH], int lane) {
    const int t = lane & 15, g = lane >> 4;
    bf16x8 qf[NH][2]; int mu_t[NH];
#pragma unroll
    for (int h = 0; h < NH; ++h) { mu_t[h] = qmu0[h] + qstep * t; const bf16* qrow = qkvb + (size_t)(mu_t[h] * dil + rho) * NQKV + 8 * g + qcol[h];
        qf[h][0] = *(const bf16x8*)qrow; qf[h][1] = *(const bf16x8*)(qrow + 32); }
    int mu_lo = qmu0[0], mu_hi = qmu0[0];
#pragma unroll
    for (int h = 1; h < NH; ++h) { mu_lo = min(mu_lo, qmu0[h]); mu_hi = max(mu_hi, qmu0[h]); }
    mu_hi += 15 * qstep;
    const int npr = L >> 5;
    const bf16* kbase = qkvb + (size_t)rho * NQKV + kcol + 8 * g;
    const bf16* vtl = vt + (size_t)t * 8192 + (size_t)rho * L + 8 * g;
    auto load = [&](int P, AttFrags& f) {
        const int Pc = min(max(P, 0), npr - 1);
        const bf16* k0p = kbase + (size_t)((32 * Pc + t) * dil) * NQKV; const bf16* k1p = k0p + (size_t)(16 * dil) * NQKV;
        f.k0a = *(const bf16x8*)k0p; f.k0b = *(const bf16x8*)(k0p + 32); f.k1a = *(const bf16x8*)k1p; f.k1b = *(const bf16x8*)(k1p + 32);
#pragma unroll
        for (int db = 0; db < 4; ++db) f.v[db] = *(const bf16x8*)(vtl + (size_t)(16 * db) * 8192 + 32 * Pc);
    };
    AttFrags cur; load(P0, cur);
    for (int pp = 0; pp < npairs; ++pp) {
        const int P = P0 + pp;
        AttFrags nxt; load(P0 + min(pp + 1, npairs - 1), nxt);
        const bool need_mask = (32 * P - mu_hi < -HW) || (32 * P + 31 - mu_lo > HW) || (P < 0) || (P >= npr);
        const int kap0 = 32 * P + 4 * g;
#pragma unroll
        for (int h = 0; h < NH; ++h) {
            f32x4 s0 = (f32x4){0.f, 0.f, 0.f, 0.f}, s1 = (f32x4){0.f, 0.f, 0.f, 0.f};
            s0 = __builtin_amdgcn_mfma_f32_16x16x32_bf16(cur.k0a, qf[h][0], s0, 0, 0, 0); s0 = __builtin_amdgcn_mfma_f32_16x16x32_bf16(cur.k0b, qf[h][1], s0, 0, 0, 0);
            s1 = __builtin_amdgcn_mfma_f32_16x16x32_bf16(cur.k1a, qf[h][0], s1, 0, 0, 0); s1 = __builtin_amdgcn_mfma_f32_16x16x32_bf16(cur.k1b, qf[h][1], s1, 0, 0, 0);
            const int rel0 = kap0 - mu_t[h];
            float sc[8], p[8], ps = 0.f;
            if (need_mask) {
                bool vd[8];
#pragma unroll
                for (int j = 0; j < 8; ++j) { const int dj = (j < 4) ? j : 12 + j; const int rel = rel0 + dj, kap = kap0 + dj;
                    vd[j] = (rel >= -HW) && (rel <= HW) && (kap >= 0) && (kap < L);
                    const int idx = min(max(rel + HW, 0), 2 * HW);
                    const float sv = (j < 4) ? s0[j & 3] : s1[j & 3];
                    sc[j] = vd[j] ? (sv * (0.125f * LOG2E) + bias[h][idx]) : -3.0e38f; }
                float mx = fmaxf(fmaxf(fmaxf(sc[0], sc[1]), fmaxf(sc[2], sc[3])), fmaxf(fmaxf(sc[4], sc[5]), fmaxf(sc[6], sc[7])));
                mx = fmaxf(mx, __shfl_xor(mx, 16)); mx = fmaxf(mx, __shfl_xor(mx, 32));
                if (__any(mx > mrun[h])) { const float mn = fmaxf(mrun[h], mx), alpha = __builtin_amdgcn_exp2f(mrun[h] - mn); mrun[h] = mn; lrun[h] *= alpha;
#pragma unroll
                    for (int db = 0; db < 4; ++db) o[h][db] = o[h][db] * alpha; }
#pragma unroll
                for (int j = 0; j < 8; ++j) { p[j] = vd[j] ? __builtin_amdgcn_exp2f(sc[j] - mrun[h]) : 0.f; ps += p[j]; }
            } else {
#pragma unroll
                for (int j = 0; j < 8; ++j) { const int dj = (j < 4) ? j : 12 + j; const float sv = (j < 4) ? s0[j & 3] : s1[j & 3];
                    sc[j] = sv * (0.125f * LOG2E) + bias[h][rel0 + dj + HW]; }
                float mx = fmaxf(fmaxf(fmaxf(sc[0], sc[1]), fmaxf(sc[2], sc[3])), fmaxf(fmaxf(sc[4], sc[5]), fmaxf(sc[6], sc[7])));
                mx = fmaxf(mx, __shfl_xor(mx, 16)); mx = fmaxf(mx, __shfl_xor(mx, 32));
                if (__any(mx > mrun[h])) { const float mn = fmaxf(mrun[h], mx), alpha = __builtin_amdgcn_exp2f(mrun[h] - mn); mrun[h] = mn; lrun[h] *= alpha;
#pragma unroll
                    for (int db = 0; db < 4; ++db) o[h][db] = o[h][db] * alpha; }
#pragma unroll
                for (int j = 0; j < 8; ++j) { p[j] = __builtin_amdgcn_exp2f(sc[j] - mrun[h]); ps += p[j]; }
            }
            lrun[h] += ps;
            u32x4 pw; pw.x = pg8::cvt_pk_bf16(p[0], p[1]); pw.y = pg8::cvt_pk_bf16(p[2], p[3]); pw.z = pg8::cvt_pk_bf16(p[4], p[5]); pw.w = pg8::cvt_pk_bf16(p[6], p[7]);
            const bf16x8 pf = __builtin_bit_cast(bf16x8, pw);
#pragma unroll
            for (int db = 0; db < 4; ++db) o[h][db] = __builtin_amdgcn_mfma_f32_16x16x32_bf16(cur.v[db], pf, o[h][db], 0, 0, 0);
        }
        cur = nxt;
    }
}
template <int NH>
__device__ __forceinline__ void band_store(const f32x4 (&o)[NH][4], const float (&lrun)[NH], bf16* const (&yrow)[NH], int lane) {
    const int g = lane >> 4;
#pragma unroll
    for (int h = 0; h < NH; ++h) { float l = lrun[h]; l += __shfl_xor(l, 16); l += __shfl_xor(l, 32); const float inv = 1.f / l;
#pragma unroll
        for (int db = 0; db < 4; ++db) { u32x2 w; w.x = pg8::cvt_pk_bf16(o[h][db][0] * inv, o[h][db][1] * inv); w.y = pg8::cvt_pk_bf16(o[h][db][2] * inv, o[h][db][3] * inv);
            *(u32x2*)(yrow[h] + 16 * db + 4 * g) = w; } }
}

struct Args { const float* in[19]; float* out; unsigned char* ws; int ph_lo, ph_hi, li, pad; };
constexpr int NPHASE = 10;

__global__ void __launch_bounds__(NWAVES * 64, 2) mk_fwd(Args args) {
    extern __shared__ __attribute__((aligned(16))) unsigned char lds[];
    Frame F;
    F.lds = (LAS unsigned char*)lds; F.MISC = (volatile LAS unsigned*)(F.lds + MISC_OFF); F.tbl = (LAS int*)(F.lds + TBL_OFF);
    F.tid = threadIdx.x; F.lane = F.tid & 63; F.wave = __builtin_amdgcn_readfirstlane(F.tid >> 6);
    F.G = gridDim.x; { const int bx = blockIdx.x; F.vcu = (F.G % 8 == 0) ? (bx % 8) * (F.G / 8) + bx / 8 : bx; }
    unsigned char* ws = args.ws; F.ctl = (gu32*)(ws + WS_CTL);
    const float* x = args.in[0]; const float* norm_mix = args.in[1]; const float* w_in = args.in[2]; const float* b_in = args.in[3];
    const float* sinks = args.in[4]; const float* rel_bias = args.in[5]; const float* w_a = args.in[6]; const float* w_b = args.in[7];
    const float* w_out = args.in[8]; const float* norm_ffn = args.in[9]; const float* router_w = args.in[10]; const float* router_b = args.in[11];
    const float* w_gate = args.in[12]; const float* b_gate = args.in[13]; const float* w_up = args.in[14]; const float* b_up = args.in[15];
    const float* w_down = args.in[16]; const float* b_down = args.in[17]; const float* norm_final = args.in[18];
    float* out = args.out;
    Tabs* tb = (Tabs*)(ws + WS_TAB);
    bf16* Win_t = (bf16*)(ws + WS_WIN); bf16* Wa_t = (bf16*)(ws + WS_WA); bf16* Wb_t = (bf16*)(ws + WS_WB); bf16* Wout_t = (bf16*)(ws + WS_WOUT);
    unsigned char* Wgu8 = ws + WS_WGU; unsigned char* Wd8 = ws + WS_WD; unsigned char* H28 = ws + WS_H2; unsigned char* HS8 = ws + WS_HS; unsigned char* ACT8 = ws + WS_ACT; bf16* YS = (bf16*)(ws + WS_YS);
    int* topi = (int*)(ws + WS_RT); float* topp = (float*)(ws + WS_RT + 256 * 1024); int* slot = (int*)(ws + WS_RT + 512 * 1024); int* pos = (int*)(ws + WS_RT + 768 * 1024);
    bf16* XN = (bf16*)(ws + WS_XN); bf16* QKV = (bf16*)(ws + WS_QKV); bf16* GATES = (bf16*)(ws + WS_GATES); bf16* YA = (bf16*)(ws + WS_YA); bf16* YB = (bf16*)(ws + WS_YB);
    bf16* MERGED = (bf16*)(ws + WS_MERGED);
    gu32* cnt = F.ctl + CW_CNT;

    for (int u = F.tid; u < (LDS_BYTES - LDSCTL_OFF) / 4; u += NWAVES * 64) ((LAS unsigned*)(F.lds + LDSCTL_OFF))[u] = 0u;
    __syncthreads();
    XcdBarrier bar = xcd_barrier_post((unsigned*)(F.ctl + CW_BAR) + args.li * XCD_BAR_WORDS, F.MISC + 8);
    const int lo = args.ph_lo, hi = args.ph_hi;
#ifndef MK_SKIP
#define MK_SKIP 0
#endif
#define IN(k) (!((MK_SKIP >> (k)) & 1) && lo <= (k) && (k) < hi)
#ifndef MK_DUP
#define MK_DUP 0
#endif
#define REP(k) _Pragma("unroll") for (int rep_ = 0; rep_ < 1 + ((MK_DUP >> (k)) & 1); ++rep_)
#define SEAM(k) do { if (IN(k) && IN((k) + 1)) xcd_barrier(bar); } while (0)
    const int gw = F.vcu * NWAVES + F.wave, NGW = F.G * NWAVES;

    if (IN(0)) REP(0) {
        { const int i = blockIdx.x * (NWAVES * 64) + F.tid;
          if (i < 16 * 257) { const int h = i / 257, r = i % 257; tb->biasA[h][r] = rel_bias[BKT_A[r] * 28 + h]; }
          if (i < 12 * 129) { const int g = i / (4 * 129), hs = (i / 129) % 4, r = i % 129; tb->biasB[g][hs][r] = rel_bias[BKT_B[g][r] * 28 + 16 + 4 * g + hs]; } }
        LAS float* scr = (LAS float*)(F.lds + RING_OFF + F.wave * 16384);
        constexpr int I_IN = (D / 64) * (NPROJ / 32), I_A = (D / 64) * (D / 32), I_B = (256 / 64) * (D / 32), I_E = (D / 64) * (D / 32);
        constexpr int NITEMS = I_IN + 2 * I_A + I_B + 3 * NE * I_E;
        for (int it = gw; it < NITEMS; it += NGW) {
            int r = it;
            if (r < I_IN) { const int nb = NPROJ / 32; p0_transpose_item(w_in, D, NPROJ, Win_t, 64 * (r / nb), 32 * (r % nb), 32 * (r % nb), scr, F.lane); continue; } r -= I_IN;
            if (r < I_A) { const int nb = D / 32; p0_transpose_item(w_a, D, D, Wa_t, 64 * (r / nb), 32 * (r % nb), 32 * (r % nb), scr, F.lane); continue; } r -= I_A;
            if (r < I_A) { const int nb = D / 32; p0_transpose_item(w_out, D, D, Wout_t, 64 * (r / nb), 32 * (r % nb), 32 * (r % nb), scr, F.lane); continue; } r -= I_A;
            if (r < I_B) { const int nb = D / 32; p0_transpose_item(w_b, 256, D, Wb_t, 64 * (r / nb), 32 * (r % nb), 32 * (r % nb), scr, F.lane); continue; } r -= I_B;
            { const int e = r / (3 * I_E), q = r % (3 * I_E), which = q / I_E, ii = q % I_E, nb = D / 32, k0 = 64 * (ii / nb), n0 = 32 * (ii % nb);
              if (which == 0) p0_transpose_item_fp8(w_gate + (size_t)e * D * D, D, D, Wgu8, k0, n0, e * 2048 + (n0 >> 7) * 256 + (n0 & 127), scr, F.lane);
              else if (which == 1) p0_transpose_item_fp8(w_up + (size_t)e * D * D, D, D, Wgu8, k0, n0, e * 2048 + (n0 >> 7) * 256 + 128 + (n0 & 127), scr, F.lane);
              else p0_transpose_item_fp8(w_down + (size_t)e * D * D, D, D, Wd8, k0, n0, e * 1024 + n0, scr, F.lane); }
        }
        for (int m = gw; m < T; m += NGW) rms_row_to_bf16(x + (size_t)m * D, norm_mix, XN + (size_t)m * D, F.lane);
    }
    SEAM(0);
    if (IN(1)) REP(1) {
        pg8::Gemm g{XN, Win_t, D}; pg8::StaticOrder So; So.init(T, NPROJ, F.G, (int)blockIdx.x);
        pg8::EpiProj E{QKV, GATES, b_in, (bf16*)(ws + WS_VT), (bf16*)(ws + WS_VT) + (size_t)2 * 4 * 64 * 8192};
        pg8::gemm_phase<pg8::EpiProj, pg8::StaticOrder, true, true>(F.lds + RING_OFF, g, So, E);
    }
    SEAM(1);
    if (IN(2)) REP(2) {
        LAS float* lb = (LAS float*)(F.lds + RING_OFF);
        for (int i = F.tid; i < 4112 + 1548; i += NWAVES * 64) lb[i] = ((const float*)tb)[i] * LOG2E;
        __syncthreads();
        const bf16* VTA = (const bf16*)(ws + WS_VT); const bf16* VTB = VTA + (size_t)2 * 4 * 64 * 8192;
        for (int it = gw; it < 4096 + 2048; it += NGW) {
            const int t = F.lane & 15;
            if (it < 4096) {
                const int b = it >> 11, kvh = (it >> 9) & 3, qb = it & 511;
                f32x4 o[4][4]; float mr[4], lr[4];
#pragma unroll
                for (int h = 0; h < 4; ++h) { mr[h] = sinks[kvh * 4 + h] * LOG2E; lr[h] = (F.lane < 16) ? 1.f : 0.f;
#pragma unroll
                    for (int db = 0; db < 4; ++db) o[h][db] = (f32x4){0.f, 0.f, 0.f, 0.f}; }
                const int qcol[4] = {C_QA + (kvh * 4 + 0) * 64, C_QA + (kvh * 4 + 1) * 64, C_QA + (kvh * 4 + 2) * 64, C_QA + (kvh * 4 + 3) * 64};
                const int qmu[4] = {16 * qb, 16 * qb, 16 * qb, 16 * qb};
                const LAS float* const bias[4] = {lb + (kvh * 4 + 0) * 257, lb + (kvh * 4 + 1) * 257, lb + (kvh * 4 + 2) * 257, lb + (kvh * 4 + 3) * 257};
                band_group<4, 128>(o, mr, lr, QKV + (size_t)b * S * NQKV, qcol, qmu, C_KA + kvh * 64, VTA + (size_t)((b * 4 + kvh) * 64) * 8192, 1, 0, S, 1, (qb - 8) >> 1, 9, bias, F.lane);
                bf16* yr = YA + (size_t)(b * S + 16 * qb + t) * D + kvh * 256; bf16* const yrow[4] = {yr, yr + 64, yr + 128, yr + 192};
                band_store<4>(o, lr, yrow, F.lane);
            } else {
                const int j = it - 4096, r = j & 7, un = j >> 3, blk = un & 31, hs = (un >> 5) & 3, b = un >> 7, i0 = blk * 256;
                f32x4 o[2][4]; float mr[2], lr[2];
#pragma unroll
                for (int h = 0; h < 2; ++h) { mr[h] = -3.0e38f; lr[h] = 0.f;
#pragma unroll
                    for (int db = 0; db < 4; ++db) o[h][db] = (f32x4){0.f, 0.f, 0.f, 0.f}; }
                const bf16* qb_ = QKV + (size_t)b * S * NQKV;
                { const int qcol[2] = {C_QB + 0 * 256 + hs * 64, C_QB + 0 * 256 + hs * 64}; const int qmu[2] = {i0 + r, i0 + r + 8}; const LAS float* const bias[2] = {lb + 4112 + (0 * 4 + hs) * 129, lb + 4112 + (0 * 4 + hs) * 129};
                  band_group<2, 64>(o, mr, lr, qb_, qcol, qmu, C_KB + 0 * 256 + hs * 64, VTB + (size_t)(((0 * 2 + b) * 4 + hs) * 64) * 8192, 1, 0, S, 16, (i0 >> 5) - 2, 12, bias, F.lane); }
                { const int qcol[2] = {C_QB + 1 * 256 + hs * 64, C_QB + 1 * 256 + hs * 64}; const int qmu[2] = {(i0 + r) >> 2, (i0 + r + 8) >> 2}; const LAS float* const bias[2] = {lb + 4112 + (1 * 4 + hs) * 129, lb + 4112 + (1 * 4 + hs) * 129};
                  band_group<2, 64>(o, mr, lr, qb_, qcol, qmu, C_KB + 1 * 256 + hs * 64, VTB + (size_t)(((1 * 2 + b) * 4 + hs) * 64) * 8192, 4, r & 3, S / 4, 4, (i0 >> 7) - 2, 6, bias, F.lane); }
#pragma unroll
                for (int h = 0; h < 2; ++h) { const int qcol[1] = {C_QB + 2 * 256 + hs * 64}; const int qmu[1] = {i0 >> 4}; const LAS float* const bias[1] = {lb + 4112 + (2 * 4 + hs) * 129};
                  band_group<1, 64>(*(f32x4(*)[1][4])&o[h], *(float(*)[1])&mr[h], *(float(*)[1])&lr[h], qb_, qcol, qmu, C_KB + 2 * 256 + hs * 64, VTB + (size_t)(((2 * 2 + b) * 4 + hs) * 64) * 8192,
                                    16, r + 8 * h, S / 16, 1, (blk - 4) >> 1, 5, bias, F.lane); }
                bf16* yr = YB + (size_t)(b * S + i0 + r + 16 * t) * 256 + hs * 64; bf16* const yrow[2] = {yr, yr + 8 * 256};
                band_store<2>(o, lr, yrow, F.lane);
            }
        }
        __syncthreads();
    }
    SEAM(2);
    if (IN(3)) REP(3) {
#ifndef NO_P3A
        { int k256 = 256; asm volatile("" : "+s"(k256)); pg8::Gemm g{YB, Wb_t, k256}; pg8::StaticOrder So; So.init(T, D, F.G, (int)blockIdx.x);
          pg8::EpiGate<0> E{MERGED, GATES, 1024};
          pg8::gemm_phase<pg8::EpiGate<0>, pg8::StaticOrder, true, true>(F.lds + RING_OFF, g, So, E); }
#endif
        VM_WAIT(); __syncthreads();
#ifndef NO_P3B
        { pg8::Gemm g{YA, Wa_t, D}; pg8::StaticOrder So; So.init(T, D, F.G, (int)blockIdx.x);
          pg8::EpiGate<1> E{MERGED, GATES, 0};
          pg8::gemm_phase<pg8::EpiGate<1>, pg8::StaticOrder, true, true>(F.lds + RING_OFF, g, So, E); }
#endif
    }
    SEAM(3);
    if (IN(4)) REP(4) {
        pg8::Gemm g{MERGED, Wout_t, D}; pg8::StaticOrder So; So.init(T, D, F.G, (int)blockIdx.x);
        pg8::EpiX1 E{x, out};
        pg8::gemm_phase<pg8::EpiX1, pg8::StaticOrder, true, true>(F.lds + RING_OFF, g, So, E);
    }
    SEAM(4);
    if (IN(5)) REP(5) {
        const bool lastrep5 = (rep_ + 1 == 1 + ((MK_DUP >> 5) & 1));
        LAS int* lcnt = F.tbl + 72; LAS int* lbase = F.tbl + 104; LAS int* ebuf = F.tbl + 136; LAS int* pbuf = F.tbl + 392;
        LAS float* plog = (LAS float*)(F.lds + RING_OFF);
        LAS float* psq = plog + 8 * 64 * 32;
        LAS float* rstd_s = psq + 512;
        const int g = F.lane >> 4, e16 = F.lane & 15, w = F.wave;
        float wB[32][2];
#pragma unroll
        for (int sc = 0; sc < 32; ++sc) { const int k = 128 * w + 32 * (sc >> 3) + 8 * g + (sc & 7); const float gm = norm_ffn[k];
            wB[sc][0] = gm * router_w[(size_t)k * NE + e16]; wB[sc][1] = gm * router_w[(size_t)k * NE + 16 + e16]; }
        for (int tblk = F.vcu; tblk < T / 64; tblk += F.G) {
            if (F.tid < 32) lcnt[F.tid] = 0;
#pragma unroll 1
            for (int tile = 0; tile < 4; ++tile) {
                const GAS float* xr = (const GAS float*)out + (size_t)(tblk * 64 + tile * 16 + e16) * D + 128 * w + 8 * g;
                f32x4 v[4][2]; float sq = 0.f;
#pragma unroll
                for (int s4 = 0; s4 < 4; ++s4) { v[s4][0] = *(const GAS f32x4*)(xr + 32 * s4); v[s4][1] = *(const GAS f32x4*)(xr + 32 * s4 + 4); }
#pragma unroll
                for (int s4 = 0; s4 < 4; ++s4) sq += (v[s4][0].x * v[s4][0].x + v[s4][0].y * v[s4][0].y) + (v[s4][0].z * v[s4][0].z + v[s4][0].w * v[s4][0].w)
                                                   + (v[s4][1].x * v[s4][1].x + v[s4][1].y * v[s4][1].y) + (v[s4][1].z * v[s4][1].z + v[s4][1].w * v[s4][1].w);
                sq += __shfl_xor(sq, 16); sq += __shfl_xor(sq, 32);
                if (g == 0) psq[w * 64 + tile * 16 + e16] = sq;
                f32x4 a0 = (f32x4){0.f, 0.f, 0.f, 0.f}, a1 = (f32x4){0.f, 0.f, 0.f, 0.f};
#pragma unroll
                for (int s4 = 0; s4 < 4; ++s4)
#pragma unroll
                    for (int c = 0; c < 8; ++c) { const float av = v[s4][c >> 2][c & 3];
                        a0 = __builtin_amdgcn_mfma_f32_16x16x4f32(av, wB[s4 * 8 + c][0], a0, 0, 0, 0); a1 = __builtin_amdgcn_mfma_f32_16x16x4f32(av, wB[s4 * 8 + c][1], a1, 0, 0, 0); }
#pragma unroll
                for (int r = 0; r < 4; ++r) { LAS float* pr = plog + (size_t)(w * 64 + tile * 16 + 4 * g + r) * 32 + e16; pr[0] = a0[r]; pr[16] = a1[r]; }
            }
            __syncthreads();
            if (F.tid < 64) { float s = 0.f;
#pragma unroll
                for (int ww = 0; ww < 8; ++ww) s += psq[ww * 64 + F.tid];
                rstd_s[F.tid] = 1.f / sqrtf(s * (1.f / D) + EPS); }
            __syncthreads();
            { const int e = F.tid & 31; const float rbv = router_b[e];
#pragma unroll 1
              for (int i = 0; i < 4; ++i) { const int tl = (F.tid >> 5) + 16 * i; float lg = 0.f;
#pragma unroll
                for (int ww = 0; ww < 8; ++ww) lg += plog[(size_t)(ww * 64 + tl) * 32 + e];
                float val = lg * rstd_s[tl] + rbv; float tv[4]; int ti[4];
#pragma unroll
                for (int r = 0; r < 4; ++r) {
                    float bv = val; int bi = e;
#pragma unroll
                    for (int o = 1; o < 32; o <<= 1) { const float ov = __shfl_xor(bv, o); const int oi = __shfl_xor(bi, o); if (ov > bv || (ov == bv && oi < bi)) { bv = ov; bi = oi; } }
                    tv[r] = bv; ti[r] = bi; if (bi == e) val = -3.0e38f;
                }
                const float e1 = __expf(tv[1] - tv[0]), e2 = __expf(tv[2] - tv[0]), e3 = __expf(tv[3] - tv[0]); const float inv = 1.f / (1.f + e1 + e2 + e3);
                if (e < 4) { const float p = (e == 0 ? 1.f : e == 1 ? e1 : e == 2 ? e2 : e3) * inv; const int ex = (e == 0 ? ti[0] : e == 1 ? ti[1] : e == 2 ? ti[2] : ti[3]);
                    const int m = tblk * 64 + tl; topi[m * 4 + e] = ex; topp[m * 4 + e] = p;
                    const int li = tl * 4 + e; ebuf[li] = ex; pbuf[li] = __hip_atomic_fetch_add(&lcnt[ex], 1, __ATOMIC_RELAXED, __HIP_MEMORY_SCOPE_WORKGROUP); } } }
#pragma unroll 1
            for (int r = 0; r < 8; ++r) { const int tl = w * 8 + r; const float rstd = rstd_s[tl]; const size_t m = (size_t)tblk * 64 + tl;
                const GAS f32x4* xr4 = (const GAS f32x4*)(out + m * D) + F.lane; GAS unsigned* o4 = (GAS unsigned*)(H28 + m * D) + F.lane;
#pragma unroll
                for (int j = 0; j < 4; ++j) { const f32x4 xv = xr4[64 * j]; const f32x4 gg = ((const GAS f32x4*)norm_ffn)[F.lane + 64 * j];
                    o4[64 * j] = pk4_fp8(xv.x * rstd * gg.x, xv.y * rstd * gg.y, xv.z * rstd * gg.z, xv.w * rstd * gg.w); } }
            __syncthreads();
            if (F.tid < 32) lbase[F.tid] = lastrep5 ? (int)__hip_atomic_fetch_add(cnt + F.tid, (unsigned)lcnt[F.tid], RLX_AGENT) : 0;
            __syncthreads();
            if (F.tid < 256) pos[tblk * 256 + F.tid] = lbase[ebuf[F.tid]] + pbuf[F.tid];
            __syncthreads();
        }
    }
    SEAM(5);
    if (IN(6) || IN(7) || IN(8)) {
        LAS int* loff = F.tbl; LAS int* ltoff = F.tbl + 36; LAS int* lc = F.tbl + 72;
        if (F.tid < 32) lc[F.tid] = (int)__hip_atomic_load(cnt + F.tid, RLX_AGENT);
        __syncthreads();
        if (F.tid == 0) { int a = 0, ta = 0; for (int e = 0; e < NE; ++e) { loff[e] = a; ltoff[e] = ta; const int c = lc[e]; a += c; ta += (c + 255) >> 8; } loff[NE] = a; ltoff[NE] = ta; }
        __syncthreads();
    }
    if (IN(6)) REP(6) {
        const LAS int* loff = F.tbl;
        for (int p = gw; p < T * 4; p += NGW) {
            const int e = topi[p], row = loff[e] + pos[p];
            if (F.lane == 0) slot[p] = row;
            const GAS u32x4* src = (const GAS u32x4*)(H28 + (size_t)(p >> 2) * D) + F.lane; GAS u32x4* dst = (GAS u32x4*)(HS8 + (size_t)row * D) + F.lane;
            const u32x4 a = src[0]; dst[0] = a;
        }
    }
    SEAM(6);
    if (IN(7)) REP(7) {
        int k512 = D / 2; asm volatile("" : "+s"(k512));
        pg8::Gemm g{(const bf16*)HS8, (const bf16*)Wgu8, k512}; pg8::GroupOrder So{F.tbl + 36, F.tbl, 8, F.G, (int)blockIdx.x, 0}; So.nunits = __builtin_amdgcn_readfirstlane(F.tbl[36 + NE]) * 8;
        pg8::EpiSwiglu E{ACT8, b_gate, b_up};
        pg8::gemm_phase<pg8::EpiSwiglu, pg8::GroupOrder, true, FP8_SP2, true>(F.lds + RING_OFF, g, So, E);
    }
    SEAM(7);
    if (IN(8)) REP(8) {
        int k512 = D / 2; asm volatile("" : "+s"(k512));
        pg8::Gemm g{(const bf16*)ACT8, (const bf16*)Wd8, k512}; pg8::GroupOrder So{F.tbl + 36, F.tbl, 4, F.G, (int)blockIdx.x, 0}; So.nunits = __builtin_amdgcn_readfirstlane(F.tbl[36 + NE]) * 4;
        pg8::EpiDown E{YS, b_down};
        pg8::gemm_phase<pg8::EpiDown, pg8::GroupOrder, true, FP8_SP2, true>(F.lds + RING_OFF, g, So, E);
    }
    SEAM(8);
#ifdef MK_XBAR
    for (int xb_ = 0; xb_ < MK_XBAR; ++xb_) xcd_barrier(bar);
#endif
    if (IN(9)) REP(9) {
        const bf16* ys = YS;
        float* dst9 = (rep_ + 1 < 1 + ((MK_DUP >> 9) & 1)) ? (float*)(ws + WS_ACT) : out;
        for (int m = gw; m < T; m += NGW) {
            GAS f32x4* xr = (GAS f32x4*)(out + (size_t)m * D) + F.lane; f32x4 v[4];
#pragma unroll
            for (int j = 0; j < 4; ++j) v[j] = xr[64 * j];
#pragma unroll
            for (int k = 0; k < 4; ++k) { const int r = slot[m * 4 + k]; const float p = topp[m * 4 + k]; const GAS unsigned long long* yr = (const GAS unsigned long long*)(ys + (size_t)r * D) + F.lane;
#pragma unroll
                for (int j = 0; j < 4; ++j) { const unsigned long long u = yr[64 * j]; const unsigned l32 = (unsigned)u, h32 = (unsigned)(u >> 32);
                    v[j].x += p * bflo(l32); v[j].y += p * bfhi(l32); v[j].z += p * bflo(h32); v[j].w += p * bfhi(h32); } }
            float s = 0.f;
#pragma unroll
            for (int j = 0; j < 4; ++j) s += (v[j].x * v[j].x + v[j].y * v[j].y) + (v[j].z * v[j].z + v[j].w * v[j].w);
            const float rstd = 1.f / sqrtf(wave_sum(s) * (1.f / D) + EPS);
#pragma unroll
            for (int j = 0; j < 4; ++j) { const f32x4 gg = ((const GAS f32x4*)norm_final)[F.lane + 64 * j]; f32x4 y; y.x = v[j].x * rstd * gg.x; y.y = v[j].y * rstd * gg.y; y.z = v[j].z * rstd * gg.z; y.w = v[j].w * rstd * gg.w; ((GAS f32x4*)(dst9 + (size_t)m * D) + F.lane)[64 * j] = y; }
        }
    }
#undef IN
#undef SEAM
}

extern "C" void kernel_launch(void* const* d_in, const int* in_sizes, int n_in, void* d_out, int out_size, void* d_ws, size_t ws_size, hipStream_t stream) {
    static int grid = 0;
    if (grid == 0) {
        if (n_in != 19 || in_sizes[0] != T * D || out_size != T * D || ws_size < WS_END) { fprintf(stderr, "kernel_launch: unexpected shapes (n_in %d, ws %zu); nothing launched\n", n_in, ws_size); grid = -1; return; }
        int dev = 0, cus = 0, per_cu = 0;
        if (hipGetDevice(&dev) != hipSuccess || hipDeviceGetAttribute(&cus, hipDeviceAttributeMultiprocessorCount, dev) != hipSuccess) { grid = -1; return; }
        if (hipFuncSetAttribute((const void*)mk_fwd, hipFuncAttributeMaxDynamicSharedMemorySize, LDS_BYTES) != hipSuccess) { fprintf(stderr, "kernel_launch: hipFuncSetAttribute failed\n"); grid = -1; return; }
        if (hipOccupancyMaxActiveBlocksPerMultiprocessor(&per_cu, (const void*)mk_fwd, NWAVES * 64, LDS_BYTES) != hipSuccess || per_cu < 1) { fprintf(stderr, "kernel_launch: occupancy query says %d blocks per CU\n", per_cu); }
        (void)hipGetLastError();
        grid = cus;
        if (grid != 256) fprintf(stderr, "kernel_launch: %d CUs (built and tuned for 256)\n", grid);
    }
    if (grid < 0) return;
    if (hipMemsetAsync((char*)d_ws + WS_CTL, 0, CTL_ZERO_BYTES, stream) != hipSuccess) return;
    Args a{};
    for (int i = 0; i < 19; ++i) a.in[i] = (const float*)d_in[i];
    a.out = (float*)d_out; a.ws = (unsigned char*)d_ws;
#if MK_MODE == 2
    a.ph_lo = 0; a.ph_hi = NPHASE; a.li = 0;
    hipLaunchKernelGGL(mk_fwd, dim3(grid), dim3(NWAVES * 64), LDS_BYTES, stream, a);
#else
    for (int ph = 0; ph < NPHASE; ++ph) { a.ph_lo = ph; a.ph_hi = ph + 1; a.li = ph; hipLaunchKernelGGL(mk_fwd, dim3(grid), dim3(NWAVES * 64), LDS_BYTES, stream, a); }
#endif
}
```

```cpp
#define MK_DUP 0
#include <hip/hip_runtime.h>
#include <stdint.h>
#include <stdio.h>

#ifndef FP8_SP2
#define FP8_SP2 true
#endif
#ifndef MK_MODE
#define MK_MODE 2
#endif

typedef unsigned short bf16;
typedef short bf16x8 __attribute__((ext_vector_type(8)));
typedef float f32x4 __attribute__((ext_vector_type(4)));
typedef float f32x2 __attribute__((ext_vector_type(2)));
typedef unsigned u32x4 __attribute__((ext_vector_type(4)));
typedef unsigned u32x2 __attribute__((ext_vector_type(2)));
#define GAS __attribute__((address_space(1)))
#define LAS __attribute__((address_space(3)))
typedef GAS unsigned gu32;

constexpr int T = 16384, S = 8192, D = 1024, NPROJ = 5888, NQKV = 3840, NGATE = 2048, NE = 32, TOPK = 4;
constexpr int C_QA = 0, C_KA = 1024, C_VA = 1280, C_QB = 1536, C_KB = 2304, C_VB = 3072;
constexpr float EPS = 1e-5f;
constexpr size_t MiB = 1u << 20;
constexpr size_t WS_CTL = 0, CTL_ZERO_BYTES = 1 * MiB;
constexpr size_t WS_TAB = 1 * MiB;
constexpr size_t WS_WIN = 2 * MiB;
constexpr size_t WS_WA = 14 * MiB;
constexpr size_t WS_WB = 16 * MiB;
constexpr size_t WS_WOUT = 17 * MiB;
constexpr size_t WS_RT = 19 * MiB;
constexpr size_t WS_WGU = 24 * MiB;
constexpr size_t WS_WD = 88 * MiB;
constexpr size_t WS_H2 = 120 * MiB;
constexpr size_t WS_HS = 136 * MiB;
constexpr size_t WS_ACT = 201 * MiB;
constexpr size_t WS_YS = 272 * MiB;
constexpr size_t WS_XN = 216 * MiB;
constexpr size_t WS_QKV = 248 * MiB;
constexpr size_t WS_GATES = 368 * MiB;
constexpr size_t WS_YA = 432 * MiB;
constexpr size_t WS_YB = 464 * MiB;
constexpr size_t WS_MERGED = 472 * MiB;
constexpr size_t WS_VT = 472 * MiB;
constexpr size_t WS_END = 506 * MiB;
constexpr int CW_CNT = 0;
constexpr int CW_BAR = 4096;

__device__ const unsigned char BKT_A[257] = {12,12,12,12,12,12,12,12,12,12,12,12,12,12,12,12,12,12,12,12,12,12,12,12,12,12,12,12,12,12,12,12,12,12,12,12,12,12,11,11,11,11,11,11,11,11,11,11,11,11,11,11,11,11,11,11,11,11,11,11,11,11,11,11,11,11,11,11,11,11,11,11,11,11,11,11,11,11,11,10,10,10,10,10,10,10,10,10,10,10,10,10,10,10,10,10,10,10,10,10,10,10,9,9,9,9,9,9,9,9,9,9,9,9,8,8,8,8,8,8,8,7,6,5,4,3,2,1,0,17,18,19,20,21,22,23,24,24,24,24,24,24,24,25,25,25,25,25,25,25,25,25,25,25,25,26,26,26,26,26,26,26,26,26,26,26,26,26,26,26,26,26,26,26,26,26,26,26,27,27,27,27,27,27,27,27,27,27,27,27,27,27,27,27,27,27,27,27,27,27,27,27,27,27,27,27,27,27,27,27,27,27,27,27,27,27,27,27,27,28,28,28,28,28,28,28,28,28,28,28,28,28,28,28,28,28,28,28,28,28,28,28,28,28,28,28,28,28,28,28,28,28,28,28,28,28,28};
__device__ const unsigned char BKT_B[3][129] = {
 {11,11,11,11,11,11,11,11,11,11,11,11,11,11,11,10,10,10,10,10,10,10,10,10,10,10,10,10,10,10,10,10,10,10,10,10,10,10,9,9,9,9,9,9,9,9,9,9,9,9,8,8,8,8,8,8,8,7,6,5,4,3,2,1,0,17,18,19,20,21,22,23,24,24,24,24,24,24,24,25,25,25,25,25,25,25,25,25,25,25,25,26,26,26,26,26,26,26,26,26,26,26,26,26,26,26,26,26,26,26,26,26,26,26,27,27,27,27,27,27,27,27,27,27,27,27,27,27,27},
 {13,13,13,13,13,13,13,13,13,13,13,13,13,13,13,13,13,13,13,13,13,13,13,12,12,12,12,12,12,12,12,12,12,12,12,12,12,12,12,12,12,12,11,11,11,11,11,11,11,11,11,11,10,10,10,10,10,10,9,9,9,8,8,4,0,20,24,24,25,25,25,26,26,26,26,26,26,27,27,27,27,27,27,27,27,27,27,28,28,28,28,28,28,28,28,28,28,28,28,28,28,28,28,28,28,28,29,29,29,29,29,29,29,29,29,29,29,29,29,29,29,29,29,29,29,29,29,29,29},
 {15,15,15,15,15,15,15,15,15,15,15,15,15,15,15,15,15,15,15,15,15,15,15,15,15,15,15,15,15,15,14,14,14,14,14,14,14,14,14,14,14,14,14,14,14,13,13,13,13,13,13,13,13,13,12,12,12,12,12,11,11,10,10,9,0,25,26,26,27,27,28,28,28,28,28,29,29,29,29,29,29,29,29,29,30,30,30,30,30,30,30,30,30,30,30,30,30,30,30,31,31,31,31,31,31,31,31,31,31,31,31,31,31,31,31,31,31,31,31,31,31,31,31,31,31,31,31,31,31}};

#define RLX_AGENT __ATOMIC_RELAXED, __HIP_MEMORY_SCOPE_AGENT
#define LDS_WAIT() asm volatile("s_waitcnt lgkmcnt(0)" ::: "memory")
#define VM_WAIT() asm volatile("s_waitcnt vmcnt(0)" ::: "memory")
__device__ __forceinline__ unsigned f2bf(float f) { unsigned u = __builtin_bit_cast(unsigned, f); return (u + 0x7fffu + ((u >> 16) & 1u)) >> 16; }
__device__ __forceinline__ unsigned pk2(float lo, float hi) { return f2bf(lo) | (f2bf(hi) << 16); }
__device__ __forceinline__ unsigned pk4_fp8(float a, float b, float c, float d) { unsigned w = 0; w = __builtin_amdgcn_cvt_pk_fp8_f32(a, b, w, false); w = __builtin_amdgcn_cvt_pk_fp8_f32(c, d, w, true); return w; }
__device__ __forceinline__ float bf2f(unsigned b) { return __builtin_bit_cast(float, b << 16); }
__device__ __forceinline__ float bflo(unsigned u) { return __builtin_bit_cast(float, u << 16); }
__device__ __forceinline__ float bfhi(unsigned u) { return __builtin_bit_cast(float, u & 0xffff0000u); }
__device__ __forceinline__ float wave_sum(float v) {
#pragma unroll
    for (int o = 1; o < 64; o <<= 1) v += __shfl_xor(v, o);
    return v;
}
__device__ __forceinline__ float sigm(float x) { return __builtin_amdgcn_rcpf(1.f + __builtin_amdgcn_exp2f(-1.4426950408889634f * x)); }

struct Tabs { float biasA[16][257]; float biasB[3][4][129]; };

namespace pg8 {
#define PG8_LAS __attribute__((address_space(3)))
typedef unsigned short bf16_t;
constexpr int BM = 256, BK = 64, HALF = 128, HTB = HALF * BK * 2, STAGE_BYTES = 8 * HTB, NXCD = 8, WGM = 8;
__host__ __device__ __forceinline__ int lds_byte(int r, int c) { const int st = (r >> 4) * 2 + (c >> 5), rr = r & 15, cc = c & 31, ob = rr * 64 + cc * 2; return st * 1024 + (ob ^ (((ob >> 9) & 1) << 5)); }
__host__ __device__ __forceinline__ void stage_rc(int b, int& R, int& C) { const int st = b / 1024, sb = b % 1024, swz = sb ^ (((sb >> 9) & 1) << 5); R = (st >> 1) * 16 + swz / 64; C = (st & 1) * 32 + (swz % 64) / 2; }
__host__ __device__ __forceinline__ int perm32(int rho) { const int n = rho >> 4, i = rho & 15; return 8 * (i >> 2) + 4 * n + (i & 3); }

struct Unit { int arow, brow, nrows, e; };
struct Gemm { const bf16_t* A; const bf16_t* Bt; int K; };

struct StaticOrder {
    int nM, nN, nwg, G, c;
    __device__ void init(int M, int N, int G_, int c_) { nM = M / BM; nN = N / BM; nwg = nM * nN; G = G_; c = c_; }
    __device__ bool next(int i, Unit& u) const {
        const long L = (long)i * G + c; if (L >= nwg) return false;
        int wgid = (int)L; { const int q = nwg / NXCD, r = nwg % NXCD, xcd = wgid % NXCD, off = wgid / NXCD; wgid = (xcd < r ? xcd * (q + 1) : r * (q + 1) + (xcd - r) * q) + off; }
        const int nig = WGM * nN, gid = wgid / nig, fm = gid * WGM, gsz = (nM - fm) < WGM ? (nM - fm) : WGM;
        u.arow = BM * (fm + ((wgid % nig) % gsz)); u.brow = BM * ((wgid % nig) / gsz); u.nrows = BM; u.e = 0; return true;
    }
    __device__ __forceinline__ void a_ready(const Unit&) const {}
    __device__ __forceinline__ void done(const Unit&) const {}
};
struct GroupOrder {
    const PG8_LAS int* toff; const PG8_LAS int* off; int NT, G, c, nunits;
    __device__ bool next(int i, Unit& u) const {
        const int L = i * G + c; if (L >= nunits) return false;
        const int mtg = L / NT, pn = L - mtg * NT;
        int e = 0;
        for (int j = 1; j < NE; ++j) e += (toff[j] <= mtg) ? 1 : 0;
        e = __builtin_amdgcn_readfirstlane(e);
        const int mt = mtg - __builtin_amdgcn_readfirstlane(toff[e]); const int o0 = __builtin_amdgcn_readfirstlane(off[e]), o1 = __builtin_amdgcn_readfirstlane(off[e + 1]);
        u.arow = o0 + BM * mt; const int rem = o1 - u.arow; u.nrows = rem < BM ? rem : BM; u.brow = (e * NT + pn) * BM; u.e = e; return true;
    }
    __device__ __forceinline__ void a_ready(const Unit&) const {}
    __device__ __forceinline__ void done(const Unit&) const {}
};

__device__ __forceinline__ unsigned cvt_pk_bf16(float lo, float hi) { unsigned r; asm volatile("v_cvt_pk_bf16_f32 %0, %1, %2" : "=v"(r) : "v"(lo), "v"(hi)); return r; }

struct EpiProj {
    static constexpr bool PERM = true, AFTER_DRAIN = false;
    bf16_t* qkv; bf16_t* gates; const float* bias; bf16_t* vta; bf16_t* vtb;
    __device__ __forceinline__ void operator()(const f32x4 (&acc)[2][2][4][2], const Unit& u, int wr, int wc, int fr, int fq) const {
        const int colt = u.brow; const bool isq = colt < NQKV; bf16_t* base = isq ? qkv : gates; const int ldc = isq ? NQKV : NGATE; const int cb = isq ? colt : colt - NQKV;
        const int row0 = u.arow + wr * 64 + fr, col0 = cb + wc * 32 + 8 * fq, bcol0 = colt + wc * 32 + 8 * fq;
        f32x4 bv[2][2];
#pragma unroll
        for (int bj = 0; bj < 2; ++bj)
#pragma unroll
            for (int n = 0; n < 2; ++n) bv[bj][n] = *(const f32x4*)(bias + bcol0 + bj * HALF + 4 * n);
        const bool isv = (colt == C_VA) || (colt >= C_VB && colt < NQKV);
        if (!isv) {
#pragma unroll
        for (int ai = 0; ai < 2; ++ai)
#pragma unroll
            for (int m = 0; m < 4; ++m) { bf16_t* rowp = base + (size_t)(row0 + ai * HALF + m * 16) * ldc + col0;
#pragma unroll
                for (int bj = 0; bj < 2; ++bj) { const f32x4 v0 = acc[ai][bj][m][0] + bv[bj][0], v1 = acc[ai][bj][m][1] + bv[bj][1];
                    u32x4 w; w.x = cvt_pk_bf16(v0[0], v0[1]); w.y = cvt_pk_bf16(v0[2], v0[3]); w.z = cvt_pk_bf16(v1[0], v1[1]); w.w = cvt_pk_bf16(v1[2], v1[3]);
                    *(u32x4*)(rowp + bj * HALF) = w; } }
        } else {
            const int gsel = (colt == C_VA) ? -1 : ((colt - C_VB) >> 8); const int sh = (gsel <= 0) ? 0 : (gsel == 1 ? 2 : 4);
            bf16_t* vb = (gsel < 0) ? vta : vtb + (size_t)gsel * (2 * 256 * 8192); const int c0 = wc * 32 + 8 * fq;
#pragma unroll
            for (int ai = 0; ai < 2; ++ai)
#pragma unroll
                for (int m = 0; m < 4; ++m) { const int row = row0 + ai * HALF + m * 16, b = row >> 13, s = row & 8191; const int mu = s >> sh; const int pos = ((s & ((1 << sh) - 1)) << (13 - sh)) + (mu & ~31) + (((mu & 15) >> 2) << 3) + (((mu >> 4) & 1) << 2) + (mu & 3);
                    bf16_t* vp = vb + (size_t)(b * 256 + c0) * 8192 + pos;
#pragma unroll
                    for (int bj = 0; bj < 2; ++bj)
#pragma unroll
                        for (int n = 0; n < 2; ++n) { const f32x4 v = acc[ai][bj][m][n] + bv[bj][n]; const unsigned w0 = cvt_pk_bf16(v[0], v[1]), w1 = cvt_pk_bf16(v[2], v[3]);
                            bf16_t* q = vp + (size_t)(bj * HALF + 4 * n) * 8192;
                            q[0] = (bf16_t)(w0 & 0xffffu); q[8192] = (bf16_t)(w0 >> 16); q[2 * 8192] = (bf16_t)(w1 & 0xffffu); q[3 * 8192] = (bf16_t)(w1 >> 16); } }
        }
    }
};
template <int MODE> struct EpiGate {
    static constexpr bool PERM = true, AFTER_DRAIN = false;
    bf16_t* out; const bf16_t* gates; int gcol0;
    __device__ __forceinline__ void operator()(const f32x4 (&acc)[2][2][4][2], const Unit& u, int wr, int wc, int fr, int fq) const {
        const int row0 = u.arow + wr * 64 + fr, col0 = u.brow + wc * 32 + 8 * fq;
#pragma unroll
        for (int ai = 0; ai < 2; ++ai)
#pragma unroll
            for (int m = 0; m < 4; ++m) { const size_t r = (size_t)(row0 + ai * HALF + m * 16);
#pragma unroll
                for (int bj = 0; bj < 2; ++bj) { const int c = col0 + bj * HALF;
                    const u32x4 gv = *(const u32x4*)(gates + r * NGATE + gcol0 + c); const f32x4 a0 = acc[ai][bj][m][0], a1 = acc[ai][bj][m][1];
                    float o[8]; o[0] = sigm(bflo(gv.x)) * a0[0]; o[1] = sigm(bfhi(gv.x)) * a0[1]; o[2] = sigm(bflo(gv.y)) * a0[2]; o[3] = sigm(bfhi(gv.y)) * a0[3];
                    o[4] = sigm(bflo(gv.z)) * a1[0]; o[5] = sigm(bfhi(gv.z)) * a1[1]; o[6] = sigm(bflo(gv.w)) * a1[2]; o[7] = sigm(bfhi(gv.w)) * a1[3];
                    if (MODE == 1) { const u32x4 mv = *(const u32x4*)(out + r * D + c);
                        o[0] += bflo(mv.x); o[1] += bfhi(mv.x); o[2] += bflo(mv.y); o[3] += bfhi(mv.y); o[4] += bflo(mv.z); o[5] += bfhi(mv.z); o[6] += bflo(mv.w); o[7] += bfhi(mv.w); }
                    u32x4 w; w.x = cvt_pk_bf16(o[0], o[1]); w.y = cvt_pk_bf16(o[2], o[3]); w.z = cvt_pk_bf16(o[4], o[5]); w.w = cvt_pk_bf16(o[6], o[7]);
                    *(u32x4*)(out + r * D + c) = w; }
                asm volatile("" ::: "memory"); }
    }
};
struct EpiX1 {
    static constexpr bool PERM = true, AFTER_DRAIN = false;
    const float* x; float* out;
    __device__ __forceinline__ void operator()(const f32x4 (&acc)[2][2][4][2], const Unit& u, int wr, int wc, int fr, int fq) const {
        const int row0 = u.arow + wr * 64 + fr, col0 = u.brow + wc * 32 + 8 * fq;
#pragma unroll
        for (int ai = 0; ai < 2; ++ai)
#pragma unroll
            for (int m = 0; m < 4; ++m) { const size_t r = (size_t)(row0 + ai * HALF + m * 16);
#pragma unroll
                for (int bj = 0; bj < 2; ++bj) { const size_t o = r * D + col0 + bj * HALF;
                    const f32x4 x0 = *(const f32x4*)(x + o), x1 = *(const f32x4*)(x + o + 4);
                    *(f32x4*)(out + o) = x0 + acc[ai][bj][m][0]; *(f32x4*)(out + o + 4) = x1 + acc[ai][bj][m][1]; }
                asm volatile("" ::: "memory"); }
    }
};
struct EpiSwiglu {
    static constexpr bool PERM = true, AFTER_DRAIN = false;
    unsigned char* act; const float* bg; const float* bu;
    __device__ __forceinline__ void operator()(const f32x4 (&acc)[2][2][4][2], const Unit& u, int wr, int wc, int fr, int fq) const {
        const int pn = (u.brow >> 8) & 7; const int col0 = pn * HALF + wc * 32 + 8 * fq; const int rl0 = wr * 64 + fr;
        const f32x4 g0 = *(const f32x4*)(bg + (size_t)u.e * D + col0), g1 = *(const f32x4*)(bg + (size_t)u.e * D + col0 + 4);
        const f32x4 u0 = *(const f32x4*)(bu + (size_t)u.e * D + col0), u1 = *(const f32x4*)(bu + (size_t)u.e * D + col0 + 4);
#pragma unroll
        for (int ai = 0; ai < 2; ++ai)
#pragma unroll
            for (int m = 0; m < 4; ++m) { const int rl = rl0 + ai * HALF + m * 16;
                const f32x4 ga = acc[ai][0][m][0] + g0, gb = acc[ai][0][m][1] + g1, ua = acc[ai][1][m][0] + u0, ub = acc[ai][1][m][1] + u1;
                float o[8];
#pragma unroll
                for (int j = 0; j < 4; ++j) { const float gt = fminf(ga[j], 7.f), up = fminf(fmaxf(ua[j], -7.f), 7.f); o[j] = gt * sigm(1.702f * gt) * (up + 1.f);
                    const float gt2 = fminf(gb[j], 7.f), up2 = fminf(fmaxf(ub[j], -7.f), 7.f); o[4 + j] = gt2 * sigm(1.702f * gt2) * (up2 + 1.f); }
                u32x2 w; w.x = pk4_fp8(o[0], o[1], o[2], o[3]); w.y = pk4_fp8(o[4], o[5], o[6], o[7]);
                if (rl < u.nrows) *(u32x2*)(act + (size_t)(u.arow + rl) * D + col0) = w; }
    }
};
struct EpiDown {
    static constexpr bool PERM = true, AFTER_DRAIN = false;
    bf16_t* ys; const float* bd;
    __device__ __forceinline__ void operator()(const f32x4 (&acc)[2][2][4][2], const Unit& u, int wr, int wc, int fr, int fq) const {
        const int pn = (u.brow >> 8) & 3; const int col0 = pn * BM + wc * 32 + 8 * fq; const int rl0 = wr * 64 + fr;
        f32x4 bv[2][2];
#pragma unroll
        for (int bj = 0; bj < 2; ++bj)
#pragma unroll
            for (int n = 0; n < 2; ++n) bv[bj][n] = *(const f32x4*)(bd + (size_t)u.e * D + col0 + bj * HALF + 4 * n);
#pragma unroll
        for (int ai = 0; ai < 2; ++ai)
#pragma unroll
            for (int m = 0; m < 4; ++m) { const int rl = rl0 + ai * HALF + m * 16; bf16_t* rowp = ys + (size_t)(u.arow + rl) * D + col0;
#pragma unroll
                for (int bj = 0; bj < 2; ++bj) { const f32x4 v0 = acc[ai][bj][m][0] + bv[bj][0], v1 = acc[ai][bj][m][1] + bv[bj][1];
                    u32x4 w; w.x = cvt_pk_bf16(v0[0], v0[1]); w.y = cvt_pk_bf16(v0[2], v0[3]); w.z = cvt_pk_bf16(v1[0], v1[1]); w.w = cvt_pk_bf16(v1[2], v1[3]);
                    if (rl < u.nrows) *(u32x4*)(rowp + bj * HALF) = w; } }
    }
};

typedef int i32x4_t __attribute__((ext_vector_type(4))); typedef int i32x8_t __attribute__((ext_vector_type(8)));
template <bool FP8> struct Frag;
template <> struct Frag<false> { bf16x8 v[2];
    __device__ __forceinline__ void ld(const PG8_LAS unsigned char* p) { v[0] = *(const PG8_LAS bf16x8*)p; v[1] = *(const PG8_LAS bf16x8*)(p + 1024); } };
template <> struct Frag<true> { i32x8_t v;
    __device__ __forceinline__ void ld(const PG8_LAS unsigned char* p) { const i32x4_t lo = *(const PG8_LAS i32x4_t*)p, hi = *(const PG8_LAS i32x4_t*)(p + 1024); v = __builtin_shufflevector(lo, hi, 0, 1, 2, 3, 4, 5, 6, 7); } };
__device__ __forceinline__ f32x4 mma_frag(const Frag<false>& w, const Frag<false>& x, f32x4 c) {
    c = __builtin_amdgcn_mfma_f32_16x16x32_bf16(w.v[0], x.v[0], c, 0, 0, 0); return __builtin_amdgcn_mfma_f32_16x16x32_bf16(w.v[1], x.v[1], c, 0, 0, 0); }
__device__ __forceinline__ f32x4 mma_frag(const Frag<true>& w, const Frag<true>& x, f32x4 c) {
    const int sa = 0x7A7A7A7A, sb = 0x7F7F7F7F;
    asm volatile("v_mfma_scale_f32_16x16x128_f8f6f4 %0, %1, %2, %0, %3, %4 op_sel_hi:[0,0,0]" : "+v"(c) : "v"(w.v), "v"(x.v), "v"(sa), "v"(sb));
    return c; }
template <class Epi, class Sched, bool ALIGN_EPI = false, bool SP2 = false, bool FP8 = false>
__device__ __forceinline__ void gemm_phase(PG8_LAS unsigned char* lds, const Gemm g, const Sched& S, const Epi& E) {
    const int tid = threadIdx.x, wid = __builtin_amdgcn_readfirstlane(tid >> 6), lane = tid & 63, wr = wid >> 2, wc = wid & 3, fr = lane & 15, fq = lane >> 4;
    const int K = g.K, nt = K / BK;
    unsigned voffA[2], voffB[2];
#pragma unroll
    for (int i = 0; i < 2; ++i) { int R, C; stage_rc(tid * 16 + i * 8192, R, C); const int Rb = Epi::PERM ? ((R & ~31) + perm32(R & 31)) : R;
        voffA[i] = (unsigned)(R * K + C) * 2u; voffB[i] = (unsigned)(Rb * K + C) * 2u; }
    const size_t kstep = (size_t)(BK * 2);
    const size_t hstep = (size_t)HALF * K * 2;
    const size_t rowb = (size_t)K * 2;
    const unsigned ldsw = (unsigned)wid * 1024u;
    const int aoff = lds_byte(wr * 64 + fr, fq * 8), boff = lds_byte(wc * 32 + fr, fq * 8);
#define PG8_SA(b, h) (((b) * 2 + (h)) * HTB)
#define PG8_SB(b, h) ((4 + (b) * 2 + (h)) * HTB)
#define PG8_STAGE(bufoff, gbase, voff) do { _Pragma("unroll") for (int _i = 0; _i < 2; ++_i) \
        __builtin_amdgcn_global_load_lds((const unsigned*)((const char*)(gbase) + (voff)[_i]), (PG8_LAS unsigned*)(lds + (bufoff) + ldsw + _i * 8192), 16, 0, 0); } while (0)
#define PG8_LDA(dst, b, h) do { _Pragma("unroll") for (int m = 0; m < 4; ++m) dst[m].ld(lds + PG8_SA(b, h) + aoff + m * 2048); } while (0)
#define PG8_LDB(dst, b, h) do { _Pragma("unroll") for (int n = 0; n < 2; ++n) dst[n].ld(lds + PG8_SB(b, h) + boff + n * 2048); } while (0)
#define PG8_MMA(ai, bj, At, Bt) do { __builtin_amdgcn_s_setprio(1); _Pragma("unroll") for (int m = 0; m < 4; ++m) _Pragma("unroll") for (int n = 0; n < 2; ++n) \
        acc[ai][bj][m][n] = mma_frag(Bt[n], At[m], acc[ai][bj][m][n]); __builtin_amdgcn_s_setprio(0); } while (0)
#define PG8_WAIT_V(n) asm volatile("s_waitcnt vmcnt(" #n ")" ::: "memory")
#define PG8_WAIT_L(n) asm volatile("s_waitcnt lgkmcnt(" #n ")" ::: "memory")
#define PG8_BAR __builtin_amdgcn_s_barrier()
#define PG8_SCHED __builtin_amdgcn_sched_barrier(0)
    Unit cur, nxt; int ui = 0;
    if (!S.next(0, cur)) return;
    f32x4 acc[2][2][4][2];
#pragma unroll
    for (int a = 0; a < 2; ++a)
#pragma unroll
        for (int b = 0; b < 2; ++b)
#pragma unroll
            for (int m = 0; m < 4; ++m)
#pragma unroll
                for (int n = 0; n < 2; ++n) acc[a][b][m][n] = (f32x4){0.f, 0.f, 0.f, 0.f};
    Frag<FP8> At[4], B0[2], B1[2];
    const char* cA = (const char*)g.A + (size_t)cur.arow * rowb; const char* cB = (const char*)g.Bt + (size_t)cur.brow * rowb;
    S.a_ready(cur);
    if constexpr (SP2) {
        PG8_STAGE(PG8_SB(0, 0), cB, voffB); PG8_STAGE(PG8_SB(0, 1), cB + hstep, voffB); PG8_STAGE(PG8_SA(0, 0), cA, voffA); PG8_STAGE(PG8_SA(0, 1), cA + hstep, voffA);
        if (wr == 1) PG8_BAR;
        PG8_WAIT_V(2); PG8_BAR;
        PG8_STAGE(PG8_SB(1, 0), cB + kstep, voffB); PG8_STAGE(PG8_SA(1, 0), cA + kstep, voffA); PG8_STAGE(PG8_SB(1, 1), cB + hstep + kstep, voffB);
        PG8_WAIT_V(6); PG8_BAR;
    } else {
        PG8_STAGE(PG8_SB(0, 0), cB, voffB); PG8_STAGE(PG8_SA(0, 0), cA, voffA); PG8_STAGE(PG8_SB(0, 1), cB + hstep, voffB); PG8_STAGE(PG8_SA(0, 1), cA + hstep, voffA);
        if (wr == 1) PG8_BAR;
        PG8_WAIT_V(4); PG8_BAR;
        PG8_STAGE(PG8_SB(1, 0), cB + kstep, voffB); PG8_STAGE(PG8_SA(1, 0), cA + kstep, voffA); PG8_STAGE(PG8_SB(1, 1), cB + hstep + kstep, voffB);
        PG8_WAIT_V(6); PG8_BAR;
    }
    for (;;) {
        const bool has_next = S.next(ui + 1, nxt);
        const char* nA = has_next ? (const char*)g.A + (size_t)nxt.arow * rowb : cA; const char* nB = has_next ? (const char*)g.Bt + (size_t)nxt.brow * rowb : cB;
        for (int t = 0; t < nt; t += 2) {
            const bool last = (t == nt - 2);
            const char* a1 = cA + (size_t)(t + 1) * kstep;
            const char* a2 = last ? nA : cA + (size_t)(t + 2) * kstep; const char* b2 = last ? nB : cB + (size_t)(t + 2) * kstep;
            const char* a3 = a2 + kstep; const char* b3 = b2 + kstep;
            if (last && has_next) S.a_ready(nxt);
            if constexpr (SP2) {
            PG8_LDB(B0, 0, 0); PG8_LDB(B1, 0, 1); PG8_SCHED; PG8_LDA(At, 0, 0); PG8_STAGE(PG8_SA(1, 1), a1 + hstep, voffA);
            PG8_WAIT_V(8); PG8_WAIT_L(0); PG8_BAR; PG8_MMA(0, 0, At, B0); PG8_MMA(0, 1, At, B1); PG8_BAR; PG8_SCHED;
            PG8_LDA(At, 0, 1); PG8_STAGE(PG8_SB(0, 0), b2, voffB); PG8_STAGE(PG8_SB(0, 1), b2 + hstep, voffB); PG8_STAGE(PG8_SA(0, 0), a2, voffA);
            PG8_WAIT_V(8); PG8_WAIT_L(0); PG8_BAR; PG8_MMA(1, 0, At, B0); PG8_MMA(1, 1, At, B1); PG8_BAR; PG8_SCHED;
            PG8_LDB(B0, 1, 0); PG8_LDB(B1, 1, 1); PG8_SCHED; PG8_LDA(At, 1, 0); PG8_STAGE(PG8_SA(0, 1), a2 + hstep, voffA);
            PG8_WAIT_V(8); PG8_WAIT_L(0); PG8_BAR; PG8_MMA(0, 0, At, B0); PG8_MMA(0, 1, At, B1); PG8_BAR; PG8_SCHED;
            PG8_LDA(At, 1, 1); PG8_STAGE(PG8_SB(1, 0), b3, voffB); PG8_STAGE(PG8_SB(1, 1), b3 + hstep, voffB); PG8_STAGE(PG8_SA(1, 0), a3, voffA);
            PG8_WAIT_V(8); PG8_WAIT_L(0); PG8_BAR; PG8_MMA(1, 0, At, B0); PG8_MMA(1, 1, At, B1); PG8_BAR; PG8_SCHED;
            } else {
            PG8_LDB(B0, 0, 0); PG8_SCHED; PG8_LDA(At, 0, 0); PG8_STAGE(PG8_SA(1, 1), a1 + hstep, voffA);
            PG8_WAIT_L(8); PG8_BAR; PG8_WAIT_L(0); PG8_MMA(0, 0, At, B0); PG8_BAR; PG8_SCHED;
            PG8_LDB(B1, 0, 1); PG8_STAGE(PG8_SB(0, 0), b2, voffB);
            PG8_BAR; PG8_WAIT_L(0); PG8_MMA(0, 1, At, B1); PG8_BAR;
            PG8_LDA(At, 0, 1); PG8_STAGE(PG8_SA(0, 0), a2, voffA);
            PG8_BAR; PG8_WAIT_L(0); PG8_MMA(1, 0, At, B0); PG8_BAR; PG8_SCHED;
            PG8_STAGE(PG8_SB(0, 1), b2 + hstep, voffB);
            PG8_WAIT_V(6); PG8_BAR; PG8_MMA(1, 1, At, B1); PG8_BAR;
            PG8_LDB(B0, 1, 0); PG8_SCHED; PG8_LDA(At, 1, 0); PG8_STAGE(PG8_SA(0, 1), a2 + hstep, voffA);
            PG8_WAIT_L(8); PG8_BAR; PG8_WAIT_L(0); PG8_MMA(0, 0, At, B0); PG8_BAR; PG8_SCHED;
            PG8_LDB(B1, 1, 1); PG8_STAGE(PG8_SB(1, 0), b3, voffB);
            PG8_BAR; PG8_WAIT_L(0); PG8_MMA(0, 1, At, B1); PG8_BAR;
            PG8_LDA(At, 1, 1); PG8_STAGE(PG8_SA(1, 0), a3, voffA);
            PG8_BAR; PG8_WAIT_L(0); PG8_MMA(1, 0, At, B0); PG8_BAR; PG8_SCHED;
            PG8_STAGE(PG8_SB(1, 1), b3 + hstep, voffB);
            PG8_WAIT_V(6); PG8_BAR; PG8_MMA(1, 1, At, B1); PG8_BAR;
            }
        }
        if constexpr (ALIGN_EPI) { if (wr == 0) PG8_BAR; }
        if constexpr (FP8) {
#define PG8_ACC8(a, b) "+v"(acc[a][b][0][0]), "+v"(acc[a][b][0][1]), "+v"(acc[a][b][1][0]), "+v"(acc[a][b][1][1]), "+v"(acc[a][b][2][0]), "+v"(acc[a][b][2][1]), "+v"(acc[a][b][3][0]), "+v"(acc[a][b][3][1])
            asm volatile("s_nop 15\n\ts_nop 15" : PG8_ACC8(0, 0), PG8_ACC8(0, 1) :: "memory");
            asm volatile("" : PG8_ACC8(1, 0), PG8_ACC8(1, 1) :: "memory");
#undef PG8_ACC8
        }
        if constexpr (!Epi::AFTER_DRAIN) { E(acc, cur, wr, wc, fr, fq); S.done(cur); }
        if (!has_next) break;
#pragma unroll
        for (int a = 0; a < 2; ++a)
#pragma unroll
            for (int b = 0; b < 2; ++b)
#pragma unroll
                for (int m = 0; m < 4; ++m)
#pragma unroll
                    for (int n = 0; n < 2; ++n) acc[a][b][m][n] = (f32x4){0.f, 0.f, 0.f, 0.f};
        cur = nxt; cA = nA; cB = nB; ++ui;
        if constexpr (ALIGN_EPI) { if (wr == 1) PG8_BAR; }
    }
    PG8_WAIT_V(0);
    if constexpr (!ALIGN_EPI) { if (wr == 0) PG8_BAR; }
    PG8_BAR;
    if constexpr (Epi::AFTER_DRAIN) { E.fused(acc, cur, wr, wc, fr, fq, lds, wid, lane); S.done(cur); }
#undef PG8_SA
#undef PG8_SB
#undef PG8_STAGE
#undef PG8_LDA
#undef PG8_LDB
#undef PG8_MMA
#undef PG8_WAIT_V
#undef PG8_WAIT_L
#undef PG8_BAR
#undef PG8_SCHED
}

}

#define XB_TMO      128
#define XB_XCNT(j)  (256  + 64 * (j))
#define XB_XSUB(j)  (1280 + 64 * (j))
#define XB_XGEN(j)  (2304 + 64 * (j))
#define XB_TOP      3328
#define XB_TOPGEN   3392
#define XCD_BAR_WORDS 3456
#define XB_SPIN_CAP (1u << 18)
__device__ __forceinline__ unsigned xb_ld(unsigned* p)              { return __hip_atomic_load(p, __ATOMIC_RELAXED, __HIP_MEMORY_SCOPE_AGENT); }
__device__ __forceinline__ unsigned xb_add(unsigned* p, unsigned v) { return __hip_atomic_fetch_add(p, v, __ATOMIC_RELAXED, __HIP_MEMORY_SCOPE_AGENT); }
__device__ __forceinline__ unsigned xb_xcc_id() { return (unsigned)__builtin_amdgcn_s_getreg((3 << 11) | 20) & 0xFu; }
#define XB_SPIN(cond, bar) do { unsigned _sp = 0; while (cond) { __builtin_amdgcn_s_sleep(1); \
    if ((++_sp & 255u) == 0u) { if (xb_ld(&(bar)[XB_TMO])) break; if (_sp > XB_SPIN_CAP) { atomicAdd(&(bar)[XB_TMO], 1u); break; } } } } while (0)
struct XcdBarrier { unsigned* bar; unsigned x; volatile LAS unsigned* st; };
__device__ __forceinline__ XcdBarrier xcd_barrier_post(unsigned* bar, volatile LAS unsigned* st) {
    XcdBarrier b; b.bar = bar; b.x = xb_xcc_id(); b.st = st;
    if (threadIdx.x == 0) (void)xb_add(&bar[XB_XCNT(b.x)], 1u);
    return b;
}
__device__ __forceinline__ void xcd_barrier_complete(unsigned* bar, unsigned x, unsigned& nloc, unsigned& nx) {
    const unsigned G = gridDim.x * gridDim.y * gridDim.z;
    unsigned sum, cnt, mine, sp = 0u;
    for (;;) {
        sum = 0u; cnt = 0u; mine = 0u;
#pragma unroll
        for (unsigned j = 0; j < 16; ++j) { const unsigned c = xb_ld(&bar[XB_XCNT(j)]); sum += c; cnt += (c > 0u) ? 1u : 0u; mine = (j == x) ? c : mine; }
        if (sum == G) break;
        __builtin_amdgcn_s_sleep(1);
        if ((++sp & 255u) == 0u) { if (xb_ld(&bar[XB_TMO])) break; if (sp > XB_SPIN_CAP) { atomicAdd(&bar[XB_TMO], 1u); break; } }
    }
    nloc = mine > 0u ? mine : 1u; nx = cnt > 0u ? cnt : 1u;
}
__device__ __forceinline__ void xcd_barrier(const XcdBarrier& b) {
    asm volatile("s_waitcnt vmcnt(0)" ::: "memory");
    __syncthreads();
    if (threadIdx.x == 0) {
        unsigned* bar = b.bar;
        __builtin_amdgcn_s_waitcnt(0);
        unsigned nloc = b.st[0], nx = b.st[1];
        if (nloc == 0u) { xcd_barrier_complete(bar, b.x, nloc, nx); b.st[0] = nloc; b.st[1] = nx; }
        const unsigned old = xb_add(&bar[XB_XSUB(b.x)], 1u);
        const unsigned gen = old / nloc;
        if (old + 1u == (gen + 1u) * nloc) {
            __builtin_amdgcn_fence(__ATOMIC_RELEASE, "agent");
            asm volatile("s_waitcnt vmcnt(0)" ::: "memory");
            const unsigned og = xb_add(&bar[XB_TOP], 1u);
            const unsigned tg = og / nx;
            if (og + 1u == (tg + 1u) * nx) xb_add(&bar[XB_TOPGEN], 1u);
            else XB_SPIN(xb_ld(&bar[XB_TOPGEN]) == tg, bar);
            __builtin_amdgcn_fence(__ATOMIC_ACQUIRE, "agent");
            xb_add(&bar[XB_XGEN(b.x)], 1u);
            asm volatile("s_waitcnt vmcnt(0)" ::: "memory");
        } else {
            XB_SPIN(xb_ld(&bar[XB_XGEN(b.x)]) == gen, bar);
            __builtin_amdgcn_fence(__ATOMIC_ACQUIRE, "agent");
            asm volatile("s_waitcnt vmcnt(0)" ::: "memory");
        }
    }
    __syncthreads();
}

constexpr int NWAVES = 8;
constexpr int RING_OFF = 0, RING_BYTES = 131072;
constexpr int LDSCTL_OFF = RING_BYTES, MISC_OFF = LDSCTL_OFF + 320;
constexpr int TBL_OFF = LDSCTL_OFF + 1024;
constexpr int LDS_BYTES = 147456;

struct Frame {
    LAS unsigned char* lds; volatile LAS unsigned* MISC; LAS int* tbl; gu32* ctl;
    int tid, lane, wave, vcu, G;
};

__device__ __forceinline__ void p0_transpose_item(const float* W, int K, int N, bf16* WT, int k0, int n0, int orow0, LAS float* scr, int lane) {
#pragma unroll 8
    for (int i = 0; i < 32; ++i) { const int kk = 2 * i + (lane >> 5); scr[kk * 33 + (lane & 31)] = W[(size_t)(k0 + kk) * N + n0 + (lane & 31)]; }
    LDS_WAIT(); asm volatile("" ::: "memory");
    const int c = lane & 7;
#pragma unroll
    for (int j = 0; j < 4; ++j) { const int n = (lane >> 3) + 8 * j; const LAS float* s = scr + (8 * c) * 33 + n;
        u32x4 o; o.x = pk2(s[0 * 33], s[1 * 33]); o.y = pk2(s[2 * 33], s[3 * 33]); o.z = pk2(s[4 * 33], s[5 * 33]); o.w = pk2(s[6 * 33], s[7 * 33]);
        *(GAS u32x4*)(WT + (size_t)(orow0 + n) * K + k0 + 8 * c) = o; }
    LDS_WAIT(); asm volatile("" ::: "memory");
}
__device__ __forceinline__ void p0_transpose_item_fp8(const float* W, int K, int N, unsigned char* WT, int k0, int n0, int orow0, LAS float* scr, int lane) {
#pragma unroll 8
    for (int i = 0; i < 32; ++i) { const int kk = 2 * i + (lane >> 5); scr[kk * 33 + (lane & 31)] = W[(size_t)(k0 + kk) * N + n0 + (lane & 31)]; }
    LDS_WAIT(); asm volatile("" ::: "memory");
    const int c = lane & 7;
#pragma unroll
    for (int j = 0; j < 4; ++j) { const int n = (lane >> 3) + 8 * j; const LAS float* sp = scr + (8 * c) * 33 + n;
        u32x2 o; o.x = pk4_fp8(sp[0 * 33] * 32.f, sp[1 * 33] * 32.f, sp[2 * 33] * 32.f, sp[3 * 33] * 32.f); o.y = pk4_fp8(sp[4 * 33] * 32.f, sp[5 * 33] * 32.f, sp[6 * 33] * 32.f, sp[7 * 33] * 32.f);
        *(GAS u32x2*)(WT + (size_t)(orow0 + n) * K + k0 + 8 * c) = o; }
    LDS_WAIT(); asm volatile("" ::: "memory");
}
__device__ __forceinline__ void rms_row_to_bf16(const float* xrow, const float* g, bf16* orow, int lane) {
    const GAS f32x4* xr = (const GAS f32x4*)xrow + lane; f32x4 v[4]; float s = 0.f;
#pragma unroll
    for (int j = 0; j < 4; ++j) { v[j] = xr[64 * j]; s += (v[j].x * v[j].x + v[j].y * v[j].y) + (v[j].z * v[j].z + v[j].w * v[j].w); }
    const float rstd = 1.f / sqrtf(wave_sum(s) * (1.f / D) + EPS);
    GAS unsigned long long* o8 = (GAS unsigned long long*)orow + lane;
#pragma unroll
    for (int j = 0; j < 4; ++j) { const f32x4 gg = ((const GAS f32x4*)g)[lane + 64 * j];
        o8[64 * j] = (unsigned long long)pk2(v[j].x * rstd * gg.x, v[j].y * rstd * gg.y) | ((unsigned long long)pk2(v[j].z * rstd * gg.z, v[j].w * rstd * gg.w) << 32); }
}

__device__ __forceinline__ void rms_row_to_fp8(const float* xrow, const float* g, unsigned char* orow, int lane) {
    const GAS f32x4* xr = (const GAS f32x4*)xrow + lane; f32x4 v[4]; float s = 0.f;
#pragma unroll
    for (int j = 0; j < 4; ++j) { v[j] = xr[64 * j]; s += (v[j].x * v[j].x + v[j].y * v[j].y) + (v[j].z * v[j].z + v[j].w * v[j].w); }
    const float rstd = 1.f / sqrtf(wave_sum(s) * (1.f / D) + EPS);
    GAS unsigned* o4 = (GAS unsigned*)orow + lane;
#pragma unroll
    for (int j = 0; j < 4; ++j) { const f32x4 gg = ((const GAS f32x4*)g)[lane + 64 * j]; o4[64 * j] = pk4_fp8(v[j].x * rstd * gg.x, v[j].y * rstd * gg.y, v[j].z * rstd * gg.z, v[j].w * rstd * gg.w); }
}
constexpr float LOG2E = 1.4426950408889634f;
struct AttFrags { bf16x8 k0a, k0b, k1a, k1b, v[4]; };
template <int NH, int HW>
__device__ __forceinline__ void band_group(f32x4 (&o)[NH][4], float (&mrun)[NH], float (&lrun)[NH], const bf16* qkvb, const int (&qcol)[NH], const int (&qmu0)[NH], int kcol, const bf16* vt,
                                           int dil, int rho, int L, int qstep, int P0, int npairs, const LAS float* const (&bias)[NH], int lane) {
    const int t = lane & 15, g = lane >> 4;
    bf16x8 qf[NH][2]; int mu_t[NH];
#pragma unroll
    for (int h = 0; h < NH; ++h) { mu_t[h] = qmu0[h] + qstep * t; const bf16* qrow = qkvb + (size_t)(mu_t[h] * dil + rho) * NQKV + 8 * g + qcol[h];
        qf[h][0] = *(const bf16x8*)qrow; qf[h][1] = *(const bf16x8*)(qrow + 32); }
    int mu_lo = qmu0[0], mu_hi = qmu0[0];
#pragma unroll
    for (int h = 1; h < NH; ++h) { mu_lo = min(mu_lo, qmu0[h]); mu_hi = max(mu_hi, qmu0[h]); }
    mu_hi += 15 * qstep;
    const int npr = L >> 5;
    const bf16* kbase = qkvb + (size_t)rho * NQKV + kcol + 8 * g;
    const bf16* vtl = vt + (size_t)t * 8192 + (size_t)rho * L + 8 * g;
    auto load = [&](int P, AttFrags& f) {
        const int Pc = min(max(P, 0), npr - 1);
        const bf16* k0p = kbase + (size_t)((32 * Pc + t) * dil) * NQKV; const bf16* k1p = k0p + (size_t)(16 * dil) * NQKV;
        f.k0a = *(const bf16x8*)k0p; f.k0b = *(const bf16x8*)(k0p + 32); f.k1a = *(const bf16x8*)k1p; f.k1b = *(const bf16x8*)(k1p + 32);
#pragma unroll
        for (int db = 0; db < 4; ++db) f.v[db] = *(const bf16x8*)(vtl + (size_t)(16 * db) * 8192 + 32 * Pc);
    };
    AttFrags cur; load(P0, cur);
    for (int pp = 0; pp < npairs; ++pp) {
        const int P = P0 + pp;
        AttFrags nxt; load(P0 + min(pp + 1, npairs - 1), nxt);
        const bool need_mask = (32 * P - mu_hi < -HW) || (32 * P + 31 - mu_lo > HW) || (P < 0) || (P >= npr);
        const int kap0 = 32 * P + 4 * g;
#pragma unroll
        for (int h = 0; h < NH; ++h) {
            f32x4 s0 = (f32x4){0.f, 0.f, 0.f, 0.f}, s1 = (f32x4){0.f, 0.f, 0.f, 0.f};
            s0 = __builtin_amdgcn_mfma_f32_16x16x32_bf16(cur.k0a, qf[h][0], s0, 0, 0, 0); s0 = __builtin_amdgcn_mfma_f32_16x16x32_bf16(cur.k0b, qf[h][1], s0, 0, 0, 0);
            s1 = __builtin_amdgcn_mfma_f32_16x16x32_bf16(cur.k1a, qf[h][0], s1, 0, 0, 0); s1 = __builtin_amdgcn_mfma_f32_16x16x32_bf16(cur.k1b, qf[h][1], s1, 0, 0, 0);
            const int rel0 = kap0 - mu_t[h];
            float sc[8], p[8], ps = 0.f;
            if (need_mask) {
                bool vd[8];
#pragma unroll
                for (int j = 0; j < 8; ++j) { const int dj = (j < 4) ? j : 12 + j; const int rel = rel0 + dj, kap = kap0 + dj;
                    vd[j] = (rel >= -HW) && (rel <= HW) && (kap >= 0) && (kap < L);
                    const int idx = min(max(rel + HW, 0), 2 * HW);
                    const float sv = (j < 4) ? s0[j & 3] : s1[j & 3];
                    sc[j] = vd[j] ? (sv * (0.125f * LOG2E) + bias[h][idx]) : -3.0e38f; }
                float mx = fmaxf(fmaxf(fmaxf(sc[0], sc[1]), fmaxf(sc[2], sc[3])), fmaxf(fmaxf(sc[4], sc[5]), fmaxf(sc[6], sc[7])));
                mx = fmaxf(mx, __shfl_xor(mx, 16)); mx = fmaxf(mx, __shfl_xor(mx, 32));
                if (__any(mx > mrun[h])) { const float mn = fmaxf(mrun[h], mx), alpha = __builtin_amdgcn_exp2f(mrun[h] - mn); mrun[h] = mn; lrun[h] *= alpha;
#pragma unroll
                    for (int db = 0; db < 4; ++db) o[h][db] = o[h][db] * alpha; }
#pragma unroll
                for (int j = 0; j < 8; ++j) { p[j] = vd[j] ? __builtin_amdgcn_exp2f(sc[j] - mrun[h]) : 0.f; ps += p[j]; }
            } else {
#pragma unroll
                for (int j = 0; j < 8; ++j) { const int dj = (j < 4) ? j : 12 + j; const float sv = (j < 4) ? s0[j & 3] : s1[j & 3];
                    sc[j] = sv * (0.125f * LOG2E) + bias[h][rel0 + dj + HW]; }
                float mx = fmaxf(fmaxf(fmaxf(sc[0], sc[1]), fmaxf(sc[2], sc[3])), fmaxf(fmaxf(sc[4], sc[5]), fmaxf(sc[6], sc[7])));
                mx = fmaxf(mx, __shfl_xor(mx, 16)); mx = fmaxf(mx, __shfl_xor(mx, 32));
                if (__any(mx > mrun[h])) { const float mn = fmaxf(mrun[h], mx), alpha = __builtin_amdgcn_exp2f(mrun[h] - mn); mrun[h] = mn; lrun[h] *= alpha;
#pragma unroll
                    for (int db = 0; db < 4; ++db) o[h][db] = o[h][db] * alpha; }
#pragma unroll
                for (int j = 0; j < 8; ++j) { p[j] = __builtin_amdgcn_exp2f(sc[j] - mrun[h]); ps += p[j]; }
            }
            lrun[h] += ps;
            u32x4 pw; pw.x = pg8::cvt_pk_bf16(p[0], p[1]); pw.y = pg8::cvt_pk_bf16(p[2], p[3]); pw.z = pg8::cvt_pk_bf16(p[4], p[5]); pw.w = pg8::cvt_pk_bf16(p[6], p[7]);
            const bf16x8 pf = __builtin_bit_cast(bf16x8, pw);
#pragma unroll
            for (int db = 0; db < 4; ++db) o[h][db] = __builtin_amdgcn_mfma_f32_16x16x32_bf16(cur.v[db], pf, o[h][db], 0, 0, 0);
        }
        cur = nxt;
    }
}
template <int NH>
__device__ __forceinline__ void band_store(const f32x4 (&o)[NH][4], const float (&lrun)[NH], bf16* const (&yrow)[NH], int lane) {
    const int g = lane >> 4;
#pragma unroll
    for (int h = 0; h < NH; ++h) { float l = lrun[h]; l += __shfl_xor(l, 16); l += __shfl_xor(l, 32); const float inv = 1.f / l;
#pragma unroll
        for (int db = 0; db < 4; ++db) { u32x2 w; w.x = pg8::cvt_pk_bf16(o[h][db][0] * inv, o[h][db][1] * inv); w.y = pg8::cvt_pk_bf16(o[h][db][2] * inv, o[h][db][3] * inv);
            *(u32x2*)(yrow[h] + 16 * db + 4 * g) = w; } }
}

struct Args { const float* in[19]; float* out; unsigned char* ws; int ph_lo, ph_hi, li, pad; };
constexpr int NPHASE = 10;

__global__ void __launch_bounds__(NWAVES * 64, 2) mk_fwd(Args args) {
    extern __shared__ __attribute__((aligned(16))) unsigned char lds[];
    Frame F;
    F.lds = (LAS unsigned char*)lds; F.MISC = (volatile LAS unsigned*)(F.lds + MISC_OFF); F.tbl = (LAS int*)(F.lds + TBL_OFF);
    F.tid = threadIdx.x; F.lane = F.tid & 63; F.wave = __builtin_amdgcn_readfirstlane(F.tid >> 6);
    F.G = gridDim.x; { const int bx = blockIdx.x; F.vcu = (F.G % 8 == 0) ? (bx % 8) * (F.G / 8) + bx / 8 : bx; }
    unsigned char* ws = args.ws; F.ctl = (gu32*)(ws + WS_CTL);
    const float* x = args.in[0]; const float* norm_mix = args.in[1]; const float* w_in = args.in[2]; const float* b_in = args.in[3];
    const float* sinks = args.in[4]; const float* rel_bias = args.in[5]; const float* w_a = args.in[6]; const float* w_b = args.in[7];
    const float* w_out = args.in[8]; const float* norm_ffn = args.in[9]; const float* router_w = args.in[10]; const float* router_b = args.in[11];
    const float* w_gate = args.in[12]; const float* b_gate = args.in[13]; const float* w_up = args.in[14]; const float* b_up = args.in[15];
    const float* w_down = args.in[16]; const float* b_down = args.in[17]; const float* norm_final = args.in[18];
    float* out = args.out;
    Tabs* tb = (Tabs*)(ws + WS_TAB);
    bf16* Win_t = (bf16*)(ws + WS_WIN); bf16* Wa_t = (bf16*)(ws + WS_WA); bf16* Wb_t = (bf16*)(ws + WS_WB); bf16* Wout_t = (bf16*)(ws + WS_WOUT);
    unsigned char* Wgu8 = ws + WS_WGU; unsigned char* Wd8 = ws + WS_WD; unsigned char* H28 = ws + WS_H2; unsigned char* HS8 = ws + WS_HS; unsigned char* ACT8 = ws + WS_ACT; bf16* YS = (bf16*)(ws + WS_YS);
    int* topi = (int*)(ws + WS_RT); float* topp = (float*)(ws + WS_RT + 256 * 1024); int* slot = (int*)(ws + WS_RT + 512 * 1024); int* pos = (int*)(ws + WS_RT + 768 * 1024);
    bf16* XN = (bf16*)(ws + WS_XN); bf16* QKV = (bf16*)(ws + WS_QKV); bf16* GATES = (bf16*)(ws + WS_GATES); bf16* YA = (bf16*)(ws + WS_YA); bf16* YB = (bf16*)(ws + WS_YB);
    bf16* MERGED = (bf16*)(ws + WS_MERGED);
    gu32* cnt = F.ctl + CW_CNT;

    for (int u = F.tid; u < (LDS_BYTES - LDSCTL_OFF) / 4; u += NWAVES * 64) ((LAS unsigned*)(F.lds + LDSCTL_OFF))[u] = 0u;
    __syncthreads();
    XcdBarrier bar = xcd_barrier_post((unsigned*)(F.ctl + CW_BAR) + args.li * XCD_BAR_WORDS, F.MISC + 8);
    const int lo = args.ph_lo, hi = args.ph_hi;
#ifndef MK_SKIP
#define MK_SKIP 0
#endif
#define IN(k) (!((MK_SKIP >> (k)) & 1) && lo <= (k) && (k) < hi)
#ifndef MK_DUP
#define MK_DUP 0
#endif
#define REP(k) _Pragma("unroll") for (int rep_ = 0; rep_ < 1 + ((MK_DUP >> (k)) & 1); ++rep_)
#define SEAM(k) do { if (IN(k) && IN((k) + 1)) xcd_barrier(bar); } while (0)
    const int gw = F.vcu * NWAVES + F.wave, NGW = F.G * NWAVES;

    if (IN(0)) REP(0) {
        { const int i = blockIdx.x * (NWAVES * 64) + F.tid;
          if (i < 16 * 257) { const int h = i / 257, r = i % 257; tb->biasA[h][r] = rel_bias[BKT_A[r] * 28 + h]; }
          if (i < 12 * 129) { const int g = i / (4 * 129), hs = (i / 129) % 4, r = i % 129; tb->biasB[g][hs][r] = rel_bias[BKT_B[g][r] * 28 + 16 + 4 * g + hs]; } }
        LAS float* scr = (LAS float*)(F.lds + RING_OFF + F.wave * 16384);
        constexpr int I_IN = (D / 64) * (NPROJ / 32), I_A = (D / 64) * (D / 32), I_B = (256 / 64) * (D / 32), I_E = (D / 64) * (D / 32);
        constexpr int NITEMS = I_IN + 2 * I_A + I_B + 3 * NE * I_E;
        for (int it = gw; it < NITEMS; it += NGW) {
            int r = it;
            if (r < I_IN) { const int nb = NPROJ / 32; p0_transpose_item_fp8(w_in, D, NPROJ, (unsigned char*)Win_t, 64 * (r / nb), 32 * (r % nb), 32 * (r % nb), scr, F.lane); continue; } r -= I_IN;
            if (r < I_A) { const int nb = D / 32; p0_transpose_item(w_a, D, D, Wa_t, 64 * (r / nb), 32 * (r % nb), 32 * (r % nb), scr, F.lane); continue; } r -= I_A;
            if (r < I_A) { const int nb = D / 32; p0_transpose_item(w_out, D, D, Wout_t, 64 * (r / nb), 32 * (r % nb), 32 * (r % nb), scr, F.lane); continue; } r -= I_A;
            if (r < I_B) { const int nb = D / 32; p0_transpose_item(w_b, 256, D, Wb_t, 64 * (r / nb), 32 * (r % nb), 32 * (r % nb), scr, F.lane); continue; } r -= I_B;
            { const int e = r / (3 * I_E), q = r % (3 * I_E), which = q / I_E, ii = q % I_E, nb = D / 32, k0 = 64 * (ii / nb), n0 = 32 * (ii % nb);
              if (which == 0) p0_transpose_item_fp8(w_gate + (size_t)e * D * D, D, D, Wgu8, k0, n0, e * 2048 + (n0 >> 7) * 256 + (n0 & 127), scr, F.lane);
              else if (which == 1) p0_transpose_item_fp8(w_up + (size_t)e * D * D, D, D, Wgu8, k0, n0, e * 2048 + (n0 >> 7) * 256 + 128 + (n0 & 127), scr, F.lane);
              else p0_transpose_item_fp8(w_down + (size_t)e * D * D, D, D, Wd8, k0, n0, e * 1024 + n0, scr, F.lane); }
        }
        for (int m = gw; m < T; m += NGW) rms_row_to_fp8(x + (size_t)m * D, norm_mix, (unsigned char*)XN + (size_t)m * D, F.lane);
    }
    SEAM(0);
    if (IN(1)) REP(1) {
        int k512 = D / 2; asm volatile("" : "+s"(k512));
        pg8::Gemm g{XN, Win_t, k512}; pg8::StaticOrder So; So.init(T, NPROJ, F.G, (int)blockIdx.x);
        pg8::EpiProj E{QKV, GATES, b_in, (bf16*)(ws + WS_VT), (bf16*)(ws + WS_VT) + (size_t)2 * 4 * 64 * 8192};
        pg8::gemm_phase<pg8::EpiProj, pg8::StaticOrder, true, true, true>(F.lds + RING_OFF, g, So, E);
    }
    SEAM(1);
    if (IN(2)) REP(2) {
        LAS float* lb = (LAS float*)(F.lds + RING_OFF);
        for (int i = F.tid; i < 4112 + 1548; i += NWAVES * 64) lb[i] = ((const float*)tb)[i] * LOG2E;
        __syncthreads();
        const bf16* VTA = (const bf16*)(ws + WS_VT); const bf16* VTB = VTA + (size_t)2 * 4 * 64 * 8192;
        for (int it = gw; it < 4096 + 2048; it += NGW) {
            const int t = F.lane & 15;
            if (it < 4096) {
                const int b = it >> 11, kvh = (it >> 9) & 3, qb = it & 511;
                f32x4 o[4][4]; float mr[4], lr[4];
#pragma unroll
                for (int h = 0; h < 4; ++h) { mr[h] = sinks[kvh * 4 + h] * LOG2E; lr[h] = (F.lane < 16) ? 1.f : 0.f;
#pragma unroll
                    for (int db = 0; db < 4; ++db) o[h][db] = (f32x4){0.f, 0.f, 0.f, 0.f}; }
                const int qcol[4] = {C_QA + (kvh * 4 + 0) * 64, C_QA + (kvh * 4 + 1) * 64, C_QA + (kvh * 4 + 2) * 64, C_QA + (kvh * 4 + 3) * 64};
                const int qmu[4] = {16 * qb, 16 * qb, 16 * qb, 16 * qb};
                const LAS float* const bias[4] = {lb + (kvh * 4 + 0) * 257, lb + (kvh * 4 + 1) * 257, lb + (kvh * 4 + 2) * 257, lb + (kvh * 4 + 3) * 257};
                band_group<4, 128>(o, mr, lr, QKV + (size_t)b * S * NQKV, qcol, qmu, C_KA + kvh * 64, VTA + (size_t)((b * 4 + kvh) * 64) * 8192, 1, 0, S, 1, (qb - 8) >> 1, 9, bias, F.lane);
                bf16* yr = YA + (size_t)(b * S + 16 * qb + t) * D + kvh * 256; bf16* const yrow[4] = {yr, yr + 64, yr + 128, yr + 192};
                band_store<4>(o, lr, yrow, F.lane);
            } else {
                const int j = it - 4096, r = j & 7, un = j >> 3, blk = un & 31, hs = (un >> 5) & 3, b = un >> 7, i0 = blk * 256;
                f32x4 o[2][4]; float mr[2], lr[2];
#pragma unroll
                for (int h = 0; h < 2; ++h) { mr[h] = -3.0e38f; lr[h] = 0.f;
#pragma unroll
                    for (int db = 0; db < 4; ++db) o[h][db] = (f32x4){0.f, 0.f, 0.f, 0.f}; }
                const bf16* qb_ = QKV + (size_t)b * S * NQKV;
                { const int qcol[2] = {C_QB + 0 * 256 + hs * 64, C_QB + 0 * 256 + hs * 64}; const int qmu[2] = {i0 + r, i0 + r + 8}; const LAS float* const bias[2] = {lb + 4112 + (0 * 4 + hs) * 129, lb + 4112 + (0 * 4 + hs) * 129};
                  band_group<2, 64>(o, mr, lr, qb_, qcol, qmu, C_KB + 0 * 256 + hs * 64, VTB + (size_t)(((0 * 2 + b) * 4 + hs) * 64) * 8192, 1, 0, S, 16, (i0 >> 5) - 2, 12, bias, F.lane); }
                { const int qcol[2] = {C_QB + 1 * 256 + hs * 64, C_QB + 1 * 256 + hs * 64}; const int qmu[2] = {(i0 + r) >> 2, (i0 + r + 8) >> 2}; const LAS float* const bias[2] = {lb + 4112 + (1 * 4 + hs) * 129, lb + 4112 + (1 * 4 + hs) * 129};
                  band_group<2, 64>(o, mr, lr, qb_, qcol, qmu, C_KB + 1 * 256 + hs * 64, VTB + (size_t)(((1 * 2 + b) * 4 + hs) * 64) * 8192, 4, r & 3, S / 4, 4, (i0 >> 7) - 2, 6, bias, F.lane); }
#pragma unroll
                for (int h = 0; h < 2; ++h) { const int qcol[1] = {C_QB + 2 * 256 + hs * 64}; const int qmu[1] = {i0 >> 4}; const LAS float* const bias[1] = {lb + 4112 + (2 * 4 + hs) * 129};
                  band_group<1, 64>(*(f32x4(*)[1][4])&o[h], *(float(*)[1])&mr[h], *(float(*)[1])&lr[h], qb_, qcol, qmu, C_KB + 2 * 256 + hs * 64, VTB + (size_t)(((2 * 2 + b) * 4 + hs) * 64) * 8192,
                                    16, r + 8 * h, S / 16, 1, (blk - 4) >> 1, 5, bias, F.lane); }
                bf16* yr = YB + (size_t)(b * S + i0 + r + 16 * t) * 256 + hs * 64; bf16* const yrow[2] = {yr, yr + 8 * 256};
                band_store<2>(o, lr, yrow, F.lane);
            }
        }
        __syncthreads();
    }
    SEAM(2);
    if (IN(3)) REP(3) {
#ifndef NO_P3A
        { int k256 = 256; asm volatile("" : "+s"(k256)); pg8::Gemm g{YB, Wb_t, k256}; pg8::StaticOrder So; So.init(T, D, F.G, (int)blockIdx.x);
          pg8::EpiGate<0> E{MERGED, GATES, 1024};
          pg8::gemm_phase<pg8::EpiGate<0>, pg8::StaticOrder, true, true>(F.lds + RING_OFF, g, So, E); }
#endif
        VM_WAIT(); __syncthreads();
#ifndef NO_P3B
        { pg8::Gemm g{YA, Wa_t, D}; pg8::StaticOrder So; So.init(T, D, F.G, (int)blockIdx.x);
          pg8::EpiGate<1> E{MERGED, GATES, 0};
          pg8::gemm_phase<pg8::EpiGate<1>, pg8::StaticOrder, true, true>(F.lds + RING_OFF, g, So, E); }
#endif
    }
    SEAM(3);
    if (IN(4)) REP(4) {
        pg8::Gemm g{MERGED, Wout_t, D}; pg8::StaticOrder So; So.init(T, D, F.G, (int)blockIdx.x);
        pg8::EpiX1 E{x, out};
        pg8::gemm_phase<pg8::EpiX1, pg8::StaticOrder, true, true>(F.lds + RING_OFF, g, So, E);
    }
    SEAM(4);
    if (IN(5)) REP(5) {
        const bool lastrep5 = (rep_ + 1 == 1 + ((MK_DUP >> 5) & 1));
        LAS int* lcnt = F.tbl + 72; LAS int* lbase = F.tbl + 104; LAS int* ebuf = F.tbl + 136; LAS int* pbuf = F.tbl + 392;
        LAS float* plog = (LAS float*)(F.lds + RING_OFF);
        LAS float* psq = plog + 8 * 64 * 32;
        LAS float* rstd_s = psq + 512;
        const int g = F.lane >> 4, e16 = F.lane & 15, w = F.wave;
        float wB[32][2];
#pragma unroll
        for (int sc = 0; sc < 32; ++sc) { const int k = 128 * w + 32 * (sc >> 3) + 8 * g + (sc & 7); const float gm = norm_ffn[k];
            wB[sc][0] = gm * router_w[(size_t)k * NE + e16]; wB[sc][1] = gm * router_w[(size_t)k * NE + 16 + e16]; }
        for (int tblk = F.vcu; tblk < T / 64; tblk += F.G) {
            if (F.tid < 32) lcnt[F.tid] = 0;
#pragma unroll 1
            for (int tile = 0; tile < 4; ++tile) {
                const GAS float* xr = (const GAS float*)out + (size_t)(tblk * 64 + tile * 16 + e16) * D + 128 * w + 8 * g;
                f32x4 v[4][2]; float sq = 0.f;
#pragma unroll
                for (int s4 = 0; s4 < 4; ++s4) { v[s4][0] = *(const GAS f32x4*)(xr + 32 * s4); v[s4][1] = *(const GAS f32x4*)(xr + 32 * s4 + 4); }
#pragma unroll
                for (int s4 = 0; s4 < 4; ++s4) sq += (v[s4][0].x * v[s4][0].x + v[s4][0].y * v[s4][0].y) + (v[s4][0].z * v[s4][0].z + v[s4][0].w * v[s4][0].w)
                                                   + (v[s4][1].x * v[s4][1].x + v[s4][1].y * v[s4][1].y) + (v[s4][1].z * v[s4][1].z + v[s4][1].w * v[s4][1].w);
                sq += __shfl_xor(sq, 16); sq += __shfl_xor(sq, 32);
                if (g == 0) psq[w * 64 + tile * 16 + e16] = sq;
                f32x4 a0 = (f32x4){0.f, 0.f, 0.f, 0.f}, a1 = (f32x4){0.f, 0.f, 0.f, 0.f};
#pragma unroll
                for (int s4 = 0; s4 < 4; ++s4)
#pragma unroll
                    for (int c = 0; c < 8; ++c) { const float av = v[s4][c >> 2][c & 3];
                        a0 = __builtin_amdgcn_mfma_f32_16x16x4f32(av, wB[s4 * 8 + c][0], a0, 0, 0, 0); a1 = __builtin_amdgcn_mfma_f32_16x16x4f32(av, wB[s4 * 8 + c][1], a1, 0, 0, 0); }
#pragma unroll
                for (int r = 0; r < 4; ++r) { LAS float* pr = plog + (size_t)(w * 64 + tile * 16 + 4 * g + r) * 32 + e16; pr[0] = a0[r]; pr[16] = a1[r]; }
            }
            __syncthreads();
            if (F.tid < 64) { float s = 0.f;
#pragma unroll
                for (int ww = 0; ww < 8; ++ww) s += psq[ww * 64 + F.tid];
                rstd_s[F.tid] = 1.f / sqrtf(s * (1.f / D) + EPS); }
            __syncthreads();
            { const int e = F.tid & 31; const float rbv = router_b[e];
#pragma unroll 1
              for (int i = 0; i < 4; ++i) { const int tl = (F.tid >> 5) + 16 * i; float lg = 0.f;
#pragma unroll
                for (int ww = 0; ww < 8; ++ww) lg += plog[(size_t)(ww * 64 + tl) * 32 + e];
                float val = lg * rstd_s[tl] + rbv; float tv[4]; int ti[4];
#pragma unroll
                for (int r = 0; r < 4; ++r) {
                    float bv = val; int bi = e;
#pragma unroll
                    for (int o = 1; o < 32; o <<= 1) { const float ov = __shfl_xor(bv, o); const int oi = __shfl_xor(bi, o); if (ov > bv || (ov == bv && oi < bi)) { bv = ov; bi = oi; } }
                    tv[r] = bv; ti[r] = bi; if (bi == e) val = -3.0e38f;
                }
                const float e1 = __expf(tv[1] - tv[0]), e2 = __expf(tv[2] - tv[0]), e3 = __expf(tv[3] - tv[0]); const float inv = 1.f / (1.f + e1 + e2 + e3);
                if (e < 4) { const float p = (e == 0 ? 1.f : e == 1 ? e1 : e == 2 ? e2 : e3) * inv; const int ex = (e == 0 ? ti[0] : e == 1 ? ti[1] : e == 2 ? ti[2] : ti[3]);
                    const int m = tblk * 64 + tl; topi[m * 4 + e] = ex; topp[m * 4 + e] = p;
                    const int li = tl * 4 + e; ebuf[li] = ex; pbuf[li] = __hip_atomic_fetch_add(&lcnt[ex], 1, __ATOMIC_RELAXED, __HIP_MEMORY_SCOPE_WORKGROUP); } } }
#pragma unroll 1
            for (int r = 0; r < 8; ++r) { const int tl = w * 8 + r; const float rstd = rstd_s[tl]; const size_t m = (size_t)tblk * 64 + tl;
                const GAS f32x4* xr4 = (const GAS f32x4*)(out + m * D) + F.lane; GAS unsigned* o4 = (GAS unsigned*)(H28 + m * D) + F.lane;
#pragma unroll
                for (int j = 0; j < 4; ++j) { const f32x4 xv = xr4[64 * j]; const f32x4 gg = ((const GAS f32x4*)norm_ffn)[F.lane + 64 * j];
                    o4[64 * j] = pk4_fp8(xv.x * rstd * gg.x, xv.y * rstd * gg.y, xv.z * rstd * gg.z, xv.w * rstd * gg.w); } }
            __syncthreads();
            if (F.tid < 32) lbase[F.tid] = lastrep5 ? (int)__hip_atomic_fetch_add(cnt + F.tid, (unsigned)lcnt[F.tid], RLX_AGENT) : 0;
            __syncthreads();
            if (F.tid < 256) pos[tblk * 256 + F.tid] = lbase[ebuf[F.tid]] + pbuf[F.tid];
            __syncthreads();
        }
    }
    SEAM(5);
    if (IN(6) || IN(7) || IN(8)) {
        LAS int* loff = F.tbl; LAS int* ltoff = F.tbl + 36; LAS int* lc = F.tbl + 72;
        if (F.tid < 32) lc[F.tid] = (int)__hip_atomic_load(cnt + F.tid, RLX_AGENT);
        __syncthreads();
        if (F.tid == 0) { int a = 0, ta = 0; for (int e = 0; e < NE; ++e) { loff[e] = a; ltoff[e] = ta; const int c = lc[e]; a += c; ta += (c + 255) >> 8; } loff[NE] = a; ltoff[NE] = ta; }
        __syncthreads();
    }
    if (IN(6)) REP(6) {
        const LAS int* loff = F.tbl;
        for (int p = gw; p < T * 4; p += NGW) {
            const int e = topi[p], row = loff[e] + pos[p];
            if (F.lane == 0) slot[p] = row;
            const GAS u32x4* src = (const GAS u32x4*)(H28 + (size_t)(p >> 2) * D) + F.lane; GAS u32x4* dst = (GAS u32x4*)(HS8 + (size_t)row * D) + F.lane;
            const u32x4 a = src[0]; dst[0] = a;
        }
    }
    SEAM(6);
    if (IN(7)) REP(7) {
        int k512 = D / 2; asm volatile("" : "+s"(k512));
        pg8::Gemm g{(const bf16*)HS8, (const bf16*)Wgu8, k512}; pg8::GroupOrder So{F.tbl + 36, F.tbl, 8, F.G, (int)blockIdx.x, 0}; So.nunits = __builtin_amdgcn_readfirstlane(F.tbl[36 + NE]) * 8;
        pg8::EpiSwiglu E{ACT8, b_gate, b_up};
        pg8::gemm_phase<pg8::EpiSwiglu, pg8::GroupOrder, true, FP8_SP2, true>(F.lds + RING_OFF, g, So, E);
    }
    SEAM(7);
    if (IN(8)) REP(8) {
        int k512 = D / 2; asm volatile("" : "+s"(k512));
        pg8::Gemm g{(const bf16*)ACT8, (const bf16*)Wd8, k512}; pg8::GroupOrder So{F.tbl + 36, F.tbl, 4, F.G, (int)blockIdx.x, 0}; So.nunits = __builtin_amdgcn_readfirstlane(F.tbl[36 + NE]) * 4;
        pg8::EpiDown E{YS, b_down};
        pg8::gemm_phase<pg8::EpiDown, pg8::GroupOrder, true, FP8_SP2, true>(F.lds + RING_OFF, g, So, E);
    }
    SEAM(8);
#ifdef MK_XBAR
    for (int xb_ = 0; xb_ < MK_XBAR; ++xb_) xcd_barrier(bar);
#endif
    if (IN(9)) REP(9) {
        const bf16* ys = YS;
        float* dst9 = (rep_ + 1 < 1 + ((MK_DUP >> 9) & 1)) ? (float*)(ws + WS_ACT) : out;
        for (int m = gw; m < T; m += NGW) {
            GAS f32x4* xr = (GAS f32x4*)(out + (size_t)m * D) + F.lane; f32x4 v[4];
#pragma unroll
            for (int j = 0; j < 4; ++j) v[j] = xr[64 * j];
#pragma unroll
            for (int k = 0; k < 4; ++k) { const int r = slot[m * 4 + k]; const float p = topp[m * 4 + k]; const GAS unsigned long long* yr = (const GAS unsigned long long*)(ys + (size_t)r * D) + F.lane;
#pragma unroll
                for (int j = 0; j < 4; ++j) { const unsigned long long u = yr[64 * j]; const unsigned l32 = (unsigned)u, h32 = (unsigned)(u >> 32);
                    v[j].x += p * bflo(l32); v[j].y += p * bfhi(l32); v[j].z += p * bflo(h32); v[j].w += p * bfhi(h32); } }
            float s = 0.f;
#pragma unroll
            for (int j = 0; j < 4; ++j) s += (v[j].x * v[j].x + v[j].y * v[j].y) + (v[j].z * v[j].z + v[j].w * v[j].w);
            const float rstd = 1.f / sqrtf(wave_sum(s) * (1.f / D) + EPS);
#pragma unroll
            for (int j = 0; j < 4; ++j) { const f32x4 gg = ((const GAS f32x4*)norm_final)[F.lane + 64 * j]; f32x4 y; y.x = v[j].x * rstd * gg.x; y.y = v[j].y * rstd * gg.y; y.z = v[j].z * rstd * gg.z; y.w = v[j].w * rstd * gg.w; ((GAS f32x4*)(dst9 + (size_t)m * D) + F.lane)[64 * j] = y; }
        }
    }
#undef IN
#undef SEAM
}

extern "C" void kernel_launch(void* const* d_in, const int* in_sizes, int n_in, void* d_out, int out_size, void* d_ws, size_t ws_size, hipStream_t stream) {
    static int grid = 0;
    if (grid == 0) {
        if (n_in != 19 || in_sizes[0] != T * D || out_size != T * D || ws_size < WS_END) { fprintf(stderr, "kernel_launch: unexpected shapes (n_in %d, ws %zu); nothing launched\n", n_in, ws_size); grid = -1; return; }
        int dev = 0, cus = 0, per_cu = 0;
        if (hipGetDevice(&dev) != hipSuccess || hipDeviceGetAttribute(&cus, hipDeviceAttributeMultiprocessorCount, dev) != hipSuccess) { grid = -1; return; }
        if (hipFuncSetAttribute((const void*)mk_fwd, hipFuncAttributeMaxDynamicSharedMemorySize, LDS_BYTES) != hipSuccess) { fprintf(stderr, "kernel_launch: hipFuncSetAttribute failed\n"); grid = -1; return; }
        if (hipOccupancyMaxActiveBlocksPerMultiprocessor(&per_cu, (const void*)mk_fwd, NWAVES * 64, LDS_BYTES) != hipSuccess || per_cu < 1) { fprintf(stderr, "kernel_launch: occupancy query says %d blocks per CU\n", per_cu); }
        (void)hipGetLastError();
        grid = cus;
        if (grid != 256) fprintf(stderr, "kernel_launch: %d CUs (built and tuned for 256)\n", grid);
    }
    if (grid < 0) return;
    if (hipMemsetAsync((char*)d_ws + WS_CTL, 0, CTL_ZERO_BYTES, stream) != hipSuccess) return;
    Args a{};
    for (int i = 0; i < 19; ++i) a.in[i] = (const float*)d_in[i];
    a.out = (float*)d_out; a.ws = (unsigned char*)d_ws;
#if MK_MODE == 2
    a.ph_lo = 0; a.ph_hi = NPHASE; a.li = 0;
    hipLaunchKernelGGL(mk_fwd, dim3(grid), dim3(NWAVES * 64), LDS_BYTES, stream, a);
#else
    for (int ph = 0; ph < NPHASE; ++ph) { a.ph_lo = ph; a.ph_hi = ph + 1; a.li = ph; hipLaunchKernelGGL(mk_fwd, dim3(grid), dim3(NWAVES * 64), LDS_BYTES, stream, a); }
#endif
}
```

```cpp
#define MK_DUP 0
#include <hip/hip_runtime.h>
#include <stdint.h>
#include <stdio.h>

#ifndef FP8_SP2
#define FP8_SP2 true
#endif
#ifndef MK_MODE
#define MK_MODE 2
#endif

typedef unsigned short bf16;
typedef short bf16x8 __attribute__((ext_vector_type(8)));
typedef float f32x4 __attribute__((ext_vector_type(4)));
typedef float f32x2 __attribute__((ext_vector_type(2)));
typedef unsigned u32x4 __attribute__((ext_vector_type(4)));
typedef unsigned u32x2 __attribute__((ext_vector_type(2)));
#define GAS __attribute__((address_space(1)))
#define LAS __attribute__((address_space(3)))
typedef GAS unsigned gu32;

constexpr int T = 16384, S = 8192, D = 1024, NPROJ = 5888, NQKV = 3840, NGATE = 2048, NE = 32, TOPK = 4;
constexpr int C_QA = 0, C_KA = 1024, C_VA = 1280, C_QB = 1536, C_KB = 2304, C_VB = 3072;
constexpr float EPS = 1e-5f;
constexpr size_t MiB = 1u << 20;
constexpr size_t WS_CTL = 0, CTL_ZERO_BYTES = 1 * MiB;
constexpr size_t WS_TAB = 1 * MiB;
constexpr size_t WS_WIN = 2 * MiB;
constexpr size_t WS_WA = 14 * MiB;
constexpr size_t WS_WB = 16 * MiB;
constexpr size_t WS_WOUT = 17 * MiB;
constexpr size_t WS_RT = 19 * MiB;
constexpr size_t WS_WGU = 24 * MiB;
constexpr size_t WS_WD = 88 * MiB;
constexpr size_t WS_H2 = 120 * MiB;
constexpr size_t WS_HS = 136 * MiB;
constexpr size_t WS_ACT = 201 * MiB;
constexpr size_t WS_YS = 272 * MiB;
constexpr size_t WS_XN = 216 * MiB;
constexpr size_t WS_QKV = 248 * MiB;
constexpr size_t WS_GATES = 368 * MiB;
constexpr size_t WS_YA = 432 * MiB;
constexpr size_t WS_YB = 464 * MiB;
constexpr size_t WS_MERGED = 472 * MiB;
constexpr size_t WS_VT = 472 * MiB;
constexpr size_t WS_END = 506 * MiB;
constexpr int CW_CNT = 0;
constexpr int CW_BAR = 4096;

__device__ const unsigned char BKT_A[257] = {12,12,12,12,12,12,12,12,12,12,12,12,12,12,12,12,12,12,12,12,12,12,12,12,12,12,12,12,12,12,12,12,12,12,12,12,12,12,11,11,11,11,11,11,11,11,11,11,11,11,11,11,11,11,11,11,11,11,11,11,11,11,11,11,11,11,11,11,11,11,11,11,11,11,11,11,11,11,11,10,10,10,10,10,10,10,10,10,10,10,10,10,10,10,10,10,10,10,10,10,10,10,9,9,9,9,9,9,9,9,9,9,9,9,8,8,8,8,8,8,8,7,6,5,4,3,2,1,0,17,18,19,20,21,22,23,24,24,24,24,24,24,24,25,25,25,25,25,25,25,25,25,25,25,25,26,26,26,26,26,26,26,26,26,26,26,26,26,26,26,26,26,26,26,26,26,26,26,27,27,27,27,27,27,27,27,27,27,27,27,27,27,27,27,27,27,27,27,27,27,27,27,27,27,27,27,27,27,27,27,27,27,27,27,27,27,27,27,27,28,28,28,28,28,28,28,28,28,28,28,28,28,28,28,28,28,28,28,28,28,28,28,28,28,28,28,28,28,28,28,28,28,28,28,28,28,28};
__device__ const unsigned char BKT_B[3][129] = {
 {11,11,11,11,11,11,11,11,11,11,11,11,11,11,11,10,10,10,10,10,10,10,10,10,10,10,10,10,10,10,10,10,10,10,10,10,10,10,9,9,9,9,9,9,9,9,9,9,9,9,8,8,8,8,8,8,8,7,6,5,4,3,2,1,0,17,18,19,20,21,22,23,24,24,24,24,24,24,24,25,25,25,25,25,25,25,25,25,25,25,25,26,26,26,26,26,26,26,26,26,26,26,26,26,26,26,26,26,26,26,26,26,26,26,27,27,27,27,27,27,27,27,27,27,27,27,27,27,27},
 {13,13,13,13,13,13,13,13,13,13,13,13,13,13,13,13,13,13,13,13,13,13,13,12,12,12,12,12,12,12,12,12,12,12,12,12,12,12,12,12,12,12,11,11,11,11,11,11,11,11,11,11,10,10,10,10,10,10,9,9,9,8,8,4,0,20,24,24,25,25,25,26,26,26,26,26,26,27,27,27,27,27,27,27,27,27,27,28,28,28,28,28,28,28,28,28,28,28,28,28,28,28,28,28,28,28,29,29,29,29,29,29,29,29,29,29,29,29,29,29,29,29,29,29,29,29,29,29,29},
 {15,15,15,15,15,15,15,15,15,15,15,15,15,15,15,15,15,15,15,15,15,15,15,15,15,15,15,15,15,15,14,14,14,14,14,14,14,14,14,14,14,14,14,14,14,13,13,13,13,13,13,13,13,13,12,12,12,12,12,11,11,10,10,9,0,25,26,26,27,27,28,28,28,28,28,29,29,29,29,29,29,29,29,29,30,30,30,30,30,30,30,30,30,30,30,30,30,30,30,31,31,31,31,31,31,31,31,31,31,31,31,31,31,31,31,31,31,31,31,31,31,31,31,31,31,31,31,31,31}};

#define RLX_AGENT __ATOMIC_RELAXED, __HIP_MEMORY_SCOPE_AGENT
#define LDS_WAIT() asm volatile("s_waitcnt lgkmcnt(0)" ::: "memory")
#define VM_WAIT() asm volatile("s_waitcnt vmcnt(0)" ::: "memory")
__device__ __forceinline__ unsigned f2bf(float f) { unsigned u = __builtin_bit_cast(unsigned, f); return (u + 0x7fffu + ((u >> 16) & 1u)) >> 16; }
__device__ __forceinline__ unsigned pk2(float lo, float hi) { return f2bf(lo) | (f2bf(hi) << 16); }
__device__ __forceinline__ unsigned pk4_fp8(float a, float b, float c, float d) { unsigned w = 0; w = __builtin_amdgcn_cvt_pk_fp8_f32(a, b, w, false); w = __builtin_amdgcn_cvt_pk_fp8_f32(c, d, w, true); return w; }
__device__ __forceinline__ float bf2f(unsigned b) { return __builtin_bit_cast(float, b << 16); }
__device__ __forceinline__ float bflo(unsigned u) { return __builtin_bit_cast(float, u << 16); }
__device__ __forceinline__ float bfhi(unsigned u) { return __builtin_bit_cast(float, u & 0xffff0000u); }
__device__ __forceinline__ float wave_sum(float v) {
#pragma unroll
    for (int o = 1; o < 64; o <<= 1) v += __shfl_xor(v, o);
    return v;
}
__device__ __forceinline__ float sigm(float x) { return __builtin_amdgcn_rcpf(1.f + __builtin_amdgcn_exp2f(-1.4426950408889634f * x)); }

struct Tabs { float biasA[16][257]; float biasB[3][4][129]; };

namespace pg8 {
#define PG8_LAS __attribute__((address_space(3)))
typedef unsigned short bf16_t;
constexpr int BM = 256, BK = 64, HALF = 128, HTB = HALF * BK * 2, STAGE_BYTES = 8 * HTB, NXCD = 8, WGM = 8;
__host__ __device__ __forceinline__ int lds_byte(int r, int c) { const int st = (r >> 4) * 2 + (c >> 5), rr = r & 15, cc = c & 31, ob = rr * 64 + cc * 2; return st * 1024 + (ob ^ (((ob >> 9) & 1) << 5)); }
__host__ __device__ __forceinline__ void stage_rc(int b, int& R, int& C) { const int st = b / 1024, sb = b % 1024, swz = sb ^ (((sb >> 9) & 1) << 5); R = (st >> 1) * 16 + swz / 64; C = (st & 1) * 32 + (swz % 64) / 2; }
__host__ __device__ __forceinline__ int perm32(int rho) { const int n = rho >> 4, i = rho & 15; return 8 * (i >> 2) + 4 * n + (i & 3); }

struct Unit { int arow, brow, nrows, e; };
struct Gemm { const bf16_t* A; const bf16_t* Bt; int K; };

struct StaticOrder {
    int nM, nN, nwg, G, c;
    __device__ void init(int M, int N, int G_, int c_) { nM = M / BM; nN = N / BM; nwg = nM * nN; G = G_; c = c_; }
    __device__ bool next(int i, Unit& u) const {
        const long L = (long)i * G + c; if (L >= nwg) return false;
        int wgid = (int)L; { const int q = nwg / NXCD, r = nwg % NXCD, xcd = wgid % NXCD, off = wgid / NXCD; wgid = (xcd < r ? xcd * (q + 1) : r * (q + 1) + (xcd - r) * q) + off; }
        const int nig = WGM * nN, gid = wgid / nig, fm = gid * WGM, gsz = (nM - fm) < WGM ? (nM - fm) : WGM;
        u.arow = BM * (fm + ((wgid % nig) % gsz)); u.brow = BM * ((wgid % nig) / gsz); u.nrows = BM; u.e = 0; return true;
    }
    __device__ __forceinline__ void a_ready(const Unit&) const {}
    __device__ __forceinline__ void done(const Unit&) const {}
};
struct GroupOrder {
    const PG8_LAS int* toff; const PG8_LAS int* off; int NT, G, c, nunits;
    __device__ bool next(int i, Unit& u) const {
        const int L = i * G + c; if (L >= nunits) return false;
        const int mtg = L / NT, pn = L - mtg * NT;
        int e = 0;
        for (int j = 1; j < NE; ++j) e += (toff[j] <= mtg) ? 1 : 0;
        e = __builtin_amdgcn_readfirstlane(e);
        const int mt = mtg - __builtin_amdgcn_readfirstlane(toff[e]); const int o0 = __builtin_amdgcn_readfirstlane(off[e]), o1 = __builtin_amdgcn_readfirstlane(off[e + 1]);
        u.arow = o0 + BM * mt; const int rem = o1 - u.arow; u.nrows = rem < BM ? rem : BM; u.brow = (e * NT + pn) * BM; u.e = e; return true;
    }
    __device__ __forceinline__ void a_ready(const Unit&) const {}
    __device__ __forceinline__ void done(const Unit&) const {}
};

__device__ __forceinline__ unsigned cvt_pk_bf16(float lo, float hi) { unsigned r; asm volatile("v_cvt_pk_bf16_f32 %0, %1, %2" : "=v"(r) : "v"(lo), "v"(hi)); return r; }

struct EpiProj {
    static constexpr bool PERM = true, AFTER_DRAIN = false;
    bf16_t* qkv; bf16_t* gates; const float* bias; bf16_t* vta; bf16_t* vtb;
    __device__ __forceinline__ void operator()(const f32x4 (&acc)[2][2][4][2], const Unit& u, int wr, int wc, int fr, int fq) const {
        const int colt = u.brow; const bool isq = colt < NQKV; bf16_t* base = isq ? qkv : gates; const int ldc = isq ? NQKV : NGATE; const int cb = isq ? colt : colt - NQKV;
        const int row0 = u.arow + wr * 64 + fr, col0 = cb + wc * 32 + 8 * fq, bcol0 = colt + wc * 32 + 8 * fq;
        f32x4 bv[2][2];
#pragma unroll
        for (int bj = 0; bj < 2; ++bj)
#pragma unroll
            for (int n = 0; n < 2; ++n) bv[bj][n] = *(const f32x4*)(bias + bcol0 + bj * HALF + 4 * n);
        const bool isv = (colt == C_VA) || (colt >= C_VB && colt < NQKV);
        if (!isv) {
#pragma unroll
        for (int ai = 0; ai < 2; ++ai)
#pragma unroll
            for (int m = 0; m < 4; ++m) { bf16_t* rowp = base + (size_t)(row0 + ai * HALF + m * 16) * ldc + col0;
#pragma unroll
                for (int bj = 0; bj < 2; ++bj) { const f32x4 v0 = acc[ai][bj][m][0] + bv[bj][0], v1 = acc[ai][bj][m][1] + bv[bj][1];
                    u32x4 w; w.x = cvt_pk_bf16(v0[0], v0[1]); w.y = cvt_pk_bf16(v0[2], v0[3]); w.z = cvt_pk_bf16(v1[0], v1[1]); w.w = cvt_pk_bf16(v1[2], v1[3]);
                    *(u32x4*)(rowp + bj * HALF) = w; } }
        } else {
            const int gsel = (colt == C_VA) ? -1 : ((colt - C_VB) >> 8); const int sh = (gsel <= 0) ? 0 : (gsel == 1 ? 2 : 4);
            bf16_t* vb = (gsel < 0) ? vta : vtb + (size_t)gsel * (2 * 256 * 8192); const int c0 = wc * 32 + 8 * fq;
#pragma unroll
            for (int ai = 0; ai < 2; ++ai)
#pragma unroll
                for (int m = 0; m < 4; ++m) { const int row = row0 + ai * HALF + m * 16, b = row >> 13, s = row & 8191; const int mu = s >> sh; const int pos = ((s & ((1 << sh) - 1)) << (13 - sh)) + (mu & ~31) + (((mu & 15) >> 2) << 3) + (((mu >> 4) & 1) << 2) + (mu & 3);
                    bf16_t* vp = vb + (size_t)(b * 256 + c0) * 8192 + pos;
#pragma unroll
                    for (int bj = 0; bj < 2; ++bj)
#pragma unroll
                        for (int n = 0; n < 2; ++n) { const f32x4 v = acc[ai][bj][m][n] + bv[bj][n]; const unsigned w0 = cvt_pk_bf16(v[0], v[1]), w1 = cvt_pk_bf16(v[2], v[3]);
                            bf16_t* q = vp + (size_t)(bj * HALF + 4 * n) * 8192;
                            q[0] = (bf16_t)(w0 & 0xffffu); q[8192] = (bf16_t)(w0 >> 16); q[2 * 8192] = (bf16_t)(w1 & 0xffffu); q[3 * 8192] = (bf16_t)(w1 >> 16); } }
        }
    }
};
template <int MODE> struct EpiGate {
    static constexpr bool PERM = true, AFTER_DRAIN = false;
    bf16_t* out; const bf16_t* gates; int gcol0;
    __device__ __forceinline__ void operator()(const f32x4 (&acc)[2][2][4][2], const Unit& u, int wr, int wc, int fr, int fq) const {
        const int row0 = u.arow + wr * 64 + fr, col0 = u.brow + wc * 32 + 8 * fq;
#pragma unroll
        for (int ai = 0; ai < 2; ++ai)
#pragma unroll
            for (int m = 0; m < 4; ++m) { const size_t r = (size_t)(row0 + ai * HALF + m * 16);
#pragma unroll
                for (int bj = 0; bj < 2; ++bj) { const int c = col0 + bj * HALF;
                    const u32x4 gv = *(const u32x4*)(gates + r * NGATE + gcol0 + c); const f32x4 a0 = acc[ai][bj][m][0], a1 = acc[ai][bj][m][1];
                    float o[8]; o[0] = sigm(bflo(gv.x)) * a0[0]; o[1] = sigm(bfhi(gv.x)) * a0[1]; o[2] = sigm(bflo(gv.y)) * a0[2]; o[3] = sigm(bfhi(gv.y)) * a0[3];
                    o[4] = sigm(bflo(gv.z)) * a1[0]; o[5] = sigm(bfhi(gv.z)) * a1[1]; o[6] = sigm(bflo(gv.w)) * a1[2]; o[7] = sigm(bfhi(gv.w)) * a1[3];
                    if (MODE == 1) { const u32x4 mv = *(const u32x4*)(out + r * D + c);
                        o[0] += bflo(mv.x); o[1] += bfhi(mv.x); o[2] += bflo(mv.y); o[3] += bfhi(mv.y); o[4] += bflo(mv.z); o[5] += bfhi(mv.z); o[6] += bflo(mv.w); o[7] += bfhi(mv.w); }
                    u32x4 w; w.x = cvt_pk_bf16(o[0], o[1]); w.y = cvt_pk_bf16(o[2], o[3]); w.z = cvt_pk_bf16(o[4], o[5]); w.w = cvt_pk_bf16(o[6], o[7]);
                    *(u32x4*)(out + r * D + c) = w; }
                asm volatile("" ::: "memory"); }
    }
};
struct EpiX1 {
    static constexpr bool PERM = true, AFTER_DRAIN = false;
    const float* x; float* out;
    __device__ __forceinline__ void operator()(const f32x4 (&acc)[2][2][4][2], const Unit& u, int wr, int wc, int fr, int fq) const {
        const int row0 = u.arow + wr * 64 + fr, col0 = u.brow + wc * 32 + 8 * fq;
#pragma unroll
        for (int ai = 0; ai < 2; ++ai)
#pragma unroll
            for (int m = 0; m < 4; ++m) { const size_t r = (size_t)(row0 + ai * HALF + m * 16);
#pragma unroll
                for (int bj = 0; bj < 2; ++bj) { const size_t o = r * D + col0 + bj * HALF;
                    const f32x4 x0 = *(const f32x4*)(x + o), x1 = *(const f32x4*)(x + o + 4);
                    *(f32x4*)(out + o) = x0 + acc[ai][bj][m][0]; *(f32x4*)(out + o + 4) = x1 + acc[ai][bj][m][1]; }
                asm volatile("" ::: "memory"); }
    }
};
struct EpiSwiglu {
    static constexpr bool PERM = true, AFTER_DRAIN = false;
    unsigned char* act; const float* bg; const float* bu;
    __device__ __forceinline__ void operator()(const f32x4 (&acc)[2][2][4][2], const Unit& u, int wr, int wc, int fr, int fq) const {
        const int pn = (u.brow >> 8) & 7; const int col0 = pn * HALF + wc * 32 + 8 * fq; const int rl0 = wr * 64 + fr;
        const f32x4 g0 = *(const f32x4*)(bg + (size_t)u.e * D + col0), g1 = *(const f32x4*)(bg + (size_t)u.e * D + col0 + 4);
        const f32x4 u0 = *(const f32x4*)(bu + (size_t)u.e * D + col0), u1 = *(const f32x4*)(bu + (size_t)u.e * D + col0 + 4);
#pragma unroll
        for (int ai = 0; ai < 2; ++ai)
#pragma unroll
            for (int m = 0; m < 4; ++m) { const int rl = rl0 + ai * HALF + m * 16;
                const f32x4 ga = acc[ai][0][m][0] + g0, gb = acc[ai][0][m][1] + g1, ua = acc[ai][1][m][0] + u0, ub = acc[ai][1][m][1] + u1;
                float o[8];
#pragma unroll
                for (int j = 0; j < 4; ++j) { const float gt = fminf(ga[j], 7.f), up = fminf(fmaxf(ua[j], -7.f), 7.f); o[j] = gt * sigm(1.702f * gt) * (up + 1.f);
                    const float gt2 = fminf(gb[j], 7.f), up2 = fminf(fmaxf(ub[j], -7.f), 7.f); o[4 + j] = gt2 * sigm(1.702f * gt2) * (up2 + 1.f); }
                u32x2 w; w.x = pk4_fp8(o[0], o[1], o[2], o[3]); w.y = pk4_fp8(o[4], o[5], o[6], o[7]);
                if (rl < u.nrows) *(u32x2*)(act + (size_t)(u.arow + rl) * D + col0) = w; }
    }
};
struct EpiDown {
    static constexpr bool PERM = true, AFTER_DRAIN = false;
    unsigned char* ys; const float* bd;
    __device__ __forceinline__ void operator()(const f32x4 (&acc)[2][2][4][2], const Unit& u, int wr, int wc, int fr, int fq) const {
        const int pn = (u.brow >> 8) & 3; const int col0 = pn * BM + wc * 32 + 8 * fq; const int rl0 = wr * 64 + fr;
        f32x4 bv[2][2];
#pragma unroll
        for (int bj = 0; bj < 2; ++bj)
#pragma unroll
            for (int n = 0; n < 2; ++n) bv[bj][n] = *(const f32x4*)(bd + (size_t)u.e * D + col0 + bj * HALF + 4 * n);
#pragma unroll
        for (int ai = 0; ai < 2; ++ai)
#pragma unroll
            for (int m = 0; m < 4; ++m) { const int rl = rl0 + ai * HALF + m * 16; unsigned char* rowp = ys + (size_t)(u.arow + rl) * D + col0;
#pragma unroll
                for (int bj = 0; bj < 2; ++bj) { const f32x4 v0 = acc[ai][bj][m][0] + bv[bj][0], v1 = acc[ai][bj][m][1] + bv[bj][1];
                    u32x2 w; w.x = pk4_fp8(v0[0], v0[1], v0[2], v0[3]); w.y = pk4_fp8(v1[0], v1[1], v1[2], v1[3]);
                    if (rl < u.nrows) *(u32x2*)(rowp + bj * HALF) = w; } }
    }
};

typedef int i32x4_t __attribute__((ext_vector_type(4))); typedef int i32x8_t __attribute__((ext_vector_type(8)));
template <bool FP8> struct Frag;
template <> struct Frag<false> { bf16x8 v[2];
    __device__ __forceinline__ void ld(const PG8_LAS unsigned char* p) { v[0] = *(const PG8_LAS bf16x8*)p; v[1] = *(const PG8_LAS bf16x8*)(p + 1024); } };
template <> struct Frag<true> { i32x8_t v;
    __device__ __forceinline__ void ld(const PG8_LAS unsigned char* p) { const i32x4_t lo = *(const PG8_LAS i32x4_t*)p, hi = *(const PG8_LAS i32x4_t*)(p + 1024); v = __builtin_shufflevector(lo, hi, 0, 1, 2, 3, 4, 5, 6, 7); } };
__device__ __forceinline__ f32x4 mma_frag(const Frag<false>& w, const Frag<false>& x, f32x4 c) {
    c = __builtin_amdgcn_mfma_f32_16x16x32_bf16(w.v[0], x.v[0], c, 0, 0, 0); return __builtin_amdgcn_mfma_f32_16x16x32_bf16(w.v[1], x.v[1], c, 0, 0, 0); }
__device__ __forceinline__ f32x4 mma_frag(const Frag<true>& w, const Frag<true>& x, f32x4 c) {
    const int sa = 0x7A7A7A7A, sb = 0x7F7F7F7F;
    asm volatile("v_mfma_scale_f32_16x16x128_f8f6f4 %0, %1, %2, %0, %3, %4 op_sel_hi:[0,0,0]" : "+v"(c) : "v"(w.v), "v"(x.v), "v"(sa), "v"(sb));
    return c; }
template <class Epi, class Sched, bool ALIGN_EPI = false, bool SP2 = false, bool FP8 = false>
__device__ __forceinline__ void gemm_phase(PG8_LAS unsigned char* lds, const Gemm g, const Sched& S, const Epi& E) {
    const int tid = threadIdx.x, wid = __builtin_amdgcn_readfirstlane(tid >> 6), lane = tid & 63, wr = wid >> 2, wc = wid & 3, fr = lane & 15, fq = lane >> 4;
    const int K = g.K, nt = K / BK;
    unsigned voffA[2], voffB[2];
#pragma unroll
    for (int i = 0; i < 2; ++i) { int R, C; stage_rc(tid * 16 + i * 8192, R, C); const int Rb = Epi::PERM ? ((R & ~31) + perm32(R & 31)) : R;
        voffA[i] = (unsigned)(R * K + C) * 2u; voffB[i] = (unsigned)(Rb * K + C) * 2u; }
    const size_t kstep = (size_t)(BK * 2);
    const size_t hstep = (size_t)HALF * K * 2;
    const size_t rowb = (size_t)K * 2;
    const unsigned ldsw = (unsigned)wid * 1024u;
    const int aoff = lds_byte(wr * 64 + fr, fq * 8), boff = lds_byte(wc * 32 + fr, fq * 8);
#define PG8_SA(b, h) (((b) * 2 + (h)) * HTB)
#define PG8_SB(b, h) ((4 + (b) * 2 + (h)) * HTB)
#define PG8_STAGE(bufoff, gbase, voff) do { _Pragma("unroll") for (int _i = 0; _i < 2; ++_i) \
        __builtin_amdgcn_global_load_lds((const unsigned*)((const char*)(gbase) + (voff)[_i]), (PG8_LAS unsigned*)(lds + (bufoff) + ldsw + _i * 8192), 16, 0, 0); } while (0)
#define PG8_LDA(dst, b, h) do { _Pragma("unroll") for (int m = 0; m < 4; ++m) dst[m].ld(lds + PG8_SA(b, h) + aoff + m * 2048); } while (0)
#define PG8_LDB(dst, b, h) do { _Pragma("unroll") for (int n = 0; n < 2; ++n) dst[n].ld(lds + PG8_SB(b, h) + boff + n * 2048); } while (0)
#define PG8_MMA(ai, bj, At, Bt) do { __builtin_amdgcn_s_setprio(1); _Pragma("unroll") for (int m = 0; m < 4; ++m) _Pragma("unroll") for (int n = 0; n < 2; ++n) \
        acc[ai][bj][m][n] = mma_frag(Bt[n], At[m], acc[ai][bj][m][n]); __builtin_amdgcn_s_setprio(0); } while (0)
#define PG8_WAIT_V(n) asm volatile("s_waitcnt vmcnt(" #n ")" ::: "memory")
#define PG8_WAIT_L(n) asm volatile("s_waitcnt lgkmcnt(" #n ")" ::: "memory")
#define PG8_BAR __builtin_amdgcn_s_barrier()
#define PG8_SCHED __builtin_amdgcn_sched_barrier(0)
    Unit cur, nxt; int ui = 0;
    if (!S.next(0, cur)) return;
    f32x4 acc[2][2][4][2];
#pragma unroll
    for (int a = 0; a < 2; ++a)
#pragma unroll
        for (int b = 0; b < 2; ++b)
#pragma unroll
            for (int m = 0; m < 4; ++m)
#pragma unroll
                for (int n = 0; n < 2; ++n) acc[a][b][m][n] = (f32x4){0.f, 0.f, 0.f, 0.f};
    Frag<FP8> At[4], B0[2], B1[2];
    const char* cA = (const char*)g.A + (size_t)cur.arow * rowb; const char* cB = (const char*)g.Bt + (size_t)cur.brow * rowb;
    S.a_ready(cur);
    if constexpr (SP2) {
        PG8_STAGE(PG8_SB(0, 0), cB, voffB); PG8_STAGE(PG8_SB(0, 1), cB + hstep, voffB); PG8_STAGE(PG8_SA(0, 0), cA, voffA); PG8_STAGE(PG8_SA(0, 1), cA + hstep, voffA);
        if (wr == 1) PG8_BAR;
        PG8_WAIT_V(2); PG8_BAR;
        PG8_STAGE(PG8_SB(1, 0), cB + kstep, voffB); PG8_STAGE(PG8_SA(1, 0), cA + kstep, voffA); PG8_STAGE(PG8_SB(1, 1), cB + hstep + kstep, voffB);
        PG8_WAIT_V(6); PG8_BAR;
    } else {
        PG8_STAGE(PG8_SB(0, 0), cB, voffB); PG8_STAGE(PG8_SA(0, 0), cA, voffA); PG8_STAGE(PG8_SB(0, 1), cB + hstep, voffB); PG8_STAGE(PG8_SA(0, 1), cA + hstep, voffA);
        if (wr == 1) PG8_BAR;
        PG8_WAIT_V(4); PG8_BAR;
        PG8_STAGE(PG8_SB(1, 0), cB + kstep, voffB); PG8_STAGE(PG8_SA(1, 0), cA + kstep, voffA); PG8_STAGE(PG8_SB(1, 1), cB + hstep + kstep, voffB);
        PG8_WAIT_V(6); PG8_BAR;
    }
    for (;;) {
        const bool has_next = S.next(ui + 1, nxt);
        const char* nA = has_next ? (const char*)g.A + (size_t)nxt.arow * rowb : cA; const char* nB = has_next ? (const char*)g.Bt + (size_t)nxt.brow * rowb : cB;
        for (int t = 0; t < nt; t += 2) {
            const bool last = (t == nt - 2);
            const char* a1 = cA + (size_t)(t + 1) * kstep;
            const char* a2 = last ? nA : cA + (size_t)(t + 2) * kstep; const char* b2 = last ? nB : cB + (size_t)(t + 2) * kstep;
            const char* a3 = a2 + kstep; const char* b3 = b2 + kstep;
            if (last && has_next) S.a_ready(nxt);
            if constexpr (SP2) {
            PG8_LDB(B0, 0, 0); PG8_LDB(B1, 0, 1); PG8_SCHED; PG8_LDA(At, 0, 0); PG8_STAGE(PG8_SA(1, 1), a1 + hstep, voffA);
            PG8_WAIT_V(8); PG8_WAIT_L(0); PG8_BAR; PG8_MMA(0, 0, At, B0); PG8_MMA(0, 1, At, B1); PG8_BAR; PG8_SCHED;
            PG8_LDA(At, 0, 1); PG8_STAGE(PG8_SB(0, 0), b2, voffB); PG8_STAGE(PG8_SB(0, 1), b2 + hstep, voffB); PG8_STAGE(PG8_SA(0, 0), a2, voffA);
            PG8_WAIT_V(8); PG8_WAIT_L(0); PG8_BAR; PG8_MMA(1, 0, At, B0); PG8_MMA(1, 1, At, B1); PG8_BAR; PG8_SCHED;
            PG8_LDB(B0, 1, 0); PG8_LDB(B1, 1, 1); PG8_SCHED; PG8_LDA(At, 1, 0); PG8_STAGE(PG8_SA(0, 1), a2 + hstep, voffA);
            PG8_WAIT_V(8); PG8_WAIT_L(0); PG8_BAR; PG8_MMA(0, 0, At, B0); PG8_MMA(0, 1, At, B1); PG8_BAR; PG8_SCHED;
            PG8_LDA(At, 1, 1); PG8_STAGE(PG8_SB(1, 0), b3, voffB); PG8_STAGE(PG8_SB(1, 1), b3 + hstep, voffB); PG8_STAGE(PG8_SA(1, 0), a3, voffA);
            PG8_WAIT_V(8); PG8_WAIT_L(0); PG8_BAR; PG8_MMA(1, 0, At, B0); PG8_MMA(1, 1, At, B1); PG8_BAR; PG8_SCHED;
            } else {
            PG8_LDB(B0, 0, 0); PG8_SCHED; PG8_LDA(At, 0, 0); PG8_STAGE(PG8_SA(1, 1), a1 + hstep, voffA);
            PG8_WAIT_L(8); PG8_BAR; PG8_WAIT_L(0); PG8_MMA(0, 0, At, B0); PG8_BAR; PG8_SCHED;
            PG8_LDB(B1, 0, 1); PG8_STAGE(PG8_SB(0, 0), b2, voffB);
            PG8_BAR; PG8_WAIT_L(0); PG8_MMA(0, 1, At, B1); PG8_BAR;
            PG8_LDA(At, 0, 1); PG8_STAGE(PG8_SA(0, 0), a2, voffA);
            PG8_BAR; PG8_WAIT_L(0); PG8_MMA(1, 0, At, B0); PG8_BAR; PG8_SCHED;
            PG8_STAGE(PG8_SB(0, 1), b2 + hstep, voffB);
            PG8_WAIT_V(6); PG8_BAR; PG8_MMA(1, 1, At, B1); PG8_BAR;
            PG8_LDB(B0, 1, 0); PG8_SCHED; PG8_LDA(At, 1, 0); PG8_STAGE(PG8_SA(0, 1), a2 + hstep, voffA);
            PG8_WAIT_L(8); PG8_BAR; PG8_WAIT_L(0); PG8_MMA(0, 0, At, B0); PG8_BAR; PG8_SCHED;
            PG8_LDB(B1, 1, 1); PG8_STAGE(PG8_SB(1, 0), b3, voffB);
            PG8_BAR; PG8_WAIT_L(0); PG8_MMA(0, 1, At, B1); PG8_BAR;
            PG8_LDA(At, 1, 1); PG8_STAGE(PG8_SA(1, 0), a3, voffA);
            PG8_BAR; PG8_WAIT_L(0); PG8_MMA(1, 0, At, B0); PG8_BAR; PG8_SCHED;
            PG8_STAGE(PG8_SB(1, 1), b3 + hstep, voffB);
            PG8_WAIT_V(6); PG8_BAR; PG8_MMA(1, 1, At, B1); PG8_BAR;
            }
        }
        if constexpr (ALIGN_EPI) { if (wr == 0) PG8_BAR; }
        if constexpr (FP8) {
#define PG8_ACC8(a, b) "+v"(acc[a][b][0][0]), "+v"(acc[a][b][0][1]), "+v"(acc[a][b][1][0]), "+v"(acc[a][b][1][1]), "+v"(acc[a][b][2][0]), "+v"(acc[a][b][2][1]), "+v"(acc[a][b][3][0]), "+v"(acc[a][b][3][1])
            asm volatile("s_nop 15\n\ts_nop 15" : PG8_ACC8(0, 0), PG8_ACC8(0, 1) :: "memory");
            asm volatile("" : PG8_ACC8(1, 0), PG8_ACC8(1, 1) :: "memory");
#undef PG8_ACC8
        }
        if constexpr (!Epi::AFTER_DRAIN) { E(acc, cur, wr, wc, fr, fq); S.done(cur); }
        if (!has_next) break;
#pragma unroll
        for (int a = 0; a < 2; ++a)
#pragma unroll
            for (int b = 0; b < 2; ++b)
#pragma unroll
                for (int m = 0; m < 4; ++m)
#pragma unroll
                    for (int n = 0; n < 2; ++n) acc[a][b][m][n] = (f32x4){0.f, 0.f, 0.f, 0.f};
        cur = nxt; cA = nA; cB = nB; ++ui;
        if constexpr (ALIGN_EPI) { if (wr == 1) PG8_BAR; }
    }
    PG8_WAIT_V(0);
    if constexpr (!ALIGN_EPI) { if (wr == 0) PG8_BAR; }
    PG8_BAR;
    if constexpr (Epi::AFTER_DRAIN) { E.fused(acc, cur, wr, wc, fr, fq, lds, wid, lane); S.done(cur); }
#undef PG8_SA
#undef PG8_SB
#undef PG8_STAGE
#undef PG8_LDA
#undef PG8_LDB
#undef PG8_MMA
#undef PG8_WAIT_V
#undef PG8_WAIT_L
#undef PG8_BAR
#undef PG8_SCHED
}

}

#define XB_TMO      128
#define XB_XCNT(j)  (256  + 64 * (j))
#define XB_XSUB(j)  (1280 + 64 * (j))
#define XB_XGEN(j)  (2304 + 64 * (j))
#define XB_TOP      3328
#define XB_TOPGEN   3392
#define XCD_BAR_WORDS 3456
#define XB_SPIN_CAP (1u << 18)
__device__ __forceinline__ unsigned xb_ld(unsigned* p)              { return __hip_atomic_load(p, __ATOMIC_RELAXED, __HIP_MEMORY_SCOPE_AGENT); }
__device__ __forceinline__ unsigned xb_add(unsigned* p, unsigned v) { return __hip_atomic_fetch_add(p, v, __ATOMIC_RELAXED, __HIP_MEMORY_SCOPE_AGENT); }
__device__ __forceinline__ unsigned xb_xcc_id() { return (unsigned)__builtin_amdgcn_s_getreg((3 << 11) | 20) & 0xFu; }
#define XB_SPIN(cond, bar) do { unsigned _sp = 0; while (cond) { __builtin_amdgcn_s_sleep(1); \
    if ((++_sp & 255u) == 0u) { if (xb_ld(&(bar)[XB_TMO])) break; if (_sp > XB_SPIN_CAP) { atomicAdd(&(bar)[XB_TMO], 1u); break; } } } } while (0)
struct XcdBarrier { unsigned* bar; unsigned x; volatile LAS unsigned* st; };
__device__ __forceinline__ XcdBarrier xcd_barrier_post(unsigned* bar, volatile LAS unsigned* st) {
    XcdBarrier b; b.bar = bar; b.x = xb_xcc_id(); b.st = st;
    if (threadIdx.x == 0) (void)xb_add(&bar[XB_XCNT(b.x)], 1u);
    return b;
}
__device__ __forceinline__ void xcd_barrier_complete(unsigned* bar, unsigned x, unsigned& nloc, unsigned& nx) {
    const unsigned G = gridDim.x * gridDim.y * gridDim.z;
    unsigned sum, cnt, mine, sp = 0u;
    for (;;) {
        sum = 0u; cnt = 0u; mine = 0u;
#pragma unroll
        for (unsigned j = 0; j < 16; ++j) { const unsigned c = xb_ld(&bar[XB_XCNT(j)]); sum += c; cnt += (c > 0u) ? 1u : 0u; mine = (j == x) ? c : mine; }
        if (sum == G) break;
        __builtin_amdgcn_s_sleep(1);
        if ((++sp & 255u) == 0u) { if (xb_ld(&bar[XB_TMO])) break; if (sp > XB_SPIN_CAP) { atomicAdd(&bar[XB_TMO], 1u); break; } }
    }
    nloc = mine > 0u ? mine : 1u; nx = cnt > 0u ? cnt : 1u;
}
__device__ __forceinline__ void xcd_barrier(const XcdBarrier& b) {
    asm volatile("s_waitcnt vmcnt(0)" ::: "memory");
    __syncthreads();
    if (threadIdx.x == 0) {
        unsigned* bar = b.bar;
        __builtin_amdgcn_s_waitcnt(0);
        unsigned nloc = b.st[0], nx = b.st[1];
        if (nloc == 0u) { xcd_barrier_complete(bar, b.x, nloc, nx); b.st[0] = nloc; b.st[1] = nx; }
        const unsigned old = xb_add(&bar[XB_XSUB(b.x)], 1u);
        const unsigned gen = old / nloc;
        if (old + 1u == (gen + 1u) * nloc) {
            __builtin_amdgcn_fence(__ATOMIC_RELEASE, "agent");
            asm volatile("s_waitcnt vmcnt(0)" ::: "memory");
            const unsigned og = xb_add(&bar[XB_TOP], 1u);
            const unsigned tg = og / nx;
            if (og + 1u == (tg + 1u) * nx) xb_add(&bar[XB_TOPGEN], 1u);
            else XB_SPIN(xb_ld(&bar[XB_TOPGEN]) == tg, bar);
            __builtin_amdgcn_fence(__ATOMIC_ACQUIRE, "agent");
            xb_add(&bar[XB_XGEN(b.x)], 1u);
            asm volatile("s_waitcnt vmcnt(0)" ::: "memory");
        } else {
            XB_SPIN(xb_ld(&bar[XB_XGEN(b.x)]) == gen, bar);
            __builtin_amdgcn_fence(__ATOMIC_ACQUIRE, "agent");
            asm volatile("s_waitcnt vmcnt(0)" ::: "memory");
        }
    }
    __syncthreads();
}

constexpr int NWAVES = 8;
constexpr int RING_OFF = 0, RING_BYTES = 131072;
constexpr int LDSCTL_OFF = RING_BYTES, MISC_OFF = LDSCTL_OFF + 320;
constexpr int TBL_OFF = LDSCTL_OFF + 1024;
constexpr int LDS_BYTES = 147456;

struct Frame {
    LAS unsigned char* lds; volatile LAS unsigned* MISC; LAS int* tbl; gu32* ctl;
    int tid, lane, wave, vcu, G;
};

__device__ __forceinline__ void p0_transpose_item(const float* W, int K, int N, bf16* WT, int k0, int n0, int orow0, LAS float* scr, int lane) {
#pragma unroll 8
    for (int i = 0; i < 32; ++i) { const int kk = 2 * i + (lane >> 5); scr[kk * 33 + (lane & 31)] = W[(size_t)(k0 + kk) * N + n0 + (lane & 31)]; }
    LDS_WAIT(); asm volatile("" ::: "memory");
    const int c = lane & 7;
#pragma unroll
    for (int j = 0; j < 4; ++j) { const int n = (lane >> 3) + 8 * j; const LAS float* s = scr + (8 * c) * 33 + n;
        u32x4 o; o.x = pk2(s[0 * 33], s[1 * 33]); o.y = pk2(s[2 * 33], s[3 * 33]); o.z = pk2(s[4 * 33], s[5 * 33]); o.w = pk2(s[6 * 33], s[7 * 33]);
        *(GAS u32x4*)(WT + (size_t)(orow0 + n) * K + k0 + 8 * c) = o; }
    LDS_WAIT(); asm volatile("" ::: "memory");
}
__device__ __forceinline__ void p0_transpose_item_fp8(const float* W, int K, int N, unsigned char* WT, int k0, int n0, int orow0, LAS float* scr, int lane) {
#pragma unroll 8
    for (int i = 0; i < 32; ++i) { const int kk = 2 * i + (lane >> 5); scr[kk * 33 + (lane & 31)] = W[(size_t)(k0 + kk) * N + n0 + (lane & 31)]; }
    LDS_WAIT(); asm volatile("" ::: "memory");
    const int c = lane & 7;
#pragma unroll
    for (int j = 0; j < 4; ++j) { const int n = (lane >> 3) + 8 * j; const LAS float* sp = scr + (8 * c) * 33 + n;
        u32x2 o; o.x = pk4_fp8(sp[0 * 33] * 32.f, sp[1 * 33] * 32.f, sp[2 * 33] * 32.f, sp[3 * 33] * 32.f); o.y = pk4_fp8(sp[4 * 33] * 32.f, sp[5 * 33] * 32.f, sp[6 * 33] * 32.f, sp[7 * 33] * 32.f);
        *(GAS u32x2*)(WT + (size_t)(orow0 + n) * K + k0 + 8 * c) = o; }
    LDS_WAIT(); asm volatile("" ::: "memory");
}
__device__ __forceinline__ void rms_row_to_bf16(const float* xrow, const float* g, bf16* orow, int lane) {
    const GAS f32x4* xr = (const GAS f32x4*)xrow + lane; f32x4 v[4]; float s = 0.f;
#pragma unroll
    for (int j = 0; j < 4; ++j) { v[j] = xr[64 * j]; s += (v[j].x * v[j].x + v[j].y * v[j].y) + (v[j].z * v[j].z + v[j].w * v[j].w); }
    const float rstd = 1.f / sqrtf(wave_sum(s) * (1.f / D) + EPS);
    GAS unsigned long long* o8 = (GAS unsigned long long*)orow + lane;
#pragma unroll
    for (int j = 0; j < 4; ++j) { const f32x4 gg = ((const GAS f32x4*)g)[lane + 64 * j];
        o8[64 * j] = (unsigned long long)pk2(v[j].x * rstd * gg.x, v[j].y * rstd * gg.y) | ((unsigned long long)pk2(v[j].z * rstd * gg.z, v[j].w * rstd * gg.w) << 32); }
}

__device__ __forceinline__ void rms_row_to_fp8(const float* xrow, const float* g, unsigned char* orow, int lane) {
    const GAS f32x4* xr = (const GAS f32x4*)xrow + lane; f32x4 v[4]; float s = 0.f;
#pragma unroll
    for (int j = 0; j < 4; ++j) { v[j] = xr[64 * j]; s += (v[j].x * v[j].x + v[j].y * v[j].y) + (v[j].z * v[j].z + v[j].w * v[j].w); }
    const float rstd = 1.f / sqrtf(wave_sum(s) * (1.f / D) + EPS);
    GAS unsigned* o4 = (GAS unsigned*)orow + lane;
#pragma unroll
    for (int j = 0; j < 4; ++j) { const f32x4 gg = ((const GAS f32x4*)g)[lane + 64 * j]; o4[64 * j] = pk4_fp8(v[j].x * rstd * gg.x, v[j].y * rstd * gg.y, v[j].z * rstd * gg.z, v[j].w * rstd * gg.w); }
}
constexpr float LOG2E = 1.4426950408889634f;
typedef __bf16 bf16x2_t __attribute__((ext_vector_type(2)));
__device__ __forceinline__ unsigned cvtpk_v(float lo, float hi) { const f32x2 v = {lo, hi}; const bf16x2_t b = __builtin_convertvector(v, bf16x2_t); return __builtin_bit_cast(unsigned, b); }
struct AttFrags { bf16x8 k0a, k0b, k1a, k1b, v[4]; };
__device__ __forceinline__ float gmax4(float m) {
    { auto rr = __builtin_amdgcn_permlane16_swap(__float_as_uint(m), __float_as_uint(m), false, false); m = fmaxf(__uint_as_float(rr[0]), __uint_as_float(rr[1])); }
    { auto rr = __builtin_amdgcn_permlane32_swap(__float_as_uint(m), __float_as_uint(m), false, false); m = fmaxf(__uint_as_float(rr[0]), __uint_as_float(rr[1])); }
    return m;
}
template <int NH, int HW>
__device__ __forceinline__ void band_group(f32x4 (&o)[NH][4], float (&mrun)[NH], float (&lrun)[NH], const bf16* qkvb, const int (&qcol)[NH], const int (&qmu0)[NH], int kcol, const bf16* vt,
                                           int dil, int rho, int L, int qstep, int P0, int npairs, const LAS float* const (&bias)[NH], int lane) {
    const int t = lane & 15, g = lane >> 4;
    bf16x8 qf[NH][2]; int mu_t[NH];
#pragma unroll
    for (int h = 0; h < NH; ++h) { mu_t[h] = qmu0[h] + qstep * t; const bf16* qrow = qkvb + (size_t)(mu_t[h] * dil + rho) * NQKV + 8 * g + qcol[h];
        qf[h][0] = *(const bf16x8*)qrow; qf[h][1] = *(const bf16x8*)(qrow + 32); }
    const int npr = L >> 5;
    const bf16* kbase = qkvb + (size_t)rho * NQKV + kcol + 8 * g;
    const bf16* vtl = vt + (size_t)t * 8192 + (size_t)rho * L + 8 * g;
    auto load = [&](int P, AttFrags& f) {
        const int Pc = min(max(P, 0), npr - 1);
        const bf16* k0p = kbase + (size_t)((32 * Pc + t) * dil) * NQKV; const bf16* k1p = k0p + (size_t)(16 * dil) * NQKV;
        f.k0a = *(const bf16x8*)k0p; f.k0b = *(const bf16x8*)(k0p + 32); f.k1a = *(const bf16x8*)k1p; f.k1b = *(const bf16x8*)(k1p + 32);
#pragma unroll
        for (int db = 0; db < 4; ++db) f.v[db] = *(const bf16x8*)(vtl + (size_t)(16 * db) * 8192 + 32 * Pc);
    };
    AttFrags cur; load(P0, cur);
    for (int pp = 0; pp < npairs; ++pp) {
        const int P = P0 + pp;
        AttFrags nxt; load(P0 + min(pp + 1, npairs - 1), nxt);
        if (P >= 0 && P < npr) {
            const int kap0 = 32 * P + 4 * g;
#pragma unroll
            for (int h = 0; h < NH; ++h) {
                f32x4 s0 = (f32x4){0.f, 0.f, 0.f, 0.f}, s1 = (f32x4){0.f, 0.f, 0.f, 0.f};
                s0 = __builtin_amdgcn_mfma_f32_16x16x32_bf16(cur.k0a, qf[h][0], s0, 0, 0, 0); s0 = __builtin_amdgcn_mfma_f32_16x16x32_bf16(cur.k0b, qf[h][1], s0, 0, 0, 0);
                s1 = __builtin_amdgcn_mfma_f32_16x16x32_bf16(cur.k1a, qf[h][0], s1, 0, 0, 0); s1 = __builtin_amdgcn_mfma_f32_16x16x32_bf16(cur.k1b, qf[h][1], s1, 0, 0, 0);
                const int rel0 = kap0 - mu_t[h];
                float bv[8], sc[8], p[8], ps = 0.f;
#pragma unroll
                for (int j = 0; j < 8; ++j) { const int dj = (j < 4) ? j : 12 + j; bv[j] = bias[h][min(max(rel0 + dj + HW, 0), 2 * HW)]; }
#pragma unroll
                for (int j = 0; j < 8; ++j) { const int dj = (j < 4) ? j : 12 + j; const int rel = rel0 + dj; const float sv = (j < 4) ? s0[j & 3] : s1[j & 3];
                    const float v = sv * (0.125f * LOG2E) + bv[j]; sc[j] = ((unsigned)(rel + HW) <= (unsigned)(2 * HW)) ? v : -3.0e38f; }
                float mx = fmaxf(fmaxf(fmaxf(sc[0], sc[1]), fmaxf(sc[2], sc[3])), fmaxf(fmaxf(sc[4], sc[5]), fmaxf(sc[6], sc[7])));
                mx = gmax4(mx);
                const float mn = fmaxf(mrun[h], mx), alpha = __builtin_amdgcn_exp2f(mrun[h] - mn); mrun[h] = mn;
#pragma unroll
                for (int j = 0; j < 8; ++j) { p[j] = __builtin_amdgcn_exp2f(sc[j] - mn); ps += p[j]; }
                lrun[h] = lrun[h] * alpha + ps;
                u32x4 pw; pw.x = cvtpk_v(p[0], p[1]); pw.y = cvtpk_v(p[2], p[3]); pw.z = cvtpk_v(p[4], p[5]); pw.w = cvtpk_v(p[6], p[7]);
                const bf16x8 pf = __builtin_bit_cast(bf16x8, pw);
#pragma unroll
                for (int db = 0; db < 4; ++db) { o[h][db] = o[h][db] * alpha; o[h][db] = __builtin_amdgcn_mfma_f32_16x16x32_bf16(cur.v[db], pf, o[h][db], 0, 0, 0); }
                if (NH > 2 && h + 1 < NH) __builtin_amdgcn_sched_barrier(0);
            }
        }
        cur = nxt;
    }
}
template <int NH>
__device__ __forceinline__ void band_store(const f32x4 (&o)[NH][4], const float (&lrun)[NH], bf16* const (&yrow)[NH], int lane) {
    const int g = lane >> 4;
#pragma unroll
    for (int h = 0; h < NH; ++h) { float l = lrun[h]; l += __shfl_xor(l, 16); l += __shfl_xor(l, 32); const float inv = 1.f / l;
#pragma unroll
        for (int db = 0; db < 4; ++db) { u32x2 w; w.x = pg8::cvt_pk_bf16(o[h][db][0] * inv, o[h][db][1] * inv); w.y = pg8::cvt_pk_bf16(o[h][db][2] * inv, o[h][db][3] * inv);
            *(u32x2*)(yrow[h] + 16 * db + 4 * g) = w; } }
}

struct Args { const float* in[19]; float* out; unsigned char* ws; int ph_lo, ph_hi, li, pad; };
constexpr int NPHASE = 10;

__global__ void __launch_bounds__(NWAVES * 64, 2) mk_fwd(Args args) {
    extern __shared__ __attribute__((aligned(16))) unsigned char lds[];
    Frame F;
    F.lds = (LAS unsigned char*)lds; F.MISC = (volatile LAS unsigned*)(F.lds + MISC_OFF); F.tbl = (LAS int*)(F.lds + TBL_OFF);
    F.tid = threadIdx.x; F.lane = F.tid & 63; F.wave = __builtin_amdgcn_readfirstlane(F.tid >> 6);
    F.G = gridDim.x; { const int bx = blockIdx.x; F.vcu = (F.G % 8 == 0) ? (bx % 8) * (F.G / 8) + bx / 8 : bx; }
    unsigned char* ws = args.ws; F.ctl = (gu32*)(ws + WS_CTL);
    const float* x = args.in[0]; const float* norm_mix = args.in[1]; const float* w_in = args.in[2]; const float* b_in = args.in[3];
    const float* sinks = args.in[4]; const float* rel_bias = args.in[5]; const float* w_a = args.in[6]; const float* w_b = args.in[7];
    const float* w_out = args.in[8]; const float* norm_ffn = args.in[9]; const float* router_w = args.in[10]; const float* router_b = args.in[11];
    const float* w_gate = args.in[12]; const float* b_gate = args.in[13]; const float* w_up = args.in[14]; const float* b_up = args.in[15];
    const float* w_down = args.in[16]; const float* b_down = args.in[17]; const float* norm_final = args.in[18];
    float* out = args.out;
    Tabs* tb = (Tabs*)(ws + WS_TAB);
    bf16* Win_t = (bf16*)(ws + WS_WIN); bf16* Wa_t = (bf16*)(ws + WS_WA); bf16* Wb_t = (bf16*)(ws + WS_WB); bf16* Wout_t = (bf16*)(ws + WS_WOUT);
    unsigned char* Wgu8 = ws + WS_WGU; unsigned char* Wd8 = ws + WS_WD; unsigned char* H28 = ws + WS_H2; unsigned char* HS8 = ws + WS_HS; unsigned char* ACT8 = ws + WS_ACT; unsigned char* YS = ws + WS_YS;
    int* topi = (int*)(ws + WS_RT); float* topp = (float*)(ws + WS_RT + 256 * 1024); int* slot = (int*)(ws + WS_RT + 512 * 1024); int* pos = (int*)(ws + WS_RT + 768 * 1024);
    bf16* XN = (bf16*)(ws + WS_XN); bf16* QKV = (bf16*)(ws + WS_QKV); bf16* GATES = (bf16*)(ws + WS_GATES); bf16* YA = (bf16*)(ws + WS_YA); bf16* YB = (bf16*)(ws + WS_YB);
    bf16* MERGED = (bf16*)(ws + WS_MERGED);
    gu32* cnt = F.ctl + CW_CNT;

    for (int u = F.tid; u < (LDS_BYTES - LDSCTL_OFF) / 4; u += NWAVES * 64) ((LAS unsigned*)(F.lds + LDSCTL_OFF))[u] = 0u;
    __syncthreads();
    XcdBarrier bar = xcd_barrier_post((unsigned*)(F.ctl + CW_BAR) + args.li * XCD_BAR_WORDS, F.MISC + 8);
    const int lo = args.ph_lo, hi = args.ph_hi;
#ifndef MK_SKIP
#define MK_SKIP 0
#endif
#define IN(k) (!((MK_SKIP >> (k)) & 1) && lo <= (k) && (k) < hi)
#ifndef MK_DUP
#define MK_DUP 0
#endif
#define REP(k) _Pragma("unroll") for (int rep_ = 0; rep_ < 1 + ((MK_DUP >> (k)) & 1); ++rep_)
#define SEAM(k) do { if (IN(k) && IN((k) + 1)) xcd_barrier(bar); } while (0)
    const int gw = F.vcu * NWAVES + F.wave, NGW = F.G * NWAVES;

    if (IN(0)) REP(0) {
        { const int i = blockIdx.x * (NWAVES * 64) + F.tid;
          if (i < 16 * 257) { const int h = i / 257, r = i % 257; tb->biasA[h][r] = rel_bias[BKT_A[r] * 28 + h]; }
          if (i < 12 * 129) { const int g = i / (4 * 129), hs = (i / 129) % 4, r = i % 129; tb->biasB[g][hs][r] = rel_bias[BKT_B[g][r] * 28 + 16 + 4 * g + hs]; } }
        LAS float* scr = (LAS float*)(F.lds + RING_OFF + F.wave * 16384);
        constexpr int I_IN = (D / 64) * (NPROJ / 32), I_A = (D / 64) * (D / 32), I_B = (256 / 64) * (D / 32), I_E = (D / 64) * (D / 32);
        constexpr int NITEMS = I_IN + 2 * I_A + I_B + 3 * NE * I_E;
        for (int it = gw; it < NITEMS; it += NGW) {
            int r = it;
            if (r < I_IN) { const int nb = NPROJ / 32; p0_transpose_item_fp8(w_in, D, NPROJ, (unsigned char*)Win_t, 64 * (r / nb), 32 * (r % nb), 32 * (r % nb), scr, F.lane); continue; } r -= I_IN;
            if (r < I_A) { const int nb = D / 32; p0_transpose_item(w_a, D, D, Wa_t, 64 * (r / nb), 32 * (r % nb), 32 * (r % nb), scr, F.lane); continue; } r -= I_A;
            if (r < I_A) { const int nb = D / 32; p0_transpose_item(w_out, D, D, Wout_t, 64 * (r / nb), 32 * (r % nb), 32 * (r % nb), scr, F.lane); continue; } r -= I_A;
            if (r < I_B) { const int nb = D / 32; p0_transpose_item(w_b, 256, D, Wb_t, 64 * (r / nb), 32 * (r % nb), 32 * (r % nb), scr, F.lane); continue; } r -= I_B;
            { const int e = r / (3 * I_E), q = r % (3 * I_E), which = q / I_E, ii = q % I_E, nb = D / 32, k0 = 64 * (ii / nb), n0 = 32 * (ii % nb);
              if (which == 0) p0_transpose_item_fp8(w_gate + (size_t)e * D * D, D, D, Wgu8, k0, n0, e * 2048 + (n0 >> 7) * 256 + (n0 & 127), scr, F.lane);
              else if (which == 1) p0_transpose_item_fp8(w_up + (size_t)e * D * D, D, D, Wgu8, k0, n0, e * 2048 + (n0 >> 7) * 256 + 128 + (n0 & 127), scr, F.lane);
              else p0_transpose_item_fp8(w_down + (size_t)e * D * D, D, D, Wd8, k0, n0, e * 1024 + n0, scr, F.lane); }
        }
        for (int m = gw; m < T; m += NGW) rms_row_to_fp8(x + (size_t)m * D, norm_mix, (unsigned char*)XN + (size_t)m * D, F.lane);
    }
    SEAM(0);
    if (IN(1)) REP(1) {
        int k512 = D / 2; asm volatile("" : "+s"(k512));
        pg8::Gemm g{XN, Win_t, k512}; pg8::StaticOrder So; So.init(T, NPROJ, F.G, (int)blockIdx.x);
        pg8::EpiProj E{QKV, GATES, b_in, (bf16*)(ws + WS_VT), (bf16*)(ws + WS_VT) + (size_t)2 * 4 * 64 * 8192};
        pg8::gemm_phase<pg8::EpiProj, pg8::StaticOrder, true, true, true>(F.lds + RING_OFF, g, So, E);
    }
    SEAM(1);
    if (IN(2)) REP(2) {
        LAS float* lb = (LAS float*)(F.lds + RING_OFF);
        for (int i = F.tid; i < 4112 + 1548; i += NWAVES * 64) lb[i] = ((const float*)tb)[i] * LOG2E;
        __syncthreads();
        const bf16* VTA = (const bf16*)(ws + WS_VT); const bf16* VTB = VTA + (size_t)2 * 4 * 64 * 8192;
        for (int it = gw; it < 4096 + 2048; it += NGW) {
            const int t = F.lane & 15;
            if (it < 4096) {
                const int b = it >> 11, kvh = (it >> 9) & 3, qb = it & 511;
                f32x4 o[4][4]; float mr[4], lr[4];
#pragma unroll
                for (int h = 0; h < 4; ++h) { mr[h] = sinks[kvh * 4 + h] * LOG2E; lr[h] = (F.lane < 16) ? 1.f : 0.f;
#pragma unroll
                    for (int db = 0; db < 4; ++db) o[h][db] = (f32x4){0.f, 0.f, 0.f, 0.f}; }
                const int qcol[4] = {C_QA + (kvh * 4 + 0) * 64, C_QA + (kvh * 4 + 1) * 64, C_QA + (kvh * 4 + 2) * 64, C_QA + (kvh * 4 + 3) * 64};
                const int qmu[4] = {16 * qb, 16 * qb, 16 * qb, 16 * qb};
                const LAS float* const bias[4] = {lb + (kvh * 4 + 0) * 257, lb + (kvh * 4 + 1) * 257, lb + (kvh * 4 + 2) * 257, lb + (kvh * 4 + 3) * 257};
                band_group<4, 128>(o, mr, lr, QKV + (size_t)b * S * NQKV, qcol, qmu, C_KA + kvh * 64, VTA + (size_t)((b * 4 + kvh) * 64) * 8192, 1, 0, S, 1, (qb - 8) >> 1, 9, bias, F.lane);
                bf16* yr = YA + (size_t)(b * S + 16 * qb + t) * D + kvh * 256; bf16* const yrow[4] = {yr, yr + 64, yr + 128, yr + 192};
                band_store<4>(o, lr, yrow, F.lane);
            } else {
                const int j = it - 4096, r = j & 7, un = j >> 3, blk = un & 31, hs = (un >> 5) & 3, b = un >> 7, i0 = blk * 256;
                f32x4 o[2][4]; float mr[2], lr[2];
#pragma unroll
                for (int h = 0; h < 2; ++h) { mr[h] = -1.0e30f; lr[h] = 0.f;
#pragma unroll
                    for (int db = 0; db < 4; ++db) o[h][db] = (f32x4){0.f, 0.f, 0.f, 0.f}; }
                const bf16* qb_ = QKV + (size_t)b * S * NQKV;
                { const int qcol[2] = {C_QB + 0 * 256 + hs * 64, C_QB + 0 * 256 + hs * 64}; const int qmu[2] = {i0 + r, i0 + r + 8}; const LAS float* const bias[2] = {lb + 4112 + (0 * 4 + hs) * 129, lb + 4112 + (0 * 4 + hs) * 129};
                  band_group<2, 64>(o, mr, lr, qb_, qcol, qmu, C_KB + 0 * 256 + hs * 64, VTB + (size_t)(((0 * 2 + b) * 4 + hs) * 64) * 8192, 1, 0, S, 16, (i0 >> 5) - 2, 12, bias, F.lane); }
                { const int qcol[2] = {C_QB + 1 * 256 + hs * 64, C_QB + 1 * 256 + hs * 64}; const int qmu[2] = {(i0 + r) >> 2, (i0 + r + 8) >> 2}; const LAS float* const bias[2] = {lb + 4112 + (1 * 4 + hs) * 129, lb + 4112 + (1 * 4 + hs) * 129};
                  band_group<2, 64>(o, mr, lr, qb_, qcol, qmu, C_KB + 1 * 256 + hs * 64, VTB + (size_t)(((1 * 2 + b) * 4 + hs) * 64) * 8192, 4, r & 3, S / 4, 4, (i0 >> 7) - 2, 6, bias, F.lane); }
#pragma unroll
                for (int h = 0; h < 2; ++h) { const int qcol[1] = {C_QB + 2 * 256 + hs * 64}; const int qmu[1] = {i0 >> 4}; const LAS float* const bias[1] = {lb + 4112 + (2 * 4 + hs) * 129};
                  band_group<1, 64>(*(f32x4(*)[1][4])&o[h], *(float(*)[1])&mr[h], *(float(*)[1])&lr[h], qb_, qcol, qmu, C_KB + 2 * 256 + hs * 64, VTB + (size_t)(((2 * 2 + b) * 4 + hs) * 64) * 8192,
                                    16, r + 8 * h, S / 16, 1, (blk - 4) >> 1, 5, bias, F.lane); }
                bf16* yr = YB + (size_t)(b * S + i0 + r + 16 * t) * 256 + hs * 64; bf16* const yrow[2] = {yr, yr + 8 * 256};
                band_store<2>(o, lr, yrow, F.lane);
            }
        }
        __syncthreads();
    }
    SEAM(2);
    if (IN(3)) REP(3) {
#ifndef NO_P3A
        { int k256 = 256; asm volatile("" : "+s"(k256)); pg8::Gemm g{YB, Wb_t, k256}; pg8::StaticOrder So; So.init(T, D, F.G, (int)blockIdx.x);
          pg8::EpiGate<0> E{MERGED, GATES, 1024};
          pg8::gemm_phase<pg8::EpiGate<0>, pg8::StaticOrder, true, true>(F.lds + RING_OFF, g, So, E); }
#endif
        VM_WAIT(); __syncthreads();
#ifndef NO_P3B
        { pg8::Gemm g{YA, Wa_t, D}; pg8::StaticOrder So; So.init(T, D, F.G, (int)blockIdx.x);
          pg8::EpiGate<1> E{MERGED, GATES, 0};
          pg8::gemm_phase<pg8::EpiGate<1>, pg8::StaticOrder, true, true>(F.lds + RING_OFF, g, So, E); }
#endif
    }
    SEAM(3);
    if (IN(4)) REP(4) {
        pg8::Gemm g{MERGED, Wout_t, D}; pg8::StaticOrder So; So.init(T, D, F.G, (int)blockIdx.x);
        pg8::EpiX1 E{x, out};
        pg8::gemm_phase<pg8::EpiX1, pg8::StaticOrder, true, true>(F.lds + RING_OFF, g, So, E);
    }
    SEAM(4);
    if (IN(5)) REP(5) {
        const bool lastrep5 = (rep_ + 1 == 1 + ((MK_DUP >> 5) & 1));
        LAS int* lcnt = F.tbl + 72; LAS int* lbase = F.tbl + 104; LAS int* ebuf = F.tbl + 136; LAS int* pbuf = F.tbl + 392;
        LAS float* plog = (LAS float*)(F.lds + RING_OFF);
        LAS float* psq = plog + 8 * 64 * 32;
        LAS float* rstd_s = psq + 512;
        const int g = F.lane >> 4, e16 = F.lane & 15, w = F.wave;
        float wB[32][2];
#pragma unroll
        for (int sc = 0; sc < 32; ++sc) { const int k = 128 * w + 32 * (sc >> 3) + 8 * g + (sc & 7); const float gm = norm_ffn[k];
            wB[sc][0] = gm * router_w[(size_t)k * NE + e16]; wB[sc][1] = gm * router_w[(size_t)k * NE + 16 + e16]; }
        for (int tblk = F.vcu; tblk < T / 64; tblk += F.G) {
            if (F.tid < 32) lcnt[F.tid] = 0;
#pragma unroll 1
            for (int tile = 0; tile < 4; ++tile) {
                const GAS float* xr = (const GAS float*)out + (size_t)(tblk * 64 + tile * 16 + e16) * D + 128 * w + 8 * g;
                f32x4 v[4][2]; float sq = 0.f;
#pragma unroll
                for (int s4 = 0; s4 < 4; ++s4) { v[s4][0] = *(const GAS f32x4*)(xr + 32 * s4); v[s4][1] = *(const GAS f32x4*)(xr + 32 * s4 + 4); }
#pragma unroll
                for (int s4 = 0; s4 < 4; ++s4) sq += (v[s4][0].x * v[s4][0].x + v[s4][0].y * v[s4][0].y) + (v[s4][0].z * v[s4][0].z + v[s4][0].w * v[s4][0].w)
                                                   + (v[s4][1].x * v[s4][1].x + v[s4][1].y * v[s4][1].y) + (v[s4][1].z * v[s4][1].z + v[s4][1].w * v[s4][1].w);
                sq += __shfl_xor(sq, 16); sq += __shfl_xor(sq, 32);
                if (g == 0) psq[w * 64 + tile * 16 + e16] = sq;
                f32x4 a0 = (f32x4){0.f, 0.f, 0.f, 0.f}, a1 = (f32x4){0.f, 0.f, 0.f, 0.f};
#pragma unroll
                for (int s4 = 0; s4 < 4; ++s4)
#pragma unroll
                    for (int c = 0; c < 8; ++c) { const float av = v[s4][c >> 2][c & 3];
                        a0 = __builtin_amdgcn_mfma_f32_16x16x4f32(av, wB[s4 * 8 + c][0], a0, 0, 0, 0); a1 = __builtin_amdgcn_mfma_f32_16x16x4f32(av, wB[s4 * 8 + c][1], a1, 0, 0, 0); }
#pragma unroll
                for (int r = 0; r < 4; ++r) { LAS float* pr = plog + (size_t)(w * 64 + tile * 16 + 4 * g + r) * 32 + e16; pr[0] = a0[r]; pr[16] = a1[r]; }
            }
            __syncthreads();
            if (F.tid < 64) { float s = 0.f;
#pragma unroll
                for (int ww = 0; ww < 8; ++ww) s += psq[ww * 64 + F.tid];
                rstd_s[F.tid] = 1.f / sqrtf(s * (1.f / D) + EPS); }
            __syncthreads();
            { const int e = F.tid & 31; const float rbv = router_b[e];
#pragma unroll 1
              for (int i = 0; i < 4; ++i) { const int tl = (F.tid >> 5) + 16 * i; float lg = 0.f;
#pragma unroll
                for (int ww = 0; ww < 8; ++ww) lg += plog[(size_t)(ww * 64 + tl) * 32 + e];
                float val = lg * rstd_s[tl] + rbv; float tv[4]; int ti[4];
#pragma unroll
                for (int r = 0; r < 4; ++r) {
                    float bv = val; int bi = e;
#pragma unroll
                    for (int o = 1; o < 32; o <<= 1) { const float ov = __shfl_xor(bv, o); const int oi = __shfl_xor(bi, o); if (ov > bv || (ov == bv && oi < bi)) { bv = ov; bi = oi; } }
                    tv[r] = bv; ti[r] = bi; if (bi == e) val = -3.0e38f;
                }
                const float e1 = __expf(tv[1] - tv[0]), e2 = __expf(tv[2] - tv[0]), e3 = __expf(tv[3] - tv[0]); const float inv = 1.f / (1.f + e1 + e2 + e3);
                if (e < 4) { const float p = (e == 0 ? 1.f : e == 1 ? e1 : e == 2 ? e2 : e3) * inv; const int ex = (e == 0 ? ti[0] : e == 1 ? ti[1] : e == 2 ? ti[2] : ti[3]);
                    const int m = tblk * 64 + tl; topi[m * 4 + e] = ex; topp[m * 4 + e] = p;
                    const int li = tl * 4 + e; ebuf[li] = ex; pbuf[li] = __hip_atomic_fetch_add(&lcnt[ex], 1, __ATOMIC_RELAXED, __HIP_MEMORY_SCOPE_WORKGROUP); } } }
#pragma unroll 1
            for (int r = 0; r < 8; ++r) { const int tl = w * 8 + r; const float rstd = rstd_s[tl]; const size_t m = (size_t)tblk * 64 + tl;
                const GAS f32x4* xr4 = (const GAS f32x4*)(out + m * D) + F.lane; GAS unsigned* o4 = (GAS unsigned*)(H28 + m * D) + F.lane;
#pragma unroll
                for (int j = 0; j < 4; ++j) { const f32x4 xv = xr4[64 * j]; const f32x4 gg = ((const GAS f32x4*)norm_ffn)[F.lane + 64 * j];
                    o4[64 * j] = pk4_fp8(xv.x * rstd * gg.x, xv.y * rstd * gg.y, xv.z * rstd * gg.z, xv.w * rstd * gg.w); } }
            __syncthreads();
            if (F.tid < 32) lbase[F.tid] = lastrep5 ? (int)__hip_atomic_fetch_add(cnt + F.tid, (unsigned)lcnt[F.tid], RLX_AGENT) : 0;
            __syncthreads();
            if (F.tid < 256) pos[tblk * 256 + F.tid] = lbase[ebuf[F.tid]] + pbuf[F.tid];
            __syncthreads();
        }
    }
    SEAM(5);
    if (IN(6) || IN(7) || IN(8)) {
        LAS int* loff = F.tbl; LAS int* ltoff = F.tbl + 36; LAS int* lc = F.tbl + 72;
        if (F.tid < 32) lc[F.tid] = (int)__hip_atomic_load(cnt + F.tid, RLX_AGENT);
        __syncthreads();
        if (F.tid == 0) { int a = 0, ta = 0; for (int e = 0; e < NE; ++e) { loff[e] = a; ltoff[e] = ta; const int c = lc[e]; a += c; ta += (c + 255) >> 8; } loff[NE] = a; ltoff[NE] = ta; }
        __syncthreads();
    }
    if (IN(6)) REP(6) {
        const LAS int* loff = F.tbl;
        for (int p = gw; p < T * 4; p += NGW) {
            const int e = topi[p], row = loff[e] + pos[p];
            if (F.lane == 0) slot[p] = row;
            const GAS u32x4* src = (const GAS u32x4*)(H28 + (size_t)(p >> 2) * D) + F.lane; GAS u32x4* dst = (GAS u32x4*)(HS8 + (size_t)row * D) + F.lane;
            const u32x4 a = src[0]; dst[0] = a;
        }
    }
    SEAM(6);
    if (IN(7)) REP(7) {
        int k512 = D / 2; asm volatile("" : "+s"(k512));
        pg8::Gemm g{(const bf16*)HS8, (const bf16*)Wgu8, k512}; pg8::GroupOrder So{F.tbl + 36, F.tbl, 8, F.G, (int)blockIdx.x, 0}; So.nunits = __builtin_amdgcn_readfirstlane(F.tbl[36 + NE]) * 8;
        pg8::EpiSwiglu E{ACT8, b_gate, b_up};
        pg8::gemm_phase<pg8::EpiSwiglu, pg8::GroupOrder, true, FP8_SP2, true>(F.lds + RING_OFF, g, So, E);
    }
    SEAM(7);
    if (IN(8)) REP(8) {
        int k512 = D / 2; asm volatile("" : "+s"(k512));
        pg8::Gemm g{(const bf16*)ACT8, (const bf16*)Wd8, k512}; pg8::GroupOrder So{F.tbl + 36, F.tbl, 4, F.G, (int)blockIdx.x, 0}; So.nunits = __builtin_amdgcn_readfirstlane(F.tbl[36 + NE]) * 4;
        pg8::EpiDown E{YS, b_down};
        pg8::gemm_phase<pg8::EpiDown, pg8::GroupOrder, true, FP8_SP2, true>(F.lds + RING_OFF, g, So, E);
    }
    SEAM(8);
#ifdef MK_XBAR
    for (int xb_ = 0; xb_ < MK_XBAR; ++xb_) xcd_barrier(bar);
#endif
    if (IN(9)) REP(9) {
        const unsigned char* ys = YS;
        float* dst9 = (rep_ + 1 < 1 + ((MK_DUP >> 9) & 1)) ? (float*)(ws + WS_ACT) : out;
        for (int m = gw; m < T; m += NGW) {
            GAS f32x4* xr = (GAS f32x4*)(out + (size_t)m * D) + F.lane; f32x4 v[4];
#pragma unroll
            for (int j = 0; j < 4; ++j) v[j] = xr[64 * j];
#pragma unroll
            for (int k = 0; k < 4; ++k) { const int r = slot[m * 4 + k]; const float p = topp[m * 4 + k]; const GAS unsigned* yr = (const GAS unsigned*)(ys + (size_t)r * D) + F.lane;
#pragma unroll
                for (int j = 0; j < 4; ++j) { const unsigned u = yr[64 * j]; const f32x2 lo = __builtin_amdgcn_cvt_pk_f32_fp8(u, false), hi = __builtin_amdgcn_cvt_pk_f32_fp8(u, true);
                    v[j].x += p * lo.x; v[j].y += p * lo.y; v[j].z += p * hi.x; v[j].w += p * hi.y; } }
            float s = 0.f;
#pragma unroll
            for (int j = 0; j < 4; ++j) s += (v[j].x * v[j].x + v[j].y * v[j].y) + (v[j].z * v[j].z + v[j].w * v[j].w);
            const float rstd = 1.f / sqrtf(wave_sum(s) * (1.f / D) + EPS);
#pragma unroll
            for (int j = 0; j < 4; ++j) { const f32x4 gg = ((const GAS f32x4*)norm_final)[F.lane + 64 * j]; f32x4 y; y.x = v[j].x * rstd * gg.x; y.y = v[j].y * rstd * gg.y; y.z = v[j].z * rstd * gg.z; y.w = v[j].w * rstd * gg.w; ((GAS f32x4*)(dst9 + (size_t)m * D) + F.lane)[64 * j] = y; }
        }
    }
#undef IN
#undef SEAM
}

extern "C" void kernel_launch(void* const* d_in, const int* in_sizes, int n_in, void* d_out, int out_size, void* d_ws, size_t ws_size, hipStream_t stream) {
    static int grid = 0;
    if (grid == 0) {
        if (n_in != 19 || in_sizes[0] != T * D || out_size != T * D || ws_size < WS_END) { fprintf(stderr, "kernel_launch: unexpected shapes (n_in %d, ws %zu); nothing launched\n", n_in, ws_size); grid = -1; return; }
        int dev = 0, cus = 0, per_cu = 0;
        if (hipGetDevice(&dev) != hipSuccess || hipDeviceGetAttribute(&cus, hipDeviceAttributeMultiprocessorCount, dev) != hipSuccess) { grid = -1; return; }
        if (hipFuncSetAttribute((const void*)mk_fwd, hipFuncAttributeMaxDynamicSharedMemorySize, LDS_BYTES) != hipSuccess) { fprintf(stderr, "kernel_launch: hipFuncSetAttribute failed\n"); grid = -1; return; }
        if (hipOccupancyMaxActiveBlocksPerMultiprocessor(&per_cu, (const void*)mk_fwd, NWAVES * 64, LDS_BYTES) != hipSuccess || per_cu < 1) { fprintf(stderr, "kernel_launch: occupancy query says %d blocks per CU\n", per_cu); }
        (void)hipGetLastError();
        grid = cus;
        if (grid != 256) fprintf(stderr, "kernel_launch: %d CUs (built and tuned for 256)\n", grid);
    }
    if (grid < 0) return;
    if (hipMemsetAsync((char*)d_ws + WS_CTL, 0, CTL_ZERO_BYTES, stream) != hipSuccess) return;
    Args a{};
    for (int i = 0; i < 19; ++i) a.in[i] = (const float*)d_in[i];
    a.out = (float*)d_out; a.ws = (unsigned char*)d_ws;
#if MK_MODE == 2
    a.ph_lo = 0; a.ph_hi = NPHASE; a.li = 0;
    hipLaunchKernelGGL(mk_fwd, dim3(grid), dim3(NWAVES * 64), LDS_BYTES, stream, a);
#else
    for (int ph = 0; ph < NPHASE; ++ph) { a.ph_lo = ph; a.ph_hi = ph + 1; a.li = ph; hipLaunchKernelGGL(mk_fwd, dim3(grid), dim3(NWAVES * 64), LDS_BYTES, stream, a); }
#endif
}
```

```cpp
#define MK_DUP 0
#include <hip/hip_runtime.h>
#include <stdint.h>
#include <stdio.h>

#ifndef FP8_SP2
#define FP8_SP2 true
#endif
#ifndef MK_MODE
#define MK_MODE 2
#endif

typedef unsigned short bf16;
typedef short bf16x8 __attribute__((ext_vector_type(8)));
typedef float f32x4 __attribute__((ext_vector_type(4)));
typedef float f32x2 __attribute__((ext_vector_type(2)));
typedef unsigned u32x4 __attribute__((ext_vector_type(4)));
typedef unsigned u32x2 __attribute__((ext_vector_type(2)));
#define GAS __attribute__((address_space(1)))
#define LAS __attribute__((address_space(3)))
typedef GAS unsigned gu32;

constexpr int T = 16384, S = 8192, D = 1024, NPROJ = 5888, NQKV = 3840, NGATE = 2048, NE = 32, TOPK = 4;
constexpr int C_QA = 0, C_KA = 1024, C_VA = 1280, C_QB = 1536, C_KB = 2304, C_VB = 3072;
constexpr float EPS = 1e-5f;
constexpr size_t MiB = 1u << 20;
constexpr size_t WS_CTL = 0, CTL_ZERO_BYTES = 1 * MiB;
constexpr size_t WS_TAB = 1 * MiB;
constexpr size_t WS_WIN = 2 * MiB;
constexpr size_t WS_WA = 14 * MiB;
constexpr size_t WS_WB = 16 * MiB;
constexpr size_t WS_WOUT = 17 * MiB;
constexpr size_t WS_RT = 19 * MiB;
constexpr size_t WS_WGU = 24 * MiB;
constexpr size_t WS_WD = 88 * MiB;
constexpr size_t WS_H2 = 120 * MiB;
constexpr size_t WS_HS = 136 * MiB;
constexpr size_t WS_ACT = 201 * MiB;
constexpr size_t WS_YS = 272 * MiB;
constexpr size_t WS_XN = 216 * MiB;
constexpr size_t WS_QKV = 248 * MiB;
constexpr size_t WS_GATES = 368 * MiB;
constexpr size_t WS_YA = 432 * MiB;
constexpr size_t WS_YB = 464 * MiB;
constexpr size_t WS_MERGED = 472 * MiB;
constexpr size_t WS_VT = 472 * MiB;
constexpr size_t WS_END = 506 * MiB;
constexpr int CW_CNT = 0;
constexpr int CW_BAR = 4096;

__device__ const unsigned char BKT_A[257] = {12,12,12,12,12,12,12,12,12,12,12,12,12,12,12,12,12,12,12,12,12,12,12,12,12,12,12,12,12,12,12,12,12,12,12,12,12,12,11,11,11,11,11,11,11,11,11,11,11,11,11,11,11,11,11,11,11,11,11,11,11,11,11,11,11,11,11,11,11,11,11,11,11,11,11,11,11,11,11,10,10,10,10,10,10,10,10,10,10,10,10,10,10,10,10,10,10,10,10,10,10,10,9,9,9,9,9,9,9,9,9,9,9,9,8,8,8,8,8,8,8,7,6,5,4,3,2,1,0,17,18,19,20,21,22,23,24,24,24,24,24,24,24,25,25,25,25,25,25,25,25,25,25,25,25,26,26,26,26,26,26,26,26,26,26,26,26,26,26,26,26,26,26,26,26,26,26,26,27,27,27,27,27,27,27,27,27,27,27,27,27,27,27,27,27,27,27,27,27,27,27,27,27,27,27,27,27,27,27,27,27,27,27,27,27,27,27,27,27,28,28,28,28,28,28,28,28,28,28,28,28,28,28,28,28,28,28,28,28,28,28,28,28,28,28,28,28,28,28,28,28,28,28,28,28,28,28};
__device__ const unsigned char BKT_B[3][129] = {
 {11,11,11,11,11,11,11,11,11,11,11,11,11,11,11,10,10,10,10,10,10,10,10,10,10,10,10,10,10,10,10,10,10,10,10,10,10,10,9,9,9,9,9,9,9,9,9,9,9,9,8,8,8,8,8,8,8,7,6,5,4,3,2,1,0,17,18,19,20,21,22,23,24,24,24,24,24,24,24,25,25,25,25,25,25,25,25,25,25,25,25,26,26,26,26,26,26,26,26,26,26,26,26,26,26,26,26,26,26,26,26,26,26,26,27,27,27,27,27,27,27,27,27,27,27,27,27,27,27},
 {13,13,13,13,13,13,13,13,13,13,13,13,13,13,13,13,13,13,13,13,13,13,13,12,12,12,12,12,12,12,12,12,12,12,12,12,12,12,12,12,12,12,11,11,11,11,11,11,11,11,11,11,10,10,10,10,10,10,9,9,9,8,8,4,0,20,24,24,25,25,25,26,26,26,26,26,26,27,27,27,27,27,27,27,27,27,27,28,28,28,28,28,28,28,28,28,28,28,28,28,28,28,28,28,28,28,29,29,29,29,29,29,29,29,29,29,29,29,29,29,29,29,29,29,29,29,29,29,29},
 {15,15,15,15,15,15,15,15,15,15,15,15,15,15,15,15,15,15,15,15,15,15,15,15,15,15,15,15,15,15,14,14,14,14,14,14,14,14,14,14,14,14,14,14,14,13,13,13,13,13,13,13,13,13,12,12,12,12,12,11,11,10,10,9,0,25,26,26,27,27,28,28,28,28,28,29,29,29,29,29,29,29,29,29,30,30,30,30,30,30,30,30,30,30,30,30,30,30,30,31,31,31,31,31,31,31,31,31,31,31,31,31,31,31,31,31,31,31,31,31,31,31,31,31,31,31,31,31,31}};

#define RLX_AGENT __ATOMIC_RELAXED, __HIP_MEMORY_SCOPE_AGENT
#define LDS_WAIT() asm volatile("s_waitcnt lgkmcnt(0)" ::: "memory")
#define VM_WAIT() asm volatile("s_waitcnt vmcnt(0)" ::: "memory")
__device__ __forceinline__ unsigned f2bf(float f) { unsigned u = __builtin_bit_cast(unsigned, f); return (u + 0x7fffu + ((u >> 16) & 1u)) >> 16; }
__device__ __forceinline__ unsigned pk2(float lo, float hi) { return f2bf(lo) | (f2bf(hi) << 16); }
__device__ __forceinline__ unsigned pk4_fp8(float a, float b, float c, float d) { unsigned w = 0; w = __builtin_amdgcn_cvt_pk_fp8_f32(a, b, w, false); w = __builtin_amdgcn_cvt_pk_fp8_f32(c, d, w, true); return w; }
__device__ __forceinline__ float bf2f(unsigned b) { return __builtin_bit_cast(float, b << 16); }
__device__ __forceinline__ float bflo(unsigned u) { return __builtin_bit_cast(float, u << 16); }
__device__ __forceinline__ float bfhi(unsigned u) { return __builtin_bit_cast(float, u & 0xffff0000u); }
__device__ __forceinline__ float wave_sum(float v) {
#pragma unroll
    for (int o = 1; o < 64; o <<= 1) v += __shfl_xor(v, o);
    return v;
}
__device__ __forceinline__ float sigm(float x) { return __builtin_amdgcn_rcpf(1.f + __builtin_amdgcn_exp2f(-1.4426950408889634f * x)); }

struct Tabs { float biasA[16][257]; float biasB[3][4][129]; };

namespace pg8 {
#define PG8_LAS __attribute__((address_space(3)))
typedef unsigned short bf16_t;
constexpr int BM = 256, BK = 64, HALF = 128, HTB = HALF * BK * 2, STAGE_BYTES = 8 * HTB, NXCD = 8, WGM = 8;
__host__ __device__ __forceinline__ int lds_byte(int r, int c) { const int st = (r >> 4) * 2 + (c >> 5), rr = r & 15, cc = c & 31, ob = rr * 64 + cc * 2; return st * 1024 + (ob ^ (((ob >> 9) & 1) << 5)); }
__host__ __device__ __forceinline__ void stage_rc(int b, int& R, int& C) { const int st = b / 1024, sb = b % 1024, swz = sb ^ (((sb >> 9) & 1) << 5); R = (st >> 1) * 16 + swz / 64; C = (st & 1) * 32 + (swz % 64) / 2; }
__host__ __device__ __forceinline__ int perm32(int rho) { const int n = rho >> 4, i = rho & 15; return 8 * (i >> 2) + 4 * n + (i & 3); }

struct Unit { int arow, brow, nrows, e; };
struct Gemm { const bf16_t* A; const bf16_t* Bt; int K; };

struct StaticOrder {
    int nM, nN, nwg, G, c;
    __device__ void init(int M, int N, int G_, int c_) { nM = M / BM; nN = N / BM; nwg = nM * nN; G = G_; c = c_; }
    __device__ bool next(int i, Unit& u) const {
        const long L = (long)i * G + c; if (L >= nwg) return false;
        int wgid = (int)L; { const int q = nwg / NXCD, r = nwg % NXCD, xcd = wgid % NXCD, off = wgid / NXCD; wgid = (xcd < r ? xcd * (q + 1) : r * (q + 1) + (xcd - r) * q) + off; }
        const int nig = WGM * nN, gid = wgid / nig, fm = gid * WGM, gsz = (nM - fm) < WGM ? (nM - fm) : WGM;
        u.arow = BM * (fm + ((wgid % nig) % gsz)); u.brow = BM * ((wgid % nig) / gsz); u.nrows = BM; u.e = 0; return true;
    }
    __device__ __forceinline__ void a_ready(const Unit&) const {}
    __device__ __forceinline__ void done(const Unit&) const {}
};
struct GroupOrder {
    const PG8_LAS int* toff; const PG8_LAS int* off; int NT, G, c, nunits;
    __device__ bool next(int i, Unit& u) const {
        const int L = i * G + c; if (L >= nunits) return false;
        const int mtg = L / NT, pn = L - mtg * NT;
        int e = 0;
        for (int j = 1; j < NE; ++j) e += (toff[j] <= mtg) ? 1 : 0;
        e = __builtin_amdgcn_readfirstlane(e);
        const int mt = mtg - __builtin_amdgcn_readfirstlane(toff[e]); const int o0 = __builtin_amdgcn_readfirstlane(off[e]), o1 = __builtin_amdgcn_readfirstlane(off[e + 1]);
        u.arow = o0 + BM * mt; const int rem = o1 - u.arow; u.nrows = rem < BM ? rem : BM; u.brow = (e * NT + pn) * BM; u.e = e; return true;
    }
    __device__ __forceinline__ void a_ready(const Unit&) const {}
    __device__ __forceinline__ void done(const Unit&) const {}
};

__device__ __forceinline__ unsigned cvt_pk_bf16(float lo, float hi) { unsigned r; asm volatile("v_cvt_pk_bf16_f32 %0, %1, %2" : "=v"(r) : "v"(lo), "v"(hi)); return r; }

struct EpiProj {
    static constexpr bool PERM = true, AFTER_DRAIN = false;
    bf16_t* qkv; bf16_t* gates; const float* bias; bf16_t* vta; bf16_t* vtb;
    __device__ __forceinline__ void operator()(const f32x4 (&acc)[2][2][4][2], const Unit& u, int wr, int wc, int fr, int fq) const {
        const int colt = u.brow; const bool isq = colt < NQKV; bf16_t* base = isq ? qkv : gates; const int ldc = isq ? NQKV : NGATE; const int cb = isq ? colt : colt - NQKV;
        const int row0 = u.arow + wr * 64 + fr, col0 = cb + wc * 32 + 8 * fq, bcol0 = colt + wc * 32 + 8 * fq;
        f32x4 bv[2][2];
#pragma unroll
        for (int bj = 0; bj < 2; ++bj)
#pragma unroll
            for (int n = 0; n < 2; ++n) bv[bj][n] = *(const f32x4*)(bias + bcol0 + bj * HALF + 4 * n);
        const bool isv = (colt == C_VA) || (colt >= C_VB && colt < NQKV);
        const float qs = (colt < C_KA || (colt >= C_QB && colt < C_KB)) ? 0.125f * 1.4426950408889634f : 1.f;
        if (!isv) {
#pragma unroll
        for (int ai = 0; ai < 2; ++ai)
#pragma unroll
            for (int m = 0; m < 4; ++m) { bf16_t* rowp = base + (size_t)(row0 + ai * HALF + m * 16) * ldc + col0;
#pragma unroll
                for (int bj = 0; bj < 2; ++bj) { const f32x4 v0 = (acc[ai][bj][m][0] + bv[bj][0]) * qs, v1 = (acc[ai][bj][m][1] + bv[bj][1]) * qs;
                    u32x4 w; w.x = cvt_pk_bf16(v0[0], v0[1]); w.y = cvt_pk_bf16(v0[2], v0[3]); w.z = cvt_pk_bf16(v1[0], v1[1]); w.w = cvt_pk_bf16(v1[2], v1[3]);
                    *(u32x4*)(rowp + bj * HALF) = w; } }
        } else {
            const int gsel = (colt == C_VA) ? -1 : ((colt - C_VB) >> 8); const int sh = (gsel <= 0) ? 0 : (gsel == 1 ? 2 : 4);
            bf16_t* vb = (gsel < 0) ? vta : vtb + (size_t)gsel * (2 * 256 * 8192); const int c0 = wc * 32 + 8 * fq;
#pragma unroll
            for (int ai = 0; ai < 2; ++ai)
#pragma unroll
                for (int m = 0; m < 4; ++m) { const int row = row0 + ai * HALF + m * 16, b = row >> 13, s = row & 8191; const int mu = s >> sh; const int pos = ((s & ((1 << sh) - 1)) << (13 - sh)) + (mu & ~31) + (((mu & 15) >> 2) << 3) + (((mu >> 4) & 1) << 2) + (mu & 3);
                    bf16_t* vp = vb + (size_t)(b * 256 + c0) * 8192 + pos;
#pragma unroll
                    for (int bj = 0; bj < 2; ++bj)
#pragma unroll
                        for (int n = 0; n < 2; ++n) { const f32x4 v = acc[ai][bj][m][n] + bv[bj][n]; const unsigned w0 = cvt_pk_bf16(v[0], v[1]), w1 = cvt_pk_bf16(v[2], v[3]);
                            bf16_t* q = vp + (size_t)(bj * HALF + 4 * n) * 8192;
                            q[0] = (bf16_t)(w0 & 0xffffu); q[8192] = (bf16_t)(w0 >> 16); q[2 * 8192] = (bf16_t)(w1 & 0xffffu); q[3 * 8192] = (bf16_t)(w1 >> 16); } }
        }
    }
};
template <int MODE> struct EpiGate {
    static constexpr bool PERM = true, AFTER_DRAIN = false;
    bf16_t* out; const bf16_t* gates; int gcol0;
    __device__ __forceinline__ void operator()(const f32x4 (&acc)[2][2][4][2], const Unit& u, int wr, int wc, int fr, int fq) const {
        const int row0 = u.arow + wr * 64 + fr, col0 = u.brow + wc * 32 + 8 * fq;
        u32x4 gv[8][2];
#pragma unroll
        for (int gi = 0; gi < 4; ++gi) { const size_t r = (size_t)(row0 + (gi >> 2) * HALF + (gi & 3) * 16);
#pragma unroll
            for (int bj = 0; bj < 2; ++bj) gv[gi][bj] = *(const u32x4*)(gates + r * NGATE + gcol0 + col0 + bj * HALF); }
        u32x4 mv[2], mn[2];
        if (MODE == 1) {
#pragma unroll
            for (int bj = 0; bj < 2; ++bj) mv[bj] = *(const u32x4*)(out + (size_t)row0 * D + col0 + bj * HALF); }
#pragma unroll
        for (int gi = 0; gi < 8; ++gi) { const int ai = gi >> 2, m = gi & 3; const size_t r = (size_t)(row0 + ai * HALF + m * 16);
            if (gi == 1) {
#pragma unroll
                for (int g2 = 4; g2 < 8; ++g2) { const size_t r2 = (size_t)(row0 + (g2 >> 2) * HALF + (g2 & 3) * 16);
#pragma unroll
                    for (int bj = 0; bj < 2; ++bj) gv[g2][bj] = *(const u32x4*)(gates + r2 * NGATE + gcol0 + col0 + bj * HALF); } }
            if (MODE == 1 && gi + 1 < 8) { const size_t rn = (size_t)(row0 + ((gi + 1) >> 2) * HALF + ((gi + 1) & 3) * 16);
#pragma unroll
                for (int bj = 0; bj < 2; ++bj) mn[bj] = *(const u32x4*)(out + rn * D + col0 + bj * HALF); }
#pragma unroll
            for (int bj = 0; bj < 2; ++bj) { const int c = col0 + bj * HALF; const u32x4 g4 = gv[gi][bj]; const f32x4 a0 = acc[ai][bj][m][0], a1 = acc[ai][bj][m][1];
                float o[8]; o[0] = sigm(bflo(g4.x)) * a0[0]; o[1] = sigm(bfhi(g4.x)) * a0[1]; o[2] = sigm(bflo(g4.y)) * a0[2]; o[3] = sigm(bfhi(g4.y)) * a0[3];
                o[4] = sigm(bflo(g4.z)) * a1[0]; o[5] = sigm(bfhi(g4.z)) * a1[1]; o[6] = sigm(bflo(g4.w)) * a1[2]; o[7] = sigm(bfhi(g4.w)) * a1[3];
                if (MODE == 1) { const u32x4 m4 = mv[bj];
                    o[0] += bflo(m4.x); o[1] += bfhi(m4.x); o[2] += bflo(m4.y); o[3] += bfhi(m4.y); o[4] += bflo(m4.z); o[5] += bfhi(m4.z); o[6] += bflo(m4.w); o[7] += bfhi(m4.w); }
                u32x4 w; w.x = cvt_pk_bf16(o[0], o[1]); w.y = cvt_pk_bf16(o[2], o[3]); w.z = cvt_pk_bf16(o[4], o[5]); w.w = cvt_pk_bf16(o[6], o[7]);
                *(u32x4*)(out + r * D + c) = w; }
            asm volatile("" ::: "memory");
            if (MODE == 1) {
#pragma unroll
                for (int bj = 0; bj < 2; ++bj) mv[bj] = mn[bj]; } }
    }
};
struct EpiX1 {
    static constexpr bool PERM = true, AFTER_DRAIN = false;
    const float* x; float* out;
    __device__ __forceinline__ void operator()(const f32x4 (&acc)[2][2][4][2], const Unit& u, int wr, int wc, int fr, int fq) const {
        const int row0 = u.arow + wr * 64 + fr, col0 = u.brow + wc * 32 + 8 * fq;
        f32x4 xv[2][2], xn[2][2];
#pragma unroll
        for (int bj = 0; bj < 2; ++bj) { const size_t o = (size_t)row0 * D + col0 + bj * HALF; xv[bj][0] = *(const f32x4*)(x + o); xv[bj][1] = *(const f32x4*)(x + o + 4); }
#pragma unroll
        for (int gi = 0; gi < 8; ++gi) { const int ai = gi >> 2, m = gi & 3; const size_t r = (size_t)(row0 + ai * HALF + m * 16);
            if (gi + 1 < 8) { const size_t rn = (size_t)(row0 + ((gi + 1) >> 2) * HALF + ((gi + 1) & 3) * 16);
#pragma unroll
                for (int bj = 0; bj < 2; ++bj) { const size_t o = rn * D + col0 + bj * HALF; xn[bj][0] = *(const f32x4*)(x + o); xn[bj][1] = *(const f32x4*)(x + o + 4); } }
#pragma unroll
            for (int bj = 0; bj < 2; ++bj) { const size_t o = r * D + col0 + bj * HALF;
                *(f32x4*)(out + o) = xv[bj][0] + acc[ai][bj][m][0]; *(f32x4*)(out + o + 4) = xv[bj][1] + acc[ai][bj][m][1]; }
            asm volatile("" ::: "memory");
#pragma unroll
            for (int bj = 0; bj < 2; ++bj) { xv[bj][0] = xn[bj][0]; xv[bj][1] = xn[bj][1]; } }
    }
};
struct EpiSwiglu {
    static constexpr bool PERM = true, AFTER_DRAIN = false;
    unsigned char* act; const float* bg; const float* bu;
    __device__ __forceinline__ void operator()(const f32x4 (&acc)[2][2][4][2], const Unit& u, int wr, int wc, int fr, int fq) const {
        const int pn = (u.brow >> 8) & 7; const int col0 = pn * HALF + wc * 32 + 8 * fq; const int rl0 = wr * 64 + fr;
        const f32x4 g0 = *(const f32x4*)(bg + (size_t)u.e * D + col0), g1 = *(const f32x4*)(bg + (size_t)u.e * D + col0 + 4);
        const f32x4 u0 = *(const f32x4*)(bu + (size_t)u.e * D + col0), u1 = *(const f32x4*)(bu + (size_t)u.e * D + col0 + 4);
#pragma unroll
        for (int ai = 0; ai < 2; ++ai)
#pragma unroll
            for (int m = 0; m < 4; ++m) { const int rl = rl0 + ai * HALF + m * 16;
                const f32x4 ga = acc[ai][0][m][0] + g0, gb = acc[ai][0][m][1] + g1, ua = acc[ai][1][m][0] + u0, ub = acc[ai][1][m][1] + u1;
                float o[8];
#pragma unroll
                for (int j = 0; j < 4; ++j) { const float gt = fminf(ga[j], 7.f), up = fminf(fmaxf(ua[j], -7.f), 7.f); o[j] = gt * sigm(1.702f * gt) * (up + 1.f);
                    const float gt2 = fminf(gb[j], 7.f), up2 = fminf(fmaxf(ub[j], -7.f), 7.f); o[4 + j] = gt2 * sigm(1.702f * gt2) * (up2 + 1.f); }
                u32x2 w; w.x = pk4_fp8(o[0], o[1], o[2], o[3]); w.y = pk4_fp8(o[4], o[5], o[6], o[7]);
                if (rl < u.nrows) *(u32x2*)(act + (size_t)(u.arow + rl) * D + col0) = w; }
    }
};
struct EpiDown {
    static constexpr bool PERM = true, AFTER_DRAIN = false;
    unsigned char* ys; const float* bd;
    __device__ __forceinline__ void operator()(const f32x4 (&acc)[2][2][4][2], const Unit& u, int wr, int wc, int fr, int fq) const {
        const int pn = (u.brow >> 8) & 3; const int col0 = pn * BM + wc * 32 + 8 * fq; const int rl0 = wr * 64 + fr;
        f32x4 bv[2][2];
#pragma unroll
        for (int bj = 0; bj < 2; ++bj)
#pragma unroll
            for (int n = 0; n < 2; ++n) bv[bj][n] = *(const f32x4*)(bd + (size_t)u.e * D + col0 + bj * HALF + 4 * n);
#pragma unroll
        for (int ai = 0; ai < 2; ++ai)
#pragma unroll
            for (int m = 0; m < 4; ++m) { const int rl = rl0 + ai * HALF + m * 16; unsigned char* rowp = ys + (size_t)(u.arow + rl) * D + col0;
#pragma unroll
                for (int bj = 0; bj < 2; ++bj) { const f32x4 v0 = acc[ai][bj][m][0] + bv[bj][0], v1 = acc[ai][bj][m][1] + bv[bj][1];
                    u32x2 w; w.x = pk4_fp8(v0[0], v0[1], v0[2], v0[3]); w.y = pk4_fp8(v1[0], v1[1], v1[2], v1[3]);
                    if (rl < u.nrows) *(u32x2*)(rowp + bj * HALF) = w; } }
    }
};

typedef int i32x4_t __attribute__((ext_vector_type(4))); typedef int i32x8_t __attribute__((ext_vector_type(8)));
template <bool FP8> struct Frag;
template <> struct Frag<false> { bf16x8 v[2];
    __device__ __forceinline__ void ld(const PG8_LAS unsigned char* p) { v[0] = *(const PG8_LAS bf16x8*)p; v[1] = *(const PG8_LAS bf16x8*)(p + 1024); } };
template <> struct Frag<true> { i32x8_t v;
    __device__ __forceinline__ void ld(const PG8_LAS unsigned char* p) { const i32x4_t lo = *(const PG8_LAS i32x4_t*)p, hi = *(const PG8_LAS i32x4_t*)(p + 1024); v = __builtin_shufflevector(lo, hi, 0, 1, 2, 3, 4, 5, 6, 7); } };
__device__ __forceinline__ f32x4 mma_frag(const Frag<false>& w, const Frag<false>& x, f32x4 c) {
    c = __builtin_amdgcn_mfma_f32_16x16x32_bf16(w.v[0], x.v[0], c, 0, 0, 0); return __builtin_amdgcn_mfma_f32_16x16x32_bf16(w.v[1], x.v[1], c, 0, 0, 0); }
__device__ __forceinline__ f32x4 mma_frag(const Frag<true>& w, const Frag<true>& x, f32x4 c) {
    const int sa = 0x7A7A7A7A, sb = 0x7F7F7F7F;
    asm volatile("v_mfma_scale_f32_16x16x128_f8f6f4 %0, %1, %2, %0, %3, %4 op_sel_hi:[0,0,0]" : "+v"(c) : "v"(w.v), "v"(x.v), "v"(sa), "v"(sb));
    return c; }
template <class Epi, class Sched, bool ALIGN_EPI = false, bool SP2 = false, bool FP8 = false>
__device__ __forceinline__ void gemm_phase(PG8_LAS unsigned char* lds, const Gemm g, const Sched& S, const Epi& E) {
    const int tid = threadIdx.x, wid = __builtin_amdgcn_readfirstlane(tid >> 6), lane = tid & 63, wr = wid >> 2, wc = wid & 3, fr = lane & 15, fq = lane >> 4;
    const int K = g.K, nt = K / BK;
    unsigned voffA[2], voffB[2];
#pragma unroll
    for (int i = 0; i < 2; ++i) { int R, C; stage_rc(tid * 16 + i * 8192, R, C); const int Rb = Epi::PERM ? ((R & ~31) + perm32(R & 31)) : R;
        voffA[i] = (unsigned)(R * K + C) * 2u; voffB[i] = (unsigned)(Rb * K + C) * 2u; }
    const size_t kstep = (size_t)(BK * 2);
    const size_t hstep = (size_t)HALF * K * 2;
    const size_t rowb = (size_t)K * 2;
    const unsigned ldsw = (unsigned)wid * 1024u;
    const int aoff = lds_byte(wr * 64 + fr, fq * 8), boff = lds_byte(wc * 32 + fr, fq * 8);
#define PG8_SA(b, h) (((b) * 2 + (h)) * HTB)
#define PG8_SB(b, h) ((4 + (b) * 2 + (h)) * HTB)
#define PG8_STAGE(bufoff, gbase, voff) do { _Pragma("unroll") for (int _i = 0; _i < 2; ++_i) \
        __builtin_amdgcn_global_load_lds((const unsigned*)((const char*)(gbase) + (voff)[_i]), (PG8_LAS unsigned*)(lds + (bufoff) + ldsw + _i * 8192), 16, 0, 0); } while (0)
#define PG8_LDA(dst, b, h) do { _Pragma("unroll") for (int m = 0; m < 4; ++m) dst[m].ld(lds + PG8_SA(b, h) + aoff + m * 2048); } while (0)
#define PG8_LDB(dst, b, h) do { _Pragma("unroll") for (int n = 0; n < 2; ++n) dst[n].ld(lds + PG8_SB(b, h) + boff + n * 2048); } while (0)
#define PG8_MMA(ai, bj, At, Bt) do { __builtin_amdgcn_s_setprio(1); _Pragma("unroll") for (int m = 0; m < 4; ++m) _Pragma("unroll") for (int n = 0; n < 2; ++n) \
        acc[ai][bj][m][n] = mma_frag(Bt[n], At[m], acc[ai][bj][m][n]); __builtin_amdgcn_s_setprio(0); } while (0)
#define PG8_WAIT_V(n) asm volatile("s_waitcnt vmcnt(" #n ")" ::: "memory")
#define PG8_WAIT_L(n) asm volatile("s_waitcnt lgkmcnt(" #n ")" ::: "memory")
#define PG8_BAR __builtin_amdgcn_s_barrier()
#define PG8_SCHED __builtin_amdgcn_sched_barrier(0)
    Unit cur, nxt; int ui = 0;
    if (!S.next(0, cur)) return;
    f32x4 acc[2][2][4][2];
#pragma unroll
    for (int a = 0; a < 2; ++a)
#pragma unroll
        for (int b = 0; b < 2; ++b)
#pragma unroll
            for (int m = 0; m < 4; ++m)
#pragma unroll
                for (int n = 0; n < 2; ++n) acc[a][b][m][n] = (f32x4){0.f, 0.f, 0.f, 0.f};
    Frag<FP8> At[4], B0[2], B1[2];
    const char* cA = (const char*)g.A + (size_t)cur.arow * rowb; const char* cB = (const char*)g.Bt + (size_t)cur.brow * rowb;
    S.a_ready(cur);
    if constexpr (SP2) {
        PG8_STAGE(PG8_SB(0, 0), cB, voffB); PG8_STAGE(PG8_SB(0, 1), cB + hstep, voffB); PG8_STAGE(PG8_SA(0, 0), cA, voffA); PG8_STAGE(PG8_SA(0, 1), cA + hstep, voffA);
        if (wr == 1) PG8_BAR;
        PG8_WAIT_V(2); PG8_BAR;
        PG8_STAGE(PG8_SB(1, 0), cB + kstep, voffB); PG8_STAGE(PG8_SA(1, 0), cA + kstep, voffA); PG8_STAGE(PG8_SB(1, 1), cB + hstep + kstep, voffB);
        PG8_WAIT_V(6); PG8_BAR;
    } else {
        PG8_STAGE(PG8_SB(0, 0), cB, voffB); PG8_STAGE(PG8_SA(0, 0), cA, voffA); PG8_STAGE(PG8_SB(0, 1), cB + hstep, voffB); PG8_STAGE(PG8_SA(0, 1), cA + hstep, voffA);
        if (wr == 1) PG8_BAR;
        PG8_WAIT_V(4); PG8_BAR;
        PG8_STAGE(PG8_SB(1, 0), cB + kstep, voffB); PG8_STAGE(PG8_SA(1, 0), cA + kstep, voffA); PG8_STAGE(PG8_SB(1, 1), cB + hstep + kstep, voffB);
        PG8_WAIT_V(6); PG8_BAR;
    }
    for (;;) {
        const bool has_next = S.next(ui + 1, nxt);
        const char* nA = has_next ? (const char*)g.A + (size_t)nxt.arow * rowb : cA; const char* nB = has_next ? (const char*)g.Bt + (size_t)nxt.brow * rowb : cB;
        for (int t = 0; t < nt; t += 2) {
            const bool last = (t == nt - 2);
            const char* a1 = cA + (size_t)(t + 1) * kstep;
            const char* a2 = last ? nA : cA + (size_t)(t + 2) * kstep; const char* b2 = last ? nB : cB + (size_t)(t + 2) * kstep;
            const char* a3 = a2 + kstep; const char* b3 = b2 + kstep;
            if (last && has_next) S.a_ready(nxt);
            if constexpr (SP2) {
            PG8_LDB(B0, 0, 0); PG8_LDB(B1, 0, 1); PG8_SCHED; PG8_LDA(At, 0, 0); PG8_STAGE(PG8_SA(1, 1), a1 + hstep, voffA);
            PG8_WAIT_V(8); PG8_WAIT_L(0); PG8_BAR; PG8_MMA(0, 0, At, B0); PG8_MMA(0, 1, At, B1); PG8_BAR; PG8_SCHED;
            PG8_LDA(At, 0, 1); PG8_STAGE(PG8_SB(0, 0), b2, voffB); PG8_STAGE(PG8_SB(0, 1), b2 + hstep, voffB); PG8_STAGE(PG8_SA(0, 0), a2, voffA);
            PG8_WAIT_V(8); PG8_WAIT_L(0); PG8_BAR; PG8_MMA(1, 0, At, B0); PG8_MMA(1, 1, At, B1); PG8_BAR; PG8_SCHED;
            PG8_LDB(B0, 1, 0); PG8_LDB(B1, 1, 1); PG8_SCHED; PG8_LDA(At, 1, 0); PG8_STAGE(PG8_SA(0, 1), a2 + hstep, voffA);
            PG8_WAIT_V(8); PG8_WAIT_L(0); PG8_BAR; PG8_MMA(0, 0, At, B0); PG8_MMA(0, 1, At, B1); PG8_BAR; PG8_SCHED;
            PG8_LDA(At, 1, 1); PG8_STAGE(PG8_SB(1, 0), b3, voffB); PG8_STAGE(PG8_SB(1, 1), b3 + hstep, voffB); PG8_STAGE(PG8_SA(1, 0), a3, voffA);
            PG8_WAIT_V(8); PG8_WAIT_L(0); PG8_BAR; PG8_MMA(1, 0, At, B0); PG8_MMA(1, 1, At, B1); PG8_BAR; PG8_SCHED;
            } else {
            PG8_LDB(B0, 0, 0); PG8_SCHED; PG8_LDA(At, 0, 0); PG8_STAGE(PG8_SA(1, 1), a1 + hstep, voffA);
            PG8_WAIT_L(8); PG8_BAR; PG8_WAIT_L(0); PG8_MMA(0, 0, At, B0); PG8_BAR; PG8_SCHED;
            PG8_LDB(B1, 0, 1); PG8_STAGE(PG8_SB(0, 0), b2, voffB);
            PG8_BAR; PG8_WAIT_L(0); PG8_MMA(0, 1, At, B1); PG8_BAR;
            PG8_LDA(At, 0, 1); PG8_STAGE(PG8_SA(0, 0), a2, voffA);
            PG8_BAR; PG8_WAIT_L(0); PG8_MMA(1, 0, At, B0); PG8_BAR; PG8_SCHED;
            PG8_STAGE(PG8_SB(0, 1), b2 + hstep, voffB);
            PG8_WAIT_V(6); PG8_BAR; PG8_MMA(1, 1, At, B1); PG8_BAR;
            PG8_LDB(B0, 1, 0); PG8_SCHED; PG8_LDA(At, 1, 0); PG8_STAGE(PG8_SA(0, 1), a2 + hstep, voffA);
            PG8_WAIT_L(8); PG8_BAR; PG8_WAIT_L(0); PG8_MMA(0, 0, At, B0); PG8_BAR; PG8_SCHED;
            PG8_LDB(B1, 1, 1); PG8_STAGE(PG8_SB(1, 0), b3, voffB);
            PG8_BAR; PG8_WAIT_L(0); PG8_MMA(0, 1, At, B1); PG8_BAR;
            PG8_LDA(At, 1, 1); PG8_STAGE(PG8_SA(1, 0), a3, voffA);
            PG8_BAR; PG8_WAIT_L(0); PG8_MMA(1, 0, At, B0); PG8_BAR; PG8_SCHED;
            PG8_STAGE(PG8_SB(1, 1), b3 + hstep, voffB);
            PG8_WAIT_V(6); PG8_BAR; PG8_MMA(1, 1, At, B1); PG8_BAR;
            }
        }
        if constexpr (ALIGN_EPI) { if (wr == 0) PG8_BAR; }
        if constexpr (FP8) {
#define PG8_ACC8(a, b) "+v"(acc[a][b][0][0]), "+v"(acc[a][b][0][1]), "+v"(acc[a][b][1][0]), "+v"(acc[a][b][1][1]), "+v"(acc[a][b][2][0]), "+v"(acc[a][b][2][1]), "+v"(acc[a][b][3][0]), "+v"(acc[a][b][3][1])
            asm volatile("s_nop 15\n\ts_nop 15" : PG8_ACC8(0, 0), PG8_ACC8(0, 1) :: "memory");
            asm volatile("" : PG8_ACC8(1, 0), PG8_ACC8(1, 1) :: "memory");
#undef PG8_ACC8
        }
        if constexpr (!Epi::AFTER_DRAIN) { E(acc, cur, wr, wc, fr, fq); S.done(cur); }
        if (!has_next) break;
#pragma unroll
        for (int a = 0; a < 2; ++a)
#pragma unroll
            for (int b = 0; b < 2; ++b)
#pragma unroll
                for (int m = 0; m < 4; ++m)
#pragma unroll
                    for (int n = 0; n < 2; ++n) acc[a][b][m][n] = (f32x4){0.f, 0.f, 0.f, 0.f};
        cur = nxt; cA = nA; cB = nB; ++ui;
        if constexpr (ALIGN_EPI) { if (wr == 1) PG8_BAR; }
    }
    PG8_WAIT_V(0);
    if constexpr (!ALIGN_EPI) { if (wr == 0) PG8_BAR; }
    PG8_BAR;
    if constexpr (Epi::AFTER_DRAIN) { E.fused(acc, cur, wr, wc, fr, fq, lds, wid, lane); S.done(cur); }
#undef PG8_SA
#undef PG8_SB
#undef PG8_STAGE
#undef PG8_LDA
#undef PG8_LDB
#undef PG8_MMA
#undef PG8_WAIT_V
#undef PG8_WAIT_L
#undef PG8_BAR
#undef PG8_SCHED
}

}

#define XB_TMO      128
#define XB_XCNT(j)  (256  + 64 * (j))
#define XB_XSUB(j)  (1280 + 64 * (j))
#define XB_XGEN(j)  (2304 + 64 * (j))
#define XB_TOP      3328
#define XB_TOPGEN   3392
#define XCD_BAR_WORDS 3456
#define XB_SPIN_CAP (1u << 18)
__device__ __forceinline__ unsigned xb_ld(unsigned* p)              { return __hip_atomic_load(p, __ATOMIC_RELAXED, __HIP_MEMORY_SCOPE_AGENT); }
__device__ __forceinline__ unsigned xb_add(unsigned* p, unsigned v) { return __hip_atomic_fetch_add(p, v, __ATOMIC_RELAXED, __HIP_MEMORY_SCOPE_AGENT); }
__device__ __forceinline__ unsigned xb_xcc_id() { return (unsigned)__builtin_amdgcn_s_getreg((3 << 11) | 20) & 0xFu; }
#define XB_SPIN(cond, bar) do { unsigned _sp = 0; while (cond) { __builtin_amdgcn_s_sleep(1); \
    if ((++_sp & 255u) == 0u) { if (xb_ld(&(bar)[XB_TMO])) break; if (_sp > XB_SPIN_CAP) { atomicAdd(&(bar)[XB_TMO], 1u); break; } } } } while (0)
struct XcdBarrier { unsigned* bar; unsigned x; volatile LAS unsigned* st; };
__device__ __forceinline__ XcdBarrier xcd_barrier_post(unsigned* bar, volatile LAS unsigned* st) {
    XcdBarrier b; b.bar = bar; b.x = xb_xcc_id(); b.st = st;
    if (threadIdx.x == 0) (void)xb_add(&bar[XB_XCNT(b.x)], 1u);
    return b;
}
__device__ __forceinline__ void xcd_barrier_complete(unsigned* bar, unsigned x, unsigned& nloc, unsigned& nx) {
    const unsigned G = gridDim.x * gridDim.y * gridDim.z;
    unsigned sum, cnt, mine, sp = 0u;
    for (;;) {
        sum = 0u; cnt = 0u; mine = 0u;
#pragma unroll
        for (unsigned j = 0; j < 16; ++j) { const unsigned c = xb_ld(&bar[XB_XCNT(j)]); sum += c; cnt += (c > 0u) ? 1u : 0u; mine = (j == x) ? c : mine; }
        if (sum == G) break;
        __builtin_amdgcn_s_sleep(1);
        if ((++sp & 255u) == 0u) { if (xb_ld(&bar[XB_TMO])) break; if (sp > XB_SPIN_CAP) { atomicAdd(&bar[XB_TMO], 1u); break; } }
    }
    nloc = mine > 0u ? mine : 1u; nx = cnt > 0u ? cnt : 1u;
}
__device__ __forceinline__ void xcd_barrier(const XcdBarrier& b) {
    asm volatile("s_waitcnt vmcnt(0)" ::: "memory");
    __syncthreads();
    if (threadIdx.x == 0) {
        unsigned* bar = b.bar;
        __builtin_amdgcn_s_waitcnt(0);
        unsigned nloc = b.st[0], nx = b.st[1];
        if (nloc == 0u) { xcd_barrier_complete(bar, b.x, nloc, nx); b.st[0] = nloc; b.st[1] = nx; }
        const unsigned old = xb_add(&bar[XB_XSUB(b.x)], 1u);
        const unsigned gen = old / nloc;
        if (old + 1u == (gen + 1u) * nloc) {
            __builtin_amdgcn_fence(__ATOMIC_RELEASE, "agent");
            asm volatile("s_waitcnt vmcnt(0)" ::: "memory");
            const unsigned og = xb_add(&bar[XB_TOP], 1u);
            const unsigned tg = og / nx;
            if (og + 1u == (tg + 1u) * nx) xb_add(&bar[XB_TOPGEN], 1u);
            else XB_SPIN(xb_ld(&bar[XB_TOPGEN]) == tg, bar);
            __builtin_amdgcn_fence(__ATOMIC_ACQUIRE, "agent");
            xb_add(&bar[XB_XGEN(b.x)], 1u);
            asm volatile("s_waitcnt vmcnt(0)" ::: "memory");
        } else {
            XB_SPIN(xb_ld(&bar[XB_XGEN(b.x)]) == gen, bar);
            __builtin_amdgcn_fence(__ATOMIC_ACQUIRE, "agent");
            asm volatile("s_waitcnt vmcnt(0)" ::: "memory");
        }
    }
    __syncthreads();
}

constexpr int NWAVES = 8;
constexpr int RING_OFF = 0, RING_BYTES = 131072;
constexpr int LDSCTL_OFF = RING_BYTES, MISC_OFF = LDSCTL_OFF + 320;
constexpr int TBL_OFF = LDSCTL_OFF + 1024;
constexpr int LDS_BYTES = 147456;

struct Frame {
    LAS unsigned char* lds; volatile LAS unsigned* MISC; LAS int* tbl; gu32* ctl;
    int tid, lane, wave, vcu, G;
};

__device__ __forceinline__ void p0_transpose_item(const float* W, int K, int N, bf16* WT, int k0, int n0, int orow0, LAS float* scr, int lane) {
#pragma unroll 8
    for (int i = 0; i < 32; ++i) { const int kk = 2 * i + (lane >> 5); scr[kk * 33 + (lane & 31)] = W[(size_t)(k0 + kk) * N + n0 + (lane & 31)]; }
    LDS_WAIT(); asm volatile("" ::: "memory");
    const int c = lane & 7;
#pragma unroll
    for (int j = 0; j < 4; ++j) { const int n = (lane >> 3) + 8 * j; const LAS float* s = scr + (8 * c) * 33 + n;
        u32x4 o; o.x = pk2(s[0 * 33], s[1 * 33]); o.y = pk2(s[2 * 33], s[3 * 33]); o.z = pk2(s[4 * 33], s[5 * 33]); o.w = pk2(s[6 * 33], s[7 * 33]);
        *(GAS u32x4*)(WT + (size_t)(orow0 + n) * K + k0 + 8 * c) = o; }
    LDS_WAIT(); asm volatile("" ::: "memory");
}
__device__ __forceinline__ void p0_transpose_item_fp8(const float* W, int K, int N, unsigned char* WT, int k0, int n0, int orow0, LAS float* scr, int lane) {
#pragma unroll 8
    for (int i = 0; i < 32; ++i) { const int kk = 2 * i + (lane >> 5); scr[kk * 33 + (lane & 31)] = W[(size_t)(k0 + kk) * N + n0 + (lane & 31)]; }
    LDS_WAIT(); asm volatile("" ::: "memory");
    const int c = lane & 7;
#pragma unroll
    for (int j = 0; j < 4; ++j) { const int n = (lane >> 3) + 8 * j; const LAS float* sp = scr + (8 * c) * 33 + n;
        u32x2 o; o.x = pk4_fp8(sp[0 * 33] * 32.f, sp[1 * 33] * 32.f, sp[2 * 33] * 32.f, sp[3 * 33] * 32.f); o.y = pk4_fp8(sp[4 * 33] * 32.f, sp[5 * 33] * 32.f, sp[6 * 33] * 32.f, sp[7 * 33] * 32.f);
        *(GAS u32x2*)(WT + (size_t)(orow0 + n) * K + k0 + 8 * c) = o; }
    LDS_WAIT(); asm volatile("" ::: "memory");
}
__device__ __forceinline__ void rms_row_to_bf16(const float* xrow, const float* g, bf16* orow, int lane) {
    const GAS f32x4* xr = (const GAS f32x4*)xrow + lane; f32x4 v[4]; float s = 0.f;
#pragma unroll
    for (int j = 0; j < 4; ++j) { v[j] = xr[64 * j]; s += (v[j].x * v[j].x + v[j].y * v[j].y) + (v[j].z * v[j].z + v[j].w * v[j].w); }
    const float rstd = 1.f / sqrtf(wave_sum(s) * (1.f / D) + EPS);
    GAS unsigned long long* o8 = (GAS unsigned long long*)orow + lane;
#pragma unroll
    for (int j = 0; j < 4; ++j) { const f32x4 gg = ((const GAS f32x4*)g)[lane + 64 * j];
        o8[64 * j] = (unsigned long long)pk2(v[j].x * rstd * gg.x, v[j].y * rstd * gg.y) | ((unsigned long long)pk2(v[j].z * rstd * gg.z, v[j].w * rstd * gg.w) << 32); }
}

__device__ __forceinline__ void rms_row_to_fp8(const float* xrow, const float* g, unsigned char* orow, int lane) {
    const GAS f32x4* xr = (const GAS f32x4*)xrow + lane; f32x4 v[4]; float s = 0.f;
#pragma unroll
    for (int j = 0; j < 4; ++j) { v[j] = xr[64 * j]; s += (v[j].x * v[j].x + v[j].y * v[j].y) + (v[j].z * v[j].z + v[j].w * v[j].w); }
    const float rstd = 1.f / sqrtf(wave_sum(s) * (1.f / D) + EPS);
    GAS unsigned* o4 = (GAS unsigned*)orow + lane;
#pragma unroll
    for (int j = 0; j < 4; ++j) { const f32x4 gg = ((const GAS f32x4*)g)[lane + 64 * j]; o4[64 * j] = pk4_fp8(v[j].x * rstd * gg.x, v[j].y * rstd * gg.y, v[j].z * rstd * gg.z, v[j].w * rstd * gg.w); }
}
constexpr float LOG2E = 1.4426950408889634f;
typedef __bf16 bf16x2_t __attribute__((ext_vector_type(2)));
__device__ __forceinline__ unsigned cvtpk_v(float lo, float hi) { const f32x2 v = {lo, hi}; const bf16x2_t b = __builtin_convertvector(v, bf16x2_t); return __builtin_bit_cast(unsigned, b); }
struct AttFrags { bf16x8 k0a, k0b, k1a, k1b, v[4]; };
__device__ __forceinline__ float gmax4(float m) {
    { auto rr = __builtin_amdgcn_permlane16_swap(__float_as_uint(m), __float_as_uint(m), false, false); m = fmaxf(__uint_as_float(rr[0]), __uint_as_float(rr[1])); }
    { auto rr = __builtin_amdgcn_permlane32_swap(__float_as_uint(m), __float_as_uint(m), false, false); m = fmaxf(__uint_as_float(rr[0]), __uint_as_float(rr[1])); }
    return m;
}
constexpr int RB_A = 160, RB_B = 320;
template <int NH, int RB>
__device__ __forceinline__ void band_group(f32x4 (&o)[NH][4], float (&mrun)[NH], float (&lrun)[NH], const bf16* qkvb, const int (&qcol)[NH], const int (&qmu0)[NH], int kcol, const bf16* vt,
                                           int dil, int rho, int L, int qstep, int P0, int npairs, const LAS float* const (&tab)[NH], int lane) {
    const int t = lane & 15, g = lane >> 4;
    bf16x8 qf[NH][2]; int mu_t[NH];
#pragma unroll
    for (int h = 0; h < NH; ++h) { mu_t[h] = qmu0[h] + qstep * t; const bf16* qrow = qkvb + (size_t)(mu_t[h] * dil + rho) * NQKV + 8 * g + qcol[h];
        qf[h][0] = *(const bf16x8*)qrow; qf[h][1] = *(const bf16x8*)(qrow + 32); }
    const int npr = L >> 5;
    const bf16* kbase = qkvb + (size_t)rho * NQKV + kcol + 8 * g;
    const bf16* vtl = vt + (size_t)t * 8192 + (size_t)rho * L + 8 * g;
    auto load = [&](int P, AttFrags& f) {
        const int Pc = min(max(P, 0), npr - 1);
        const bf16* k0p = kbase + (size_t)((32 * Pc + t) * dil) * NQKV; const bf16* k1p = k0p + (size_t)(16 * dil) * NQKV;
        f.k0a = *(const bf16x8*)k0p; f.k0b = *(const bf16x8*)(k0p + 32); f.k1a = *(const bf16x8*)k1p; f.k1b = *(const bf16x8*)(k1p + 32);
#pragma unroll
        for (int db = 0; db < 4; ++db) f.v[db] = *(const bf16x8*)(vtl + (size_t)(16 * db) * 8192 + 32 * Pc);
    };
    AttFrags cur; load(P0, cur);
    for (int pp = 0; pp < npairs; ++pp) {
        const int P = P0 + pp;
        AttFrags nxt; load(P0 + min(pp + 1, npairs - 1), nxt);
        if (P >= 0 && P < npr) {
            const int kap0 = 32 * P + 4 * g;
#pragma unroll
            for (int h = 0; h < NH; ++h) {
                const LAS float* tb_ = tab[h] + (kap0 - mu_t[h] + RB);
                f32x4 s0 = (f32x4){tb_[0], tb_[1], tb_[2], tb_[3]}, s1 = (f32x4){tb_[16], tb_[17], tb_[18], tb_[19]};
                s0 = __builtin_amdgcn_mfma_f32_16x16x32_bf16(cur.k0a, qf[h][0], s0, 0, 0, 0); s0 = __builtin_amdgcn_mfma_f32_16x16x32_bf16(cur.k0b, qf[h][1], s0, 0, 0, 0);
                s1 = __builtin_amdgcn_mfma_f32_16x16x32_bf16(cur.k1a, qf[h][0], s1, 0, 0, 0); s1 = __builtin_amdgcn_mfma_f32_16x16x32_bf16(cur.k1b, qf[h][1], s1, 0, 0, 0);
                float mx = fmaxf(fmaxf(fmaxf(s0[0], s0[1]), fmaxf(s0[2], s0[3])), fmaxf(fmaxf(s1[0], s1[1]), fmaxf(s1[2], s1[3])));
                mx = gmax4(mx);
                if (__any(mx > mrun[h])) { const float mn = fmaxf(mrun[h], mx), alpha = __builtin_amdgcn_exp2f(mrun[h] - mn); mrun[h] = mn; lrun[h] *= alpha;
#pragma unroll
                    for (int db = 0; db < 4; ++db) o[h][db] = o[h][db] * alpha; }
                const float mn = mrun[h]; float p[8], ps = 0.f;
#pragma unroll
                for (int j = 0; j < 8; ++j) { p[j] = __builtin_amdgcn_exp2f(((j < 4) ? s0[j & 3] : s1[j & 3]) - mn); ps += p[j]; }
                lrun[h] += ps;
                u32x4 pw; pw.x = cvtpk_v(p[0], p[1]); pw.y = cvtpk_v(p[2], p[3]); pw.z = cvtpk_v(p[4], p[5]); pw.w = cvtpk_v(p[6], p[7]);
                const bf16x8 pf = __builtin_bit_cast(bf16x8, pw);
#pragma unroll
                for (int db = 0; db < 4; ++db) o[h][db] = __builtin_amdgcn_mfma_f32_16x16x32_bf16(cur.v[db], pf, o[h][db], 0, 0, 0);
                if (NH > 2 && h + 1 < NH) __builtin_amdgcn_sched_barrier(0);
            }
        }
        cur = nxt;
    }
}
template <int NH>
__device__ __forceinline__ void band_store(const f32x4 (&o)[NH][4], const float (&lrun)[NH], bf16* const (&yrow)[NH], int lane) {
    const int g = lane >> 4;
#pragma unroll
    for (int h = 0; h < NH; ++h) { float l = lrun[h]; l += __shfl_xor(l, 16); l += __shfl_xor(l, 32); const float inv = 1.f / l;
#pragma unroll
        for (int db = 0; db < 4; ++db) { u32x2 w; w.x = pg8::cvt_pk_bf16(o[h][db][0] * inv, o[h][db][1] * inv); w.y = pg8::cvt_pk_bf16(o[h][db][2] * inv, o[h][db][3] * inv);
            *(u32x2*)(yrow[h] + 16 * db + 4 * g) = w; } }
}

struct Args { const float* in[19]; float* out; unsigned char* ws; int ph_lo, ph_hi, li, pad; };
constexpr int NPHASE = 10;

__global__ void __launch_bounds__(NWAVES * 64, 2) mk_fwd(Args args) {
    extern __shared__ __attribute__((aligned(16))) unsigned char lds[];
    Frame F;
    F.lds = (LAS unsigned char*)lds; F.MISC = (volatile LAS unsigned*)(F.lds + MISC_OFF); F.tbl = (LAS int*)(F.lds + TBL_OFF);
    F.tid = threadIdx.x; F.lane = F.tid & 63; F.wave = __builtin_amdgcn_readfirstlane(F.tid >> 6);
    F.G = gridDim.x; { const int bx = blockIdx.x; F.vcu = (F.G % 8 == 0) ? (bx % 8) * (F.G / 8) + bx / 8 : bx; }
    unsigned char* ws = args.ws; F.ctl = (gu32*)(ws + WS_CTL);
    const float* x = args.in[0]; const float* norm_mix = args.in[1]; const float* w_in = args.in[2]; const float* b_in = args.in[3];
    const float* sinks = args.in[4]; const float* rel_bias = args.in[5]; const float* w_a = args.in[6]; const float* w_b = args.in[7];
    const float* w_out = args.in[8]; const float* norm_ffn = args.in[9]; const float* router_w = args.in[10]; const float* router_b = args.in[11];
    const float* w_gate = args.in[12]; const float* b_gate = args.in[13]; const float* w_up = args.in[14]; const float* b_up = args.in[15];
    const float* w_down = args.in[16]; const float* b_down = args.in[17]; const float* norm_final = args.in[18];
    float* out = args.out;
    Tabs* tb = (Tabs*)(ws + WS_TAB);
    bf16* Win_t = (bf16*)(ws + WS_WIN); bf16* Wa_t = (bf16*)(ws + WS_WA); bf16* Wb_t = (bf16*)(ws + WS_WB); bf16* Wout_t = (bf16*)(ws + WS_WOUT);
    unsigned char* Wgu8 = ws + WS_WGU; unsigned char* Wd8 = ws + WS_WD; unsigned char* H28 = ws + WS_H2; unsigned char* HS8 = ws + WS_HS; unsigned char* ACT8 = ws + WS_ACT; unsigned char* YS = ws + WS_YS;
    int* topi = (int*)(ws + WS_RT); float* topp = (float*)(ws + WS_RT + 256 * 1024); int* slot = (int*)(ws + WS_RT + 512 * 1024); int* pos = (int*)(ws + WS_RT + 768 * 1024);
    bf16* XN = (bf16*)(ws + WS_XN); bf16* QKV = (bf16*)(ws + WS_QKV); bf16* GATES = (bf16*)(ws + WS_GATES); bf16* YA = (bf16*)(ws + WS_YA); bf16* YB = (bf16*)(ws + WS_YB);
    bf16* MERGED = (bf16*)(ws + WS_MERGED);
    gu32* cnt = F.ctl + CW_CNT;

    for (int u = F.tid; u < (LDS_BYTES - LDSCTL_OFF) / 4; u += NWAVES * 64) ((LAS unsigned*)(F.lds + LDSCTL_OFF))[u] = 0u;
    __syncthreads();
    XcdBarrier bar = xcd_barrier_post((unsigned*)(F.ctl + CW_BAR) + args.li * XCD_BAR_WORDS, F.MISC + 8);
    const int lo = args.ph_lo, hi = args.ph_hi;
#ifndef MK_SKIP
#define MK_SKIP 0
#endif
#define IN(k) (!((MK_SKIP >> (k)) & 1) && lo <= (k) && (k) < hi)
#ifndef MK_DUP
#define MK_DUP 0
#endif
#define REP(k) _Pragma("unroll") for (int rep_ = 0; rep_ < 1 + ((MK_DUP >> (k)) & 1); ++rep_)
#ifdef MK_TSTAMP
    unsigned long long ts_a = __builtin_amdgcn_s_memrealtime(), ts_b = ts_a;
#define SEAM(k) do { if (IN(k) && IN((k) + 1)) xcd_barrier(bar); if ((k) + 1 == MK_TSTAMP) ts_a = __builtin_amdgcn_s_memrealtime(); if ((k) == MK_TSTAMP) ts_b = __builtin_amdgcn_s_memrealtime(); } while (0)
#else
#define SEAM(k) do { if (IN(k) && IN((k) + 1)) xcd_barrier(bar); } while (0)
#endif
    const int gw = F.vcu * NWAVES + F.wave, NGW = F.G * NWAVES;

    LAS float* scr = (LAS float*)(F.lds + RING_OFF + F.wave * 16384);
    constexpr int I_IN = (D / 64) * (NPROJ / 32), I_A = (D / 64) * (D / 32), I_B = (256 / 64) * (D / 32), I_E = (D / 64) * (D / 32);
    constexpr int NITEMS = I_IN + 2 * I_A + I_B + 3 * NE * I_E;
    auto transpose_items = [&](int first, int last) {
    for (int it = first + gw; it < last; it += NGW) {
        int r = it;
        if (r < I_IN) { const int nb = NPROJ / 32; p0_transpose_item_fp8(w_in, D, NPROJ, (unsigned char*)Win_t, 64 * (r / nb), 32 * (r % nb), 32 * (r % nb), scr, F.lane); continue; } r -= I_IN;
        if (r < I_A) { const int nb = D / 32; p0_transpose_item(w_a, D, D, Wa_t, 64 * (r / nb), 32 * (r % nb), 32 * (r % nb), scr, F.lane); continue; } r -= I_A;
        if (r < I_A) { const int nb = D / 32; p0_transpose_item(w_out, D, D, Wout_t, 64 * (r / nb), 32 * (r % nb), 32 * (r % nb), scr, F.lane); continue; } r -= I_A;
        if (r < I_B) { const int nb = D / 32; p0_transpose_item(w_b, 256, D, Wb_t, 64 * (r / nb), 32 * (r % nb), 32 * (r % nb), scr, F.lane); continue; } r -= I_B;
        { const int e = r / (3 * I_E), q = r % (3 * I_E), which = q / I_E, ii = q % I_E, nb = D / 32, k0 = 64 * (ii / nb), n0 = 32 * (ii % nb);
          if (which == 0) p0_transpose_item_fp8(w_gate + (size_t)e * D * D, D, D, Wgu8, k0, n0, e * 2048 + (n0 >> 7) * 256 + (n0 & 127), scr, F.lane);
          else if (which == 1) p0_transpose_item_fp8(w_up + (size_t)e * D * D, D, D, Wgu8, k0, n0, e * 2048 + (n0 >> 7) * 256 + 128 + (n0 & 127), scr, F.lane);
          else p0_transpose_item_fp8(w_down + (size_t)e * D * D, D, D, Wd8, k0, n0, e * 1024 + n0, scr, F.lane); }
    }
    };
    if (IN(0)) REP(0) {
        { const int i = blockIdx.x * (NWAVES * 64) + F.tid;
          if (i < 16 * 257) { const int h = i / 257, r = i % 257; tb->biasA[h][r] = rel_bias[BKT_A[r] * 28 + h]; }
          if (i < 12 * 129) { const int g = i / (4 * 129), hs = (i / 129) % 4, r = i % 129; tb->biasB[g][hs][r] = rel_bias[BKT_B[g][r] * 28 + 16 + 4 * g + hs]; } }
        transpose_items(0, I_IN + 2 * I_A + I_B);
        for (int m = gw; m < T; m += NGW) rms_row_to_fp8(x + (size_t)m * D, norm_mix, (unsigned char*)XN + (size_t)m * D, F.lane);
    }
    SEAM(0);
    if (IN(1)) REP(1) {
        int k512 = D / 2; asm volatile("" : "+s"(k512));
        pg8::Gemm g{XN, Win_t, k512}; pg8::StaticOrder So; So.init(T, NPROJ, F.G, (int)blockIdx.x);
        pg8::EpiProj E{QKV, GATES, b_in, (bf16*)(ws + WS_VT), (bf16*)(ws + WS_VT) + (size_t)2 * 4 * 64 * 8192};
        pg8::gemm_phase<pg8::EpiProj, pg8::StaticOrder, true, true, true>(F.lds + RING_OFF, g, So, E);
    }
    SEAM(1);
    int nrep2 = 1 + ((MK_DUP >> 2) & 1); asm volatile("" : "+s"(nrep2));
    if (IN(2)) for (int rep_ = 0; rep_ < nrep2; ++rep_) {
        LAS float* lb = (LAS float*)(F.lds + RING_OFF);
        constexpr int TA = 2 * RB_A + 1, TB = 2 * RB_B + 1;
        for (int i = F.tid; i < 16 * TA; i += NWAVES * 64) { const int h = i / TA, rel = i % TA - RB_A; lb[i] = (rel >= -128 && rel <= 128) ? tb->biasA[h][rel + 128] * LOG2E : -3.0e38f; }
        for (int i = F.tid; i < 12 * TB; i += NWAVES * 64) { const int gh = i / TB, rel = i % TB - RB_B; lb[16 * TA + i] = (rel >= -64 && rel <= 64) ? tb->biasB[gh >> 2][gh & 3][rel + 64] * LOG2E : -3.0e38f; }
        __syncthreads();
        const bf16* VTA = (const bf16*)(ws + WS_VT); const bf16* VTB = VTA + (size_t)2 * 4 * 64 * 8192;
        for (int it = gw; it < 4096 + 2048; it += NGW) {
            const int t = F.lane & 15;
            if (it < 4096) {
                const int b = it >> 11, kvh = (it >> 9) & 3, qb = it & 511;
                f32x4 o[4][4]; float mr[4], lr[4];
#pragma unroll
                for (int h = 0; h < 4; ++h) { mr[h] = sinks[kvh * 4 + h] * LOG2E; lr[h] = (F.lane < 16) ? 1.f : 0.f;
#pragma unroll
                    for (int db = 0; db < 4; ++db) o[h][db] = (f32x4){0.f, 0.f, 0.f, 0.f}; }
                const int qcol[4] = {C_QA + (kvh * 4 + 0) * 64, C_QA + (kvh * 4 + 1) * 64, C_QA + (kvh * 4 + 2) * 64, C_QA + (kvh * 4 + 3) * 64};
                const int qmu[4] = {16 * qb, 16 * qb, 16 * qb, 16 * qb};
                const LAS float* const bias[4] = {lb + (kvh * 4 + 0) * TA, lb + (kvh * 4 + 1) * TA, lb + (kvh * 4 + 2) * TA, lb + (kvh * 4 + 3) * TA};
                band_group<4, RB_A>(o, mr, lr, QKV + (size_t)b * S * NQKV, qcol, qmu, C_KA + kvh * 64, VTA + (size_t)((b * 4 + kvh) * 64) * 8192, 1, 0, S, 1, (qb - 8) >> 1, 9, bias, F.lane);
                bf16* yr = YA + (size_t)(b * S + 16 * qb + t) * D + kvh * 256; bf16* const yrow[4] = {yr, yr + 64, yr + 128, yr + 192};
                band_store<4>(o, lr, yrow, F.lane);
            } else {
                const int j = it - 4096, r = j & 7, un = j >> 3, blk = un & 31, hs = (un >> 5) & 3, b = un >> 7, i0 = blk * 256;
                f32x4 o[2][4]; float mr[2], lr[2];
#pragma unroll
                for (int h = 0; h < 2; ++h) { mr[h] = -1.0e30f; lr[h] = 0.f;
#pragma unroll
                    for (int db = 0; db < 4; ++db) o[h][db] = (f32x4){0.f, 0.f, 0.f, 0.f}; }
                const bf16* qb_ = QKV + (size_t)b * S * NQKV;
                { const int qcol[2] = {C_QB + 0 * 256 + hs * 64, C_QB + 0 * 256 + hs * 64}; const int qmu[2] = {i0 + r, i0 + r + 8}; const LAS float* const bias[2] = {lb + 16 * TA + (0 * 4 + hs) * TB, lb + 16 * TA + (0 * 4 + hs) * TB};
                  band_group<2, RB_B>(o, mr, lr, qb_, qcol, qmu, C_KB + 0 * 256 + hs * 64, VTB + (size_t)(((0 * 2 + b) * 4 + hs) * 64) * 8192, 1, 0, S, 16, (i0 >> 5) - 2, 12, bias, F.lane); }
                { const int qcol[2] = {C_QB + 1 * 256 + hs * 64, C_QB + 1 * 256 + hs * 64}; const int qmu[2] = {(i0 + r) >> 2, (i0 + r + 8) >> 2}; const LAS float* const bias[2] = {lb + 16 * TA + (1 * 4 + hs) * TB, lb + 16 * TA + (1 * 4 + hs) * TB};
                  band_group<2, RB_B>(o, mr, lr, qb_, qcol, qmu, C_KB + 1 * 256 + hs * 64, VTB + (size_t)(((1 * 2 + b) * 4 + hs) * 64) * 8192, 4, r & 3, S / 4, 4, (i0 >> 7) - 2, 6, bias, F.lane); }
#pragma unroll
                for (int h = 0; h < 2; ++h) { const int qcol[1] = {C_QB + 2 * 256 + hs * 64}; const int qmu[1] = {i0 >> 4}; const LAS float* const bias[1] = {lb + 16 * TA + (2 * 4 + hs) * TB};
                  band_group<1, RB_B>(*(f32x4(*)[1][4])&o[h], *(float(*)[1])&mr[h], *(float(*)[1])&lr[h], qb_, qcol, qmu, C_KB + 2 * 256 + hs * 64, VTB + (size_t)(((2 * 2 + b) * 4 + hs) * 64) * 8192,
                                    16, r + 8 * h, S / 16, 1, (blk - 4) >> 1, 5, bias, F.lane); }
                bf16* yr = YB + (size_t)(b * S + i0 + r + 16 * t) * 256 + hs * 64; bf16* const yrow[2] = {yr, yr + 8 * 256};
                band_store<2>(o, lr, yrow, F.lane);
            }
        }
        __syncthreads();
    }
    SEAM(2);
    if (IN(3)) REP(3) {
#ifndef NO_P3A
        { int k256 = 256; asm volatile("" : "+s"(k256)); pg8::Gemm g{YB, Wb_t, k256}; pg8::StaticOrder So; So.init(T, D, F.G, (int)blockIdx.x);
          pg8::EpiGate<0> E{MERGED, GATES, 1024};
          pg8::gemm_phase<pg8::EpiGate<0>, pg8::StaticOrder, true, true>(F.lds + RING_OFF, g, So, E); }
#endif
        VM_WAIT(); __syncthreads();
#ifndef NO_P3B
        { pg8::Gemm g{YA, Wa_t, D}; pg8::StaticOrder So; So.init(T, D, F.G, (int)blockIdx.x);
          pg8::EpiGate<1> E{MERGED, GATES, 0};
          pg8::gemm_phase<pg8::EpiGate<1>, pg8::StaticOrder, true, true>(F.lds + RING_OFF, g, So, E); }
#endif
    }
    SEAM(3);
    if (IN(4)) REP(4) {
        pg8::Gemm g{MERGED, Wout_t, D}; pg8::StaticOrder So; So.init(T, D, F.G, (int)blockIdx.x);
        pg8::EpiX1 E{x, out};
        pg8::gemm_phase<pg8::EpiX1, pg8::StaticOrder, true, true>(F.lds + RING_OFF, g, So, E);
    }
    SEAM(4);
    if (IN(5)) REP(5) {
        const bool lastrep5 = (rep_ + 1 == 1 + ((MK_DUP >> 5) & 1));
        LAS int* lcnt = F.tbl + 72; LAS int* lbase = F.tbl + 104; LAS int* ebuf = F.tbl + 136; LAS int* pbuf = F.tbl + 392;
        LAS float* plog = (LAS float*)(F.lds + RING_OFF);
        LAS float* psq = plog + 8 * 64 * 32;
        LAS float* rstd_s = psq + 512;
        const int g = F.lane >> 4, e16 = F.lane & 15, w = F.wave;
        float wB[32][2];
#pragma unroll
        for (int sc = 0; sc < 32; ++sc) { const int k = 128 * w + 32 * (sc >> 3) + 8 * g + (sc & 7); const float gm = norm_ffn[k];
            wB[sc][0] = gm * router_w[(size_t)k * NE + e16]; wB[sc][1] = gm * router_w[(size_t)k * NE + 16 + e16]; }
        for (int tblk = F.vcu; tblk < T / 64; tblk += F.G) {
            if (F.tid < 32) lcnt[F.tid] = 0;
            f32x4 v[4][2];
            { const GAS float* xr = (const GAS float*)out + (size_t)(tblk * 64 + e16) * D + 128 * w + 8 * g;
#pragma unroll
              for (int s4 = 0; s4 < 4; ++s4) { v[s4][0] = *(const GAS f32x4*)(xr + 32 * s4); v[s4][1] = *(const GAS f32x4*)(xr + 32 * s4 + 4); } }
#pragma unroll 1
            for (int tile = 0; tile < 4; ++tile) {
                f32x4 vn[4][2];
                { const int tn = tile < 3 ? tile + 1 : 3; const GAS float* xr = (const GAS float*)out + (size_t)(tblk * 64 + tn * 16 + e16) * D + 128 * w + 8 * g;
#pragma unroll
                  for (int s4 = 0; s4 < 4; ++s4) { vn[s4][0] = *(const GAS f32x4*)(xr + 32 * s4); vn[s4][1] = *(const GAS f32x4*)(xr + 32 * s4 + 4); } }
                float sq = 0.f;
#pragma unroll
                for (int s4 = 0; s4 < 4; ++s4) sq += (v[s4][0].x * v[s4][0].x + v[s4][0].y * v[s4][0].y) + (v[s4][0].z * v[s4][0].z + v[s4][0].w * v[s4][0].w)
                                                   + (v[s4][1].x * v[s4][1].x + v[s4][1].y * v[s4][1].y) + (v[s4][1].z * v[s4][1].z + v[s4][1].w * v[s4][1].w);
                sq += __shfl_xor(sq, 16); sq += __shfl_xor(sq, 32);
                if (g == 0) psq[w * 64 + tile * 16 + e16] = sq;
                f32x4 a0 = (f32x4){0.f, 0.f, 0.f, 0.f}, a1 = (f32x4){0.f, 0.f, 0.f, 0.f};
#pragma unroll
                for (int s4 = 0; s4 < 4; ++s4)
#pragma unroll
                    for (int c = 0; c < 8; ++c) { const float av = v[s4][c >> 2][c & 3];
                        a0 = __builtin_amdgcn_mfma_f32_16x16x4f32(av, wB[s4 * 8 + c][0], a0, 0, 0, 0); a1 = __builtin_amdgcn_mfma_f32_16x16x4f32(av, wB[s4 * 8 + c][1], a1, 0, 0, 0); }
#pragma unroll
                for (int r = 0; r < 4; ++r) { LAS float* pr = plog + (size_t)(w * 64 + tile * 16 + 4 * g + r) * 32 + e16; pr[0] = a0[r]; pr[16] = a1[r]; }
#pragma unroll
                for (int s4 = 0; s4 < 4; ++s4) { v[s4][0] = vn[s4][0]; v[s4][1] = vn[s4][1]; }
            }
            __syncthreads();
            if (F.tid < 64) { float s = 0.f;
#pragma unroll
                for (int ww = 0; ww < 8; ++ww) s += psq[ww * 64 + F.tid];
                rstd_s[F.tid] = 1.f / sqrtf(s * (1.f / D) + EPS); }
            __syncthreads();
            { const int e = F.tid & 31; const float rbv = router_b[e];
#pragma unroll 1
              for (int i = 0; i < 4; ++i) { const int tl = (F.tid >> 5) + 16 * i; float lg = 0.f;
#pragma unroll
                for (int ww = 0; ww < 8; ++ww) lg += plog[(size_t)(ww * 64 + tl) * 32 + e];
                float val = lg * rstd_s[tl] + rbv; float tv[4]; int ti[4];
#pragma unroll
                for (int r = 0; r < 4; ++r) {
                    float bv = val; int bi = e;
#pragma unroll
                    for (int o = 1; o < 32; o <<= 1) { const float ov = __shfl_xor(bv, o); const int oi = __shfl_xor(bi, o); if (ov > bv || (ov == bv && oi < bi)) { bv = ov; bi = oi; } }
                    tv[r] = bv; ti[r] = bi; if (bi == e) val = -3.0e38f;
                }
                const float e1 = __expf(tv[1] - tv[0]), e2 = __expf(tv[2] - tv[0]), e3 = __expf(tv[3] - tv[0]); const float inv = 1.f / (1.f + e1 + e2 + e3);
                if (e < 4) { const float p = (e == 0 ? 1.f : e == 1 ? e1 : e == 2 ? e2 : e3) * inv; const int ex = (e == 0 ? ti[0] : e == 1 ? ti[1] : e == 2 ? ti[2] : ti[3]);
                    const int m = tblk * 64 + tl; topi[m * 4 + e] = ex; topp[m * 4 + e] = p;
                    const int li = tl * 4 + e; ebuf[li] = ex; pbuf[li] = __hip_atomic_fetch_add(&lcnt[ex], 1, __ATOMIC_RELAXED, __HIP_MEMORY_SCOPE_WORKGROUP); } } }
#pragma unroll 1
            for (int rb = 0; rb < 8; rb += 4) { f32x4 xv[4][4];
#pragma unroll
                for (int r = 0; r < 4; ++r) { const GAS f32x4* xr4 = (const GAS f32x4*)(out + ((size_t)tblk * 64 + w * 8 + rb + r) * D) + F.lane;
#pragma unroll
                    for (int j = 0; j < 4; ++j) xv[r][j] = xr4[64 * j]; }
#pragma unroll
                for (int r = 0; r < 4; ++r) { const int tl = w * 8 + rb + r; const float rstd = rstd_s[tl]; GAS unsigned* o4 = (GAS unsigned*)(H28 + ((size_t)tblk * 64 + tl) * D) + F.lane;
#pragma unroll
                    for (int j = 0; j < 4; ++j) { const f32x4 gg = ((const GAS f32x4*)norm_ffn)[F.lane + 64 * j];
                        o4[64 * j] = pk4_fp8(xv[r][j].x * rstd * gg.x, xv[r][j].y * rstd * gg.y, xv[r][j].z * rstd * gg.z, xv[r][j].w * rstd * gg.w); } } }
            __syncthreads();
            if (F.tid < 32) lbase[F.tid] = lastrep5 ? (int)__hip_atomic_fetch_add(cnt + F.tid, (unsigned)lcnt[F.tid], RLX_AGENT) : 0;
            __syncthreads();
            if (F.tid < 256) pos[tblk * 256 + F.tid] = lbase[ebuf[F.tid]] + pbuf[F.tid];
            __syncthreads();
        }
    }
    SEAM(5);
    if (IN(6) || IN(7) || IN(8)) {
        LAS int* loff = F.tbl; LAS int* ltoff = F.tbl + 36; LAS int* lc = F.tbl + 72;
        if (F.tid < 32) lc[F.tid] = (int)__hip_atomic_load(cnt + F.tid, RLX_AGENT);
        __syncthreads();
        if (F.tid == 0) { int a = 0, ta = 0; for (int e = 0; e < NE; ++e) { loff[e] = a; ltoff[e] = ta; const int c = lc[e]; a += c; ta += (c + 255) >> 8; } loff[NE] = a; ltoff[NE] = ta; }
        __syncthreads();
    }
    if (IN(6)) REP(6) {
        transpose_items(I_IN + 2 * I_A + I_B, NITEMS);
        const LAS int* loff = F.tbl;
        for (int p0 = gw; p0 < T * 4; p0 += 4 * NGW) {
            int row[4]; u32x4 dv[4];
#pragma unroll
            for (int q = 0; q < 4; ++q) { const int p = p0 + q * NGW; row[q] = (p < T * 4) ? loff[topi[p]] + pos[p] : -1; }
#pragma unroll
            for (int q = 0; q < 4; ++q) { const int p = p0 + q * NGW; if (row[q] >= 0) dv[q] = ((const GAS u32x4*)(H28 + (size_t)(p >> 2) * D))[F.lane]; }
#pragma unroll
            for (int q = 0; q < 4; ++q) { const int p = p0 + q * NGW; if (row[q] >= 0) { if (F.lane == 0) slot[p] = row[q]; ((GAS u32x4*)(HS8 + (size_t)row[q] * D))[F.lane] = dv[q]; } }
        }
    }
    SEAM(6);
    if (IN(7)) REP(7) {
        int k512 = D / 2; asm volatile("" : "+s"(k512));
        pg8::Gemm g{(const bf16*)HS8, (const bf16*)Wgu8, k512}; pg8::GroupOrder So{F.tbl + 36, F.tbl, 8, F.G, (int)blockIdx.x, 0}; So.nunits = __builtin_amdgcn_readfirstlane(F.tbl[36 + NE]) * 8;
        pg8::EpiSwiglu E{ACT8, b_gate, b_up};
        pg8::gemm_phase<pg8::EpiSwiglu, pg8::GroupOrder, true, FP8_SP2, true>(F.lds + RING_OFF, g, So, E);
    }
    SEAM(7);
    if (IN(8)) REP(8) {
        int k512 = D / 2; asm volatile("" : "+s"(k512));
        pg8::Gemm g{(const bf16*)ACT8, (const bf16*)Wd8, k512}; pg8::GroupOrder So{F.tbl + 36, F.tbl, 4, F.G, (int)blockIdx.x, 0}; So.nunits = __builtin_amdgcn_readfirstlane(F.tbl[36 + NE]) * 4;
        pg8::EpiDown E{YS, b_down};
        pg8::gemm_phase<pg8::EpiDown, pg8::GroupOrder, true, FP8_SP2, true>(F.lds + RING_OFF, g, So, E);
    }
    SEAM(8);
#ifdef MK_XBAR
    for (int xb_ = 0; xb_ < MK_XBAR; ++xb_) xcd_barrier(bar);
#endif
    if (IN(9)) REP(9) {
        const unsigned char* ys = YS;
        float* dst9 = (rep_ + 1 < 1 + ((MK_DUP >> 9) & 1)) ? (float*)(ws + WS_ACT) : out;
        for (int m0 = gw; m0 < T; m0 += 2 * NGW) {
            f32x4 v[2][4]; int sl[2][4]; float pr[2][4]; unsigned yv[2][4][4]; bool ok[2];
#pragma unroll
            for (int q = 0; q < 2; ++q) { const int m = m0 + q * NGW; ok[q] = m < T; const int mc = ok[q] ? m : m0; const GAS f32x4* xr = (const GAS f32x4*)(out + (size_t)mc * D) + F.lane;
#pragma unroll
                for (int j = 0; j < 4; ++j) v[q][j] = xr[64 * j];
#pragma unroll
                for (int k = 0; k < 4; ++k) { sl[q][k] = slot[mc * 4 + k]; pr[q][k] = topp[mc * 4 + k]; } }
#pragma unroll
            for (int q = 0; q < 2; ++q)
#pragma unroll
                for (int k = 0; k < 4; ++k) { const GAS unsigned* yr = (const GAS unsigned*)(ys + (size_t)sl[q][k] * D) + F.lane;
#pragma unroll
                    for (int j = 0; j < 4; ++j) yv[q][k][j] = yr[64 * j]; }
#pragma unroll
            for (int q = 0; q < 2; ++q) { if (!ok[q]) continue; const int m = m0 + q * NGW;
#pragma unroll
                for (int k = 0; k < 4; ++k) { const float p = pr[q][k];
#pragma unroll
                    for (int j = 0; j < 4; ++j) { const unsigned u = yv[q][k][j]; const f32x2 lo = __builtin_amdgcn_cvt_pk_f32_fp8(u, false), hi = __builtin_amdgcn_cvt_pk_f32_fp8(u, true);
                        v[q][j].x += p * lo.x; v[q][j].y += p * lo.y; v[q][j].z += p * hi.x; v[q][j].w += p * hi.y; } }
                float s = 0.f;
#pragma unroll
                for (int j = 0; j < 4; ++j) s += (v[q][j].x * v[q][j].x + v[q][j].y * v[q][j].y) + (v[q][j].z * v[q][j].z + v[q][j].w * v[q][j].w);
                const float rstd = 1.f / sqrtf(wave_sum(s) * (1.f / D) + EPS);
#pragma unroll
                for (int j = 0; j < 4; ++j) { const f32x4 gg = ((const GAS f32x4*)norm_final)[F.lane + 64 * j]; f32x4 y; y.x = v[q][j].x * rstd * gg.x; y.y = v[q][j].y * rstd * gg.y; y.z = v[q][j].z * rstd * gg.z; y.w = v[q][j].w * rstd * gg.w;
                    ((GAS f32x4*)(dst9 + (size_t)m * D) + F.lane)[64 * j] = y; } }
        }
    }
#ifdef MK_TSTAMP
    if (MK_TSTAMP == 9) ts_b = __builtin_amdgcn_s_memrealtime();
    if (blockIdx.x == 0) { const unsigned long long dt = ts_b - ts_a, t0_ = __builtin_amdgcn_s_memrealtime();
        while (__builtin_amdgcn_s_memrealtime() - t0_ < 2 * dt) __builtin_amdgcn_s_sleep(8); }
#endif
#undef IN
#undef SEAM
}

extern "C" void kernel_launch(void* const* d_in, const int* in_sizes, int n_in, void* d_out, int out_size, void* d_ws, size_t ws_size, hipStream_t stream) {
    static int grid = 0;
    if (grid == 0) {
        if (n_in != 19 || in_sizes[0] != T * D || out_size != T * D || ws_size < WS_END) { fprintf(stderr, "kernel_launch: unexpected shapes (n_in %d, ws %zu); nothing launched\n", n_in, ws_size); grid = -1; return; }
        int dev = 0, cus = 0, per_cu = 0;
        if (hipGetDevice(&dev) != hipSuccess || hipDeviceGetAttribute(&cus, hipDeviceAttributeMultiprocessorCount, dev) != hipSuccess) { grid = -1; return; }
        if (hipFuncSetAttribute((const void*)mk_fwd, hipFuncAttributeMaxDynamicSharedMemorySize, LDS_BYTES) != hipSuccess) { fprintf(stderr, "kernel_launch: hipFuncSetAttribute failed\n"); grid = -1; return; }
        if (hipOccupancyMaxActiveBlocksPerMultiprocessor(&per_cu, (const void*)mk_fwd, NWAVES * 64, LDS_BYTES) != hipSuccess || per_cu < 1) { fprintf(stderr, "kernel_launch: occupancy query says %d blocks per CU\n", per_cu); }
        (void)hipGetLastError();
        grid = cus;
        if (grid != 256) fprintf(stderr, "kernel_launch: %d CUs (built and tuned for 256)\n", grid);
    }
    if (grid < 0) return;
    if (hipMemsetAsync((char*)d_ws + WS_CTL, 0, CTL_ZERO_BYTES, stream) != hipSuccess) return;
    Args a{};
    for (int i = 0; i < 19; ++i) a.in[i] = (const float*)d_in[i];
    a.out = (float*)d_out; a.ws = (unsigned char*)d_ws;
#if MK_MODE == 2
    a.ph_lo = 0; a.ph_hi = NPHASE; a.li = 0;
    hipLaunchKernelGGL(mk_fwd, dim3(grid), dim3(NWAVES * 64), LDS_BYTES, stream, a);
#else
    for (int ph = 0; ph < NPHASE; ++ph) { a.ph_lo = ph; a.ph_hi = ph + 1; a.li = ph; hipLaunchKernelGGL(mk_fwd, dim3(grid), dim3(NWAVES * 64), LDS_BYTES, stream, a); }
#endif
}
```

```cpp
#define MK_DUP 0
#include <hip/hip_runtime.h>
#include <stdint.h>
#include <stdio.h>

#ifndef FP8_SP2
#define FP8_SP2 true
#endif
#ifndef MK_MODE
#define MK_MODE 2
#endif

typedef unsigned short bf16;
typedef short bf16x8 __attribute__((ext_vector_type(8)));
typedef float f32x4 __attribute__((ext_vector_type(4)));
typedef float f32x2 __attribute__((ext_vector_type(2)));
typedef unsigned u32x4 __attribute__((ext_vector_type(4)));
typedef unsigned u32x2 __attribute__((ext_vector_type(2)));
#define GAS __attribute__((address_space(1)))
#define LAS __attribute__((address_space(3)))
typedef GAS unsigned gu32;

constexpr int T = 16384, S = 8192, D = 1024, NPROJ = 5888, NQKV = 3840, NGATE = 2048, NE = 32, TOPK = 4;
constexpr int C_QA = 0, C_KA = 1024, C_VA = 1280, C_QB = 1536, C_KB = 2304, C_VB = 3072;
constexpr float EPS = 1e-5f;
constexpr size_t MiB = 1u << 20;
constexpr size_t WS_CTL = 0, CTL_ZERO_BYTES = 1 * MiB;
constexpr size_t WS_TAB = 1 * MiB;
constexpr size_t WS_WIN = 2 * MiB;
constexpr size_t WS_WA = 14 * MiB;
constexpr size_t WS_WB = 16 * MiB;
constexpr size_t WS_WOUT = 17 * MiB;
constexpr size_t WS_RT = 19 * MiB;
constexpr size_t WS_WGU = 24 * MiB;
constexpr size_t WS_WD = 88 * MiB;
constexpr size_t WS_H2 = 120 * MiB;
constexpr size_t WS_HS = 136 * MiB;
constexpr size_t WS_ACT = 201 * MiB;
constexpr size_t WS_YS = 272 * MiB;
constexpr size_t WS_XN = 216 * MiB;
constexpr size_t WS_QKV = 248 * MiB;
constexpr size_t WS_GATES = 368 * MiB;
constexpr size_t WS_YA = 432 * MiB;
constexpr size_t WS_YB = 464 * MiB;
constexpr size_t WS_MERGED = 472 * MiB;
constexpr size_t WS_VT = 472 * MiB;
constexpr size_t WS_END = 506 * MiB;
constexpr int CW_CNT = 0;
constexpr int CW_BAR = 4096;

__device__ const unsigned char BKT_A[257] = {12,12,12,12,12,12,12,12,12,12,12,12,12,12,12,12,12,12,12,12,12,12,12,12,12,12,12,12,12,12,12,12,12,12,12,12,12,12,11,11,11,11,11,11,11,11,11,11,11,11,11,11,11,11,11,11,11,11,11,11,11,11,11,11,11,11,11,11,11,11,11,11,11,11,11,11,11,11,11,10,10,10,10,10,10,10,10,10,10,10,10,10,10,10,10,10,10,10,10,10,10,10,9,9,9,9,9,9,9,9,9,9,9,9,8,8,8,8,8,8,8,7,6,5,4,3,2,1,0,17,18,19,20,21,22,23,24,24,24,24,24,24,24,25,25,25,25,25,25,25,25,25,25,25,25,26,26,26,26,26,26,26,26,26,26,26,26,26,26,26,26,26,26,26,26,26,26,26,27,27,27,27,27,27,27,27,27,27,27,27,27,27,27,27,27,27,27,27,27,27,27,27,27,27,27,27,27,27,27,27,27,27,27,27,27,27,27,27,27,28,28,28,28,28,28,28,28,28,28,28,28,28,28,28,28,28,28,28,28,28,28,28,28,28,28,28,28,28,28,28,28,28,28,28,28,28,28};
__device__ const unsigned char BKT_B[3][129] = {
 {11,11,11,11,11,11,11,11,11,11,11,11,11,11,11,10,10,10,10,10,10,10,10,10,10,10,10,10,10,10,10,10,10,10,10,10,10,10,9,9,9,9,9,9,9,9,9,9,9,9,8,8,8,8,8,8,8,7,6,5,4,3,2,1,0,17,18,19,20,21,22,23,24,24,24,24,24,24,24,25,25,25,25,25,25,25,25,25,25,25,25,26,26,26,26,26,26,26,26,26,26,26,26,26,26,26,26,26,26,26,26,26,26,26,27,27,27,27,27,27,27,27,27,27,27,27,27,27,27},
 {13,13,13,13,13,13,13,13,13,13,13,13,13,13,13,13,13,13,13,13,13,13,13,12,12,12,12,12,12,12,12,12,12,12,12,12,12,12,12,12,12,12,11,11,11,11,11,11,11,11,11,11,10,10,10,10,10,10,9,9,9,8,8,4,0,20,24,24,25,25,25,26,26,26,26,26,26,27,27,27,27,27,27,27,27,27,27,28,28,28,28,28,28,28,28,28,28,28,28,28,28,28,28,28,28,28,29,29,29,29,29,29,29,29,29,29,29,29,29,29,29,29,29,29,29,29,29,29,29},
 {15,15,15,15,15,15,15,15,15,15,15,15,15,15,15,15,15,15,15,15,15,15,15,15,15,15,15,15,15,15,14,14,14,14,14,14,14,14,14,14,14,14,14,14,14,13,13,13,13,13,13,13,13,13,12,12,12,12,12,11,11,10,10,9,0,25,26,26,27,27,28,28,28,28,28,29,29,29,29,29,29,29,29,29,30,30,30,30,30,30,30,30,30,30,30,30,30,30,30,31,31,31,31,31,31,31,31,31,31,31,31,31,31,31,31,31,31,31,31,31,31,31,31,31,31,31,31,31,31}};

#define RLX_AGENT __ATOMIC_RELAXED, __HIP_MEMORY_SCOPE_AGENT
#define LDS_WAIT() asm volatile("s_waitcnt lgkmcnt(0)" ::: "memory")
#define VM_WAIT() asm volatile("s_waitcnt vmcnt(0)" ::: "memory")
__device__ __forceinline__ unsigned f2bf(float f) { unsigned u = __builtin_bit_cast(unsigned, f); return (u + 0x7fffu + ((u >> 16) & 1u)) >> 16; }
__device__ __forceinline__ unsigned pk2(float lo, float hi) { return f2bf(lo) | (f2bf(hi) << 16); }
__device__ __forceinline__ unsigned pk4_fp8(float a, float b, float c, float d) { unsigned w = 0; w = __builtin_amdgcn_cvt_pk_fp8_f32(a, b, w, false); w = __builtin_amdgcn_cvt_pk_fp8_f32(c, d, w, true); return w; }
__device__ __forceinline__ float bf2f(unsigned b) { return __builtin_bit_cast(float, b << 16); }
__device__ __forceinline__ float bflo(unsigned u) { return __builtin_bit_cast(float, u << 16); }
__device__ __forceinline__ float bfhi(unsigned u) { return __builtin_bit_cast(float, u & 0xffff0000u); }
__device__ __forceinline__ float wave_sum(float v) {
#pragma unroll
    for (int o = 1; o < 64; o <<= 1) v += __shfl_xor(v, o);
    return v;
}
__device__ __forceinline__ float sigm(float x) { return __builtin_amdgcn_rcpf(1.f + __builtin_amdgcn_exp2f(-1.4426950408889634f * x)); }

struct Tabs { float biasA[16][257]; float biasB[3][4][129]; };

namespace pg8 {
#define PG8_LAS __attribute__((address_space(3)))
typedef unsigned short bf16_t;
constexpr int BM = 256, BK = 64, HALF = 128, HTB = HALF * BK * 2, STAGE_BYTES = 8 * HTB, NXCD = 8, WGM = 8;
__host__ __device__ __forceinline__ int lds_byte(int r, int c) { const int st = (r >> 4) * 2 + (c >> 5), rr = r & 15, cc = c & 31, ob = rr * 64 + cc * 2; return st * 1024 + (ob ^ (((ob >> 9) & 1) << 5)); }
__host__ __device__ __forceinline__ void stage_rc(int b, int& R, int& C) { const int st = b / 1024, sb = b % 1024, swz = sb ^ (((sb >> 9) & 1) << 5); R = (st >> 1) * 16 + swz / 64; C = (st & 1) * 32 + (swz % 64) / 2; }
__host__ __device__ __forceinline__ int perm32(int rho) { const int n = rho >> 4, i = rho & 15; return 8 * (i >> 2) + 4 * n + (i & 3); }

struct Unit { int arow, brow, nrows, e; };
struct Gemm { const bf16_t* A; const bf16_t* Bt; int K; };

struct StaticOrder {
    int nM, nN, nwg, G, c;
    __device__ void init(int M, int N, int G_, int c_) { nM = M / BM; nN = N / BM; nwg = nM * nN; G = G_; c = c_; }
    __device__ bool next(int i, Unit& u) const {
        const long L = (long)i * G + c; if (L >= nwg) return false;
        int wgid = (int)L; { const int q = nwg / NXCD, r = nwg % NXCD, xcd = wgid % NXCD, off = wgid / NXCD; wgid = (xcd < r ? xcd * (q + 1) : r * (q + 1) + (xcd - r) * q) + off; }
        const int nig = WGM * nN, gid = wgid / nig, fm = gid * WGM, gsz = (nM - fm) < WGM ? (nM - fm) : WGM;
        u.arow = BM * (fm + ((wgid % nig) % gsz)); u.brow = BM * ((wgid % nig) / gsz); u.nrows = BM; u.e = 0; return true;
    }
    __device__ __forceinline__ void a_ready(const Unit&) const {}
    __device__ __forceinline__ void done(const Unit&) const {}
};
struct GroupOrder {
    const PG8_LAS int* toff; const PG8_LAS int* off; int NT, G, c, nunits;
    __device__ bool next(int i, Unit& u) const {
        const int L = i * G + c; if (L >= nunits) return false;
        const int mtg = L / NT, pn = L - mtg * NT;
        int e = 0;
        for (int j = 1; j < NE; ++j) e += (toff[j] <= mtg) ? 1 : 0;
        e = __builtin_amdgcn_readfirstlane(e);
        const int mt = mtg - __builtin_amdgcn_readfirstlane(toff[e]); const int o0 = __builtin_amdgcn_readfirstlane(off[e]), o1 = __builtin_amdgcn_readfirstlane(off[e + 1]);
        u.arow = o0 + BM * mt; const int rem = o1 - u.arow; u.nrows = rem < BM ? rem : BM; u.brow = (e * NT + pn) * BM; u.e = e; return true;
    }
    __device__ __forceinline__ void a_ready(const Unit&) const {}
    __device__ __forceinline__ void done(const Unit&) const {}
};

__device__ __forceinline__ unsigned cvt_pk_bf16(float lo, float hi) { unsigned r; asm volatile("v_cvt_pk_bf16_f32 %0, %1, %2" : "=v"(r) : "v"(lo), "v"(hi)); return r; }

struct EpiProj {
    static constexpr bool PERM = true, AFTER_DRAIN = false; static constexpr int TAG = 1;
    bf16_t* qkv; bf16_t* gates; const float* bias; bf16_t* vta; bf16_t* vtb;
    __device__ __forceinline__ void prefetch(const Unit& u, PG8_LAS unsigned char* slot, int wid, int lane) const {
        if (wid == 0) __builtin_amdgcn_global_load_lds((const unsigned*)(bias + u.brow + 4 * lane), (PG8_LAS unsigned*)slot, 16, 0, 0); }
    __device__ __forceinline__ void operator()(const f32x4 (&acc)[2][2][4][2], const Unit& u, int wr, int wc, int fr, int fq, const PG8_LAS unsigned char* slot) const {
        const int colt = u.brow; const bool isq = colt < NQKV; bf16_t* base = isq ? qkv : gates; const int ldc = isq ? NQKV : NGATE; const int cb = isq ? colt : colt - NQKV;
        const int row0 = u.arow + wr * 64 + fr, col0 = cb + wc * 32 + 8 * fq, bcol0 = colt + wc * 32 + 8 * fq;
        f32x4 bv[2][2];
#pragma unroll
        for (int bj = 0; bj < 2; ++bj)
#pragma unroll
            for (int n = 0; n < 2; ++n) bv[bj][n] = *(const PG8_LAS f32x4*)(slot + (wc * 32 + 8 * fq + bj * HALF + 4 * n) * 4);
        const bool isv = (colt == C_VA) || (colt >= C_VB && colt < NQKV);
        const float qs = (colt < C_KA || (colt >= C_QB && colt < C_KB)) ? 0.125f * 1.4426950408889634f : 1.f;
        if (!isv) {
#pragma unroll
        for (int ai = 0; ai < 2; ++ai)
#pragma unroll
            for (int m = 0; m < 4; ++m) { bf16_t* rowp = base + (size_t)(row0 + ai * HALF + m * 16) * ldc + col0;
#pragma unroll
                for (int bj = 0; bj < 2; ++bj) { const f32x4 v0 = (acc[ai][bj][m][0] + bv[bj][0]) * qs, v1 = (acc[ai][bj][m][1] + bv[bj][1]) * qs;
                    u32x4 w; w.x = cvt_pk_bf16(v0[0], v0[1]); w.y = cvt_pk_bf16(v0[2], v0[3]); w.z = cvt_pk_bf16(v1[0], v1[1]); w.w = cvt_pk_bf16(v1[2], v1[3]);
                    *(u32x4*)(rowp + bj * HALF) = w; } }
        } else {
            const int gsel = (colt == C_VA) ? -1 : ((colt - C_VB) >> 8); const int sh = (gsel <= 0) ? 0 : (gsel == 1 ? 2 : 4);
            bf16_t* vb = (gsel < 0) ? vta : vtb + (size_t)gsel * (2 * 256 * 8192); const int c0 = wc * 32 + 8 * fq;
#pragma unroll
            for (int ai = 0; ai < 2; ++ai)
#pragma unroll
                for (int m = 0; m < 4; ++m) { const int row = row0 + ai * HALF + m * 16, b = row >> 13, s = row & 8191; const int mu = s >> sh; const int pos = ((s & ((1 << sh) - 1)) << (13 - sh)) + (mu & ~31) + (((mu & 15) >> 2) << 3) + (((mu >> 4) & 1) << 2) + (mu & 3);
                    bf16_t* vp = vb + (size_t)(b * 256 + c0) * 8192 + pos;
#pragma unroll
                    for (int bj = 0; bj < 2; ++bj)
#pragma unroll
                        for (int n = 0; n < 2; ++n) { const f32x4 v = acc[ai][bj][m][n] + bv[bj][n]; const unsigned w0 = cvt_pk_bf16(v[0], v[1]), w1 = cvt_pk_bf16(v[2], v[3]);
                            bf16_t* q = vp + (size_t)(bj * HALF + 4 * n) * 8192;
                            q[0] = (bf16_t)(w0 & 0xffffu); q[8192] = (bf16_t)(w0 >> 16); q[2 * 8192] = (bf16_t)(w1 & 0xffffu); q[3 * 8192] = (bf16_t)(w1 >> 16); } }
        }
    }
};
template <int MODE> struct EpiGate {
    static constexpr bool PERM = true, AFTER_DRAIN = false; static constexpr int TAG = 3;
    bf16_t* out; const bf16_t* gates; int gcol0;
    __device__ __forceinline__ void prefetch(const Unit&, PG8_LAS unsigned char*, int, int) const {}
    __device__ __forceinline__ void operator()(const f32x4 (&acc)[2][2][4][2], const Unit& u, int wr, int wc, int fr, int fq, const PG8_LAS unsigned char*) const {
        const int row0 = u.arow + wr * 64 + fr, col0 = u.brow + wc * 32 + 8 * fq;
        u32x4 gv[8][2];
#pragma unroll
        for (int gi = 0; gi < 4; ++gi) { const size_t r = (size_t)(row0 + (gi >> 2) * HALF + (gi & 3) * 16);
#pragma unroll
            for (int bj = 0; bj < 2; ++bj) gv[gi][bj] = *(const u32x4*)(gates + r * NGATE + gcol0 + col0 + bj * HALF); }
        u32x4 mv[2], mn[2];
        if (MODE == 1) {
#pragma unroll
            for (int bj = 0; bj < 2; ++bj) mv[bj] = *(const u32x4*)(out + (size_t)row0 * D + col0 + bj * HALF); }
#pragma unroll
        for (int gi = 0; gi < 8; ++gi) { const int ai = gi >> 2, m = gi & 3; const size_t r = (size_t)(row0 + ai * HALF + m * 16);
            if (gi == 1) {
#pragma unroll
                for (int g2 = 4; g2 < 8; ++g2) { const size_t r2 = (size_t)(row0 + (g2 >> 2) * HALF + (g2 & 3) * 16);
#pragma unroll
                    for (int bj = 0; bj < 2; ++bj) gv[g2][bj] = *(const u32x4*)(gates + r2 * NGATE + gcol0 + col0 + bj * HALF); } }
            if (MODE == 1 && gi + 1 < 8) { const size_t rn = (size_t)(row0 + ((gi + 1) >> 2) * HALF + ((gi + 1) & 3) * 16);
#pragma unroll
                for (int bj = 0; bj < 2; ++bj) mn[bj] = *(const u32x4*)(out + rn * D + col0 + bj * HALF); }
#pragma unroll
            for (int bj = 0; bj < 2; ++bj) { const int c = col0 + bj * HALF; const u32x4 g4 = gv[gi][bj]; const f32x4 a0 = acc[ai][bj][m][0], a1 = acc[ai][bj][m][1];
                float o[8]; o[0] = sigm(bflo(g4.x)) * a0[0]; o[1] = sigm(bfhi(g4.x)) * a0[1]; o[2] = sigm(bflo(g4.y)) * a0[2]; o[3] = sigm(bfhi(g4.y)) * a0[3];
                o[4] = sigm(bflo(g4.z)) * a1[0]; o[5] = sigm(bfhi(g4.z)) * a1[1]; o[6] = sigm(bflo(g4.w)) * a1[2]; o[7] = sigm(bfhi(g4.w)) * a1[3];
                if (MODE == 1) { const u32x4 m4 = mv[bj];
                    o[0] += bflo(m4.x); o[1] += bfhi(m4.x); o[2] += bflo(m4.y); o[3] += bfhi(m4.y); o[4] += bflo(m4.z); o[5] += bfhi(m4.z); o[6] += bflo(m4.w); o[7] += bfhi(m4.w); }
                u32x4 w; w.x = cvt_pk_bf16(o[0], o[1]); w.y = cvt_pk_bf16(o[2], o[3]); w.z = cvt_pk_bf16(o[4], o[5]); w.w = cvt_pk_bf16(o[6], o[7]);
                *(u32x4*)(out + r * D + c) = w; }
            asm volatile("" ::: "memory");
            if (MODE == 1) {
#pragma unroll
                for (int bj = 0; bj < 2; ++bj) mv[bj] = mn[bj]; } }
    }
};
struct EpiX1 {
    static constexpr bool PERM = true, AFTER_DRAIN = false; static constexpr int TAG = 4;
    const float* x; float* out;
    __device__ __forceinline__ void prefetch(const Unit&, PG8_LAS unsigned char*, int, int) const {}
    __device__ __forceinline__ void operator()(const f32x4 (&acc)[2][2][4][2], const Unit& u, int wr, int wc, int fr, int fq, const PG8_LAS unsigned char*) const {
        const int row0 = u.arow + wr * 64 + fr, col0 = u.brow + wc * 32 + 8 * fq;
        f32x4 xv[2][2], xn[2][2];
#pragma unroll
        for (int bj = 0; bj < 2; ++bj) { const size_t o = (size_t)row0 * D + col0 + bj * HALF; xv[bj][0] = *(const f32x4*)(x + o); xv[bj][1] = *(const f32x4*)(x + o + 4); }
#pragma unroll
        for (int gi = 0; gi < 8; ++gi) { const int ai = gi >> 2, m = gi & 3; const size_t r = (size_t)(row0 + ai * HALF + m * 16);
            if (gi + 1 < 8) { const size_t rn = (size_t)(row0 + ((gi + 1) >> 2) * HALF + ((gi + 1) & 3) * 16);
#pragma unroll
                for (int bj = 0; bj < 2; ++bj) { const size_t o = rn * D + col0 + bj * HALF; xn[bj][0] = *(const f32x4*)(x + o); xn[bj][1] = *(const f32x4*)(x + o + 4); } }
#pragma unroll
            for (int bj = 0; bj < 2; ++bj) { const size_t o = r * D + col0 + bj * HALF;
                *(f32x4*)(out + o) = xv[bj][0] + acc[ai][bj][m][0]; *(f32x4*)(out + o + 4) = xv[bj][1] + acc[ai][bj][m][1]; }
            asm volatile("" ::: "memory");
#pragma unroll
            for (int bj = 0; bj < 2; ++bj) { xv[bj][0] = xn[bj][0]; xv[bj][1] = xn[bj][1]; } }
    }
};
struct EpiSwiglu {
    static constexpr bool PERM = true, AFTER_DRAIN = false; static constexpr int TAG = 7;
    unsigned char* act; const float* bg; const float* bu;
    __device__ __forceinline__ void prefetch(const Unit& u, PG8_LAS unsigned char* slot, int wid, int lane) const {
        if (wid == 0) { const int pn = (u.brow >> 8) & 7; const float* src = ((lane < 32) ? bg : bu) + (size_t)u.e * D + pn * HALF + 4 * (lane & 31);
            __builtin_amdgcn_global_load_lds((const unsigned*)src, (PG8_LAS unsigned*)slot, 16, 0, 0); } }
    __device__ __forceinline__ void operator()(const f32x4 (&acc)[2][2][4][2], const Unit& u, int wr, int wc, int fr, int fq, const PG8_LAS unsigned char* slot) const {
        const int pn = (u.brow >> 8) & 7; const int col0 = pn * HALF + wc * 32 + 8 * fq; const int rl0 = wr * 64 + fr;
        const PG8_LAS f32x4* bl = (const PG8_LAS f32x4*)(slot + (wc * 32 + 8 * fq) * 4);
        const f32x4 g0 = bl[0], g1 = bl[1], u0 = bl[32], u1 = bl[33];
#pragma unroll
        for (int ai = 0; ai < 2; ++ai)
#pragma unroll
            for (int m = 0; m < 4; ++m) { const int rl = rl0 + ai * HALF + m * 16;
                const f32x4 ga = acc[ai][0][m][0] + g0, gb = acc[ai][0][m][1] + g1, ua = acc[ai][1][m][0] + u0, ub = acc[ai][1][m][1] + u1;
                float o[8];
#pragma unroll
                for (int j = 0; j < 4; ++j) { const float gt = fminf(ga[j], 7.f), up = fminf(fmaxf(ua[j], -7.f), 7.f); o[j] = gt * sigm(1.702f * gt) * (up + 1.f);
                    const float gt2 = fminf(gb[j], 7.f), up2 = fminf(fmaxf(ub[j], -7.f), 7.f); o[4 + j] = gt2 * sigm(1.702f * gt2) * (up2 + 1.f); }
                u32x2 w; w.x = pk4_fp8(o[0], o[1], o[2], o[3]); w.y = pk4_fp8(o[4], o[5], o[6], o[7]);
                if (rl < u.nrows) *(u32x2*)(act + (size_t)(u.arow + rl) * D + col0) = w; }
    }
};
struct EpiDown {
    static constexpr bool PERM = true, AFTER_DRAIN = false; static constexpr int TAG = 8;
    unsigned char* ys; const float* bd;
    __device__ __forceinline__ void prefetch(const Unit& u, PG8_LAS unsigned char* slot, int wid, int lane) const {
        if (wid == 0) { const int pn = (u.brow >> 8) & 3; __builtin_amdgcn_global_load_lds((const unsigned*)(bd + (size_t)u.e * D + pn * BM + 4 * lane), (PG8_LAS unsigned*)slot, 16, 0, 0); } }
    __device__ __forceinline__ void operator()(const f32x4 (&acc)[2][2][4][2], const Unit& u, int wr, int wc, int fr, int fq, const PG8_LAS unsigned char* slot) const {
        const int pn = (u.brow >> 8) & 3; const int col0 = pn * BM + wc * 32 + 8 * fq; const int rl0 = wr * 64 + fr;
        f32x4 bv[2][2];
#pragma unroll
        for (int bj = 0; bj < 2; ++bj)
#pragma unroll
            for (int n = 0; n < 2; ++n) bv[bj][n] = *(const PG8_LAS f32x4*)(slot + (wc * 32 + 8 * fq + bj * HALF + 4 * n) * 4);
#pragma unroll
        for (int ai = 0; ai < 2; ++ai)
#pragma unroll
            for (int m = 0; m < 4; ++m) { const int rl = rl0 + ai * HALF + m * 16; unsigned char* rowp = ys + (size_t)(u.arow + rl) * D + col0;
#pragma unroll
                for (int bj = 0; bj < 2; ++bj) { const f32x4 v0 = acc[ai][bj][m][0] + bv[bj][0], v1 = acc[ai][bj][m][1] + bv[bj][1];
                    u32x2 w; w.x = pk4_fp8(v0[0], v0[1], v0[2], v0[3]); w.y = pk4_fp8(v1[0], v1[1], v1[2], v1[3]);
                    if (rl < u.nrows) *(u32x2*)(rowp + bj * HALF) = w; } }
    }
};

typedef int i32x4_t __attribute__((ext_vector_type(4))); typedef int i32x8_t __attribute__((ext_vector_type(8)));
template <bool FP8> struct Frag;
template <> struct Frag<false> { bf16x8 v[2];
    __device__ __forceinline__ void ld(const PG8_LAS unsigned char* p) { v[0] = *(const PG8_LAS bf16x8*)p; v[1] = *(const PG8_LAS bf16x8*)(p + 1024); } };
template <> struct Frag<true> { i32x8_t v;
    __device__ __forceinline__ void ld(const PG8_LAS unsigned char* p) { const i32x4_t lo = *(const PG8_LAS i32x4_t*)p, hi = *(const PG8_LAS i32x4_t*)(p + 1024); v = __builtin_shufflevector(lo, hi, 0, 1, 2, 3, 4, 5, 6, 7); } };
__device__ __forceinline__ f32x4 mma_frag(const Frag<false>& w, const Frag<false>& x, f32x4 c) {
    c = __builtin_amdgcn_mfma_f32_16x16x32_bf16(w.v[0], x.v[0], c, 0, 0, 0); return __builtin_amdgcn_mfma_f32_16x16x32_bf16(w.v[1], x.v[1], c, 0, 0, 0); }
__device__ __forceinline__ f32x4 mma_frag(const Frag<true>& w, const Frag<true>& x, f32x4 c) {
    const int sa = 0x7A7A7A7A, sb = 0x7F7F7F7F;
    asm volatile("v_mfma_scale_f32_16x16x128_f8f6f4 %0, %1, %2, %0, %3, %4 op_sel_hi:[0,0,0]" : "+v"(c) : "v"(w.v), "v"(x.v), "v"(sa), "v"(sb));
    return c; }
template <class Epi, class Sched, bool ALIGN_EPI = false, bool SP2 = false, bool FP8 = false>
__device__ __forceinline__ void gemm_phase(PG8_LAS unsigned char* lds, const Gemm g, const Sched& S, const Epi& E) {
    const int tid = threadIdx.x, wid = __builtin_amdgcn_readfirstlane(tid >> 6), lane = tid & 63, wr = wid >> 2, wc = wid & 3, fr = lane & 15, fq = lane >> 4;
    const int K = g.K, nt = K / BK;
    unsigned voffA[2], voffB[2];
#pragma unroll
    for (int i = 0; i < 2; ++i) { int R, C; stage_rc(tid * 16 + i * 8192, R, C); const int Rb = Epi::PERM ? ((R & ~31) + perm32(R & 31)) : R;
        voffA[i] = (unsigned)(R * K + C) * 2u; voffB[i] = (unsigned)(Rb * K + C) * 2u; }
    const size_t kstep = (size_t)(BK * 2);
    const size_t hstep = (size_t)HALF * K * 2;
    const size_t rowb = (size_t)K * 2;
    const unsigned ldsw = (unsigned)wid * 1024u;
    const int aoff = lds_byte(wr * 64 + fr, fq * 8), boff = lds_byte(wc * 32 + fr, fq * 8);
#define PG8_SA(b, h) (((b) * 2 + (h)) * HTB)
#define PG8_SB(b, h) ((4 + (b) * 2 + (h)) * HTB)
#define PG8_STAGE(bufoff, gbase, voff) do { _Pragma("unroll") for (int _i = 0; _i < 2; ++_i) \
        __builtin_amdgcn_global_load_lds((const unsigned*)((const char*)(gbase) + (voff)[_i]), (PG8_LAS unsigned*)(lds + (bufoff) + ldsw + _i * 8192), 16, 0, 0); } while (0)
#define PG8_LDA(dst, b, h) do { _Pragma("unroll") for (int m = 0; m < 4; ++m) dst[m].ld(lds + PG8_SA(b, h) + aoff + m * 2048); } while (0)
#define PG8_LDB(dst, b, h) do { _Pragma("unroll") for (int n = 0; n < 2; ++n) dst[n].ld(lds + PG8_SB(b, h) + boff + n * 2048); } while (0)
#define PG8_MMA(ai, bj, At, Bt) do { __builtin_amdgcn_s_setprio(1); _Pragma("unroll") for (int m = 0; m < 4; ++m) _Pragma("unroll") for (int n = 0; n < 2; ++n) \
        acc[ai][bj][m][n] = mma_frag(Bt[n], At[m], acc[ai][bj][m][n]); __builtin_amdgcn_s_setprio(0); } while (0)
#define PG8_WAIT_V(n) asm volatile("s_waitcnt vmcnt(" #n ")" ::: "memory")
#define PG8_WAIT_L(n) asm volatile("s_waitcnt lgkmcnt(" #n ")" ::: "memory")
#define PG8_BAR __builtin_amdgcn_s_barrier()
#define PG8_SCHED __builtin_amdgcn_sched_barrier(0)
    Unit cur, nxt; int ui = 0;
    if (!S.next(0, cur)) return;
    f32x4 acc[2][2][4][2];
#pragma unroll
    for (int a = 0; a < 2; ++a)
#pragma unroll
        for (int b = 0; b < 2; ++b)
#pragma unroll
            for (int m = 0; m < 4; ++m)
#pragma unroll
                for (int n = 0; n < 2; ++n) acc[a][b][m][n] = (f32x4){0.f, 0.f, 0.f, 0.f};
    Frag<FP8> At[4], B0[2], B1[2];
    const char* cA = (const char*)g.A + (size_t)cur.arow * rowb; const char* cB = (const char*)g.Bt + (size_t)cur.brow * rowb;
    S.a_ready(cur);
    PG8_LAS unsigned char* const blds = lds + 131072 + 4096;
    E.prefetch(cur, blds, wid, lane);
    if constexpr (SP2) {
        PG8_STAGE(PG8_SB(0, 0), cB, voffB); PG8_STAGE(PG8_SB(0, 1), cB + hstep, voffB); PG8_STAGE(PG8_SA(0, 0), cA, voffA); PG8_STAGE(PG8_SA(0, 1), cA + hstep, voffA);
        if (wr == 1) PG8_BAR;
        PG8_WAIT_V(2); PG8_BAR;
        PG8_STAGE(PG8_SB(1, 0), cB + kstep, voffB); PG8_STAGE(PG8_SA(1, 0), cA + kstep, voffA); PG8_STAGE(PG8_SB(1, 1), cB + hstep + kstep, voffB);
        PG8_WAIT_V(6); PG8_BAR;
    } else {
        PG8_STAGE(PG8_SB(0, 0), cB, voffB); PG8_STAGE(PG8_SA(0, 0), cA, voffA); PG8_STAGE(PG8_SB(0, 1), cB + hstep, voffB); PG8_STAGE(PG8_SA(0, 1), cA + hstep, voffA);
        if (wr == 1) PG8_BAR;
        PG8_WAIT_V(4); PG8_BAR;
        PG8_STAGE(PG8_SB(1, 0), cB + kstep, voffB); PG8_STAGE(PG8_SA(1, 0), cA + kstep, voffA); PG8_STAGE(PG8_SB(1, 1), cB + hstep + kstep, voffB);
        PG8_WAIT_V(6); PG8_BAR;
    }
    for (;;) {
        const bool has_next = S.next(ui + 1, nxt);
        const char* nA = has_next ? (const char*)g.A + (size_t)nxt.arow * rowb : cA; const char* nB = has_next ? (const char*)g.Bt + (size_t)nxt.brow * rowb : cB;
        for (int t = 0; t < nt; t += 2) {
            const bool last = (t == nt - 2);
            const char* a1 = cA + (size_t)(t + 1) * kstep;
            const char* a2 = last ? nA : cA + (size_t)(t + 2) * kstep; const char* b2 = last ? nB : cB + (size_t)(t + 2) * kstep;
            const char* a3 = a2 + kstep; const char* b3 = b2 + kstep;
            if (last && has_next) { S.a_ready(nxt); E.prefetch(nxt, blds + (((ui + 1) & 1) << 10), wid, lane); }
            if constexpr (SP2) {
            PG8_LDB(B0, 0, 0); PG8_LDB(B1, 0, 1); PG8_SCHED; PG8_LDA(At, 0, 0); PG8_STAGE(PG8_SA(1, 1), a1 + hstep, voffA);
            PG8_WAIT_V(8); PG8_WAIT_L(0); PG8_BAR; PG8_MMA(0, 0, At, B0); PG8_MMA(0, 1, At, B1); PG8_BAR; PG8_SCHED;
            PG8_LDA(At, 0, 1); PG8_STAGE(PG8_SB(0, 0), b2, voffB); PG8_STAGE(PG8_SB(0, 1), b2 + hstep, voffB); PG8_STAGE(PG8_SA(0, 0), a2, voffA);
            PG8_WAIT_V(8); PG8_WAIT_L(0); PG8_BAR; PG8_MMA(1, 0, At, B0); PG8_MMA(1, 1, At, B1); PG8_BAR; PG8_SCHED;
            PG8_LDB(B0, 1, 0); PG8_LDB(B1, 1, 1); PG8_SCHED; PG8_LDA(At, 1, 0); PG8_STAGE(PG8_SA(0, 1), a2 + hstep, voffA);
            PG8_WAIT_V(8); PG8_WAIT_L(0); PG8_BAR; PG8_MMA(0, 0, At, B0); PG8_MMA(0, 1, At, B1); PG8_BAR; PG8_SCHED;
            PG8_LDA(At, 1, 1); PG8_STAGE(PG8_SB(1, 0), b3, voffB); PG8_STAGE(PG8_SB(1, 1), b3 + hstep, voffB); PG8_STAGE(PG8_SA(1, 0), a3, voffA);
            PG8_WAIT_V(8); PG8_WAIT_L(0); PG8_BAR; PG8_MMA(1, 0, At, B0); PG8_MMA(1, 1, At, B1); PG8_BAR; PG8_SCHED;
            } else {
            PG8_LDB(B0, 0, 0); PG8_SCHED; PG8_LDA(At, 0, 0); PG8_STAGE(PG8_SA(1, 1), a1 + hstep, voffA);
            PG8_WAIT_L(8); PG8_BAR; PG8_WAIT_L(0); PG8_MMA(0, 0, At, B0); PG8_BAR; PG8_SCHED;
            PG8_LDB(B1, 0, 1); PG8_STAGE(PG8_SB(0, 0), b2, voffB);
            PG8_BAR; PG8_WAIT_L(0); PG8_MMA(0, 1, At, B1); PG8_BAR;
            PG8_LDA(At, 0, 1); PG8_STAGE(PG8_SA(0, 0), a2, voffA);
            PG8_BAR; PG8_WAIT_L(0); PG8_MMA(1, 0, At, B0); PG8_BAR; PG8_SCHED;
            PG8_STAGE(PG8_SB(0, 1), b2 + hstep, voffB);
            PG8_WAIT_V(6); PG8_BAR; PG8_MMA(1, 1, At, B1); PG8_BAR;
            PG8_LDB(B0, 1, 0); PG8_SCHED; PG8_LDA(At, 1, 0); PG8_STAGE(PG8_SA(0, 1), a2 + hstep, voffA);
            PG8_WAIT_L(8); PG8_BAR; PG8_WAIT_L(0); PG8_MMA(0, 0, At, B0); PG8_BAR; PG8_SCHED;
            PG8_LDB(B1, 1, 1); PG8_STAGE(PG8_SB(1, 0), b3, voffB);
            PG8_BAR; PG8_WAIT_L(0); PG8_MMA(0, 1, At, B1); PG8_BAR;
            PG8_LDA(At, 1, 1); PG8_STAGE(PG8_SA(1, 0), a3, voffA);
            PG8_BAR; PG8_WAIT_L(0); PG8_MMA(1, 0, At, B0); PG8_BAR; PG8_SCHED;
            PG8_STAGE(PG8_SB(1, 1), b3 + hstep, voffB);
            PG8_WAIT_V(6); PG8_BAR; PG8_MMA(1, 1, At, B1); PG8_BAR;
            }
        }
        if constexpr (ALIGN_EPI) { if (wr == 0) PG8_BAR; }
        if constexpr (FP8) {
#define PG8_ACC8(a, b) "+v"(acc[a][b][0][0]), "+v"(acc[a][b][0][1]), "+v"(acc[a][b][1][0]), "+v"(acc[a][b][1][1]), "+v"(acc[a][b][2][0]), "+v"(acc[a][b][2][1]), "+v"(acc[a][b][3][0]), "+v"(acc[a][b][3][1])
            asm volatile("s_nop 15\n\ts_nop 15" : PG8_ACC8(0, 0), PG8_ACC8(0, 1) :: "memory");
            asm volatile("" : PG8_ACC8(1, 0), PG8_ACC8(1, 1) :: "memory");
#undef PG8_ACC8
        }
#ifdef MK_EPI2
        if constexpr (Epi::TAG == MK_EPI2) { E(acc, cur, wr, wc, fr, fq, blds + ((ui & 1) << 10)); asm volatile("" ::: "memory"); }
#endif
        if constexpr (!Epi::AFTER_DRAIN) { E(acc, cur, wr, wc, fr, fq, blds + ((ui & 1) << 10)); S.done(cur); }
        if (!has_next) break;
#pragma unroll
        for (int a = 0; a < 2; ++a)
#pragma unroll
            for (int b = 0; b < 2; ++b)
#pragma unroll
                for (int m = 0; m < 4; ++m)
#pragma unroll
                    for (int n = 0; n < 2; ++n) acc[a][b][m][n] = (f32x4){0.f, 0.f, 0.f, 0.f};
        cur = nxt; cA = nA; cB = nB; ++ui;
        if constexpr (ALIGN_EPI) { if (wr == 1) PG8_BAR; }
    }
    PG8_WAIT_V(0);
    if constexpr (!ALIGN_EPI) { if (wr == 0) PG8_BAR; }
    PG8_BAR;
    if constexpr (Epi::AFTER_DRAIN) { E.fused(acc, cur, wr, wc, fr, fq, lds, wid, lane); S.done(cur); }
#undef PG8_SA
#undef PG8_SB
#undef PG8_STAGE
#undef PG8_LDA
#undef PG8_LDB
#undef PG8_MMA
#undef PG8_WAIT_V
#undef PG8_WAIT_L
#undef PG8_BAR
#undef PG8_SCHED
}

}

#define XB_TMO      128
#define XB_XCNT(j)  (256  + 64 * (j))
#define XB_XSUB(j)  (1280 + 64 * (j))
#define XB_XGEN(j)  (2304 + 64 * (j))
#define XB_TOP      3328
#define XB_TOPGEN   3392
#define XCD_BAR_WORDS 3456
#define XB_SPIN_CAP (1u << 18)
__device__ __forceinline__ unsigned xb_ld(unsigned* p)              { return __hip_atomic_load(p, __ATOMIC_RELAXED, __HIP_MEMORY_SCOPE_AGENT); }
__device__ __forceinline__ unsigned xb_add(unsigned* p, unsigned v) { return __hip_atomic_fetch_add(p, v, __ATOMIC_RELAXED, __HIP_MEMORY_SCOPE_AGENT); }
__device__ __forceinline__ unsigned xb_xcc_id() { return (unsigned)__builtin_amdgcn_s_getreg((3 << 11) | 20) & 0xFu; }
#define XB_SPIN(cond, bar) do { unsigned _sp = 0; while (cond) { __builtin_amdgcn_s_sleep(1); \
    if ((++_sp & 255u) == 0u) { if (xb_ld(&(bar)[XB_TMO])) break; if (_sp > XB_SPIN_CAP) { atomicAdd(&(bar)[XB_TMO], 1u); break; } } } } while (0)
struct XcdBarrier { unsigned* bar; unsigned x; volatile LAS unsigned* st; };
__device__ __forceinline__ XcdBarrier xcd_barrier_post(unsigned* bar, volatile LAS unsigned* st) {
    XcdBarrier b; b.bar = bar; b.x = xb_xcc_id(); b.st = st;
    if (threadIdx.x == 0) (void)xb_add(&bar[XB_XCNT(b.x)], 1u);
    return b;
}
__device__ __forceinline__ void xcd_barrier_complete(unsigned* bar, unsigned x, unsigned& nloc, unsigned& nx) {
    const unsigned G = gridDim.x * gridDim.y * gridDim.z;
    unsigned sum, cnt, mine, sp = 0u;
    for (;;) {
        sum = 0u; cnt = 0u; mine = 0u;
#pragma unroll
        for (unsigned j = 0; j < 16; ++j) { const unsigned c = xb_ld(&bar[XB_XCNT(j)]); sum += c; cnt += (c > 0u) ? 1u : 0u; mine = (j == x) ? c : mine; }
        if (sum == G) break;
        __builtin_amdgcn_s_sleep(1);
        if ((++sp & 255u) == 0u) { if (xb_ld(&bar[XB_TMO])) break; if (sp > XB_SPIN_CAP) { atomicAdd(&bar[XB_TMO], 1u); break; } }
    }
    nloc = mine > 0u ? mine : 1u; nx = cnt > 0u ? cnt : 1u;
}
__device__ __forceinline__ void xcd_barrier(const XcdBarrier& b) {
    asm volatile("s_waitcnt vmcnt(0)" ::: "memory");
    __syncthreads();
    if (threadIdx.x == 0) {
        unsigned* bar = b.bar;
        __builtin_amdgcn_s_waitcnt(0);
        unsigned nloc = b.st[0], nx = b.st[1];
        if (nloc == 0u) { xcd_barrier_complete(bar, b.x, nloc, nx); b.st[0] = nloc; b.st[1] = nx; }
        const unsigned old = xb_add(&bar[XB_XSUB(b.x)], 1u);
        const unsigned gen = old / nloc;
        if (old + 1u == (gen + 1u) * nloc) {
            __builtin_amdgcn_fence(__ATOMIC_RELEASE, "agent");
            asm volatile("s_waitcnt vmcnt(0)" ::: "memory");
            const unsigned og = xb_add(&bar[XB_TOP], 1u);
            const unsigned tg = og / nx;
            if (og + 1u == (tg + 1u) * nx) xb_add(&bar[XB_TOPGEN], 1u);
            else XB_SPIN(xb_ld(&bar[XB_TOPGEN]) == tg, bar);
            __builtin_amdgcn_fence(__ATOMIC_ACQUIRE, "agent");
            xb_add(&bar[XB_XGEN(b.x)], 1u);
            asm volatile("s_waitcnt vmcnt(0)" ::: "memory");
        } else {
            XB_SPIN(xb_ld(&bar[XB_XGEN(b.x)]) == gen, bar);
            __builtin_amdgcn_fence(__ATOMIC_ACQUIRE, "agent");
            asm volatile("s_waitcnt vmcnt(0)" ::: "memory");
        }
    }
    __syncthreads();
}

constexpr int NWAVES = 8;
constexpr int RING_OFF = 0, RING_BYTES = 131072;
constexpr int LDSCTL_OFF = RING_BYTES, MISC_OFF = LDSCTL_OFF + 320;
constexpr int TBL_OFF = LDSCTL_OFF + 1024;
constexpr int LDS_BYTES = 147456;

struct Frame {
    LAS unsigned char* lds; volatile LAS unsigned* MISC; LAS int* tbl; gu32* ctl;
    int tid, lane, wave, vcu, G;
};

__device__ __forceinline__ void p0_transpose_item(const float* W, int K, int N, bf16* WT, int k0, int n0, int orow0, LAS float* scr, int lane) {
#pragma unroll 8
    for (int i = 0; i < 32; ++i) { const int kk = 2 * i + (lane >> 5); scr[kk * 33 + (lane & 31)] = W[(size_t)(k0 + kk) * N + n0 + (lane & 31)]; }
    LDS_WAIT(); asm volatile("" ::: "memory");
    const int c = lane & 7;
#pragma unroll
    for (int j = 0; j < 4; ++j) { const int n = (lane >> 3) + 8 * j; const LAS float* s = scr + (8 * c) * 33 + n;
        u32x4 o; o.x = pk2(s[0 * 33], s[1 * 33]); o.y = pk2(s[2 * 33], s[3 * 33]); o.z = pk2(s[4 * 33], s[5 * 33]); o.w = pk2(s[6 * 33], s[7 * 33]);
        *(GAS u32x4*)(WT + (size_t)(orow0 + n) * K + k0 + 8 * c) = o; }
    LDS_WAIT(); asm volatile("" ::: "memory");
}
__device__ __forceinline__ void p0_transpose_item_fp8(const float* W, int K, int N, unsigned char* WT, int k0, int n0, int orow0, LAS float* scr, int lane) {
#pragma unroll 8
    for (int i = 0; i < 32; ++i) { const int kk = 2 * i + (lane >> 5); scr[kk * 33 + (lane & 31)] = W[(size_t)(k0 + kk) * N + n0 + (lane & 31)]; }
    LDS_WAIT(); asm volatile("" ::: "memory");
    const int c = lane & 7;
#pragma unroll
    for (int j = 0; j < 4; ++j) { const int n = (lane >> 3) + 8 * j; const LAS float* sp = scr + (8 * c) * 33 + n;
        u32x2 o; o.x = pk4_fp8(sp[0 * 33] * 32.f, sp[1 * 33] * 32.f, sp[2 * 33] * 32.f, sp[3 * 33] * 32.f); o.y = pk4_fp8(sp[4 * 33] * 32.f, sp[5 * 33] * 32.f, sp[6 * 33] * 32.f, sp[7 * 33] * 32.f);
        *(GAS u32x2*)(WT + (size_t)(orow0 + n) * K + k0 + 8 * c) = o; }
    LDS_WAIT(); asm volatile("" ::: "memory");
}
__device__ __forceinline__ void rms_row_to_bf16(const float* xrow, const float* g, bf16* orow, int lane) {
    const GAS f32x4* xr = (const GAS f32x4*)xrow + lane; f32x4 v[4]; float s = 0.f;
#pragma unroll
    for (int j = 0; j < 4; ++j) { v[j] = xr[64 * j]; s += (v[j].x * v[j].x + v[j].y * v[j].y) + (v[j].z * v[j].z + v[j].w * v[j].w); }
    const float rstd = 1.f / sqrtf(wave_sum(s) * (1.f / D) + EPS);
    GAS unsigned long long* o8 = (GAS unsigned long long*)orow + lane;
#pragma unroll
    for (int j = 0; j < 4; ++j) { const f32x4 gg = ((const GAS f32x4*)g)[lane + 64 * j];
        o8[64 * j] = (unsigned long long)pk2(v[j].x * rstd * gg.x, v[j].y * rstd * gg.y) | ((unsigned long long)pk2(v[j].z * rstd * gg.z, v[j].w * rstd * gg.w) << 32); }
}

__device__ __forceinline__ void rms_row_to_fp8(const float* xrow, const float* g, unsigned char* orow, int lane) {
    const GAS f32x4* xr = (const GAS f32x4*)xrow + lane; f32x4 v[4]; float s = 0.f;
#pragma unroll
    for (int j = 0; j < 4; ++j) { v[j] = xr[64 * j]; s += (v[j].x * v[j].x + v[j].y * v[j].y) + (v[j].z * v[j].z + v[j].w * v[j].w); }
    const float rstd = 1.f / sqrtf(wave_sum(s) * (1.f / D) + EPS);
    GAS unsigned* o4 = (GAS unsigned*)orow + lane;
#pragma unroll
    for (int j = 0; j < 4; ++j) { const f32x4 gg = ((const GAS f32x4*)g)[lane + 64 * j]; o4[64 * j] = pk4_fp8(v[j].x * rstd * gg.x, v[j].y * rstd * gg.y, v[j].z * rstd * gg.z, v[j].w * rstd * gg.w); }
}
constexpr float LOG2E = 1.4426950408889634f;
typedef __bf16 bf16x2_t __attribute__((ext_vector_type(2)));
__device__ __forceinline__ unsigned cvtpk_v(float lo, float hi) { const f32x2 v = {lo, hi}; const bf16x2_t b = __builtin_convertvector(v, bf16x2_t); return __builtin_bit_cast(unsigned, b); }
struct AttFrags { bf16x8 k0a, k0b, k1a, k1b, v[4]; };
__device__ __forceinline__ float gmax4(float m) {
    { auto rr = __builtin_amdgcn_permlane16_swap(__float_as_uint(m), __float_as_uint(m), false, false); m = fmaxf(__uint_as_float(rr[0]), __uint_as_float(rr[1])); }
    { auto rr = __builtin_amdgcn_permlane32_swap(__float_as_uint(m), __float_as_uint(m), false, false); m = fmaxf(__uint_as_float(rr[0]), __uint_as_float(rr[1])); }
    return m;
}
constexpr int RB_A = 160, RB_B = 320;
template <int NH, int RB>
__device__ __forceinline__ void band_group(f32x4 (&o)[NH][4], float (&mrun)[NH], float (&lrun)[NH], const bf16* qkvb, const int (&qcol)[NH], const int (&qmu0)[NH], int kcol, const bf16* vt,
                                           int dil, int rho, int L, int qstep, int P0, int npairs, const LAS float* const (&tab)[NH], int lane) {
    const int t = lane & 15, g = lane >> 4;
    bf16x8 qf[NH][2]; int mu_t[NH];
#pragma unroll
    for (int h = 0; h < NH; ++h) { mu_t[h] = qmu0[h] + qstep * t; const bf16* qrow = qkvb + (size_t)(mu_t[h] * dil + rho) * NQKV + 8 * g + qcol[h];
        qf[h][0] = *(const bf16x8*)qrow; qf[h][1] = *(const bf16x8*)(qrow + 32); }
    const int npr = L >> 5;
    const bf16* kbase = qkvb + (size_t)rho * NQKV + kcol + 8 * g;
    const bf16* vtl = vt + (size_t)t * 8192 + (size_t)rho * L + 8 * g;
    auto load = [&](int P, AttFrags& f) {
        const int Pc = min(max(P, 0), npr - 1);
        const bf16* k0p = kbase + (size_t)((32 * Pc + t) * dil) * NQKV; const bf16* k1p = k0p + (size_t)(16 * dil) * NQKV;
        f.k0a = *(const bf16x8*)k0p; f.k0b = *(const bf16x8*)(k0p + 32); f.k1a = *(const bf16x8*)k1p; f.k1b = *(const bf16x8*)(k1p + 32);
#pragma unroll
        for (int db = 0; db < 4; ++db) f.v[db] = *(const bf16x8*)(vtl + (size_t)(16 * db) * 8192 + 32 * Pc);
    };
    AttFrags cur; load(P0, cur);
    for (int pp = 0; pp < npairs; ++pp) {
        const int P = P0 + pp;
        AttFrags nxt; load(P0 + min(pp + 1, npairs - 1), nxt);
        if (P >= 0 && P < npr) {
            const int kap0 = 32 * P + 4 * g;
#pragma unroll
            for (int h = 0; h < NH; ++h) {
                const LAS float* tb_ = tab[h] + (kap0 - mu_t[h] + RB);
                f32x4 s0 = (f32x4){tb_[0], tb_[1], tb_[2], tb_[3]}, s1 = (f32x4){tb_[16], tb_[17], tb_[18], tb_[19]};
                s0 = __builtin_amdgcn_mfma_f32_16x16x32_bf16(cur.k0a, qf[h][0], s0, 0, 0, 0); s0 = __builtin_amdgcn_mfma_f32_16x16x32_bf16(cur.k0b, qf[h][1], s0, 0, 0, 0);
                s1 = __builtin_amdgcn_mfma_f32_16x16x32_bf16(cur.k1a, qf[h][0], s1, 0, 0, 0); s1 = __builtin_amdgcn_mfma_f32_16x16x32_bf16(cur.k1b, qf[h][1], s1, 0, 0, 0);
                float mx = fmaxf(fmaxf(fmaxf(s0[0], s0[1]), fmaxf(s0[2], s0[3])), fmaxf(fmaxf(s1[0], s1[1]), fmaxf(s1[2], s1[3])));
                mx = gmax4(mx);
                if (__any(mx > mrun[h])) { const float mn = fmaxf(mrun[h], mx), alpha = __builtin_amdgcn_exp2f(mrun[h] - mn); mrun[h] = mn; lrun[h] *= alpha;
#pragma unroll
                    for (int db = 0; db < 4; ++db) o[h][db] = o[h][db] * alpha; }
                const float mn = mrun[h]; float p[8], ps = 0.f;
#pragma unroll
                for (int j = 0; j < 8; ++j) { p[j] = __builtin_amdgcn_exp2f(((j < 4) ? s0[j & 3] : s1[j & 3]) - mn); ps += p[j]; }
                lrun[h] += ps;
                u32x4 pw; pw.x = cvtpk_v(p[0], p[1]); pw.y = cvtpk_v(p[2], p[3]); pw.z = cvtpk_v(p[4], p[5]); pw.w = cvtpk_v(p[6], p[7]);
                const bf16x8 pf = __builtin_bit_cast(bf16x8, pw);
#pragma unroll
                for (int db = 0; db < 4; ++db) o[h][db] = __builtin_amdgcn_mfma_f32_16x16x32_bf16(cur.v[db], pf, o[h][db], 0, 0, 0);
                if (NH > 2 && h + 1 < NH) __builtin_amdgcn_sched_barrier(0);
            }
        }
        cur = nxt;
    }
}
template <int NH>
__device__ __forceinline__ void band_store(const f32x4 (&o)[NH][4], const float (&lrun)[NH], bf16* const (&yrow)[NH], int lane) {
    const int g = lane >> 4;
#pragma unroll
    for (int h = 0; h < NH; ++h) { float l = lrun[h]; l += __shfl_xor(l, 16); l += __shfl_xor(l, 32); const float inv = 1.f / l;
#pragma unroll
        for (int db = 0; db < 4; ++db) { u32x2 w; w.x = pg8::cvt_pk_bf16(o[h][db][0] * inv, o[h][db][1] * inv); w.y = pg8::cvt_pk_bf16(o[h][db][2] * inv, o[h][db][3] * inv);
            *(u32x2*)(yrow[h] + 16 * db + 4 * g) = w; } }
}

struct Args { const float* in[19]; float* out; unsigned char* ws; int ph_lo, ph_hi, li, pad; };
constexpr int NPHASE = 10;

__global__ void __launch_bounds__(NWAVES * 64, 2) mk_fwd(Args args) {
    extern __shared__ __attribute__((aligned(16))) unsigned char lds[];
    Frame F;
    F.lds = (LAS unsigned char*)lds; F.MISC = (volatile LAS unsigned*)(F.lds + MISC_OFF); F.tbl = (LAS int*)(F.lds + TBL_OFF);
    F.tid = threadIdx.x; F.lane = F.tid & 63; F.wave = __builtin_amdgcn_readfirstlane(F.tid >> 6);
    F.G = gridDim.x; { const int bx = blockIdx.x; F.vcu = (F.G % 8 == 0) ? (bx % 8) * (F.G / 8) + bx / 8 : bx; }
    unsigned char* ws = args.ws; F.ctl = (gu32*)(ws + WS_CTL);
    const float* x = args.in[0]; const float* norm_mix = args.in[1]; const float* w_in = args.in[2]; const float* b_in = args.in[3];
    const float* sinks = args.in[4]; const float* rel_bias = args.in[5]; const float* w_a = args.in[6]; const float* w_b = args.in[7];
    const float* w_out = args.in[8]; const float* norm_ffn = args.in[9]; const float* router_w = args.in[10]; const float* router_b = args.in[11];
    const float* w_gate = args.in[12]; const float* b_gate = args.in[13]; const float* w_up = args.in[14]; const float* b_up = args.in[15];
    const float* w_down = args.in[16]; const float* b_down = args.in[17]; const float* norm_final = args.in[18];
    float* out = args.out;
    Tabs* tb = (Tabs*)(ws + WS_TAB);
    bf16* Win_t = (bf16*)(ws + WS_WIN); bf16* Wa_t = (bf16*)(ws + WS_WA); bf16* Wb_t = (bf16*)(ws + WS_WB); bf16* Wout_t = (bf16*)(ws + WS_WOUT);
    unsigned char* Wgu8 = ws + WS_WGU; unsigned char* Wd8 = ws + WS_WD; unsigned char* H28 = ws + WS_H2; unsigned char* HS8 = ws + WS_HS; unsigned char* ACT8 = ws + WS_ACT; unsigned char* YS = ws + WS_YS;
    int* topi = (int*)(ws + WS_RT); float* topp = (float*)(ws + WS_RT + 256 * 1024); int* slot = (int*)(ws + WS_RT + 512 * 1024); int* pos = (int*)(ws + WS_RT + 768 * 1024);
    bf16* XN = (bf16*)(ws + WS_XN); bf16* QKV = (bf16*)(ws + WS_QKV); bf16* GATES = (bf16*)(ws + WS_GATES); bf16* YA = (bf16*)(ws + WS_YA); bf16* YB = (bf16*)(ws + WS_YB);
    bf16* MERGED = (bf16*)(ws + WS_MERGED);
    gu32* cnt = F.ctl + CW_CNT;

    for (int u = F.tid; u < (LDS_BYTES - LDSCTL_OFF) / 4; u += NWAVES * 64) ((LAS unsigned*)(F.lds + LDSCTL_OFF))[u] = 0u;
    __syncthreads();
    XcdBarrier bar = xcd_barrier_post((unsigned*)(F.ctl + CW_BAR) + args.li * XCD_BAR_WORDS, F.MISC + 8);
    const int lo = args.ph_lo, hi = args.ph_hi;
#ifndef MK_SKIP
#define MK_SKIP 0
#endif
#define IN(k) (!((MK_SKIP >> (k)) & 1) && lo <= (k) && (k) < hi)
#ifndef MK_DUP
#define MK_DUP 0
#endif
#define REP(k) _Pragma("unroll") for (int rep_ = 0; rep_ < 1 + ((MK_DUP >> (k)) & 1); ++rep_)
#ifdef MK_TSTAMP
    unsigned long long ts_a = __builtin_amdgcn_s_memrealtime(), ts_b = ts_a;
#define SEAM(k) do { if (IN(k) && IN((k) + 1)) xcd_barrier(bar); if ((k) + 1 == MK_TSTAMP) ts_a = __builtin_amdgcn_s_memrealtime(); if ((k) == MK_TSTAMP) ts_b = __builtin_amdgcn_s_memrealtime(); } while (0)
#else
#define SEAM(k) do { if (IN(k) && IN((k) + 1)) xcd_barrier(bar); } while (0)
#endif
    const int gw = F.vcu * NWAVES + F.wave, NGW = F.G * NWAVES;

    LAS float* scr = (LAS float*)(F.lds + RING_OFF + F.wave * 16384);
    constexpr int I_IN = (D / 64) * (NPROJ / 32), I_A = (D / 64) * (D / 32), I_B = (256 / 64) * (D / 32), I_E = (D / 64) * (D / 32);
    constexpr int NITEMS = I_IN + 2 * I_A + I_B + 3 * NE * I_E;
    auto transpose_items = [&](int first, int last) {
    for (int it = first + gw; it < last; it += NGW) {
        int r = it;
        if (r < I_IN) { const int nb = NPROJ / 32; p0_transpose_item_fp8(w_in, D, NPROJ, (unsigned char*)Win_t, 64 * (r / nb), 32 * (r % nb), 32 * (r % nb), scr, F.lane); continue; } r -= I_IN;
        if (r < I_A) { const int nb = D / 32; p0_transpose_item(w_a, D, D, Wa_t, 64 * (r / nb), 32 * (r % nb), 32 * (r % nb), scr, F.lane); continue; } r -= I_A;
        if (r < I_A) { const int nb = D / 32; p0_transpose_item(w_out, D, D, Wout_t, 64 * (r / nb), 32 * (r % nb), 32 * (r % nb), scr, F.lane); continue; } r -= I_A;
        if (r < I_B) { const int nb = D / 32; p0_transpose_item(w_b, 256, D, Wb_t, 64 * (r / nb), 32 * (r % nb), 32 * (r % nb), scr, F.lane); continue; } r -= I_B;
        { const int e = r / (3 * I_E), q = r % (3 * I_E), which = q / I_E, ii = q % I_E, nb = D / 32, k0 = 64 * (ii / nb), n0 = 32 * (ii % nb);
          if (which == 0) p0_transpose_item_fp8(w_gate + (size_t)e * D * D, D, D, Wgu8, k0, n0, e * 2048 + (n0 >> 7) * 256 + (n0 & 127), scr, F.lane);
          else if (which == 1) p0_transpose_item_fp8(w_up + (size_t)e * D * D, D, D, Wgu8, k0, n0, e * 2048 + (n0 >> 7) * 256 + 128 + (n0 & 127), scr, F.lane);
          else p0_transpose_item_fp8(w_down + (size_t)e * D * D, D, D, Wd8, k0, n0, e * 1024 + n0, scr, F.lane); }
    }
    };
    if (IN(0)) REP(0) {
        { const int i = blockIdx.x * (NWAVES * 64) + F.tid;
          if (i < 16 * 257) { const int h = i / 257, r = i % 257; tb->biasA[h][r] = rel_bias[BKT_A[r] * 28 + h]; }
          if (i < 12 * 129) { const int g = i / (4 * 129), hs = (i / 129) % 4, r = i % 129; tb->biasB[g][hs][r] = rel_bias[BKT_B[g][r] * 28 + 16 + 4 * g + hs]; } }
        transpose_items(0, I_IN + 2 * I_A + I_B);
        for (int m = gw; m < T; m += NGW) rms_row_to_fp8(x + (size_t)m * D, norm_mix, (unsigned char*)XN + (size_t)m * D, F.lane);
    }
    SEAM(0);
    if (IN(1)) REP(1) {
        int k512 = D / 2; asm volatile("" : "+s"(k512));
        pg8::Gemm g{XN, Win_t, k512}; pg8::StaticOrder So; So.init(T, NPROJ, F.G, (int)blockIdx.x);
        pg8::EpiProj E{QKV, GATES, b_in, (bf16*)(ws + WS_VT), (bf16*)(ws + WS_VT) + (size_t)2 * 4 * 64 * 8192};
        pg8::gemm_phase<pg8::EpiProj, pg8::StaticOrder, true, true, true>(F.lds + RING_OFF, g, So, E);
    }
    SEAM(1);
    int nrep2 = 1 + ((MK_DUP >> 2) & 1); asm volatile("" : "+s"(nrep2));
    if (IN(2)) for (int rep_ = 0; rep_ < nrep2; ++rep_) {
        LAS float* lb = (LAS float*)(F.lds + RING_OFF);
        constexpr int TA = 2 * RB_A + 1, TB = 2 * RB_B + 1;
        for (int i = F.tid; i < 16 * TA; i += NWAVES * 64) { const int h = i / TA, rel = i % TA - RB_A; lb[i] = (rel >= -128 && rel <= 128) ? tb->biasA[h][rel + 128] * LOG2E : -3.0e38f; }
        for (int i = F.tid; i < 12 * TB; i += NWAVES * 64) { const int gh = i / TB, rel = i % TB - RB_B; lb[16 * TA + i] = (rel >= -64 && rel <= 64) ? tb->biasB[gh >> 2][gh & 3][rel + 64] * LOG2E : -3.0e38f; }
        __syncthreads();
        const bf16* VTA = (const bf16*)(ws + WS_VT); const bf16* VTB = VTA + (size_t)2 * 4 * 64 * 8192;
        for (int it = gw; it < 4096 + 2048; it += NGW) {
            const int t = F.lane & 15;
            if (it < 4096) {
                const int b = it >> 11, kvh = (it >> 9) & 3, qb = it & 511;
                f32x4 o[4][4]; float mr[4], lr[4];
#pragma unroll
                for (int h = 0; h < 4; ++h) { mr[h] = sinks[kvh * 4 + h] * LOG2E; lr[h] = (F.lane < 16) ? 1.f : 0.f;
#pragma unroll
                    for (int db = 0; db < 4; ++db) o[h][db] = (f32x4){0.f, 0.f, 0.f, 0.f}; }
                const int qcol[4] = {C_QA + (kvh * 4 + 0) * 64, C_QA + (kvh * 4 + 1) * 64, C_QA + (kvh * 4 + 2) * 64, C_QA + (kvh * 4 + 3) * 64};
                const int qmu[4] = {16 * qb, 16 * qb, 16 * qb, 16 * qb};
                const LAS float* const bias[4] = {lb + (kvh * 4 + 0) * TA, lb + (kvh * 4 + 1) * TA, lb + (kvh * 4 + 2) * TA, lb + (kvh * 4 + 3) * TA};
                band_group<4, RB_A>(o, mr, lr, QKV + (size_t)b * S * NQKV, qcol, qmu, C_KA + kvh * 64, VTA + (size_t)((b * 4 + kvh) * 64) * 8192, 1, 0, S, 1, (qb - 8) >> 1, 9, bias, F.lane);
                bf16* yr = YA + (size_t)(b * S + 16 * qb + t) * D + kvh * 256; bf16* const yrow[4] = {yr, yr + 64, yr + 128, yr + 192};
                band_store<4>(o, lr, yrow, F.lane);
            } else {
                const int j = it - 4096, r = j & 7, un = j >> 3, blk = un & 31, hs = (un >> 5) & 3, b = un >> 7, i0 = blk * 256;
                f32x4 o[2][4]; float mr[2], lr[2];
#pragma unroll
                for (int h = 0; h < 2; ++h) { mr[h] = -1.0e30f; lr[h] = 0.f;
#pragma unroll
                    for (int db = 0; db < 4; ++db) o[h][db] = (f32x4){0.f, 0.f, 0.f, 0.f}; }
                const bf16* qb_ = QKV + (size_t)b * S * NQKV;
                { const int qcol[2] = {C_QB + 0 * 256 + hs * 64, C_QB + 0 * 256 + hs * 64}; const int qmu[2] = {i0 + r, i0 + r + 8}; const LAS float* const bias[2] = {lb + 16 * TA + (0 * 4 + hs) * TB, lb + 16 * TA + (0 * 4 + hs) * TB};
                  band_group<2, RB_B>(o, mr, lr, qb_, qcol, qmu, C_KB + 0 * 256 + hs * 64, VTB + (size_t)(((0 * 2 + b) * 4 + hs) * 64) * 8192, 1, 0, S, 16, (i0 >> 5) - 2, 12, bias, F.lane); }
                { const int qcol[2] = {C_QB + 1 * 256 + hs * 64, C_QB + 1 * 256 + hs * 64}; const int qmu[2] = {(i0 + r) >> 2, (i0 + r + 8) >> 2}; const LAS float* const bias[2] = {lb + 16 * TA + (1 * 4 + hs) * TB, lb + 16 * TA + (1 * 4 + hs) * TB};
                  band_group<2, RB_B>(o, mr, lr, qb_, qcol, qmu, C_KB + 1 * 256 + hs * 64, VTB + (size_t)(((1 * 2 + b) * 4 + hs) * 64) * 8192, 4, r & 3, S / 4, 4, (i0 >> 7) - 2, 6, bias, F.lane); }
#pragma unroll
                for (int h = 0; h < 2; ++h) { const int qcol[1] = {C_QB + 2 * 256 + hs * 64}; const int qmu[1] = {i0 >> 4}; const LAS float* const bias[1] = {lb + 16 * TA + (2 * 4 + hs) * TB};
                  band_group<1, RB_B>(*(f32x4(*)[1][4])&o[h], *(float(*)[1])&mr[h], *(float(*)[1])&lr[h], qb_, qcol, qmu, C_KB + 2 * 256 + hs * 64, VTB + (size_t)(((2 * 2 + b) * 4 + hs) * 64) * 8192,
                                    16, r + 8 * h, S / 16, 1, (blk - 4) >> 1, 5, bias, F.lane); }
                bf16* yr = YB + (size_t)(b * S + i0 + r + 16 * t) * 256 + hs * 64; bf16* const yrow[2] = {yr, yr + 8 * 256};
                band_store<2>(o, lr, yrow, F.lane);
            }
        }
        __syncthreads();
    }
    SEAM(2);
    if (IN(3)) REP(3) {
#ifndef NO_P3A
        { int k256 = 256; asm volatile("" : "+s"(k256)); pg8::Gemm g{YB, Wb_t, k256}; pg8::StaticOrder So; So.init(T, D, F.G, (int)blockIdx.x);
          pg8::EpiGate<0> E{MERGED, GATES, 1024};
          pg8::gemm_phase<pg8::EpiGate<0>, pg8::StaticOrder, true, true>(F.lds + RING_OFF, g, So, E); }
#endif
        VM_WAIT(); __syncthreads();
#ifndef NO_P3B
        { pg8::Gemm g{YA, Wa_t, D}; pg8::StaticOrder So; So.init(T, D, F.G, (int)blockIdx.x);
          pg8::EpiGate<1> E{MERGED, GATES, 0};
          pg8::gemm_phase<pg8::EpiGate<1>, pg8::StaticOrder, true, true>(F.lds + RING_OFF, g, So, E); }
#endif
    }
    SEAM(3);
    if (IN(4)) REP(4) {
        pg8::Gemm g{MERGED, Wout_t, D}; pg8::StaticOrder So; So.init(T, D, F.G, (int)blockIdx.x);
        pg8::EpiX1 E{x, out};
        pg8::gemm_phase<pg8::EpiX1, pg8::StaticOrder, true, true>(F.lds + RING_OFF, g, So, E);
    }
    SEAM(4);
    if (IN(5)) REP(5) {
        const bool lastrep5 = (rep_ + 1 == 1 + ((MK_DUP >> 5) & 1));
        LAS int* lcnt = F.tbl + 72; LAS int* lbase = F.tbl + 104; LAS int* ebuf = F.tbl + 136; LAS int* pbuf = F.tbl + 392;
        LAS float* plog = (LAS float*)(F.lds + RING_OFF);
        LAS float* psq = plog + 8 * 64 * 32;
        LAS float* rstd_s = psq + 512;
        const int g = F.lane >> 4, e16 = F.lane & 15, w = F.wave;
        float wB[32][2];
#pragma unroll
        for (int sc = 0; sc < 32; ++sc) { const int k = 128 * w + 32 * (sc >> 3) + 8 * g + (sc & 7); const float gm = norm_ffn[k];
            wB[sc][0] = gm * router_w[(size_t)k * NE + e16]; wB[sc][1] = gm * router_w[(size_t)k * NE + 16 + e16]; }
        for (int tblk = F.vcu; tblk < T / 64; tblk += F.G) {
            if (F.tid < 32) lcnt[F.tid] = 0;
            f32x4 v[4][2];
            { const GAS float* xr = (const GAS float*)out + (size_t)(tblk * 64 + e16) * D + 128 * w + 8 * g;
#pragma unroll
              for (int s4 = 0; s4 < 4; ++s4) { v[s4][0] = *(const GAS f32x4*)(xr + 32 * s4); v[s4][1] = *(const GAS f32x4*)(xr + 32 * s4 + 4); } }
#pragma unroll 1
            for (int tile = 0; tile < 4; ++tile) {
                f32x4 vn[4][2];
                { const int tn = tile < 3 ? tile + 1 : 3; const GAS float* xr = (const GAS float*)out + (size_t)(tblk * 64 + tn * 16 + e16) * D + 128 * w + 8 * g;
#pragma unroll
                  for (int s4 = 0; s4 < 4; ++s4) { vn[s4][0] = *(const GAS f32x4*)(xr + 32 * s4); vn[s4][1] = *(const GAS f32x4*)(xr + 32 * s4 + 4); } }
                float sq = 0.f;
#pragma unroll
                for (int s4 = 0; s4 < 4; ++s4) sq += (v[s4][0].x * v[s4][0].x + v[s4][0].y * v[s4][0].y) + (v[s4][0].z * v[s4][0].z + v[s4][0].w * v[s4][0].w)
                                                   + (v[s4][1].x * v[s4][1].x + v[s4][1].y * v[s4][1].y) + (v[s4][1].z * v[s4][1].z + v[s4][1].w * v[s4][1].w);
                sq += __shfl_xor(sq, 16); sq += __shfl_xor(sq, 32);
                if (g == 0) psq[w * 64 + tile * 16 + e16] = sq;
                f32x4 a0 = (f32x4){0.f, 0.f, 0.f, 0.f}, a1 = (f32x4){0.f, 0.f, 0.f, 0.f};
#pragma unroll
                for (int s4 = 0; s4 < 4; ++s4)
#pragma unroll
                    for (int c = 0; c < 8; ++c) { const float av = v[s4][c >> 2][c & 3];
                        a0 = __builtin_amdgcn_mfma_f32_16x16x4f32(av, wB[s4 * 8 + c][0], a0, 0, 0, 0); a1 = __builtin_amdgcn_mfma_f32_16x16x4f32(av, wB[s4 * 8 + c][1], a1, 0, 0, 0); }
#pragma unroll
                for (int r = 0; r < 4; ++r) { LAS float* pr = plog + (size_t)(w * 64 + tile * 16 + 4 * g + r) * 32 + e16; pr[0] = a0[r]; pr[16] = a1[r]; }
#pragma unroll
                for (int s4 = 0; s4 < 4; ++s4) { v[s4][0] = vn[s4][0]; v[s4][1] = vn[s4][1]; }
            }
            __syncthreads();
            if (F.tid < 64) { float s = 0.f;
#pragma unroll
                for (int ww = 0; ww < 8; ++ww) s += psq[ww * 64 + F.tid];
                rstd_s[F.tid] = 1.f / sqrtf(s * (1.f / D) + EPS); }
            __syncthreads();
            { const int e = F.tid & 31; const float rbv = router_b[e];
#pragma unroll 1
              for (int i = 0; i < 4; ++i) { const int tl = (F.tid >> 5) + 16 * i; float lg = 0.f;
#pragma unroll
                for (int ww = 0; ww < 8; ++ww) lg += plog[(size_t)(ww * 64 + tl) * 32 + e];
                float val = lg * rstd_s[tl] + rbv; float tv[4]; int ti[4];
#pragma unroll
                for (int r = 0; r < 4; ++r) {
                    float bv = val; int bi = e;
#pragma unroll
                    for (int o = 1; o < 32; o <<= 1) { const float ov = __shfl_xor(bv, o); const int oi = __shfl_xor(bi, o); if (ov > bv || (ov == bv && oi < bi)) { bv = ov; bi = oi; } }
                    tv[r] = bv; ti[r] = bi; if (bi == e) val = -3.0e38f;
                }
                const float e1 = __expf(tv[1] - tv[0]), e2 = __expf(tv[2] - tv[0]), e3 = __expf(tv[3] - tv[0]); const float inv = 1.f / (1.f + e1 + e2 + e3);
                if (e < 4) { const float p = (e == 0 ? 1.f : e == 1 ? e1 : e == 2 ? e2 : e3) * inv; const int ex = (e == 0 ? ti[0] : e == 1 ? ti[1] : e == 2 ? ti[2] : ti[3]);
                    const int m = tblk * 64 + tl; topi[m * 4 + e] = ex; topp[m * 4 + e] = p;
                    const int li = tl * 4 + e; ebuf[li] = ex; pbuf[li] = __hip_atomic_fetch_add(&lcnt[ex], 1, __ATOMIC_RELAXED, __HIP_MEMORY_SCOPE_WORKGROUP); } } }
#pragma unroll 1
            for (int rb = 0; rb < 8; rb += 4) { f32x4 xv[4][4];
#pragma unroll
                for (int r = 0; r < 4; ++r) { const GAS f32x4* xr4 = (const GAS f32x4*)(out + ((size_t)tblk * 64 + w * 8 + rb + r) * D) + F.lane;
#pragma unroll
                    for (int j = 0; j < 4; ++j) xv[r][j] = xr4[64 * j]; }
#pragma unroll
                for (int r = 0; r < 4; ++r) { const int tl = w * 8 + rb + r; const float rstd = rstd_s[tl]; GAS unsigned* o4 = (GAS unsigned*)(H28 + ((size_t)tblk * 64 + tl) * D) + F.lane;
#pragma unroll
                    for (int j = 0; j < 4; ++j) { const f32x4 gg = ((const GAS f32x4*)norm_ffn)[F.lane + 64 * j];
                        o4[64 * j] = pk4_fp8(xv[r][j].x * rstd * gg.x, xv[r][j].y * rstd * gg.y, xv[r][j].z * rstd * gg.z, xv[r][j].w * rstd * gg.w); } } }
            __syncthreads();
            if (F.tid < 32) lbase[F.tid] = lastrep5 ? (int)__hip_atomic_fetch_add(cnt + F.tid, (unsigned)lcnt[F.tid], RLX_AGENT) : 0;
            __syncthreads();
            if (F.tid < 256) pos[tblk * 256 + F.tid] = lbase[ebuf[F.tid]] + pbuf[F.tid];
            __syncthreads();
        }
    }
    SEAM(5);
    if (IN(6) || IN(7) || IN(8)) {
        LAS int* loff = F.tbl; LAS int* ltoff = F.tbl + 36; LAS int* lc = F.tbl + 72;
        if (F.tid < 32) lc[F.tid] = (int)__hip_atomic_load(cnt + F.tid, RLX_AGENT);
        __syncthreads();
        if (F.tid == 0) { int a = 0, ta = 0; for (int e = 0; e < NE; ++e) { loff[e] = a; ltoff[e] = ta; const int c = lc[e]; a += c; ta += (c + 255) >> 8; } loff[NE] = a; ltoff[NE] = ta; }
        __syncthreads();
    }
    if (IN(6)) REP(6) {
        transpose_items(I_IN + 2 * I_A + I_B, NITEMS);
        const LAS int* loff = F.tbl;
        for (int p0 = gw; p0 < T * 4; p0 += 4 * NGW) {
            int row[4]; u32x4 dv[4];
#pragma unroll
            for (int q = 0; q < 4; ++q) { const int p = p0 + q * NGW; row[q] = (p < T * 4) ? loff[topi[p]] + pos[p] : -1; }
#pragma unroll
            for (int q = 0; q < 4; ++q) { const int p = p0 + q * NGW; if (row[q] >= 0) dv[q] = ((const GAS u32x4*)(H28 + (size_t)(p >> 2) * D))[F.lane]; }
#pragma unroll
            for (int q = 0; q < 4; ++q) { const int p = p0 + q * NGW; if (row[q] >= 0) { if (F.lane == 0) slot[p] = row[q]; ((GAS u32x4*)(HS8 + (size_t)row[q] * D))[F.lane] = dv[q]; } }
        }
    }
    SEAM(6);
    if (IN(7)) REP(7) {
        int k512 = D / 2; asm volatile("" : "+s"(k512));
        pg8::Gemm g{(const bf16*)HS8, (const bf16*)Wgu8, k512}; pg8::GroupOrder So{F.tbl + 36, F.tbl, 8, F.G, (int)blockIdx.x, 0}; So.nunits = __builtin_amdgcn_readfirstlane(F.tbl[36 + NE]) * 8;
        pg8::EpiSwiglu E{ACT8, b_gate, b_up};
        pg8::gemm_phase<pg8::EpiSwiglu, pg8::GroupOrder, true, FP8_SP2, true>(F.lds + RING_OFF, g, So, E);
    }
    SEAM(7);
    if (IN(8)) REP(8) {
        int k512 = D / 2; asm volatile("" : "+s"(k512));
        pg8::Gemm g{(const bf16*)ACT8, (const bf16*)Wd8, k512}; pg8::GroupOrder So{F.tbl + 36, F.tbl, 4, F.G, (int)blockIdx.x, 0}; So.nunits = __builtin_amdgcn_readfirstlane(F.tbl[36 + NE]) * 4;
        pg8::EpiDown E{YS, b_down};
        pg8::gemm_phase<pg8::EpiDown, pg8::GroupOrder, true, FP8_SP2, true>(F.lds + RING_OFF, g, So, E);
    }
    SEAM(8);
#ifdef MK_XBAR
    for (int xb_ = 0; xb_ < MK_XBAR; ++xb_) xcd_barrier(bar);
#endif
    if (IN(9)) REP(9) {
        const unsigned char* ys = YS;
        float* dst9 = (rep_ + 1 < 1 + ((MK_DUP >> 9) & 1)) ? (float*)(ws + WS_ACT) : out;
        for (int m0 = gw; m0 < T; m0 += 2 * NGW) {
            f32x4 v[2][4]; int sl[2][4]; float pr[2][4]; unsigned yv[2][4][4]; bool ok[2];
#pragma unroll
            for (int q = 0; q < 2; ++q) { const int m = m0 + q * NGW; ok[q] = m < T; const int mc = ok[q] ? m : m0; const GAS f32x4* xr = (const GAS f32x4*)(out + (size_t)mc * D) + F.lane;
#pragma unroll
                for (int j = 0; j < 4; ++j) v[q][j] = xr[64 * j];
#pragma unroll
                for (int k = 0; k < 4; ++k) { sl[q][k] = slot[mc * 4 + k]; pr[q][k] = topp[mc * 4 + k]; } }
#pragma unroll
            for (int q = 0; q < 2; ++q)
#pragma unroll
                for (int k = 0; k < 4; ++k) { const GAS unsigned* yr = (const GAS unsigned*)(ys + (size_t)sl[q][k] * D) + F.lane;
#pragma unroll
                    for (int j = 0; j < 4; ++j) yv[q][k][j] = yr[64 * j]; }
#pragma unroll
            for (int q = 0; q < 2; ++q) { if (!ok[q]) continue; const int m = m0 + q * NGW;
#pragma unroll
                for (int k = 0; k < 4; ++k) { const float p = pr[q][k];
#pragma unroll
                    for (int j = 0; j < 4; ++j) { const unsigned u = yv[q][k][j]; const f32x2 lo = __builtin_amdgcn_cvt_pk_f32_fp8(u, false), hi = __builtin_amdgcn_cvt_pk_f32_fp8(u, true);
                        v[q][j].x += p * lo.x; v[q][j].y += p * lo.y; v[q][j].z += p * hi.x; v[q][j].w += p * hi.y; } }
                float s = 0.f;
#pragma unroll
                for (int j = 0; j < 4; ++j) s += (v[q][j].x * v[q][j].x + v[q][j].y * v[q][j].y) + (v[q][j].z * v[q][j].z + v[q][j].w * v[q][j].w);
                const float rstd = 1.f / sqrtf(wave_sum(s) * (1.f / D) + EPS);
#pragma unroll
                for (int j = 0; j < 4; ++j) { const f32x4 gg = ((const GAS f32x4*)norm_final)[F.lane + 64 * j]; f32x4 y; y.x = v[q][j].x * rstd * gg.x; y.y = v[q][j].y * rstd * gg.y; y.z = v[q][j].z * rstd * gg.z; y.w = v[q][j].w * rstd * gg.w;
                    ((GAS f32x4*)(dst9 + (size_t)m * D) + F.lane)[64 * j] = y; } }
        }
    }
#ifdef MK_TSTAMP
    if (MK_TSTAMP == 9) ts_b = __builtin_amdgcn_s_memrealtime();
    if (blockIdx.x == 0) { const unsigned long long dt = ts_b - ts_a, t0_ = __builtin_amdgcn_s_memrealtime();
        while (__builtin_amdgcn_s_memrealtime() - t0_ < 2 * dt) __builtin_amdgcn_s_sleep(8); }
#endif
#undef IN
#undef SEAM
}

extern "C" void kernel_launch(void* const* d_in, const int* in_sizes, int n_in, void* d_out, int out_size, void* d_ws, size_t ws_size, hipStream_t stream) {
    static int grid = 0;
    if (grid == 0) {
        if (n_in != 19 || in_sizes[0] != T * D || out_size != T * D || ws_size < WS_END) { fprintf(stderr, "kernel_launch: unexpected shapes (n_in %d, ws %zu); nothing launched\n", n_in, ws_size); grid = -1; return; }
        int dev = 0, cus = 0, per_cu = 0;
        if (hipGetDevice(&dev) != hipSuccess || hipDeviceGetAttribute(&cus, hipDeviceAttributeMultiprocessorCount, dev) != hipSuccess) { grid = -1; return; }
        if (hipFuncSetAttribute((const void*)mk_fwd, hipFuncAttributeMaxDynamicSharedMemorySize, LDS_BYTES) != hipSuccess) { fprintf(stderr, "kernel_launch: hipFuncSetAttribute failed\n"); grid = -1; return; }
        if (hipOccupancyMaxActiveBlocksPerMultiprocessor(&per_cu, (const void*)mk_fwd, NWAVES * 64, LDS_BYTES) != hipSuccess || per_cu < 1) { fprintf(stderr, "kernel_launch: occupancy query says %d blocks per CU\n", per_cu); }
        (void)hipGetLastError();
        grid = cus;
        if (grid != 256) fprintf(stderr, "kernel_launch: %d CUs (built and tuned for 256)\n", grid);
    }
    if (grid < 0) return;
    if (hipMemsetAsync((char*)d_ws + WS_CTL, 0, CTL_ZERO_BYTES, stream) != hipSuccess) return;
    Args a{};
    for (int i = 0; i < 19; ++i) a.in[i] = (const float*)d_in[i];
    a.out = (float*)d_out; a.ws = (unsigned char*)d_ws;
#if MK_MODE == 2
    a.ph_lo = 0; a.ph_hi = NPHASE; a.li = 0;
    hipLaunchKernelGGL(mk_fwd, dim3(grid), dim3(NWAVES * 64), LDS_BYTES, stream, a);
#else
    for (int ph = 0; ph < NPHASE; ++ph) { a.ph_lo = ph; a.ph_hi = ph + 1; a.li = ph; hipLaunchKernelGGL(mk_fwd, dim3(grid), dim3(NWAVES * 64), LDS_BYTES, stream, a); }
#endif
}
```

```cpp
#define MK_DUP 0
#include <hip/hip_runtime.h>
#include <stdint.h>
#include <stdio.h>

#ifndef FP8_SP2
#define FP8_SP2 true
#endif
#ifndef MK_MODE
#define MK_MODE 2
#endif

typedef unsigned short bf16;
typedef short bf16x8 __attribute__((ext_vector_type(8)));
typedef float f32x4 __attribute__((ext_vector_type(4)));
typedef float f32x2 __attribute__((ext_vector_type(2)));
typedef unsigned u32x4 __attribute__((ext_vector_type(4)));
typedef unsigned u32x2 __attribute__((ext_vector_type(2)));
#define GAS __attribute__((address_space(1)))
#define LAS __attribute__((address_space(3)))
typedef GAS unsigned gu32;

constexpr int T = 16384, S = 8192, D = 1024, NPROJ = 5888, NQKV = 3840, NGATE = 2048, NE = 32, TOPK = 4;
constexpr int C_QA = 0, C_KA = 1024, C_VA = 1280, C_QB = 1536, C_KB = 2304, C_VB = 3072;
constexpr float EPS = 1e-5f;
constexpr size_t MiB = 1u << 20;
constexpr size_t WS_CTL = 0, CTL_ZERO_BYTES = 1 * MiB;
constexpr size_t WS_TAB = 1 * MiB;
constexpr size_t WS_WIN = 2 * MiB;
constexpr size_t WS_WA = 14 * MiB;
constexpr size_t WS_WB = 16 * MiB;
constexpr size_t WS_WOUT = 17 * MiB;
constexpr size_t WS_RT = 19 * MiB;
constexpr size_t WS_WGU = 24 * MiB;
constexpr size_t WS_WD = 88 * MiB;
constexpr size_t WS_H2 = 120 * MiB;
constexpr size_t WS_HS = 136 * MiB;
constexpr size_t WS_ACT = 201 * MiB;
constexpr size_t WS_YS = 272 * MiB;
constexpr size_t WS_XN = 216 * MiB;
constexpr size_t WS_QKV = 248 * MiB;
constexpr size_t WS_GATES = 368 * MiB;
constexpr size_t WS_YA = 432 * MiB;
constexpr size_t WS_YB = 464 * MiB;
constexpr size_t WS_MERGED = 472 * MiB;
constexpr size_t WS_VT = 472 * MiB;
constexpr size_t WS_END = 506 * MiB;
constexpr int CW_CNT = 0;
constexpr int CW_BAR = 4096;

__device__ const unsigned char BKT_A[257] = {12,12,12,12,12,12,12,12,12,12,12,12,12,12,12,12,12,12,12,12,12,12,12,12,12,12,12,12,12,12,12,12,12,12,12,12,12,12,11,11,11,11,11,11,11,11,11,11,11,11,11,11,11,11,11,11,11,11,11,11,11,11,11,11,11,11,11,11,11,11,11,11,11,11,11,11,11,11,11,10,10,10,10,10,10,10,10,10,10,10,10,10,10,10,10,10,10,10,10,10,10,10,9,9,9,9,9,9,9,9,9,9,9,9,8,8,8,8,8,8,8,7,6,5,4,3,2,1,0,17,18,19,20,21,22,23,24,24,24,24,24,24,24,25,25,25,25,25,25,25,25,25,25,25,25,26,26,26,26,26,26,26,26,26,26,26,26,26,26,26,26,26,26,26,26,26,26,26,27,27,27,27,27,27,27,27,27,27,27,27,27,27,27,27,27,27,27,27,27,27,27,27,27,27,27,27,27,27,27,27,27,27,27,27,27,27,27,27,27,28,28,28,28,28,28,28,28,28,28,28,28,28,28,28,28,28,28,28,28,28,28,28,28,28,28,28,28,28,28,28,28,28,28,28,28,28,28};
__device__ const unsigned char BKT_B[3][129] = {
 {11,11,11,11,11,11,11,11,11,11,11,11,11,11,11,10,10,10,10,10,10,10,10,10,10,10,10,10,10,10,10,10,10,10,10,10,10,10,9,9,9,9,9,9,9,9,9,9,9,9,8,8,8,8,8,8,8,7,6,5,4,3,2,1,0,17,18,19,20,21,22,23,24,24,24,24,24,24,24,25,25,25,25,25,25,25,25,25,25,25,25,26,26,26,26,26,26,26,26,26,26,26,26,26,26,26,26,26,26,26,26,26,26,26,27,27,27,27,27,27,27,27,27,27,27,27,27,27,27},
 {13,13,13,13,13,13,13,13,13,13,13,13,13,13,13,13,13,13,13,13,13,13,13,12,12,12,12,12,12,12,12,12,12,12,12,12,12,12,12,12,12,12,11,11,11,11,11,11,11,11,11,11,10,10,10,10,10,10,9,9,9,8,8,4,0,20,24,24,25,25,25,26,26,26,26,26,26,27,27,27,27,27,27,27,27,27,27,28,28,28,28,28,28,28,28,28,28,28,28,28,28,28,28,28,28,28,29,29,29,29,29,29,29,29,29,29,29,29,29,29,29,29,29,29,29,29,29,29,29},
 {15,15,15,15,15,15,15,15,15,15,15,15,15,15,15,15,15,15,15,15,15,15,15,15,15,15,15,15,15,15,14,14,14,14,14,14,14,14,14,14,14,14,14,14,14,13,13,13,13,13,13,13,13,13,12,12,12,12,12,11,11,10,10,9,0,25,26,26,27,27,28,28,28,28,28,29,29,29,29,29,29,29,29,29,30,30,30,30,30,30,30,30,30,30,30,30,30,30,30,31,31,31,31,31,31,31,31,31,31,31,31,31,31,31,31,31,31,31,31,31,31,31,31,31,31,31,31,31,31}};

#define RLX_AGENT __ATOMIC_RELAXED, __HIP_MEMORY_SCOPE_AGENT
#define LDS_WAIT() asm volatile("s_waitcnt lgkmcnt(0)" ::: "memory")
#define VM_WAIT() asm volatile("s_waitcnt vmcnt(0)" ::: "memory")
__device__ __forceinline__ unsigned f2bf(float f) { unsigned u = __builtin_bit_cast(unsigned, f); return (u + 0x7fffu + ((u >> 16) & 1u)) >> 16; }
__device__ __forceinline__ unsigned pk2(float lo, float hi) { return f2bf(lo) | (f2bf(hi) << 16); }
__device__ __forceinline__ unsigned pk4_fp8(float a, float b, float c, float d) { unsigned w = 0; w = __builtin_amdgcn_cvt_pk_fp8_f32(a, b, w, false); w = __builtin_amdgcn_cvt_pk_fp8_f32(c, d, w, true); return w; }
__device__ __forceinline__ float bf2f(unsigned b) { return __builtin_bit_cast(float, b << 16); }
__device__ __forceinline__ float bflo(unsigned u) { return __builtin_bit_cast(float, u << 16); }
__device__ __forceinline__ float bfhi(unsigned u) { return __builtin_bit_cast(float, u & 0xffff0000u); }
__device__ __forceinline__ float wave_sum(float v) {
#pragma unroll
    for (int o = 1; o < 64; o <<= 1) v += __shfl_xor(v, o);
    return v;
}
__device__ __forceinline__ float sigm(float x) { return __builtin_amdgcn_rcpf(1.f + __builtin_amdgcn_exp2f(-1.4426950408889634f * x)); }

struct Tabs { float biasA[16][257]; float biasB[3][4][129]; };

namespace pg8 {
#define PG8_LAS __attribute__((address_space(3)))
typedef unsigned short bf16_t;
constexpr int BM = 256, BK = 64, HALF = 128, HTB = HALF * BK * 2, STAGE_BYTES = 8 * HTB, NXCD = 8, WGM = 8;
__host__ __device__ __forceinline__ int lds_byte(int r, int c) { const int st = (r >> 4) * 2 + (c >> 5), rr = r & 15, cc = c & 31, ob = rr * 64 + cc * 2; return st * 1024 + (ob ^ (((ob >> 9) & 1) << 5)); }
__host__ __device__ __forceinline__ void stage_rc(int b, int& R, int& C) { const int st = b / 1024, sb = b % 1024, swz = sb ^ (((sb >> 9) & 1) << 5); R = (st >> 1) * 16 + swz / 64; C = (st & 1) * 32 + (swz % 64) / 2; }
__host__ __device__ __forceinline__ int perm32(int rho) { const int n = rho >> 4, i = rho & 15; return 8 * (i >> 2) + 4 * n + (i & 3); }

struct Unit { int arow, brow, nrows, e; };
struct Gemm { const bf16_t* A; const bf16_t* Bt; int K; };

struct StaticOrder {
    int nM, nN, nwg, G, c;
    __device__ void init(int M, int N, int G_, int c_) { nM = M / BM; nN = N / BM; nwg = nM * nN; G = G_; c = c_; }
    __device__ bool next(int i, Unit& u) const {
        const long L = (long)i * G + c; if (L >= nwg) return false;
        int wgid = (int)L; { const int q = nwg / NXCD, r = nwg % NXCD, xcd = wgid % NXCD, off = wgid / NXCD; wgid = (xcd < r ? xcd * (q + 1) : r * (q + 1) + (xcd - r) * q) + off; }
        const int nig = WGM * nN, gid = wgid / nig, fm = gid * WGM, gsz = (nM - fm) < WGM ? (nM - fm) : WGM;
        u.arow = BM * (fm + ((wgid % nig) % gsz)); u.brow = BM * ((wgid % nig) / gsz); u.nrows = BM; u.e = 0; return true;
    }
    __device__ __forceinline__ void a_ready(const Unit&) const {}
    __device__ __forceinline__ void done(const Unit&) const {}
};
struct GroupOrder {
    const PG8_LAS int* toff; const PG8_LAS int* off; int NT, G, c, nunits;
    __device__ bool next(int i, Unit& u) const {
        const int L = i * G + c; if (L >= nunits) return false;
        const int mtg = L / NT, pn = L - mtg * NT;
        int e = 0;
        for (int j = 1; j < NE; ++j) e += (toff[j] <= mtg) ? 1 : 0;
        e = __builtin_amdgcn_readfirstlane(e);
        const int mt = mtg - __builtin_amdgcn_readfirstlane(toff[e]); const int o0 = __builtin_amdgcn_readfirstlane(off[e]), o1 = __builtin_amdgcn_readfirstlane(off[e + 1]);
        u.arow = o0 + BM * mt; const int rem = o1 - u.arow; u.nrows = rem < BM ? rem : BM; u.brow = (e * NT + pn) * BM; u.e = e; return true;
    }
    __device__ __forceinline__ void a_ready(const Unit&) const {}
    __device__ __forceinline__ void done(const Unit&) const {}
};

__device__ __forceinline__ unsigned cvt_pk_bf16(float lo, float hi) { unsigned r; asm volatile("v_cvt_pk_bf16_f32 %0, %1, %2" : "=v"(r) : "v"(lo), "v"(hi)); return r; }

struct EpiProj {
    static constexpr bool PERM = true, AFTER_DRAIN = false; static constexpr int TAG = 1;
    bf16_t* qkv; bf16_t* gates; const float* bias; bf16_t* vta; bf16_t* vtb;
    __device__ __forceinline__ void prefetch(const Unit& u, PG8_LAS unsigned char* slot, int wid, int lane) const {
        if (wid == 0) __builtin_amdgcn_global_load_lds((const unsigned*)(bias + u.brow + 4 * lane), (PG8_LAS unsigned*)slot, 16, 0, 0); }
    __device__ __forceinline__ void operator()(const f32x4 (&acc)[2][2][4][2], const Unit& u, int wr, int wc, int fr, int fq, const PG8_LAS unsigned char* slot) const {
        const int colt = u.brow; const bool isq = colt < NQKV; bf16_t* base = isq ? qkv : gates; const int ldc = isq ? NQKV : NGATE; const int cb = isq ? colt : colt - NQKV;
        const int row0 = u.arow + wr * 64 + fr, col0 = cb + wc * 32 + 8 * fq, bcol0 = colt + wc * 32 + 8 * fq;
        f32x4 bv[2][2];
#pragma unroll
        for (int bj = 0; bj < 2; ++bj)
#pragma unroll
            for (int n = 0; n < 2; ++n) bv[bj][n] = *(const PG8_LAS f32x4*)(slot + (wc * 32 + 8 * fq + bj * HALF + 4 * n) * 4);
        const bool isv = (colt == C_VA) || (colt >= C_VB && colt < NQKV);
        const float qs = (colt < C_KA || (colt >= C_QB && colt < C_KB)) ? 0.125f * 1.4426950408889634f : 1.f;
        if (!isv) {
#pragma unroll
        for (int ai = 0; ai < 2; ++ai)
#pragma unroll
            for (int m = 0; m < 4; ++m) { bf16_t* rowp = base + (size_t)(row0 + ai * HALF + m * 16) * ldc + col0;
#pragma unroll
                for (int bj = 0; bj < 2; ++bj) { const f32x4 v0 = (acc[ai][bj][m][0] + bv[bj][0]) * qs, v1 = (acc[ai][bj][m][1] + bv[bj][1]) * qs;
                    u32x4 w; w.x = cvt_pk_bf16(v0[0], v0[1]); w.y = cvt_pk_bf16(v0[2], v0[3]); w.z = cvt_pk_bf16(v1[0], v1[1]); w.w = cvt_pk_bf16(v1[2], v1[3]);
                    *(u32x4*)(rowp + bj * HALF) = w; } }
        } else {
            const int gsel = (colt == C_VA) ? -1 : ((colt - C_VB) >> 8); const int sh = (gsel <= 0) ? 0 : (gsel == 1 ? 2 : 4);
            bf16_t* vb = (gsel < 0) ? vta : vtb + (size_t)gsel * (2 * 256 * 8192); const int c0 = wc * 32 + 8 * fq;
#pragma unroll
            for (int ai = 0; ai < 2; ++ai)
#pragma unroll
                for (int m = 0; m < 4; ++m) { const int row = row0 + ai * HALF + m * 16, b = row >> 13, s = row & 8191; const int mu = s >> sh; const int pos = ((s & ((1 << sh) - 1)) << (13 - sh)) + (mu & ~31) + (((mu & 15) >> 2) << 3) + (((mu >> 4) & 1) << 2) + (mu & 3);
                    bf16_t* vp = vb + (size_t)(b * 256 + c0) * 8192 + pos;
#pragma unroll
                    for (int bj = 0; bj < 2; ++bj)
#pragma unroll
                        for (int n = 0; n < 2; ++n) { const f32x4 v = acc[ai][bj][m][n] + bv[bj][n]; const unsigned w0 = cvt_pk_bf16(v[0], v[1]), w1 = cvt_pk_bf16(v[2], v[3]);
                            bf16_t* q = vp + (size_t)(bj * HALF + 4 * n) * 8192;
                            q[0] = (bf16_t)(w0 & 0xffffu); q[8192] = (bf16_t)(w0 >> 16); q[2 * 8192] = (bf16_t)(w1 & 0xffffu); q[3 * 8192] = (bf16_t)(w1 >> 16); } }
        }
    }
};
template <int MODE> struct EpiGate {
    static constexpr bool PERM = true, AFTER_DRAIN = false; static constexpr int TAG = 3;
    bf16_t* out; const bf16_t* gates; int gcol0; unsigned char* out8;
    __device__ __forceinline__ void prefetch(const Unit&, PG8_LAS unsigned char*, int, int) const {}
    __device__ __forceinline__ void operator()(const f32x4 (&acc)[2][2][4][2], const Unit& u, int wr, int wc, int fr, int fq, const PG8_LAS unsigned char*) const {
        const int row0 = u.arow + wr * 64 + fr, col0 = u.brow + wc * 32 + 8 * fq;
        u32x4 gv[8][2];
#pragma unroll
        for (int gi = 0; gi < 4; ++gi) { const size_t r = (size_t)(row0 + (gi >> 2) * HALF + (gi & 3) * 16);
#pragma unroll
            for (int bj = 0; bj < 2; ++bj) gv[gi][bj] = *(const u32x4*)(gates + r * NGATE + gcol0 + col0 + bj * HALF); }
        u32x4 mv[2], mn[2];
        if (MODE == 1) {
#pragma unroll
            for (int bj = 0; bj < 2; ++bj) mv[bj] = *(const u32x4*)(out + (size_t)row0 * D + col0 + bj * HALF); }
#pragma unroll
        for (int gi = 0; gi < 8; ++gi) { const int ai = gi >> 2, m = gi & 3; const size_t r = (size_t)(row0 + ai * HALF + m * 16);
            if (gi == 1) {
#pragma unroll
                for (int g2 = 4; g2 < 8; ++g2) { const size_t r2 = (size_t)(row0 + (g2 >> 2) * HALF + (g2 & 3) * 16);
#pragma unroll
                    for (int bj = 0; bj < 2; ++bj) gv[g2][bj] = *(const u32x4*)(gates + r2 * NGATE + gcol0 + col0 + bj * HALF); } }
            if (MODE == 1 && gi + 1 < 8) { const size_t rn = (size_t)(row0 + ((gi + 1) >> 2) * HALF + ((gi + 1) & 3) * 16);
#pragma unroll
                for (int bj = 0; bj < 2; ++bj) mn[bj] = *(const u32x4*)(out + rn * D + col0 + bj * HALF); }
#pragma unroll
            for (int bj = 0; bj < 2; ++bj) { const int c = col0 + bj * HALF; const u32x4 g4 = gv[gi][bj]; const f32x4 a0 = acc[ai][bj][m][0], a1 = acc[ai][bj][m][1];
                float o[8]; o[0] = sigm(bflo(g4.x)) * a0[0]; o[1] = sigm(bfhi(g4.x)) * a0[1]; o[2] = sigm(bflo(g4.y)) * a0[2]; o[3] = sigm(bfhi(g4.y)) * a0[3];
                o[4] = sigm(bflo(g4.z)) * a1[0]; o[5] = sigm(bfhi(g4.z)) * a1[1]; o[6] = sigm(bflo(g4.w)) * a1[2]; o[7] = sigm(bfhi(g4.w)) * a1[3];
                if (MODE == 1) { const u32x4 m4 = mv[bj];
                    o[0] += bflo(m4.x); o[1] += bfhi(m4.x); o[2] += bflo(m4.y); o[3] += bfhi(m4.y); o[4] += bflo(m4.z); o[5] += bfhi(m4.z); o[6] += bflo(m4.w); o[7] += bfhi(m4.w); }
                if (MODE == 1) { u32x2 w8; w8.x = pk4_fp8(o[0], o[1], o[2], o[3]); w8.y = pk4_fp8(o[4], o[5], o[6], o[7]); *(u32x2*)(out8 + r * D + c) = w8; }
                else { u32x4 w; w.x = cvt_pk_bf16(o[0], o[1]); w.y = cvt_pk_bf16(o[2], o[3]); w.z = cvt_pk_bf16(o[4], o[5]); w.w = cvt_pk_bf16(o[6], o[7]);
                    *(u32x4*)(out + r * D + c) = w; } }
            asm volatile("" ::: "memory");
            if (MODE == 1) {
#pragma unroll
                for (int bj = 0; bj < 2; ++bj) mv[bj] = mn[bj]; } }
    }
};
struct EpiX1 {
    static constexpr bool PERM = true, AFTER_DRAIN = false; static constexpr int TAG = 4;
    const float* x; float* out;
    __device__ __forceinline__ void prefetch(const Unit&, PG8_LAS unsigned char*, int, int) const {}
    __device__ __forceinline__ void operator()(const f32x4 (&acc)[2][2][4][2], const Unit& u, int wr, int wc, int fr, int fq, const PG8_LAS unsigned char*) const {
        const int row0 = u.arow + wr * 64 + fr, col0 = u.brow + wc * 32 + 8 * fq;
        f32x4 xv[2][2], xn[2][2];
#pragma unroll
        for (int bj = 0; bj < 2; ++bj) { const size_t o = (size_t)row0 * D + col0 + bj * HALF; xv[bj][0] = *(const f32x4*)(x + o); xv[bj][1] = *(const f32x4*)(x + o + 4); }
#pragma unroll
        for (int gi = 0; gi < 8; ++gi) { const int ai = gi >> 2, m = gi & 3; const size_t r = (size_t)(row0 + ai * HALF + m * 16);
            if (gi + 1 < 8) { const size_t rn = (size_t)(row0 + ((gi + 1) >> 2) * HALF + ((gi + 1) & 3) * 16);
#pragma unroll
                for (int bj = 0; bj < 2; ++bj) { const size_t o = rn * D + col0 + bj * HALF; xn[bj][0] = *(const f32x4*)(x + o); xn[bj][1] = *(const f32x4*)(x + o + 4); } }
#pragma unroll
            for (int bj = 0; bj < 2; ++bj) { const size_t o = r * D + col0 + bj * HALF;
                *(f32x4*)(out + o) = xv[bj][0] + acc[ai][bj][m][0]; *(f32x4*)(out + o + 4) = xv[bj][1] + acc[ai][bj][m][1]; }
            asm volatile("" ::: "memory");
#pragma unroll
            for (int bj = 0; bj < 2; ++bj) { xv[bj][0] = xn[bj][0]; xv[bj][1] = xn[bj][1]; } }
    }
};
struct EpiSwiglu {
    static constexpr bool PERM = true, AFTER_DRAIN = false; static constexpr int TAG = 7;
    unsigned char* act; const float* bg; const float* bu;
    __device__ __forceinline__ void prefetch(const Unit& u, PG8_LAS unsigned char* slot, int wid, int lane) const {
        if (wid == 0) { const int pn = (u.brow >> 8) & 7; const float* src = ((lane < 32) ? bg : bu) + (size_t)u.e * D + pn * HALF + 4 * (lane & 31);
            __builtin_amdgcn_global_load_lds((const unsigned*)src, (PG8_LAS unsigned*)slot, 16, 0, 0); } }
    __device__ __forceinline__ void operator()(const f32x4 (&acc)[2][2][4][2], const Unit& u, int wr, int wc, int fr, int fq, const PG8_LAS unsigned char* slot) const {
        const int pn = (u.brow >> 8) & 7; const int col0 = pn * HALF + wc * 32 + 8 * fq; const int rl0 = wr * 64 + fr;
        const PG8_LAS f32x4* bl = (const PG8_LAS f32x4*)(slot + (wc * 32 + 8 * fq) * 4);
        const f32x4 g0 = bl[0], g1 = bl[1], u0 = bl[32], u1 = bl[33];
#pragma unroll
        for (int ai = 0; ai < 2; ++ai)
#pragma unroll
            for (int m = 0; m < 4; ++m) { const int rl = rl0 + ai * HALF + m * 16;
                const f32x4 ga = acc[ai][0][m][0] + g0, gb = acc[ai][0][m][1] + g1, ua = acc[ai][1][m][0] + u0, ub = acc[ai][1][m][1] + u1;
                float o[8];
#pragma unroll
                for (int j = 0; j < 4; ++j) { const float gt = fminf(ga[j], 7.f), up = fminf(fmaxf(ua[j], -7.f), 7.f); o[j] = gt * sigm(1.702f * gt) * (up + 1.f);
                    const float gt2 = fminf(gb[j], 7.f), up2 = fminf(fmaxf(ub[j], -7.f), 7.f); o[4 + j] = gt2 * sigm(1.702f * gt2) * (up2 + 1.f); }
                u32x2 w; w.x = pk4_fp8(o[0], o[1], o[2], o[3]); w.y = pk4_fp8(o[4], o[5], o[6], o[7]);
                if (rl < u.nrows) *(u32x2*)(act + (size_t)(u.arow + rl) * D + col0) = w; }
    }
};
struct EpiDown {
    static constexpr bool PERM = true, AFTER_DRAIN = false; static constexpr int TAG = 8;
    unsigned char* ys; const float* bd;
    __device__ __forceinline__ void prefetch(const Unit& u, PG8_LAS unsigned char* slot, int wid, int lane) const {
        if (wid == 0) { const int pn = (u.brow >> 8) & 3; __builtin_amdgcn_global_load_lds((const unsigned*)(bd + (size_t)u.e * D + pn * BM + 4 * lane), (PG8_LAS unsigned*)slot, 16, 0, 0); } }
    __device__ __forceinline__ void operator()(const f32x4 (&acc)[2][2][4][2], const Unit& u, int wr, int wc, int fr, int fq, const PG8_LAS unsigned char* slot) const {
        const int pn = (u.brow >> 8) & 3; const int col0 = pn * BM + wc * 32 + 8 * fq; const int rl0 = wr * 64 + fr;
        f32x4 bv[2][2];
#pragma unroll
        for (int bj = 0; bj < 2; ++bj)
#pragma unroll
            for (int n = 0; n < 2; ++n) bv[bj][n] = *(const PG8_LAS f32x4*)(slot + (wc * 32 + 8 * fq + bj * HALF + 4 * n) * 4);
#pragma unroll
        for (int ai = 0; ai < 2; ++ai)
#pragma unroll
            for (int m = 0; m < 4; ++m) { const int rl = rl0 + ai * HALF + m * 16; unsigned char* rowp = ys + (size_t)(u.arow + rl) * D + col0;
#pragma unroll
                for (int bj = 0; bj < 2; ++bj) { const f32x4 v0 = acc[ai][bj][m][0] + bv[bj][0], v1 = acc[ai][bj][m][1] + bv[bj][1];
                    u32x2 w; w.x = pk4_fp8(v0[0], v0[1], v0[2], v0[3]); w.y = pk4_fp8(v1[0], v1[1], v1[2], v1[3]);
                    if (rl < u.nrows) *(u32x2*)(rowp + bj * HALF) = w; } }
    }
};

typedef int i32x4_t __attribute__((ext_vector_type(4))); typedef int i32x8_t __attribute__((ext_vector_type(8)));
template <bool FP8> struct Frag;
template <> struct Frag<false> { bf16x8 v[2];
    __device__ __forceinline__ void ld(const PG8_LAS unsigned char* p) { v[0] = *(const PG8_LAS bf16x8*)p; v[1] = *(const PG8_LAS bf16x8*)(p + 1024); } };
template <> struct Frag<true> { i32x8_t v;
    __device__ __forceinline__ void ld(const PG8_LAS unsigned char* p) { const i32x4_t lo = *(const PG8_LAS i32x4_t*)p, hi = *(const PG8_LAS i32x4_t*)(p + 1024); v = __builtin_shufflevector(lo, hi, 0, 1, 2, 3, 4, 5, 6, 7); } };
__device__ __forceinline__ f32x4 mma_frag(const Frag<false>& w, const Frag<false>& x, f32x4 c) {
    c = __builtin_amdgcn_mfma_f32_16x16x32_bf16(w.v[0], x.v[0], c, 0, 0, 0); return __builtin_amdgcn_mfma_f32_16x16x32_bf16(w.v[1], x.v[1], c, 0, 0, 0); }
__device__ __forceinline__ f32x4 mma_frag(const Frag<true>& w, const Frag<true>& x, f32x4 c) {
    const int sa = 0x7A7A7A7A, sb = 0x7F7F7F7F;
    asm volatile("v_mfma_scale_f32_16x16x128_f8f6f4 %0, %1, %2, %0, %3, %4 op_sel_hi:[0,0,0]" : "+v"(c) : "v"(w.v), "v"(x.v), "v"(sa), "v"(sb));
    return c; }
template <class Epi, class Sched, bool ALIGN_EPI = false, bool SP2 = false, bool FP8 = false>
__device__ __forceinline__ void gemm_phase(PG8_LAS unsigned char* lds, const Gemm g, const Sched& S, const Epi& E) {
    const int tid = threadIdx.x, wid = __builtin_amdgcn_readfirstlane(tid >> 6), lane = tid & 63, wr = wid >> 2, wc = wid & 3, fr = lane & 15, fq = lane >> 4;
    const int K = g.K, nt = K / BK;
    unsigned voffA[2], voffB[2];
#pragma unroll
    for (int i = 0; i < 2; ++i) { int R, C; stage_rc(tid * 16 + i * 8192, R, C); const int Rb = Epi::PERM ? ((R & ~31) + perm32(R & 31)) : R;
        voffA[i] = (unsigned)(R * K + C) * 2u; voffB[i] = (unsigned)(Rb * K + C) * 2u; }
    const size_t kstep = (size_t)(BK * 2);
    const size_t hstep = (size_t)HALF * K * 2;
    const size_t rowb = (size_t)K * 2;
    const unsigned ldsw = (unsigned)wid * 1024u;
    const int aoff = lds_byte(wr * 64 + fr, fq * 8), boff = lds_byte(wc * 32 + fr, fq * 8);
#define PG8_SA(b, h) (((b) * 2 + (h)) * HTB)
#define PG8_SB(b, h) ((4 + (b) * 2 + (h)) * HTB)
#define PG8_STAGE(bufoff, gbase, voff) do { _Pragma("unroll") for (int _i = 0; _i < 2; ++_i) \
        __builtin_amdgcn_global_load_lds((const unsigned*)((const char*)(gbase) + (voff)[_i]), (PG8_LAS unsigned*)(lds + (bufoff) + ldsw + _i * 8192), 16, 0, 0); } while (0)
#define PG8_LDA(dst, b, h) do { _Pragma("unroll") for (int m = 0; m < 4; ++m) dst[m].ld(lds + PG8_SA(b, h) + aoff + m * 2048); } while (0)
#define PG8_LDB(dst, b, h) do { _Pragma("unroll") for (int n = 0; n < 2; ++n) dst[n].ld(lds + PG8_SB(b, h) + boff + n * 2048); } while (0)
#define PG8_MMA(ai, bj, At, Bt) do { __builtin_amdgcn_s_setprio(1); _Pragma("unroll") for (int m = 0; m < 4; ++m) _Pragma("unroll") for (int n = 0; n < 2; ++n) \
        acc[ai][bj][m][n] = mma_frag(Bt[n], At[m], acc[ai][bj][m][n]); __builtin_amdgcn_s_setprio(0); } while (0)
#define PG8_WAIT_V(n) asm volatile("s_waitcnt vmcnt(" #n ")" ::: "memory")
#define PG8_WAIT_L(n) asm volatile("s_waitcnt lgkmcnt(" #n ")" ::: "memory")
#define PG8_BAR __builtin_amdgcn_s_barrier()
#define PG8_SCHED __builtin_amdgcn_sched_barrier(0)
    Unit cur, nxt; int ui = 0;
    if (!S.next(0, cur)) return;
    f32x4 acc[2][2][4][2];
#pragma unroll
    for (int a = 0; a < 2; ++a)
#pragma unroll
        for (int b = 0; b < 2; ++b)
#pragma unroll
            for (int m = 0; m < 4; ++m)
#pragma unroll
                for (int n = 0; n < 2; ++n) acc[a][b][m][n] = (f32x4){0.f, 0.f, 0.f, 0.f};
    Frag<FP8> At[4], B0[2], B1[2];
    const char* cA = (const char*)g.A + (size_t)cur.arow * rowb; const char* cB = (const char*)g.Bt + (size_t)cur.brow * rowb;
    S.a_ready(cur);
    PG8_LAS unsigned char* const blds = lds + 131072 + 4096;
    E.prefetch(cur, blds, wid, lane);
    if constexpr (SP2) {
        PG8_STAGE(PG8_SB(0, 0), cB, voffB); PG8_STAGE(PG8_SB(0, 1), cB + hstep, voffB); PG8_STAGE(PG8_SA(0, 0), cA, voffA); PG8_STAGE(PG8_SA(0, 1), cA + hstep, voffA);
        if (wr == 1) PG8_BAR;
        PG8_WAIT_V(2); PG8_BAR;
        PG8_STAGE(PG8_SB(1, 0), cB + kstep, voffB); PG8_STAGE(PG8_SA(1, 0), cA + kstep, voffA); PG8_STAGE(PG8_SB(1, 1), cB + hstep + kstep, voffB);
        PG8_WAIT_V(6); PG8_BAR;
    } else {
        PG8_STAGE(PG8_SB(0, 0), cB, voffB); PG8_STAGE(PG8_SA(0, 0), cA, voffA); PG8_STAGE(PG8_SB(0, 1), cB + hstep, voffB); PG8_STAGE(PG8_SA(0, 1), cA + hstep, voffA);
        if (wr == 1) PG8_BAR;
        PG8_WAIT_V(4); PG8_BAR;
        PG8_STAGE(PG8_SB(1, 0), cB + kstep, voffB); PG8_STAGE(PG8_SA(1, 0), cA + kstep, voffA); PG8_STAGE(PG8_SB(1, 1), cB + hstep + kstep, voffB);
        PG8_WAIT_V(6); PG8_BAR;
    }
    for (;;) {
        const bool has_next = S.next(ui + 1, nxt);
        const char* nA = has_next ? (const char*)g.A + (size_t)nxt.arow * rowb : cA; const char* nB = has_next ? (const char*)g.Bt + (size_t)nxt.brow * rowb : cB;
        for (int t = 0; t < nt; t += 2) {
            const bool last = (t == nt - 2);
            const char* a1 = cA + (size_t)(t + 1) * kstep;
            const char* a2 = last ? nA : cA + (size_t)(t + 2) * kstep; const char* b2 = last ? nB : cB + (size_t)(t + 2) * kstep;
            const char* a3 = a2 + kstep; const char* b3 = b2 + kstep;
            if (last && has_next) { S.a_ready(nxt); E.prefetch(nxt, blds + (((ui + 1) & 1) << 10), wid, lane); }
            if constexpr (SP2) {
            PG8_LDB(B0, 0, 0); PG8_LDB(B1, 0, 1); PG8_SCHED; PG8_LDA(At, 0, 0); PG8_STAGE(PG8_SA(1, 1), a1 + hstep, voffA);
            PG8_WAIT_V(8); PG8_WAIT_L(0); PG8_BAR; PG8_MMA(0, 0, At, B0); PG8_MMA(0, 1, At, B1); PG8_BAR; PG8_SCHED;
            PG8_LDA(At, 0, 1); PG8_STAGE(PG8_SB(0, 0), b2, voffB); PG8_STAGE(PG8_SB(0, 1), b2 + hstep, voffB); PG8_STAGE(PG8_SA(0, 0), a2, voffA);
            PG8_WAIT_V(8); PG8_WAIT_L(0); PG8_BAR; PG8_MMA(1, 0, At, B0); PG8_MMA(1, 1, At, B1); PG8_BAR; PG8_SCHED;
            PG8_LDB(B0, 1, 0); PG8_LDB(B1, 1, 1); PG8_SCHED; PG8_LDA(At, 1, 0); PG8_STAGE(PG8_SA(0, 1), a2 + hstep, voffA);
            PG8_WAIT_V(8); PG8_WAIT_L(0); PG8_BAR; PG8_MMA(0, 0, At, B0); PG8_MMA(0, 1, At, B1); PG8_BAR; PG8_SCHED;
            PG8_LDA(At, 1, 1); PG8_STAGE(PG8_SB(1, 0), b3, voffB); PG8_STAGE(PG8_SB(1, 1), b3 + hstep, voffB); PG8_STAGE(PG8_SA(1, 0), a3, voffA);
            PG8_WAIT_V(8); PG8_WAIT_L(0); PG8_BAR; PG8_MMA(1, 0, At, B0); PG8_MMA(1, 1, At, B1); PG8_BAR; PG8_SCHED;
            } else {
            PG8_LDB(B0, 0, 0); PG8_SCHED; PG8_LDA(At, 0, 0); PG8_STAGE(PG8_SA(1, 1), a1 + hstep, voffA);
            PG8_WAIT_L(8); PG8_BAR; PG8_WAIT_L(0); PG8_MMA(0, 0, At, B0); PG8_BAR; PG8_SCHED;
            PG8_LDB(B1, 0, 1); PG8_STAGE(PG8_SB(0, 0), b2, voffB);
            PG8_BAR; PG8_WAIT_L(0); PG8_MMA(0, 1, At, B1); PG8_BAR;
            PG8_LDA(At, 0, 1); PG8_STAGE(PG8_SA(0, 0), a2, voffA);
            PG8_BAR; PG8_WAIT_L(0); PG8_MMA(1, 0, At, B0); PG8_BAR; PG8_SCHED;
            PG8_STAGE(PG8_SB(0, 1), b2 + hstep, voffB);
            PG8_WAIT_V(6); PG8_BAR; PG8_MMA(1, 1, At, B1); PG8_BAR;
            PG8_LDB(B0, 1, 0); PG8_SCHED; PG8_LDA(At, 1, 0); PG8_STAGE(PG8_SA(0, 1), a2 + hstep, voffA);
            PG8_WAIT_L(8); PG8_BAR; PG8_WAIT_L(0); PG8_MMA(0, 0, At, B0); PG8_BAR; PG8_SCHED;
            PG8_LDB(B1, 1, 1); PG8_STAGE(PG8_SB(1, 0), b3, voffB);
            PG8_BAR; PG8_WAIT_L(0); PG8_MMA(0, 1, At, B1); PG8_BAR;
            PG8_LDA(At, 1, 1); PG8_STAGE(PG8_SA(1, 0), a3, voffA);
            PG8_BAR; PG8_WAIT_L(0); PG8_MMA(1, 0, At, B0); PG8_BAR; PG8_SCHED;
            PG8_STAGE(PG8_SB(1, 1), b3 + hstep, voffB);
            PG8_WAIT_V(6); PG8_BAR; PG8_MMA(1, 1, At, B1); PG8_BAR;
            }
        }
        if constexpr (ALIGN_EPI) { if (wr == 0) PG8_BAR; }
        if constexpr (FP8) {
#define PG8_ACC8(a, b) "+v"(acc[a][b][0][0]), "+v"(acc[a][b][0][1]), "+v"(acc[a][b][1][0]), "+v"(acc[a][b][1][1]), "+v"(acc[a][b][2][0]), "+v"(acc[a][b][2][1]), "+v"(acc[a][b][3][0]), "+v"(acc[a][b][3][1])
            asm volatile("s_nop 15\n\ts_nop 15" : PG8_ACC8(0, 0), PG8_ACC8(0, 1) :: "memory");
            asm volatile("" : PG8_ACC8(1, 0), PG8_ACC8(1, 1) :: "memory");
#undef PG8_ACC8
        }
#ifdef MK_EPI2
        if constexpr (Epi::TAG == MK_EPI2) { E(acc, cur, wr, wc, fr, fq, blds + ((ui & 1) << 10)); asm volatile("" ::: "memory"); }
#endif
        if constexpr (!Epi::AFTER_DRAIN) { E(acc, cur, wr, wc, fr, fq, blds + ((ui & 1) << 10)); S.done(cur); }
        if (!has_next) break;
#pragma unroll
        for (int a = 0; a < 2; ++a)
#pragma unroll
            for (int b = 0; b < 2; ++b)
#pragma unroll
                for (int m = 0; m < 4; ++m)
#pragma unroll
                    for (int n = 0; n < 2; ++n) acc[a][b][m][n] = (f32x4){0.f, 0.f, 0.f, 0.f};
        cur = nxt; cA = nA; cB = nB; ++ui;
        if constexpr (ALIGN_EPI) { if (wr == 1) PG8_BAR; }
    }
    PG8_WAIT_V(0);
    if constexpr (!ALIGN_EPI) { if (wr == 0) PG8_BAR; }
    PG8_BAR;
    if constexpr (Epi::AFTER_DRAIN) { E.fused(acc, cur, wr, wc, fr, fq, lds, wid, lane); S.done(cur); }
#undef PG8_SA
#undef PG8_SB
#undef PG8_STAGE
#undef PG8_LDA
#undef PG8_LDB
#undef PG8_MMA
#undef PG8_WAIT_V
#undef PG8_WAIT_L
#undef PG8_BAR
#undef PG8_SCHED
}

}

#define XB_TMO      128
#define XB_XCNT(j)  (256  + 64 * (j))
#define XB_XSUB(j)  (1280 + 64 * (j))
#define XB_XGEN(j)  (2304 + 64 * (j))
#define XB_TOP      3328
#define XB_TOPGEN   3392
#define XCD_BAR_WORDS 3456
#define XB_SPIN_CAP (1u << 18)
__device__ __forceinline__ unsigned xb_ld(unsigned* p)              { return __hip_atomic_load(p, __ATOMIC_RELAXED, __HIP_MEMORY_SCOPE_AGENT); }
__device__ __forceinline__ unsigned xb_add(unsigned* p, unsigned v) { return __hip_atomic_fetch_add(p, v, __ATOMIC_RELAXED, __HIP_MEMORY_SCOPE_AGENT); }
__device__ __forceinline__ unsigned xb_xcc_id() { return (unsigned)__builtin_amdgcn_s_getreg((3 << 11) | 20) & 0xFu; }
#define XB_SPIN(cond, bar) do { unsigned _sp = 0; while (cond) { __builtin_amdgcn_s_sleep(1); \
    if ((++_sp & 255u) == 0u) { if (xb_ld(&(bar)[XB_TMO])) break; if (_sp > XB_SPIN_CAP) { atomicAdd(&(bar)[XB_TMO], 1u); break; } } } } while (0)
struct XcdBarrier { unsigned* bar; unsigned x; volatile LAS unsigned* st; };
__device__ __forceinline__ XcdBarrier xcd_barrier_post(unsigned* bar, volatile LAS unsigned* st) {
    XcdBarrier b; b.bar = bar; b.x = xb_xcc_id(); b.st = st;
    if (threadIdx.x == 0) (void)xb_add(&bar[XB_XCNT(b.x)], 1u);
    return b;
}
__device__ __forceinline__ void xcd_barrier_complete(unsigned* bar, unsigned x, unsigned& nloc, unsigned& nx) {
    const unsigned G = gridDim.x * gridDim.y * gridDim.z;
    unsigned sum, cnt, mine, sp = 0u;
    for (;;) {
        sum = 0u; cnt = 0u; mine = 0u;
#pragma unroll
        for (unsigned j = 0; j < 16; ++j) { const unsigned c = xb_ld(&bar[XB_XCNT(j)]); sum += c; cnt += (c > 0u) ? 1u : 0u; mine = (j == x) ? c : mine; }
        if (sum == G) break;
        __builtin_amdgcn_s_sleep(1);
        if ((++sp & 255u) == 0u) { if (xb_ld(&bar[XB_TMO])) break; if (sp > XB_SPIN_CAP) { atomicAdd(&bar[XB_TMO], 1u); break; } }
    }
    nloc = mine > 0u ? mine : 1u; nx = cnt > 0u ? cnt : 1u;
}
__device__ __forceinline__ void xcd_barrier(const XcdBarrier& b) {
    asm volatile("s_waitcnt vmcnt(0)" ::: "memory");
    __syncthreads();
    if (threadIdx.x == 0) {
        unsigned* bar = b.bar;
        __builtin_amdgcn_s_waitcnt(0);
        unsigned nloc = b.st[0], nx = b.st[1];
        if (nloc == 0u) { xcd_barrier_complete(bar, b.x, nloc, nx); b.st[0] = nloc; b.st[1] = nx; }
        const unsigned old = xb_add(&bar[XB_XSUB(b.x)], 1u);
        const unsigned gen = old / nloc;
        if (old + 1u == (gen + 1u) * nloc) {
            __builtin_amdgcn_fence(__ATOMIC_RELEASE, "agent");
            asm volatile("s_waitcnt vmcnt(0)" ::: "memory");
            const unsigned og = xb_add(&bar[XB_TOP], 1u);
            const unsigned tg = og / nx;
            if (og + 1u == (tg + 1u) * nx) xb_add(&bar[XB_TOPGEN], 1u);
            else XB_SPIN(xb_ld(&bar[XB_TOPGEN]) == tg, bar);
            __builtin_amdgcn_fence(__ATOMIC_ACQUIRE, "agent");
            xb_add(&bar[XB_XGEN(b.x)], 1u);
            asm volatile("s_waitcnt vmcnt(0)" ::: "memory");
        } else {
            XB_SPIN(xb_ld(&bar[XB_XGEN(b.x)]) == gen, bar);
            __builtin_amdgcn_fence(__ATOMIC_ACQUIRE, "agent");
            asm volatile("s_waitcnt vmcnt(0)" ::: "memory");
        }
    }
    __syncthreads();
}

constexpr int NWAVES = 8;
constexpr int RING_OFF = 0, RING_BYTES = 131072;
constexpr int LDSCTL_OFF = RING_BYTES, MISC_OFF = LDSCTL_OFF + 320;
constexpr int TBL_OFF = LDSCTL_OFF + 1024;
constexpr int LDS_BYTES = 147456;

struct Frame {
    LAS unsigned char* lds; volatile LAS unsigned* MISC; LAS int* tbl; gu32* ctl;
    int tid, lane, wave, vcu, G;
};

__device__ __forceinline__ void p0_transpose_item(const float* W, int K, int N, bf16* WT, int k0, int n0, int orow0, LAS float* scr, int lane) {
#pragma unroll 8
    for (int i = 0; i < 32; ++i) { const int kk = 2 * i + (lane >> 5); scr[kk * 33 + (lane & 31)] = W[(size_t)(k0 + kk) * N + n0 + (lane & 31)]; }
    LDS_WAIT(); asm volatile("" ::: "memory");
    const int c = lane & 7;
#pragma unroll
    for (int j = 0; j < 4; ++j) { const int n = (lane >> 3) + 8 * j; const LAS float* s = scr + (8 * c) * 33 + n;
        u32x4 o; o.x = pk2(s[0 * 33], s[1 * 33]); o.y = pk2(s[2 * 33], s[3 * 33]); o.z = pk2(s[4 * 33], s[5 * 33]); o.w = pk2(s[6 * 33], s[7 * 33]);
        *(GAS u32x4*)(WT + (size_t)(orow0 + n) * K + k0 + 8 * c) = o; }
    LDS_WAIT(); asm volatile("" ::: "memory");
}
__device__ __forceinline__ void p0_transpose_item_fp8(const float* W, int K, int N, unsigned char* WT, int k0, int n0, int orow0, LAS float* scr, int lane) {
#pragma unroll 8
    for (int i = 0; i < 32; ++i) { const int kk = 2 * i + (lane >> 5); scr[kk * 33 + (lane & 31)] = W[(size_t)(k0 + kk) * N + n0 + (lane & 31)]; }
    LDS_WAIT(); asm volatile("" ::: "memory");
    const int c = lane & 7;
#pragma unroll
    for (int j = 0; j < 4; ++j) { const int n = (lane >> 3) + 8 * j; const LAS float* sp = scr + (8 * c) * 33 + n;
        u32x2 o; o.x = pk4_fp8(sp[0 * 33] * 32.f, sp[1 * 33] * 32.f, sp[2 * 33] * 32.f, sp[3 * 33] * 32.f); o.y = pk4_fp8(sp[4 * 33] * 32.f, sp[5 * 33] * 32.f, sp[6 * 33] * 32.f, sp[7 * 33] * 32.f);
        *(GAS u32x2*)(WT + (size_t)(orow0 + n) * K + k0 + 8 * c) = o; }
    LDS_WAIT(); asm volatile("" ::: "memory");
}
__device__ __forceinline__ void rms_row_to_bf16(const float* xrow, const float* g, bf16* orow, int lane) {
    const GAS f32x4* xr = (const GAS f32x4*)xrow + lane; f32x4 v[4]; float s = 0.f;
#pragma unroll
    for (int j = 0; j < 4; ++j) { v[j] = xr[64 * j]; s += (v[j].x * v[j].x + v[j].y * v[j].y) + (v[j].z * v[j].z + v[j].w * v[j].w); }
    const float rstd = 1.f / sqrtf(wave_sum(s) * (1.f / D) + EPS);
    GAS unsigned long long* o8 = (GAS unsigned long long*)orow + lane;
#pragma unroll
    for (int j = 0; j < 4; ++j) { const f32x4 gg = ((const GAS f32x4*)g)[lane + 64 * j];
        o8[64 * j] = (unsigned long long)pk2(v[j].x * rstd * gg.x, v[j].y * rstd * gg.y) | ((unsigned long long)pk2(v[j].z * rstd * gg.z, v[j].w * rstd * gg.w) << 32); }
}

__device__ __forceinline__ void rms_row_to_fp8(const float* xrow, const float* g, unsigned char* orow, int lane) {
    const GAS f32x4* xr = (const GAS f32x4*)xrow + lane; f32x4 v[4]; float s = 0.f;
#pragma unroll
    for (int j = 0; j < 4; ++j) { v[j] = xr[64 * j]; s += (v[j].x * v[j].x + v[j].y * v[j].y) + (v[j].z * v[j].z + v[j].w * v[j].w); }
    const float rstd = 1.f / sqrtf(wave_sum(s) * (1.f / D) + EPS);
    GAS unsigned* o4 = (GAS unsigned*)orow + lane;
#pragma unroll
    for (int j = 0; j < 4; ++j) { const f32x4 gg = ((const GAS f32x4*)g)[lane + 64 * j]; o4[64 * j] = pk4_fp8(v[j].x * rstd * gg.x, v[j].y * rstd * gg.y, v[j].z * rstd * gg.z, v[j].w * rstd * gg.w); }
}
constexpr float LOG2E = 1.4426950408889634f;
typedef __bf16 bf16x2_t __attribute__((ext_vector_type(2)));
__device__ __forceinline__ unsigned cvtpk_v(float lo, float hi) { const f32x2 v = {lo, hi}; const bf16x2_t b = __builtin_convertvector(v, bf16x2_t); return __builtin_bit_cast(unsigned, b); }
struct AttFrags { bf16x8 k0a, k0b, k1a, k1b, v[4]; };
__device__ __forceinline__ float gmax4(float m) {
    { auto rr = __builtin_amdgcn_permlane16_swap(__float_as_uint(m), __float_as_uint(m), false, false); m = fmaxf(__uint_as_float(rr[0]), __uint_as_float(rr[1])); }
    { auto rr = __builtin_amdgcn_permlane32_swap(__float_as_uint(m), __float_as_uint(m), false, false); m = fmaxf(__uint_as_float(rr[0]), __uint_as_float(rr[1])); }
    return m;
}
constexpr int RB_A = 160, RB_B = 320;
template <int NH, int RB>
__device__ __forceinline__ void band_group(f32x4 (&o)[NH][4], float (&mrun)[NH], float (&lrun)[NH], const bf16* qkvb, const int (&qcol)[NH], const int (&qmu0)[NH], int kcol, const bf16* vt,
                                           int dil, int rho, int L, int qstep, int P0, int npairs, const LAS float* const (&tab)[NH], int lane) {
    const int t = lane & 15, g = lane >> 4;
    bf16x8 qf[NH][2]; int mu_t[NH];
#pragma unroll
    for (int h = 0; h < NH; ++h) { mu_t[h] = qmu0[h] + qstep * t; const bf16* qrow = qkvb + (size_t)(mu_t[h] * dil + rho) * NQKV + 8 * g + qcol[h];
        qf[h][0] = *(const bf16x8*)qrow; qf[h][1] = *(const bf16x8*)(qrow + 32); }
    const int npr = L >> 5;
    const bf16* kbase = qkvb + (size_t)rho * NQKV + kcol + 8 * g;
    const bf16* vtl = vt + (size_t)t * 8192 + (size_t)rho * L + 8 * g;
    auto load = [&](int P, AttFrags& f) {
        const int Pc = min(max(P, 0), npr - 1);
        const bf16* k0p = kbase + (size_t)((32 * Pc + t) * dil) * NQKV; const bf16* k1p = k0p + (size_t)(16 * dil) * NQKV;
        f.k0a = *(const bf16x8*)k0p; f.k0b = *(const bf16x8*)(k0p + 32); f.k1a = *(const bf16x8*)k1p; f.k1b = *(const bf16x8*)(k1p + 32);
#pragma unroll
        for (int db = 0; db < 4; ++db) f.v[db] = *(const bf16x8*)(vtl + (size_t)(16 * db) * 8192 + 32 * Pc);
    };
    AttFrags cur; load(P0, cur);
    for (int pp = 0; pp < npairs; ++pp) {
        const int P = P0 + pp;
        AttFrags nxt; load(P0 + min(pp + 1, npairs - 1), nxt);
        if (P >= 0 && P < npr) {
            const int kap0 = 32 * P + 4 * g;
#pragma unroll
            for (int h = 0; h < NH; ++h) {
                const LAS float* tb_ = tab[h] + (kap0 - mu_t[h] + RB);
                f32x4 s0 = (f32x4){tb_[0], tb_[1], tb_[2], tb_[3]}, s1 = (f32x4){tb_[16], tb_[17], tb_[18], tb_[19]};
                s0 = __builtin_amdgcn_mfma_f32_16x16x32_bf16(cur.k0a, qf[h][0], s0, 0, 0, 0); s0 = __builtin_amdgcn_mfma_f32_16x16x32_bf16(cur.k0b, qf[h][1], s0, 0, 0, 0);
                s1 = __builtin_amdgcn_mfma_f32_16x16x32_bf16(cur.k1a, qf[h][0], s1, 0, 0, 0); s1 = __builtin_amdgcn_mfma_f32_16x16x32_bf16(cur.k1b, qf[h][1], s1, 0, 0, 0);
                float mx = fmaxf(fmaxf(fmaxf(s0[0], s0[1]), fmaxf(s0[2], s0[3])), fmaxf(fmaxf(s1[0], s1[1]), fmaxf(s1[2], s1[3])));
                mx = gmax4(mx);
                if (__any(mx > mrun[h])) { const float mn = fmaxf(mrun[h], mx), alpha = __builtin_amdgcn_exp2f(mrun[h] - mn); mrun[h] = mn; lrun[h] *= alpha;
#pragma unroll
                    for (int db = 0; db < 4; ++db) o[h][db] = o[h][db] * alpha; }
                const float mn = mrun[h]; float p[8], ps = 0.f;
#pragma unroll
                for (int j = 0; j < 8; ++j) { p[j] = __builtin_amdgcn_exp2f(((j < 4) ? s0[j & 3] : s1[j & 3]) - mn); ps += p[j]; }
                lrun[h] += ps;
                u32x4 pw; pw.x = cvtpk_v(p[0], p[1]); pw.y = cvtpk_v(p[2], p[3]); pw.z = cvtpk_v(p[4], p[5]); pw.w = cvtpk_v(p[6], p[7]);
                const bf16x8 pf = __builtin_bit_cast(bf16x8, pw);
#pragma unroll
                for (int db = 0; db < 4; ++db) o[h][db] = __builtin_amdgcn_mfma_f32_16x16x32_bf16(cur.v[db], pf, o[h][db], 0, 0, 0);
                if (NH > 2 && h + 1 < NH) __builtin_amdgcn_sched_barrier(0);
            }
        }
        cur = nxt;
    }
}
template <int NH>
__device__ __forceinline__ void band_store(const f32x4 (&o)[NH][4], const float (&lrun)[NH], unsigned char* const (&yrow)[NH], int lane) {
    const int g = lane >> 4;
#pragma unroll
    for (int h = 0; h < NH; ++h) { float l = lrun[h]; l += __shfl_xor(l, 16); l += __shfl_xor(l, 32); const float inv = 1.f / l;
#pragma unroll
        for (int db = 0; db < 4; ++db) *(unsigned*)(yrow[h] + 16 * db + 4 * g) = pk4_fp8(o[h][db][0] * inv, o[h][db][1] * inv, o[h][db][2] * inv, o[h][db][3] * inv); }
}

struct Args { const float* in[19]; float* out; unsigned char* ws; int ph_lo, ph_hi, li, pad; };
constexpr int NPHASE = 10;

__global__ void __launch_bounds__(NWAVES * 64, 2) mk_fwd(Args args) {
    extern __shared__ __attribute__((aligned(16))) unsigned char lds[];
    Frame F;
    F.lds = (LAS unsigned char*)lds; F.MISC = (volatile LAS unsigned*)(F.lds + MISC_OFF); F.tbl = (LAS int*)(F.lds + TBL_OFF);
    F.tid = threadIdx.x; F.lane = F.tid & 63; F.wave = __builtin_amdgcn_readfirstlane(F.tid >> 6);
    F.G = gridDim.x; { const int bx = blockIdx.x; F.vcu = (F.G % 8 == 0) ? (bx % 8) * (F.G / 8) + bx / 8 : bx; }
    unsigned char* ws = args.ws; F.ctl = (gu32*)(ws + WS_CTL);
    const float* x = args.in[0]; const float* norm_mix = args.in[1]; const float* w_in = args.in[2]; const float* b_in = args.in[3];
    const float* sinks = args.in[4]; const float* rel_bias = args.in[5]; const float* w_a = args.in[6]; const float* w_b = args.in[7];
    const float* w_out = args.in[8]; const float* norm_ffn = args.in[9]; const float* router_w = args.in[10]; const float* router_b = args.in[11];
    const float* w_gate = args.in[12]; const float* b_gate = args.in[13]; const float* w_up = args.in[14]; const float* b_up = args.in[15];
    const float* w_down = args.in[16]; const float* b_down = args.in[17]; const float* norm_final = args.in[18];
    float* out = args.out;
    Tabs* tb = (Tabs*)(ws + WS_TAB);
    bf16* Win_t = (bf16*)(ws + WS_WIN); bf16* Wa_t = (bf16*)(ws + WS_WA); bf16* Wb_t = (bf16*)(ws + WS_WB); bf16* Wout_t = (bf16*)(ws + WS_WOUT);
    unsigned char* Wgu8 = ws + WS_WGU; unsigned char* Wd8 = ws + WS_WD; unsigned char* H28 = ws + WS_H2; unsigned char* HS8 = ws + WS_HS; unsigned char* ACT8 = ws + WS_ACT; unsigned char* YS = ws + WS_YS;
    int* topi = (int*)(ws + WS_RT); float* topp = (float*)(ws + WS_RT + 256 * 1024); int* slot = (int*)(ws + WS_RT + 512 * 1024); int* pos = (int*)(ws + WS_RT + 768 * 1024);
    bf16* XN = (bf16*)(ws + WS_XN); bf16* QKV = (bf16*)(ws + WS_QKV); bf16* GATES = (bf16*)(ws + WS_GATES); bf16* YA = (bf16*)(ws + WS_YA); bf16* YB = (bf16*)(ws + WS_YB);
    bf16* MERGED = (bf16*)(ws + WS_MERGED);
    gu32* cnt = F.ctl + CW_CNT;

    for (int u = F.tid; u < (LDS_BYTES - LDSCTL_OFF) / 4; u += NWAVES * 64) ((LAS unsigned*)(F.lds + LDSCTL_OFF))[u] = 0u;
    __syncthreads();
    XcdBarrier bar = xcd_barrier_post((unsigned*)(F.ctl + CW_BAR) + args.li * XCD_BAR_WORDS, F.MISC + 8);
    const int lo = args.ph_lo, hi = args.ph_hi;
#ifndef MK_SKIP
#define MK_SKIP 0
#endif
#define IN(k) (!((MK_SKIP >> (k)) & 1) && lo <= (k) && (k) < hi)
#ifndef MK_DUP
#define MK_DUP 0
#endif
#define REP(k) _Pragma("unroll") for (int rep_ = 0; rep_ < 1 + ((MK_DUP >> (k)) & 1); ++rep_)
#ifdef MK_TSTAMP
    unsigned long long ts_a = __builtin_amdgcn_s_memrealtime(), ts_b = ts_a;
#define SEAM(k) do { if (IN(k) && IN((k) + 1)) xcd_barrier(bar); if ((k) + 1 == MK_TSTAMP) ts_a = __builtin_amdgcn_s_memrealtime(); if ((k) == MK_TSTAMP) ts_b = __builtin_amdgcn_s_memrealtime(); } while (0)
#else
#define SEAM(k) do { if (IN(k) && IN((k) + 1)) xcd_barrier(bar); } while (0)
#endif
    const int gw = F.vcu * NWAVES + F.wave, NGW = F.G * NWAVES;

    LAS float* scr = (LAS float*)(F.lds + RING_OFF + F.wave * 16384);
    constexpr int I_IN = (D / 64) * (NPROJ / 32), I_A = (D / 64) * (D / 32), I_B = (256 / 64) * (D / 32), I_E = (D / 64) * (D / 32);
    constexpr int NITEMS = I_IN + 2 * I_A + I_B + 3 * NE * I_E;
    auto transpose_items = [&](int first, int last) {
    for (int it = first + gw; it < last; it += NGW) {
        int r = it;
        if (r < I_IN) { const int nb = NPROJ / 32; p0_transpose_item_fp8(w_in, D, NPROJ, (unsigned char*)Win_t, 64 * (r / nb), 32 * (r % nb), 32 * (r % nb), scr, F.lane); continue; } r -= I_IN;
        if (r < I_A) { const int nb = D / 32; p0_transpose_item_fp8(w_a, D, D, (unsigned char*)Wa_t, 64 * (r / nb), 32 * (r % nb), 32 * (r % nb), scr, F.lane); continue; } r -= I_A;
        if (r < I_A) { const int nb = D / 32; p0_transpose_item_fp8(w_out, D, D, (unsigned char*)Wout_t, 64 * (r / nb), 32 * (r % nb), 32 * (r % nb), scr, F.lane); continue; } r -= I_A;
        if (r < I_B) { const int nb = D / 32; p0_transpose_item_fp8(w_b, 256, D, (unsigned char*)Wb_t, 64 * (r / nb), 32 * (r % nb), 32 * (r % nb), scr, F.lane); continue; } r -= I_B;
        { const int e = r / (3 * I_E), q = r % (3 * I_E), which = q / I_E, ii = q % I_E, nb = D / 32, k0 = 64 * (ii / nb), n0 = 32 * (ii % nb);
          if (which == 0) p0_transpose_item_fp8(w_gate + (size_t)e * D * D, D, D, Wgu8, k0, n0, e * 2048 + (n0 >> 7) * 256 + (n0 & 127), scr, F.lane);
          else if (which == 1) p0_transpose_item_fp8(w_up + (size_t)e * D * D, D, D, Wgu8, k0, n0, e * 2048 + (n0 >> 7) * 256 + 128 + (n0 & 127), scr, F.lane);
          else p0_transpose_item_fp8(w_down + (size_t)e * D * D, D, D, Wd8, k0, n0, e * 1024 + n0, scr, F.lane); }
    }
    };
    if (IN(0)) REP(0) {
        { const int i = blockIdx.x * (NWAVES * 64) + F.tid;
          if (i < 16 * 257) { const int h = i / 257, r = i % 257; tb->biasA[h][r] = rel_bias[BKT_A[r] * 28 + h]; }
          if (i < 12 * 129) { const int g = i / (4 * 129), hs = (i / 129) % 4, r = i % 129; tb->biasB[g][hs][r] = rel_bias[BKT_B[g][r] * 28 + 16 + 4 * g + hs]; } }
        transpose_items(0, I_IN + 2 * I_A + I_B);
        for (int m = gw; m < T; m += NGW) rms_row_to_fp8(x + (size_t)m * D, norm_mix, (unsigned char*)XN + (size_t)m * D, F.lane);
    }
    SEAM(0);
    if (IN(1)) REP(1) {
        int k512 = D / 2; asm volatile("" : "+s"(k512));
        pg8::Gemm g{XN, Win_t, k512}; pg8::StaticOrder So; So.init(T, NPROJ, F.G, (int)blockIdx.x);
        pg8::EpiProj E{QKV, GATES, b_in, (bf16*)(ws + WS_VT), (bf16*)(ws + WS_VT) + (size_t)2 * 4 * 64 * 8192};
        pg8::gemm_phase<pg8::EpiProj, pg8::StaticOrder, true, true, true>(F.lds + RING_OFF, g, So, E);
    }
    SEAM(1);
    int nrep2 = 1 + ((MK_DUP >> 2) & 1); asm volatile("" : "+s"(nrep2));
    if (IN(2)) for (int rep_ = 0; rep_ < nrep2; ++rep_) {
        LAS float* lb = (LAS float*)(F.lds + RING_OFF);
        constexpr int TA = 2 * RB_A + 1, TB = 2 * RB_B + 1;
        for (int i = F.tid; i < 16 * TA; i += NWAVES * 64) { const int h = i / TA, rel = i % TA - RB_A; lb[i] = (rel >= -128 && rel <= 128) ? tb->biasA[h][rel + 128] * LOG2E : -3.0e38f; }
        for (int i = F.tid; i < 12 * TB; i += NWAVES * 64) { const int gh = i / TB, rel = i % TB - RB_B; lb[16 * TA + i] = (rel >= -64 && rel <= 64) ? tb->biasB[gh >> 2][gh & 3][rel + 64] * LOG2E : -3.0e38f; }
        __syncthreads();
        const bf16* VTA = (const bf16*)(ws + WS_VT); const bf16* VTB = VTA + (size_t)2 * 4 * 64 * 8192;
        for (int it = gw; it < 4096 + 2048; it += NGW) {
            const int t = F.lane & 15;
            if (it < 4096) {
                const int b = it >> 11, kvh = (it >> 9) & 3, qb = it & 511;
                f32x4 o[4][4]; float mr[4], lr[4];
#pragma unroll
                for (int h = 0; h < 4; ++h) { mr[h] = sinks[kvh * 4 + h] * LOG2E; lr[h] = (F.lane < 16) ? 1.f : 0.f;
#pragma unroll
                    for (int db = 0; db < 4; ++db) o[h][db] = (f32x4){0.f, 0.f, 0.f, 0.f}; }
                const int qcol[4] = {C_QA + (kvh * 4 + 0) * 64, C_QA + (kvh * 4 + 1) * 64, C_QA + (kvh * 4 + 2) * 64, C_QA + (kvh * 4 + 3) * 64};
                const int qmu[4] = {16 * qb, 16 * qb, 16 * qb, 16 * qb};
                const LAS float* const bias[4] = {lb + (kvh * 4 + 0) * TA, lb + (kvh * 4 + 1) * TA, lb + (kvh * 4 + 2) * TA, lb + (kvh * 4 + 3) * TA};
                band_group<4, RB_A>(o, mr, lr, QKV + (size_t)b * S * NQKV, qcol, qmu, C_KA + kvh * 64, VTA + (size_t)((b * 4 + kvh) * 64) * 8192, 1, 0, S, 1, (qb - 8) >> 1, 9, bias, F.lane);
                unsigned char* yr = (unsigned char*)YA + (size_t)(b * S + 16 * qb + t) * D + kvh * 256; unsigned char* const yrow[4] = {yr, yr + 64, yr + 128, yr + 192};
                band_store<4>(o, lr, yrow, F.lane);
            } else {
                const int j = it - 4096, r = j & 7, un = j >> 3, blk = un & 31, hs = (un >> 5) & 3, b = un >> 7, i0 = blk * 256;
                f32x4 o[2][4]; float mr[2], lr[2];
#pragma unroll
                for (int h = 0; h < 2; ++h) { mr[h] = -1.0e30f; lr[h] = 0.f;
#pragma unroll
                    for (int db = 0; db < 4; ++db) o[h][db] = (f32x4){0.f, 0.f, 0.f, 0.f}; }
                const bf16* qb_ = QKV + (size_t)b * S * NQKV;
                { const int qcol[2] = {C_QB + 0 * 256 + hs * 64, C_QB + 0 * 256 + hs * 64}; const int qmu[2] = {i0 + r, i0 + r + 8}; const LAS float* const bias[2] = {lb + 16 * TA + (0 * 4 + hs) * TB, lb + 16 * TA + (0 * 4 + hs) * TB};
                  band_group<2, RB_B>(o, mr, lr, qb_, qcol, qmu, C_KB + 0 * 256 + hs * 64, VTB + (size_t)(((0 * 2 + b) * 4 + hs) * 64) * 8192, 1, 0, S, 16, (i0 >> 5) - 2, 12, bias, F.lane); }
                { const int qcol[2] = {C_QB + 1 * 256 + hs * 64, C_QB + 1 * 256 + hs * 64}; const int qmu[2] = {(i0 + r) >> 2, (i0 + r + 8) >> 2}; const LAS float* const bias[2] = {lb + 16 * TA + (1 * 4 + hs) * TB, lb + 16 * TA + (1 * 4 + hs) * TB};
                  band_group<2, RB_B>(o, mr, lr, qb_, qcol, qmu, C_KB + 1 * 256 + hs * 64, VTB + (size_t)(((1 * 2 + b) * 4 + hs) * 64) * 8192, 4, r & 3, S / 4, 4, (i0 >> 7) - 2, 6, bias, F.lane); }
#pragma unroll
                for (int h = 0; h < 2; ++h) { const int qcol[1] = {C_QB + 2 * 256 + hs * 64}; const int qmu[1] = {i0 >> 4}; const LAS float* const bias[1] = {lb + 16 * TA + (2 * 4 + hs) * TB};
                  band_group<1, RB_B>(*(f32x4(*)[1][4])&o[h], *(float(*)[1])&mr[h], *(float(*)[1])&lr[h], qb_, qcol, qmu, C_KB + 2 * 256 + hs * 64, VTB + (size_t)(((2 * 2 + b) * 4 + hs) * 64) * 8192,
                                    16, r + 8 * h, S / 16, 1, (blk - 4) >> 1, 5, bias, F.lane); }
                unsigned char* yr = (unsigned char*)YB + (size_t)(b * S + i0 + r + 16 * t) * 256 + hs * 64; unsigned char* const yrow[2] = {yr, yr + 8 * 256};
                band_store<2>(o, lr, yrow, F.lane);
            }
        }
        __syncthreads();
    }
    SEAM(2);
    if (IN(3)) REP(3) {
#ifndef NO_P3A
        { int k256 = 128; asm volatile("" : "+s"(k256)); pg8::Gemm g{YB, Wb_t, k256};   pg8::StaticOrder So; So.init(T, D, F.G, (int)blockIdx.x);
          pg8::EpiGate<0> E{MERGED, GATES, 1024, nullptr};
          pg8::gemm_phase<pg8::EpiGate<0>, pg8::StaticOrder, true, true, true>(F.lds + RING_OFF, g, So, E); }
#endif
        VM_WAIT(); __syncthreads();
#ifndef NO_P3B
        { int k512 = D / 2; asm volatile("" : "+s"(k512)); pg8::Gemm g{YA, Wa_t, k512}; pg8::StaticOrder So; So.init(T, D, F.G, (int)blockIdx.x);
          pg8::EpiGate<1> E{MERGED, GATES, 0, (unsigned char*)YA + (size_t)16 * MiB};
          pg8::gemm_phase<pg8::EpiGate<1>, pg8::StaticOrder, true, true, true>(F.lds + RING_OFF, g, So, E); }
#endif
    }
    SEAM(3);
    if (IN(4)) REP(4) {
        int k512 = D / 2; asm volatile("" : "+s"(k512)); pg8::Gemm g{(const bf16*)((unsigned char*)YA + (size_t)16 * MiB), Wout_t, k512}; pg8::StaticOrder So; So.init(T, D, F.G, (int)blockIdx.x);
        pg8::EpiX1 E{x, out};
        pg8::gemm_phase<pg8::EpiX1, pg8::StaticOrder, true, true, true>(F.lds + RING_OFF, g, So, E);
    }
    SEAM(4);
    if (IN(5)) REP(5) {
        const bool lastrep5 = (rep_ + 1 == 1 + ((MK_DUP >> 5) & 1));
        LAS int* lcnt = F.tbl + 72; LAS int* lbase = F.tbl + 104; LAS int* ebuf = F.tbl + 136; LAS int* pbuf = F.tbl + 392;
        LAS float* plog = (LAS float*)(F.lds + RING_OFF);
        LAS float* psq = plog + 8 * 64 * 32;
        LAS float* rstd_s = psq + 512;
        const int g = F.lane >> 4, e16 = F.lane & 15, w = F.wave;
        float wB[32][2];
#pragma unroll
        for (int sc = 0; sc < 32; ++sc) { const int k = 128 * w + 32 * (sc >> 3) + 8 * g + (sc & 7); const float gm = norm_ffn[k];
            wB[sc][0] = gm * router_w[(size_t)k * NE + e16]; wB[sc][1] = gm * router_w[(size_t)k * NE + 16 + e16]; }
        for (int tblk = F.vcu; tblk < T / 64; tblk += F.G) {
            if (F.tid < 32) lcnt[F.tid] = 0;
            f32x4 v[4][2];
            { const GAS float* xr = (const GAS float*)out + (size_t)(tblk * 64 + e16) * D + 128 * w + 8 * g;
#pragma unroll
              for (int s4 = 0; s4 < 4; ++s4) { v[s4][0] = *(const GAS f32x4*)(xr + 32 * s4); v[s4][1] = *(const GAS f32x4*)(xr + 32 * s4 + 4); } }
#pragma unroll 1
            for (int tile = 0; tile < 4; ++tile) {
                f32x4 vn[4][2];
                { const int tn = tile < 3 ? tile + 1 : 3; const GAS float* xr = (const GAS float*)out + (size_t)(tblk * 64 + tn * 16 + e16) * D + 128 * w + 8 * g;
#pragma unroll
                  for (int s4 = 0; s4 < 4; ++s4) { vn[s4][0] = *(const GAS f32x4*)(xr + 32 * s4); vn[s4][1] = *(const GAS f32x4*)(xr + 32 * s4 + 4); } }
                float sq = 0.f;
#pragma unroll
                for (int s4 = 0; s4 < 4; ++s4) sq += (v[s4][0].x * v[s4][0].x + v[s4][0].y * v[s4][0].y) + (v[s4][0].z * v[s4][0].z + v[s4][0].w * v[s4][0].w)
                                                   + (v[s4][1].x * v[s4][1].x + v[s4][1].y * v[s4][1].y) + (v[s4][1].z * v[s4][1].z + v[s4][1].w * v[s4][1].w);
                sq += __shfl_xor(sq, 16); sq += __shfl_xor(sq, 32);
                if (g == 0) psq[w * 64 + tile * 16 + e16] = sq;
                f32x4 a0 = (f32x4){0.f, 0.f, 0.f, 0.f}, a1 = (f32x4){0.f, 0.f, 0.f, 0.f};
#pragma unroll
                for (int s4 = 0; s4 < 4; ++s4)
#pragma unroll
                    for (int c = 0; c < 8; ++c) { const float av = v[s4][c >> 2][c & 3];
                        a0 = __builtin_amdgcn_mfma_f32_16x16x4f32(av, wB[s4 * 8 + c][0], a0, 0, 0, 0); a1 = __builtin_amdgcn_mfma_f32_16x16x4f32(av, wB[s4 * 8 + c][1], a1, 0, 0, 0); }
#pragma unroll
                for (int r = 0; r < 4; ++r) { LAS float* pr = plog + (size_t)(w * 64 + tile * 16 + 4 * g + r) * 32 + e16; pr[0] = a0[r]; pr[16] = a1[r]; }
#pragma unroll
                for (int s4 = 0; s4 < 4; ++s4) { v[s4][0] = vn[s4][0]; v[s4][1] = vn[s4][1]; }
            }
            __syncthreads();
            if (F.tid < 64) { float s = 0.f;
#pragma unroll
                for (int ww = 0; ww < 8; ++ww) s += psq[ww * 64 + F.tid];
                rstd_s[F.tid] = 1.f / sqrtf(s * (1.f / D) + EPS); }
            __syncthreads();
            { const int e = F.tid & 31; const float rbv = router_b[e];
#pragma unroll 1
              for (int i = 0; i < 4; ++i) { const int tl = (F.tid >> 5) + 16 * i; float lg = 0.f;
#pragma unroll
                for (int ww = 0; ww < 8; ++ww) lg += plog[(size_t)(ww * 64 + tl) * 32 + e];
                float val = lg * rstd_s[tl] + rbv; float tv[4]; int ti[4];
#pragma unroll
                for (int r = 0; r < 4; ++r) {
                    float bv = val; int bi = e;
#pragma unroll
                    for (int o = 1; o < 32; o <<= 1) { const float ov = __shfl_xor(bv, o); const int oi = __shfl_xor(bi, o); if (ov > bv || (ov == bv && oi < bi)) { bv = ov; bi = oi; } }
                    tv[r] = bv; ti[r] = bi; if (bi == e) val = -3.0e38f;
                }
                const float e1 = __expf(tv[1] - tv[0]), e2 = __expf(tv[2] - tv[0]), e3 = __expf(tv[3] - tv[0]); const float inv = 1.f / (1.f + e1 + e2 + e3);
                if (e < 4) { const float p = (e == 0 ? 1.f : e == 1 ? e1 : e == 2 ? e2 : e3) * inv; const int ex = (e == 0 ? ti[0] : e == 1 ? ti[1] : e == 2 ? ti[2] : ti[3]);
                    const int m = tblk * 64 + tl; topi[m * 4 + e] = ex; topp[m * 4 + e] = p;
                    const int li = tl * 4 + e; ebuf[li] = ex; pbuf[li] = __hip_atomic_fetch_add(&lcnt[ex], 1, __ATOMIC_RELAXED, __HIP_MEMORY_SCOPE_WORKGROUP); } } }
#pragma unroll 1
            for (int rb = 0; rb < 8; rb += 4) { f32x4 xv[4][4];
#pragma unroll
                for (int r = 0; r < 4; ++r) { const GAS f32x4* xr4 = (const GAS f32x4*)(out + ((size_t)tblk * 64 + w * 8 + rb + r) * D) + F.lane;
#pragma unroll
                    for (int j = 0; j < 4; ++j) xv[r][j] = xr4[64 * j]; }
#pragma unroll
                for (int r = 0; r < 4; ++r) { const int tl = w * 8 + rb + r; const float rstd = rstd_s[tl]; GAS unsigned* o4 = (GAS unsigned*)(H28 + ((size_t)tblk * 64 + tl) * D) + F.lane;
#pragma unroll
                    for (int j = 0; j < 4; ++j) { const f32x4 gg = ((const GAS f32x4*)norm_ffn)[F.lane + 64 * j];
                        o4[64 * j] = pk4_fp8(xv[r][j].x * rstd * gg.x, xv[r][j].y * rstd * gg.y, xv[r][j].z * rstd * gg.z, xv[r][j].w * rstd * gg.w); } } }
            __syncthreads();
            if (F.tid < 32) lbase[F.tid] = lastrep5 ? (int)__hip_atomic_fetch_add(cnt + F.tid, (unsigned)lcnt[F.tid], RLX_AGENT) : 0;
            __syncthreads();
            if (F.tid < 256) pos[tblk * 256 + F.tid] = lbase[ebuf[F.tid]] + pbuf[F.tid];
            __syncthreads();
        }
    }
    SEAM(5);
    if (IN(6) || IN(7) || IN(8)) {
        LAS int* loff = F.tbl; LAS int* ltoff = F.tbl + 36; LAS int* lc = F.tbl + 72;
        if (F.tid < 32) lc[F.tid] = (int)__hip_atomic_load(cnt + F.tid, RLX_AGENT);
        __syncthreads();
        if (F.tid == 0) { int a = 0, ta = 0; for (int e = 0; e < NE; ++e) { loff[e] = a; ltoff[e] = ta; const int c = lc[e]; a += c; ta += (c + 255) >> 8; } loff[NE] = a; ltoff[NE] = ta; }
        __syncthreads();
    }
    if (IN(6)) REP(6) {
        transpose_items(I_IN + 2 * I_A + I_B, NITEMS);
        const LAS int* loff = F.tbl;
        for (int p0 = gw; p0 < T * 4; p0 += 4 * NGW) {
            int row[4]; u32x4 dv[4];
#pragma unroll
            for (int q = 0; q < 4; ++q) { const int p = p0 + q * NGW; row[q] = (p < T * 4) ? loff[topi[p]] + pos[p] : -1; }
#pragma unroll
            for (int q = 0; q < 4; ++q) { const int p = p0 + q * NGW; if (row[q] >= 0) dv[q] = ((const GAS u32x4*)(H28 + (size_t)(p >> 2) * D))[F.lane]; }
#pragma unroll
            for (int q = 0; q < 4; ++q) { const int p = p0 + q * NGW; if (row[q] >= 0) { if (F.lane == 0) slot[p] = row[q]; ((GAS u32x4*)(HS8 + (size_t)row[q] * D))[F.lane] = dv[q]; } }
        }
    }
    SEAM(6);
    if (IN(7)) REP(7) {
        int k512 = D / 2; asm volatile("" : "+s"(k512));
        pg8::Gemm g{(const bf16*)HS8, (const bf16*)Wgu8, k512}; pg8::GroupOrder So{F.tbl + 36, F.tbl, 8, F.G, (int)blockIdx.x, 0}; So.nunits = __builtin_amdgcn_readfirstlane(F.tbl[36 + NE]) * 8;
        pg8::EpiSwiglu E{ACT8, b_gate, b_up};
        pg8::gemm_phase<pg8::EpiSwiglu, pg8::GroupOrder, true, FP8_SP2, true>(F.lds + RING_OFF, g, So, E);
    }
    SEAM(7);
    if (IN(8)) REP(8) {
        int k512 = D / 2; asm volatile("" : "+s"(k512));
        pg8::Gemm g{(const bf16*)ACT8, (const bf16*)Wd8, k512}; pg8::GroupOrder So{F.tbl + 36, F.tbl, 4, F.G, (int)blockIdx.x, 0}; So.nunits = __builtin_amdgcn_readfirstlane(F.tbl[36 + NE]) * 4;
        pg8::EpiDown E{YS, b_down};
        pg8::gemm_phase<pg8::EpiDown, pg8::GroupOrder, true, FP8_SP2, true>(F.lds + RING_OFF, g, So, E);
    }
    SEAM(8);
#ifdef MK_XBAR
    for (int xb_ = 0; xb_ < MK_XBAR; ++xb_) xcd_barrier(bar);
#endif
    if (IN(9)) REP(9) {
        const unsigned char* ys = YS;
        float* dst9 = (rep_ + 1 < 1 + ((MK_DUP >> 9) & 1)) ? (float*)(ws + WS_ACT) : out;
        for (int m0 = gw; m0 < T; m0 += 2 * NGW) {
            f32x4 v[2][4]; int sl[2][4]; float pr[2][4]; unsigned yv[2][4][4]; bool ok[2];
#pragma unroll
            for (int q = 0; q < 2; ++q) { const int m = m0 + q * NGW; ok[q] = m < T; const int mc = ok[q] ? m : m0; const GAS f32x4* xr = (const GAS f32x4*)(out + (size_t)mc * D) + F.lane;
#pragma unroll
                for (int j = 0; j < 4; ++j) v[q][j] = xr[64 * j];
#pragma unroll
                for (int k = 0; k < 4; ++k) { sl[q][k] = slot[mc * 4 + k]; pr[q][k] = topp[mc * 4 + k]; } }
#pragma unroll
            for (int q = 0; q < 2; ++q)
#pragma unroll
                for (int k = 0; k < 4; ++k) { const GAS unsigned* yr = (const GAS unsigned*)(ys + (size_t)sl[q][k] * D) + F.lane;
#pragma unroll
                    for (int j = 0; j < 4; ++j) yv[q][k][j] = yr[64 * j]; }
#pragma unroll
            for (int q = 0; q < 2; ++q) { if (!ok[q]) continue; const int m = m0 + q * NGW;
#pragma unroll
                for (int k = 0; k < 4; ++k) { const float p = pr[q][k];
#pragma unroll
                    for (int j = 0; j < 4; ++j) { const unsigned u = yv[q][k][j]; const f32x2 lo = __builtin_amdgcn_cvt_pk_f32_fp8(u, false), hi = __builtin_amdgcn_cvt_pk_f32_fp8(u, true);
                        v[q][j].x += p * lo.x; v[q][j].y += p * lo.y; v[q][j].z += p * hi.x; v[q][j].w += p * hi.y; } }
                float s = 0.f;
#pragma unroll
                for (int j = 0; j < 4; ++j) s += (v[q][j].x * v[q][j].x + v[q][j].y * v[q][j].y) + (v[q][j].z * v[q][j].z + v[q][j].w * v[q][j].w);
                const float rstd = 1.f / sqrtf(wave_sum(s) * (1.f / D) + EPS);
#pragma unroll
                for (int j = 0; j < 4; ++j) { const f32x4 gg = ((const GAS f32x4*)norm_final)[F.lane + 64 * j]; f32x4 y; y.x = v[q][j].x * rstd * gg.x; y.y = v[q][j].y * rstd * gg.y; y.z = v[q][j].z * rstd * gg.z; y.w = v[q][j].w * rstd * gg.w;
                    ((GAS f32x4*)(dst9 + (size_t)m * D) + F.lane)[64 * j] = y; } }
        }
    }
#ifdef MK_TSTAMP
    if (MK_TSTAMP == 9) ts_b = __builtin_amdgcn_s_memrealtime();
    if (blockIdx.x == 0) { const unsigned long long dt = ts_b - ts_a, t0_ = __builtin_amdgcn_s_memrealtime();
        while (__builtin_amdgcn_s_memrealtime() - t0_ < 2 * dt) __builtin_amdgcn_s_sleep(8); }
#endif
#undef IN
#undef SEAM
}

extern "C" void kernel_launch(void* const* d_in, const int* in_sizes, int n_in, void* d_out, int out_size, void* d_ws, size_t ws_size, hipStream_t stream) {
    static int grid = 0;
    if (grid == 0) {
        if (n_in != 19 || in_sizes[0] != T * D || out_size != T * D || ws_size < WS_END) { fprintf(stderr, "kernel_launch: unexpected shapes (n_in %d, ws %zu); nothing launched\n", n_in, ws_size); grid = -1; return; }
        int dev = 0, cus = 0, per_cu = 0;
        if (hipGetDevice(&dev) != hipSuccess || hipDeviceGetAttribute(&cus, hipDeviceAttributeMultiprocessorCount, dev) != hipSuccess) { grid = -1; return; }
        if (hipFuncSetAttribute((const void*)mk_fwd, hipFuncAttributeMaxDynamicSharedMemorySize, LDS_BYTES) != hipSuccess) { fprintf(stderr, "kernel_launch: hipFuncSetAttribute failed\n"); grid = -1; return; }
        if (hipOccupancyMaxActiveBlocksPerMultiprocessor(&per_cu, (const void*)mk_fwd, NWAVES * 64, LDS_BYTES) != hipSuccess || per_cu < 1) { fprintf(stderr, "kernel_launch: occupancy query says %d blocks per CU\n", per_cu); }
        (void)hipGetLastError();
        grid = cus;
        if (grid != 256) fprintf(stderr, "kernel_launch: %d CUs (built and tuned for 256)\n", grid);
    }
    if (grid < 0) return;
    if (hipMemsetAsync((char*)d_ws + WS_CTL, 0, CTL_ZERO_BYTES, stream) != hipSuccess) return;
    Args a{};
    for (int i = 0; i < 19; ++i) a.in[i] = (const float*)d_in[i];
    a.out = (float*)d_out; a.ws = (unsigned char*)d_ws;
#if MK_MODE == 2
    a.ph_lo = 0; a.ph_hi = NPHASE; a.li = 0;
    hipLaunchKernelGGL(mk_fwd, dim3(grid), dim3(NWAVES * 64), LDS_BYTES, stream, a);
#else
    for (int ph = 0; ph < NPHASE; ++ph) { a.ph_lo = ph; a.ph_hi = ph + 1; a.li = ph; hipLaunchKernelGGL(mk_fwd, dim3(grid), dim3(NWAVES * 64), LDS_BYTES, stream, a); }
#endif
}
```

```cpp
#define MK_DUP 0
#include <hip/hip_runtime.h>
#include <stdint.h>
#include <stdio.h>

#ifndef FP8_SP2
#define FP8_SP2 true
#endif
#ifndef MK_MODE
#define MK_MODE 2
#endif

typedef unsigned short bf16;
typedef short bf16x8 __attribute__((ext_vector_type(8)));
typedef float f32x4 __attribute__((ext_vector_type(4)));
typedef float f32x2 __attribute__((ext_vector_type(2)));
typedef unsigned u32x4 __attribute__((ext_vector_type(4)));
typedef unsigned u32x2 __attribute__((ext_vector_type(2)));
#define GAS __attribute__((address_space(1)))
#define LAS __attribute__((address_space(3)))
typedef GAS unsigned gu32;

constexpr int T = 16384, S = 8192, D = 1024, NPROJ = 5888, NQKV = 3840, NGATE = 2048, NE = 32, TOPK = 4;
constexpr int C_QA = 0, C_KA = 1024, C_VA = 1280, C_QB = 1536, C_KB = 2304, C_VB = 3072;
constexpr float EPS = 1e-5f;
constexpr size_t MiB = 1u << 20;
constexpr size_t WS_CTL = 0, CTL_ZERO_BYTES = 1 * MiB;
constexpr size_t WS_TAB = 1 * MiB;
constexpr size_t WS_WIN = 2 * MiB;
constexpr size_t WS_WA = 14 * MiB;
constexpr size_t WS_WB = 16 * MiB;
constexpr size_t WS_WOUT = 17 * MiB;
constexpr size_t WS_RT = 19 * MiB;
constexpr size_t WS_WGU = 24 * MiB;
constexpr size_t WS_WD = 88 * MiB;
constexpr size_t WS_H2 = 120 * MiB;
constexpr size_t WS_HS = 136 * MiB;
constexpr size_t WS_ACT = 201 * MiB;
constexpr size_t WS_YS = 272 * MiB;
constexpr size_t WS_XN = 216 * MiB;
constexpr size_t WS_QKV = 248 * MiB;
constexpr size_t WS_GATES = 368 * MiB;
constexpr size_t WS_YA = 432 * MiB;
constexpr size_t WS_YB = 464 * MiB;
constexpr size_t WS_MERGED = 472 * MiB;
constexpr size_t WS_VT = 472 * MiB;
constexpr size_t WS_END = 506 * MiB;
constexpr int CW_CNT = 0;
constexpr int CW_BAR = 4096;

__device__ const unsigned char BKT_A[257] = {12,12,12,12,12,12,12,12,12,12,12,12,12,12,12,12,12,12,12,12,12,12,12,12,12,12,12,12,12,12,12,12,12,12,12,12,12,12,11,11,11,11,11,11,11,11,11,11,11,11,11,11,11,11,11,11,11,11,11,11,11,11,11,11,11,11,11,11,11,11,11,11,11,11,11,11,11,11,11,10,10,10,10,10,10,10,10,10,10,10,10,10,10,10,10,10,10,10,10,10,10,10,9,9,9,9,9,9,9,9,9,9,9,9,8,8,8,8,8,8,8,7,6,5,4,3,2,1,0,17,18,19,20,21,22,23,24,24,24,24,24,24,24,25,25,25,25,25,25,25,25,25,25,25,25,26,26,26,26,26,26,26,26,26,26,26,26,26,26,26,26,26,26,26,26,26,26,26,27,27,27,27,27,27,27,27,27,27,27,27,27,27,27,27,27,27,27,27,27,27,27,27,27,27,27,27,27,27,27,27,27,27,27,27,27,27,27,27,27,28,28,28,28,28,28,28,28,28,28,28,28,28,28,28,28,28,28,28,28,28,28,28,28,28,28,28,28,28,28,28,28,28,28,28,28,28,28};
__device__ const unsigned char BKT_B[3][129] = {
 {11,11,11,11,11,11,11,11,11,11,11,11,11,11,11,10,10,10,10,10,10,10,10,10,10,10,10,10,10,10,10,10,10,10,10,10,10,10,9,9,9,9,9,9,9,9,9,9,9,9,8,8,8,8,8,8,8,7,6,5,4,3,2,1,0,17,18,19,20,21,22,23,24,24,24,24,24,24,24,25,25,25,25,25,25,25,25,25,25,25,25,26,26,26,26,26,26,26,26,26,26,26,26,26,26,26,26,26,26,26,26,26,26,26,27,27,27,27,27,27,27,27,27,27,27,27,27,27,27},
 {13,13,13,13,13,13,13,13,13,13,13,13,13,13,13,13,13,13,13,13,13,13,13,12,12,12,12,12,12,12,12,12,12,12,12,12,12,12,12,12,12,12,11,11,11,11,11,11,11,11,11,11,10,10,10,10,10,10,9,9,9,8,8,4,0,20,24,24,25,25,25,26,26,26,26,26,26,27,27,27,27,27,27,27,27,27,27,28,28,28,28,28,28,28,28,28,28,28,28,28,28,28,28,28,28,28,29,29,29,29,29,29,29,29,29,29,29,29,29,29,29,29,29,29,29,29,29,29,29},
 {15,15,15,15,15,15,15,15,15,15,15,15,15,15,15,15,15,15,15,15,15,15,15,15,15,15,15,15,15,15,14,14,14,14,14,14,14,14,14,14,14,14,14,14,14,13,13,13,13,13,13,13,13,13,12,12,12,12,12,11,11,10,10,9,0,25,26,26,27,27,28,28,28,28,28,29,29,29,29,29,29,29,29,29,30,30,30,30,30,30,30,30,30,30,30,30,30,30,30,31,31,31,31,31,31,31,31,31,31,31,31,31,31,31,31,31,31,31,31,31,31,31,31,31,31,31,31,31,31}};

#define RLX_AGENT __ATOMIC_RELAXED, __HIP_MEMORY_SCOPE_AGENT
#define LDS_WAIT() asm volatile("s_waitcnt lgkmcnt(0)" ::: "memory")
#define VM_WAIT() asm volatile("s_waitcnt vmcnt(0)" ::: "memory")
__device__ __forceinline__ unsigned f2bf(float f) { unsigned u = __builtin_bit_cast(unsigned, f); return (u + 0x7fffu + ((u >> 16) & 1u)) >> 16; }
__device__ __forceinline__ unsigned pk2(float lo, float hi) { return f2bf(lo) | (f2bf(hi) << 16); }
__device__ __forceinline__ unsigned pk4_fp8(float a, float b, float c, float d) { unsigned w = 0; w = __builtin_amdgcn_cvt_pk_fp8_f32(a, b, w, false); w = __builtin_amdgcn_cvt_pk_fp8_f32(c, d, w, true); return w; }
__device__ __forceinline__ float bf2f(unsigned b) { return __builtin_bit_cast(float, b << 16); }
__device__ __forceinline__ float bflo(unsigned u) { return __builtin_bit_cast(float, u << 16); }
__device__ __forceinline__ float bfhi(unsigned u) { return __builtin_bit_cast(float, u & 0xffff0000u); }
__device__ __forceinline__ float wave_sum(float v) {
#pragma unroll
    for (int o = 1; o < 64; o <<= 1) v += __shfl_xor(v, o);
    return v;
}
__device__ __forceinline__ float sigm(float x) { return __builtin_amdgcn_rcpf(1.f + __builtin_amdgcn_exp2f(-1.4426950408889634f * x)); }

struct Tabs { float biasA[16][257]; float biasB[3][4][129]; };

namespace pg8 {
#define PG8_LAS __attribute__((address_space(3)))
typedef unsigned short bf16_t;
constexpr int BM = 256, BK = 64, HALF = 128, HTB = HALF * BK * 2, STAGE_BYTES = 8 * HTB, NXCD = 8, WGM = 8;
__host__ __device__ __forceinline__ int lds_byte(int r, int c) { const int st = (r >> 4) * 2 + (c >> 5), rr = r & 15, cc = c & 31, ob = rr * 64 + cc * 2; return st * 1024 + (ob ^ (((ob >> 9) & 1) << 5)); }
__host__ __device__ __forceinline__ void stage_rc(int b, int& R, int& C) { const int st = b / 1024, sb = b % 1024, swz = sb ^ (((sb >> 9) & 1) << 5); R = (st >> 1) * 16 + swz / 64; C = (st & 1) * 32 + (swz % 64) / 2; }
__host__ __device__ __forceinline__ int perm32(int rho) { const int n = rho >> 4, i = rho & 15; return 8 * (i >> 2) + 4 * n + (i & 3); }

struct Unit { int arow, brow, nrows, e; };
struct Gemm { const bf16_t* A; const bf16_t* Bt; int K; };

struct StaticOrder {
    int nM, nN, nwg, G, c;
    __device__ void init(int M, int N, int G_, int c_) { nM = M / BM; nN = N / BM; nwg = nM * nN; G = G_; c = c_; }
    __device__ bool next(int i, Unit& u) const {
        const long L = (long)i * G + c; if (L >= nwg) return false;
        int wgid = (int)L; { const int q = nwg / NXCD, r = nwg % NXCD, xcd = wgid % NXCD, off = wgid / NXCD; wgid = (xcd < r ? xcd * (q + 1) : r * (q + 1) + (xcd - r) * q) + off; }
        const int nig = WGM * nN, gid = wgid / nig, fm = gid * WGM, gsz = (nM - fm) < WGM ? (nM - fm) : WGM;
        u.arow = BM * (fm + ((wgid % nig) % gsz)); u.brow = BM * ((wgid % nig) / gsz); u.nrows = BM; u.e = 0; return true;
    }
    __device__ __forceinline__ void a_ready(const Unit&) const {}
    __device__ __forceinline__ void done(const Unit&) const {}
};
struct GroupOrder {
    const PG8_LAS int* toff; const PG8_LAS int* off; int NT, G, c, nunits;
    __device__ bool next(int i, Unit& u) const {
        const int L = i * G + c; if (L >= nunits) return false;
        const int mtg = L / NT, pn = L - mtg * NT;
        int e = 0;
        for (int j = 1; j < NE; ++j) e += (toff[j] <= mtg) ? 1 : 0;
        e = __builtin_amdgcn_readfirstlane(e);
        const int mt = mtg - __builtin_amdgcn_readfirstlane(toff[e]); const int o0 = __builtin_amdgcn_readfirstlane(off[e]), o1 = __builtin_amdgcn_readfirstlane(off[e + 1]);
        u.arow = o0 + BM * mt; const int rem = o1 - u.arow; u.nrows = rem < BM ? rem : BM; u.brow = (e * NT + pn) * BM; u.e = e; return true;
    }
    __device__ __forceinline__ void a_ready(const Unit&) const {}
    __device__ __forceinline__ void done(const Unit&) const {}
};

__device__ __forceinline__ void st16_wt(void* p, u32x4 v) { asm volatile("global_store_dwordx4 %0, %1, off sc1\n\ts_nop 2" :: "v"(p), "v"(v) : "memory"); }
__device__ __forceinline__ void st8_wt(void* p, u32x2 v) { asm volatile("global_store_dwordx2 %0, %1, off sc1\n\ts_nop 2" :: "v"(p), "v"(v) : "memory"); }
__device__ __forceinline__ unsigned cvt_pk_bf16(float lo, float hi) { unsigned r; asm volatile("v_cvt_pk_bf16_f32 %0, %1, %2" : "=v"(r) : "v"(lo), "v"(hi)); return r; }

struct EpiProj {
    static constexpr bool PERM = true, AFTER_DRAIN = false; static constexpr int TAG = 1;
    bf16_t* qkv; bf16_t* gates; const float* bias; bf16_t* vta; bf16_t* vtb;
    __device__ __forceinline__ void prefetch(const Unit& u, PG8_LAS unsigned char* slot, int wid, int lane) const {
        if (wid == 0) __builtin_amdgcn_global_load_lds((const unsigned*)(bias + u.brow + 4 * lane), (PG8_LAS unsigned*)slot, 16, 0, 0); }
    __device__ __forceinline__ void operator()(const f32x4 (&acc)[2][2][4][2], const Unit& u, int wr, int wc, int fr, int fq, const PG8_LAS unsigned char* slot) const {
        const int colt = u.brow; const bool isq = colt < NQKV; bf16_t* base = isq ? qkv : gates; const int ldc = isq ? NQKV : NGATE; const int cb = isq ? colt : colt - NQKV;
        const int row0 = u.arow + wr * 64 + fr, col0 = cb + wc * 32 + 8 * fq, bcol0 = colt + wc * 32 + 8 * fq;
        f32x4 bv[2][2];
#pragma unroll
        for (int bj = 0; bj < 2; ++bj)
#pragma unroll
            for (int n = 0; n < 2; ++n) bv[bj][n] = *(const PG8_LAS f32x4*)(slot + (wc * 32 + 8 * fq + bj * HALF + 4 * n) * 4);
        const bool isv = (colt == C_VA) || (colt >= C_VB && colt < NQKV);
        const float qs = (colt < C_KA || (colt >= C_QB && colt < C_KB)) ? 0.125f * 1.4426950408889634f : 1.f;
        if (!isq) {
#pragma unroll
        for (int ai = 0; ai < 2; ++ai)
#pragma unroll
            for (int m = 0; m < 4; ++m) { unsigned char* rowp = (unsigned char*)gates + (size_t)(row0 + ai * HALF + m * 16) * NGATE + col0;
#pragma unroll
                for (int bj = 0; bj < 2; ++bj) { const f32x4 v0 = acc[ai][bj][m][0] + bv[bj][0], v1 = acc[ai][bj][m][1] + bv[bj][1];
                    u32x2 w; w.x = pk4_fp8(v0[0], v0[1], v0[2], v0[3]); w.y = pk4_fp8(v1[0], v1[1], v1[2], v1[3]); *(u32x2*)(rowp + bj * HALF) = w; } }
        } else if (!isv) {
#pragma unroll
        for (int ai = 0; ai < 2; ++ai)
#pragma unroll
            for (int m = 0; m < 4; ++m) { bf16_t* rowp = base + (size_t)(row0 + ai * HALF + m * 16) * ldc + col0;
#pragma unroll
                for (int bj = 0; bj < 2; ++bj) { const f32x4 v0 = (acc[ai][bj][m][0] + bv[bj][0]) * qs, v1 = (acc[ai][bj][m][1] + bv[bj][1]) * qs;
                    u32x4 w; w.x = cvt_pk_bf16(v0[0], v0[1]); w.y = cvt_pk_bf16(v0[2], v0[3]); w.z = cvt_pk_bf16(v1[0], v1[1]); w.w = cvt_pk_bf16(v1[2], v1[3]);
                    *(u32x4*)(rowp + bj * HALF) = w; } }
        } else {
            const int gsel = (colt == C_VA) ? -1 : ((colt - C_VB) >> 8); const int sh = (gsel <= 0) ? 0 : (gsel == 1 ? 2 : 4);
            bf16_t* vb = (gsel < 0) ? vta : vtb + (size_t)gsel * (2 * 256 * 8192); const int c0 = wc * 32 + 8 * fq;
#pragma unroll
            for (int ai = 0; ai < 2; ++ai)
#pragma unroll
                for (int m = 0; m < 4; ++m) { const int row = row0 + ai * HALF + m * 16, b = row >> 13, s = row & 8191; const int mu = s >> sh; const int pos = ((s & ((1 << sh) - 1)) << (13 - sh)) + (mu & ~31) + (((mu & 15) >> 2) << 3) + (((mu >> 4) & 1) << 2) + (mu & 3);
                    bf16_t* vp = vb + (size_t)(b * 256 + c0) * 8192 + pos;
#pragma unroll
                    for (int bj = 0; bj < 2; ++bj)
#pragma unroll
                        for (int n = 0; n < 2; ++n) { const f32x4 v = acc[ai][bj][m][n] + bv[bj][n]; const unsigned w0 = cvt_pk_bf16(v[0], v[1]), w1 = cvt_pk_bf16(v[2], v[3]);
                            bf16_t* q = vp + (size_t)(bj * HALF + 4 * n) * 8192;
                            q[0] = (bf16_t)(w0 & 0xffffu); q[8192] = (bf16_t)(w0 >> 16); q[2 * 8192] = (bf16_t)(w1 & 0xffffu); q[3 * 8192] = (bf16_t)(w1 >> 16); } }
        }
    }
};
template <int MODE> struct EpiGate {
    static constexpr bool PERM = true, AFTER_DRAIN = false; static constexpr int TAG = 3;
    bf16_t* out; const bf16_t* gates; int gcol0; unsigned char* out8;
    __device__ __forceinline__ void prefetch(const Unit&, PG8_LAS unsigned char*, int, int) const {}
    __device__ __forceinline__ void operator()(const f32x4 (&acc)[2][2][4][2], const Unit& u, int wr, int wc, int fr, int fq, const PG8_LAS unsigned char*) const {
        const int row0 = u.arow + wr * 64 + fr, col0 = u.brow + wc * 32 + 8 * fq;
        u32x2 gv[8][2];
#pragma unroll
        for (int gi = 0; gi < 4; ++gi) { const size_t r = (size_t)(row0 + (gi >> 2) * HALF + (gi & 3) * 16);
#pragma unroll
            for (int bj = 0; bj < 2; ++bj) gv[gi][bj] = *(const u32x2*)((const unsigned char*)gates + r * NGATE + gcol0 + col0 + bj * HALF); }
        u32x4 mv[2], mn[2];
        if (MODE == 1) {
#pragma unroll
            for (int bj = 0; bj < 2; ++bj) mv[bj] = *(const u32x4*)(out + (size_t)row0 * D + col0 + bj * HALF); }
#pragma unroll
        for (int gi = 0; gi < 8; ++gi) { const int ai = gi >> 2, m = gi & 3; const size_t r = (size_t)(row0 + ai * HALF + m * 16);
            if (gi == 1) {
#pragma unroll
                for (int g2 = 4; g2 < 8; ++g2) { const size_t r2 = (size_t)(row0 + (g2 >> 2) * HALF + (g2 & 3) * 16);
#pragma unroll
                    for (int bj = 0; bj < 2; ++bj) gv[g2][bj] = *(const u32x2*)((const unsigned char*)gates + r2 * NGATE + gcol0 + col0 + bj * HALF); } }
            if (MODE == 1 && gi + 1 < 8) { const size_t rn = (size_t)(row0 + ((gi + 1) >> 2) * HALF + ((gi + 1) & 3) * 16);
#pragma unroll
                for (int bj = 0; bj < 2; ++bj) mn[bj] = *(const u32x4*)(out + rn * D + col0 + bj * HALF); }
#pragma unroll
            for (int bj = 0; bj < 2; ++bj) { const int c = col0 + bj * HALF; const u32x2 g4 = gv[gi][bj]; const f32x4 a0 = acc[ai][bj][m][0], a1 = acc[ai][bj][m][1];
                const f32x2 ga = __builtin_amdgcn_cvt_pk_f32_fp8(g4.x, false), gb = __builtin_amdgcn_cvt_pk_f32_fp8(g4.x, true), gc = __builtin_amdgcn_cvt_pk_f32_fp8(g4.y, false), gd = __builtin_amdgcn_cvt_pk_f32_fp8(g4.y, true);
                float o[8]; o[0] = sigm(ga.x) * a0[0]; o[1] = sigm(ga.y) * a0[1]; o[2] = sigm(gb.x) * a0[2]; o[3] = sigm(gb.y) * a0[3];
                o[4] = sigm(gc.x) * a1[0]; o[5] = sigm(gc.y) * a1[1]; o[6] = sigm(gd.x) * a1[2]; o[7] = sigm(gd.y) * a1[3];
                if (MODE == 1) { const u32x4 m4 = mv[bj];
                    o[0] += bflo(m4.x); o[1] += bfhi(m4.x); o[2] += bflo(m4.y); o[3] += bfhi(m4.y); o[4] += bflo(m4.z); o[5] += bfhi(m4.z); o[6] += bflo(m4.w); o[7] += bfhi(m4.w); }
                if (MODE == 1) { u32x2 w8; w8.x = pk4_fp8(o[0], o[1], o[2], o[3]); w8.y = pk4_fp8(o[4], o[5], o[6], o[7]); *(u32x2*)(out8 + r * D + c) = w8; }
                else { u32x4 w; w.x = cvt_pk_bf16(o[0], o[1]); w.y = cvt_pk_bf16(o[2], o[3]); w.z = cvt_pk_bf16(o[4], o[5]); w.w = cvt_pk_bf16(o[6], o[7]);
                    *(u32x4*)(out + r * D + c) = w; } }
            asm volatile("" ::: "memory");
            if (MODE == 1) {
#pragma unroll
                for (int bj = 0; bj < 2; ++bj) mv[bj] = mn[bj]; } }
    }
};
struct EpiX1 {
    static constexpr bool PERM = true, AFTER_DRAIN = false; static constexpr int TAG = 4;
    const float* x; float* out;
    __device__ __forceinline__ void prefetch(const Unit&, PG8_LAS unsigned char*, int, int) const {}
    __device__ __forceinline__ void operator()(const f32x4 (&acc)[2][2][4][2], const Unit& u, int wr, int wc, int fr, int fq, const PG8_LAS unsigned char*) const {
        const int row0 = u.arow + wr * 64 + fr, col0 = u.brow + wc * 32 + 8 * fq;
        f32x4 xv[2][2], xn[2][2];
#pragma unroll
        for (int bj = 0; bj < 2; ++bj) { const size_t o = (size_t)row0 * D + col0 + bj * HALF; xv[bj][0] = *(const f32x4*)(x + o); xv[bj][1] = *(const f32x4*)(x + o + 4); }
#pragma unroll
        for (int gi = 0; gi < 8; ++gi) { const int ai = gi >> 2, m = gi & 3; const size_t r = (size_t)(row0 + ai * HALF + m * 16);
            if (gi + 1 < 8) { const size_t rn = (size_t)(row0 + ((gi + 1) >> 2) * HALF + ((gi + 1) & 3) * 16);
#pragma unroll
                for (int bj = 0; bj < 2; ++bj) { const size_t o = rn * D + col0 + bj * HALF; xn[bj][0] = *(const f32x4*)(x + o); xn[bj][1] = *(const f32x4*)(x + o + 4); } }
#pragma unroll
            for (int bj = 0; bj < 2; ++bj) { const size_t o = r * D + col0 + bj * HALF;
                *(f32x4*)(out + o) = xv[bj][0] + acc[ai][bj][m][0]; *(f32x4*)(out + o + 4) = xv[bj][1] + acc[ai][bj][m][1]; }
            asm volatile("" ::: "memory");
#pragma unroll
            for (int bj = 0; bj < 2; ++bj) { xv[bj][0] = xn[bj][0]; xv[bj][1] = xn[bj][1]; } }
    }
};
struct EpiSwiglu {
    static constexpr bool PERM = true, AFTER_DRAIN = false; static constexpr int TAG = 7;
    unsigned char* act; const float* bg; const float* bu;
    __device__ __forceinline__ void prefetch(const Unit& u, PG8_LAS unsigned char* slot, int wid, int lane) const {
        if (wid == 0) { const int pn = (u.brow >> 8) & 7; const float* src = ((lane < 32) ? bg : bu) + (size_t)u.e * D + pn * HALF + 4 * (lane & 31);
            __builtin_amdgcn_global_load_lds((const unsigned*)src, (PG8_LAS unsigned*)slot, 16, 0, 0); } }
    __device__ __forceinline__ void operator()(const f32x4 (&acc)[2][2][4][2], const Unit& u, int wr, int wc, int fr, int fq, const PG8_LAS unsigned char* slot) const {
        const int pn = (u.brow >> 8) & 7; const int col0 = pn * HALF + wc * 32 + 8 * fq; const int rl0 = wr * 64 + fr;
        const PG8_LAS f32x4* bl = (const PG8_LAS f32x4*)(slot + (wc * 32 + 8 * fq) * 4);
        const f32x4 g0 = bl[0], g1 = bl[1], u0 = bl[32], u1 = bl[33];
#pragma unroll
        for (int ai = 0; ai < 2; ++ai)
#pragma unroll
            for (int m = 0; m < 4; ++m) { const int rl = rl0 + ai * HALF + m * 16;
                const f32x4 ga = acc[ai][0][m][0] + g0, gb = acc[ai][0][m][1] + g1, ua = acc[ai][1][m][0] + u0, ub = acc[ai][1][m][1] + u1;
                float o[8];
#pragma unroll
                for (int j = 0; j < 4; ++j) { const float gt = fminf(ga[j], 7.f), up = fminf(fmaxf(ua[j], -7.f), 7.f); o[j] = gt * sigm(1.702f * gt) * (up + 1.f);
                    const float gt2 = fminf(gb[j], 7.f), up2 = fminf(fmaxf(ub[j], -7.f), 7.f); o[4 + j] = gt2 * sigm(1.702f * gt2) * (up2 + 1.f); }
                u32x2 w; w.x = pk4_fp8(o[0], o[1], o[2], o[3]); w.y = pk4_fp8(o[4], o[5], o[6], o[7]);
                if (rl < u.nrows) *(u32x2*)(act + (size_t)(u.arow + rl) * D + col0) = w; }
    }
};
struct EpiDown {
    static constexpr bool PERM = true, AFTER_DRAIN = false; static constexpr int TAG = 8;
    unsigned char* ys; const float* bd;
    __device__ __forceinline__ void prefetch(const Unit& u, PG8_LAS unsigned char* slot, int wid, int lane) const {
        if (wid == 0) { const int pn = (u.brow >> 8) & 3; __builtin_amdgcn_global_load_lds((const unsigned*)(bd + (size_t)u.e * D + pn * BM + 4 * lane), (PG8_LAS unsigned*)slot, 16, 0, 0); } }
    __device__ __forceinline__ void operator()(const f32x4 (&acc)[2][2][4][2], const Unit& u, int wr, int wc, int fr, int fq, const PG8_LAS unsigned char* slot) const {
        const int pn = (u.brow >> 8) & 3; const int col0 = pn * BM + wc * 32 + 8 * fq; const int rl0 = wr * 64 + fr;
        f32x4 bv[2][2];
#pragma unroll
        for (int bj = 0; bj < 2; ++bj)
#pragma unroll
            for (int n = 0; n < 2; ++n) bv[bj][n] = *(const PG8_LAS f32x4*)(slot + (wc * 32 + 8 * fq + bj * HALF + 4 * n) * 4);
#pragma unroll
        for (int ai = 0; ai < 2; ++ai)
#pragma unroll
            for (int m = 0; m < 4; ++m) { const int rl = rl0 + ai * HALF + m * 16; unsigned char* rowp = ys + (size_t)(u.arow + rl) * D + col0;
#pragma unroll
                for (int bj = 0; bj < 2; ++bj) { const f32x4 v0 = acc[ai][bj][m][0] + bv[bj][0], v1 = acc[ai][bj][m][1] + bv[bj][1];
                    u32x2 w; w.x = pk4_fp8(v0[0], v0[1], v0[2], v0[3]); w.y = pk4_fp8(v1[0], v1[1], v1[2], v1[3]);
                    if (rl < u.nrows) *(u32x2*)(rowp + bj * HALF) = w; } }
    }
};

typedef int i32x4_t __attribute__((ext_vector_type(4))); typedef int i32x8_t __attribute__((ext_vector_type(8)));
template <bool FP8> struct Frag;
template <> struct Frag<false> { bf16x8 v[2];
    __device__ __forceinline__ void ld(const PG8_LAS unsigned char* p) { v[0] = *(const PG8_LAS bf16x8*)p; v[1] = *(const PG8_LAS bf16x8*)(p + 1024); } };
template <> struct Frag<true> { i32x8_t v;
    __device__ __forceinline__ void ld(const PG8_LAS unsigned char* p) { const i32x4_t lo = *(const PG8_LAS i32x4_t*)p, hi = *(const PG8_LAS i32x4_t*)(p + 1024); v = __builtin_shufflevector(lo, hi, 0, 1, 2, 3, 4, 5, 6, 7); } };
__device__ __forceinline__ f32x4 mma_frag(const Frag<false>& w, const Frag<false>& x, f32x4 c) {
    c = __builtin_amdgcn_mfma_f32_16x16x32_bf16(w.v[0], x.v[0], c, 0, 0, 0); return __builtin_amdgcn_mfma_f32_16x16x32_bf16(w.v[1], x.v[1], c, 0, 0, 0); }
__device__ __forceinline__ f32x4 mma_frag(const Frag<true>& w, const Frag<true>& x, f32x4 c) {
    const int sa = 0x7A7A7A7A, sb = 0x7F7F7F7F;
    asm volatile("v_mfma_scale_f32_16x16x128_f8f6f4 %0, %1, %2, %0, %3, %4 op_sel_hi:[0,0,0]" : "+v"(c) : "v"(w.v), "v"(x.v), "v"(sa), "v"(sb));
    return c; }
template <class Epi, class Sched, bool ALIGN_EPI = false, bool SP2 = false, bool FP8 = false>
__device__ __forceinline__ void gemm_phase(PG8_LAS unsigned char* lds, const Gemm g, const Sched& S, const Epi& E) {
    const int tid = threadIdx.x, wid = __builtin_amdgcn_readfirstlane(tid >> 6), lane = tid & 63, wr = wid >> 2, wc = wid & 3, fr = lane & 15, fq = lane >> 4;
    const int K = g.K, nt = K / BK;
    unsigned voffA[2], voffB[2];
#pragma unroll
    for (int i = 0; i < 2; ++i) { int R, C; stage_rc(tid * 16 + i * 8192, R, C); const int Rb = Epi::PERM ? ((R & ~31) + perm32(R & 31)) : R;
        voffA[i] = (unsigned)(R * K + C) * 2u; voffB[i] = (unsigned)(Rb * K + C) * 2u; }
    const size_t kstep = (size_t)(BK * 2);
    const size_t hstep = (size_t)HALF * K * 2;
    const size_t rowb = (size_t)K * 2;
    const unsigned ldsw = (unsigned)wid * 1024u;
    const int aoff = lds_byte(wr * 64 + fr, fq * 8), boff = lds_byte(wc * 32 + fr, fq * 8);
#define PG8_SA(b, h) (((b) * 2 + (h)) * HTB)
#define PG8_SB(b, h) ((4 + (b) * 2 + (h)) * HTB)
#define PG8_STAGE(bufoff, gbase, voff) do { _Pragma("unroll") for (int _i = 0; _i < 2; ++_i) \
        __builtin_amdgcn_global_load_lds((const unsigned*)((const char*)(gbase) + (voff)[_i]), (PG8_LAS unsigned*)(lds + (bufoff) + ldsw + _i * 8192), 16, 0, 0); } while (0)
#define PG8_LDA(dst, b, h) do { _Pragma("unroll") for (int m = 0; m < 4; ++m) dst[m].ld(lds + PG8_SA(b, h) + aoff + m * 2048); } while (0)
#define PG8_LDB(dst, b, h) do { _Pragma("unroll") for (int n = 0; n < 2; ++n) dst[n].ld(lds + PG8_SB(b, h) + boff + n * 2048); } while (0)
#define PG8_MMA(ai, bj, At, Bt) do { __builtin_amdgcn_s_setprio(1); _Pragma("unroll") for (int m = 0; m < 4; ++m) _Pragma("unroll") for (int n = 0; n < 2; ++n) \
        acc[ai][bj][m][n] = mma_frag(Bt[n], At[m], acc[ai][bj][m][n]); __builtin_amdgcn_s_setprio(0); } while (0)
#define PG8_WAIT_V(n) asm volatile("s_waitcnt vmcnt(" #n ")" ::: "memory")
#define PG8_WAIT_L(n) asm volatile("s_waitcnt lgkmcnt(" #n ")" ::: "memory")
#define PG8_BAR __builtin_amdgcn_s_barrier()
#define PG8_SCHED __builtin_amdgcn_sched_barrier(0)
    Unit cur, nxt; int ui = 0;
    if (!S.next(0, cur)) return;
    f32x4 acc[2][2][4][2];
#pragma unroll
    for (int a = 0; a < 2; ++a)
#pragma unroll
        for (int b = 0; b < 2; ++b)
#pragma unroll
            for (int m = 0; m < 4; ++m)
#pragma unroll
                for (int n = 0; n < 2; ++n) acc[a][b][m][n] = (f32x4){0.f, 0.f, 0.f, 0.f};
    Frag<FP8> At[4], B0[2], B1[2];
    const char* cA = (const char*)g.A + (size_t)cur.arow * rowb; const char* cB = (const char*)g.Bt + (size_t)cur.brow * rowb;
    S.a_ready(cur);
    PG8_LAS unsigned char* const blds = lds + 131072 + 4096;
    E.prefetch(cur, blds, wid, lane);
    if constexpr (SP2) {
        PG8_STAGE(PG8_SB(0, 0), cB, voffB); PG8_STAGE(PG8_SB(0, 1), cB + hstep, voffB); PG8_STAGE(PG8_SA(0, 0), cA, voffA); PG8_STAGE(PG8_SA(0, 1), cA + hstep, voffA);
        if (wr == 1) PG8_BAR;
        PG8_WAIT_V(2); PG8_BAR;
        PG8_STAGE(PG8_SB(1, 0), cB + kstep, voffB); PG8_STAGE(PG8_SA(1, 0), cA + kstep, voffA); PG8_STAGE(PG8_SB(1, 1), cB + hstep + kstep, voffB);
        PG8_WAIT_V(6); PG8_BAR;
    } else {
        PG8_STAGE(PG8_SB(0, 0), cB, voffB); PG8_STAGE(PG8_SA(0, 0), cA, voffA); PG8_STAGE(PG8_SB(0, 1), cB + hstep, voffB); PG8_STAGE(PG8_SA(0, 1), cA + hstep, voffA);
        if (wr == 1) PG8_BAR;
        PG8_WAIT_V(4); PG8_BAR;
        PG8_STAGE(PG8_SB(1, 0), cB + kstep, voffB); PG8_STAGE(PG8_SA(1, 0), cA + kstep, voffA); PG8_STAGE(PG8_SB(1, 1), cB + hstep + kstep, voffB);
        PG8_WAIT_V(6); PG8_BAR;
    }
    for (;;) {
        const bool has_next = S.next(ui + 1, nxt);
        const char* nA = has_next ? (const char*)g.A + (size_t)nxt.arow * rowb : cA; const char* nB = has_next ? (const char*)g.Bt + (size_t)nxt.brow * rowb : cB;
        for (int t = 0; t < nt; t += 2) {
            const bool last = (t == nt - 2);
            const char* a1 = cA + (size_t)(t + 1) * kstep;
            const char* a2 = last ? nA : cA + (size_t)(t + 2) * kstep; const char* b2 = last ? nB : cB + (size_t)(t + 2) * kstep;
            const char* a3 = a2 + kstep; const char* b3 = b2 + kstep;
            if (last && has_next) { S.a_ready(nxt); E.prefetch(nxt, blds + (((ui + 1) & 1) << 10), wid, lane); }
            if constexpr (SP2) {
            PG8_LDB(B0, 0, 0); PG8_LDB(B1, 0, 1); PG8_SCHED; PG8_LDA(At, 0, 0); PG8_STAGE(PG8_SA(1, 1), a1 + hstep, voffA);
            PG8_WAIT_V(8); PG8_WAIT_L(0); PG8_BAR; PG8_MMA(0, 0, At, B0); PG8_MMA(0, 1, At, B1); PG8_BAR; PG8_SCHED;
            PG8_LDA(At, 0, 1); PG8_STAGE(PG8_SB(0, 0), b2, voffB); PG8_STAGE(PG8_SB(0, 1), b2 + hstep, voffB); PG8_STAGE(PG8_SA(0, 0), a2, voffA);
            PG8_WAIT_V(8); PG8_WAIT_L(0); PG8_BAR; PG8_MMA(1, 0, At, B0); PG8_MMA(1, 1, At, B1); PG8_BAR; PG8_SCHED;
            PG8_LDB(B0, 1, 0); PG8_LDB(B1, 1, 1); PG8_SCHED; PG8_LDA(At, 1, 0); PG8_STAGE(PG8_SA(0, 1), a2 + hstep, voffA);
            PG8_WAIT_V(8); PG8_WAIT_L(0); PG8_BAR; PG8_MMA(0, 0, At, B0); PG8_MMA(0, 1, At, B1); PG8_BAR; PG8_SCHED;
            PG8_LDA(At, 1, 1); PG8_STAGE(PG8_SB(1, 0), b3, voffB); PG8_STAGE(PG8_SB(1, 1), b3 + hstep, voffB); PG8_STAGE(PG8_SA(1, 0), a3, voffA);
            PG8_WAIT_V(8); PG8_WAIT_L(0); PG8_BAR; PG8_MMA(1, 0, At, B0); PG8_MMA(1, 1, At, B1); PG8_BAR; PG8_SCHED;
            } else {
            PG8_LDB(B0, 0, 0); PG8_SCHED; PG8_LDA(At, 0, 0); PG8_STAGE(PG8_SA(1, 1), a1 + hstep, voffA);
            PG8_WAIT_L(8); PG8_BAR; PG8_WAIT_L(0); PG8_MMA(0, 0, At, B0); PG8_BAR; PG8_SCHED;
            PG8_LDB(B1, 0, 1); PG8_STAGE(PG8_SB(0, 0), b2, voffB);
            PG8_BAR; PG8_WAIT_L(0); PG8_MMA(0, 1, At, B1); PG8_BAR;
            PG8_LDA(At, 0, 1); PG8_STAGE(PG8_SA(0, 0), a2, voffA);
            PG8_BAR; PG8_WAIT_L(0); PG8_MMA(1, 0, At, B0); PG8_BAR; PG8_SCHED;
            PG8_STAGE(PG8_SB(0, 1), b2 + hstep, voffB);
            PG8_WAIT_V(6); PG8_BAR; PG8_MMA(1, 1, At, B1); PG8_BAR;
            PG8_LDB(B0, 1, 0); PG8_SCHED; PG8_LDA(At, 1, 0); PG8_STAGE(PG8_SA(0, 1), a2 + hstep, voffA);
            PG8_WAIT_L(8); PG8_BAR; PG8_WAIT_L(0); PG8_MMA(0, 0, At, B0); PG8_BAR; PG8_SCHED;
            PG8_LDB(B1, 1, 1); PG8_STAGE(PG8_SB(1, 0), b3, voffB);
            PG8_BAR; PG8_WAIT_L(0); PG8_MMA(0, 1, At, B1); PG8_BAR;
            PG8_LDA(At, 1, 1); PG8_STAGE(PG8_SA(1, 0), a3, voffA);
            PG8_BAR; PG8_WAIT_L(0); PG8_MMA(1, 0, At, B0); PG8_BAR; PG8_SCHED;
            PG8_STAGE(PG8_SB(1, 1), b3 + hstep, voffB);
            PG8_WAIT_V(6); PG8_BAR; PG8_MMA(1, 1, At, B1); PG8_BAR;
            }
        }
        if constexpr (ALIGN_EPI) { if (wr == 0) PG8_BAR; }
        if constexpr (FP8) {
#define PG8_ACC8(a, b) "+v"(acc[a][b][0][0]), "+v"(acc[a][b][0][1]), "+v"(acc[a][b][1][0]), "+v"(acc[a][b][1][1]), "+v"(acc[a][b][2][0]), "+v"(acc[a][b][2][1]), "+v"(acc[a][b][3][0]), "+v"(acc[a][b][3][1])
            asm volatile("s_nop 15\n\ts_nop 15" : PG8_ACC8(0, 0), PG8_ACC8(0, 1) :: "memory");
            asm volatile("" : PG8_ACC8(1, 0), PG8_ACC8(1, 1) :: "memory");
#undef PG8_ACC8
        }
#ifdef MK_EPI2
        if constexpr (Epi::TAG == MK_EPI2) { E(acc, cur, wr, wc, fr, fq, blds + ((ui & 1) << 10)); asm volatile("" ::: "memory"); }
#endif
        if constexpr (!Epi::AFTER_DRAIN) { E(acc, cur, wr, wc, fr, fq, blds + ((ui & 1) << 10)); S.done(cur); }
        if (!has_next) break;
#pragma unroll
        for (int a = 0; a < 2; ++a)
#pragma unroll
            for (int b = 0; b < 2; ++b)
#pragma unroll
                for (int m = 0; m < 4; ++m)
#pragma unroll
                    for (int n = 0; n < 2; ++n) acc[a][b][m][n] = (f32x4){0.f, 0.f, 0.f, 0.f};
        cur = nxt; cA = nA; cB = nB; ++ui;
        if constexpr (ALIGN_EPI) { if (wr == 1) PG8_BAR; }
    }
    PG8_WAIT_V(0);
    if constexpr (!ALIGN_EPI) { if (wr == 0) PG8_BAR; }
    PG8_BAR;
    if constexpr (Epi::AFTER_DRAIN) { E.fused(acc, cur, wr, wc, fr, fq, lds, wid, lane); S.done(cur); }
#undef PG8_SA
#undef PG8_SB
#undef PG8_STAGE
#undef PG8_LDA
#undef PG8_LDB
#undef PG8_MMA
#undef PG8_WAIT_V
#undef PG8_WAIT_L
#undef PG8_BAR
#undef PG8_SCHED
}

}

#define XB_TMO      128
#define XB_XCNT(j)  (256  + 64 * (j))
#define XB_XSUB(j)  (1280 + 64 * (j))
#define XB_XGEN(j)  (2304 + 64 * (j))
#define XB_TOP      3328
#define XB_TOPGEN   3392
#define XCD_BAR_WORDS 3456
#define XB_SPIN_CAP (1u << 18)
__device__ __forceinline__ unsigned xb_ld(unsigned* p)              { return __hip_atomic_load(p, __ATOMIC_RELAXED, __HIP_MEMORY_SCOPE_AGENT); }
__device__ __forceinline__ unsigned xb_add(unsigned* p, unsigned v) { return __hip_atomic_fetch_add(p, v, __ATOMIC_RELAXED, __HIP_MEMORY_SCOPE_AGENT); }
__device__ __forceinline__ unsigned xb_xcc_id() { return (unsigned)__builtin_amdgcn_s_getreg((3 << 11) | 20) & 0xFu; }
#define XB_SPIN(cond, bar) do { unsigned _sp = 0; while (cond) { __builtin_amdgcn_s_sleep(1); \
    if ((++_sp & 255u) == 0u) { if (xb_ld(&(bar)[XB_TMO])) break; if (_sp > XB_SPIN_CAP) { atomicAdd(&(bar)[XB_TMO], 1u); break; } } } } while (0)
struct XcdBarrier { unsigned* bar; unsigned x; volatile LAS unsigned* st; };
__device__ __forceinline__ XcdBarrier xcd_barrier_post(unsigned* bar, volatile LAS unsigned* st) {
    XcdBarrier b; b.bar = bar; b.x = xb_xcc_id(); b.st = st;
    if (threadIdx.x == 0) (void)xb_add(&bar[XB_XCNT(b.x)], 1u);
    return b;
}
__device__ __forceinline__ void xcd_barrier_complete(unsigned* bar, unsigned x, unsigned& nloc, unsigned& nx) {
    const unsigned G = gridDim.x * gridDim.y * gridDim.z;
    unsigned sum, cnt, mine, sp = 0u;
    for (;;) {
        sum = 0u; cnt = 0u; mine = 0u;
#pragma unroll
        for (unsigned j = 0; j < 16; ++j) { const unsigned c = xb_ld(&bar[XB_XCNT(j)]); sum += c; cnt += (c > 0u) ? 1u : 0u; mine = (j == x) ? c : mine; }
        if (sum == G) break;
        __builtin_amdgcn_s_sleep(1);
        if ((++sp & 255u) == 0u) { if (xb_ld(&bar[XB_TMO])) break; if (sp > XB_SPIN_CAP) { atomicAdd(&bar[XB_TMO], 1u); break; } }
    }
    nloc = mine > 0u ? mine : 1u; nx = cnt > 0u ? cnt : 1u;
}
__device__ __forceinline__ void xcd_barrier(const XcdBarrier& b) {
    asm volatile("s_waitcnt vmcnt(0)" ::: "memory");
    __syncthreads();
    if (threadIdx.x == 0) {
        unsigned* bar = b.bar;
        __builtin_amdgcn_s_waitcnt(0);
        unsigned nloc = b.st[0], nx = b.st[1];
        if (nloc == 0u) { xcd_barrier_complete(bar, b.x, nloc, nx); b.st[0] = nloc; b.st[1] = nx; }
        const unsigned old = xb_add(&bar[XB_XSUB(b.x)], 1u);
        const unsigned gen = old / nloc;
        if (old + 1u == (gen + 1u) * nloc) {
            __builtin_amdgcn_fence(__ATOMIC_RELEASE, "agent");
            asm volatile("s_waitcnt vmcnt(0)" ::: "memory");
            const unsigned og = xb_add(&bar[XB_TOP], 1u);
            const unsigned tg = og / nx;
            if (og + 1u == (tg + 1u) * nx) xb_add(&bar[XB_TOPGEN], 1u);
            else XB_SPIN(xb_ld(&bar[XB_TOPGEN]) == tg, bar);
            __builtin_amdgcn_fence(__ATOMIC_ACQUIRE, "agent");
            xb_add(&bar[XB_XGEN(b.x)], 1u);
            asm volatile("s_waitcnt vmcnt(0)" ::: "memory");
        } else {
            XB_SPIN(xb_ld(&bar[XB_XGEN(b.x)]) == gen, bar);
            __builtin_amdgcn_fence(__ATOMIC_ACQUIRE, "agent");
            asm volatile("s_waitcnt vmcnt(0)" ::: "memory");
        }
    }
    __syncthreads();
}

constexpr int NWAVES = 8;
constexpr int RING_OFF = 0, RING_BYTES = 131072;
constexpr int LDSCTL_OFF = RING_BYTES, MISC_OFF = LDSCTL_OFF + 320;
constexpr int TBL_OFF = LDSCTL_OFF + 1024;
constexpr int LDS_BYTES = 147456;

struct Frame {
    LAS unsigned char* lds; volatile LAS unsigned* MISC; LAS int* tbl; gu32* ctl;
    int tid, lane, wave, vcu, G;
};

__device__ __forceinline__ void p0_transpose_item(const float* W, int K, int N, bf16* WT, int k0, int n0, int orow0, LAS float* scr, int lane) {
#pragma unroll 8
    for (int i = 0; i < 32; ++i) { const int kk = 2 * i + (lane >> 5); scr[kk * 33 + (lane & 31)] = W[(size_t)(k0 + kk) * N + n0 + (lane & 31)]; }
    LDS_WAIT(); asm volatile("" ::: "memory");
    const int c = lane & 7;
#pragma unroll
    for (int j = 0; j < 4; ++j) { const int n = (lane >> 3) + 8 * j; const LAS float* s = scr + (8 * c) * 33 + n;
        u32x4 o; o.x = pk2(s[0 * 33], s[1 * 33]); o.y = pk2(s[2 * 33], s[3 * 33]); o.z = pk2(s[4 * 33], s[5 * 33]); o.w = pk2(s[6 * 33], s[7 * 33]);
        *(GAS u32x4*)(WT + (size_t)(orow0 + n) * K + k0 + 8 * c) = o; }
    LDS_WAIT(); asm volatile("" ::: "memory");
}
__device__ __forceinline__ void p0_transpose_item_fp8(const float* W, int K, int N, unsigned char* WT, int k0, int n0, int orow0, LAS float* scr, int lane) {
#pragma unroll 8
    for (int i = 0; i < 32; ++i) { const int kk = 2 * i + (lane >> 5); scr[kk * 33 + (lane & 31)] = W[(size_t)(k0 + kk) * N + n0 + (lane & 31)]; }
    LDS_WAIT(); asm volatile("" ::: "memory");
    const int c = lane & 7;
#pragma unroll
    for (int j = 0; j < 4; ++j) { const int n = (lane >> 3) + 8 * j; const LAS float* sp = scr + (8 * c) * 33 + n;
        u32x2 o; o.x = pk4_fp8(sp[0 * 33] * 32.f, sp[1 * 33] * 32.f, sp[2 * 33] * 32.f, sp[3 * 33] * 32.f); o.y = pk4_fp8(sp[4 * 33] * 32.f, sp[5 * 33] * 32.f, sp[6 * 33] * 32.f, sp[7 * 33] * 32.f);
        *(GAS u32x2*)(WT + (size_t)(orow0 + n) * K + k0 + 8 * c) = o; }
    LDS_WAIT(); asm volatile("" ::: "memory");
}
__device__ __forceinline__ void rms_row_to_bf16(const float* xrow, const float* g, bf16* orow, int lane) {
    const GAS f32x4* xr = (const GAS f32x4*)xrow + lane; f32x4 v[4]; float s = 0.f;
#pragma unroll
    for (int j = 0; j < 4; ++j) { v[j] = xr[64 * j]; s += (v[j].x * v[j].x + v[j].y * v[j].y) + (v[j].z * v[j].z + v[j].w * v[j].w); }
    const float rstd = 1.f / sqrtf(wave_sum(s) * (1.f / D) + EPS);
    GAS unsigned long long* o8 = (GAS unsigned long long*)orow + lane;
#pragma unroll
    for (int j = 0; j < 4; ++j) { const f32x4 gg = ((const GAS f32x4*)g)[lane + 64 * j];
        o8[64 * j] = (unsigned long long)pk2(v[j].x * rstd * gg.x, v[j].y * rstd * gg.y) | ((unsigned long long)pk2(v[j].z * rstd * gg.z, v[j].w * rstd * gg.w) << 32); }
}

__device__ __forceinline__ void rms_row_to_fp8(const float* xrow, const float* g, unsigned char* orow, int lane) {
    const GAS f32x4* xr = (const GAS f32x4*)xrow + lane; f32x4 v[4]; float s = 0.f;
#pragma unroll
    for (int j = 0; j < 4; ++j) { v[j] = xr[64 * j]; s += (v[j].x * v[j].x + v[j].y * v[j].y) + (v[j].z * v[j].z + v[j].w * v[j].w); }
    const float rstd = 1.f / sqrtf(wave_sum(s) * (1.f / D) + EPS);
    GAS unsigned* o4 = (GAS unsigned*)orow + lane;
#pragma unroll
    for (int j = 0; j < 4; ++j) { const f32x4 gg = ((const GAS f32x4*)g)[lane + 64 * j]; o4[64 * j] = pk4_fp8(v[j].x * rstd * gg.x, v[j].y * rstd * gg.y, v[j].z * rstd * gg.z, v[j].w * rstd * gg.w); }
}
constexpr float LOG2E = 1.4426950408889634f;
typedef __bf16 bf16x2_t __attribute__((ext_vector_type(2)));
__device__ __forceinline__ unsigned cvtpk_v(float lo, float hi) { const f32x2 v = {lo, hi}; const bf16x2_t b = __builtin_convertvector(v, bf16x2_t); return __builtin_bit_cast(unsigned, b); }
struct AttFrags { bf16x8 k0a, k0b, k1a, k1b, v[4]; };
__device__ __forceinline__ float gmax4(float m) {
    { auto rr = __builtin_amdgcn_permlane16_swap(__float_as_uint(m), __float_as_uint(m), false, false); m = fmaxf(__uint_as_float(rr[0]), __uint_as_float(rr[1])); }
    { auto rr = __builtin_amdgcn_permlane32_swap(__float_as_uint(m), __float_as_uint(m), false, false); m = fmaxf(__uint_as_float(rr[0]), __uint_as_float(rr[1])); }
    return m;
}
constexpr int RB_A = 160, RB_B = 320;
template <int NH, int RB>
__device__ __forceinline__ void band_group(f32x4 (&o)[NH][4], float (&mrun)[NH], float (&lrun)[NH], const bf16* qkvb, const int (&qcol)[NH], const int (&qmu0)[NH], int kcol, const bf16* vt,
                                           int dil, int rho, int L, int qstep, int P0, int npairs, const LAS float* const (&tab)[NH], int lane) {
    const int t = lane & 15, g = lane >> 4;
    bf16x8 qf[NH][2]; int mu_t[NH];
#pragma unroll
    for (int h = 0; h < NH; ++h) { mu_t[h] = qmu0[h] + qstep * t; const bf16* qrow = qkvb + (size_t)(mu_t[h] * dil + rho) * NQKV + 8 * g + qcol[h];
        qf[h][0] = *(const bf16x8*)qrow; qf[h][1] = *(const bf16x8*)(qrow + 32); }
    const int npr = L >> 5;
    const bf16* kbase = qkvb + (size_t)rho * NQKV + kcol + 8 * g;
    const bf16* vtl = vt + (size_t)t * 8192 + (size_t)rho * L + 8 * g;
    auto load = [&](int P, AttFrags& f) {
        const int Pc = min(max(P, 0), npr - 1);
        const bf16* k0p = kbase + (size_t)((32 * Pc + t) * dil) * NQKV; const bf16* k1p = k0p + (size_t)(16 * dil) * NQKV;
        f.k0a = *(const bf16x8*)k0p; f.k0b = *(const bf16x8*)(k0p + 32); f.k1a = *(const bf16x8*)k1p; f.k1b = *(const bf16x8*)(k1p + 32);
#pragma unroll
        for (int db = 0; db < 4; ++db) f.v[db] = *(const bf16x8*)(vtl + (size_t)(16 * db) * 8192 + 32 * Pc);
    };
    AttFrags cur; load(P0, cur);
    for (int pp = 0; pp < npairs; ++pp) {
        const int P = P0 + pp;
        AttFrags nxt; load(P0 + min(pp + 1, npairs - 1), nxt);
        if (P >= 0 && P < npr) {
            const int kap0 = 32 * P + 4 * g;
#pragma unroll
            for (int h = 0; h < NH; ++h) {
                const LAS float* tb_ = tab[h] + (kap0 - mu_t[h] + RB);
                f32x4 s0 = (f32x4){tb_[0], tb_[1], tb_[2], tb_[3]}, s1 = (f32x4){tb_[16], tb_[17], tb_[18], tb_[19]};
                s0 = __builtin_amdgcn_mfma_f32_16x16x32_bf16(cur.k0a, qf[h][0], s0, 0, 0, 0); s0 = __builtin_amdgcn_mfma_f32_16x16x32_bf16(cur.k0b, qf[h][1], s0, 0, 0, 0);
                s1 = __builtin_amdgcn_mfma_f32_16x16x32_bf16(cur.k1a, qf[h][0], s1, 0, 0, 0); s1 = __builtin_amdgcn_mfma_f32_16x16x32_bf16(cur.k1b, qf[h][1], s1, 0, 0, 0);
                float mx = fmaxf(fmaxf(fmaxf(s0[0], s0[1]), fmaxf(s0[2], s0[3])), fmaxf(fmaxf(s1[0], s1[1]), fmaxf(s1[2], s1[3])));
                mx = gmax4(mx);
                if (__any(mx > mrun[h])) { const float mn = fmaxf(mrun[h], mx), alpha = __builtin_amdgcn_exp2f(mrun[h] - mn); mrun[h] = mn; lrun[h] *= alpha;
#pragma unroll
                    for (int db = 0; db < 4; ++db) o[h][db] = o[h][db] * alpha; }
                const float mn = mrun[h]; float p[8], ps = 0.f;
#pragma unroll
                for (int j = 0; j < 8; ++j) { p[j] = __builtin_amdgcn_exp2f(((j < 4) ? s0[j & 3] : s1[j & 3]) - mn); ps += p[j]; }
                lrun[h] += ps;
                u32x4 pw; pw.x = cvtpk_v(p[0], p[1]); pw.y = cvtpk_v(p[2], p[3]); pw.z = cvtpk_v(p[4], p[5]); pw.w = cvtpk_v(p[6], p[7]);
                const bf16x8 pf = __builtin_bit_cast(bf16x8, pw);
#pragma unroll
                for (int db = 0; db < 4; ++db) o[h][db] = __builtin_amdgcn_mfma_f32_16x16x32_bf16(cur.v[db], pf, o[h][db], 0, 0, 0);
                if (NH > 2 && h + 1 < NH) __builtin_amdgcn_sched_barrier(0);
            }
        }
        cur = nxt;
    }
}
template <int NH>
__device__ __forceinline__ void band_store(const f32x4 (&o)[NH][4], const float (&lrun)[NH], unsigned char* const (&yrow)[NH], int lane) {
    const int g = lane >> 4;
#pragma unroll
    for (int h = 0; h < NH; ++h) { float l = lrun[h]; l += __shfl_xor(l, 16); l += __shfl_xor(l, 32); const float inv = 1.f / l;
#pragma unroll
        for (int db = 0; db < 4; ++db) *(unsigned*)(yrow[h] + 16 * db + 4 * g) = pk4_fp8(o[h][db][0] * inv, o[h][db][1] * inv, o[h][db][2] * inv, o[h][db][3] * inv); }
}

struct Args { const float* in[19]; float* out; unsigned char* ws; int ph_lo, ph_hi, li, pad; };
constexpr int NPHASE = 10;

__global__ void __launch_bounds__(NWAVES * 64, 2) mk_fwd(Args args) {
    extern __shared__ __attribute__((aligned(16))) unsigned char lds[];
    Frame F;
    F.lds = (LAS unsigned char*)lds; F.MISC = (volatile LAS unsigned*)(F.lds + MISC_OFF); F.tbl = (LAS int*)(F.lds + TBL_OFF);
    F.tid = threadIdx.x; F.lane = F.tid & 63; F.wave = __builtin_amdgcn_readfirstlane(F.tid >> 6);
    F.G = gridDim.x; { const int bx = blockIdx.x; F.vcu = (F.G % 8 == 0) ? (bx % 8) * (F.G / 8) + bx / 8 : bx; }
    unsigned char* ws = args.ws; F.ctl = (gu32*)(ws + WS_CTL);
    const float* x = args.in[0]; const float* norm_mix = args.in[1]; const float* w_in = args.in[2]; const float* b_in = args.in[3];
    const float* sinks = args.in[4]; const float* rel_bias = args.in[5]; const float* w_a = args.in[6]; const float* w_b = args.in[7];
    const float* w_out = args.in[8]; const float* norm_ffn = args.in[9]; const float* router_w = args.in[10]; const float* router_b = args.in[11];
    const float* w_gate = args.in[12]; const float* b_gate = args.in[13]; const float* w_up = args.in[14]; const float* b_up = args.in[15];
    const float* w_down = args.in[16]; const float* b_down = args.in[17]; const float* norm_final = args.in[18];
    float* out = args.out;
    Tabs* tb = (Tabs*)(ws + WS_TAB);
    bf16* Win_t = (bf16*)(ws + WS_WIN); bf16* Wa_t = (bf16*)(ws + WS_WA); bf16* Wb_t = (bf16*)(ws + WS_WB); bf16* Wout_t = (bf16*)(ws + WS_WOUT);
    unsigned char* Wgu8 = ws + WS_WGU; unsigned char* Wd8 = ws + WS_WD; unsigned char* H28 = ws + WS_H2; unsigned char* HS8 = ws + WS_HS; unsigned char* ACT8 = ws + WS_ACT; unsigned char* YS = ws + WS_YS;
    int* topi = (int*)(ws + WS_RT); float* topp = (float*)(ws + WS_RT + 256 * 1024); int* slot = (int*)(ws + WS_RT + 512 * 1024); int* pos = (int*)(ws + WS_RT + 768 * 1024);
    bf16* XN = (bf16*)(ws + WS_XN); bf16* QKV = (bf16*)(ws + WS_QKV); bf16* GATES = (bf16*)(ws + WS_GATES); bf16* YA = (bf16*)(ws + WS_YA); bf16* YB = (bf16*)(ws + WS_YB);
    bf16* MERGED = (bf16*)(ws + WS_MERGED);
    gu32* cnt = F.ctl + CW_CNT;

    for (int u = F.tid; u < (LDS_BYTES - LDSCTL_OFF) / 4; u += NWAVES * 64) ((LAS unsigned*)(F.lds + LDSCTL_OFF))[u] = 0u;
    __syncthreads();
    XcdBarrier bar = xcd_barrier_post((unsigned*)(F.ctl + CW_BAR) + args.li * XCD_BAR_WORDS, F.MISC + 8);
    const int lo = args.ph_lo, hi = args.ph_hi;
#ifndef MK_SKIP
#define MK_SKIP 0
#endif
#define IN(k) (!((MK_SKIP >> (k)) & 1) && lo <= (k) && (k) < hi)
#ifndef MK_DUP
#define MK_DUP 0
#endif
#define REP(k) _Pragma("unroll") for (int rep_ = 0; rep_ < 1 + ((MK_DUP >> (k)) & 1); ++rep_)
#ifdef MK_TSTAMP
    unsigned long long ts_a = __builtin_amdgcn_s_memrealtime(), ts_b = ts_a;
#define SEAM(k) do { if (IN(k) && IN((k) + 1)) xcd_barrier(bar); if ((k) + 1 == MK_TSTAMP) ts_a = __builtin_amdgcn_s_memrealtime(); if ((k) == MK_TSTAMP) ts_b = __builtin_amdgcn_s_memrealtime(); } while (0)
#else
#define SEAM(k) do { if (IN(k) && IN((k) + 1)) xcd_barrier(bar); } while (0)
#endif
    const int gw = F.vcu * NWAVES + F.wave, NGW = F.G * NWAVES;

    LAS float* scr = (LAS float*)(F.lds + RING_OFF + F.wave * 16384);
    constexpr int I_IN = (D / 64) * (NPROJ / 32), I_A = (D / 64) * (D / 32), I_B = (256 / 64) * (D / 32), I_E = (D / 64) * (D / 32);
    constexpr int NITEMS = I_IN + 2 * I_A + I_B + 3 * NE * I_E;
    auto transpose_items = [&](int first, int last) {
    for (int it = first + gw; it < last; it += NGW) {
        int r = it;
        if (r < I_IN) { const int nb = NPROJ / 32; p0_transpose_item_fp8(w_in, D, NPROJ, (unsigned char*)Win_t, 64 * (r / nb), 32 * (r % nb), 32 * (r % nb), scr, F.lane); continue; } r -= I_IN;
        if (r < I_A) { const int nb = D / 32; p0_transpose_item_fp8(w_a, D, D, (unsigned char*)Wa_t, 64 * (r / nb), 32 * (r % nb), 32 * (r % nb), scr, F.lane); continue; } r -= I_A;
        if (r < I_A) { const int nb = D / 32; p0_transpose_item_fp8(w_out, D, D, (unsigned char*)Wout_t, 64 * (r / nb), 32 * (r % nb), 32 * (r % nb), scr, F.lane); continue; } r -= I_A;
        if (r < I_B) { const int nb = D / 32; p0_transpose_item_fp8(w_b, 256, D, (unsigned char*)Wb_t, 64 * (r / nb), 32 * (r % nb), 32 * (r % nb), scr, F.lane); continue; } r -= I_B;
        { const int e = r / (3 * I_E), q = r % (3 * I_E), which = q / I_E, ii = q % I_E, nb = D / 32, k0 = 64 * (ii / nb), n0 = 32 * (ii % nb);
          if (which == 0) p0_transpose_item_fp8(w_gate + (size_t)e * D * D, D, D, Wgu8, k0, n0, e * 2048 + (n0 >> 7) * 256 + (n0 & 127), scr, F.lane);
          else if (which == 1) p0_transpose_item_fp8(w_up + (size_t)e * D * D, D, D, Wgu8, k0, n0, e * 2048 + (n0 >> 7) * 256 + 128 + (n0 & 127), scr, F.lane);
          else p0_transpose_item_fp8(w_down + (size_t)e * D * D, D, D, Wd8, k0, n0, e * 1024 + n0, scr, F.lane); }
    }
    };
    if (IN(0)) REP(0) {
        { const int i = blockIdx.x * (NWAVES * 64) + F.tid;
          if (i < 16 * 257) { const int h = i / 257, r = i % 257; tb->biasA[h][r] = rel_bias[BKT_A[r] * 28 + h]; }
          if (i < 12 * 129) { const int g = i / (4 * 129), hs = (i / 129) % 4, r = i % 129; tb->biasB[g][hs][r] = rel_bias[BKT_B[g][r] * 28 + 16 + 4 * g + hs]; } }
        transpose_items(0, I_IN + 2 * I_A + I_B);
        for (int m = gw; m < T; m += NGW) rms_row_to_fp8(x + (size_t)m * D, norm_mix, (unsigned char*)XN + (size_t)m * D, F.lane);
    }
    SEAM(0);
    if (IN(1)) REP(1) {
        int k512 = D / 2; asm volatile("" : "+s"(k512));
        pg8::Gemm g{XN, Win_t, k512}; pg8::StaticOrder So; So.init(T, NPROJ, F.G, (int)blockIdx.x);
        pg8::EpiProj E{QKV, GATES, b_in, (bf16*)(ws + WS_VT), (bf16*)(ws + WS_VT) + (size_t)2 * 4 * 64 * 8192};
        pg8::gemm_phase<pg8::EpiProj, pg8::StaticOrder, true, true, true>(F.lds + RING_OFF, g, So, E);
    }
    SEAM(1);
    int nrep2 = 1 + ((MK_DUP >> 2) & 1); asm volatile("" : "+s"(nrep2));
    if (IN(2)) for (int rep_ = 0; rep_ < nrep2; ++rep_) {
        LAS float* lb = (LAS float*)(F.lds + RING_OFF);
        constexpr int TA = 2 * RB_A + 1, TB = 2 * RB_B + 1;
        for (int i = F.tid; i < 16 * TA; i += NWAVES * 64) { const int h = i / TA, rel = i % TA - RB_A; lb[i] = (rel >= -128 && rel <= 128) ? tb->biasA[h][rel + 128] * LOG2E : -3.0e38f; }
        for (int i = F.tid; i < 12 * TB; i += NWAVES * 64) { const int gh = i / TB, rel = i % TB - RB_B; lb[16 * TA + i] = (rel >= -64 && rel <= 64) ? tb->biasB[gh >> 2][gh & 3][rel + 64] * LOG2E : -3.0e38f; }
        __syncthreads();
        const bf16* VTA = (const bf16*)(ws + WS_VT); const bf16* VTB = VTA + (size_t)2 * 4 * 64 * 8192;
        for (int it = gw; it < 4096 + 2048; it += NGW) {
            const int t = F.lane & 15;
            if (it < 4096) {
                const int b = it >> 11, kvh = (it >> 9) & 3, qb = it & 511;
                f32x4 o[4][4]; float mr[4], lr[4];
#pragma unroll
                for (int h = 0; h < 4; ++h) { mr[h] = sinks[kvh * 4 + h] * LOG2E; lr[h] = (F.lane < 16) ? 1.f : 0.f;
#pragma unroll
                    for (int db = 0; db < 4; ++db) o[h][db] = (f32x4){0.f, 0.f, 0.f, 0.f}; }
                const int qcol[4] = {C_QA + (kvh * 4 + 0) * 64, C_QA + (kvh * 4 + 1) * 64, C_QA + (kvh * 4 + 2) * 64, C_QA + (kvh * 4 + 3) * 64};
                const int qmu[4] = {16 * qb, 16 * qb, 16 * qb, 16 * qb};
                const LAS float* const bias[4] = {lb + (kvh * 4 + 0) * TA, lb + (kvh * 4 + 1) * TA, lb + (kvh * 4 + 2) * TA, lb + (kvh * 4 + 3) * TA};
                band_group<4, RB_A>(o, mr, lr, QKV + (size_t)b * S * NQKV, qcol, qmu, C_KA + kvh * 64, VTA + (size_t)((b * 4 + kvh) * 64) * 8192, 1, 0, S, 1, (qb - 8) >> 1, 9, bias, F.lane);
                unsigned char* yr = (unsigned char*)YA + (size_t)(b * S + 16 * qb + t) * D + kvh * 256; unsigned char* const yrow[4] = {yr, yr + 64, yr + 128, yr + 192};
                band_store<4>(o, lr, yrow, F.lane);
            } else {
                const int j = it - 4096, r = j & 7, un = j >> 3, blk = un & 31, hs = (un >> 5) & 3, b = un >> 7, i0 = blk * 256;
                f32x4 o[2][4]; float mr[2], lr[2];
#pragma unroll
                for (int h = 0; h < 2; ++h) { mr[h] = -1.0e30f; lr[h] = 0.f;
#pragma unroll
                    for (int db = 0; db < 4; ++db) o[h][db] = (f32x4){0.f, 0.f, 0.f, 0.f}; }
                const bf16* qb_ = QKV + (size_t)b * S * NQKV;
                { const int qcol[2] = {C_QB + 0 * 256 + hs * 64, C_QB + 0 * 256 + hs * 64}; const int qmu[2] = {i0 + r, i0 + r + 8}; const LAS float* const bias[2] = {lb + 16 * TA + (0 * 4 + hs) * TB, lb + 16 * TA + (0 * 4 + hs) * TB};
                  band_group<2, RB_B>(o, mr, lr, qb_, qcol, qmu, C_KB + 0 * 256 + hs * 64, VTB + (size_t)(((0 * 2 + b) * 4 + hs) * 64) * 8192, 1, 0, S, 16, (i0 >> 5) - 2, 12, bias, F.lane); }
                { const int qcol[2] = {C_QB + 1 * 256 + hs * 64, C_QB + 1 * 256 + hs * 64}; const int qmu[2] = {(i0 + r) >> 2, (i0 + r + 8) >> 2}; const LAS float* const bias[2] = {lb + 16 * TA + (1 * 4 + hs) * TB, lb + 16 * TA + (1 * 4 + hs) * TB};
                  band_group<2, RB_B>(o, mr, lr, qb_, qcol, qmu, C_KB + 1 * 256 + hs * 64, VTB + (size_t)(((1 * 2 + b) * 4 + hs) * 64) * 8192, 4, r & 3, S / 4, 4, (i0 >> 7) - 2, 6, bias, F.lane); }
#pragma unroll
                for (int h = 0; h < 2; ++h) { const int qcol[1] = {C_QB + 2 * 256 + hs * 64}; const int qmu[1] = {i0 >> 4}; const LAS float* const bias[1] = {lb + 16 * TA + (2 * 4 + hs) * TB};
                  band_group<1, RB_B>(*(f32x4(*)[1][4])&o[h], *(float(*)[1])&mr[h], *(float(*)[1])&lr[h], qb_, qcol, qmu, C_KB + 2 * 256 + hs * 64, VTB + (size_t)(((2 * 2 + b) * 4 + hs) * 64) * 8192,
                                    16, r + 8 * h, S / 16, 1, (blk - 4) >> 1, 5, bias, F.lane); }
                unsigned char* yr = (unsigned char*)YB + (size_t)(b * S + i0 + r + 16 * t) * 256 + hs * 64; unsigned char* const yrow[2] = {yr, yr + 8 * 256};
                band_store<2>(o, lr, yrow, F.lane);
            }
        }
        __syncthreads();
    }
    SEAM(2);
    if (IN(3)) REP(3) {
#ifndef NO_P3A
        { int k256 = 128; asm volatile("" : "+s"(k256)); pg8::Gemm g{YB, Wb_t, k256};   pg8::StaticOrder So; So.init(T, D, F.G, (int)blockIdx.x);
          pg8::EpiGate<0> E{MERGED, GATES, 1024, nullptr};
          pg8::gemm_phase<pg8::EpiGate<0>, pg8::StaticOrder, true, true, true>(F.lds + RING_OFF, g, So, E); }
#endif
        VM_WAIT(); __syncthreads();
#ifndef NO_P3B
        { int k512 = D / 2; asm volatile("" : "+s"(k512)); pg8::Gemm g{YA, Wa_t, k512}; pg8::StaticOrder So; So.init(T, D, F.G, (int)blockIdx.x);
          pg8::EpiGate<1> E{MERGED, GATES, 0, (unsigned char*)YA + (size_t)16 * MiB};
          pg8::gemm_phase<pg8::EpiGate<1>, pg8::StaticOrder, true, true, true>(F.lds + RING_OFF, g, So, E); }
#endif
    }
    SEAM(3);
    if (IN(4)) REP(4) {
        int k512 = D / 2; asm volatile("" : "+s"(k512)); pg8::Gemm g{(const bf16*)((unsigned char*)YA + (size_t)16 * MiB), Wout_t, k512}; pg8::StaticOrder So; So.init(T, D, F.G, (int)blockIdx.x);
        pg8::EpiX1 E{x, out};
        pg8::gemm_phase<pg8::EpiX1, pg8::StaticOrder, true, true, true>(F.lds + RING_OFF, g, So, E);
    }
    SEAM(4);
    if (IN(5)) REP(5) {
        const bool lastrep5 = (rep_ + 1 == 1 + ((MK_DUP >> 5) & 1));
        LAS int* lcnt = F.tbl + 72; LAS int* lbase = F.tbl + 104; LAS int* ebuf = F.tbl + 136; LAS int* pbuf = F.tbl + 392;
        LAS float* plog = (LAS float*)(F.lds + RING_OFF);
        LAS float* psq = plog + 8 * 64 * 32;
        LAS float* rstd_s = psq + 512;
        const int g = F.lane >> 4, e16 = F.lane & 15, w = F.wave;
        float wB[32][2];
#pragma unroll
        for (int sc = 0; sc < 32; ++sc) { const int k = 128 * w + 32 * (sc >> 3) + 8 * g + (sc & 7); const float gm = norm_ffn[k];
            wB[sc][0] = gm * router_w[(size_t)k * NE + e16]; wB[sc][1] = gm * router_w[(size_t)k * NE + 16 + e16]; }
        for (int tblk = F.vcu; tblk < T / 64; tblk += F.G) {
            if (F.tid < 32) lcnt[F.tid] = 0;
            f32x4 v[4][2];
            { const GAS float* xr = (const GAS float*)out + (size_t)(tblk * 64 + e16) * D + 128 * w + 8 * g;
#pragma unroll
              for (int s4 = 0; s4 < 4; ++s4) { v[s4][0] = *(const GAS f32x4*)(xr + 32 * s4); v[s4][1] = *(const GAS f32x4*)(xr + 32 * s4 + 4); } }
#pragma unroll 1
            for (int tile = 0; tile < 4; ++tile) {
                f32x4 vn[4][2];
                { const int tn = tile < 3 ? tile + 1 : 3; const GAS float* xr = (const GAS float*)out + (size_t)(tblk * 64 + tn * 16 + e16) * D + 128 * w + 8 * g;
#pragma unroll
                  for (int s4 = 0; s4 < 4; ++s4) { vn[s4][0] = *(const GAS f32x4*)(xr + 32 * s4); vn[s4][1] = *(const GAS f32x4*)(xr + 32 * s4 + 4); } }
                float sq = 0.f;
#pragma unroll
                for (int s4 = 0; s4 < 4; ++s4) sq += (v[s4][0].x * v[s4][0].x + v[s4][0].y * v[s4][0].y) + (v[s4][0].z * v[s4][0].z + v[s4][0].w * v[s4][0].w)
                                                   + (v[s4][1].x * v[s4][1].x + v[s4][1].y * v[s4][1].y) + (v[s4][1].z * v[s4][1].z + v[s4][1].w * v[s4][1].w);
                sq += __shfl_xor(sq, 16); sq += __shfl_xor(sq, 32);
                if (g == 0) psq[w * 64 + tile * 16 + e16] = sq;
                f32x4 a0 = (f32x4){0.f, 0.f, 0.f, 0.f}, a1 = (f32x4){0.f, 0.f, 0.f, 0.f};
#pragma unroll
                for (int s4 = 0; s4 < 4; ++s4)
#pragma unroll
                    for (int c = 0; c < 8; ++c) { const float av = v[s4][c >> 2][c & 3];
                        a0 = __builtin_amdgcn_mfma_f32_16x16x4f32(av, wB[s4 * 8 + c][0], a0, 0, 0, 0); a1 = __builtin_amdgcn_mfma_f32_16x16x4f32(av, wB[s4 * 8 + c][1], a1, 0, 0, 0); }
#pragma unroll
                for (int r = 0; r < 4; ++r) { LAS float* pr = plog + (size_t)(w * 64 + tile * 16 + 4 * g + r) * 32 + e16; pr[0] = a0[r]; pr[16] = a1[r]; }
#pragma unroll
                for (int s4 = 0; s4 < 4; ++s4) { v[s4][0] = vn[s4][0]; v[s4][1] = vn[s4][1]; }
            }
            __syncthreads();
            if (F.tid < 64) { float s = 0.f;
#pragma unroll
                for (int ww = 0; ww < 8; ++ww) s += psq[ww * 64 + F.tid];
                rstd_s[F.tid] = 1.f / sqrtf(s * (1.f / D) + EPS); }
            __syncthreads();
            { const int e = F.tid & 31; const float rbv = router_b[e];
#pragma unroll 1
              for (int i = 0; i < 4; ++i) { const int tl = (F.tid >> 5) + 16 * i; float lg = 0.f;
#pragma unroll
                for (int ww = 0; ww < 8; ++ww) lg += plog[(size_t)(ww * 64 + tl) * 32 + e];
                float val = lg * rstd_s[tl] + rbv; float tv[4]; int ti[4];
#pragma unroll
                for (int r = 0; r < 4; ++r) {
                    float bv = val; int bi = e;
#pragma unroll
                    for (int o = 1; o < 32; o <<= 1) { const float ov = __shfl_xor(bv, o); const int oi = __shfl_xor(bi, o); if (ov > bv || (ov == bv && oi < bi)) { bv = ov; bi = oi; } }
                    tv[r] = bv; ti[r] = bi; if (bi == e) val = -3.0e38f;
                }
                const float e1 = __expf(tv[1] - tv[0]), e2 = __expf(tv[2] - tv[0]), e3 = __expf(tv[3] - tv[0]); const float inv = 1.f / (1.f + e1 + e2 + e3);
                if (e < 4) { const float p = (e == 0 ? 1.f : e == 1 ? e1 : e == 2 ? e2 : e3) * inv; const int ex = (e == 0 ? ti[0] : e == 1 ? ti[1] : e == 2 ? ti[2] : ti[3]);
                    const int m = tblk * 64 + tl; topi[m * 4 + e] = ex; topp[m * 4 + e] = p;
                    const int li = tl * 4 + e; ebuf[li] = ex; pbuf[li] = __hip_atomic_fetch_add(&lcnt[ex], 1, __ATOMIC_RELAXED, __HIP_MEMORY_SCOPE_WORKGROUP); } } }
#pragma unroll 1
            for (int rb = 0; rb < 8; rb += 4) { f32x4 xv[4][4];
#pragma unroll
                for (int r = 0; r < 4; ++r) { const GAS f32x4* xr4 = (const GAS f32x4*)(out + ((size_t)tblk * 64 + w * 8 + rb + r) * D) + F.lane;
#pragma unroll
                    for (int j = 0; j < 4; ++j) xv[r][j] = xr4[64 * j]; }
#pragma unroll
                for (int r = 0; r < 4; ++r) { const int tl = w * 8 + rb + r; const float rstd = rstd_s[tl]; GAS unsigned* o4 = (GAS unsigned*)(H28 + ((size_t)tblk * 64 + tl) * D) + F.lane;
#pragma unroll
                    for (int j = 0; j < 4; ++j) { const f32x4 gg = ((const GAS f32x4*)norm_ffn)[F.lane + 64 * j];
                        o4[64 * j] = pk4_fp8(xv[r][j].x * rstd * gg.x, xv[r][j].y * rstd * gg.y, xv[r][j].z * rstd * gg.z, xv[r][j].w * rstd * gg.w); } } }
            __syncthreads();
            if (F.tid < 32) lbase[F.tid] = lastrep5 ? (int)__hip_atomic_fetch_add(cnt + F.tid, (unsigned)lcnt[F.tid], RLX_AGENT) : 0;
            __syncthreads();
            if (F.tid < 256) pos[tblk * 256 + F.tid] = lbase[ebuf[F.tid]] + pbuf[F.tid];
            __syncthreads();
        }
    }
    SEAM(5);
    if (IN(6) || IN(7) || IN(8)) {
        LAS int* loff = F.tbl; LAS int* ltoff = F.tbl + 36; LAS int* lc = F.tbl + 72;
        if (F.tid < 32) lc[F.tid] = (int)__hip_atomic_load(cnt + F.tid, RLX_AGENT);
        __syncthreads();
        if (F.tid == 0) { int a = 0, ta = 0; for (int e = 0; e < NE; ++e) { loff[e] = a; ltoff[e] = ta; const int c = lc[e]; a += c; ta += (c + 255) >> 8; } loff[NE] = a; ltoff[NE] = ta; }
        __syncthreads();
    }
    if (IN(6)) REP(6) {
        transpose_items(I_IN + 2 * I_A + I_B, NITEMS);
        const LAS int* loff = F.tbl;
        for (int p0 = gw; p0 < T * 4; p0 += 4 * NGW) {
            int row[4]; u32x4 dv[4];
#pragma unroll
            for (int q = 0; q < 4; ++q) { const int p = p0 + q * NGW; row[q] = (p < T * 4) ? loff[topi[p]] + pos[p] : -1; }
#pragma unroll
            for (int q = 0; q < 4; ++q) { const int p = p0 + q * NGW; if (row[q] >= 0) dv[q] = ((const GAS u32x4*)(H28 + (size_t)(p >> 2) * D))[F.lane]; }
#pragma unroll
            for (int q = 0; q < 4; ++q) { const int p = p0 + q * NGW; if (row[q] >= 0) { if (F.lane == 0) slot[p] = row[q]; ((GAS u32x4*)(HS8 + (size_t)row[q] * D))[F.lane] = dv[q]; } }
        }
    }
    SEAM(6);
    if (IN(7)) REP(7) {
        int k512 = D / 2; asm volatile("" : "+s"(k512));
        pg8::Gemm g{(const bf16*)HS8, (const bf16*)Wgu8, k512}; pg8::GroupOrder So{F.tbl + 36, F.tbl, 8, F.G, (int)blockIdx.x, 0}; So.nunits = __builtin_amdgcn_readfirstlane(F.tbl[36 + NE]) * 8;
        pg8::EpiSwiglu E{ACT8, b_gate, b_up};
        pg8::gemm_phase<pg8::EpiSwiglu, pg8::GroupOrder, true, FP8_SP2, true>(F.lds + RING_OFF, g, So, E);
    }
    SEAM(7);
    if (IN(8)) REP(8) {
        int k512 = D / 2; asm volatile("" : "+s"(k512));
        pg8::Gemm g{(const bf16*)ACT8, (const bf16*)Wd8, k512}; pg8::GroupOrder So{F.tbl + 36, F.tbl, 4, F.G, (int)blockIdx.x, 0}; So.nunits = __builtin_amdgcn_readfirstlane(F.tbl[36 + NE]) * 4;
        pg8::EpiDown E{YS, b_down};
        pg8::gemm_phase<pg8::EpiDown, pg8::GroupOrder, true, FP8_SP2, true>(F.lds + RING_OFF, g, So, E);
    }
    SEAM(8);
#ifdef MK_XBAR
    for (int xb_ = 0; xb_ < MK_XBAR; ++xb_) xcd_barrier(bar);
#endif
    if (IN(9)) REP(9) {
        const unsigned char* ys = YS;
        float* dst9 = (rep_ + 1 < 1 + ((MK_DUP >> 9) & 1)) ? (float*)(ws + WS_ACT) : out;
        for (int m0 = gw; m0 < T; m0 += 2 * NGW) {
            f32x4 v[2][4]; int sl[2][4]; float pr[2][4]; unsigned yv[2][4][4]; bool ok[2];
#pragma unroll
            for (int q = 0; q < 2; ++q) { const int m = m0 + q * NGW; ok[q] = m < T; const int mc = ok[q] ? m : m0; const GAS f32x4* xr = (const GAS f32x4*)(out + (size_t)mc * D) + F.lane;
#pragma unroll
                for (int j = 0; j < 4; ++j) v[q][j] = xr[64 * j];
#pragma unroll
                for (int k = 0; k < 4; ++k) { sl[q][k] = slot[mc * 4 + k]; pr[q][k] = topp[mc * 4 + k]; } }
#pragma unroll
            for (int q = 0; q < 2; ++q)
#pragma unroll
                for (int k = 0; k < 4; ++k) { const GAS unsigned* yr = (const GAS unsigned*)(ys + (size_t)sl[q][k] * D) + F.lane;
#pragma unroll
                    for (int j = 0; j < 4; ++j) yv[q][k][j] = yr[64 * j]; }
#pragma unroll
            for (int q = 0; q < 2; ++q) { if (!ok[q]) continue; const int m = m0 + q * NGW;
#pragma unroll
                for (int k = 0; k < 4; ++k) { const float p = pr[q][k];
#pragma unroll
                    for (int j = 0; j < 4; ++j) { const unsigned u = yv[q][k][j]; const f32x2 lo = __builtin_amdgcn_cvt_pk_f32_fp8(u, false), hi = __builtin_amdgcn_cvt_pk_f32_fp8(u, true);
                        v[q][j].x += p * lo.x; v[q][j].y += p * lo.y; v[q][j].z += p * hi.x; v[q][j].w += p * hi.y; } }
                float s = 0.f;
#pragma unroll
                for (int j = 0; j < 4; ++j) s += (v[q][j].x * v[q][j].x + v[q][j].y * v[q][j].y) + (v[q][j].z * v[q][j].z + v[q][j].w * v[q][j].w);
                const float rstd = 1.f / sqrtf(wave_sum(s) * (1.f / D) + EPS);
#pragma unroll
                for (int j = 0; j < 4; ++j) { const f32x4 gg = ((const GAS f32x4*)norm_final)[F.lane + 64 * j]; f32x4 y; y.x = v[q][j].x * rstd * gg.x; y.y = v[q][j].y * rstd * gg.y; y.z = v[q][j].z * rstd * gg.z; y.w = v[q][j].w * rstd * gg.w;
                    ((GAS f32x4*)(dst9 + (size_t)m * D) + F.lane)[64 * j] = y; } }
        }
    }
#ifdef MK_TSTAMP
    if (MK_TSTAMP == 9) ts_b = __builtin_amdgcn_s_memrealtime();
    if (blockIdx.x == 0) { const unsigned long long dt = ts_b - ts_a, t0_ = __builtin_amdgcn_s_memrealtime();
        while (__builtin_amdgcn_s_memrealtime() - t0_ < 2 * dt) __builtin_amdgcn_s_sleep(8); }
#endif
#undef IN
#undef SEAM
}

extern "C" void kernel_launch(void* const* d_in, const int* in_sizes, int n_in, void* d_out, int out_size, void* d_ws, size_t ws_size, hipStream_t stream) {
    static int grid = 0;
    if (grid == 0) {
        if (n_in != 19 || in_sizes[0] != T * D || out_size != T * D || ws_size < WS_END) { fprintf(stderr, "kernel_launch: unexpected shapes (n_in %d, ws %zu); nothing launched\n", n_in, ws_size); grid = -1; return; }
        int dev = 0, cus = 0, per_cu = 0;
        if (hipGetDevice(&dev) != hipSuccess || hipDeviceGetAttribute(&cus, hipDeviceAttributeMultiprocessorCount, dev) != hipSuccess) { grid = -1; return; }
        if (hipFuncSetAttribute((const void*)mk_fwd, hipFuncAttributeMaxDynamicSharedMemorySize, LDS_BYTES) != hipSuccess) { fprintf(stderr, "kernel_launch: hipFuncSetAttribute failed\n"); grid = -1; return; }
        if (hipOccupancyMaxActiveBlocksPerMultiprocessor(&per_cu, (const void*)mk_fwd, NWAVES * 64, LDS_BYTES) != hipSuccess || per_cu < 1) { fprintf(stderr, "kernel_launch: occupancy query says %d blocks per CU\n", per_cu); }
        (void)hipGetLastError();
        grid = cus;
        if (grid != 256) fprintf(stderr, "kernel_launch: %d CUs (built and tuned for 256)\n", grid);
    }
    if (grid < 0) return;
    if (hipMemsetAsync((char*)d_ws + WS_CTL, 0, CTL_ZERO_BYTES, stream) != hipSuccess) return;
    Args a{};
    for (int i = 0; i < 19; ++i) a.in[i] = (const float*)d_in[i];
    a.out = (float*)d_out; a.ws = (unsigned char*)d_ws;
#if MK_MODE == 2
    a.ph_lo = 0; a.ph_hi = NPHASE; a.li = 0;
    hipLaunchKernelGGL(mk_fwd, dim3(grid), dim3(NWAVES * 64), LDS_BYTES, stream, a);
#else
    for (int ph = 0; ph < NPHASE; ++ph) { a.ph_lo = ph; a.ph_hi = ph + 1; a.li = ph; hipLaunchKernelGGL(mk_fwd, dim3(grid), dim3(NWAVES * 64), LDS_BYTES, stream, a); }
#endif
}
```

```cpp
#define MK_DUP 0
#include <hip/hip_runtime.h>
#include <stdint.h>
#include <stdio.h>

#ifndef FP8_SP2
#define FP8_SP2 true
#endif
#ifndef MK_MODE
#define MK_MODE 2
#endif

typedef unsigned short bf16;
typedef short bf16x8 __attribute__((ext_vector_type(8)));
typedef float f32x4 __attribute__((ext_vector_type(4)));
typedef float f32x2 __attribute__((ext_vector_type(2)));
typedef unsigned u32x4 __attribute__((ext_vector_type(4)));
typedef unsigned u32x2 __attribute__((ext_vector_type(2)));
#define GAS __attribute__((address_space(1)))
#define LAS __attribute__((address_space(3)))
typedef GAS unsigned gu32;

constexpr int T = 16384, S = 8192, D = 1024, NPROJ = 5888, NQKV = 3840, NGATE = 2048, NE = 32, TOPK = 4;
constexpr int C_QA = 0, C_KA = 1024, C_VA = 1280, C_QB = 1536, C_KB = 2304, C_VB = 3072;
constexpr float EPS = 1e-5f;
constexpr size_t MiB = 1u << 20;
constexpr size_t WS_CTL = 0, CTL_ZERO_BYTES = 1 * MiB;
constexpr size_t WS_TAB = 1 * MiB;
constexpr size_t WS_WIN = 2 * MiB;
constexpr size_t WS_WA = 14 * MiB;
constexpr size_t WS_WB = 16 * MiB;
constexpr size_t WS_WOUT = 17 * MiB;
constexpr size_t WS_RT = 19 * MiB;
constexpr size_t WS_WGU = 24 * MiB;
constexpr size_t WS_WD = 88 * MiB;
constexpr size_t WS_H2 = 120 * MiB;
constexpr size_t WS_HS = 136 * MiB;
constexpr size_t WS_ACT = 201 * MiB;
constexpr size_t WS_YS = 272 * MiB;
constexpr size_t WS_XN = 216 * MiB;
constexpr size_t WS_XNP = 312 * MiB;
constexpr size_t WS_QKV = 248 * MiB;
constexpr size_t WS_GATES = 368 * MiB;
constexpr size_t WS_YA = 432 * MiB;
constexpr size_t WS_YB = 464 * MiB;
constexpr size_t WS_MERGED = 472 * MiB;
constexpr size_t WS_VT = 472 * MiB;
constexpr size_t WS_END = 506 * MiB;
constexpr int CW_CNT = 0;
constexpr int CW_BAR = 4096;

__device__ const unsigned char BKT_A[257] = {12,12,12,12,12,12,12,12,12,12,12,12,12,12,12,12,12,12,12,12,12,12,12,12,12,12,12,12,12,12,12,12,12,12,12,12,12,12,11,11,11,11,11,11,11,11,11,11,11,11,11,11,11,11,11,11,11,11,11,11,11,11,11,11,11,11,11,11,11,11,11,11,11,11,11,11,11,11,11,10,10,10,10,10,10,10,10,10,10,10,10,10,10,10,10,10,10,10,10,10,10,10,9,9,9,9,9,9,9,9,9,9,9,9,8,8,8,8,8,8,8,7,6,5,4,3,2,1,0,17,18,19,20,21,22,23,24,24,24,24,24,24,24,25,25,25,25,25,25,25,25,25,25,25,25,26,26,26,26,26,26,26,26,26,26,26,26,26,26,26,26,26,26,26,26,26,26,26,27,27,27,27,27,27,27,27,27,27,27,27,27,27,27,27,27,27,27,27,27,27,27,27,27,27,27,27,27,27,27,27,27,27,27,27,27,27,27,27,27,28,28,28,28,28,28,28,28,28,28,28,28,28,28,28,28,28,28,28,28,28,28,28,28,28,28,28,28,28,28,28,28,28,28,28,28,28,28};
__device__ const unsigned char BKT_B[3][129] = {
 {11,11,11,11,11,11,11,11,11,11,11,11,11,11,11,10,10,10,10,10,10,10,10,10,10,10,10,10,10,10,10,10,10,10,10,10,10,10,9,9,9,9,9,9,9,9,9,9,9,9,8,8,8,8,8,8,8,7,6,5,4,3,2,1,0,17,18,19,20,21,22,23,24,24,24,24,24,24,24,25,25,25,25,25,25,25,25,25,25,25,25,26,26,26,26,26,26,26,26,26,26,26,26,26,26,26,26,26,26,26,26,26,26,26,27,27,27,27,27,27,27,27,27,27,27,27,27,27,27},
 {13,13,13,13,13,13,13,13,13,13,13,13,13,13,13,13,13,13,13,13,13,13,13,12,12,12,12,12,12,12,12,12,12,12,12,12,12,12,12,12,12,12,11,11,11,11,11,11,11,11,11,11,10,10,10,10,10,10,9,9,9,8,8,4,0,20,24,24,25,25,25,26,26,26,26,26,26,27,27,27,27,27,27,27,27,27,27,28,28,28,28,28,28,28,28,28,28,28,28,28,28,28,28,28,28,28,29,29,29,29,29,29,29,29,29,29,29,29,29,29,29,29,29,29,29,29,29,29,29},
 {15,15,15,15,15,15,15,15,15,15,15,15,15,15,15,15,15,15,15,15,15,15,15,15,15,15,15,15,15,15,14,14,14,14,14,14,14,14,14,14,14,14,14,14,14,13,13,13,13,13,13,13,13,13,12,12,12,12,12,11,11,10,10,9,0,25,26,26,27,27,28,28,28,28,28,29,29,29,29,29,29,29,29,29,30,30,30,30,30,30,30,30,30,30,30,30,30,30,30,31,31,31,31,31,31,31,31,31,31,31,31,31,31,31,31,31,31,31,31,31,31,31,31,31,31,31,31,31,31}};

#define RLX_AGENT __ATOMIC_RELAXED, __HIP_MEMORY_SCOPE_AGENT
#define LDS_WAIT() asm volatile("s_waitcnt lgkmcnt(0)" ::: "memory")
#define VM_WAIT() asm volatile("s_waitcnt vmcnt(0)" ::: "memory")
__device__ __forceinline__ unsigned f2bf(float f) { unsigned u = __builtin_bit_cast(unsigned, f); return (u + 0x7fffu + ((u >> 16) & 1u)) >> 16; }
__device__ __forceinline__ unsigned pk2(float lo, float hi) { return f2bf(lo) | (f2bf(hi) << 16); }
__device__ __forceinline__ unsigned pk4_fp8(float a, float b, float c, float d) { unsigned w = 0; w = __builtin_amdgcn_cvt_pk_fp8_f32(a, b, w, false); w = __builtin_amdgcn_cvt_pk_fp8_f32(c, d, w, true); return w; }
__device__ __forceinline__ float bf2f(unsigned b) { return __builtin_bit_cast(float, b << 16); }
__device__ __forceinline__ float bflo(unsigned u) { return __builtin_bit_cast(float, u << 16); }
__device__ __forceinline__ float bfhi(unsigned u) { return __builtin_bit_cast(float, u & 0xffff0000u); }
__device__ __forceinline__ float wave_sum(float v) {
#pragma unroll
    for (int o = 1; o < 64; o <<= 1) v += __shfl_xor(v, o);
    return v;
}
__device__ __forceinline__ float sigm(float x) { return __builtin_amdgcn_rcpf(1.f + __builtin_amdgcn_exp2f(-1.4426950408889634f * x)); }

struct Tabs { float biasA[16][257]; float biasB[3][4][129]; };

namespace pg8 {
#define PG8_LAS __attribute__((address_space(3)))
typedef unsigned short bf16_t;
constexpr int BM = 256, BK = 64, HALF = 128, HTB = HALF * BK * 2, STAGE_BYTES = 8 * HTB, NXCD = 8, WGM = 8;
__host__ __device__ __forceinline__ int lds_byte(int r, int c) { const int st = (r >> 4) * 2 + (c >> 5), rr = r & 15, cc = c & 31, ob = rr * 64 + cc * 2; return st * 1024 + (ob ^ (((ob >> 9) & 1) << 5)); }
__host__ __device__ __forceinline__ void stage_rc(int b, int& R, int& C) { const int st = b / 1024, sb = b % 1024, swz = sb ^ (((sb >> 9) & 1) << 5); R = (st >> 1) * 16 + swz / 64; C = (st & 1) * 32 + (swz % 64) / 2; }
__host__ __device__ __forceinline__ int perm32(int rho) { const int n = rho >> 4, i = rho & 15; return 8 * (i >> 2) + 4 * n + (i & 3); }

struct Unit { int arow, brow, nrows, e, swap; };
struct Gemm { const bf16_t* A; const bf16_t* Bt; int K; };

struct StaticOrder {
    int nM, nN, nwg, G, c;
    __device__ void init(int M, int N, int G_, int c_) { nM = M / BM; nN = N / BM; nwg = nM * nN; G = G_; c = c_; }
    __device__ bool next(int i, Unit& u) const {
        const long L = (long)i * G + c; if (L >= nwg) return false;
        int wgid = (int)L; { const int q = nwg / NXCD, r = nwg % NXCD, xcd = wgid % NXCD, off = wgid / NXCD; wgid = (xcd < r ? xcd * (q + 1) : r * (q + 1) + (xcd - r) * q) + off; }
        const int nig = WGM * nN, gid = wgid / nig, fm = gid * WGM, gsz = (nM - fm) < WGM ? (nM - fm) : WGM;
        u.arow = BM * (fm + ((wgid % nig) % gsz)); u.brow = BM * ((wgid % nig) / gsz); u.nrows = BM; u.e = 0; u.swap = 0; return true;
    }
    __device__ __forceinline__ void a_ready(const Unit&) const {}
    __device__ __forceinline__ void done(const Unit&) const {}
};
constexpr int XNP_ROW0 = (int)((WS_XNP - WS_XN) / D);
struct ProjOrder {
    StaticOrder so;
    __device__ bool next(int i, Unit& u) const { if (!so.next(i, u)) return false;
        if (u.brow == C_VA || (u.brow >= C_VB && u.brow < NQKV)) { const int a = u.arow; u.arow = u.brow; u.brow = a; u.swap = 1; u.e = a;
            if (u.arow == C_VB + 256) u.brow += XNP_ROW0; else if (u.arow == C_VB + 512) u.brow += XNP_ROW0 + T; } return true; }
    __device__ __forceinline__ void a_ready(const Unit&) const {}
    __device__ __forceinline__ void done(const Unit&) const {}
};
struct GroupOrder {
    const PG8_LAS int* toff; const PG8_LAS int* off; int NT, G, c, nunits;
    __device__ bool next(int i, Unit& u) const {
        const int L = i * G + c; if (L >= nunits) return false;
        const int mtg = L / NT, pn = L - mtg * NT;
        int e = 0;
        for (int j = 1; j < NE; ++j) e += (toff[j] <= mtg) ? 1 : 0;
        e = __builtin_amdgcn_readfirstlane(e);
        const int mt = mtg - __builtin_amdgcn_readfirstlane(toff[e]); const int o0 = __builtin_amdgcn_readfirstlane(off[e]), o1 = __builtin_amdgcn_readfirstlane(off[e + 1]);
        u.arow = o0 + BM * mt; const int rem = o1 - u.arow; u.nrows = rem < BM ? rem : BM; u.brow = (e * NT + pn) * BM; u.e = e; u.swap = 0; return true;
    }
    __device__ __forceinline__ void a_ready(const Unit&) const {}
    __device__ __forceinline__ void done(const Unit&) const {}
};

__device__ __forceinline__ void st16_wt(void* p, u32x4 v) { asm volatile("global_store_dwordx4 %0, %1, off sc1\n\ts_nop 2" :: "v"(p), "v"(v) : "memory"); }
__device__ __forceinline__ void st8_wt(void* p, u32x2 v) { asm volatile("global_store_dwordx2 %0, %1, off sc1\n\ts_nop 2" :: "v"(p), "v"(v) : "memory"); }
__device__ __forceinline__ unsigned cvt_pk_bf16(float lo, float hi) { unsigned r; asm volatile("v_cvt_pk_bf16_f32 %0, %1, %2" : "=v"(r) : "v"(lo), "v"(hi)); return r; }

struct EpiProj {
    static constexpr bool PERM = true, AFTER_DRAIN = false; static constexpr int TAG = 1;
    bf16_t* qkv; bf16_t* gates; const float* bias; bf16_t* vta; bf16_t* vtb;
    __device__ __forceinline__ void prefetch(const Unit& u, PG8_LAS unsigned char* slot, int wid, int lane) const {
        if (wid == 0) { int l4 = 4 * lane; asm volatile("" : "+v"(l4));
            __builtin_amdgcn_global_load_lds((const unsigned*)(bias + (u.swap ? u.arow : u.brow) + l4), (PG8_LAS unsigned*)slot, 16, 0, 0); } }
    __device__ __forceinline__ void operator()(const f32x4 (&acc)[2][2][4][2], const Unit& u, int wr, int wc, int fr, int fq, const PG8_LAS unsigned char* slot) const {
        if (!u.swap) {
            const int colt = u.brow; const bool isq = colt < NQKV; unsigned char* base = isq ? (unsigned char*)qkv : (unsigned char*)gates; const int ldc = isq ? NQKV : NGATE; const int cb = isq ? colt : colt - NQKV;
            const int row0 = u.arow + wr * 64 + fr, col0 = cb + wc * 32 + 8 * fq;
            const PG8_LAS f32x4* bl = (const PG8_LAS f32x4*)(slot + (wc * 32 + 8 * fq) * 4);
            const float qs = (colt < C_KA || (colt >= C_QB && colt < C_KB)) ? 0.125f * 1.4426950408889634f : 1.f;
#pragma unroll
            for (int ai = 0; ai < 2; ++ai)
#pragma unroll
                for (int m = 0; m < 4; ++m) { unsigned char* rowp = base + (size_t)(row0 + ai * HALF + m * 16) * ldc + col0;
#pragma unroll
                    for (int bj = 0; bj < 2; ++bj) { const f32x4 v0 = (acc[ai][bj][m][0] + bl[bj * 32]) * qs, v1 = (acc[ai][bj][m][1] + bl[bj * 32 + 1]) * qs;
                        u32x2 w; w.x = pk4_fp8(v0[0], v0[1], v0[2], v0[3]); w.y = pk4_fp8(v1[0], v1[1], v1[2], v1[3]); *(u32x2*)(rowp + bj * HALF) = w; }
                    asm volatile("" ::: "memory"); }
        } else {
            const int colt = u.arow, tok0 = u.e; const int gsel = (colt == C_VA) ? -1 : ((colt - C_VB) >> 8); const int sh = (gsel <= 0) ? 0 : (gsel == 1 ? 2 : 4);
            bf16_t* vb = ((gsel < 0) ? vta : vtb + (size_t)gsel * (2 * 256 * 8192)) + (size_t)((tok0 >> 13) * 256) * 8192;
            const int mub = (tok0 & 8191) >> sh;
#pragma unroll
            for (int ai = 0; ai < 2; ++ai)
#pragma unroll
                for (int m = 0; m < 4; ++m) { const int c = ai * HALF + wr * 64 + m * 16 + fr; const float bvr = *(const PG8_LAS float*)(slot + c * 4); bf16_t* vrow = vb + (size_t)c * 8192;
#pragma unroll
                    for (int bj = 0; bj < 2; ++bj) { const int j0 = bj * HALF + wc * 32 + 8 * fq;
                        const int rho = j0 >> (8 - sh), mu = mub + (j0 & ((256 >> sh) - 1));
                        const int p0 = (rho << (13 - sh)) + (mu & ~31) + (((mu & 15) >> 2) << 3) + (((mu >> 4) & 1) << 2);
                        const f32x4 v0 = acc[ai][bj][m][0] + bvr, v1 = acc[ai][bj][m][1] + bvr;
                        u32x2 w0, w1; w0.x = cvt_pk_bf16(v0[0], v0[1]); w0.y = cvt_pk_bf16(v0[2], v0[3]); w1.x = cvt_pk_bf16(v1[0], v1[1]); w1.y = cvt_pk_bf16(v1[2], v1[3]);
                        *(u32x2*)(vrow + p0) = w0; *(u32x2*)(vrow + p0 + 8) = w1; }
                    asm volatile("" ::: "memory"); }
        }
    }
};
template <int MODE> struct EpiGate {
    static constexpr bool PERM = true, AFTER_DRAIN = false; static constexpr int TAG = 3;
    bf16_t* out; const bf16_t* gates; int gcol0; unsigned char* out8;
    __device__ __forceinline__ void prefetch(const Unit&, PG8_LAS unsigned char*, int, int) const {}
    __device__ __forceinline__ void operator()(const f32x4 (&acc)[2][2][4][2], const Unit& u, int wr, int wc, int fr, int fq, const PG8_LAS unsigned char*) const {
        const int row0 = u.arow + wr * 64 + fr, col0 = u.brow + wc * 32 + 8 * fq;
        u32x2 gv[8][2];
#pragma unroll
        for (int gi = 0; gi < 4; ++gi) { const size_t r = (size_t)(row0 + (gi >> 2) * HALF + (gi & 3) * 16);
#pragma unroll
            for (int bj = 0; bj < 2; ++bj) gv[gi][bj] = *(const u32x2*)((const unsigned char*)gates + r * NGATE + gcol0 + col0 + bj * HALF); }
        u32x4 mv[2], mn[2];
        if (MODE == 1) {
#pragma unroll
            for (int bj = 0; bj < 2; ++bj) mv[bj] = *(const u32x4*)(out + (size_t)row0 * D + col0 + bj * HALF); }
#pragma unroll
        for (int gi = 0; gi < 8; ++gi) { const int ai = gi >> 2, m = gi & 3; const size_t r = (size_t)(row0 + ai * HALF + m * 16);
            if (gi == 1) {
#pragma unroll
                for (int g2 = 4; g2 < 8; ++g2) { const size_t r2 = (size_t)(row0 + (g2 >> 2) * HALF + (g2 & 3) * 16);
#pragma unroll
                    for (int bj = 0; bj < 2; ++bj) gv[g2][bj] = *(const u32x2*)((const unsigned char*)gates + r2 * NGATE + gcol0 + col0 + bj * HALF); } }
            if (MODE == 1 && gi + 1 < 8) { const size_t rn = (size_t)(row0 + ((gi + 1) >> 2) * HALF + ((gi + 1) & 3) * 16);
#pragma unroll
                for (int bj = 0; bj < 2; ++bj) mn[bj] = *(const u32x4*)(out + rn * D + col0 + bj * HALF); }
#pragma unroll
            for (int bj = 0; bj < 2; ++bj) { const int c = col0 + bj * HALF; const u32x2 g4 = gv[gi][bj]; const f32x4 a0 = acc[ai][bj][m][0], a1 = acc[ai][bj][m][1];
                const f32x2 ga = __builtin_amdgcn_cvt_pk_f32_fp8(g4.x, false), gb = __builtin_amdgcn_cvt_pk_f32_fp8(g4.x, true), gc = __builtin_amdgcn_cvt_pk_f32_fp8(g4.y, false), gd = __builtin_amdgcn_cvt_pk_f32_fp8(g4.y, true);
                float o[8]; o[0] = sigm(ga.x) * a0[0]; o[1] = sigm(ga.y) * a0[1]; o[2] = sigm(gb.x) * a0[2]; o[3] = sigm(gb.y) * a0[3];
                o[4] = sigm(gc.x) * a1[0]; o[5] = sigm(gc.y) * a1[1]; o[6] = sigm(gd.x) * a1[2]; o[7] = sigm(gd.y) * a1[3];
                if (MODE == 1) { const u32x4 m4 = mv[bj];
                    o[0] += bflo(m4.x); o[1] += bfhi(m4.x); o[2] += bflo(m4.y); o[3] += bfhi(m4.y); o[4] += bflo(m4.z); o[5] += bfhi(m4.z); o[6] += bflo(m4.w); o[7] += bfhi(m4.w); }
                if (MODE == 1) { u32x2 w8; w8.x = pk4_fp8(o[0], o[1], o[2], o[3]); w8.y = pk4_fp8(o[4], o[5], o[6], o[7]); *(u32x2*)(out8 + r * D + c) = w8; }
                else { u32x4 w; w.x = cvt_pk_bf16(o[0], o[1]); w.y = cvt_pk_bf16(o[2], o[3]); w.z = cvt_pk_bf16(o[4], o[5]); w.w = cvt_pk_bf16(o[6], o[7]);
                    *(u32x4*)(out + r * D + c) = w; } }
            asm volatile("" ::: "memory");
            if (MODE == 1) {
#pragma unroll
                for (int bj = 0; bj < 2; ++bj) mv[bj] = mn[bj]; } }
    }
};
struct EpiX1 {
    static constexpr bool PERM = true, AFTER_DRAIN = false; static constexpr int TAG = 4;
    const float* x; float* out;
    __device__ __forceinline__ void prefetch(const Unit&, PG8_LAS unsigned char*, int, int) const {}
    __device__ __forceinline__ void operator()(const f32x4 (&acc)[2][2][4][2], const Unit& u, int wr, int wc, int fr, int fq, const PG8_LAS unsigned char*) const {
        const int row0 = u.arow + wr * 64 + fr, col0 = u.brow + wc * 32 + 8 * fq;
        f32x4 xv[2][2], xn[2][2];
#pragma unroll
        for (int bj = 0; bj < 2; ++bj) { const size_t o = (size_t)row0 * D + col0 + bj * HALF; xv[bj][0] = *(const f32x4*)(x + o); xv[bj][1] = *(const f32x4*)(x + o + 4); }
#pragma unroll
        for (int gi = 0; gi < 8; ++gi) { const int ai = gi >> 2, m = gi & 3; const size_t r = (size_t)(row0 + ai * HALF + m * 16);
            if (gi + 1 < 8) { const size_t rn = (size_t)(row0 + ((gi + 1) >> 2) * HALF + ((gi + 1) & 3) * 16);
#pragma unroll
                for (int bj = 0; bj < 2; ++bj) { const size_t o = rn * D + col0 + bj * HALF; xn[bj][0] = *(const f32x4*)(x + o); xn[bj][1] = *(const f32x4*)(x + o + 4); } }
#pragma unroll
            for (int bj = 0; bj < 2; ++bj) { const size_t o = r * D + col0 + bj * HALF;
                *(f32x4*)(out + o) = xv[bj][0] + acc[ai][bj][m][0]; *(f32x4*)(out + o + 4) = xv[bj][1] + acc[ai][bj][m][1]; }
            asm volatile("" ::: "memory");
#pragma unroll
            for (int bj = 0; bj < 2; ++bj) { xv[bj][0] = xn[bj][0]; xv[bj][1] = xn[bj][1]; } }
    }
};
struct EpiSwiglu {
    static constexpr bool PERM = true, AFTER_DRAIN = false; static constexpr int TAG = 7;
    unsigned char* act; const float* bg; const float* bu;
    __device__ __forceinline__ void prefetch(const Unit& u, PG8_LAS unsigned char* slot, int wid, int lane) const {
        if (wid == 0) { const int pn = (u.brow >> 8) & 7; const float* src = ((lane < 32) ? bg : bu) + (size_t)u.e * D + pn * HALF + 4 * (lane & 31);
            __builtin_amdgcn_global_load_lds((const unsigned*)src, (PG8_LAS unsigned*)slot, 16, 0, 0); } }
    __device__ __forceinline__ void operator()(const f32x4 (&acc)[2][2][4][2], const Unit& u, int wr, int wc, int fr, int fq, const PG8_LAS unsigned char* slot) const {
        const int pn = (u.brow >> 8) & 7; const int col0 = pn * HALF + wc * 32 + 8 * fq; const int rl0 = wr * 64 + fr;
        const PG8_LAS f32x4* bl = (const PG8_LAS f32x4*)(slot + (wc * 32 + 8 * fq) * 4);
        const f32x4 g0 = bl[0], g1 = bl[1], u0 = bl[32], u1 = bl[33];
#pragma unroll
        for (int ai = 0; ai < 2; ++ai)
#pragma unroll
            for (int m = 0; m < 4; ++m) { const int rl = rl0 + ai * HALF + m * 16;
                const f32x4 ga = acc[ai][0][m][0] + g0, gb = acc[ai][0][m][1] + g1, ua = acc[ai][1][m][0] + u0, ub = acc[ai][1][m][1] + u1;
                float o[8];
#pragma unroll
                for (int j = 0; j < 4; ++j) { const float gt = fminf(ga[j], 7.f), up = fminf(fmaxf(ua[j], -7.f), 7.f); o[j] = gt * sigm(1.702f * gt) * (up + 1.f);
                    const float gt2 = fminf(gb[j], 7.f), up2 = fminf(fmaxf(ub[j], -7.f), 7.f); o[4 + j] = gt2 * sigm(1.702f * gt2) * (up2 + 1.f); }
                u32x2 w; w.x = pk4_fp8(o[0], o[1], o[2], o[3]); w.y = pk4_fp8(o[4], o[5], o[6], o[7]);
                if (rl < u.nrows) *(u32x2*)(act + (size_t)(u.arow + rl) * D + col0) = w; }
    }
};
struct EpiDown {
    static constexpr bool PERM = true, AFTER_DRAIN = false; static constexpr int TAG = 8;
    unsigned char* ys; const float* bd;
    __device__ __forceinline__ void prefetch(const Unit& u, PG8_LAS unsigned char* slot, int wid, int lane) const {
        if (wid == 0) { const int pn = (u.brow >> 8) & 3; __builtin_amdgcn_global_load_lds((const unsigned*)(bd + (size_t)u.e * D + pn * BM + 4 * lane), (PG8_LAS unsigned*)slot, 16, 0, 0); } }
    __device__ __forceinline__ void operator()(const f32x4 (&acc)[2][2][4][2], const Unit& u, int wr, int wc, int fr, int fq, const PG8_LAS unsigned char* slot) const {
        const int pn = (u.brow >> 8) & 3; const int col0 = pn * BM + wc * 32 + 8 * fq; const int rl0 = wr * 64 + fr;
        f32x4 bv[2][2];
#pragma unroll
        for (int bj = 0; bj < 2; ++bj)
#pragma unroll
            for (int n = 0; n < 2; ++n) bv[bj][n] = *(const PG8_LAS f32x4*)(slot + (wc * 32 + 8 * fq + bj * HALF + 4 * n) * 4);
#pragma unroll
        for (int ai = 0; ai < 2; ++ai)
#pragma unroll
            for (int m = 0; m < 4; ++m) { const int rl = rl0 + ai * HALF + m * 16; unsigned char* rowp = ys + (size_t)(u.arow + rl) * D + col0;
#pragma unroll
                for (int bj = 0; bj < 2; ++bj) { const f32x4 v0 = acc[ai][bj][m][0] + bv[bj][0], v1 = acc[ai][bj][m][1] + bv[bj][1];
                    u32x2 w; w.x = pk4_fp8(v0[0], v0[1], v0[2], v0[3]); w.y = pk4_fp8(v1[0], v1[1], v1[2], v1[3]);
                    if (rl < u.nrows) *(u32x2*)(rowp + bj * HALF) = w; } }
    }
};

typedef int i32x4_t __attribute__((ext_vector_type(4))); typedef int i32x8_t __attribute__((ext_vector_type(8)));
template <bool FP8> struct Frag;
template <> struct Frag<false> { bf16x8 v[2];
    __device__ __forceinline__ void ld(const PG8_LAS unsigned char* p) { v[0] = *(const PG8_LAS bf16x8*)p; v[1] = *(const PG8_LAS bf16x8*)(p + 1024); } };
template <> struct Frag<true> { i32x8_t v;
    __device__ __forceinline__ void ld(const PG8_LAS unsigned char* p) { const i32x4_t lo = *(const PG8_LAS i32x4_t*)p, hi = *(const PG8_LAS i32x4_t*)(p + 1024); v = __builtin_shufflevector(lo, hi, 0, 1, 2, 3, 4, 5, 6, 7); } };
__device__ __forceinline__ f32x4 mma_frag(const Frag<false>& w, const Frag<false>& x, f32x4 c) {
    c = __builtin_amdgcn_mfma_f32_16x16x32_bf16(w.v[0], x.v[0], c, 0, 0, 0); return __builtin_amdgcn_mfma_f32_16x16x32_bf16(w.v[1], x.v[1], c, 0, 0, 0); }
__device__ __forceinline__ f32x4 mma_frag(const Frag<true>& w, const Frag<true>& x, f32x4 c) {
    const int sa = 0x7A7A7A7A, sb = 0x7F7F7F7F;
    asm volatile("v_mfma_scale_f32_16x16x128_f8f6f4 %0, %1, %2, %0, %3, %4 op_sel_hi:[0,0,0]" : "+v"(c) : "v"(w.v), "v"(x.v), "v"(sa), "v"(sb));
    return c; }
template <class Epi, class Sched, bool ALIGN_EPI = false, bool SP2 = false, bool FP8 = false>
__device__ __forceinline__ void gemm_phase(PG8_LAS unsigned char* lds, const Gemm g, const Sched& S, const Epi& E) {
    const int tid = threadIdx.x, wid = __builtin_amdgcn_readfirstlane(tid >> 6), lane = tid & 63, wr = wid >> 2, wc = wid & 3, fr = lane & 15, fq = lane >> 4;
    const int K = g.K, nt = K / BK;
    unsigned voffA[2], voffB[2];
#pragma unroll
    for (int i = 0; i < 2; ++i) { int R, C; stage_rc(tid * 16 + i * 8192, R, C); const int Rb = Epi::PERM ? ((R & ~31) + perm32(R & 31)) : R;
        voffA[i] = (unsigned)(R * K + C) * 2u; voffB[i] = (unsigned)(Rb * K + C) * 2u; }
    const size_t kstep = (size_t)(BK * 2);
    const size_t hstep = (size_t)HALF * K * 2;
    const size_t rowb = (size_t)K * 2;
    const unsigned ldsw = (unsigned)wid * 1024u;
    const int aoff = lds_byte(wr * 64 + fr, fq * 8), boff = lds_byte(wc * 32 + fr, fq * 8);
#define PG8_SA(b, h) (((b) * 2 + (h)) * HTB)
#define PG8_SB(b, h) ((4 + (b) * 2 + (h)) * HTB)
#define PG8_STAGE(bufoff, gbase, voff) do { _Pragma("unroll") for (int _i = 0; _i < 2; ++_i) \
        __builtin_amdgcn_global_load_lds((const unsigned*)((const char*)(gbase) + (voff)[_i]), (PG8_LAS unsigned*)(lds + (bufoff) + ldsw + _i * 8192), 16, 0, 0); } while (0)
#define PG8_LDA(dst, b, h) do { _Pragma("unroll") for (int m = 0; m < 4; ++m) dst[m].ld(lds + PG8_SA(b, h) + aoff + m * 2048); } while (0)
#define PG8_LDB(dst, b, h) do { _Pragma("unroll") for (int n = 0; n < 2; ++n) dst[n].ld(lds + PG8_SB(b, h) + boff + n * 2048); } while (0)
#define PG8_MMA(ai, bj, At, Bt) do { __builtin_amdgcn_s_setprio(1); _Pragma("unroll") for (int m = 0; m < 4; ++m) _Pragma("unroll") for (int n = 0; n < 2; ++n) \
        acc[ai][bj][m][n] = mma_frag(Bt[n], At[m], acc[ai][bj][m][n]); __builtin_amdgcn_s_setprio(0); } while (0)
#define PG8_WAIT_V(n) asm volatile("s_waitcnt vmcnt(" #n ")" ::: "memory")
#define PG8_WAIT_L(n) asm volatile("s_waitcnt lgkmcnt(" #n ")" ::: "memory")
#define PG8_BAR __builtin_amdgcn_s_barrier()
#define PG8_SCHED __builtin_amdgcn_sched_barrier(0)
    Unit cur, nxt; int ui = 0;
    if (!S.next(0, cur)) return;
    f32x4 acc[2][2][4][2];
#pragma unroll
    for (int a = 0; a < 2; ++a)
#pragma unroll
        for (int b = 0; b < 2; ++b)
#pragma unroll
            for (int m = 0; m < 4; ++m)
#pragma unroll
                for (int n = 0; n < 2; ++n) acc[a][b][m][n] = (f32x4){0.f, 0.f, 0.f, 0.f};
    Frag<FP8> At[4], B0[2], B1[2];
    const char* cA = (const char*)(cur.swap ? g.Bt : g.A) + (size_t)cur.arow * rowb; const char* cB = (const char*)(cur.swap ? g.A : g.Bt) + (size_t)cur.brow * rowb;
    S.a_ready(cur);
    PG8_LAS unsigned char* const blds = lds + 131072 + 4096;
    E.prefetch(cur, blds, wid, lane);
    if constexpr (SP2) {
        PG8_STAGE(PG8_SB(0, 0), cB, voffB); PG8_STAGE(PG8_SB(0, 1), cB + hstep, voffB); PG8_STAGE(PG8_SA(0, 0), cA, voffA); PG8_STAGE(PG8_SA(0, 1), cA + hstep, voffA);
        if (wr == 1) PG8_BAR;
        PG8_WAIT_V(2); PG8_BAR;
        PG8_STAGE(PG8_SB(1, 0), cB + kstep, voffB); PG8_STAGE(PG8_SA(1, 0), cA + kstep, voffA); PG8_STAGE(PG8_SB(1, 1), cB + hstep + kstep, voffB);
        PG8_WAIT_V(6); PG8_BAR;
    } else {
        PG8_STAGE(PG8_SB(0, 0), cB, voffB); PG8_STAGE(PG8_SA(0, 0), cA, voffA); PG8_STAGE(PG8_SB(0, 1), cB + hstep, voffB); PG8_STAGE(PG8_SA(0, 1), cA + hstep, voffA);
        if (wr == 1) PG8_BAR;
        PG8_WAIT_V(4); PG8_BAR;
        PG8_STAGE(PG8_SB(1, 0), cB + kstep, voffB); PG8_STAGE(PG8_SA(1, 0), cA + kstep, voffA); PG8_STAGE(PG8_SB(1, 1), cB + hstep + kstep, voffB);
        PG8_WAIT_V(6); PG8_BAR;
    }
    for (;;) {
        const bool has_next = S.next(ui + 1, nxt);
        const char* nA = has_next ? (const char*)(nxt.swap ? g.Bt : g.A) + (size_t)nxt.arow * rowb : cA; const char* nB = has_next ? (const char*)(nxt.swap ? g.A : g.Bt) + (size_t)nxt.brow * rowb : cB;
        for (int t = 0; t < nt; t += 2) {
            const bool last = (t == nt - 2);
            const char* a1 = cA + (size_t)(t + 1) * kstep;
            const char* a2 = last ? nA : cA + (size_t)(t + 2) * kstep; const char* b2 = last ? nB : cB + (size_t)(t + 2) * kstep;
            const char* a3 = a2 + kstep; const char* b3 = b2 + kstep;
            if (last && has_next) { S.a_ready(nxt); E.prefetch(nxt, blds + (((ui + 1) & 1) << 10), wid, lane); }
            if constexpr (SP2) {
            PG8_LDB(B0, 0, 0); PG8_LDB(B1, 0, 1); PG8_SCHED; PG8_LDA(At, 0, 0); PG8_STAGE(PG8_SA(1, 1), a1 + hstep, voffA);
            PG8_WAIT_V(8); PG8_WAIT_L(0); PG8_BAR; PG8_MMA(0, 0, At, B0); PG8_MMA(0, 1, At, B1); PG8_BAR; PG8_SCHED;
            PG8_LDA(At, 0, 1); PG8_STAGE(PG8_SB(0, 0), b2, voffB); PG8_STAGE(PG8_SB(0, 1), b2 + hstep, voffB); PG8_STAGE(PG8_SA(0, 0), a2, voffA);
            PG8_WAIT_V(8); PG8_WAIT_L(0); PG8_BAR; PG8_MMA(1, 0, At, B0); PG8_MMA(1, 1, At, B1); PG8_BAR; PG8_SCHED;
            PG8_LDB(B0, 1, 0); PG8_LDB(B1, 1, 1); PG8_SCHED; PG8_LDA(At, 1, 0); PG8_STAGE(PG8_SA(0, 1), a2 + hstep, voffA);
            PG8_WAIT_V(8); PG8_WAIT_L(0); PG8_BAR; PG8_MMA(0, 0, At, B0); PG8_MMA(0, 1, At, B1); PG8_BAR; PG8_SCHED;
            PG8_LDA(At, 1, 1); PG8_STAGE(PG8_SB(1, 0), b3, voffB); PG8_STAGE(PG8_SB(1, 1), b3 + hstep, voffB); PG8_STAGE(PG8_SA(1, 0), a3, voffA);
            PG8_WAIT_V(8); PG8_WAIT_L(0); PG8_BAR; PG8_MMA(1, 0, At, B0); PG8_MMA(1, 1, At, B1); PG8_BAR; PG8_SCHED;
            } else {
            PG8_LDB(B0, 0, 0); PG8_SCHED; PG8_LDA(At, 0, 0); PG8_STAGE(PG8_SA(1, 1), a1 + hstep, voffA);
            PG8_WAIT_L(8); PG8_BAR; PG8_WAIT_L(0); PG8_MMA(0, 0, At, B0); PG8_BAR; PG8_SCHED;
            PG8_LDB(B1, 0, 1); PG8_STAGE(PG8_SB(0, 0), b2, voffB);
            PG8_BAR; PG8_WAIT_L(0); PG8_MMA(0, 1, At, B1); PG8_BAR;
            PG8_LDA(At, 0, 1); PG8_STAGE(PG8_SA(0, 0), a2, voffA);
            PG8_BAR; PG8_WAIT_L(0); PG8_MMA(1, 0, At, B0); PG8_BAR; PG8_SCHED;
            PG8_STAGE(PG8_SB(0, 1), b2 + hstep, voffB);
            PG8_WAIT_V(6); PG8_BAR; PG8_MMA(1, 1, At, B1); PG8_BAR;
            PG8_LDB(B0, 1, 0); PG8_SCHED; PG8_LDA(At, 1, 0); PG8_STAGE(PG8_SA(0, 1), a2 + hstep, voffA);
            PG8_WAIT_L(8); PG8_BAR; PG8_WAIT_L(0); PG8_MMA(0, 0, At, B0); PG8_BAR; PG8_SCHED;
            PG8_LDB(B1, 1, 1); PG8_STAGE(PG8_SB(1, 0), b3, voffB);
            PG8_BAR; PG8_WAIT_L(0); PG8_MMA(0, 1, At, B1); PG8_BAR;
            PG8_LDA(At, 1, 1); PG8_STAGE(PG8_SA(1, 0), a3, voffA);
            PG8_BAR; PG8_WAIT_L(0); PG8_MMA(1, 0, At, B0); PG8_BAR; PG8_SCHED;
            PG8_STAGE(PG8_SB(1, 1), b3 + hstep, voffB);
            PG8_WAIT_V(6); PG8_BAR; PG8_MMA(1, 1, At, B1); PG8_BAR;
            }
        }
        if constexpr (ALIGN_EPI) { if (wr == 0) PG8_BAR; }
        if constexpr (FP8) {
#define PG8_ACC8(a, b) "+v"(acc[a][b][0][0]), "+v"(acc[a][b][0][1]), "+v"(acc[a][b][1][0]), "+v"(acc[a][b][1][1]), "+v"(acc[a][b][2][0]), "+v"(acc[a][b][2][1]), "+v"(acc[a][b][3][0]), "+v"(acc[a][b][3][1])
            asm volatile("s_nop 15\n\ts_nop 15" : PG8_ACC8(0, 0), PG8_ACC8(0, 1) :: "memory");
            asm volatile("" : PG8_ACC8(1, 0), PG8_ACC8(1, 1) :: "memory");
#undef PG8_ACC8
        }
#ifdef MK_EPI2
        if constexpr (Epi::TAG == MK_EPI2) { E(acc, cur, wr, wc, fr, fq, blds + ((ui & 1) << 10)); asm volatile("" ::: "memory"); }
#endif
        if constexpr (!Epi::AFTER_DRAIN) { E(acc, cur, wr, wc, fr, fq, blds + ((ui & 1) << 10)); S.done(cur); }
        if (!has_next) break;
#pragma unroll
        for (int a = 0; a < 2; ++a)
#pragma unroll
            for (int b = 0; b < 2; ++b)
#pragma unroll
                for (int m = 0; m < 4; ++m)
#pragma unroll
                    for (int n = 0; n < 2; ++n) acc[a][b][m][n] = (f32x4){0.f, 0.f, 0.f, 0.f};
        cur = nxt; cA = nA; cB = nB; ++ui;
        if constexpr (ALIGN_EPI) { if (wr == 1) PG8_BAR; }
    }
    PG8_WAIT_V(0);
    if constexpr (!ALIGN_EPI) { if (wr == 0) PG8_BAR; }
    PG8_BAR;
    if constexpr (Epi::AFTER_DRAIN) { E.fused(acc, cur, wr, wc, fr, fq, lds, wid, lane); S.done(cur); }
#undef PG8_SA
#undef PG8_SB
#undef PG8_STAGE
#undef PG8_LDA
#undef PG8_LDB
#undef PG8_MMA
#undef PG8_WAIT_V
#undef PG8_WAIT_L
#undef PG8_BAR
#undef PG8_SCHED
}

}

#define XB_TMO      128
#define XB_XCNT(j)  (256  + 64 * (j))
#define XB_XSUB(j)  (1280 + 64 * (j))
#define XB_XGEN(j)  (2304 + 64 * (j))
#define XB_TOP      3328
#define XB_TOPGEN   3392
#define XCD_BAR_WORDS 3456
#define XB_SPIN_CAP (1u << 18)
__device__ __forceinline__ unsigned xb_ld(unsigned* p)              { return __hip_atomic_load(p, __ATOMIC_RELAXED, __HIP_MEMORY_SCOPE_AGENT); }
__device__ __forceinline__ unsigned xb_add(unsigned* p, unsigned v) { return __hip_atomic_fetch_add(p, v, __ATOMIC_RELAXED, __HIP_MEMORY_SCOPE_AGENT); }
__device__ __forceinline__ unsigned xb_xcc_id() { return (unsigned)__builtin_amdgcn_s_getreg((3 << 11) | 20) & 0xFu; }
#define XB_SPIN(cond, bar) do { unsigned _sp = 0; while (cond) { __builtin_amdgcn_s_sleep(1); \
    if ((++_sp & 255u) == 0u) { if (xb_ld(&(bar)[XB_TMO])) break; if (_sp > XB_SPIN_CAP) { atomicAdd(&(bar)[XB_TMO], 1u); break; } } } } while (0)
struct XcdBarrier { unsigned* bar; unsigned x; volatile LAS unsigned* st; };
__device__ __forceinline__ XcdBarrier xcd_barrier_post(unsigned* bar, volatile LAS unsigned* st) {
    XcdBarrier b; b.bar = bar; b.x = xb_xcc_id(); b.st = st;
    if (threadIdx.x == 0) (void)xb_add(&bar[XB_XCNT(b.x)], 1u);
    return b;
}
__device__ __forceinline__ void xcd_barrier_complete(unsigned* bar, unsigned x, unsigned& nloc, unsigned& nx) {
    const unsigned G = gridDim.x * gridDim.y * gridDim.z;
    unsigned sum, cnt, mine, sp = 0u;
    for (;;) {
        sum = 0u; cnt = 0u; mine = 0u;
#pragma unroll
        for (unsigned j = 0; j < 16; ++j) { const unsigned c = xb_ld(&bar[XB_XCNT(j)]); sum += c; cnt += (c > 0u) ? 1u : 0u; mine = (j == x) ? c : mine; }
        if (sum == G) break;
        __builtin_amdgcn_s_sleep(1);
        if ((++sp & 255u) == 0u) { if (xb_ld(&bar[XB_TMO])) break; if (sp > XB_SPIN_CAP) { atomicAdd(&bar[XB_TMO], 1u); break; } }
    }
    nloc = mine > 0u ? mine : 1u; nx = cnt > 0u ? cnt : 1u;
}
__device__ __forceinline__ void xcd_barrier(const XcdBarrier& b) {
    asm volatile("s_waitcnt vmcnt(0)" ::: "memory");
    __syncthreads();
    if (threadIdx.x == 0) {
        unsigned* bar = b.bar;
        __builtin_amdgcn_s_waitcnt(0);
        unsigned nloc = b.st[0], nx = b.st[1];
        if (nloc == 0u) { xcd_barrier_complete(bar, b.x, nloc, nx); b.st[0] = nloc; b.st[1] = nx; }
        const unsigned old = xb_add(&bar[XB_XSUB(b.x)], 1u);
        const unsigned gen = old / nloc;
        if (old + 1u == (gen + 1u) * nloc) {
            __builtin_amdgcn_fence(__ATOMIC_RELEASE, "agent");
            asm volatile("s_waitcnt vmcnt(0)" ::: "memory");
            const unsigned og = xb_add(&bar[XB_TOP], 1u);
            const unsigned tg = og / nx;
            if (og + 1u == (tg + 1u) * nx) xb_add(&bar[XB_TOPGEN], 1u);
            else XB_SPIN(xb_ld(&bar[XB_TOPGEN]) == tg, bar);
            __builtin_amdgcn_fence(__ATOMIC_ACQUIRE, "agent");
            xb_add(&bar[XB_XGEN(b.x)], 1u);
            asm volatile("s_waitcnt vmcnt(0)" ::: "memory");
        } else {
            XB_SPIN(xb_ld(&bar[XB_XGEN(b.x)]) == gen, bar);
            __builtin_amdgcn_fence(__ATOMIC_ACQUIRE, "agent");
            asm volatile("s_waitcnt vmcnt(0)" ::: "memory");
        }
    }
    __syncthreads();
}

constexpr int NWAVES = 8;
constexpr int RING_OFF = 0, RING_BYTES = 131072;
constexpr int LDSCTL_OFF = RING_BYTES, MISC_OFF = LDSCTL_OFF + 320;
constexpr int TBL_OFF = LDSCTL_OFF + 1024;
constexpr int LDS_BYTES = 147456;

struct Frame {
    LAS unsigned char* lds; volatile LAS unsigned* MISC; LAS int* tbl; gu32* ctl;
    int tid, lane, wave, vcu, G;
};

__device__ __forceinline__ void p0_transpose_item(const float* W, int K, int N, bf16* WT, int k0, int n0, int orow0, LAS float* scr, int lane) {
#pragma unroll 8
    for (int i = 0; i < 32; ++i) { const int kk = 2 * i + (lane >> 5); scr[kk * 33 + (lane & 31)] = W[(size_t)(k0 + kk) * N + n0 + (lane & 31)]; }
    LDS_WAIT(); asm volatile("" ::: "memory");
    const int c = lane & 7;
#pragma unroll
    for (int j = 0; j < 4; ++j) { const int n = (lane >> 3) + 8 * j; const LAS float* s = scr + (8 * c) * 33 + n;
        u32x4 o; o.x = pk2(s[0 * 33], s[1 * 33]); o.y = pk2(s[2 * 33], s[3 * 33]); o.z = pk2(s[4 * 33], s[5 * 33]); o.w = pk2(s[6 * 33], s[7 * 33]);
        *(GAS u32x4*)(WT + (size_t)(orow0 + n) * K + k0 + 8 * c) = o; }
    LDS_WAIT(); asm volatile("" ::: "memory");
}
__device__ __forceinline__ void p0_transpose_item_fp8(const float* W, int K, int N, unsigned char* WT, int k0, int n0, int orow0, LAS float* scr, int lane) {
#pragma unroll 8
    for (int i = 0; i < 32; ++i) { const int kk = 2 * i + (lane >> 5); scr[kk * 33 + (lane & 31)] = W[(size_t)(k0 + kk) * N + n0 + (lane & 31)]; }
    LDS_WAIT(); asm volatile("" ::: "memory");
    const int c = lane & 7;
#pragma unroll
    for (int j = 0; j < 4; ++j) { const int n = (lane >> 3) + 8 * j; const LAS float* sp = scr + (8 * c) * 33 + n;
        u32x2 o; o.x = pk4_fp8(sp[0 * 33] * 32.f, sp[1 * 33] * 32.f, sp[2 * 33] * 32.f, sp[3 * 33] * 32.f); o.y = pk4_fp8(sp[4 * 33] * 32.f, sp[5 * 33] * 32.f, sp[6 * 33] * 32.f, sp[7 * 33] * 32.f);
        *(GAS u32x2*)(WT + (size_t)(orow0 + n) * K + k0 + 8 * c) = o; }
    LDS_WAIT(); asm volatile("" ::: "memory");
}
__device__ __forceinline__ void rms_row_to_bf16(const float* xrow, const float* g, bf16* orow, int lane) {
    const GAS f32x4* xr = (const GAS f32x4*)xrow + lane; f32x4 v[4]; float s = 0.f;
#pragma unroll
    for (int j = 0; j < 4; ++j) { v[j] = xr[64 * j]; s += (v[j].x * v[j].x + v[j].y * v[j].y) + (v[j].z * v[j].z + v[j].w * v[j].w); }
    const float rstd = 1.f / sqrtf(wave_sum(s) * (1.f / D) + EPS);
    GAS unsigned long long* o8 = (GAS unsigned long long*)orow + lane;
#pragma unroll
    for (int j = 0; j < 4; ++j) { const f32x4 gg = ((const GAS f32x4*)g)[lane + 64 * j];
        o8[64 * j] = (unsigned long long)pk2(v[j].x * rstd * gg.x, v[j].y * rstd * gg.y) | ((unsigned long long)pk2(v[j].z * rstd * gg.z, v[j].w * rstd * gg.w) << 32); }
}

__device__ __forceinline__ void rms_row_to_fp8(const float* xrow, const float* g, unsigned char* orow, unsigned char* orow4, unsigned char* orow16, int lane) {
    const GAS f32x4* xr = (const GAS f32x4*)xrow + lane; f32x4 v[4]; float s = 0.f;
#pragma unroll
    for (int j = 0; j < 4; ++j) { v[j] = xr[64 * j]; s += (v[j].x * v[j].x + v[j].y * v[j].y) + (v[j].z * v[j].z + v[j].w * v[j].w); }
    const float rstd = 1.f / sqrtf(wave_sum(s) * (1.f / D) + EPS);
    GAS unsigned* o4 = (GAS unsigned*)orow + lane; GAS unsigned* p4 = (GAS unsigned*)orow4 + lane; GAS unsigned* p16 = (GAS unsigned*)orow16 + lane;
#pragma unroll
    for (int j = 0; j < 4; ++j) { const f32x4 gg = ((const GAS f32x4*)g)[lane + 64 * j]; const unsigned w = pk4_fp8(v[j].x * rstd * gg.x, v[j].y * rstd * gg.y, v[j].z * rstd * gg.z, v[j].w * rstd * gg.w);
        o4[64 * j] = w; p4[64 * j] = w; p16[64 * j] = w; }
}
constexpr float LOG2E = 1.4426950408889634f;
typedef __bf16 bf16x2_t __attribute__((ext_vector_type(2)));
__device__ __forceinline__ unsigned cvtpk_v(float lo, float hi) { const f32x2 v = {lo, hi}; const bf16x2_t b = __builtin_convertvector(v, bf16x2_t); return __builtin_bit_cast(unsigned, b); }
struct AttFrags { long k0a, k0b, k1a, k1b; bf16x8 v[4]; };
__device__ __forceinline__ float gmax4(float m) {
    { auto rr = __builtin_amdgcn_permlane16_swap(__float_as_uint(m), __float_as_uint(m), false, false); m = fmaxf(__uint_as_float(rr[0]), __uint_as_float(rr[1])); }
    { auto rr = __builtin_amdgcn_permlane32_swap(__float_as_uint(m), __float_as_uint(m), false, false); m = fmaxf(__uint_as_float(rr[0]), __uint_as_float(rr[1])); }
    return m;
}
constexpr int RB_A = 160, RB_B = 320;
template <int NH, int RB>
__device__ __forceinline__ void band_group(f32x4 (&o)[NH][4], float (&mrun)[NH], float (&lrun)[NH], const unsigned char* qkvb, const int (&qcol)[NH], const int (&qmu0)[NH], int kcol, const bf16* vt,
                                           int dil, int rho, int L, int qstep, int P0, int npairs, const LAS float* const (&tab)[NH], int lane) {
    const int t = lane & 15, g = lane >> 4;
    long qf[NH][2]; int mu_t[NH];
#pragma unroll
    for (int h = 0; h < NH; ++h) { mu_t[h] = qmu0[h] + qstep * t; const unsigned char* qrow = qkvb + (size_t)(mu_t[h] * dil + rho) * NQKV + 8 * g + qcol[h];
        qf[h][0] = *(const long*)qrow; qf[h][1] = *(const long*)(qrow + 32); }
    const int npr = L >> 5;
    const unsigned char* kbase = qkvb + (size_t)rho * NQKV + kcol + 8 * g;
    const bf16* vtl = vt + (size_t)t * 8192 + (size_t)rho * L + 8 * g;
    auto load = [&](int P, AttFrags& f) {
        const int Pc = min(max(P, 0), npr - 1);
        const unsigned char* k0p = kbase + (size_t)((32 * Pc + t) * dil) * NQKV; const unsigned char* k1p = k0p + (size_t)(16 * dil) * NQKV;
        f.k0a = *(const long*)k0p; f.k0b = *(const long*)(k0p + 32); f.k1a = *(const long*)k1p; f.k1b = *(const long*)(k1p + 32);
#pragma unroll
        for (int db = 0; db < 4; ++db) f.v[db] = *(const bf16x8*)(vtl + (size_t)(16 * db) * 8192 + 32 * Pc);
    };
    AttFrags cur; load(P0, cur);
    for (int pp = 0; pp < npairs; ++pp) {
        const int P = P0 + pp;
        AttFrags nxt; load(P0 + min(pp + 1, npairs - 1), nxt);
        if (P >= 0 && P < npr) {
            const int kap0 = 32 * P + 4 * g;
#pragma unroll
            for (int h = 0; h < NH; ++h) {
                const LAS float* tb_ = tab[h] + (kap0 - mu_t[h] + RB);
                f32x4 s0 = (f32x4){tb_[0], tb_[1], tb_[2], tb_[3]}, s1 = (f32x4){tb_[16], tb_[17], tb_[18], tb_[19]};
                s0 = __builtin_amdgcn_mfma_f32_16x16x32_fp8_fp8(cur.k0a, qf[h][0], s0, 0, 0, 0); s0 = __builtin_amdgcn_mfma_f32_16x16x32_fp8_fp8(cur.k0b, qf[h][1], s0, 0, 0, 0);
                s1 = __builtin_amdgcn_mfma_f32_16x16x32_fp8_fp8(cur.k1a, qf[h][0], s1, 0, 0, 0); s1 = __builtin_amdgcn_mfma_f32_16x16x32_fp8_fp8(cur.k1b, qf[h][1], s1, 0, 0, 0);
                float mx = fmaxf(fmaxf(fmaxf(s0[0], s0[1]), fmaxf(s0[2], s0[3])), fmaxf(fmaxf(s1[0], s1[1]), fmaxf(s1[2], s1[3])));
                mx = gmax4(mx);
                if (__any(mx > mrun[h])) { const float mn = fmaxf(mrun[h], mx), alpha = __builtin_amdgcn_exp2f(mrun[h] - mn); mrun[h] = mn; lrun[h] *= alpha;
#pragma unroll
                    for (int db = 0; db < 4; ++db) o[h][db] = o[h][db] * alpha; }
                const float mn = mrun[h]; float p[8], ps = 0.f;
#pragma unroll
                for (int j = 0; j < 8; ++j) { p[j] = __builtin_amdgcn_exp2f(((j < 4) ? s0[j & 3] : s1[j & 3]) - mn); ps += p[j]; }
                lrun[h] += ps;
                u32x4 pw; pw.x = cvtpk_v(p[0], p[1]); pw.y = cvtpk_v(p[2], p[3]); pw.z = cvtpk_v(p[4], p[5]); pw.w = cvtpk_v(p[6], p[7]);
                const bf16x8 pf = __builtin_bit_cast(bf16x8, pw);
#pragma unroll
                for (int db = 0; db < 4; ++db) o[h][db] = __builtin_amdgcn_mfma_f32_16x16x32_bf16(cur.v[db], pf, o[h][db], 0, 0, 0);
                if (NH > 2 && h + 1 < NH) __builtin_amdgcn_sched_barrier(0);
            }
        }
        cur = nxt;
    }
}
template <int NH>
__device__ __forceinline__ void band_store(const f32x4 (&o)[NH][4], const float (&lrun)[NH], unsigned char* const (&yrow)[NH], int lane) {
    const int g = lane >> 4;
#pragma unroll
    for (int h = 0; h < NH; ++h) { float l = lrun[h]; l += __shfl_xor(l, 16); l += __shfl_xor(l, 32); const float inv = 1.f / l;
#pragma unroll
        for (int db = 0; db < 4; ++db) *(unsigned*)(yrow[h] + 16 * db + 4 * g) = pk4_fp8(o[h][db][0] * inv, o[h][db][1] * inv, o[h][db][2] * inv, o[h][db][3] * inv); }
}

struct Args { const float* in[19]; float* out; unsigned char* ws; int ph_lo, ph_hi, li, pad; };
constexpr int NPHASE = 10;

__global__ void __launch_bounds__(NWAVES * 64, 2) mk_fwd(Args args) {
    extern __shared__ __attribute__((aligned(16))) unsigned char lds[];
    Frame F;
    F.lds = (LAS unsigned char*)lds; F.MISC = (volatile LAS unsigned*)(F.lds + MISC_OFF); F.tbl = (LAS int*)(F.lds + TBL_OFF);
    F.tid = threadIdx.x; F.lane = F.tid & 63; F.wave = __builtin_amdgcn_readfirstlane(F.tid >> 6);
    F.G = gridDim.x; { const int bx = blockIdx.x; F.vcu = (F.G % 8 == 0) ? (bx % 8) * (F.G / 8) + bx / 8 : bx; }
    unsigned char* ws = args.ws; F.ctl = (gu32*)(ws + WS_CTL);
    const float* x = args.in[0]; const float* norm_mix = args.in[1]; const float* w_in = args.in[2]; const float* b_in = args.in[3];
    const float* sinks = args.in[4]; const float* rel_bias = args.in[5]; const float* w_a = args.in[6]; const float* w_b = args.in[7];
    const float* w_out = args.in[8]; const float* norm_ffn = args.in[9]; const float* router_w = args.in[10]; const float* router_b = args.in[11];
    const float* w_gate = args.in[12]; const float* b_gate = args.in[13]; const float* w_up = args.in[14]; const float* b_up = args.in[15];
    const float* w_down = args.in[16]; const float* b_down = args.in[17]; const float* norm_final = args.in[18];
    float* out = args.out;
    Tabs* tb = (Tabs*)(ws + WS_TAB);
    bf16* Win_t = (bf16*)(ws + WS_WIN); bf16* Wa_t = (bf16*)(ws + WS_WA); bf16* Wb_t = (bf16*)(ws + WS_WB); bf16* Wout_t = (bf16*)(ws + WS_WOUT);
    unsigned char* Wgu8 = ws + WS_WGU; unsigned char* Wd8 = ws + WS_WD; unsigned char* H28 = ws + WS_H2; unsigned char* HS8 = ws + WS_HS; unsigned char* ACT8 = ws + WS_ACT; unsigned char* YS = ws + WS_YS;
    int* topi = (int*)(ws + WS_RT); float* topp = (float*)(ws + WS_RT + 256 * 1024); int* slot = (int*)(ws + WS_RT + 512 * 1024); int* pos = (int*)(ws + WS_RT + 768 * 1024);
    bf16* XN = (bf16*)(ws + WS_XN); bf16* QKV = (bf16*)(ws + WS_QKV); bf16* GATES = (bf16*)(ws + WS_GATES); bf16* YA = (bf16*)(ws + WS_YA); bf16* YB = (bf16*)(ws + WS_YB);
    bf16* MERGED = (bf16*)(ws + WS_MERGED);
    gu32* cnt = F.ctl + CW_CNT;

    for (int u = F.tid; u < (LDS_BYTES - LDSCTL_OFF) / 4; u += NWAVES * 64) ((LAS unsigned*)(F.lds + LDSCTL_OFF))[u] = 0u;
    __syncthreads();
    XcdBarrier bar = xcd_barrier_post((unsigned*)(F.ctl + CW_BAR) + args.li * XCD_BAR_WORDS, F.MISC + 8);
    const int lo = args.ph_lo, hi = args.ph_hi;
#ifndef MK_SKIP
#define MK_SKIP 0
#endif
#define IN(k) (!((MK_SKIP >> (k)) & 1) && lo <= (k) && (k) < hi)
#ifndef MK_DUP
#define MK_DUP 0
#endif
#define REP(k) _Pragma("unroll") for (int rep_ = 0; rep_ < 1 + ((MK_DUP >> (k)) & 1); ++rep_)
#ifdef MK_TSTAMP
    unsigned long long ts_a = __builtin_amdgcn_s_memrealtime(), ts_b = ts_a;
#define SEAM(k) do { if (IN(k) && IN((k) + 1)) xcd_barrier(bar); if ((k) + 1 == MK_TSTAMP) ts_a = __builtin_amdgcn_s_memrealtime(); if ((k) == MK_TSTAMP) ts_b = __builtin_amdgcn_s_memrealtime(); } while (0)
#else
#define SEAM(k) do { if (IN(k) && IN((k) + 1)) xcd_barrier(bar); } while (0)
#endif
    const int gw = F.vcu * NWAVES + F.wave, NGW = F.G * NWAVES;

    LAS float* scr = (LAS float*)(F.lds + RING_OFF + F.wave * 16384);
    constexpr int I_IN = (D / 64) * (NPROJ / 32), I_A = (D / 64) * (D / 32), I_B = (256 / 64) * (D / 32), I_E = (D / 64) * (D / 32);
    constexpr int NITEMS = I_IN + 2 * I_A + I_B + 3 * NE * I_E;
    auto transpose_items = [&](int first, int last) {
    for (int it = first + gw; it < last; it += NGW) {
        int r = it;
        if (r < I_IN) { const int nb = NPROJ / 32; p0_transpose_item_fp8(w_in, D, NPROJ, (unsigned char*)Win_t, 64 * (r / nb), 32 * (r % nb), 32 * (r % nb), scr, F.lane); continue; } r -= I_IN;
        if (r < I_A) { const int nb = D / 32; p0_transpose_item_fp8(w_a, D, D, (unsigned char*)Wa_t, 64 * (r / nb), 32 * (r % nb), 32 * (r % nb), scr, F.lane); continue; } r -= I_A;
        if (r < I_A) { const int nb = D / 32; p0_transpose_item_fp8(w_out, D, D, (unsigned char*)Wout_t, 64 * (r / nb), 32 * (r % nb), 32 * (r % nb), scr, F.lane); continue; } r -= I_A;
        if (r < I_B) { const int nb = D / 32; p0_transpose_item_fp8(w_b, 256, D, (unsigned char*)Wb_t, 64 * (r / nb), 32 * (r % nb), 32 * (r % nb), scr, F.lane); continue; } r -= I_B;
        { const int e = r / (3 * I_E), q = r % (3 * I_E), which = q / I_E, ii = q % I_E, nb = D / 32, k0 = 64 * (ii / nb), n0 = 32 * (ii % nb);
          if (which == 0) p0_transpose_item_fp8(w_gate + (size_t)e * D * D, D, D, Wgu8, k0, n0, e * 2048 + (n0 >> 7) * 256 + (n0 & 127), scr, F.lane);
          else if (which == 1) p0_transpose_item_fp8(w_up + (size_t)e * D * D, D, D, Wgu8, k0, n0, e * 2048 + (n0 >> 7) * 256 + 128 + (n0 & 127), scr, F.lane);
          else p0_transpose_item_fp8(w_down + (size_t)e * D * D, D, D, Wd8, k0, n0, e * 1024 + n0, scr, F.lane); }
    }
    };
    if (IN(0)) REP(0) {
        { const int i = blockIdx.x * (NWAVES * 64) + F.tid;
          if (i < 16 * 257) { const int h = i / 257, r = i % 257; tb->biasA[h][r] = rel_bias[BKT_A[r] * 28 + h]; }
          if (i < 12 * 129) { const int g = i / (4 * 129), hs = (i / 129) % 4, r = i % 129; tb->biasB[g][hs][r] = rel_bias[BKT_B[g][r] * 28 + 16 + 4 * g + hs]; } }
        transpose_items(0, I_IN + 2 * I_A + I_B);
        for (int m = gw; m < T; m += NGW) { const int t0 = m & ~255, tl = m & 255;
            rms_row_to_fp8(x + (size_t)m * D, norm_mix, (unsigned char*)XN + (size_t)m * D, ws + WS_XNP + (size_t)(t0 + (tl & 3) * 64 + (tl >> 2)) * D,
                           ws + WS_XNP + (size_t)(T + t0 + (tl & 15) * 16 + (tl >> 4)) * D, F.lane); }
    }
    SEAM(0);
    if (IN(1)) REP(1) {
        int k512 = D / 2; asm volatile("" : "+s"(k512));
        pg8::Gemm g{XN, Win_t, k512}; pg8::ProjOrder So; So.so.init(T, NPROJ, F.G, (int)blockIdx.x);
        pg8::EpiProj E{QKV, GATES, b_in, (bf16*)(ws + WS_VT), (bf16*)(ws + WS_VT) + (size_t)2 * 4 * 64 * 8192};
        pg8::gemm_phase<pg8::EpiProj, pg8::ProjOrder, true, true, true>(F.lds + RING_OFF, g, So, E);
    }
    SEAM(1);
    int nrep2 = 1 + ((MK_DUP >> 2) & 1); asm volatile("" : "+s"(nrep2));
    if (IN(2)) for (int rep_ = 0; rep_ < nrep2; ++rep_) {
        LAS float* lb = (LAS float*)(F.lds + RING_OFF);
        constexpr int TA = 2 * RB_A + 1, TB = 2 * RB_B + 1;
        for (int i = F.tid; i < 16 * TA; i += NWAVES * 64) { const int h = i / TA, rel = i % TA - RB_A; lb[i] = (rel >= -128 && rel <= 128) ? tb->biasA[h][rel + 128] * LOG2E : -3.0e38f; }
        for (int i = F.tid; i < 12 * TB; i += NWAVES * 64) { const int gh = i / TB, rel = i % TB - RB_B; lb[16 * TA + i] = (rel >= -64 && rel <= 64) ? tb->biasB[gh >> 2][gh & 3][rel + 64] * LOG2E : -3.0e38f; }
        __syncthreads();
        const bf16* VTA = (const bf16*)(ws + WS_VT); const bf16* VTB = VTA + (size_t)2 * 4 * 64 * 8192;
        for (int it = gw; it < 4096 + 2048; it += NGW) {
            const int t = F.lane & 15;
            if (it < 4096) {
                const int b = it >> 11, kvh = (it >> 9) & 3, qb = it & 511;
                f32x4 o[4][4]; float mr[4], lr[4];
#pragma unroll
                for (int h = 0; h < 4; ++h) { mr[h] = sinks[kvh * 4 + h] * LOG2E; lr[h] = (F.lane < 16) ? 1.f : 0.f;
#pragma unroll
                    for (int db = 0; db < 4; ++db) o[h][db] = (f32x4){0.f, 0.f, 0.f, 0.f}; }
                const int qcol[4] = {C_QA + (kvh * 4 + 0) * 64, C_QA + (kvh * 4 + 1) * 64, C_QA + (kvh * 4 + 2) * 64, C_QA + (kvh * 4 + 3) * 64};
                const int qmu[4] = {16 * qb, 16 * qb, 16 * qb, 16 * qb};
                const LAS float* const bias[4] = {lb + (kvh * 4 + 0) * TA, lb + (kvh * 4 + 1) * TA, lb + (kvh * 4 + 2) * TA, lb + (kvh * 4 + 3) * TA};
                band_group<4, RB_A>(o, mr, lr, (const unsigned char*)QKV + (size_t)b * S * NQKV, qcol, qmu, C_KA + kvh * 64, VTA + (size_t)((b * 4 + kvh) * 64) * 8192, 1, 0, S, 1, (qb - 8) >> 1, 9, bias, F.lane);
                unsigned char* yr = (unsigned char*)YA + (size_t)(b * S + 16 * qb + t) * D + kvh * 256; unsigned char* const yrow[4] = {yr, yr + 64, yr + 128, yr + 192};
                band_store<4>(o, lr, yrow, F.lane);
            } else {
                const int j = it - 4096, r = j & 7, un = j >> 3, blk = un & 31, hs = (un >> 5) & 3, b = un >> 7, i0 = blk * 256;
                f32x4 o[2][4]; float mr[2], lr[2];
#pragma unroll
                for (int h = 0; h < 2; ++h) { mr[h] = -1.0e30f; lr[h] = 0.f;
#pragma unroll
                    for (int db = 0; db < 4; ++db) o[h][db] = (f32x4){0.f, 0.f, 0.f, 0.f}; }
                const unsigned char* qb_ = (const unsigned char*)QKV + (size_t)b * S * NQKV;
                { const int qcol[2] = {C_QB + 0 * 256 + hs * 64, C_QB + 0 * 256 + hs * 64}; const int qmu[2] = {i0 + r, i0 + r + 8}; const LAS float* const bias[2] = {lb + 16 * TA + (0 * 4 + hs) * TB, lb + 16 * TA + (0 * 4 + hs) * TB};
                  band_group<2, RB_B>(o, mr, lr, qb_, qcol, qmu, C_KB + 0 * 256 + hs * 64, VTB + (size_t)(((0 * 2 + b) * 4 + hs) * 64) * 8192, 1, 0, S, 16, (i0 >> 5) - 2, 12, bias, F.lane); }
                { const int qcol[2] = {C_QB + 1 * 256 + hs * 64, C_QB + 1 * 256 + hs * 64}; const int qmu[2] = {(i0 + r) >> 2, (i0 + r + 8) >> 2}; const LAS float* const bias[2] = {lb + 16 * TA + (1 * 4 + hs) * TB, lb + 16 * TA + (1 * 4 + hs) * TB};
                  band_group<2, RB_B>(o, mr, lr, qb_, qcol, qmu, C_KB + 1 * 256 + hs * 64, VTB + (size_t)(((1 * 2 + b) * 4 + hs) * 64) * 8192, 4, r & 3, S / 4, 4, (i0 >> 7) - 2, 6, bias, F.lane); }
#pragma unroll
                for (int h = 0; h < 2; ++h) { const int qcol[1] = {C_QB + 2 * 256 + hs * 64}; const int qmu[1] = {i0 >> 4}; const LAS float* const bias[1] = {lb + 16 * TA + (2 * 4 + hs) * TB};
                  band_group<1, RB_B>(*(f32x4(*)[1][4])&o[h], *(float(*)[1])&mr[h], *(float(*)[1])&lr[h], qb_, qcol, qmu, C_KB + 2 * 256 + hs * 64, VTB + (size_t)(((2 * 2 + b) * 4 + hs) * 64) * 8192,
                                    16, r + 8 * h, S / 16, 1, (blk - 4) >> 1, 5, bias, F.lane); }
                unsigned char* yr = (unsigned char*)YB + (size_t)(b * S + i0 + r + 16 * t) * 256 + hs * 64; unsigned char* const yrow[2] = {yr, yr + 8 * 256};
                band_store<2>(o, lr, yrow, F.lane);
            }
        }
        __syncthreads();
    }
    SEAM(2);
    if (IN(3)) REP(3) {
#ifndef NO_P3A
        { int k256 = 128; asm volatile("" : "+s"(k256)); pg8::Gemm g{YB, Wb_t, k256};   pg8::StaticOrder So; So.init(T, D, F.G, (int)blockIdx.x);
          pg8::EpiGate<0> E{MERGED, GATES, 1024, nullptr};
          pg8::gemm_phase<pg8::EpiGate<0>, pg8::StaticOrder, true, true, true>(F.lds + RING_OFF, g, So, E); }
#endif
        VM_WAIT(); __syncthreads();
#ifndef NO_P3B
        { int k512 = D / 2; asm volatile("" : "+s"(k512)); pg8::Gemm g{YA, Wa_t, k512}; pg8::StaticOrder So; So.init(T, D, F.G, (int)blockIdx.x);
          pg8::EpiGate<1> E{MERGED, GATES, 0, (unsigned char*)YA + (size_t)16 * MiB};
          pg8::gemm_phase<pg8::EpiGate<1>, pg8::StaticOrder, true, true, true>(F.lds + RING_OFF, g, So, E); }
#endif
    }
    SEAM(3);
    if (IN(4)) REP(4) {
        int k512 = D / 2; asm volatile("" : "+s"(k512)); pg8::Gemm g{(const bf16*)((unsigned char*)YA + (size_t)16 * MiB), Wout_t, k512}; pg8::StaticOrder So; So.init(T, D, F.G, (int)blockIdx.x);
        pg8::EpiX1 E{x, out};
        pg8::gemm_phase<pg8::EpiX1, pg8::StaticOrder, true, true, true>(F.lds + RING_OFF, g, So, E);
    }
    SEAM(4);
    if (IN(5)) REP(5) {
        const bool lastrep5 = (rep_ + 1 == 1 + ((MK_DUP >> 5) & 1));
        LAS int* lcnt = F.tbl + 72; LAS int* lbase = F.tbl + 104; LAS int* ebuf = F.tbl + 136; LAS int* pbuf = F.tbl + 392;
        LAS float* plog = (LAS float*)(F.lds + RING_OFF);
        LAS float* psq = plog + 8 * 64 * 32;
        LAS float* rstd_s = psq + 512;
        const int g = F.lane >> 4, e16 = F.lane & 15, w = F.wave;
        float wB[32][2];
#pragma unroll
        for (int sc = 0; sc < 32; ++sc) { const int k = 128 * w + 32 * (sc >> 3) + 8 * g + (sc & 7); const float gm = norm_ffn[k];
            wB[sc][0] = gm * router_w[(size_t)k * NE + e16]; wB[sc][1] = gm * router_w[(size_t)k * NE + 16 + e16]; }
        for (int tblk = F.vcu; tblk < T / 64; tblk += F.G) {
            if (F.tid < 32) lcnt[F.tid] = 0;
            f32x4 v[4][2];
            { const GAS float* xr = (const GAS float*)out + (size_t)(tblk * 64 + e16) * D + 128 * w + 8 * g;
#pragma unroll
              for (int s4 = 0; s4 < 4; ++s4) { v[s4][0] = *(const GAS f32x4*)(xr + 32 * s4); v[s4][1] = *(const GAS f32x4*)(xr + 32 * s4 + 4); } }
#pragma unroll 1
            for (int tile = 0; tile < 4; ++tile) {
                f32x4 vn[4][2];
                { const int tn = tile < 3 ? tile + 1 : 3; const GAS float* xr = (const GAS float*)out + (size_t)(tblk * 64 + tn * 16 + e16) * D + 128 * w + 8 * g;
#pragma unroll
                  for (int s4 = 0; s4 < 4; ++s4) { vn[s4][0] = *(const GAS f32x4*)(xr + 32 * s4); vn[s4][1] = *(const GAS f32x4*)(xr + 32 * s4 + 4); } }
                float sq = 0.f;
#pragma unroll
                for (int s4 = 0; s4 < 4; ++s4) sq += (v[s4][0].x * v[s4][0].x + v[s4][0].y * v[s4][0].y) + (v[s4][0].z * v[s4][0].z + v[s4][0].w * v[s4][0].w)
                                                   + (v[s4][1].x * v[s4][1].x + v[s4][1].y * v[s4][1].y) + (v[s4][1].z * v[s4][1].z + v[s4][1].w * v[s4][1].w);
                sq += __shfl_xor(sq, 16); sq += __shfl_xor(sq, 32);
                if (g == 0) psq[w * 64 + tile * 16 + e16] = sq;
                f32x4 a0 = (f32x4){0.f, 0.f, 0.f, 0.f}, a1 = (f32x4){0.f, 0.f, 0.f, 0.f};
#pragma unroll
                for (int s4 = 0; s4 < 4; ++s4)
#pragma unroll
                    for (int c = 0; c < 8; ++c) { const float av = v[s4][c >> 2][c & 3];
                        a0 = __builtin_amdgcn_mfma_f32_16x16x4f32(av, wB[s4 * 8 + c][0], a0, 0, 0, 0); a1 = __builtin_amdgcn_mfma_f32_16x16x4f32(av, wB[s4 * 8 + c][1], a1, 0, 0, 0); }
#pragma unroll
                for (int r = 0; r < 4; ++r) { LAS float* pr = plog + (size_t)(w * 64 + tile * 16 + 4 * g + r) * 32 + e16; pr[0] = a0[r]; pr[16] = a1[r]; }
#pragma unroll
                for (int s4 = 0; s4 < 4; ++s4) { v[s4][0] = vn[s4][0]; v[s4][1] = vn[s4][1]; }
            }
            __syncthreads();
            if (F.tid < 64) { float s = 0.f;
#pragma unroll
                for (int ww = 0; ww < 8; ++ww) s += psq[ww * 64 + F.tid];
                rstd_s[F.tid] = 1.f / sqrtf(s * (1.f / D) + EPS); }
            __syncthreads();
            { const int e = F.tid & 31; const float rbv = router_b[e];
#pragma unroll 1
              for (int i = 0; i < 4; ++i) { const int tl = (F.tid >> 5) + 16 * i; float lg = 0.f;
#pragma unroll
                for (int ww = 0; ww < 8; ++ww) lg += plog[(size_t)(ww * 64 + tl) * 32 + e];
                float val = lg * rstd_s[tl] + rbv; float tv[4]; int ti[4];
#pragma unroll
                for (int r = 0; r < 4; ++r) {
                    float bv = val; int bi = e;
#pragma unroll
                    for (int o = 1; o < 32; o <<= 1) { const float ov = __shfl_xor(bv, o); const int oi = __shfl_xor(bi, o); if (ov > bv || (ov == bv && oi < bi)) { bv = ov; bi = oi; } }
                    tv[r] = bv; ti[r] = bi; if (bi == e) val = -3.0e38f;
                }
                const float e1 = __expf(tv[1] - tv[0]), e2 = __expf(tv[2] - tv[0]), e3 = __expf(tv[3] - tv[0]); const float inv = 1.f / (1.f + e1 + e2 + e3);
                if (e < 4) { const float p = (e == 0 ? 1.f : e == 1 ? e1 : e == 2 ? e2 : e3) * inv; const int ex = (e == 0 ? ti[0] : e == 1 ? ti[1] : e == 2 ? ti[2] : ti[3]);
                    const int m = tblk * 64 + tl; topi[m * 4 + e] = ex; topp[m * 4 + e] = p;
                    const int li = tl * 4 + e; ebuf[li] = ex; pbuf[li] = __hip_atomic_fetch_add(&lcnt[ex], 1, __ATOMIC_RELAXED, __HIP_MEMORY_SCOPE_WORKGROUP); } } }
#pragma unroll 1
            for (int rb = 0; rb < 8; rb += 4) { f32x4 xv[4][4];
#pragma unroll
                for (int r = 0; r < 4; ++r) { const GAS f32x4* xr4 = (const GAS f32x4*)(out + ((size_t)tblk * 64 + w * 8 + rb + r) * D) + F.lane;
#pragma unroll
                    for (int j = 0; j < 4; ++j) xv[r][j] = xr4[64 * j]; }
#pragma unroll
                for (int r = 0; r < 4; ++r) { const int tl = w * 8 + rb + r; const float rstd = rstd_s[tl]; GAS unsigned* o4 = (GAS unsigned*)(H28 + ((size_t)tblk * 64 + tl) * D) + F.lane;
#pragma unroll
                    for (int j = 0; j < 4; ++j) { const f32x4 gg = ((const GAS f32x4*)norm_ffn)[F.lane + 64 * j];
                        o4[64 * j] = pk4_fp8(xv[r][j].x * rstd * gg.x, xv[r][j].y * rstd * gg.y, xv[r][j].z * rstd * gg.z, xv[r][j].w * rstd * gg.w); } } }
            __syncthreads();
            if (F.tid < 32) lbase[F.tid] = lastrep5 ? (int)__hip_atomic_fetch_add(cnt + F.tid, (unsigned)lcnt[F.tid], RLX_AGENT) : 0;
            __syncthreads();
            if (F.tid < 256) pos[tblk * 256 + F.tid] = lbase[ebuf[F.tid]] + pbuf[F.tid];
            __syncthreads();
        }
    }
    SEAM(5);
    if (IN(6) || IN(7) || IN(8)) {
        LAS int* loff = F.tbl; LAS int* ltoff = F.tbl + 36; LAS int* lc = F.tbl + 72;
        if (F.tid < 32) lc[F.tid] = (int)__hip_atomic_load(cnt + F.tid, RLX_AGENT);
        __syncthreads();
        if (F.tid == 0) { int a = 0, ta = 0; for (int e = 0; e < NE; ++e) { loff[e] = a; ltoff[e] = ta; const int c = lc[e]; a += c; ta += (c + 255) >> 8; } loff[NE] = a; ltoff[NE] = ta; }
        __syncthreads();
    }
    if (IN(6)) REP(6) {
        transpose_items(I_IN + 2 * I_A + I_B, NITEMS);
        const LAS int* loff = F.tbl;
        for (int p0 = gw; p0 < T * 4; p0 += 4 * NGW) {
            int row[4]; u32x4 dv[4];
#pragma unroll
            for (int q = 0; q < 4; ++q) { const int p = p0 + q * NGW; row[q] = (p < T * 4) ? loff[topi[p]] + pos[p] : -1; }
#pragma unroll
            for (int q = 0; q < 4; ++q) { const int p = p0 + q * NGW; if (row[q] >= 0) dv[q] = ((const GAS u32x4*)(H28 + (size_t)(p >> 2) * D))[F.lane]; }
#pragma unroll
            for (int q = 0; q < 4; ++q) { const int p = p0 + q * NGW; if (row[q] >= 0) { if (F.lane == 0) slot[p] = row[q]; ((GAS u32x4*)(HS8 + (size_t)row[q] * D))[F.lane] = dv[q]; } }
        }
    }
    SEAM(6);
    if (IN(7)) REP(7) {
        int k512 = D / 2; asm volatile("" : "+s"(k512));
        pg8::Gemm g{(const bf16*)HS8, (const bf16*)Wgu8, k512}; pg8::GroupOrder So{F.tbl + 36, F.tbl, 8, F.G, (int)blockIdx.x, 0}; So.nunits = __builtin_amdgcn_readfirstlane(F.tbl[36 + NE]) * 8;
        pg8::EpiSwiglu E{ACT8, b_gate, b_up};
        pg8::gemm_phase<pg8::EpiSwiglu, pg8::GroupOrder, true, FP8_SP2, true>(F.lds + RING_OFF, g, So, E);
    }
    SEAM(7);
    if (IN(8)) REP(8) {
        int k512 = D / 2; asm volatile("" : "+s"(k512));
        pg8::Gemm g{(const bf16*)ACT8, (const bf16*)Wd8, k512}; pg8::GroupOrder So{F.tbl + 36, F.tbl, 4, F.G, (int)blockIdx.x, 0}; So.nunits = __builtin_amdgcn_readfirstlane(F.tbl[36 + NE]) * 4;
        pg8::EpiDown E{YS, b_down};
        pg8::gemm_phase<pg8::EpiDown, pg8::GroupOrder, true, FP8_SP2, true>(F.lds + RING_OFF, g, So, E);
    }
    SEAM(8);
#ifdef MK_XBAR
    for (int xb_ = 0; xb_ < MK_XBAR; ++xb_) xcd_barrier(bar);
#endif
    if (IN(9)) REP(9) {
        const unsigned char* ys = YS;
        const int lane9 = (int)__builtin_amdgcn_mbcnt_hi(~0u, __builtin_amdgcn_mbcnt_lo(~0u, 0u));
        float* dst9 = (rep_ + 1 < 1 + ((MK_DUP >> 9) & 1)) ? (float*)(ws + WS_ACT) : out;
        for (int m0 = gw; m0 < T; m0 += 2 * NGW) {
            f32x4 v[2][4]; int sl[2][4]; float pr[2][4]; unsigned yv[2][4][4]; bool ok[2];
#pragma unroll
            for (int q = 0; q < 2; ++q) { const int m = m0 + q * NGW; ok[q] = m < T; const int mc = ok[q] ? m : m0; const GAS f32x4* xr = (const GAS f32x4*)(out + (size_t)mc * D) + lane9;
#pragma unroll
                for (int j = 0; j < 4; ++j) v[q][j] = xr[64 * j];
#pragma unroll
                for (int k = 0; k < 4; ++k) { sl[q][k] = slot[mc * 4 + k]; pr[q][k] = topp[mc * 4 + k]; } }
#pragma unroll
            for (int q = 0; q < 2; ++q)
#pragma unroll
                for (int k = 0; k < 4; ++k) { const GAS unsigned* yr = (const GAS unsigned*)(ys + (size_t)sl[q][k] * D) + lane9;
#pragma unroll
                    for (int j = 0; j < 4; ++j) yv[q][k][j] = yr[64 * j]; }
#pragma unroll
            for (int q = 0; q < 2; ++q) { if (!ok[q]) continue; const int m = m0 + q * NGW;
#pragma unroll
                for (int k = 0; k < 4; ++k) { const float p = pr[q][k];
#pragma unroll
                    for (int j = 0; j < 4; ++j) { const unsigned u = yv[q][k][j]; const f32x2 lo = __builtin_amdgcn_cvt_pk_f32_fp8(u, false), hi = __builtin_amdgcn_cvt_pk_f32_fp8(u, true);
                        v[q][j].x += p * lo.x; v[q][j].y += p * lo.y; v[q][j].z += p * hi.x; v[q][j].w += p * hi.y; } }
                float s = 0.f;
#pragma unroll
                for (int j = 0; j < 4; ++j) s += (v[q][j].x * v[q][j].x + v[q][j].y * v[q][j].y) + (v[q][j].z * v[q][j].z + v[q][j].w * v[q][j].w);
                const float rstd = 1.f / sqrtf(wave_sum(s) * (1.f / D) + EPS);
#pragma unroll
                for (int j = 0; j < 4; ++j) { const f32x4 gg = ((const GAS f32x4*)norm_final)[lane9 + 64 * j]; f32x4 y; y.x = v[q][j].x * rstd * gg.x; y.y = v[q][j].y * rstd * gg.y; y.z = v[q][j].z * rstd * gg.z; y.w = v[q][j].w * rstd * gg.w;
                    ((GAS f32x4*)(dst9 + (size_t)m * D) + lane9)[64 * j] = y; } }
        }
    }
#ifdef MK_TSTAMP
    if (MK_TSTAMP == 9) ts_b = __builtin_amdgcn_s_memrealtime();
    if (blockIdx.x == 0) { const unsigned long long dt = ts_b - ts_a, t0_ = __builtin_amdgcn_s_memrealtime();
        while (__builtin_amdgcn_s_memrealtime() - t0_ < 2 * dt) __builtin_amdgcn_s_sleep(8); }
#endif
#undef IN
#undef SEAM
}

extern "C" void kernel_launch(void* const* d_in, const int* in_sizes, int n_in, void* d_out, int out_size, void* d_ws, size_t ws_size, hipStream_t stream) {
    static int grid = 0;
    if (grid == 0) {
        if (n_in != 19 || in_sizes[0] != T * D || out_size != T * D || ws_size < WS_END) { fprintf(stderr, "kernel_launch: unexpected shapes (n_in %d, ws %zu); nothing launched\n", n_in, ws_size); grid = -1; return; }
        int dev = 0, cus = 0, per_cu = 0;
        if (hipGetDevice(&dev) != hipSuccess || hipDeviceGetAttribute(&cus, hipDeviceAttributeMultiprocessorCount, dev) != hipSuccess) { grid = -1; return; }
        if (hipFuncSetAttribute((const void*)mk_fwd, hipFuncAttributeMaxDynamicSharedMemorySize, LDS_BYTES) != hipSuccess) { fprintf(stderr, "kernel_launch: hipFuncSetAttribute failed\n"); grid = -1; return; }
        if (hipOccupancyMaxActiveBlocksPerMultiprocessor(&per_cu, (const void*)mk_fwd, NWAVES * 64, LDS_BYTES) != hipSuccess || per_cu < 1) { fprintf(stderr, "kernel_launch: occupancy query says %d blocks per CU\n", per_cu); }
        (void)hipGetLastError();
        grid = cus;
        if (grid != 256) fprintf(stderr, "kernel_launch: %d CUs (built and tuned for 256)\n", grid);
    }
    if (grid < 0) return;
    if (hipMemsetAsync((char*)d_ws + WS_CTL, 0, CTL_ZERO_BYTES, stream) != hipSuccess) return;
    Args a{};
    for (int i = 0; i < 19; ++i) a.in[i] = (const float*)d_in[i];
    a.out = (float*)d_out; a.ws = (unsigned char*)d_ws;
#if MK_MODE == 2
    a.ph_lo = 0; a.ph_hi = NPHASE; a.li = 0;
    hipLaunchKernelGGL(mk_fwd, dim3(grid), dim3(NWAVES * 64), LDS_BYTES, stream, a);
#else
    for (int ph = 0; ph < NPHASE; ++ph) { a.ph_lo = ph; a.ph_hi = ph + 1; a.li = ph; hipLaunchKernelGGL(mk_fwd, dim3(grid), dim3(NWAVES * 64), LDS_BYTES, stream, a); }
#endif
}
```

```cpp
#define MK_DUP 0
#include <hip/hip_runtime.h>
#include <stdint.h>
#include <stdio.h>

#ifndef FP8_SP2
#define FP8_SP2 true
#endif
#ifndef MK_MODE
#define MK_MODE 2
#endif

typedef unsigned short bf16;
typedef short bf16x8 __attribute__((ext_vector_type(8)));
typedef float f32x4 __attribute__((ext_vector_type(4)));
typedef float f32x2 __attribute__((ext_vector_type(2)));
typedef unsigned u32x4 __attribute__((ext_vector_type(4)));
typedef unsigned u32x2 __attribute__((ext_vector_type(2)));
#define GAS __attribute__((address_space(1)))
#define LAS __attribute__((address_space(3)))
typedef GAS unsigned gu32;

constexpr int T = 16384, S = 8192, D = 1024, NPROJ = 5888, NQKV = 3840, NGATE = 2048, NE = 32, TOPK = 4;
constexpr int C_QA = 0, C_KA = 1024, C_VA = 1280, C_QB = 1536, C_KB = 2304, C_VB = 3072;
constexpr float EPS = 1e-5f;
constexpr size_t MiB = 1u << 20;
constexpr size_t WS_CTL = 0, CTL_ZERO_BYTES = 1 * MiB;
constexpr size_t WS_TAB = 1 * MiB;
constexpr size_t WS_WIN = 2 * MiB;
constexpr size_t WS_WA = 14 * MiB;
constexpr size_t WS_WB = 16 * MiB;
constexpr size_t WS_WOUT = 17 * MiB;
constexpr size_t WS_RT = 19 * MiB;
constexpr size_t WS_WGU = 24 * MiB;
constexpr size_t WS_WD = 88 * MiB;
constexpr size_t WS_H2 = 120 * MiB;
constexpr size_t WS_HS = 136 * MiB;
constexpr size_t WS_ACT = 201 * MiB;
constexpr size_t WS_YS = 272 * MiB;
constexpr size_t WS_XN = 216 * MiB;
constexpr size_t WS_XNP = 312 * MiB;
constexpr size_t WS_QKV = 248 * MiB;
constexpr size_t WS_GATES = 368 * MiB;
constexpr size_t WS_YA = 432 * MiB;
constexpr size_t WS_YB = 464 * MiB;
constexpr size_t WS_MERGED = 472 * MiB;
constexpr size_t WS_VT = 472 * MiB;
constexpr size_t WS_END = 506 * MiB;
constexpr int CW_CNT = 0;
constexpr int CW_BAR = 4096;

__device__ const unsigned char BKT_A[257] = {12,12,12,12,12,12,12,12,12,12,12,12,12,12,12,12,12,12,12,12,12,12,12,12,12,12,12,12,12,12,12,12,12,12,12,12,12,12,11,11,11,11,11,11,11,11,11,11,11,11,11,11,11,11,11,11,11,11,11,11,11,11,11,11,11,11,11,11,11,11,11,11,11,11,11,11,11,11,11,10,10,10,10,10,10,10,10,10,10,10,10,10,10,10,10,10,10,10,10,10,10,10,9,9,9,9,9,9,9,9,9,9,9,9,8,8,8,8,8,8,8,7,6,5,4,3,2,1,0,17,18,19,20,21,22,23,24,24,24,24,24,24,24,25,25,25,25,25,25,25,25,25,25,25,25,26,26,26,26,26,26,26,26,26,26,26,26,26,26,26,26,26,26,26,26,26,26,26,27,27,27,27,27,27,27,27,27,27,27,27,27,27,27,27,27,27,27,27,27,27,27,27,27,27,27,27,27,27,27,27,27,27,27,27,27,27,27,27,27,28,28,28,28,28,28,28,28,28,28,28,28,28,28,28,28,28,28,28,28,28,28,28,28,28,28,28,28,28,28,28,28,28,28,28,28,28,28};
__device__ const unsigned char BKT_B[3][129] = {
 {11,11,11,11,11,11,11,11,11,11,11,11,11,11,11,10,10,10,10,10,10,10,10,10,10,10,10,10,10,10,10,10,10,10,10,10,10,10,9,9,9,9,9,9,9,9,9,9,9,9,8,8,8,8,8,8,8,7,6,5,4,3,2,1,0,17,18,19,20,21,22,23,24,24,24,24,24,24,24,25,25,25,25,25,25,25,25,25,25,25,25,26,26,26,26,26,26,26,26,26,26,26,26,26,26,26,26,26,26,26,26,26,26,26,27,27,27,27,27,27,27,27,27,27,27,27,27,27,27},
 {13,13,13,13,13,13,13,13,13,13,13,13,13,13,13,13,13,13,13,13,13,13,13,12,12,12,12,12,12,12,12,12,12,12,12,12,12,12,12,12,12,12,11,11,11,11,11,11,11,11,11,11,10,10,10,10,10,10,9,9,9,8,8,4,0,20,24,24,25,25,25,26,26,26,26,26,26,27,27,27,27,27,27,27,27,27,27,28,28,28,28,28,28,28,28,28,28,28,28,28,28,28,28,28,28,28,29,29,29,29,29,29,29,29,29,29,29,29,29,29,29,29,29,29,29,29,29,29,29},
 {15,15,15,15,15,15,15,15,15,15,15,15,15,15,15,15,15,15,15,15,15,15,15,15,15,15,15,15,15,15,14,14,14,14,14,14,14,14,14,14,14,14,14,14,14,13,13,13,13,13,13,13,13,13,12,12,12,12,12,11,11,10,10,9,0,25,26,26,27,27,28,28,28,28,28,29,29,29,29,29,29,29,29,29,30,30,30,30,30,30,30,30,30,30,30,30,30,30,30,31,31,31,31,31,31,31,31,31,31,31,31,31,31,31,31,31,31,31,31,31,31,31,31,31,31,31,31,31,31}};

#define RLX_AGENT __ATOMIC_RELAXED, __HIP_MEMORY_SCOPE_AGENT
#define LDS_WAIT() asm volatile("s_waitcnt lgkmcnt(0)" ::: "memory")
#define VM_WAIT() asm volatile("s_waitcnt vmcnt(0)" ::: "memory")
__device__ __forceinline__ unsigned f2bf(float f) { unsigned u = __builtin_bit_cast(unsigned, f); return (u + 0x7fffu + ((u >> 16) & 1u)) >> 16; }
__device__ __forceinline__ unsigned pk2(float lo, float hi) { return f2bf(lo) | (f2bf(hi) << 16); }
__device__ __forceinline__ unsigned pk4_fp8(float a, float b, float c, float d) { unsigned w = 0; w = __builtin_amdgcn_cvt_pk_fp8_f32(a, b, w, false); w = __builtin_amdgcn_cvt_pk_fp8_f32(c, d, w, true); return w; }
__device__ __forceinline__ float bf2f(unsigned b) { return __builtin_bit_cast(float, b << 16); }
__device__ __forceinline__ float bflo(unsigned u) { return __builtin_bit_cast(float, u << 16); }
__device__ __forceinline__ float bfhi(unsigned u) { return __builtin_bit_cast(float, u & 0xffff0000u); }
__device__ __forceinline__ float wave_sum(float v) {
#pragma unroll
    for (int o = 1; o < 64; o <<= 1) v += __shfl_xor(v, o);
    return v;
}
__device__ __forceinline__ float sigm(float x) { return __builtin_amdgcn_rcpf(1.f + __builtin_amdgcn_exp2f(-1.4426950408889634f * x)); }

struct Tabs { float biasA[16][257]; float biasB[3][4][129]; };

namespace pg8 {
#define PG8_LAS __attribute__((address_space(3)))
typedef unsigned short bf16_t;
constexpr int BM = 256, BK = 64, HALF = 128, HTB = HALF * BK * 2, STAGE_BYTES = 8 * HTB, NXCD = 8, WGM = 8;
__host__ __device__ __forceinline__ int lds_byte(int r, int c) { const int st = (r >> 4) * 2 + (c >> 5), rr = r & 15, cc = c & 31, ob = rr * 64 + cc * 2; return st * 1024 + (ob ^ (((ob >> 9) & 1) << 5)); }
__host__ __device__ __forceinline__ void stage_rc(int b, int& R, int& C) { const int st = b / 1024, sb = b % 1024, swz = sb ^ (((sb >> 9) & 1) << 5); R = (st >> 1) * 16 + swz / 64; C = (st & 1) * 32 + (swz % 64) / 2; }
__host__ __device__ __forceinline__ int perm32(int rho) { const int n = rho >> 4, i = rho & 15; return 8 * (i >> 2) + 4 * n + (i & 3); }

struct Unit { int arow, brow, nrows, e, swap; };
struct Gemm { const bf16_t* A; const bf16_t* Bt; int K; };

struct StaticOrder {
    int nM, nN, nwg, G, c;
    __device__ void init(int M, int N, int G_, int c_) { nM = M / BM; nN = N / BM; nwg = nM * nN; G = G_; c = c_; }
    __device__ bool next(int i, Unit& u) const {
        const long L = (long)i * G + c; if (L >= nwg) return false;
        int wgid = (int)L; { const int q = nwg / NXCD, r = nwg % NXCD, xcd = wgid % NXCD, off = wgid / NXCD; wgid = (xcd < r ? xcd * (q + 1) : r * (q + 1) + (xcd - r) * q) + off; }
        const int nig = WGM * nN, gid = wgid / nig, fm = gid * WGM, gsz = (nM - fm) < WGM ? (nM - fm) : WGM;
        u.arow = BM * (fm + ((wgid % nig) % gsz)); u.brow = BM * ((wgid % nig) / gsz); u.nrows = BM; u.e = 0; u.swap = 0; return true;
    }
    __device__ __forceinline__ void a_ready(const Unit&) const {}
    __device__ __forceinline__ void done(const Unit&) const {}
};
constexpr int XNP_ROW0 = (int)((WS_XNP - WS_XN) / D);
struct ProjOrder {
    StaticOrder so;
    __device__ bool next(int i, Unit& u) const { if (!so.next(i, u)) return false;
        if (u.brow == C_VA || (u.brow >= C_VB && u.brow < NQKV)) { const int a = u.arow; u.arow = u.brow; u.brow = a; u.swap = 1; u.e = a;
            if (u.arow == C_VB + 256) u.brow += XNP_ROW0; else if (u.arow == C_VB + 512) u.brow += XNP_ROW0 + T; } return true; }
    __device__ __forceinline__ void a_ready(const Unit&) const {}
    __device__ __forceinline__ void done(const Unit&) const {}
};
struct GroupOrder {
    const PG8_LAS int* toff; const PG8_LAS int* off; int NT, G, c, nunits;
    __device__ bool next(int i, Unit& u) const {
        int L;
        if (G & 7) { L = i * G + c; }
        else { const int q = (nunits + 7) >> 3, j = i * (G >> 3) + (c >> 3); if (j >= q) return false; L = (c & 7) * q + j; }
        if (L >= nunits) return false;
        const int mtg = L / NT, pn = L - mtg * NT;
        int e = 0;
        for (int j = 1; j < NE; ++j) e += (toff[j] <= mtg) ? 1 : 0;
        e = __builtin_amdgcn_readfirstlane(e);
        const int mt = mtg - __builtin_amdgcn_readfirstlane(toff[e]); const int o0 = __builtin_amdgcn_readfirstlane(off[e]), o1 = __builtin_amdgcn_readfirstlane(off[e + 1]);
        u.arow = o0 + BM * mt; const int rem = o1 - u.arow; u.nrows = rem < BM ? rem : BM; u.brow = (e * NT + pn) * BM; u.e = e; u.swap = 0; return true;
    }
    __device__ __forceinline__ void a_ready(const Unit&) const {}
    __device__ __forceinline__ void done(const Unit&) const {}
};

__device__ __forceinline__ void st16_wt(void* p, u32x4 v) { asm volatile("global_store_dwordx4 %0, %1, off sc1\n\ts_nop 2" :: "v"(p), "v"(v) : "memory"); }
__device__ __forceinline__ void st8_wt(void* p, u32x2 v) { asm volatile("global_store_dwordx2 %0, %1, off sc1\n\ts_nop 2" :: "v"(p), "v"(v) : "memory"); }
__device__ __forceinline__ unsigned cvt_pk_bf16(float lo, float hi) { unsigned r; asm volatile("v_cvt_pk_bf16_f32 %0, %1, %2" : "=v"(r) : "v"(lo), "v"(hi)); return r; }

struct EpiProj {
    static constexpr bool PERM = true, AFTER_DRAIN = false; static constexpr int TAG = 1;
    bf16_t* qkv; bf16_t* gates; const float* bias; bf16_t* vta; bf16_t* vtb;
    __device__ __forceinline__ void prefetch(const Unit& u, PG8_LAS unsigned char* slot, int wid, int lane) const {
        if (wid == 0) { int l4 = 4 * lane; asm volatile("" : "+v"(l4));
            __builtin_amdgcn_global_load_lds((const unsigned*)(bias + (u.swap ? u.arow : u.brow) + l4), (PG8_LAS unsigned*)slot, 16, 0, 0); } }
    __device__ __forceinline__ void operator()(const f32x4 (&acc)[2][2][4][2], const Unit& u, int wr, int wc, int fr, int fq, const PG8_LAS unsigned char* slot) const {
        if (!u.swap) {
            const int colt = u.brow; const bool isq = colt < NQKV; unsigned char* base = isq ? (unsigned char*)qkv : (unsigned char*)gates; const int ldc = isq ? NQKV : NGATE; const int cb = isq ? colt : colt - NQKV;
            const int row0 = u.arow + wr * 64 + fr, col0 = cb + wc * 32 + 8 * fq;
            const PG8_LAS f32x4* bl = (const PG8_LAS f32x4*)(slot + (wc * 32 + 8 * fq) * 4);
            const float qs = (colt < C_KA || (colt >= C_QB && colt < C_KB)) ? 0.125f * 1.4426950408889634f : 1.f;
#pragma unroll
            for (int ai = 0; ai < 2; ++ai)
#pragma unroll
                for (int m = 0; m < 4; ++m) { unsigned char* rowp = base + (size_t)(row0 + ai * HALF + m * 16) * ldc + col0;
#pragma unroll
                    for (int bj = 0; bj < 2; ++bj) { const f32x4 v0 = (acc[ai][bj][m][0] + bl[bj * 32]) * qs, v1 = (acc[ai][bj][m][1] + bl[bj * 32 + 1]) * qs;
                        u32x2 w; w.x = pk4_fp8(v0[0], v0[1], v0[2], v0[3]); w.y = pk4_fp8(v1[0], v1[1], v1[2], v1[3]); *(u32x2*)(rowp + bj * HALF) = w; }
                    asm volatile("" ::: "memory"); }
        } else {
            const int colt = u.arow, tok0 = u.e; const int gsel = (colt == C_VA) ? -1 : ((colt - C_VB) >> 8); const int sh = (gsel <= 0) ? 0 : (gsel == 1 ? 2 : 4);
            bf16_t* vb = ((gsel < 0) ? vta : vtb + (size_t)gsel * (2 * 256 * 8192)) + (size_t)((tok0 >> 13) * 256) * 8192;
            const int mub = (tok0 & 8191) >> sh;
#pragma unroll
            for (int ai = 0; ai < 2; ++ai)
#pragma unroll
                for (int m = 0; m < 4; ++m) { const int c = ai * HALF + wr * 64 + m * 16 + fr; const float bvr = *(const PG8_LAS float*)(slot + c * 4); bf16_t* vrow = vb + (size_t)c * 8192;
#pragma unroll
                    for (int bj = 0; bj < 2; ++bj) { const int j0 = bj * HALF + wc * 32 + 8 * fq;
                        const int rho = j0 >> (8 - sh), mu = mub + (j0 & ((256 >> sh) - 1));
                        const int p0 = (rho << (13 - sh)) + (mu & ~31) + (((mu & 15) >> 2) << 3) + (((mu >> 4) & 1) << 2);
                        const f32x4 v0 = acc[ai][bj][m][0] + bvr, v1 = acc[ai][bj][m][1] + bvr;
                        u32x2 w0, w1; w0.x = cvt_pk_bf16(v0[0], v0[1]); w0.y = cvt_pk_bf16(v0[2], v0[3]); w1.x = cvt_pk_bf16(v1[0], v1[1]); w1.y = cvt_pk_bf16(v1[2], v1[3]);
                        *(u32x2*)(vrow + p0) = w0; *(u32x2*)(vrow + p0 + 8) = w1; }
                    asm volatile("" ::: "memory"); }
        }
    }
};
template <int MODE> struct EpiGate {
    static constexpr bool PERM = true, AFTER_DRAIN = false; static constexpr int TAG = 3;
    bf16_t* out; const bf16_t* gates; int gcol0; unsigned char* out8;
    __device__ __forceinline__ void prefetch(const Unit&, PG8_LAS unsigned char*, int, int) const {}
    __device__ __forceinline__ void operator()(const f32x4 (&acc)[2][2][4][2], const Unit& u, int wr, int wc, int fr, int fq, const PG8_LAS unsigned char*) const {
        const int row0 = u.arow + wr * 64 + fr, col0 = u.brow + wc * 32 + 8 * fq;
        u32x2 gv[8][2];
#pragma unroll
        for (int gi = 0; gi < 4; ++gi) { const size_t r = (size_t)(row0 + (gi >> 2) * HALF + (gi & 3) * 16);
#pragma unroll
            for (int bj = 0; bj < 2; ++bj) gv[gi][bj] = *(const u32x2*)((const unsigned char*)gates + r * NGATE + gcol0 + col0 + bj * HALF); }
        u32x4 mv[2], mn[2];
        if (MODE == 1) {
#pragma unroll
            for (int bj = 0; bj < 2; ++bj) mv[bj] = *(const u32x4*)(out + (size_t)row0 * D + col0 + bj * HALF); }
#pragma unroll
        for (int gi = 0; gi < 8; ++gi) { const int ai = gi >> 2, m = gi & 3; const size_t r = (size_t)(row0 + ai * HALF + m * 16);
            if (gi == 1) {
#pragma unroll
                for (int g2 = 4; g2 < 8; ++g2) { const size_t r2 = (size_t)(row0 + (g2 >> 2) * HALF + (g2 & 3) * 16);
#pragma unroll
                    for (int bj = 0; bj < 2; ++bj) gv[g2][bj] = *(const u32x2*)((const unsigned char*)gates + r2 * NGATE + gcol0 + col0 + bj * HALF); } }
            if (MODE == 1 && gi + 1 < 8) { const size_t rn = (size_t)(row0 + ((gi + 1) >> 2) * HALF + ((gi + 1) & 3) * 16);
#pragma unroll
                for (int bj = 0; bj < 2; ++bj) mn[bj] = *(const u32x4*)(out + rn * D + col0 + bj * HALF); }
#pragma unroll
            for (int bj = 0; bj < 2; ++bj) { const int c = col0 + bj * HALF; const u32x2 g4 = gv[gi][bj]; const f32x4 a0 = acc[ai][bj][m][0], a1 = acc[ai][bj][m][1];
                const f32x2 ga = __builtin_amdgcn_cvt_pk_f32_fp8(g4.x, false), gb = __builtin_amdgcn_cvt_pk_f32_fp8(g4.x, true), gc = __builtin_amdgcn_cvt_pk_f32_fp8(g4.y, false), gd = __builtin_amdgcn_cvt_pk_f32_fp8(g4.y, true);
                float o[8]; o[0] = sigm(ga.x) * a0[0]; o[1] = sigm(ga.y) * a0[1]; o[2] = sigm(gb.x) * a0[2]; o[3] = sigm(gb.y) * a0[3];
                o[4] = sigm(gc.x) * a1[0]; o[5] = sigm(gc.y) * a1[1]; o[6] = sigm(gd.x) * a1[2]; o[7] = sigm(gd.y) * a1[3];
                if (MODE == 1) { const u32x4 m4 = mv[bj];
                    o[0] += bflo(m4.x); o[1] += bfhi(m4.x); o[2] += bflo(m4.y); o[3] += bfhi(m4.y); o[4] += bflo(m4.z); o[5] += bfhi(m4.z); o[6] += bflo(m4.w); o[7] += bfhi(m4.w); }
                if (MODE == 1) { u32x2 w8; w8.x = pk4_fp8(o[0], o[1], o[2], o[3]); w8.y = pk4_fp8(o[4], o[5], o[6], o[7]); *(u32x2*)(out8 + r * D + c) = w8; }
                else { u32x4 w; w.x = cvt_pk_bf16(o[0], o[1]); w.y = cvt_pk_bf16(o[2], o[3]); w.z = cvt_pk_bf16(o[4], o[5]); w.w = cvt_pk_bf16(o[6], o[7]);
                    *(u32x4*)(out + r * D + c) = w; } }
            asm volatile("" ::: "memory");
            if (MODE == 1) {
#pragma unroll
                for (int bj = 0; bj < 2; ++bj) mv[bj] = mn[bj]; } }
    }
};
struct EpiX1 {
    static constexpr bool PERM = true, AFTER_DRAIN = false; static constexpr int TAG = 4;
    const float* x; float* out;
    __device__ __forceinline__ void prefetch(const Unit&, PG8_LAS unsigned char*, int, int) const {}
    __device__ __forceinline__ void operator()(const f32x4 (&acc)[2][2][4][2], const Unit& u, int wr, int wc, int fr, int fq, const PG8_LAS unsigned char*) const {
        const int row0 = u.arow + wr * 64 + fr, col0 = u.brow + wc * 32 + 8 * fq;
        f32x4 xv[2][2], xn[2][2];
#pragma unroll
        for (int bj = 0; bj < 2; ++bj) { const size_t o = (size_t)row0 * D + col0 + bj * HALF; xv[bj][0] = *(const f32x4*)(x + o); xv[bj][1] = *(const f32x4*)(x + o + 4); }
#pragma unroll
        for (int gi = 0; gi < 8; ++gi) { const int ai = gi >> 2, m = gi & 3; const size_t r = (size_t)(row0 + ai * HALF + m * 16);
            if (gi + 1 < 8) { const size_t rn = (size_t)(row0 + ((gi + 1) >> 2) * HALF + ((gi + 1) & 3) * 16);
#pragma unroll
                for (int bj = 0; bj < 2; ++bj) { const size_t o = rn * D + col0 + bj * HALF; xn[bj][0] = *(const f32x4*)(x + o); xn[bj][1] = *(const f32x4*)(x + o + 4); } }
#pragma unroll
            for (int bj = 0; bj < 2; ++bj) { const size_t o = r * D + col0 + bj * HALF;
                *(f32x4*)(out + o) = xv[bj][0] + acc[ai][bj][m][0]; *(f32x4*)(out + o + 4) = xv[bj][1] + acc[ai][bj][m][1]; }
            asm volatile("" ::: "memory");
#pragma unroll
            for (int bj = 0; bj < 2; ++bj) { xv[bj][0] = xn[bj][0]; xv[bj][1] = xn[bj][1]; } }
    }
};
struct EpiSwiglu {
    static constexpr bool PERM = true, AFTER_DRAIN = false; static constexpr int TAG = 7;
    unsigned char* act; const float* bg; const float* bu;
    __device__ __forceinline__ void prefetch(const Unit& u, PG8_LAS unsigned char* slot, int wid, int lane) const {
        if (wid == 0) { const int pn = (u.brow >> 8) & 7; const float* src = ((lane < 32) ? bg : bu) + (size_t)u.e * D + pn * HALF + 4 * (lane & 31);
            __builtin_amdgcn_global_load_lds((const unsigned*)src, (PG8_LAS unsigned*)slot, 16, 0, 0); } }
    __device__ __forceinline__ void operator()(const f32x4 (&acc)[2][2][4][2], const Unit& u, int wr, int wc, int fr, int fq, const PG8_LAS unsigned char* slot) const {
        const int pn = (u.brow >> 8) & 7; const int col0 = pn * HALF + wc * 32 + 8 * fq; const int rl0 = wr * 64 + fr;
        const PG8_LAS f32x4* bl = (const PG8_LAS f32x4*)(slot + (wc * 32 + 8 * fq) * 4);
        const f32x4 g0 = bl[0], g1 = bl[1], u0 = bl[32], u1 = bl[33];
#pragma unroll
        for (int ai = 0; ai < 2; ++ai)
#pragma unroll
            for (int m = 0; m < 4; ++m) { const int rl = rl0 + ai * HALF + m * 16;
                const f32x4 ga = acc[ai][0][m][0] + g0, gb = acc[ai][0][m][1] + g1, ua = acc[ai][1][m][0] + u0, ub = acc[ai][1][m][1] + u1;
                float o[8];
#pragma unroll
                for (int j = 0; j < 4; ++j) { const float gt = fminf(ga[j], 7.f), up = fminf(fmaxf(ua[j], -7.f), 7.f); o[j] = gt * sigm(1.702f * gt) * (up + 1.f);
                    const float gt2 = fminf(gb[j], 7.f), up2 = fminf(fmaxf(ub[j], -7.f), 7.f); o[4 + j] = gt2 * sigm(1.702f * gt2) * (up2 + 1.f); }
                u32x2 w; w.x = pk4_fp8(o[0], o[1], o[2], o[3]); w.y = pk4_fp8(o[4], o[5], o[6], o[7]);
                if (rl < u.nrows) *(u32x2*)(act + (size_t)(u.arow + rl) * D + col0) = w; }
    }
};
struct EpiDown {
    static constexpr bool PERM = true, AFTER_DRAIN = false; static constexpr int TAG = 8;
    unsigned char* ys; const float* bd;
    __device__ __forceinline__ void prefetch(const Unit& u, PG8_LAS unsigned char* slot, int wid, int lane) const {
        if (wid == 0) { const int pn = (u.brow >> 8) & 3; __builtin_amdgcn_global_load_lds((const unsigned*)(bd + (size_t)u.e * D + pn * BM + 4 * lane), (PG8_LAS unsigned*)slot, 16, 0, 0); } }
    __device__ __forceinline__ void operator()(const f32x4 (&acc)[2][2][4][2], const Unit& u, int wr, int wc, int fr, int fq, const PG8_LAS unsigned char* slot) const {
        const int pn = (u.brow >> 8) & 3; const int col0 = pn * BM + wc * 32 + 8 * fq; const int rl0 = wr * 64 + fr;
        f32x4 bv[2][2];
#pragma unroll
        for (int bj = 0; bj < 2; ++bj)
#pragma unroll
            for (int n = 0; n < 2; ++n) bv[bj][n] = *(const PG8_LAS f32x4*)(slot + (wc * 32 + 8 * fq + bj * HALF + 4 * n) * 4);
#pragma unroll
        for (int ai = 0; ai < 2; ++ai)
#pragma unroll
            for (int m = 0; m < 4; ++m) { const int rl = rl0 + ai * HALF + m * 16; unsigned char* rowp = ys + (size_t)(u.arow + rl) * D + col0;
#pragma unroll
                for (int bj = 0; bj < 2; ++bj) { const f32x4 v0 = acc[ai][bj][m][0] + bv[bj][0], v1 = acc[ai][bj][m][1] + bv[bj][1];
                    u32x2 w; w.x = pk4_fp8(v0[0], v0[1], v0[2], v0[3]); w.y = pk4_fp8(v1[0], v1[1], v1[2], v1[3]);
                    if (rl < u.nrows) *(u32x2*)(rowp + bj * HALF) = w; } }
    }
};

typedef int i32x4_t __attribute__((ext_vector_type(4))); typedef int i32x8_t __attribute__((ext_vector_type(8)));
template <bool FP8> struct Frag;
template <> struct Frag<false> { bf16x8 v[2];
    __device__ __forceinline__ void ld(const PG8_LAS unsigned char* p) { v[0] = *(const PG8_LAS bf16x8*)p; v[1] = *(const PG8_LAS bf16x8*)(p + 1024); } };
template <> struct Frag<true> { i32x8_t v;
    __device__ __forceinline__ void ld(const PG8_LAS unsigned char* p) { const i32x4_t lo = *(const PG8_LAS i32x4_t*)p, hi = *(const PG8_LAS i32x4_t*)(p + 1024); v = __builtin_shufflevector(lo, hi, 0, 1, 2, 3, 4, 5, 6, 7); } };
__device__ __forceinline__ f32x4 mma_frag(const Frag<false>& w, const Frag<false>& x, f32x4 c) {
    c = __builtin_amdgcn_mfma_f32_16x16x32_bf16(w.v[0], x.v[0], c, 0, 0, 0); return __builtin_amdgcn_mfma_f32_16x16x32_bf16(w.v[1], x.v[1], c, 0, 0, 0); }
__device__ __forceinline__ f32x4 mma_frag(const Frag<true>& w, const Frag<true>& x, f32x4 c) {
    const int sa = 0x7A7A7A7A, sb = 0x7F7F7F7F;
    asm volatile("v_mfma_scale_f32_16x16x128_f8f6f4 %0, %1, %2, %0, %3, %4 op_sel_hi:[0,0,0]" : "+v"(c) : "v"(w.v), "v"(x.v), "v"(sa), "v"(sb));
    return c; }
template <class Epi, class Sched, bool ALIGN_EPI = false, bool SP2 = false, bool FP8 = false>
__device__ __forceinline__ void gemm_phase(PG8_LAS unsigned char* lds, const Gemm g, const Sched& S, const Epi& E) {
    const int tid = threadIdx.x, wid = __builtin_amdgcn_readfirstlane(tid >> 6), lane = tid & 63, wr = wid >> 2, wc = wid & 3, fr = lane & 15, fq = lane >> 4;
    const int K = g.K, nt = K / BK;
    unsigned voffA[2], voffB[2];
#pragma unroll
    for (int i = 0; i < 2; ++i) { int R, C; stage_rc(tid * 16 + i * 8192, R, C); const int Rb = Epi::PERM ? ((R & ~31) + perm32(R & 31)) : R;
        voffA[i] = (unsigned)(R * K + C) * 2u; voffB[i] = (unsigned)(Rb * K + C) * 2u; }
    const size_t kstep = (size_t)(BK * 2);
    const size_t hstep = (size_t)HALF * K * 2;
    const size_t rowb = (size_t)K * 2;
    const unsigned ldsw = (unsigned)wid * 1024u;
    const int aoff = lds_byte(wr * 64 + fr, fq * 8), boff = lds_byte(wc * 32 + fr, fq * 8);
#define PG8_SA(b, h) (((b) * 2 + (h)) * HTB)
#define PG8_SB(b, h) ((4 + (b) * 2 + (h)) * HTB)
#define PG8_STAGE(bufoff, gbase, voff) do { _Pragma("unroll") for (int _i = 0; _i < 2; ++_i) \
        __builtin_amdgcn_global_load_lds((const unsigned*)((const char*)(gbase) + (voff)[_i]), (PG8_LAS unsigned*)(lds + (bufoff) + ldsw + _i * 8192), 16, 0, 0); } while (0)
#define PG8_LDA(dst, b, h) do { _Pragma("unroll") for (int m = 0; m < 4; ++m) dst[m].ld(lds + PG8_SA(b, h) + aoff + m * 2048); } while (0)
#define PG8_LDB(dst, b, h) do { _Pragma("unroll") for (int n = 0; n < 2; ++n) dst[n].ld(lds + PG8_SB(b, h) + boff + n * 2048); } while (0)
#define PG8_MMA(ai, bj, At, Bt) do { __builtin_amdgcn_s_setprio(1); _Pragma("unroll") for (int m = 0; m < 4; ++m) _Pragma("unroll") for (int n = 0; n < 2; ++n) \
        acc[ai][bj][m][n] = mma_frag(Bt[n], At[m], acc[ai][bj][m][n]); __builtin_amdgcn_s_setprio(0); } while (0)
#define PG8_WAIT_V(n) asm volatile("s_waitcnt vmcnt(" #n ")" ::: "memory")
#define PG8_WAIT_L(n) asm volatile("s_waitcnt lgkmcnt(" #n ")" ::: "memory")
#define PG8_BAR __builtin_amdgcn_s_barrier()
#define PG8_SCHED __builtin_amdgcn_sched_barrier(0)
    Unit cur, nxt; int ui = 0;
    if (!S.next(0, cur)) return;
    f32x4 acc[2][2][4][2];
#pragma unroll
    for (int a = 0; a < 2; ++a)
#pragma unroll
        for (int b = 0; b < 2; ++b)
#pragma unroll
            for (int m = 0; m < 4; ++m)
#pragma unroll
                for (int n = 0; n < 2; ++n) acc[a][b][m][n] = (f32x4){0.f, 0.f, 0.f, 0.f};
    Frag<FP8> At[4], B0[2], B1[2];
    const char* cA = (const char*)(cur.swap ? g.Bt : g.A) + (size_t)cur.arow * rowb; const char* cB = (const char*)(cur.swap ? g.A : g.Bt) + (size_t)cur.brow * rowb;
    S.a_ready(cur);
    PG8_LAS unsigned char* const blds = lds + 131072 + 4096;
    E.prefetch(cur, blds, wid, lane);
    if constexpr (SP2) {
        PG8_STAGE(PG8_SB(0, 0), cB, voffB); PG8_STAGE(PG8_SB(0, 1), cB + hstep, voffB); PG8_STAGE(PG8_SA(0, 0), cA, voffA); PG8_STAGE(PG8_SA(0, 1), cA + hstep, voffA);
        if (wr == 1) PG8_BAR;
        PG8_WAIT_V(2); PG8_BAR;
        PG8_STAGE(PG8_SB(1, 0), cB + kstep, voffB); PG8_STAGE(PG8_SA(1, 0), cA + kstep, voffA); PG8_STAGE(PG8_SB(1, 1), cB + hstep + kstep, voffB);
        PG8_WAIT_V(6); PG8_BAR;
    } else {
        PG8_STAGE(PG8_SB(0, 0), cB, voffB); PG8_STAGE(PG8_SA(0, 0), cA, voffA); PG8_STAGE(PG8_SB(0, 1), cB + hstep, voffB); PG8_STAGE(PG8_SA(0, 1), cA + hstep, voffA);
        if (wr == 1) PG8_BAR;
        PG8_WAIT_V(4); PG8_BAR;
        PG8_STAGE(PG8_SB(1, 0), cB + kstep, voffB); PG8_STAGE(PG8_SA(1, 0), cA + kstep, voffA); PG8_STAGE(PG8_SB(1, 1), cB + hstep + kstep, voffB);
        PG8_WAIT_V(6); PG8_BAR;
    }
    for (;;) {
        const bool has_next = S.next(ui + 1, nxt);
        const char* nA = has_next ? (const char*)(nxt.swap ? g.Bt : g.A) + (size_t)nxt.arow * rowb : cA; const char* nB = has_next ? (const char*)(nxt.swap ? g.A : g.Bt) + (size_t)nxt.brow * rowb : cB;
        for (int t = 0; t < nt; t += 2) {
            const bool last = (t == nt - 2);
            const char* a1 = cA + (size_t)(t + 1) * kstep;
            const char* a2 = last ? nA : cA + (size_t)(t + 2) * kstep; const char* b2 = last ? nB : cB + (size_t)(t + 2) * kstep;
            const char* a3 = a2 + kstep; const char* b3 = b2 + kstep;
            if (last && has_next) { S.a_ready(nxt); E.prefetch(nxt, blds + (((ui + 1) & 1) << 10), wid, lane); }
            if constexpr (SP2) {
            PG8_LDB(B0, 0, 0); PG8_LDB(B1, 0, 1); PG8_SCHED; PG8_LDA(At, 0, 0); PG8_STAGE(PG8_SA(1, 1), a1 + hstep, voffA);
            PG8_WAIT_V(8); PG8_WAIT_L(0); PG8_BAR; PG8_MMA(0, 0, At, B0); PG8_MMA(0, 1, At, B1); PG8_BAR; PG8_SCHED;
            PG8_LDA(At, 0, 1); PG8_STAGE(PG8_SB(0, 0), b2, voffB); PG8_STAGE(PG8_SB(0, 1), b2 + hstep, voffB); PG8_STAGE(PG8_SA(0, 0), a2, voffA);
            PG8_WAIT_V(8); PG8_WAIT_L(0); PG8_BAR; PG8_MMA(1, 0, At, B0); PG8_MMA(1, 1, At, B1); PG8_BAR; PG8_SCHED;
            PG8_LDB(B0, 1, 0); PG8_LDB(B1, 1, 1); PG8_SCHED; PG8_LDA(At, 1, 0); PG8_STAGE(PG8_SA(0, 1), a2 + hstep, voffA);
            PG8_WAIT_V(8); PG8_WAIT_L(0); PG8_BAR; PG8_MMA(0, 0, At, B0); PG8_MMA(0, 1, At, B1); PG8_BAR; PG8_SCHED;
            PG8_LDA(At, 1, 1); PG8_STAGE(PG8_SB(1, 0), b3, voffB); PG8_STAGE(PG8_SB(1, 1), b3 + hstep, voffB); PG8_STAGE(PG8_SA(1, 0), a3, voffA);
            PG8_WAIT_V(8); PG8_WAIT_L(0); PG8_BAR; PG8_MMA(1, 0, At, B0); PG8_MMA(1, 1, At, B1); PG8_BAR; PG8_SCHED;
            } else {
            PG8_LDB(B0, 0, 0); PG8_SCHED; PG8_LDA(At, 0, 0); PG8_STAGE(PG8_SA(1, 1), a1 + hstep, voffA);
            PG8_WAIT_L(8); PG8_BAR; PG8_WAIT_L(0); PG8_MMA(0, 0, At, B0); PG8_BAR; PG8_SCHED;
            PG8_LDB(B1, 0, 1); PG8_STAGE(PG8_SB(0, 0), b2, voffB);
            PG8_BAR; PG8_WAIT_L(0); PG8_MMA(0, 1, At, B1); PG8_BAR;
            PG8_LDA(At, 0, 1); PG8_STAGE(PG8_SA(0, 0), a2, voffA);
            PG8_BAR; PG8_WAIT_L(0); PG8_MMA(1, 0, At, B0); PG8_BAR; PG8_SCHED;
            PG8_STAGE(PG8_SB(0, 1), b2 + hstep, voffB);
            PG8_WAIT_V(6); PG8_BAR; PG8_MMA(1, 1, At, B1); PG8_BAR;
            PG8_LDB(B0, 1, 0); PG8_SCHED; PG8_LDA(At, 1, 0); PG8_STAGE(PG8_SA(0, 1), a2 + hstep, voffA);
            PG8_WAIT_L(8); PG8_BAR; PG8_WAIT_L(0); PG8_MMA(0, 0, At, B0); PG8_BAR; PG8_SCHED;
            PG8_LDB(B1, 1, 1); PG8_STAGE(PG8_SB(1, 0), b3, voffB);
            PG8_BAR; PG8_WAIT_L(0); PG8_MMA(0, 1, At, B1); PG8_BAR;
            PG8_LDA(At, 1, 1); PG8_STAGE(PG8_SA(1, 0), a3, voffA);
            PG8_BAR; PG8_WAIT_L(0); PG8_MMA(1, 0, At, B0); PG8_BAR; PG8_SCHED;
            PG8_STAGE(PG8_SB(1, 1), b3 + hstep, voffB);
            PG8_WAIT_V(6); PG8_BAR; PG8_MMA(1, 1, At, B1); PG8_BAR;
            }
        }
        if constexpr (ALIGN_EPI) { if (wr == 0) PG8_BAR; }
        if constexpr (FP8) {
#define PG8_ACC8(a, b) "+v"(acc[a][b][0][0]), "+v"(acc[a][b][0][1]), "+v"(acc[a][b][1][0]), "+v"(acc[a][b][1][1]), "+v"(acc[a][b][2][0]), "+v"(acc[a][b][2][1]), "+v"(acc[a][b][3][0]), "+v"(acc[a][b][3][1])
            asm volatile("s_nop 15\n\ts_nop 15" : PG8_ACC8(0, 0), PG8_ACC8(0, 1) :: "memory");
            asm volatile("" : PG8_ACC8(1, 0), PG8_ACC8(1, 1) :: "memory");
#undef PG8_ACC8
        }
#ifdef MK_EPI2
        if constexpr (Epi::TAG == MK_EPI2) { E(acc, cur, wr, wc, fr, fq, blds + ((ui & 1) << 10)); asm volatile("" ::: "memory"); }
#endif
        if constexpr (!Epi::AFTER_DRAIN) { E(acc, cur, wr, wc, fr, fq, blds + ((ui & 1) << 10)); S.done(cur); }
        if (!has_next) break;
#pragma unroll
        for (int a = 0; a < 2; ++a)
#pragma unroll
            for (int b = 0; b < 2; ++b)
#pragma unroll
                for (int m = 0; m < 4; ++m)
#pragma unroll
                    for (int n = 0; n < 2; ++n) acc[a][b][m][n] = (f32x4){0.f, 0.f, 0.f, 0.f};
        cur = nxt; cA = nA; cB = nB; ++ui;
        if constexpr (ALIGN_EPI) { if (wr == 1) PG8_BAR; }
    }
    PG8_WAIT_V(0);
    if constexpr (!ALIGN_EPI) { if (wr == 0) PG8_BAR; }
    PG8_BAR;
    if constexpr (Epi::AFTER_DRAIN) { E.fused(acc, cur, wr, wc, fr, fq, lds, wid, lane); S.done(cur); }
#undef PG8_SA
#undef PG8_SB
#undef PG8_STAGE
#undef PG8_LDA
#undef PG8_LDB
#undef PG8_MMA
#undef PG8_WAIT_V
#undef PG8_WAIT_L
#undef PG8_BAR
#undef PG8_SCHED
}

}

#define XB_TMO      128
#define XB_XCNT(j)  (256  + 64 * (j))
#define XB_XSUB(j)  (1280 + 64 * (j))
#define XB_XGEN(j)  (2304 + 64 * (j))
#define XB_TOP      3328
#define XB_TOPGEN   3392
#define XCD_BAR_WORDS 3456
#define XB_SPIN_CAP (1u << 18)
__device__ __forceinline__ unsigned xb_ld(unsigned* p)              { return __hip_atomic_load(p, __ATOMIC_RELAXED, __HIP_MEMORY_SCOPE_AGENT); }
__device__ __forceinline__ unsigned xb_add(unsigned* p, unsigned v) { return __hip_atomic_fetch_add(p, v, __ATOMIC_RELAXED, __HIP_MEMORY_SCOPE_AGENT); }
__device__ __forceinline__ unsigned xb_xcc_id() { return (unsigned)__builtin_amdgcn_s_getreg((3 << 11) | 20) & 0xFu; }
#define XB_SPIN(cond, bar) do { unsigned _sp = 0; while (cond) { __builtin_amdgcn_s_sleep(1); \
    if ((++_sp & 255u) == 0u) { if (xb_ld(&(bar)[XB_TMO])) break; if (_sp > XB_SPIN_CAP) { atomicAdd(&(bar)[XB_TMO], 1u); break; } } } } while (0)
struct XcdBarrier { unsigned* bar; unsigned x; volatile LAS unsigned* st; };
__device__ __forceinline__ XcdBarrier xcd_barrier_post(unsigned* bar, volatile LAS unsigned* st) {
    XcdBarrier b; b.bar = bar; b.x = xb_xcc_id(); b.st = st;
    if (threadIdx.x == 0) (void)xb_add(&bar[XB_XCNT(b.x)], 1u);
    return b;
}
__device__ __forceinline__ void xcd_barrier_complete(unsigned* bar, unsigned x, unsigned& nloc, unsigned& nx) {
    const unsigned G = gridDim.x * gridDim.y * gridDim.z;
    unsigned sum, cnt, mine, sp = 0u;
    for (;;) {
        sum = 0u; cnt = 0u; mine = 0u;
#pragma unroll
        for (unsigned j = 0; j < 16; ++j) { const unsigned c = xb_ld(&bar[XB_XCNT(j)]); sum += c; cnt += (c > 0u) ? 1u : 0u; mine = (j == x) ? c : mine; }
        if (sum == G) break;
        __builtin_amdgcn_s_sleep(1);
        if ((++sp & 255u) == 0u) { if (xb_ld(&bar[XB_TMO])) break; if (sp > XB_SPIN_CAP) { atomicAdd(&bar[XB_TMO], 1u); break; } }
    }
    nloc = mine > 0u ? mine : 1u; nx = cnt > 0u ? cnt : 1u;
}
__device__ __forceinline__ void xcd_barrier(const XcdBarrier& b) {
    asm volatile("s_waitcnt vmcnt(0)" ::: "memory");
    __syncthreads();
    if (threadIdx.x == 0) {
        unsigned* bar = b.bar;
        __builtin_amdgcn_s_waitcnt(0);
        unsigned nloc = b.st[0], nx = b.st[1];
        if (nloc == 0u) { xcd_barrier_complete(bar, b.x, nloc, nx); b.st[0] = nloc; b.st[1] = nx; }
        const unsigned old = xb_add(&bar[XB_XSUB(b.x)], 1u);
        const unsigned gen = old / nloc;
        if (old + 1u == (gen + 1u) * nloc) {
            __builtin_amdgcn_fence(__ATOMIC_RELEASE, "agent");
            asm volatile("s_waitcnt vmcnt(0)" ::: "memory");
            const unsigned og = xb_add(&bar[XB_TOP], 1u);
            const unsigned tg = og / nx;
            if (og + 1u == (tg + 1u) * nx) xb_add(&bar[XB_TOPGEN], 1u);
            else XB_SPIN(xb_ld(&bar[XB_TOPGEN]) == tg, bar);
            __builtin_amdgcn_fence(__ATOMIC_ACQUIRE, "agent");
            xb_add(&bar[XB_XGEN(b.x)], 1u);
            asm volatile("s_waitcnt vmcnt(0)" ::: "memory");
        } else {
            XB_SPIN(xb_ld(&bar[XB_XGEN(b.x)]) == gen, bar);
            __builtin_amdgcn_fence(__ATOMIC_ACQUIRE, "agent");
            asm volatile("s_waitcnt vmcnt(0)" ::: "memory");
        }
    }
    __syncthreads();
}

constexpr int NWAVES = 8;
constexpr int RING_OFF = 0, RING_BYTES = 131072;
constexpr int LDSCTL_OFF = RING_BYTES, MISC_OFF = LDSCTL_OFF + 320;
constexpr int TBL_OFF = LDSCTL_OFF + 1024;
constexpr int LDS_BYTES = 147456;

struct Frame {
    LAS unsigned char* lds; volatile LAS unsigned* MISC; LAS int* tbl; gu32* ctl;
    int tid, lane, wave, vcu, G;
};

__device__ __forceinline__ void p0_transpose_item(const float* W, int K, int N, bf16* WT, int k0, int n0, int orow0, LAS float* scr, int lane) {
#pragma unroll 8
    for (int i = 0; i < 32; ++i) { const int kk = 2 * i + (lane >> 5); scr[kk * 33 + (lane & 31)] = W[(size_t)(k0 + kk) * N + n0 + (lane & 31)]; }
    LDS_WAIT(); asm volatile("" ::: "memory");
    const int c = lane & 7;
#pragma unroll
    for (int j = 0; j < 4; ++j) { const int n = (lane >> 3) + 8 * j; const LAS float* s = scr + (8 * c) * 33 + n;
        u32x4 o; o.x = pk2(s[0 * 33], s[1 * 33]); o.y = pk2(s[2 * 33], s[3 * 33]); o.z = pk2(s[4 * 33], s[5 * 33]); o.w = pk2(s[6 * 33], s[7 * 33]);
        *(GAS u32x4*)(WT + (size_t)(orow0 + n) * K + k0 + 8 * c) = o; }
    LDS_WAIT(); asm volatile("" ::: "memory");
}
__device__ __forceinline__ void p0_transpose_item_fp8(const float* W, int K, int N, unsigned char* WT, int k0, int n0, int orow0, LAS float* scr, int lane) {
#pragma unroll 8
    for (int i = 0; i < 32; ++i) { const int kk = 2 * i + (lane >> 5); scr[kk * 33 + (lane & 31)] = W[(size_t)(k0 + kk) * N + n0 + (lane & 31)]; }
    LDS_WAIT(); asm volatile("" ::: "memory");
    const int c = lane & 7;
#pragma unroll
    for (int j = 0; j < 4; ++j) { const int n = (lane >> 3) + 8 * j; const LAS float* sp = scr + (8 * c) * 33 + n;
        u32x2 o; o.x = pk4_fp8(sp[0 * 33] * 32.f, sp[1 * 33] * 32.f, sp[2 * 33] * 32.f, sp[3 * 33] * 32.f); o.y = pk4_fp8(sp[4 * 33] * 32.f, sp[5 * 33] * 32.f, sp[6 * 33] * 32.f, sp[7 * 33] * 32.f);
        *(GAS u32x2*)(WT + (size_t)(orow0 + n) * K + k0 + 8 * c) = o; }
    LDS_WAIT(); asm volatile("" ::: "memory");
}
__device__ __forceinline__ void rms_row_to_bf16(const float* xrow, const float* g, bf16* orow, int lane) {
    const GAS f32x4* xr = (const GAS f32x4*)xrow + lane; f32x4 v[4]; float s = 0.f;
#pragma unroll
    for (int j = 0; j < 4; ++j) { v[j] = xr[64 * j]; s += (v[j].x * v[j].x + v[j].y * v[j].y) + (v[j].z * v[j].z + v[j].w * v[j].w); }
    const float rstd = 1.f / sqrtf(wave_sum(s) * (1.f / D) + EPS);
    GAS unsigned long long* o8 = (GAS unsigned long long*)orow + lane;
#pragma unroll
    for (int j = 0; j < 4; ++j) { const f32x4 gg = ((const GAS f32x4*)g)[lane + 64 * j];
        o8[64 * j] = (unsigned long long)pk2(v[j].x * rstd * gg.x, v[j].y * rstd * gg.y) | ((unsigned long long)pk2(v[j].z * rstd * gg.z, v[j].w * rstd * gg.w) << 32); }
}

__device__ __forceinline__ void rms_row_to_fp8(const float* xrow, const float* g, unsigned char* orow, unsigned char* orow4, unsigned char* orow16, int lane) {
    const GAS f32x4* xr = (const GAS f32x4*)xrow + lane; f32x4 v[4]; float s = 0.f;
#pragma unroll
    for (int j = 0; j < 4; ++j) { v[j] = xr[64 * j]; s += (v[j].x * v[j].x + v[j].y * v[j].y) + (v[j].z * v[j].z + v[j].w * v[j].w); }
    const float rstd = 1.f / sqrtf(wave_sum(s) * (1.f / D) + EPS);
    GAS unsigned* o4 = (GAS unsigned*)orow + lane; GAS unsigned* p4 = (GAS unsigned*)orow4 + lane; GAS unsigned* p16 = (GAS unsigned*)orow16 + lane;
#pragma unroll
    for (int j = 0; j < 4; ++j) { const f32x4 gg = ((const GAS f32x4*)g)[lane + 64 * j]; const unsigned w = pk4_fp8(v[j].x * rstd * gg.x, v[j].y * rstd * gg.y, v[j].z * rstd * gg.z, v[j].w * rstd * gg.w);
        o4[64 * j] = w; p4[64 * j] = w; p16[64 * j] = w; }
}
constexpr float LOG2E = 1.4426950408889634f;
typedef __bf16 bf16x2_t __attribute__((ext_vector_type(2)));
__device__ __forceinline__ unsigned cvtpk_v(float lo, float hi) { const f32x2 v = {lo, hi}; const bf16x2_t b = __builtin_convertvector(v, bf16x2_t); return __builtin_bit_cast(unsigned, b); }
struct AttFrags { long k0a, k0b, k1a, k1b; bf16x8 v[4]; };
__device__ __forceinline__ float gmax4(float m) {
    { auto rr = __builtin_amdgcn_permlane16_swap(__float_as_uint(m), __float_as_uint(m), false, false); m = fmaxf(__uint_as_float(rr[0]), __uint_as_float(rr[1])); }
    { auto rr = __builtin_amdgcn_permlane32_swap(__float_as_uint(m), __float_as_uint(m), false, false); m = fmaxf(__uint_as_float(rr[0]), __uint_as_float(rr[1])); }
    return m;
}
constexpr int RB_A = 160, RB_B = 320;
template <int NH, int RB>
__device__ __forceinline__ void band_group(f32x4 (&o)[NH][4], float (&mrun)[NH], float (&lrun)[NH], const unsigned char* qkvb, const int (&qcol)[NH], const int (&qmu0)[NH], int kcol, const bf16* vt,
                                           int dil, int rho, int L, int qstep, int P0, int npairs, const LAS float* const (&tab)[NH], int lane) {
    const int t = lane & 15, g = lane >> 4;
    long qf[NH][2]; int mu_t[NH];
#pragma unroll
    for (int h = 0; h < NH; ++h) { mu_t[h] = qmu0[h] + qstep * t; const unsigned char* qrow = qkvb + (size_t)(mu_t[h] * dil + rho) * NQKV + 8 * g + qcol[h];
        qf[h][0] = *(const long*)qrow; qf[h][1] = *(const long*)(qrow + 32); }
    const int npr = L >> 5;
    const unsigned char* kbase = qkvb + (size_t)rho * NQKV + kcol + 8 * g;
    const bf16* vtl = vt + (size_t)t * 8192 + (size_t)rho * L + 8 * g;
    auto load = [&](int P, AttFrags& f) {
        const int Pc = min(max(P, 0), npr - 1);
        const unsigned char* k0p = kbase + (size_t)((32 * Pc + t) * dil) * NQKV; const unsigned char* k1p = k0p + (size_t)(16 * dil) * NQKV;
        f.k0a = *(const long*)k0p; f.k0b = *(const long*)(k0p + 32); f.k1a = *(const long*)k1p; f.k1b = *(const long*)(k1p + 32);
#pragma unroll
        for (int db = 0; db < 4; ++db) f.v[db] = *(const bf16x8*)(vtl + (size_t)(16 * db) * 8192 + 32 * Pc);
    };
    AttFrags cur; load(P0, cur);
    for (int pp = 0; pp < npairs; ++pp) {
        const int P = P0 + pp;
        AttFrags nxt; load(P0 + min(pp + 1, npairs - 1), nxt);
        if (P >= 0 && P < npr) {
            const int kap0 = 32 * P + 4 * g;
#pragma unroll
            for (int h = 0; h < NH; ++h) {
                const LAS float* tb_ = tab[h] + (kap0 - mu_t[h] + RB);
                f32x4 s0 = (f32x4){tb_[0], tb_[1], tb_[2], tb_[3]}, s1 = (f32x4){tb_[16], tb_[17], tb_[18], tb_[19]};
                s0 = __builtin_amdgcn_mfma_f32_16x16x32_fp8_fp8(cur.k0a, qf[h][0], s0, 0, 0, 0); s0 = __builtin_amdgcn_mfma_f32_16x16x32_fp8_fp8(cur.k0b, qf[h][1], s0, 0, 0, 0);
                s1 = __builtin_amdgcn_mfma_f32_16x16x32_fp8_fp8(cur.k1a, qf[h][0], s1, 0, 0, 0); s1 = __builtin_amdgcn_mfma_f32_16x16x32_fp8_fp8(cur.k1b, qf[h][1], s1, 0, 0, 0);
                float mx = fmaxf(fmaxf(fmaxf(s0[0], s0[1]), fmaxf(s0[2], s0[3])), fmaxf(fmaxf(s1[0], s1[1]), fmaxf(s1[2], s1[3])));
                mx = gmax4(mx);
                if (__any(mx > mrun[h])) { const float mn = fmaxf(mrun[h], mx), alpha = __builtin_amdgcn_exp2f(mrun[h] - mn); mrun[h] = mn; lrun[h] *= alpha;
#pragma unroll
                    for (int db = 0; db < 4; ++db) o[h][db] = o[h][db] * alpha; }
                const float mn = mrun[h]; float p[8], ps = 0.f;
#pragma unroll
                for (int j = 0; j < 8; ++j) { p[j] = __builtin_amdgcn_exp2f(((j < 4) ? s0[j & 3] : s1[j & 3]) - mn); ps += p[j]; }
                lrun[h] += ps;
                u32x4 pw; pw.x = cvtpk_v(p[0], p[1]); pw.y = cvtpk_v(p[2], p[3]); pw.z = cvtpk_v(p[4], p[5]); pw.w = cvtpk_v(p[6], p[7]);
                const bf16x8 pf = __builtin_bit_cast(bf16x8, pw);
#pragma unroll
                for (int db = 0; db < 4; ++db) o[h][db] = __builtin_amdgcn_mfma_f32_16x16x32_bf16(cur.v[db], pf, o[h][db], 0, 0, 0);
                if (NH > 2 && h + 1 < NH) __builtin_amdgcn_sched_barrier(0);
            }
        }
        cur = nxt;
    }
}
template <int NH>
__device__ __forceinline__ void band_store(const f32x4 (&o)[NH][4], const float (&lrun)[NH], unsigned char* const (&yrow)[NH], int lane) {
    const int g = lane >> 4;
#pragma unroll
    for (int h = 0; h < NH; ++h) { float l = lrun[h]; l += __shfl_xor(l, 16); l += __shfl_xor(l, 32); const float inv = 1.f / l;
#pragma unroll
        for (int db = 0; db < 4; ++db) *(unsigned*)(yrow[h] + 16 * db + 4 * g) = pk4_fp8(o[h][db][0] * inv, o[h][db][1] * inv, o[h][db][2] * inv, o[h][db][3] * inv); }
}

struct Args { const float* in[19]; float* out; unsigned char* ws; int ph_lo, ph_hi, li, pad; };
constexpr int NPHASE = 10;

__global__ void __launch_bounds__(NWAVES * 64, 2) mk_fwd(Args args) {
    extern __shared__ __attribute__((aligned(16))) unsigned char lds[];
    Frame F;
    F.lds = (LAS unsigned char*)lds; F.MISC = (volatile LAS unsigned*)(F.lds + MISC_OFF); F.tbl = (LAS int*)(F.lds + TBL_OFF);
    F.tid = threadIdx.x; F.lane = F.tid & 63; F.wave = __builtin_amdgcn_readfirstlane(F.tid >> 6);
    F.G = gridDim.x; { const int bx = blockIdx.x; F.vcu = (F.G % 8 == 0) ? (bx % 8) * (F.G / 8) + bx / 8 : bx; }
    unsigned char* ws = args.ws; F.ctl = (gu32*)(ws + WS_CTL);
    const float* x = args.in[0]; const float* norm_mix = args.in[1]; const float* w_in = args.in[2]; const float* b_in = args.in[3];
    const float* sinks = args.in[4]; const float* rel_bias = args.in[5]; const float* w_a = args.in[6]; const float* w_b = args.in[7];
    const float* w_out = args.in[8]; const float* norm_ffn = args.in[9]; const float* router_w = args.in[10]; const float* router_b = args.in[11];
    const float* w_gate = args.in[12]; const float* b_gate = args.in[13]; const float* w_up = args.in[14]; const float* b_up = args.in[15];
    const float* w_down = args.in[16]; const float* b_down = args.in[17]; const float* norm_final = args.in[18];
    float* out = args.out;
    Tabs* tb = (Tabs*)(ws + WS_TAB);
    bf16* Win_t = (bf16*)(ws + WS_WIN); bf16* Wa_t = (bf16*)(ws + WS_WA); bf16* Wb_t = (bf16*)(ws + WS_WB); bf16* Wout_t = (bf16*)(ws + WS_WOUT);
    unsigned char* Wgu8 = ws + WS_WGU; unsigned char* Wd8 = ws + WS_WD; unsigned char* H28 = ws + WS_H2; unsigned char* HS8 = ws + WS_HS; unsigned char* ACT8 = ws + WS_ACT; unsigned char* YS = ws + WS_YS;
    int* topi = (int*)(ws + WS_RT); float* topp = (float*)(ws + WS_RT + 256 * 1024); int* slot = (int*)(ws + WS_RT + 512 * 1024); int* pos = (int*)(ws + WS_RT + 768 * 1024);
    bf16* XN = (bf16*)(ws + WS_XN); bf16* QKV = (bf16*)(ws + WS_QKV); bf16* GATES = (bf16*)(ws + WS_GATES); bf16* YA = (bf16*)(ws + WS_YA); bf16* YB = (bf16*)(ws + WS_YB);
    bf16* MERGED = (bf16*)(ws + WS_MERGED);
    gu32* cnt = F.ctl + CW_CNT;

    for (int u = F.tid; u < (LDS_BYTES - LDSCTL_OFF) / 4; u += NWAVES * 64) ((LAS unsigned*)(F.lds + LDSCTL_OFF))[u] = 0u;
    __syncthreads();
    XcdBarrier bar = xcd_barrier_post((unsigned*)(F.ctl + CW_BAR) + args.li * XCD_BAR_WORDS, F.MISC + 8);
    const int lo = args.ph_lo, hi = args.ph_hi;
#ifndef MK_SKIP
#define MK_SKIP 0
#endif
#define IN(k) (!((MK_SKIP >> (k)) & 1) && lo <= (k) && (k) < hi)
#ifndef MK_DUP
#define MK_DUP 0
#endif
#define REP(k) _Pragma("unroll") for (int rep_ = 0; rep_ < 1 + ((MK_DUP >> (k)) & 1); ++rep_)
#ifdef MK_TSTAMP
    unsigned long long ts_a = __builtin_amdgcn_s_memrealtime(), ts_b = ts_a;
#define SEAM(k) do { if (IN(k) && IN((k) + 1)) xcd_barrier(bar); if ((k) + 1 == MK_TSTAMP) ts_a = __builtin_amdgcn_s_memrealtime(); if ((k) == MK_TSTAMP) ts_b = __builtin_amdgcn_s_memrealtime(); } while (0)
#else
#define SEAM(k) do { if (IN(k) && IN((k) + 1)) xcd_barrier(bar); } while (0)
#endif
    const int gw = F.vcu * NWAVES + F.wave, NGW = F.G * NWAVES;

    LAS float* scr = (LAS float*)(F.lds + RING_OFF + F.wave * 16384);
    constexpr int I_IN = (D / 64) * (NPROJ / 32), I_A = (D / 64) * (D / 32), I_B = (256 / 64) * (D / 32), I_E = (D / 64) * (D / 32);
    constexpr int NITEMS = I_IN + 2 * I_A + I_B + 3 * NE * I_E;
    auto transpose_items = [&](int first, int last) {
    for (int it = first + gw; it < last; it += NGW) {
        int r = it;
        if (r < I_IN) { const int nb = NPROJ / 32; p0_transpose_item_fp8(w_in, D, NPROJ, (unsigned char*)Win_t, 64 * (r / nb), 32 * (r % nb), 32 * (r % nb), scr, F.lane); continue; } r -= I_IN;
        if (r < I_A) { const int nb = D / 32; p0_transpose_item_fp8(w_a, D, D, (unsigned char*)Wa_t, 64 * (r / nb), 32 * (r % nb), 32 * (r % nb), scr, F.lane); continue; } r -= I_A;
        if (r < I_A) { const int nb = D / 32; p0_transpose_item_fp8(w_out, D, D, (unsigned char*)Wout_t, 64 * (r / nb), 32 * (r % nb), 32 * (r % nb), scr, F.lane); continue; } r -= I_A;
        if (r < I_B) { const int nb = D / 32; p0_transpose_item_fp8(w_b, 256, D, (unsigned char*)Wb_t, 64 * (r / nb), 32 * (r % nb), 32 * (r % nb), scr, F.lane); continue; } r -= I_B;
        { const int e = r / (3 * I_E), q = r % (3 * I_E), which = q / I_E, ii = q % I_E, nb = D / 32, k0 = 64 * (ii / nb), n0 = 32 * (ii % nb);
          if (which == 0) p0_transpose_item_fp8(w_gate + (size_t)e * D * D, D, D, Wgu8, k0, n0, e * 2048 + (n0 >> 7) * 256 + (n0 & 127), scr, F.lane);
          else if (which == 1) p0_transpose_item_fp8(w_up + (size_t)e * D * D, D, D, Wgu8, k0, n0, e * 2048 + (n0 >> 7) * 256 + 128 + (n0 & 127), scr, F.lane);
          else p0_transpose_item_fp8(w_down + (size_t)e * D * D, D, D, Wd8, k0, n0, e * 1024 + n0, scr, F.lane); }
    }
    };
    if (IN(0)) REP(0) {
        { const int i = blockIdx.x * (NWAVES * 64) + F.tid;
          if (i < 16 * 257) { const int h = i / 257, r = i % 257; tb->biasA[h][r] = rel_bias[BKT_A[r] * 28 + h]; }
          if (i < 12 * 129) { const int g = i / (4 * 129), hs = (i / 129) % 4, r = i % 129; tb->biasB[g][hs][r] = rel_bias[BKT_B[g][r] * 28 + 16 + 4 * g + hs]; } }
        transpose_items(0, I_IN + 2 * I_A + I_B);
        for (int m = gw; m < T; m += NGW) { const int t0 = m & ~255, tl = m & 255;
            rms_row_to_fp8(x + (size_t)m * D, norm_mix, (unsigned char*)XN + (size_t)m * D, ws + WS_XNP + (size_t)(t0 + (tl & 3) * 64 + (tl >> 2)) * D,
                           ws + WS_XNP + (size_t)(T + t0 + (tl & 15) * 16 + (tl >> 4)) * D, F.lane); }
    }
    SEAM(0);
    if (IN(1)) REP(1) {
        int k512 = D / 2; asm volatile("" : "+s"(k512));
        pg8::Gemm g{XN, Win_t, k512}; pg8::ProjOrder So; So.so.init(T, NPROJ, F.G, (int)blockIdx.x);
        pg8::EpiProj E{QKV, GATES, b_in, (bf16*)(ws + WS_VT), (bf16*)(ws + WS_VT) + (size_t)2 * 4 * 64 * 8192};
        pg8::gemm_phase<pg8::EpiProj, pg8::ProjOrder, true, true, true>(F.lds + RING_OFF, g, So, E);
    }
    SEAM(1);
    int nrep2 = 1 + ((MK_DUP >> 2) & 1); asm volatile("" : "+s"(nrep2));
    if (IN(2)) for (int rep_ = 0; rep_ < nrep2; ++rep_) {
        LAS float* lb = (LAS float*)(F.lds + RING_OFF);
        constexpr int TA = 2 * RB_A + 1, TB = 2 * RB_B + 1;
        for (int i = F.tid; i < 16 * TA; i += NWAVES * 64) { const int h = i / TA, rel = i % TA - RB_A; lb[i] = (rel >= -128 && rel <= 128) ? tb->biasA[h][rel + 128] * LOG2E : -3.0e38f; }
        for (int i = F.tid; i < 12 * TB; i += NWAVES * 64) { const int gh = i / TB, rel = i % TB - RB_B; lb[16 * TA + i] = (rel >= -64 && rel <= 64) ? tb->biasB[gh >> 2][gh & 3][rel + 64] * LOG2E : -3.0e38f; }
        __syncthreads();
        const bf16* VTA = (const bf16*)(ws + WS_VT); const bf16* VTB = VTA + (size_t)2 * 4 * 64 * 8192;
        for (int it = gw; it < 4096 + 2048; it += NGW) {
            const int t = F.lane & 15;
            if (it < 4096) {
                const int b = it >> 11, kvh = (it >> 9) & 3, qb = it & 511;
                f32x4 o[4][4]; float mr[4], lr[4];
#pragma unroll
                for (int h = 0; h < 4; ++h) { mr[h] = sinks[kvh * 4 + h] * LOG2E; lr[h] = (F.lane < 16) ? 1.f : 0.f;
#pragma unroll
                    for (int db = 0; db < 4; ++db) o[h][db] = (f32x4){0.f, 0.f, 0.f, 0.f}; }
                const int qcol[4] = {C_QA + (kvh * 4 + 0) * 64, C_QA + (kvh * 4 + 1) * 64, C_QA + (kvh * 4 + 2) * 64, C_QA + (kvh * 4 + 3) * 64};
                const int qmu[4] = {16 * qb, 16 * qb, 16 * qb, 16 * qb};
                const LAS float* const bias[4] = {lb + (kvh * 4 + 0) * TA, lb + (kvh * 4 + 1) * TA, lb + (kvh * 4 + 2) * TA, lb + (kvh * 4 + 3) * TA};
                band_group<4, RB_A>(o, mr, lr, (const unsigned char*)QKV + (size_t)b * S * NQKV, qcol, qmu, C_KA + kvh * 64, VTA + (size_t)((b * 4 + kvh) * 64) * 8192, 1, 0, S, 1, (qb - 8) >> 1, 9, bias, F.lane);
                unsigned char* yr = (unsigned char*)YA + (size_t)(b * S + 16 * qb + t) * D + kvh * 256; unsigned char* const yrow[4] = {yr, yr + 64, yr + 128, yr + 192};
                band_store<4>(o, lr, yrow, F.lane);
            } else {
                const int j = it - 4096, r = j & 7, un = j >> 3, blk = un & 31, hs = (un >> 5) & 3, b = un >> 7, i0 = blk * 256;
                f32x4 o[2][4]; float mr[2], lr[2];
#pragma unroll
                for (int h = 0; h < 2; ++h) { mr[h] = -1.0e30f; lr[h] = 0.f;
#pragma unroll
                    for (int db = 0; db < 4; ++db) o[h][db] = (f32x4){0.f, 0.f, 0.f, 0.f}; }
                const unsigned char* qb_ = (const unsigned char*)QKV + (size_t)b * S * NQKV;
                { const int qcol[2] = {C_QB + 0 * 256 + hs * 64, C_QB + 0 * 256 + hs * 64}; const int qmu[2] = {i0 + r, i0 + r + 8}; const LAS float* const bias[2] = {lb + 16 * TA + (0 * 4 + hs) * TB, lb + 16 * TA + (0 * 4 + hs) * TB};
                  band_group<2, RB_B>(o, mr, lr, qb_, qcol, qmu, C_KB + 0 * 256 + hs * 64, VTB + (size_t)(((0 * 2 + b) * 4 + hs) * 64) * 8192, 1, 0, S, 16, (i0 >> 5) - 2, 12, bias, F.lane); }
                { const int qcol[2] = {C_QB + 1 * 256 + hs * 64, C_QB + 1 * 256 + hs * 64}; const int qmu[2] = {(i0 + r) >> 2, (i0 + r + 8) >> 2}; const LAS float* const bias[2] = {lb + 16 * TA + (1 * 4 + hs) * TB, lb + 16 * TA + (1 * 4 + hs) * TB};
                  band_group<2, RB_B>(o, mr, lr, qb_, qcol, qmu, C_KB + 1 * 256 + hs * 64, VTB + (size_t)(((1 * 2 + b) * 4 + hs) * 64) * 8192, 4, r & 3, S / 4, 4, (i0 >> 7) - 2, 6, bias, F.lane); }
#pragma unroll
                for (int h = 0; h < 2; ++h) { const int qcol[1] = {C_QB + 2 * 256 + hs * 64}; const int qmu[1] = {i0 >> 4}; const LAS float* const bias[1] = {lb + 16 * TA + (2 * 4 + hs) * TB};
                  band_group<1, RB_B>(*(f32x4(*)[1][4])&o[h], *(float(*)[1])&mr[h], *(float(*)[1])&lr[h], qb_, qcol, qmu, C_KB + 2 * 256 + hs * 64, VTB + (size_t)(((2 * 2 + b) * 4 + hs) * 64) * 8192,
                                    16, r + 8 * h, S / 16, 1, (blk - 4) >> 1, 5, bias, F.lane); }
                unsigned char* yr = (unsigned char*)YB + (size_t)(b * S + i0 + r + 16 * t) * 256 + hs * 64; unsigned char* const yrow[2] = {yr, yr + 8 * 256};
                band_store<2>(o, lr, yrow, F.lane);
            }
        }
        __syncthreads();
    }
    SEAM(2);
    if (IN(3)) REP(3) {
#ifndef NO_P3A
        { int k256 = 128; asm volatile("" : "+s"(k256)); pg8::Gemm g{YB, Wb_t, k256};   pg8::StaticOrder So; So.init(T, D, F.G, (int)blockIdx.x);
          pg8::EpiGate<0> E{MERGED, GATES, 1024, nullptr};
          pg8::gemm_phase<pg8::EpiGate<0>, pg8::StaticOrder, true, true, true>(F.lds + RING_OFF, g, So, E); }
#endif
        VM_WAIT(); __syncthreads();
#ifndef NO_P3B
        { int k512 = D / 2; asm volatile("" : "+s"(k512)); pg8::Gemm g{YA, Wa_t, k512}; pg8::StaticOrder So; So.init(T, D, F.G, (int)blockIdx.x);
          pg8::EpiGate<1> E{MERGED, GATES, 0, (unsigned char*)YA + (size_t)16 * MiB};
          pg8::gemm_phase<pg8::EpiGate<1>, pg8::StaticOrder, true, true, true>(F.lds + RING_OFF, g, So, E); }
#endif
    }
    SEAM(3);
    if (IN(4)) REP(4) {
        int k512 = D / 2; asm volatile("" : "+s"(k512)); pg8::Gemm g{(const bf16*)((unsigned char*)YA + (size_t)16 * MiB), Wout_t, k512}; pg8::StaticOrder So; So.init(T, D, F.G, (int)blockIdx.x);
        pg8::EpiX1 E{x, out};
        pg8::gemm_phase<pg8::EpiX1, pg8::StaticOrder, true, true, true>(F.lds + RING_OFF, g, So, E);
    }
    SEAM(4);
    if (IN(5)) REP(5) {
        const bool lastrep5 = (rep_ + 1 == 1 + ((MK_DUP >> 5) & 1));
        LAS int* lcnt = F.tbl + 72; LAS int* lbase = F.tbl + 104; LAS int* ebuf = F.tbl + 136; LAS int* pbuf = F.tbl + 392;
        LAS float* plog = (LAS float*)(F.lds + RING_OFF);
        LAS float* psq = plog + 8 * 64 * 32;
        LAS float* rstd_s = psq + 512;
        const int g = F.lane >> 4, e16 = F.lane & 15, w = F.wave;
        float wB[32][2];
#pragma unroll
        for (int sc = 0; sc < 32; ++sc) { const int k = 128 * w + 32 * (sc >> 3) + 8 * g + (sc & 7); const float gm = norm_ffn[k];
            wB[sc][0] = gm * router_w[(size_t)k * NE + e16]; wB[sc][1] = gm * router_w[(size_t)k * NE + 16 + e16]; }
        for (int tblk = F.vcu; tblk < T / 64; tblk += F.G) {
            if (F.tid < 32) lcnt[F.tid] = 0;
            f32x4 v[4][2];
            { const GAS float* xr = (const GAS float*)out + (size_t)(tblk * 64 + e16) * D + 128 * w + 8 * g;
#pragma unroll
              for (int s4 = 0; s4 < 4; ++s4) { v[s4][0] = *(const GAS f32x4*)(xr + 32 * s4); v[s4][1] = *(const GAS f32x4*)(xr + 32 * s4 + 4); } }
#pragma unroll 1
            for (int tile = 0; tile < 4; ++tile) {
                f32x4 vn[4][2];
                { const int tn = tile < 3 ? tile + 1 : 3; const GAS float* xr = (const GAS float*)out + (size_t)(tblk * 64 + tn * 16 + e16) * D + 128 * w + 8 * g;
#pragma unroll
                  for (int s4 = 0; s4 < 4; ++s4) { vn[s4][0] = *(const GAS f32x4*)(xr + 32 * s4); vn[s4][1] = *(const GAS f32x4*)(xr + 32 * s4 + 4); } }
                float sq = 0.f;
#pragma unroll
                for (int s4 = 0; s4 < 4; ++s4) sq += (v[s4][0].x * v[s4][0].x + v[s4][0].y * v[s4][0].y) + (v[s4][0].z * v[s4][0].z + v[s4][0].w * v[s4][0].w)
                                                   + (v[s4][1].x * v[s4][1].x + v[s4][1].y * v[s4][1].y) + (v[s4][1].z * v[s4][1].z + v[s4][1].w * v[s4][1].w);
                sq += __shfl_xor(sq, 16); sq += __shfl_xor(sq, 32);
                if (g == 0) psq[w * 64 + tile * 16 + e16] = sq;
                f32x4 a0 = (f32x4){0.f, 0.f, 0.f, 0.f}, a1 = (f32x4){0.f, 0.f, 0.f, 0.f};
#pragma unroll
                for (int s4 = 0; s4 < 4; ++s4)
#pragma unroll
                    for (int c = 0; c < 8; ++c) { const float av = v[s4][c >> 2][c & 3];
                        a0 = __builtin_amdgcn_mfma_f32_16x16x4f32(av, wB[s4 * 8 + c][0], a0, 0, 0, 0); a1 = __builtin_amdgcn_mfma_f32_16x16x4f32(av, wB[s4 * 8 + c][1], a1, 0, 0, 0); }
#pragma unroll
                for (int r = 0; r < 4; ++r) { LAS float* pr = plog + (size_t)(w * 64 + tile * 16 + 4 * g + r) * 32 + e16; pr[0] = a0[r]; pr[16] = a1[r]; }
#pragma unroll
                for (int s4 = 0; s4 < 4; ++s4) { v[s4][0] = vn[s4][0]; v[s4][1] = vn[s4][1]; }
            }
            __syncthreads();
            if (F.tid < 64) { float s = 0.f;
#pragma unroll
                for (int ww = 0; ww < 8; ++ww) s += psq[ww * 64 + F.tid];
                rstd_s[F.tid] = 1.f / sqrtf(s * (1.f / D) + EPS); }
            __syncthreads();
            { const int e = F.tid & 31; const float rbv = router_b[e];
#pragma unroll 1
              for (int i = 0; i < 4; ++i) { const int tl = (F.tid >> 5) + 16 * i; float lg = 0.f;
#pragma unroll
                for (int ww = 0; ww < 8; ++ww) lg += plog[(size_t)(ww * 64 + tl) * 32 + e];
                float val = lg * rstd_s[tl] + rbv; float tv[4]; int ti[4];
#pragma unroll
                for (int r = 0; r < 4; ++r) {
                    float bv = val; int bi = e;
#pragma unroll
                    for (int o = 1; o < 32; o <<= 1) { const float ov = __shfl_xor(bv, o); const int oi = __shfl_xor(bi, o); if (ov > bv || (ov == bv && oi < bi)) { bv = ov; bi = oi; } }
                    tv[r] = bv; ti[r] = bi; if (bi == e) val = -3.0e38f;
                }
                const float e1 = __expf(tv[1] - tv[0]), e2 = __expf(tv[2] - tv[0]), e3 = __expf(tv[3] - tv[0]); const float inv = 1.f / (1.f + e1 + e2 + e3);
                if (e < 4) { const float p = (e == 0 ? 1.f : e == 1 ? e1 : e == 2 ? e2 : e3) * inv; const int ex = (e == 0 ? ti[0] : e == 1 ? ti[1] : e == 2 ? ti[2] : ti[3]);
                    const int m = tblk * 64 + tl; topi[m * 4 + e] = ex; topp[m * 4 + e] = p;
                    const int li = tl * 4 + e; ebuf[li] = ex; pbuf[li] = __hip_atomic_fetch_add(&lcnt[ex], 1, __ATOMIC_RELAXED, __HIP_MEMORY_SCOPE_WORKGROUP); } } }
#pragma unroll 1
            for (int rb = 0; rb < 8; rb += 4) { f32x4 xv[4][4];
#pragma unroll
                for (int r = 0; r < 4; ++r) { const GAS f32x4* xr4 = (const GAS f32x4*)(out + ((size_t)tblk * 64 + w * 8 + rb + r) * D) + F.lane;
#pragma unroll
                    for (int j = 0; j < 4; ++j) xv[r][j] = xr4[64 * j]; }
#pragma unroll
                for (int r = 0; r < 4; ++r) { const int tl = w * 8 + rb + r; const float rstd = rstd_s[tl]; GAS unsigned* o4 = (GAS unsigned*)(H28 + ((size_t)tblk * 64 + tl) * D) + F.lane;
#pragma unroll
                    for (int j = 0; j < 4; ++j) { const f32x4 gg = ((const GAS f32x4*)norm_ffn)[F.lane + 64 * j];
                        o4[64 * j] = pk4_fp8(xv[r][j].x * rstd * gg.x, xv[r][j].y * rstd * gg.y, xv[r][j].z * rstd * gg.z, xv[r][j].w * rstd * gg.w); } } }
            __syncthreads();
            if (F.tid < 32) lbase[F.tid] = lastrep5 ? (int)__hip_atomic_fetch_add(cnt + F.tid, (unsigned)lcnt[F.tid], RLX_AGENT) : 0;
            __syncthreads();
            if (F.tid < 256) pos[tblk * 256 + F.tid] = lbase[ebuf[F.tid]] + pbuf[F.tid];
            __syncthreads();
        }
    }
    SEAM(5);
    if (IN(6) || IN(7) || IN(8)) {
        LAS int* loff = F.tbl; LAS int* ltoff = F.tbl + 36; LAS int* lc = F.tbl + 72;
        if (F.tid < 32) lc[F.tid] = (int)__hip_atomic_load(cnt + F.tid, RLX_AGENT);
        __syncthreads();
        if (F.tid == 0) { int a = 0, ta = 0; for (int e = 0; e < NE; ++e) { loff[e] = a; ltoff[e] = ta; const int c = lc[e]; a += c; ta += (c + 255) >> 8; } loff[NE] = a; ltoff[NE] = ta; }
        __syncthreads();
    }
    if (IN(6)) REP(6) {
        transpose_items(I_IN + 2 * I_A + I_B, NITEMS);
        const LAS int* loff = F.tbl;
        for (int p0 = gw; p0 < T * 4; p0 += 4 * NGW) {
            int row[4]; u32x4 dv[4];
#pragma unroll
            for (int q = 0; q < 4; ++q) { const int p = p0 + q * NGW; row[q] = (p < T * 4) ? loff[topi[p]] + pos[p] : -1; }
#pragma unroll
            for (int q = 0; q < 4; ++q) { const int p = p0 + q * NGW; if (row[q] >= 0) dv[q] = ((const GAS u32x4*)(H28 + (size_t)(p >> 2) * D))[F.lane]; }
#pragma unroll
            for (int q = 0; q < 4; ++q) { const int p = p0 + q * NGW; if (row[q] >= 0) { if (F.lane == 0) slot[p] = row[q]; ((GAS u32x4*)(HS8 + (size_t)row[q] * D))[F.lane] = dv[q]; } }
        }
    }
    SEAM(6);
    if (IN(7)) REP(7) {
        int k512 = D / 2; asm volatile("" : "+s"(k512));
        pg8::Gemm g{(const bf16*)HS8, (const bf16*)Wgu8, k512}; pg8::GroupOrder So{F.tbl + 36, F.tbl, 8, F.G, (int)blockIdx.x, 0}; So.nunits = __builtin_amdgcn_readfirstlane(F.tbl[36 + NE]) * 8;
        pg8::EpiSwiglu E{ACT8, b_gate, b_up};
        pg8::gemm_phase<pg8::EpiSwiglu, pg8::GroupOrder, true, FP8_SP2, true>(F.lds + RING_OFF, g, So, E);
    }
    SEAM(7);
    if (IN(8)) REP(8) {
        int k512 = D / 2; asm volatile("" : "+s"(k512));
        pg8::Gemm g{(const bf16*)ACT8, (const bf16*)Wd8, k512}; pg8::GroupOrder So{F.tbl + 36, F.tbl, 4, F.G, (int)blockIdx.x, 0}; So.nunits = __builtin_amdgcn_readfirstlane(F.tbl[36 + NE]) * 4;
        pg8::EpiDown E{YS, b_down};
        pg8::gemm_phase<pg8::EpiDown, pg8::GroupOrder, true, FP8_SP2, true>(F.lds + RING_OFF, g, So, E);
    }
    SEAM(8);
#ifdef MK_XBAR
    for (int xb_ = 0; xb_ < MK_XBAR; ++xb_) xcd_barrier(bar);
#endif
    if (IN(9)) REP(9) {
        const unsigned char* ys = YS;
        const int lane9 = (int)__builtin_amdgcn_mbcnt_hi(~0u, __builtin_amdgcn_mbcnt_lo(~0u, 0u));
        float* dst9 = (rep_ + 1 < 1 + ((MK_DUP >> 9) & 1)) ? (float*)(ws + WS_ACT) : out;
        for (int m0 = gw; m0 < T; m0 += 2 * NGW) {
            f32x4 v[2][4]; int sl[2][4]; float pr[2][4]; unsigned yv[2][4][4]; bool ok[2];
#pragma unroll
            for (int q = 0; q < 2; ++q) { const int m = m0 + q * NGW; ok[q] = m < T; const int mc = ok[q] ? m : m0; const GAS f32x4* xr = (const GAS f32x4*)(out + (size_t)mc * D) + lane9;
#pragma unroll
                for (int j = 0; j < 4; ++j) v[q][j] = xr[64 * j];
#pragma unroll
                for (int k = 0; k < 4; ++k) { sl[q][k] = slot[mc * 4 + k]; pr[q][k] = topp[mc * 4 + k]; } }
#pragma unroll
            for (int q = 0; q < 2; ++q)
#pragma unroll
                for (int k = 0; k < 4; ++k) { const GAS unsigned* yr = (const GAS unsigned*)(ys + (size_t)sl[q][k] * D) + lane9;
#pragma unroll
                    for (int j = 0; j < 4; ++j) yv[q][k][j] = yr[64 * j]; }
#pragma unroll
            for (int q = 0; q < 2; ++q) { if (!ok[q]) continue; const int m = m0 + q * NGW;
#pragma unroll
                for (int k = 0; k < 4; ++k) { const float p = pr[q][k];
#pragma unroll
                    for (int j = 0; j < 4; ++j) { const unsigned u = yv[q][k][j]; const f32x2 lo = __builtin_amdgcn_cvt_pk_f32_fp8(u, false), hi = __builtin_amdgcn_cvt_pk_f32_fp8(u, true);
                        v[q][j].x += p * lo.x; v[q][j].y += p * lo.y; v[q][j].z += p * hi.x; v[q][j].w += p * hi.y; } }
                float s = 0.f;
#pragma unroll
                for (int j = 0; j < 4; ++j) s += (v[q][j].x * v[q][j].x + v[q][j].y * v[q][j].y) + (v[q][j].z * v[q][j].z + v[q][j].w * v[q][j].w);
                const float rstd = 1.f / sqrtf(wave_sum(s) * (1.f / D) + EPS);
#pragma unroll
                for (int j = 0; j < 4; ++j) { const f32x4 gg = ((const GAS f32x4*)norm_final)[lane9 + 64 * j]; f32x4 y; y.x = v[q][j].x * rstd * gg.x; y.y = v[q][j].y * rstd * gg.y; y.z = v[q][j].z * rstd * gg.z; y.w = v[q][j].w * rstd * gg.w;
                    ((GAS f32x4*)(dst9 + (size_t)m * D) + lane9)[64 * j] = y; } }
        }
    }
#ifdef MK_TSTAMP
    if (MK_TSTAMP == 9) ts_b = __builtin_amdgcn_s_memrealtime();
    if (blockIdx.x == 0) { const unsigned long long dt = ts_b - ts_a, t0_ = __builtin_amdgcn_s_memrealtime();
        while (__builtin_amdgcn_s_memrealtime() - t0_ < 2 * dt) __builtin_amdgcn_s_sleep(8); }
#endif
#undef IN
#undef SEAM
}

extern "C" void kernel_launch(void* const* d_in, const int* in_sizes, int n_in, void* d_out, int out_size, void* d_ws, size_t ws_size, hipStream_t stream) {
    static int grid = 0;
    if (grid == 0) {
        if (n_in != 19 || in_sizes[0] != T * D || out_size != T * D || ws_size < WS_END) { fprintf(stderr, "kernel_launch: unexpected shapes (n_in %d, ws %zu); nothing launched\n", n_in, ws_size); grid = -1; return; }
        int dev = 0, cus = 0, per_cu = 0;
        if (hipGetDevice(&dev) != hipSuccess || hipDeviceGetAttribute(&cus, hipDeviceAttributeMultiprocessorCount, dev) != hipSuccess) { grid = -1; return; }
        if (hipFuncSetAttribute((const void*)mk_fwd, hipFuncAttributeMaxDynamicSharedMemorySize, LDS_BYTES) != hipSuccess) { fprintf(stderr, "kernel_launch: hipFuncSetAttribute failed\n"); grid = -1; return; }
        if (hipOccupancyMaxActiveBlocksPerMultiprocessor(&per_cu, (const void*)mk_fwd, NWAVES * 64, LDS_BYTES) != hipSuccess || per_cu < 1) { fprintf(stderr, "kernel_launch: occupancy query says %d blocks per CU\n", per_cu); }
        (void)hipGetLastError();
        grid = cus;
        if (grid != 256) fprintf(stderr, "kernel_launch: %d CUs (built and tuned for 256)\n", grid);
    }
    if (grid < 0) return;
    if (hipMemsetAsync((char*)d_ws + WS_CTL, 0, CTL_ZERO_BYTES, stream) != hipSuccess) return;
    Args a{};
    for (int i = 0; i < 19; ++i) a.in[i] = (const float*)d_in[i];
    a.out = (float*)d_out; a.ws = (unsigned char*)d_ws;
#if MK_MODE == 2
    a.ph_lo = 0; a.ph_hi = NPHASE; a.li = 0;
    hipLaunchKernelGGL(mk_fwd, dim3(grid), dim3(NWAVES * 64), LDS_BYTES, stream, a);
#else
    for (int ph = 0; ph < NPHASE; ++ph) { a.ph_lo = ph; a.ph_hi = ph + 1; a.li = ph; hipLaunchKernelGGL(mk_fwd, dim3(grid), dim3(NWAVES * 64), LDS_BYTES, stream, a); }
#endif
}
```

```cpp
#define MK_DUP 0
#include <hip/hip_runtime.h>
#include <stdint.h>
#include <stdio.h>

#ifndef FP8_SP2
#define FP8_SP2 true
#endif
#ifndef MK_MODE
#define MK_MODE 2
#endif

typedef unsigned short bf16;
typedef short bf16x8 __attribute__((ext_vector_type(8)));
typedef float f32x4 __attribute__((ext_vector_type(4)));
typedef float f32x2 __attribute__((ext_vector_type(2)));
typedef unsigned u32x4 __attribute__((ext_vector_type(4)));
typedef unsigned u32x2 __attribute__((ext_vector_type(2)));
#define GAS __attribute__((address_space(1)))
#define LAS __attribute__((address_space(3)))
typedef GAS unsigned gu32;

constexpr int T = 16384, S = 8192, D = 1024, NPROJ = 5888, NQKV = 3840, NGATE = 2048, NE = 32, TOPK = 4;
constexpr int C_QA = 0, C_KA = 1024, C_VA = 1280, C_QB = 1536, C_KB = 2304, C_VB = 3072;
constexpr float EPS = 1e-5f;
constexpr size_t MiB = 1u << 20;
constexpr size_t WS_CTL = 0, CTL_ZERO_BYTES = 1 * MiB;
constexpr size_t WS_TAB = 1 * MiB;
constexpr size_t WS_WIN = 2 * MiB;
constexpr size_t WS_WA = 14 * MiB;
constexpr size_t WS_WB = 16 * MiB;
constexpr size_t WS_WOUT = 17 * MiB;
constexpr size_t WS_RT = 19 * MiB;
constexpr size_t WS_WGU = 24 * MiB;
constexpr size_t WS_WD = 88 * MiB;
constexpr size_t WS_H2 = 120 * MiB;
constexpr size_t WS_HS = 136 * MiB;
constexpr size_t WS_ACT = 201 * MiB;
constexpr size_t WS_YS = 272 * MiB;
constexpr size_t WS_XN = 216 * MiB;
constexpr size_t WS_XNP = 312 * MiB;
constexpr size_t WS_K2 = 344 * MiB;
constexpr size_t WS_QKV = 248 * MiB;
constexpr size_t WS_GATES = 368 * MiB;
constexpr size_t WS_YA = 432 * MiB;
constexpr size_t WS_YB = 464 * MiB;
constexpr size_t WS_MERGED = 472 * MiB;
constexpr size_t WS_VT = 472 * MiB;
constexpr size_t WS_END = 506 * MiB;
constexpr int CW_CNT = 0;
constexpr int CW_BAR = 4096;

__device__ const unsigned char BKT_A[257] = {12,12,12,12,12,12,12,12,12,12,12,12,12,12,12,12,12,12,12,12,12,12,12,12,12,12,12,12,12,12,12,12,12,12,12,12,12,12,11,11,11,11,11,11,11,11,11,11,11,11,11,11,11,11,11,11,11,11,11,11,11,11,11,11,11,11,11,11,11,11,11,11,11,11,11,11,11,11,11,10,10,10,10,10,10,10,10,10,10,10,10,10,10,10,10,10,10,10,10,10,10,10,9,9,9,9,9,9,9,9,9,9,9,9,8,8,8,8,8,8,8,7,6,5,4,3,2,1,0,17,18,19,20,21,22,23,24,24,24,24,24,24,24,25,25,25,25,25,25,25,25,25,25,25,25,26,26,26,26,26,26,26,26,26,26,26,26,26,26,26,26,26,26,26,26,26,26,26,27,27,27,27,27,27,27,27,27,27,27,27,27,27,27,27,27,27,27,27,27,27,27,27,27,27,27,27,27,27,27,27,27,27,27,27,27,27,27,27,27,28,28,28,28,28,28,28,28,28,28,28,28,28,28,28,28,28,28,28,28,28,28,28,28,28,28,28,28,28,28,28,28,28,28,28,28,28,28};
__device__ const unsigned char BKT_B[3][129] = {
 {11,11,11,11,11,11,11,11,11,11,11,11,11,11,11,10,10,10,10,10,10,10,10,10,10,10,10,10,10,10,10,10,10,10,10,10,10,10,9,9,9,9,9,9,9,9,9,9,9,9,8,8,8,8,8,8,8,7,6,5,4,3,2,1,0,17,18,19,20,21,22,23,24,24,24,24,24,24,24,25,25,25,25,25,25,25,25,25,25,25,25,26,26,26,26,26,26,26,26,26,26,26,26,26,26,26,26,26,26,26,26,26,26,26,27,27,27,27,27,27,27,27,27,27,27,27,27,27,27},
 {13,13,13,13,13,13,13,13,13,13,13,13,13,13,13,13,13,13,13,13,13,13,13,12,12,12,12,12,12,12,12,12,12,12,12,12,12,12,12,12,12,12,11,11,11,11,11,11,11,11,11,11,10,10,10,10,10,10,9,9,9,8,8,4,0,20,24,24,25,25,25,26,26,26,26,26,26,27,27,27,27,27,27,27,27,27,27,28,28,28,28,28,28,28,28,28,28,28,28,28,28,28,28,28,28,28,29,29,29,29,29,29,29,29,29,29,29,29,29,29,29,29,29,29,29,29,29,29,29},
 {15,15,15,15,15,15,15,15,15,15,15,15,15,15,15,15,15,15,15,15,15,15,15,15,15,15,15,15,15,15,14,14,14,14,14,14,14,14,14,14,14,14,14,14,14,13,13,13,13,13,13,13,13,13,12,12,12,12,12,11,11,10,10,9,0,25,26,26,27,27,28,28,28,28,28,29,29,29,29,29,29,29,29,29,30,30,30,30,30,30,30,30,30,30,30,30,30,30,30,31,31,31,31,31,31,31,31,31,31,31,31,31,31,31,31,31,31,31,31,31,31,31,31,31,31,31,31,31,31}};

#define RLX_AGENT __ATOMIC_RELAXED, __HIP_MEMORY_SCOPE_AGENT
#define LDS_WAIT() asm volatile("s_waitcnt lgkmcnt(0)" ::: "memory")
#define VM_WAIT() asm volatile("s_waitcnt vmcnt(0)" ::: "memory")
__device__ __forceinline__ unsigned f2bf(float f) { unsigned u = __builtin_bit_cast(unsigned, f); return (u + 0x7fffu + ((u >> 16) & 1u)) >> 16; }
__device__ __forceinline__ unsigned pk2(float lo, float hi) { return f2bf(lo) | (f2bf(hi) << 16); }
__device__ __forceinline__ unsigned pk4_fp8(float a, float b, float c, float d) { unsigned w = 0; w = __builtin_amdgcn_cvt_pk_fp8_f32(a, b, w, false); w = __builtin_amdgcn_cvt_pk_fp8_f32(c, d, w, true); return w; }
__device__ __forceinline__ float bf2f(unsigned b) { return __builtin_bit_cast(float, b << 16); }
__device__ __forceinline__ float bflo(unsigned u) { return __builtin_bit_cast(float, u << 16); }
__device__ __forceinline__ float bfhi(unsigned u) { return __builtin_bit_cast(float, u & 0xffff0000u); }
__device__ __forceinline__ float wave_sum(float v) {
#pragma unroll
    for (int o = 1; o < 64; o <<= 1) v += __shfl_xor(v, o);
    return v;
}
__device__ __forceinline__ float sigm(float x) { return __builtin_amdgcn_rcpf(1.f + __builtin_amdgcn_exp2f(-1.4426950408889634f * x)); }

struct Tabs { float biasA[16][257]; float biasB[3][4][129]; };

namespace pg8 {
#define PG8_LAS __attribute__((address_space(3)))
typedef unsigned short bf16_t;
constexpr int BM = 256, BK = 64, HALF = 128, HTB = HALF * BK * 2, STAGE_BYTES = 8 * HTB, NXCD = 8, WGM = 8;
__host__ __device__ __forceinline__ int lds_byte(int r, int c) { const int st = (r >> 4) * 2 + (c >> 5), rr = r & 15, cc = c & 31, ob = rr * 64 + cc * 2; return st * 1024 + (ob ^ (((ob >> 9) & 1) << 5)); }
__host__ __device__ __forceinline__ void stage_rc(int b, int& R, int& C) { const int st = b / 1024, sb = b % 1024, swz = sb ^ (((sb >> 9) & 1) << 5); R = (st >> 1) * 16 + swz / 64; C = (st & 1) * 32 + (swz % 64) / 2; }
__host__ __device__ __forceinline__ int perm32(int rho) { const int n = rho >> 4, i = rho & 15; return 8 * (i >> 2) + 4 * n + (i & 3); }

struct Unit { int arow, brow, nrows, e, swap; };
struct Gemm { const bf16_t* A; const bf16_t* Bt; int K; };

struct StaticOrder {
    int nM, nN, nwg, G, c;
    __device__ void init(int M, int N, int G_, int c_) { nM = M / BM; nN = N / BM; nwg = nM * nN; G = G_; c = c_; }
    __device__ bool next(int i, Unit& u) const {
        const long L = (long)i * G + c; if (L >= nwg) return false;
        int wgid = (int)L; { const int q = nwg / NXCD, r = nwg % NXCD, xcd = wgid % NXCD, off = wgid / NXCD; wgid = (xcd < r ? xcd * (q + 1) : r * (q + 1) + (xcd - r) * q) + off; }
        const int nig = WGM * nN, gid = wgid / nig, fm = gid * WGM, gsz = (nM - fm) < WGM ? (nM - fm) : WGM;
        u.arow = BM * (fm + ((wgid % nig) % gsz)); u.brow = BM * ((wgid % nig) / gsz); u.nrows = BM; u.e = 0; u.swap = 0; return true;
    }
    __device__ __forceinline__ void a_ready(const Unit&) const {}
    __device__ __forceinline__ void done(const Unit&) const {}
};
constexpr int XNP_ROW0 = (int)((WS_XNP - WS_XN) / D);
struct ProjOrder {
    StaticOrder so;
    __device__ bool next(int i, Unit& u) const { if (!so.next(i, u)) return false;
        if (u.brow == C_VA || (u.brow >= C_VB && u.brow < NQKV)) { const int a = u.arow; u.arow = u.brow; u.brow = a; u.swap = 1; u.e = a;
            if (u.arow == C_VB + 256) u.brow += XNP_ROW0; else if (u.arow == C_VB + 512) u.brow += XNP_ROW0 + T; } return true; }
    __device__ __forceinline__ void a_ready(const Unit&) const {}
    __device__ __forceinline__ void done(const Unit&) const {}
};
struct GroupOrder {
    const PG8_LAS int* toff; const PG8_LAS int* off; int NT, G, c, nunits;
    __device__ bool next(int i, Unit& u) const {
        int L;
        if (G & 7) { L = i * G + c; }
        else { const int q = (nunits + 7) >> 3, j = i * (G >> 3) + (c >> 3); if (j >= q) return false; L = (c & 7) * q + j; }
        if (L >= nunits) return false;
        const int mtg = L / NT, pn = L - mtg * NT;
        int e = 0;
        for (int j = 1; j < NE; ++j) e += (toff[j] <= mtg) ? 1 : 0;
        e = __builtin_amdgcn_readfirstlane(e);
        const int mt = mtg - __builtin_amdgcn_readfirstlane(toff[e]); const int o0 = __builtin_amdgcn_readfirstlane(off[e]), o1 = __builtin_amdgcn_readfirstlane(off[e + 1]);
        u.arow = o0 + BM * mt; const int rem = o1 - u.arow; u.nrows = rem < BM ? rem : BM; u.brow = (e * NT + pn) * BM; u.e = e; u.swap = 0; return true;
    }
    __device__ __forceinline__ void a_ready(const Unit&) const {}
    __device__ __forceinline__ void done(const Unit&) const {}
};

__device__ __forceinline__ void st16_wt(void* p, u32x4 v) { asm volatile("global_store_dwordx4 %0, %1, off sc1\n\ts_nop 2" :: "v"(p), "v"(v) : "memory"); }
__device__ __forceinline__ void st8_wt(void* p, u32x2 v) { asm volatile("global_store_dwordx2 %0, %1, off sc1\n\ts_nop 2" :: "v"(p), "v"(v) : "memory"); }
__device__ __forceinline__ unsigned cvt_pk_bf16(float lo, float hi) { unsigned r; asm volatile("v_cvt_pk_bf16_f32 %0, %1, %2" : "=v"(r) : "v"(lo), "v"(hi)); return r; }

struct EpiProj {
    static constexpr bool PERM = true, AFTER_DRAIN = false; static constexpr int TAG = 1;
    bf16_t* qkv; bf16_t* gates; const float* bias; bf16_t* vta; bf16_t* vtb; unsigned char* k2;
    __device__ __forceinline__ void prefetch(const Unit& u, PG8_LAS unsigned char* slot, int wid, int lane) const {
        if (wid == 0) { int l4 = 4 * lane; asm volatile("" : "+v"(l4));
            __builtin_amdgcn_global_load_lds((const unsigned*)(bias + (u.swap ? u.arow : u.brow) + l4), (PG8_LAS unsigned*)slot, 16, 0, 0); } }
    __device__ __forceinline__ void operator()(const f32x4 (&acc)[2][2][4][2], const Unit& u, int wr, int wc, int fr, int fq, const PG8_LAS unsigned char* slot) const {
        if (!u.swap) {
            const int colt = u.brow; const bool isq = colt < NQKV; unsigned char* base = isq ? (unsigned char*)qkv : (unsigned char*)gates; const int ldc = isq ? NQKV : NGATE; const int cb = isq ? colt : colt - NQKV;
            const int row0 = u.arow + wr * 64 + fr, col0 = cb + wc * 32 + 8 * fq;
            const PG8_LAS f32x4* bl = (const PG8_LAS f32x4*)(slot + (wc * 32 + 8 * fq) * 4);
            const float qs = (colt < C_KA || (colt >= C_QB && colt < C_KB)) ? 0.125f * 1.4426950408889634f : 1.f;
            const bool isk = (colt == C_KA) || (colt >= C_KB && colt < C_VB);
            if (!isk) {
#pragma unroll
            for (int ai = 0; ai < 2; ++ai)
#pragma unroll
                for (int m = 0; m < 4; ++m) { unsigned char* rowp = base + (size_t)(row0 + ai * HALF + m * 16) * ldc + col0;
#pragma unroll
                    for (int bj = 0; bj < 2; ++bj) { const f32x4 v0 = (acc[ai][bj][m][0] + bl[bj * 32]) * qs, v1 = (acc[ai][bj][m][1] + bl[bj * 32 + 1]) * qs;
                        u32x2 w; w.x = pk4_fp8(v0[0], v0[1], v0[2], v0[3]); w.y = pk4_fp8(v1[0], v1[1], v1[2], v1[3]); *(u32x2*)(rowp + bj * HALF) = w; }
                    asm volatile("" ::: "memory"); }
            } else {
                const int gsel = (colt == C_KA) ? -1 : ((colt - C_KB) >> 8); const int sh = (gsel <= 0) ? 0 : (gsel == 1 ? 2 : 4);
                unsigned char* kb = k2 + (size_t)(gsel + 1) * (2 * 4 * 8192 * 64);
                int c0 = wc * 32 + 8 * fq; asm volatile("" : "+v"(c0));
#pragma unroll
                for (int ai = 0; ai < 2; ++ai)
#pragma unroll
                    for (int m = 0; m < 4; ++m) { const int row = row0 + ai * HALF + m * 16, b = row >> 13, sq = row & 8191; const int pos = ((sq & ((1 << sh) - 1)) << (13 - sh)) + (sq >> sh);
#pragma unroll
                        for (int bj = 0; bj < 2; ++bj) { const int c = c0 + bj * HALF; const f32x4 v0 = acc[ai][bj][m][0] + bl[bj * 32], v1 = acc[ai][bj][m][1] + bl[bj * 32 + 1];
                            u32x2 w; w.x = pk4_fp8(v0[0], v0[1], v0[2], v0[3]); w.y = pk4_fp8(v1[0], v1[1], v1[2], v1[3]);
                            *(u32x2*)(kb + ((size_t)((b * 4 + (c >> 6)) * 8192 + pos)) * 64 + (c & 63)) = w; }
                        asm volatile("" ::: "memory"); }
            }
        } else {
            const int colt = u.arow, tok0 = u.e; const int gsel = (colt == C_VA) ? -1 : ((colt - C_VB) >> 8); const int sh = (gsel <= 0) ? 0 : (gsel == 1 ? 2 : 4);
            bf16_t* vb = ((gsel < 0) ? vta : vtb + (size_t)gsel * (2 * 256 * 8192)) + (size_t)((tok0 >> 13) * 256) * 8192;
            const int mub = (tok0 & 8191) >> sh;
#pragma unroll
            for (int ai = 0; ai < 2; ++ai)
#pragma unroll
                for (int m = 0; m < 4; ++m) { const int c = ai * HALF + wr * 64 + m * 16 + fr; const float bvr = *(const PG8_LAS float*)(slot + c * 4); bf16_t* vrow = vb + (size_t)(c >> 6) * (64 * 8192) + (c & 63) * 32;
#pragma unroll
                    for (int bj = 0; bj < 2; ++bj) { const int j0 = bj * HALF + wc * 32 + 8 * fq;
                        const int rho = j0 >> (8 - sh), mu = mub + (j0 & ((256 >> sh) - 1));
                        const int p0 = ((rho << (8 - sh)) + (mu >> 5)) * 2048 + (((mu & 15) >> 2) << 3) + (((mu >> 4) & 1) << 2);
                        const f32x4 v0 = acc[ai][bj][m][0] + bvr, v1 = acc[ai][bj][m][1] + bvr;
                        u32x2 w0, w1; w0.x = cvt_pk_bf16(v0[0], v0[1]); w0.y = cvt_pk_bf16(v0[2], v0[3]); w1.x = cvt_pk_bf16(v1[0], v1[1]); w1.y = cvt_pk_bf16(v1[2], v1[3]);
                        *(u32x2*)(vrow + p0) = w0; *(u32x2*)(vrow + p0 + 8) = w1; }
                    asm volatile("" ::: "memory"); }
        }
    }
};
template <int MODE> struct EpiGate {
    static constexpr bool PERM = true, AFTER_DRAIN = false; static constexpr int TAG = 3;
    bf16_t* out; const bf16_t* gates; int gcol0; unsigned char* out8;
    __device__ __forceinline__ void prefetch(const Unit&, PG8_LAS unsigned char*, int, int) const {}
    __device__ __forceinline__ void operator()(const f32x4 (&acc)[2][2][4][2], const Unit& u, int wr, int wc, int fr, int fq, const PG8_LAS unsigned char*) const {
        const int row0 = u.arow + wr * 64 + fr, col0 = u.brow + wc * 32 + 8 * fq;
        u32x2 gv[8][2];
#pragma unroll
        for (int gi = 0; gi < 4; ++gi) { const size_t r = (size_t)(row0 + (gi >> 2) * HALF + (gi & 3) * 16);
#pragma unroll
            for (int bj = 0; bj < 2; ++bj) gv[gi][bj] = *(const u32x2*)((const unsigned char*)gates + r * NGATE + gcol0 + col0 + bj * HALF); }
        u32x4 mv[2], mn[2];
        if (MODE == 1) {
#pragma unroll
            for (int bj = 0; bj < 2; ++bj) mv[bj] = *(const u32x4*)(out + (size_t)row0 * D + col0 + bj * HALF); }
#pragma unroll
        for (int gi = 0; gi < 8; ++gi) { const int ai = gi >> 2, m = gi & 3; const size_t r = (size_t)(row0 + ai * HALF + m * 16);
            if (gi == 1) {
#pragma unroll
                for (int g2 = 4; g2 < 8; ++g2) { const size_t r2 = (size_t)(row0 + (g2 >> 2) * HALF + (g2 & 3) * 16);
#pragma unroll
                    for (int bj = 0; bj < 2; ++bj) gv[g2][bj] = *(const u32x2*)((const unsigned char*)gates + r2 * NGATE + gcol0 + col0 + bj * HALF); } }
            if (MODE == 1 && gi + 1 < 8) { const size_t rn = (size_t)(row0 + ((gi + 1) >> 2) * HALF + ((gi + 1) & 3) * 16);
#pragma unroll
                for (int bj = 0; bj < 2; ++bj) mn[bj] = *(const u32x4*)(out + rn * D + col0 + bj * HALF); }
#pragma unroll
            for (int bj = 0; bj < 2; ++bj) { const int c = col0 + bj * HALF; const u32x2 g4 = gv[gi][bj]; const f32x4 a0 = acc[ai][bj][m][0], a1 = acc[ai][bj][m][1];
                const f32x2 ga = __builtin_amdgcn_cvt_pk_f32_fp8(g4.x, false), gb = __builtin_amdgcn_cvt_pk_f32_fp8(g4.x, true), gc = __builtin_amdgcn_cvt_pk_f32_fp8(g4.y, false), gd = __builtin_amdgcn_cvt_pk_f32_fp8(g4.y, true);
                float o[8]; o[0] = sigm(ga.x) * a0[0]; o[1] = sigm(ga.y) * a0[1]; o[2] = sigm(gb.x) * a0[2]; o[3] = sigm(gb.y) * a0[3];
                o[4] = sigm(gc.x) * a1[0]; o[5] = sigm(gc.y) * a1[1]; o[6] = sigm(gd.x) * a1[2]; o[7] = sigm(gd.y) * a1[3];
                if (MODE == 1) { const u32x4 m4 = mv[bj];
                    o[0] += bflo(m4.x); o[1] += bfhi(m4.x); o[2] += bflo(m4.y); o[3] += bfhi(m4.y); o[4] += bflo(m4.z); o[5] += bfhi(m4.z); o[6] += bflo(m4.w); o[7] += bfhi(m4.w); }
                if (MODE == 1) { u32x2 w8; w8.x = pk4_fp8(o[0], o[1], o[2], o[3]); w8.y = pk4_fp8(o[4], o[5], o[6], o[7]); *(u32x2*)(out8 + r * D + c) = w8; }
                else { u32x4 w; w.x = cvt_pk_bf16(o[0], o[1]); w.y = cvt_pk_bf16(o[2], o[3]); w.z = cvt_pk_bf16(o[4], o[5]); w.w = cvt_pk_bf16(o[6], o[7]);
                    *(u32x4*)(out + r * D + c) = w; } }
            asm volatile("" ::: "memory");
            if (MODE == 1) {
#pragma unroll
                for (int bj = 0; bj < 2; ++bj) mv[bj] = mn[bj]; } }
    }
};
struct EpiX1 {
    static constexpr bool PERM = true, AFTER_DRAIN = false; static constexpr int TAG = 4;
    const float* x; float* out;
    __device__ __forceinline__ void prefetch(const Unit&, PG8_LAS unsigned char*, int, int) const {}
    __device__ __forceinline__ void operator()(const f32x4 (&acc)[2][2][4][2], const Unit& u, int wr, int wc, int fr, int fq, const PG8_LAS unsigned char*) const {
        const int row0 = u.arow + wr * 64 + fr, col0 = u.brow + wc * 32 + 8 * fq;
        f32x4 xv[2][2], xn[2][2];
#pragma unroll
        for (int bj = 0; bj < 2; ++bj) { const size_t o = (size_t)row0 * D + col0 + bj * HALF; xv[bj][0] = *(const f32x4*)(x + o); xv[bj][1] = *(const f32x4*)(x + o + 4); }
#pragma unroll
        for (int gi = 0; gi < 8; ++gi) { const int ai = gi >> 2, m = gi & 3; const size_t r = (size_t)(row0 + ai * HALF + m * 16);
            if (gi + 1 < 8) { const size_t rn = (size_t)(row0 + ((gi + 1) >> 2) * HALF + ((gi + 1) & 3) * 16);
#pragma unroll
                for (int bj = 0; bj < 2; ++bj) { const size_t o = rn * D + col0 + bj * HALF; xn[bj][0] = *(const f32x4*)(x + o); xn[bj][1] = *(const f32x4*)(x + o + 4); } }
#pragma unroll
            for (int bj = 0; bj < 2; ++bj) { const size_t o = r * D + col0 + bj * HALF;
                *(f32x4*)(out + o) = xv[bj][0] + acc[ai][bj][m][0]; *(f32x4*)(out + o + 4) = xv[bj][1] + acc[ai][bj][m][1]; }
            asm volatile("" ::: "memory");
#pragma unroll
            for (int bj = 0; bj < 2; ++bj) { xv[bj][0] = xn[bj][0]; xv[bj][1] = xn[bj][1]; } }
    }
};
struct EpiSwiglu {
    static constexpr bool PERM = true, AFTER_DRAIN = false; static constexpr int TAG = 7;
    unsigned char* act; const float* bg; const float* bu;
    __device__ __forceinline__ void prefetch(const Unit& u, PG8_LAS unsigned char* slot, int wid, int lane) const {
        if (wid == 0) { const int pn = (u.brow >> 8) & 7; const float* src = ((lane < 32) ? bg : bu) + (size_t)u.e * D + pn * HALF + 4 * (lane & 31);
            __builtin_amdgcn_global_load_lds((const unsigned*)src, (PG8_LAS unsigned*)slot, 16, 0, 0); } }
    __device__ __forceinline__ void operator()(const f32x4 (&acc)[2][2][4][2], const Unit& u, int wr, int wc, int fr, int fq, const PG8_LAS unsigned char* slot) const {
        const int pn = (u.brow >> 8) & 7; const int col0 = pn * HALF + wc * 32 + 8 * fq; const int rl0 = wr * 64 + fr;
        const PG8_LAS f32x4* bl = (const PG8_LAS f32x4*)(slot + (wc * 32 + 8 * fq) * 4);
        const f32x4 g0 = bl[0], g1 = bl[1], u0 = bl[32], u1 = bl[33];
#pragma unroll
        for (int ai = 0; ai < 2; ++ai)
#pragma unroll
            for (int m = 0; m < 4; ++m) { const int rl = rl0 + ai * HALF + m * 16;
                const f32x4 ga = acc[ai][0][m][0] + g0, gb = acc[ai][0][m][1] + g1, ua = acc[ai][1][m][0] + u0, ub = acc[ai][1][m][1] + u1;
                float o[8];
#pragma unroll
                for (int j = 0; j < 4; ++j) { const float gt = fminf(ga[j], 7.f), up = fminf(fmaxf(ua[j], -7.f), 7.f); o[j] = gt * sigm(1.702f * gt) * (up + 1.f);
                    const float gt2 = fminf(gb[j], 7.f), up2 = fminf(fmaxf(ub[j], -7.f), 7.f); o[4 + j] = gt2 * sigm(1.702f * gt2) * (up2 + 1.f); }
                u32x2 w; w.x = pk4_fp8(o[0], o[1], o[2], o[3]); w.y = pk4_fp8(o[4], o[5], o[6], o[7]);
                if (rl < u.nrows) *(u32x2*)(act + (size_t)(u.arow + rl) * D + col0) = w; }
    }
};
struct EpiDown {
    static constexpr bool PERM = true, AFTER_DRAIN = false; static constexpr int TAG = 8;
    unsigned char* ys; const float* bd;
    __device__ __forceinline__ void prefetch(const Unit& u, PG8_LAS unsigned char* slot, int wid, int lane) const {
        if (wid == 0) { const int pn = (u.brow >> 8) & 3; __builtin_amdgcn_global_load_lds((const unsigned*)(bd + (size_t)u.e * D + pn * BM + 4 * lane), (PG8_LAS unsigned*)slot, 16, 0, 0); } }
    __device__ __forceinline__ void operator()(const f32x4 (&acc)[2][2][4][2], const Unit& u, int wr, int wc, int fr, int fq, const PG8_LAS unsigned char* slot) const {
        const int pn = (u.brow >> 8) & 3; const int col0 = pn * BM + wc * 32 + 8 * fq; const int rl0 = wr * 64 + fr;
        f32x4 bv[2][2];
#pragma unroll
        for (int bj = 0; bj < 2; ++bj)
#pragma unroll
            for (int n = 0; n < 2; ++n) bv[bj][n] = *(const PG8_LAS f32x4*)(slot + (wc * 32 + 8 * fq + bj * HALF + 4 * n) * 4);
#pragma unroll
        for (int ai = 0; ai < 2; ++ai)
#pragma unroll
            for (int m = 0; m < 4; ++m) { const int rl = rl0 + ai * HALF + m * 16; unsigned char* rowp = ys + (size_t)(u.arow + rl) * D + col0;
#pragma unroll
                for (int bj = 0; bj < 2; ++bj) { const f32x4 v0 = acc[ai][bj][m][0] + bv[bj][0], v1 = acc[ai][bj][m][1] + bv[bj][1];
                    u32x2 w; w.x = pk4_fp8(v0[0], v0[1], v0[2], v0[3]); w.y = pk4_fp8(v1[0], v1[1], v1[2], v1[3]);
                    if (rl < u.nrows) *(u32x2*)(rowp + bj * HALF) = w; } }
    }
};

typedef int i32x4_t __attribute__((ext_vector_type(4))); typedef int i32x8_t __attribute__((ext_vector_type(8)));
template <bool FP8> struct Frag;
template <> struct Frag<false> { bf16x8 v[2];
    __device__ __forceinline__ void ld(const PG8_LAS unsigned char* p) { v[0] = *(const PG8_LAS bf16x8*)p; v[1] = *(const PG8_LAS bf16x8*)(p + 1024); } };
template <> struct Frag<true> { i32x8_t v;
    __device__ __forceinline__ void ld(const PG8_LAS unsigned char* p) { const i32x4_t lo = *(const PG8_LAS i32x4_t*)p, hi = *(const PG8_LAS i32x4_t*)(p + 1024); v = __builtin_shufflevector(lo, hi, 0, 1, 2, 3, 4, 5, 6, 7); } };
__device__ __forceinline__ f32x4 mma_frag(const Frag<false>& w, const Frag<false>& x, f32x4 c) {
    c = __builtin_amdgcn_mfma_f32_16x16x32_bf16(w.v[0], x.v[0], c, 0, 0, 0); return __builtin_amdgcn_mfma_f32_16x16x32_bf16(w.v[1], x.v[1], c, 0, 0, 0); }
__device__ __forceinline__ f32x4 mma_frag(const Frag<true>& w, const Frag<true>& x, f32x4 c) {
    const int sa = 0x7A7A7A7A, sb = 0x7F7F7F7F;
    asm volatile("v_mfma_scale_f32_16x16x128_f8f6f4 %0, %1, %2, %0, %3, %4 op_sel_hi:[0,0,0]" : "+v"(c) : "v"(w.v), "v"(x.v), "v"(sa), "v"(sb));
    return c; }
template <class Epi, class Sched, bool ALIGN_EPI = false, bool SP2 = false, bool FP8 = false>
__device__ __forceinline__ void gemm_phase(PG8_LAS unsigned char* lds, const Gemm g, const Sched& S, const Epi& E) {
    const int tid = threadIdx.x, wid = __builtin_amdgcn_readfirstlane(tid >> 6), lane = tid & 63, wr = wid >> 2, wc = wid & 3, fr = lane & 15, fq = lane >> 4;
    const int K = g.K, nt = K / BK;
    unsigned voffA[2], voffB[2];
#pragma unroll
    for (int i = 0; i < 2; ++i) { int R, C; stage_rc(tid * 16 + i * 8192, R, C); const int Rb = Epi::PERM ? ((R & ~31) + perm32(R & 31)) : R;
        voffA[i] = (unsigned)(R * K + C) * 2u; voffB[i] = (unsigned)(Rb * K + C) * 2u; }
    const size_t kstep = (size_t)(BK * 2);
    const size_t hstep = (size_t)HALF * K * 2;
    const size_t rowb = (size_t)K * 2;
    const unsigned ldsw = (unsigned)wid * 1024u;
    const int aoff = lds_byte(wr * 64 + fr, fq * 8), boff = lds_byte(wc * 32 + fr, fq * 8);
#define PG8_SA(b, h) (((b) * 2 + (h)) * HTB)
#define PG8_SB(b, h) ((4 + (b) * 2 + (h)) * HTB)
#define PG8_STAGE(bufoff, gbase, voff) do { _Pragma("unroll") for (int _i = 0; _i < 2; ++_i) \
        __builtin_amdgcn_global_load_lds((const unsigned*)((const char*)(gbase) + (voff)[_i]), (PG8_LAS unsigned*)(lds + (bufoff) + ldsw + _i * 8192), 16, 0, 0); } while (0)
#define PG8_LDA(dst, b, h) do { _Pragma("unroll") for (int m = 0; m < 4; ++m) dst[m].ld(lds + PG8_SA(b, h) + aoff + m * 2048); } while (0)
#define PG8_LDB(dst, b, h) do { _Pragma("unroll") for (int n = 0; n < 2; ++n) dst[n].ld(lds + PG8_SB(b, h) + boff + n * 2048); } while (0)
#define PG8_MMA(ai, bj, At, Bt) do { __builtin_amdgcn_s_setprio(1); _Pragma("unroll") for (int m = 0; m < 4; ++m) _Pragma("unroll") for (int n = 0; n < 2; ++n) \
        acc[ai][bj][m][n] = mma_frag(Bt[n], At[m], acc[ai][bj][m][n]); __builtin_amdgcn_s_setprio(0); } while (0)
#define PG8_WAIT_V(n) asm volatile("s_waitcnt vmcnt(" #n ")" ::: "memory")
#define PG8_WAIT_L(n) asm volatile("s_waitcnt lgkmcnt(" #n ")" ::: "memory")
#define PG8_BAR __builtin_amdgcn_s_barrier()
#define PG8_SCHED __builtin_amdgcn_sched_barrier(0)
    Unit cur, nxt; int ui = 0;
    if (!S.next(0, cur)) return;
    f32x4 acc[2][2][4][2];
#pragma unroll
    for (int a = 0; a < 2; ++a)
#pragma unroll
        for (int b = 0; b < 2; ++b)
#pragma unroll
            for (int m = 0; m < 4; ++m)
#pragma unroll
                for (int n = 0; n < 2; ++n) acc[a][b][m][n] = (f32x4){0.f, 0.f, 0.f, 0.f};
    Frag<FP8> At[4], B0[2], B1[2];
    const char* cA = (const char*)(cur.swap ? g.Bt : g.A) + (size_t)cur.arow * rowb; const char* cB = (const char*)(cur.swap ? g.A : g.Bt) + (size_t)cur.brow * rowb;
    S.a_ready(cur);
    PG8_LAS unsigned char* const blds = lds + 131072 + 4096;
    E.prefetch(cur, blds, wid, lane);
    if constexpr (SP2) {
        PG8_STAGE(PG8_SB(0, 0), cB, voffB); PG8_STAGE(PG8_SB(0, 1), cB + hstep, voffB); PG8_STAGE(PG8_SA(0, 0), cA, voffA); PG8_STAGE(PG8_SA(0, 1), cA + hstep, voffA);
        if (wr == 1) PG8_BAR;
        PG8_WAIT_V(2); PG8_BAR;
        PG8_STAGE(PG8_SB(1, 0), cB + kstep, voffB); PG8_STAGE(PG8_SA(1, 0), cA + kstep, voffA); PG8_STAGE(PG8_SB(1, 1), cB + hstep + kstep, voffB);
        PG8_WAIT_V(6); PG8_BAR;
    } else {
        PG8_STAGE(PG8_SB(0, 0), cB, voffB); PG8_STAGE(PG8_SA(0, 0), cA, voffA); PG8_STAGE(PG8_SB(0, 1), cB + hstep, voffB); PG8_STAGE(PG8_SA(0, 1), cA + hstep, voffA);
        if (wr == 1) PG8_BAR;
        PG8_WAIT_V(4); PG8_BAR;
        PG8_STAGE(PG8_SB(1, 0), cB + kstep, voffB); PG8_STAGE(PG8_SA(1, 0), cA + kstep, voffA); PG8_STAGE(PG8_SB(1, 1), cB + hstep + kstep, voffB);
        PG8_WAIT_V(6); PG8_BAR;
    }
    for (;;) {
        const bool has_next = S.next(ui + 1, nxt);
        const char* nA = has_next ? (const char*)(nxt.swap ? g.Bt : g.A) + (size_t)nxt.arow * rowb : cA; const char* nB = has_next ? (const char*)(nxt.swap ? g.A : g.Bt) + (size_t)nxt.brow * rowb : cB;
        for (int t = 0; t < nt; t += 2) {
            const bool last = (t == nt - 2);
            const char* a1 = cA + (size_t)(t + 1) * kstep;
            const char* a2 = last ? nA : cA + (size_t)(t + 2) * kstep; const char* b2 = last ? nB : cB + (size_t)(t + 2) * kstep;
            const char* a3 = a2 + kstep; const char* b3 = b2 + kstep;
            if (last && has_next) { S.a_ready(nxt); E.prefetch(nxt, blds + (((ui + 1) & 1) << 10), wid, lane); }
            if constexpr (SP2) {
            PG8_LDB(B0, 0, 0); PG8_LDB(B1, 0, 1); PG8_SCHED; PG8_LDA(At, 0, 0); PG8_STAGE(PG8_SA(1, 1), a1 + hstep, voffA);
            PG8_WAIT_V(8); PG8_WAIT_L(0); PG8_BAR; PG8_MMA(0, 0, At, B0); PG8_MMA(0, 1, At, B1); PG8_BAR; PG8_SCHED;
            PG8_LDA(At, 0, 1); PG8_STAGE(PG8_SB(0, 0), b2, voffB); PG8_STAGE(PG8_SB(0, 1), b2 + hstep, voffB); PG8_STAGE(PG8_SA(0, 0), a2, voffA);
            PG8_WAIT_V(8); PG8_WAIT_L(0); PG8_BAR; PG8_MMA(1, 0, At, B0); PG8_MMA(1, 1, At, B1); PG8_BAR; PG8_SCHED;
            PG8_LDB(B0, 1, 0); PG8_LDB(B1, 1, 1); PG8_SCHED; PG8_LDA(At, 1, 0); PG8_STAGE(PG8_SA(0, 1), a2 + hstep, voffA);
            PG8_WAIT_V(8); PG8_WAIT_L(0); PG8_BAR; PG8_MMA(0, 0, At, B0); PG8_MMA(0, 1, At, B1); PG8_BAR; PG8_SCHED;
            PG8_LDA(At, 1, 1); PG8_STAGE(PG8_SB(1, 0), b3, voffB); PG8_STAGE(PG8_SB(1, 1), b3 + hstep, voffB); PG8_STAGE(PG8_SA(1, 0), a3, voffA);
            PG8_WAIT_V(8); PG8_WAIT_L(0); PG8_BAR; PG8_MMA(1, 0, At, B0); PG8_MMA(1, 1, At, B1); PG8_BAR; PG8_SCHED;
            } else {
            PG8_LDB(B0, 0, 0); PG8_SCHED; PG8_LDA(At, 0, 0); PG8_STAGE(PG8_SA(1, 1), a1 + hstep, voffA);
            PG8_WAIT_L(8); PG8_BAR; PG8_WAIT_L(0); PG8_MMA(0, 0, At, B0); PG8_BAR; PG8_SCHED;
            PG8_LDB(B1, 0, 1); PG8_STAGE(PG8_SB(0, 0), b2, voffB);
            PG8_BAR; PG8_WAIT_L(0); PG8_MMA(0, 1, At, B1); PG8_BAR;
            PG8_LDA(At, 0, 1); PG8_STAGE(PG8_SA(0, 0), a2, voffA);
            PG8_BAR; PG8_WAIT_L(0); PG8_MMA(1, 0, At, B0); PG8_BAR; PG8_SCHED;
            PG8_STAGE(PG8_SB(0, 1), b2 + hstep, voffB);
            PG8_WAIT_V(6); PG8_BAR; PG8_MMA(1, 1, At, B1); PG8_BAR;
            PG8_LDB(B0, 1, 0); PG8_SCHED; PG8_LDA(At, 1, 0); PG8_STAGE(PG8_SA(0, 1), a2 + hstep, voffA);
            PG8_WAIT_L(8); PG8_BAR; PG8_WAIT_L(0); PG8_MMA(0, 0, At, B0); PG8_BAR; PG8_SCHED;
            PG8_LDB(B1, 1, 1); PG8_STAGE(PG8_SB(1, 0), b3, voffB);
            PG8_BAR; PG8_WAIT_L(0); PG8_MMA(0, 1, At, B1); PG8_BAR;
            PG8_LDA(At, 1, 1); PG8_STAGE(PG8_SA(1, 0), a3, voffA);
            PG8_BAR; PG8_WAIT_L(0); PG8_MMA(1, 0, At, B0); PG8_BAR; PG8_SCHED;
            PG8_STAGE(PG8_SB(1, 1), b3 + hstep, voffB);
            PG8_WAIT_V(6); PG8_BAR; PG8_MMA(1, 1, At, B1); PG8_BAR;
            }
        }
        if constexpr (ALIGN_EPI) { if (wr == 0) PG8_BAR; }
        if constexpr (FP8) {
#define PG8_ACC8(a, b) "+v"(acc[a][b][0][0]), "+v"(acc[a][b][0][1]), "+v"(acc[a][b][1][0]), "+v"(acc[a][b][1][1]), "+v"(acc[a][b][2][0]), "+v"(acc[a][b][2][1]), "+v"(acc[a][b][3][0]), "+v"(acc[a][b][3][1])
            asm volatile("s_nop 15\n\ts_nop 15" : PG8_ACC8(0, 0), PG8_ACC8(0, 1) :: "memory");
            asm volatile("" : PG8_ACC8(1, 0), PG8_ACC8(1, 1) :: "memory");
#undef PG8_ACC8
        }
#ifdef MK_EPI2
        if constexpr (Epi::TAG == MK_EPI2) { E(acc, cur, wr, wc, fr, fq, blds + ((ui & 1) << 10)); asm volatile("" ::: "memory"); }
#endif
        if constexpr (!Epi::AFTER_DRAIN) { E(acc, cur, wr, wc, fr, fq, blds + ((ui & 1) << 10)); S.done(cur); }
        if (!has_next) break;
#pragma unroll
        for (int a = 0; a < 2; ++a)
#pragma unroll
            for (int b = 0; b < 2; ++b)
#pragma unroll
                for (int m = 0; m < 4; ++m)
#pragma unroll
                    for (int n = 0; n < 2; ++n) acc[a][b][m][n] = (f32x4){0.f, 0.f, 0.f, 0.f};
        cur = nxt; cA = nA; cB = nB; ++ui;
        if constexpr (ALIGN_EPI) { if (wr == 1) PG8_BAR; }
    }
    PG8_WAIT_V(0);
    if constexpr (!ALIGN_EPI) { if (wr == 0) PG8_BAR; }
    PG8_BAR;
    if constexpr (Epi::AFTER_DRAIN) { E.fused(acc, cur, wr, wc, fr, fq, lds, wid, lane); S.done(cur); }
#undef PG8_SA
#undef PG8_SB
#undef PG8_STAGE
#undef PG8_LDA
#undef PG8_LDB
#undef PG8_MMA
#undef PG8_WAIT_V
#undef PG8_WAIT_L
#undef PG8_BAR
#undef PG8_SCHED
}

}

#define XB_TMO      128
#define XB_XCNT(j)  (256  + 64 * (j))
#define XB_XSUB(j)  (1280 + 64 * (j))
#define XB_XGEN(j)  (2304 + 64 * (j))
#define XB_TOP      3328
#define XB_TOPGEN   3392
#define XCD_BAR_WORDS 3456
#define XB_SPIN_CAP (1u << 18)
__device__ __forceinline__ unsigned xb_ld(unsigned* p)              { return __hip_atomic_load(p, __ATOMIC_RELAXED, __HIP_MEMORY_SCOPE_AGENT); }
__device__ __forceinline__ unsigned xb_add(unsigned* p, unsigned v) { return __hip_atomic_fetch_add(p, v, __ATOMIC_RELAXED, __HIP_MEMORY_SCOPE_AGENT); }
__device__ __forceinline__ unsigned xb_xcc_id() { return (unsigned)__builtin_amdgcn_s_getreg((3 << 11) | 20) & 0xFu; }
#define XB_SPIN(cond, bar) do { unsigned _sp = 0; while (cond) { __builtin_amdgcn_s_sleep(1); \
    if ((++_sp & 255u) == 0u) { if (xb_ld(&(bar)[XB_TMO])) break; if (_sp > XB_SPIN_CAP) { atomicAdd(&(bar)[XB_TMO], 1u); break; } } } } while (0)
struct XcdBarrier { unsigned* bar; unsigned x; volatile LAS unsigned* st; };
__device__ __forceinline__ XcdBarrier xcd_barrier_post(unsigned* bar, volatile LAS unsigned* st) {
    XcdBarrier b; b.bar = bar; b.x = xb_xcc_id(); b.st = st;
    if (threadIdx.x == 0) (void)xb_add(&bar[XB_XCNT(b.x)], 1u);
    return b;
}
__device__ __forceinline__ void xcd_barrier_complete(unsigned* bar, unsigned x, unsigned& nloc, unsigned& nx) {
    const unsigned G = gridDim.x * gridDim.y * gridDim.z;
    unsigned sum, cnt, mine, sp = 0u;
    for (;;) {
        sum = 0u; cnt = 0u; mine = 0u;
#pragma unroll
        for (unsigned j = 0; j < 16; ++j) { const unsigned c = xb_ld(&bar[XB_XCNT(j)]); sum += c; cnt += (c > 0u) ? 1u : 0u; mine = (j == x) ? c : mine; }
        if (sum == G) break;
        __builtin_amdgcn_s_sleep(1);
        if ((++sp & 255u) == 0u) { if (xb_ld(&bar[XB_TMO])) break; if (sp > XB_SPIN_CAP) { atomicAdd(&bar[XB_TMO], 1u); break; } }
    }
    nloc = mine > 0u ? mine : 1u; nx = cnt > 0u ? cnt : 1u;
}
__device__ __forceinline__ void xcd_barrier(const XcdBarrier& b) {
    asm volatile("s_waitcnt vmcnt(0)" ::: "memory");
    __syncthreads();
    if (threadIdx.x == 0) {
        unsigned* bar = b.bar;
        __builtin_amdgcn_s_waitcnt(0);
        unsigned nloc = b.st[0], nx = b.st[1];
        if (nloc == 0u) { xcd_barrier_complete(bar, b.x, nloc, nx); b.st[0] = nloc; b.st[1] = nx; }
        const unsigned old = xb_add(&bar[XB_XSUB(b.x)], 1u);
        const unsigned gen = old / nloc;
        if (old + 1u == (gen + 1u) * nloc) {
            __builtin_amdgcn_fence(__ATOMIC_RELEASE, "agent");
            asm volatile("s_waitcnt vmcnt(0)" ::: "memory");
            const unsigned og = xb_add(&bar[XB_TOP], 1u);
            const unsigned tg = og / nx;
            if (og + 1u == (tg + 1u) * nx) xb_add(&bar[XB_TOPGEN], 1u);
            else XB_SPIN(xb_ld(&bar[XB_TOPGEN]) == tg, bar);
            __builtin_amdgcn_fence(__ATOMIC_ACQUIRE, "agent");
            xb_add(&bar[XB_XGEN(b.x)], 1u);
            asm volatile("s_waitcnt vmcnt(0)" ::: "memory");
        } else {
            XB_SPIN(xb_ld(&bar[XB_XGEN(b.x)]) == gen, bar);
            __builtin_amdgcn_fence(__ATOMIC_ACQUIRE, "agent");
            asm volatile("s_waitcnt vmcnt(0)" ::: "memory");
        }
    }
    __syncthreads();
}

constexpr int NWAVES = 8;
constexpr int RING_OFF = 0, RING_BYTES = 131072;
constexpr int LDSCTL_OFF = RING_BYTES, MISC_OFF = LDSCTL_OFF + 320;
constexpr int TBL_OFF = LDSCTL_OFF + 1024;
constexpr int LDS_BYTES = 147456;

struct Frame {
    LAS unsigned char* lds; volatile LAS unsigned* MISC; LAS int* tbl; gu32* ctl;
    int tid, lane, wave, vcu, G;
};

__device__ __forceinline__ void p0_transpose_item(const float* W, int K, int N, bf16* WT, int k0, int n0, int orow0, LAS float* scr, int lane) {
#pragma unroll 8
    for (int i = 0; i < 32; ++i) { const int kk = 2 * i + (lane >> 5); scr[kk * 33 + (lane & 31)] = W[(size_t)(k0 + kk) * N + n0 + (lane & 31)]; }
    LDS_WAIT(); asm volatile("" ::: "memory");
    const int c = lane & 7;
#pragma unroll
    for (int j = 0; j < 4; ++j) { const int n = (lane >> 3) + 8 * j; const LAS float* s = scr + (8 * c) * 33 + n;
        u32x4 o; o.x = pk2(s[0 * 33], s[1 * 33]); o.y = pk2(s[2 * 33], s[3 * 33]); o.z = pk2(s[4 * 33], s[5 * 33]); o.w = pk2(s[6 * 33], s[7 * 33]);
        *(GAS u32x4*)(WT + (size_t)(orow0 + n) * K + k0 + 8 * c) = o; }
    LDS_WAIT(); asm volatile("" ::: "memory");
}
__device__ __forceinline__ void p0_transpose_item_fp8(const float* W, int K, int N, unsigned char* WT, int k0, int n0, int orow0, LAS float* scr, int lane) {
#pragma unroll 8
    for (int i = 0; i < 32; ++i) { const int kk = 2 * i + (lane >> 5); scr[kk * 33 + (lane & 31)] = W[(size_t)(k0 + kk) * N + n0 + (lane & 31)]; }
    LDS_WAIT(); asm volatile("" ::: "memory");
    const int c = lane & 7;
#pragma unroll
    for (int j = 0; j < 4; ++j) { const int n = (lane >> 3) + 8 * j; const LAS float* sp = scr + (8 * c) * 33 + n;
        u32x2 o; o.x = pk4_fp8(sp[0 * 33] * 32.f, sp[1 * 33] * 32.f, sp[2 * 33] * 32.f, sp[3 * 33] * 32.f); o.y = pk4_fp8(sp[4 * 33] * 32.f, sp[5 * 33] * 32.f, sp[6 * 33] * 32.f, sp[7 * 33] * 32.f);
        *(GAS u32x2*)(WT + (size_t)(orow0 + n) * K + k0 + 8 * c) = o; }
    LDS_WAIT(); asm volatile("" ::: "memory");
}
__device__ __forceinline__ void rms_row_to_bf16(const float* xrow, const float* g, bf16* orow, int lane) {
    const GAS f32x4* xr = (const GAS f32x4*)xrow + lane; f32x4 v[4]; float s = 0.f;
#pragma unroll
    for (int j = 0; j < 4; ++j) { v[j] = xr[64 * j]; s += (v[j].x * v[j].x + v[j].y * v[j].y) + (v[j].z * v[j].z + v[j].w * v[j].w); }
    const float rstd = 1.f / sqrtf(wave_sum(s) * (1.f / D) + EPS);
    GAS unsigned long long* o8 = (GAS unsigned long long*)orow + lane;
#pragma unroll
    for (int j = 0; j < 4; ++j) { const f32x4 gg = ((const GAS f32x4*)g)[lane + 64 * j];
        o8[64 * j] = (unsigned long long)pk2(v[j].x * rstd * gg.x, v[j].y * rstd * gg.y) | ((unsigned long long)pk2(v[j].z * rstd * gg.z, v[j].w * rstd * gg.w) << 32); }
}

__device__ __forceinline__ void rms_row_to_fp8(const float* xrow, const float* g, unsigned char* orow, unsigned char* orow4, unsigned char* orow16, int lane) {
    const GAS f32x4* xr = (const GAS f32x4*)xrow + lane; f32x4 v[4]; float s = 0.f;
#pragma unroll
    for (int j = 0; j < 4; ++j) { v[j] = xr[64 * j]; s += (v[j].x * v[j].x + v[j].y * v[j].y) + (v[j].z * v[j].z + v[j].w * v[j].w); }
    const float rstd = 1.f / sqrtf(wave_sum(s) * (1.f / D) + EPS);
    GAS unsigned* o4 = (GAS unsigned*)orow + lane; GAS unsigned* p4 = (GAS unsigned*)orow4 + lane; GAS unsigned* p16 = (GAS unsigned*)orow16 + lane;
#pragma unroll
    for (int j = 0; j < 4; ++j) { const f32x4 gg = ((const GAS f32x4*)g)[lane + 64 * j]; const unsigned w = pk4_fp8(v[j].x * rstd * gg.x, v[j].y * rstd * gg.y, v[j].z * rstd * gg.z, v[j].w * rstd * gg.w);
        o4[64 * j] = w; p4[64 * j] = w; p16[64 * j] = w; }
}
constexpr float LOG2E = 1.4426950408889634f;
typedef __bf16 bf16x2_t __attribute__((ext_vector_type(2)));
__device__ __forceinline__ unsigned cvtpk_v(float lo, float hi) { const f32x2 v = {lo, hi}; const bf16x2_t b = __builtin_convertvector(v, bf16x2_t); return __builtin_bit_cast(unsigned, b); }
typedef long longx2 __attribute__((ext_vector_type(2)));
struct AttFrags { longx2 k0, k1; bf16x8 v[4]; };
__device__ __forceinline__ float gmax4(float m) {
    { auto rr = __builtin_amdgcn_permlane16_swap(__float_as_uint(m), __float_as_uint(m), false, false); m = fmaxf(__uint_as_float(rr[0]), __uint_as_float(rr[1])); }
    { auto rr = __builtin_amdgcn_permlane32_swap(__float_as_uint(m), __float_as_uint(m), false, false); m = fmaxf(__uint_as_float(rr[0]), __uint_as_float(rr[1])); }
    return m;
}
constexpr int RB_A = 160, RB_B = 320;
template <int NH, int RB>
__device__ __forceinline__ void band_group(f32x4 (&o)[NH][4], float (&mrun)[NH], float (&lrun)[NH], const unsigned char* qkvb, const int (&qcol)[NH], const int (&qmu0)[NH], const unsigned char* kh, const bf16* vt,
                                           int dil, int rho, int L, int qstep, int P0, int npairs, const LAS float* const (&tab)[NH], int lane) {
    const int t = lane & 15, g = lane >> 4;
    longx2 qf[NH]; int mu_t[NH];
#pragma unroll
    for (int h = 0; h < NH; ++h) { mu_t[h] = qmu0[h] + qstep * t; qf[h] = *(const longx2*)(qkvb + (size_t)(mu_t[h] * dil + rho) * NQKV + 16 * g + qcol[h]); }
    const int npr = L >> 5;
    const unsigned char* kbase = kh + ((size_t)rho * L) * 64 + 16 * g;
    const bf16* vtl = vt + (size_t)(rho * npr) * 2048 + t * 32 + 8 * g;
    auto load = [&](int P, AttFrags& f) {
        const int Pc = min(max(P, 0), npr - 1);
        const unsigned char* k0p = kbase + (size_t)(32 * Pc + t) * 64; const unsigned char* k1p = k0p + 16 * 64;
        f.k0 = *(const longx2*)k0p; f.k1 = *(const longx2*)k1p;
#pragma unroll
        for (int db = 0; db < 4; ++db) f.v[db] = *(const bf16x8*)(vtl + (size_t)Pc * 2048 + db * 512);
    };
    AttFrags cur; load(P0, cur);
    for (int pp = 0; pp < npairs; ++pp) {
        const int P = P0 + pp;
        AttFrags nxt; load(P0 + min(pp + 1, npairs - 1), nxt);
        if (P >= 0 && P < npr) {
            const int kap0 = 32 * P + 4 * g;
#pragma unroll
            for (int h = 0; h < NH; ++h) {
                const LAS float* tb_ = tab[h] + (kap0 - mu_t[h] + RB);
                f32x4 s0 = (f32x4){tb_[0], tb_[1], tb_[2], tb_[3]}, s1 = (f32x4){tb_[16], tb_[17], tb_[18], tb_[19]};
                s0 = __builtin_amdgcn_mfma_f32_16x16x32_fp8_fp8(cur.k0.x, qf[h].x, s0, 0, 0, 0); s0 = __builtin_amdgcn_mfma_f32_16x16x32_fp8_fp8(cur.k0.y, qf[h].y, s0, 0, 0, 0);
                s1 = __builtin_amdgcn_mfma_f32_16x16x32_fp8_fp8(cur.k1.x, qf[h].x, s1, 0, 0, 0); s1 = __builtin_amdgcn_mfma_f32_16x16x32_fp8_fp8(cur.k1.y, qf[h].y, s1, 0, 0, 0);
                float mx = fmaxf(fmaxf(fmaxf(s0[0], s0[1]), fmaxf(s0[2], s0[3])), fmaxf(fmaxf(s1[0], s1[1]), fmaxf(s1[2], s1[3])));
                mx = gmax4(mx);
                if (__any(mx > mrun[h])) { const float mn = fmaxf(mrun[h], mx), alpha = __builtin_amdgcn_exp2f(mrun[h] - mn); mrun[h] = mn; lrun[h] *= alpha;
#pragma unroll
                    for (int db = 0; db < 4; ++db) o[h][db] = o[h][db] * alpha; }
                const float mn = mrun[h]; float p[8], ps = 0.f;
#pragma unroll
                for (int j = 0; j < 8; ++j) { p[j] = __builtin_amdgcn_exp2f(((j < 4) ? s0[j & 3] : s1[j & 3]) - mn); ps += p[j]; }
                lrun[h] += ps;
                u32x4 pw; pw.x = cvtpk_v(p[0], p[1]); pw.y = cvtpk_v(p[2], p[3]); pw.z = cvtpk_v(p[4], p[5]); pw.w = cvtpk_v(p[6], p[7]);
                const bf16x8 pf = __builtin_bit_cast(bf16x8, pw);
#pragma unroll
                for (int db = 0; db < 4; ++db) o[h][db] = __builtin_amdgcn_mfma_f32_16x16x32_bf16(cur.v[db], pf, o[h][db], 0, 0, 0);
                if (NH > 2 && h + 1 < NH) __builtin_amdgcn_sched_barrier(0);
            }
        }
        cur = nxt;
    }
}
template <int NH>
__device__ __forceinline__ void band_store(const f32x4 (&o)[NH][4], const float (&lrun)[NH], unsigned char* const (&yrow)[NH], int lane) {
    const int g = lane >> 4;
#pragma unroll
    for (int h = 0; h < NH; ++h) { float l = lrun[h]; l += __shfl_xor(l, 16); l += __shfl_xor(l, 32); const float inv = 1.f / l;
#pragma unroll
        for (int db = 0; db < 4; ++db) *(unsigned*)(yrow[h] + 16 * db + 4 * g) = pk4_fp8(o[h][db][0] * inv, o[h][db][1] * inv, o[h][db][2] * inv, o[h][db][3] * inv); }
}

struct Args { const float* in[19]; float* out; unsigned char* ws; int ph_lo, ph_hi, li, pad; };
constexpr int NPHASE = 10;

__global__ void __launch_bounds__(NWAVES * 64, 2) mk_fwd(Args args) {
    extern __shared__ __attribute__((aligned(16))) unsigned char lds[];
    Frame F;
    F.lds = (LAS unsigned char*)lds; F.MISC = (volatile LAS unsigned*)(F.lds + MISC_OFF); F.tbl = (LAS int*)(F.lds + TBL_OFF);
    F.tid = threadIdx.x; F.lane = F.tid & 63; F.wave = __builtin_amdgcn_readfirstlane(F.tid >> 6);
    F.G = gridDim.x; { const int bx = blockIdx.x; F.vcu = (F.G % 8 == 0) ? (bx % 8) * (F.G / 8) + bx / 8 : bx; }
    unsigned char* ws = args.ws; F.ctl = (gu32*)(ws + WS_CTL);
    const float* x = args.in[0]; const float* norm_mix = args.in[1]; const float* w_in = args.in[2]; const float* b_in = args.in[3];
    const float* sinks = args.in[4]; const float* rel_bias = args.in[5]; const float* w_a = args.in[6]; const float* w_b = args.in[7];
    const float* w_out = args.in[8]; const float* norm_ffn = args.in[9]; const float* router_w = args.in[10]; const float* router_b = args.in[11];
    const float* w_gate = args.in[12]; const float* b_gate = args.in[13]; const float* w_up = args.in[14]; const float* b_up = args.in[15];
    const float* w_down = args.in[16]; const float* b_down = args.in[17]; const float* norm_final = args.in[18];
    float* out = args.out;
    Tabs* tb = (Tabs*)(ws + WS_TAB);
    bf16* Win_t = (bf16*)(ws + WS_WIN); bf16* Wa_t = (bf16*)(ws + WS_WA); bf16* Wb_t = (bf16*)(ws + WS_WB); bf16* Wout_t = (bf16*)(ws + WS_WOUT);
    unsigned char* Wgu8 = ws + WS_WGU; unsigned char* Wd8 = ws + WS_WD; unsigned char* H28 = ws + WS_H2; unsigned char* HS8 = ws + WS_HS; unsigned char* ACT8 = ws + WS_ACT; unsigned char* YS = ws + WS_YS;
    int* topi = (int*)(ws + WS_RT); float* topp = (float*)(ws + WS_RT + 256 * 1024); int* slot = (int*)(ws + WS_RT + 512 * 1024); int* pos = (int*)(ws + WS_RT + 768 * 1024);
    bf16* XN = (bf16*)(ws + WS_XN); bf16* QKV = (bf16*)(ws + WS_QKV); bf16* GATES = (bf16*)(ws + WS_GATES); bf16* YA = (bf16*)(ws + WS_YA); bf16* YB = (bf16*)(ws + WS_YB);
    bf16* MERGED = (bf16*)(ws + WS_MERGED);
    gu32* cnt = F.ctl + CW_CNT;

    for (int u = F.tid; u < (LDS_BYTES - LDSCTL_OFF) / 4; u += NWAVES * 64) ((LAS unsigned*)(F.lds + LDSCTL_OFF))[u] = 0u;
    __syncthreads();
    XcdBarrier bar = xcd_barrier_post((unsigned*)(F.ctl + CW_BAR) + args.li * XCD_BAR_WORDS, F.MISC + 8);
    const int lo = args.ph_lo, hi = args.ph_hi;
#ifndef MK_SKIP
#define MK_SKIP 0
#endif
#define IN(k) (!((MK_SKIP >> (k)) & 1) && lo <= (k) && (k) < hi)
#ifndef MK_DUP
#define MK_DUP 0
#endif
#define REP(k) _Pragma("unroll") for (int rep_ = 0; rep_ < 1 + ((MK_DUP >> (k)) & 1); ++rep_)
#ifdef MK_TSTAMP
    unsigned long long ts_a = __builtin_amdgcn_s_memrealtime(), ts_b = ts_a;
#define SEAM(k) do { if (IN(k) && IN((k) + 1)) xcd_barrier(bar); if ((k) + 1 == MK_TSTAMP) ts_a = __builtin_amdgcn_s_memrealtime(); if ((k) == MK_TSTAMP) ts_b = __builtin_amdgcn_s_memrealtime(); } while (0)
#else
#define SEAM(k) do { if (IN(k) && IN((k) + 1)) xcd_barrier(bar); } while (0)
#endif
    const int gw = F.vcu * NWAVES + F.wave, NGW = F.G * NWAVES;

    LAS float* scr = (LAS float*)(F.lds + RING_OFF + F.wave * 16384);
    constexpr int I_IN = (D / 64) * (NPROJ / 32), I_A = (D / 64) * (D / 32), I_B = (256 / 64) * (D / 32), I_E = (D / 64) * (D / 32);
    constexpr int NITEMS = I_IN + 2 * I_A + I_B + 3 * NE * I_E;
    auto transpose_items = [&](int first, int last) {
    for (int it = first + gw; it < last; it += NGW) {
        int r = it;
        if (r < I_IN) { const int nb = NPROJ / 32; p0_transpose_item_fp8(w_in, D, NPROJ, (unsigned char*)Win_t, 64 * (r / nb), 32 * (r % nb), 32 * (r % nb), scr, F.lane); continue; } r -= I_IN;
        if (r < I_A) { const int nb = D / 32; p0_transpose_item_fp8(w_a, D, D, (unsigned char*)Wa_t, 64 * (r / nb), 32 * (r % nb), 32 * (r % nb), scr, F.lane); continue; } r -= I_A;
        if (r < I_A) { const int nb = D / 32; p0_transpose_item_fp8(w_out, D, D, (unsigned char*)Wout_t, 64 * (r / nb), 32 * (r % nb), 32 * (r % nb), scr, F.lane); continue; } r -= I_A;
        if (r < I_B) { const int nb = D / 32; p0_transpose_item_fp8(w_b, 256, D, (unsigned char*)Wb_t, 64 * (r / nb), 32 * (r % nb), 32 * (r % nb), scr, F.lane); continue; } r -= I_B;
        { const int e = r / (3 * I_E), q = r % (3 * I_E), which = q / I_E, ii = q % I_E, nb = D / 32, k0 = 64 * (ii / nb), n0 = 32 * (ii % nb);
          if (which == 0) p0_transpose_item_fp8(w_gate + (size_t)e * D * D, D, D, Wgu8, k0, n0, e * 2048 + (n0 >> 7) * 256 + (n0 & 127), scr, F.lane);
          else if (which == 1) p0_transpose_item_fp8(w_up + (size_t)e * D * D, D, D, Wgu8, k0, n0, e * 2048 + (n0 >> 7) * 256 + 128 + (n0 & 127), scr, F.lane);
          else p0_transpose_item_fp8(w_down + (size_t)e * D * D, D, D, Wd8, k0, n0, e * 1024 + n0, scr, F.lane); }
    }
    };
    if (IN(0)) REP(0) {
        { const int i = blockIdx.x * (NWAVES * 64) + F.tid;
          if (i < 16 * 257) { const int h = i / 257, r = i % 257; tb->biasA[h][r] = rel_bias[BKT_A[r] * 28 + h]; }
          if (i < 12 * 129) { const int g = i / (4 * 129), hs = (i / 129) % 4, r = i % 129; tb->biasB[g][hs][r] = rel_bias[BKT_B[g][r] * 28 + 16 + 4 * g + hs]; } }
        transpose_items(0, I_IN + 2 * I_A + I_B);
        for (int m = gw; m < T; m += NGW) { const int t0 = m & ~255, tl = m & 255;
            rms_row_to_fp8(x + (size_t)m * D, norm_mix, (unsigned char*)XN + (size_t)m * D, ws + WS_XNP + (size_t)(t0 + (tl & 3) * 64 + (tl >> 2)) * D,
                           ws + WS_XNP + (size_t)(T + t0 + (tl & 15) * 16 + (tl >> 4)) * D, F.lane); }
    }
    SEAM(0);
    if (IN(1)) REP(1) {
        int k512 = D / 2; asm volatile("" : "+s"(k512));
        pg8::Gemm g{XN, Win_t, k512}; pg8::ProjOrder So; So.so.init(T, NPROJ, F.G, (int)blockIdx.x);
        pg8::EpiProj E{QKV, GATES, b_in, (bf16*)(ws + WS_VT), (bf16*)(ws + WS_VT) + (size_t)2 * 4 * 64 * 8192, ws + WS_K2};
        pg8::gemm_phase<pg8::EpiProj, pg8::ProjOrder, true, true, true>(F.lds + RING_OFF, g, So, E);
    }
    SEAM(1);
    int nrep2 = 1 + ((MK_DUP >> 2) & 1); asm volatile("" : "+s"(nrep2));
    if (IN(2)) for (int rep_ = 0; rep_ < nrep2; ++rep_) {
        LAS float* lb = (LAS float*)(F.lds + RING_OFF);
        constexpr int TA = 2 * RB_A + 1, TB = 2 * RB_B + 1;
        for (int i = F.tid; i < 16 * TA; i += NWAVES * 64) { const int h = i / TA, rel = i % TA - RB_A; lb[i] = (rel >= -128 && rel <= 128) ? tb->biasA[h][rel + 128] * LOG2E : -3.0e38f; }
        for (int i = F.tid; i < 12 * TB; i += NWAVES * 64) { const int gh = i / TB, rel = i % TB - RB_B; lb[16 * TA + i] = (rel >= -64 && rel <= 64) ? tb->biasB[gh >> 2][gh & 3][rel + 64] * LOG2E : -3.0e38f; }
        __syncthreads();
        const bf16* VTA = (const bf16*)(ws + WS_VT); const bf16* VTB = VTA + (size_t)2 * 4 * 64 * 8192; const unsigned char* K2 = ws + WS_K2;
        for (int it = gw; it < 4096 + 2048; it += NGW) {
            const int t = F.lane & 15;
            if (it < 4096) {
                const int b = it >> 11, kvh = (it >> 9) & 3, qb = it & 511;
                f32x4 o[4][4]; float mr[4], lr[4];
#pragma unroll
                for (int h = 0; h < 4; ++h) { mr[h] = sinks[kvh * 4 + h] * LOG2E; lr[h] = (F.lane < 16) ? 1.f : 0.f;
#pragma unroll
                    for (int db = 0; db < 4; ++db) o[h][db] = (f32x4){0.f, 0.f, 0.f, 0.f}; }
                const int qcol[4] = {C_QA + (kvh * 4 + 0) * 64, C_QA + (kvh * 4 + 1) * 64, C_QA + (kvh * 4 + 2) * 64, C_QA + (kvh * 4 + 3) * 64};
                const int qmu[4] = {16 * qb, 16 * qb, 16 * qb, 16 * qb};
                const LAS float* const bias[4] = {lb + (kvh * 4 + 0) * TA, lb + (kvh * 4 + 1) * TA, lb + (kvh * 4 + 2) * TA, lb + (kvh * 4 + 3) * TA};
                band_group<4, RB_A>(o, mr, lr, (const unsigned char*)QKV + (size_t)b * S * NQKV, qcol, qmu, K2 + (size_t)((b * 4 + kvh) * 8192) * 64, VTA + (size_t)((b * 4 + kvh) * 64) * 8192, 1, 0, S, 1, (qb - 8) >> 1, 9, bias, F.lane);
                unsigned char* yr = (unsigned char*)YA + (size_t)(b * S + 16 * qb + t) * D + kvh * 256; unsigned char* const yrow[4] = {yr, yr + 64, yr + 128, yr + 192};
                band_store<4>(o, lr, yrow, F.lane);
            } else {
                const int j = it - 4096, r = j & 7, un = j >> 3, blk = un & 31, hs = (un >> 5) & 3, b = un >> 7, i0 = blk * 256;
                f32x4 o[2][4]; float mr[2], lr[2];
#pragma unroll
                for (int h = 0; h < 2; ++h) { mr[h] = -1.0e30f; lr[h] = 0.f;
#pragma unroll
                    for (int db = 0; db < 4; ++db) o[h][db] = (f32x4){0.f, 0.f, 0.f, 0.f}; }
                const unsigned char* qb_ = (const unsigned char*)QKV + (size_t)b * S * NQKV;
                { const int qcol[2] = {C_QB + 0 * 256 + hs * 64, C_QB + 0 * 256 + hs * 64}; const int qmu[2] = {i0 + r, i0 + r + 8}; const LAS float* const bias[2] = {lb + 16 * TA + (0 * 4 + hs) * TB, lb + 16 * TA + (0 * 4 + hs) * TB};
                  band_group<2, RB_B>(o, mr, lr, qb_, qcol, qmu, K2 + (size_t)((((0 + 1) * 2 + b) * 4 + hs) * 8192) * 64, VTB + (size_t)(((0 * 2 + b) * 4 + hs) * 64) * 8192, 1, 0, S, 16, (i0 >> 5) - 2, 12, bias, F.lane); }
                { const int qcol[2] = {C_QB + 1 * 256 + hs * 64, C_QB + 1 * 256 + hs * 64}; const int qmu[2] = {(i0 + r) >> 2, (i0 + r + 8) >> 2}; const LAS float* const bias[2] = {lb + 16 * TA + (1 * 4 + hs) * TB, lb + 16 * TA + (1 * 4 + hs) * TB};
                  band_group<2, RB_B>(o, mr, lr, qb_, qcol, qmu, K2 + (size_t)((((1 + 1) * 2 + b) * 4 + hs) * 8192) * 64, VTB + (size_t)(((1 * 2 + b) * 4 + hs) * 64) * 8192, 4, r & 3, S / 4, 4, (i0 >> 7) - 2, 6, bias, F.lane); }
#pragma unroll
                for (int h = 0; h < 2; ++h) { const int qcol[1] = {C_QB + 2 * 256 + hs * 64}; const int qmu[1] = {i0 >> 4}; const LAS float* const bias[1] = {lb + 16 * TA + (2 * 4 + hs) * TB};
                  band_group<1, RB_B>(*(f32x4(*)[1][4])&o[h], *(float(*)[1])&mr[h], *(float(*)[1])&lr[h], qb_, qcol, qmu, K2 + (size_t)((((2 + 1) * 2 + b) * 4 + hs) * 8192) * 64, VTB + (size_t)(((2 * 2 + b) * 4 + hs) * 64) * 8192,
                                    16, r + 8 * h, S / 16, 1, (blk - 4) >> 1, 5, bias, F.lane); }
                unsigned char* yr = (unsigned char*)YB + (size_t)(b * S + i0 + r + 16 * t) * 256 + hs * 64; unsigned char* const yrow[2] = {yr, yr + 8 * 256};
                band_store<2>(o, lr, yrow, F.lane);
            }
        }
        __syncthreads();
    }
    SEAM(2);
    if (IN(3)) REP(3) {
#ifndef NO_P3A
        { int k256 = 128; asm volatile("" : "+s"(k256)); pg8::Gemm g{YB, Wb_t, k256};   pg8::StaticOrder So; So.init(T, D, F.G, (int)blockIdx.x);
          pg8::EpiGate<0> E{MERGED, GATES, 1024, nullptr};
          pg8::gemm_phase<pg8::EpiGate<0>, pg8::StaticOrder, true, true, true>(F.lds + RING_OFF, g, So, E); }
#endif
        VM_WAIT(); __syncthreads();
#ifndef NO_P3B
        { int k512 = D / 2; asm volatile("" : "+s"(k512)); pg8::Gemm g{YA, Wa_t, k512}; pg8::StaticOrder So; So.init(T, D, F.G, (int)blockIdx.x);
          pg8::EpiGate<1> E{MERGED, GATES, 0, (unsigned char*)YA + (size_t)16 * MiB};
          pg8::gemm_phase<pg8::EpiGate<1>, pg8::StaticOrder, true, true, true>(F.lds + RING_OFF, g, So, E); }
#endif
    }
    SEAM(3);
    if (IN(4)) REP(4) {
        int k512 = D / 2; asm volatile("" : "+s"(k512)); pg8::Gemm g{(const bf16*)((unsigned char*)YA + (size_t)16 * MiB), Wout_t, k512}; pg8::StaticOrder So; So.init(T, D, F.G, (int)blockIdx.x);
        pg8::EpiX1 E{x, out};
        pg8::gemm_phase<pg8::EpiX1, pg8::StaticOrder, true, true, true>(F.lds + RING_OFF, g, So, E);
    }
    SEAM(4);
    if (IN(5)) REP(5) {
        const bool lastrep5 = (rep_ + 1 == 1 + ((MK_DUP >> 5) & 1));
        LAS int* lcnt = F.tbl + 72; LAS int* lbase = F.tbl + 104; LAS int* ebuf = F.tbl + 136; LAS int* pbuf = F.tbl + 392;
        LAS float* plog = (LAS float*)(F.lds + RING_OFF);
        LAS float* psq = plog + 8 * 64 * 32;
        LAS float* rstd_s = psq + 512;
        const int g = F.lane >> 4, e16 = F.lane & 15, w = F.wave;
        float wB[32][2];
#pragma unroll
        for (int sc = 0; sc < 32; ++sc) { const int k = 128 * w + 32 * (sc >> 3) + 8 * g + (sc & 7); const float gm = norm_ffn[k];
            wB[sc][0] = gm * router_w[(size_t)k * NE + e16]; wB[sc][1] = gm * router_w[(size_t)k * NE + 16 + e16]; }
        for (int tblk = F.vcu; tblk < T / 64; tblk += F.G) {
            if (F.tid < 32) lcnt[F.tid] = 0;
            f32x4 v[4][2];
            { const GAS float* xr = (const GAS float*)out + (size_t)(tblk * 64 + e16) * D + 128 * w + 8 * g;
#pragma unroll
              for (int s4 = 0; s4 < 4; ++s4) { v[s4][0] = *(const GAS f32x4*)(xr + 32 * s4); v[s4][1] = *(const GAS f32x4*)(xr + 32 * s4 + 4); } }
#pragma unroll 1
            for (int tile = 0; tile < 4; ++tile) {
                f32x4 vn[4][2];
                { const int tn = tile < 3 ? tile + 1 : 3; const GAS float* xr = (const GAS float*)out + (size_t)(tblk * 64 + tn * 16 + e16) * D + 128 * w + 8 * g;
#pragma unroll
                  for (int s4 = 0; s4 < 4; ++s4) { vn[s4][0] = *(const GAS f32x4*)(xr + 32 * s4); vn[s4][1] = *(const GAS f32x4*)(xr + 32 * s4 + 4); } }
                float sq = 0.f;
#pragma unroll
                for (int s4 = 0; s4 < 4; ++s4) sq += (v[s4][0].x * v[s4][0].x + v[s4][0].y * v[s4][0].y) + (v[s4][0].z * v[s4][0].z + v[s4][0].w * v[s4][0].w)
                                                   + (v[s4][1].x * v[s4][1].x + v[s4][1].y * v[s4][1].y) + (v[s4][1].z * v[s4][1].z + v[s4][1].w * v[s4][1].w);
                sq += __shfl_xor(sq, 16); sq += __shfl_xor(sq, 32);
                if (g == 0) psq[w * 64 + tile * 16 + e16] = sq;
                f32x4 a0 = (f32x4){0.f, 0.f, 0.f, 0.f}, a1 = (f32x4){0.f, 0.f, 0.f, 0.f};
#pragma unroll
                for (int s4 = 0; s4 < 4; ++s4)
#pragma unroll
                    for (int c = 0; c < 8; ++c) { const float av = v[s4][c >> 2][c & 3];
                        a0 = __builtin_amdgcn_mfma_f32_16x16x4f32(av, wB[s4 * 8 + c][0], a0, 0, 0, 0); a1 = __builtin_amdgcn_mfma_f32_16x16x4f32(av, wB[s4 * 8 + c][1], a1, 0, 0, 0); }
#pragma unroll
                for (int r = 0; r < 4; ++r) { LAS float* pr = plog + (size_t)(w * 64 + tile * 16 + 4 * g + r) * 32 + e16; pr[0] = a0[r]; pr[16] = a1[r]; }
#pragma unroll
                for (int s4 = 0; s4 < 4; ++s4) { v[s4][0] = vn[s4][0]; v[s4][1] = vn[s4][1]; }
            }
            __syncthreads();
            if (F.tid < 64) { float s = 0.f;
#pragma unroll
                for (int ww = 0; ww < 8; ++ww) s += psq[ww * 64 + F.tid];
                rstd_s[F.tid] = 1.f / sqrtf(s * (1.f / D) + EPS); }
            __syncthreads();
            { const int e = F.tid & 31; const float rbv = router_b[e];
#pragma unroll 1
              for (int i = 0; i < 4; ++i) { const int tl = (F.tid >> 5) + 16 * i; float lg = 0.f;
#pragma unroll
                for (int ww = 0; ww < 8; ++ww) lg += plog[(size_t)(ww * 64 + tl) * 32 + e];
                float val = lg * rstd_s[tl] + rbv; float tv[4]; int ti[4];
#pragma unroll
                for (int r = 0; r < 4; ++r) {
                    float bv = val; int bi = e;
#pragma unroll
                    for (int o = 1; o < 32; o <<= 1) { const float ov = __shfl_xor(bv, o); const int oi = __shfl_xor(bi, o); if (ov > bv || (ov == bv && oi < bi)) { bv = ov; bi = oi; } }
                    tv[r] = bv; ti[r] = bi; if (bi == e) val = -3.0e38f;
                }
                const float e1 = __expf(tv[1] - tv[0]), e2 = __expf(tv[2] - tv[0]), e3 = __expf(tv[3] - tv[0]); const float inv = 1.f / (1.f + e1 + e2 + e3);
                if (e < 4) { const float p = (e == 0 ? 1.f : e == 1 ? e1 : e == 2 ? e2 : e3) * inv; const int ex = (e == 0 ? ti[0] : e == 1 ? ti[1] : e == 2 ? ti[2] : ti[3]);
                    const int m = tblk * 64 + tl; topi[m * 4 + e] = ex; topp[m * 4 + e] = p;
                    const int li = tl * 4 + e; ebuf[li] = ex; pbuf[li] = __hip_atomic_fetch_add(&lcnt[ex], 1, __ATOMIC_RELAXED, __HIP_MEMORY_SCOPE_WORKGROUP); } } }
#pragma unroll 1
            for (int rb = 0; rb < 8; rb += 4) { f32x4 xv[4][4];
#pragma unroll
                for (int r = 0; r < 4; ++r) { const GAS f32x4* xr4 = (const GAS f32x4*)(out + ((size_t)tblk * 64 + w * 8 + rb + r) * D) + F.lane;
#pragma unroll
                    for (int j = 0; j < 4; ++j) xv[r][j] = xr4[64 * j]; }
#pragma unroll
                for (int r = 0; r < 4; ++r) { const int tl = w * 8 + rb + r; const float rstd = rstd_s[tl]; GAS unsigned* o4 = (GAS unsigned*)(H28 + ((size_t)tblk * 64 + tl) * D) + F.lane;
#pragma unroll
                    for (int j = 0; j < 4; ++j) { const f32x4 gg = ((const GAS f32x4*)norm_ffn)[F.lane + 64 * j];
                        o4[64 * j] = pk4_fp8(xv[r][j].x * rstd * gg.x, xv[r][j].y * rstd * gg.y, xv[r][j].z * rstd * gg.z, xv[r][j].w * rstd * gg.w); } } }
            __syncthreads();
            if (F.tid < 32) lbase[F.tid] = lastrep5 ? (int)__hip_atomic_fetch_add(cnt + F.tid, (unsigned)lcnt[F.tid], RLX_AGENT) : 0;
            __syncthreads();
            if (F.tid < 256) pos[tblk * 256 + F.tid] = lbase[ebuf[F.tid]] + pbuf[F.tid];
            __syncthreads();
        }
    }
    SEAM(5);
    if (IN(6) || IN(7) || IN(8)) {
        LAS int* loff = F.tbl; LAS int* ltoff = F.tbl + 36; LAS int* lc = F.tbl + 72;
        if (F.tid < 32) lc[F.tid] = (int)__hip_atomic_load(cnt + F.tid, RLX_AGENT);
        __syncthreads();
        if (F.tid == 0) { int a = 0, ta = 0; for (int e = 0; e < NE; ++e) { loff[e] = a; ltoff[e] = ta; const int c = lc[e]; a += c; ta += (c + 255) >> 8; } loff[NE] = a; ltoff[NE] = ta; }
        __syncthreads();
    }
    if (IN(6)) REP(6) {
        transpose_items(I_IN + 2 * I_A + I_B, NITEMS);
        const LAS int* loff = F.tbl;
        for (int p0 = gw; p0 < T * 4; p0 += 4 * NGW) {
            int row[4]; u32x4 dv[4];
#pragma unroll
            for (int q = 0; q < 4; ++q) { const int p = p0 + q * NGW; row[q] = (p < T * 4) ? loff[topi[p]] + pos[p] : -1; }
#pragma unroll
            for (int q = 0; q < 4; ++q) { const int p = p0 + q * NGW; if (row[q] >= 0) dv[q] = ((const GAS u32x4*)(H28 + (size_t)(p >> 2) * D))[F.lane]; }
#pragma unroll
            for (int q = 0; q < 4; ++q) { const int p = p0 + q * NGW; if (row[q] >= 0) { if (F.lane == 0) slot[p] = row[q]; ((GAS u32x4*)(HS8 + (size_t)row[q] * D))[F.lane] = dv[q]; } }
        }
    }
    SEAM(6);
    if (IN(7)) REP(7) {
        int k512 = D / 2; asm volatile("" : "+s"(k512));
        pg8::Gemm g{(const bf16*)HS8, (const bf16*)Wgu8, k512}; pg8::GroupOrder So{F.tbl + 36, F.tbl, 8, F.G, (int)blockIdx.x, 0}; So.nunits = __builtin_amdgcn_readfirstlane(F.tbl[36 + NE]) * 8;
        pg8::EpiSwiglu E{ACT8, b_gate, b_up};
        pg8::gemm_phase<pg8::EpiSwiglu, pg8::GroupOrder, true, FP8_SP2, true>(F.lds + RING_OFF, g, So, E);
    }
    SEAM(7);
    if (IN(8)) REP(8) {
        int k512 = D / 2; asm volatile("" : "+s"(k512));
        pg8::Gemm g{(const bf16*)ACT8, (const bf16*)Wd8, k512}; pg8::GroupOrder So{F.tbl + 36, F.tbl, 4, F.G, (int)blockIdx.x, 0}; So.nunits = __builtin_amdgcn_readfirstlane(F.tbl[36 + NE]) * 4;
        pg8::EpiDown E{YS, b_down};
        pg8::gemm_phase<pg8::EpiDown, pg8::GroupOrder, true, FP8_SP2, true>(F.lds + RING_OFF, g, So, E);
    }
    SEAM(8);
#ifdef MK_XBAR
    for (int xb_ = 0; xb_ < MK_XBAR; ++xb_) xcd_barrier(bar);
#endif
    if (IN(9)) REP(9) {
        const unsigned char* ys = YS;
        const int lane9 = (int)__builtin_amdgcn_mbcnt_hi(~0u, __builtin_amdgcn_mbcnt_lo(~0u, 0u));
        float* dst9 = (rep_ + 1 < 1 + ((MK_DUP >> 9) & 1)) ? (float*)(ws + WS_ACT) : out;
        for (int m0 = gw; m0 < T; m0 += 2 * NGW) {
            f32x4 v[2][4]; int sl[2][4]; float pr[2][4]; unsigned yv[2][4][4]; bool ok[2];
#pragma unroll
            for (int q = 0; q < 2; ++q) { const int m = m0 + q * NGW; ok[q] = m < T; const int mc = ok[q] ? m : m0; const GAS f32x4* xr = (const GAS f32x4*)(out + (size_t)mc * D) + lane9;
#pragma unroll
                for (int j = 0; j < 4; ++j) v[q][j] = xr[64 * j];
#pragma unroll
                for (int k = 0; k < 4; ++k) { sl[q][k] = slot[mc * 4 + k]; pr[q][k] = topp[mc * 4 + k]; } }
#pragma unroll
            for (int q = 0; q < 2; ++q)
#pragma unroll
                for (int k = 0; k < 4; ++k) { const GAS unsigned* yr = (const GAS unsigned*)(ys + (size_t)sl[q][k] * D) + lane9;
#pragma unroll
                    for (int j = 0; j < 4; ++j) yv[q][k][j] = yr[64 * j]; }
#pragma unroll
            for (int q = 0; q < 2; ++q) { if (!ok[q]) continue; const int m = m0 + q * NGW;
#pragma unroll
                for (int k = 0; k < 4; ++k) { const float p = pr[q][k];
#pragma unroll
                    for (int j = 0; j < 4; ++j) { const unsigned u = yv[q][k][j]; const f32x2 lo = __builtin_amdgcn_cvt_pk_f32_fp8(u, false), hi = __builtin_amdgcn_cvt_pk_f32_fp8(u, true);
                        v[q][j].x += p * lo.x; v[q][j].y += p * lo.y; v[q][j].z += p * hi.x; v[q][j].w += p * hi.y; } }
                float s = 0.f;
#pragma unroll
                for (int j = 0; j < 4; ++j) s += (v[q][j].x * v[q][j].x + v[q][j].y * v[q][j].y) + (v[q][j].z * v[q][j].z + v[q][j].w * v[q][j].w);
                const float rstd = 1.f / sqrtf(wave_sum(s) * (1.f / D) + EPS);
#pragma unroll
                for (int j = 0; j < 4; ++j) { const f32x4 gg = ((const GAS f32x4*)norm_final)[lane9 + 64 * j]; f32x4 y; y.x = v[q][j].x * rstd * gg.x; y.y = v[q][j].y * rstd * gg.y; y.z = v[q][j].z * rstd * gg.z; y.w = v[q][j].w * rstd * gg.w;
                    ((GAS f32x4*)(dst9 + (size_t)m * D) + lane9)[64 * j] = y; } }
        }
    }
#ifdef MK_TSTAMP
    if (MK_TSTAMP == 9) ts_b = __builtin_amdgcn_s_memrealtime();
    if (blockIdx.x == 0) { const unsigned long long dt = ts_b - ts_a, t0_ = __builtin_amdgcn_s_memrealtime();
        while (__builtin_amdgcn_s_memrealtime() - t0_ < 2 * dt) __builtin_amdgcn_s_sleep(8); }
#endif
#undef IN
#undef SEAM
}

extern "C" void kernel_launch(void* const* d_in, const int* in_sizes, int n_in, void* d_out, int out_size, void* d_ws, size_t ws_size, hipStream_t stream) {
    static int grid = 0;
    if (grid == 0) {
        if (n_in != 19 || in_sizes[0] != T * D || out_size != T * D || ws_size < WS_END) { fprintf(stderr, "kernel_launch: unexpected shapes (n_in %d, ws %zu); nothing launched\n", n_in, ws_size); grid = -1; return; }
        int dev = 0, cus = 0, per_cu = 0;
        if (hipGetDevice(&dev) != hipSuccess || hipDeviceGetAttribute(&cus, hipDeviceAttributeMultiprocessorCount, dev) != hipSuccess) { grid = -1; return; }
        if (hipFuncSetAttribute((const void*)mk_fwd, hipFuncAttributeMaxDynamicSharedMemorySize, LDS_BYTES) != hipSuccess) { fprintf(stderr, "kernel_launch: hipFuncSetAttribute failed\n"); grid = -1; return; }
        if (hipOccupancyMaxActiveBlocksPerMultiprocessor(&per_cu, (const void*)mk_fwd, NWAVES * 64, LDS_BYTES) != hipSuccess || per_cu < 1) { fprintf(stderr, "kernel_launch: occupancy query says %d blocks per CU\n", per_cu); }
        (void)hipGetLastError();
        grid = cus;
        if (grid != 256) fprintf(stderr, "kernel_launch: %d CUs (built and tuned for 256)\n", grid);
    }
    if (grid < 0) return;
    if (hipMemsetAsync((char*)d_ws + WS_CTL, 0, CTL_ZERO_BYTES, stream) != hipSuccess) return;
    Args a{};
    for (int i = 0; i < 19; ++i) a.in[i] = (const float*)d_in[i];
    a.out = (float*)d_out; a.ws = (unsigned char*)d_ws;
#if MK_MODE == 2
    a.ph_lo = 0; a.ph_hi = NPHASE; a.li = 0;
    hipLaunchKernelGGL(mk_fwd, dim3(grid), dim3(NWAVES * 64), LDS_BYTES, stream, a);
#else
    for (int ph = 0; ph < NPHASE; ++ph) { a.ph_lo = ph; a.ph_hi = ph + 1; a.li = ph; hipLaunchKernelGGL(mk_fwd, dim3(grid), dim3(NWAVES * 64), LDS_BYTES, stream, a); }
#endif
}
```

```cpp
#define MK_DUP 0
#include <hip/hip_runtime.h>
#include <stdint.h>
#include <stdio.h>

#ifndef FP8_SP2
#define FP8_SP2 true
#endif
#ifndef MK_MODE
#define MK_MODE 2
#endif

typedef unsigned short bf16;
typedef short bf16x8 __attribute__((ext_vector_type(8)));
typedef float f32x4 __attribute__((ext_vector_type(4)));
typedef float f32x2 __attribute__((ext_vector_type(2)));
typedef unsigned u32x4 __attribute__((ext_vector_type(4)));
typedef unsigned u32x2 __attribute__((ext_vector_type(2)));
#define GAS __attribute__((address_space(1)))
#define LAS __attribute__((address_space(3)))
typedef GAS unsigned gu32;

constexpr int T = 16384, S = 8192, D = 1024, NPROJ = 5888, NQKV = 3840, NGATE = 2048, NE = 32, TOPK = 4;
constexpr int C_QA = 0, C_KA = 1024, C_VA = 1280, C_QB = 1536, C_KB = 2304, C_VB = 3072;
constexpr float EPS = 1e-5f;
constexpr size_t MiB = 1u << 20;
constexpr size_t WS_CTL = 0, CTL_ZERO_BYTES = 1 * MiB;
constexpr size_t WS_TAB = 1 * MiB;
constexpr size_t WS_WIN = 2 * MiB;
constexpr size_t WS_WA = 14 * MiB;
constexpr size_t WS_WB = 16 * MiB;
constexpr size_t WS_WOUT = 17 * MiB;
constexpr size_t WS_RT = 19 * MiB;
constexpr size_t WS_RTC = 20 * MiB;
constexpr size_t WS_WGU = 24 * MiB;
constexpr size_t WS_WD = 88 * MiB;
constexpr size_t WS_H2 = 120 * MiB;
constexpr size_t WS_HS = 136 * MiB;
constexpr size_t WS_ACT = 201 * MiB;
constexpr size_t WS_YS = 272 * MiB;
constexpr size_t WS_XN = 216 * MiB;
constexpr size_t WS_XNP = 312 * MiB;
constexpr size_t WS_K2 = 344 * MiB;
constexpr size_t WS_QKV = 248 * MiB;
constexpr size_t WS_GATES = 368 * MiB;
constexpr size_t WS_YA = 432 * MiB;
constexpr size_t WS_YB = 464 * MiB;
constexpr size_t WS_MERGED = 472 * MiB;
constexpr size_t WS_VT = 472 * MiB;
constexpr size_t WS_END = 506 * MiB;
constexpr int CW_CNT = 0;
constexpr int CW_BAR = 4096;

__device__ const unsigned char BKT_A[257] = {12,12,12,12,12,12,12,12,12,12,12,12,12,12,12,12,12,12,12,12,12,12,12,12,12,12,12,12,12,12,12,12,12,12,12,12,12,12,11,11,11,11,11,11,11,11,11,11,11,11,11,11,11,11,11,11,11,11,11,11,11,11,11,11,11,11,11,11,11,11,11,11,11,11,11,11,11,11,11,10,10,10,10,10,10,10,10,10,10,10,10,10,10,10,10,10,10,10,10,10,10,10,9,9,9,9,9,9,9,9,9,9,9,9,8,8,8,8,8,8,8,7,6,5,4,3,2,1,0,17,18,19,20,21,22,23,24,24,24,24,24,24,24,25,25,25,25,25,25,25,25,25,25,25,25,26,26,26,26,26,26,26,26,26,26,26,26,26,26,26,26,26,26,26,26,26,26,26,27,27,27,27,27,27,27,27,27,27,27,27,27,27,27,27,27,27,27,27,27,27,27,27,27,27,27,27,27,27,27,27,27,27,27,27,27,27,27,27,27,28,28,28,28,28,28,28,28,28,28,28,28,28,28,28,28,28,28,28,28,28,28,28,28,28,28,28,28,28,28,28,28,28,28,28,28,28,28};
__device__ const unsigned char BKT_B[3][129] = {
 {11,11,11,11,11,11,11,11,11,11,11,11,11,11,11,10,10,10,10,10,10,10,10,10,10,10,10,10,10,10,10,10,10,10,10,10,10,10,9,9,9,9,9,9,9,9,9,9,9,9,8,8,8,8,8,8,8,7,6,5,4,3,2,1,0,17,18,19,20,21,22,23,24,24,24,24,24,24,24,25,25,25,25,25,25,25,25,25,25,25,25,26,26,26,26,26,26,26,26,26,26,26,26,26,26,26,26,26,26,26,26,26,26,26,27,27,27,27,27,27,27,27,27,27,27,27,27,27,27},
 {13,13,13,13,13,13,13,13,13,13,13,13,13,13,13,13,13,13,13,13,13,13,13,12,12,12,12,12,12,12,12,12,12,12,12,12,12,12,12,12,12,12,11,11,11,11,11,11,11,11,11,11,10,10,10,10,10,10,9,9,9,8,8,4,0,20,24,24,25,25,25,26,26,26,26,26,26,27,27,27,27,27,27,27,27,27,27,28,28,28,28,28,28,28,28,28,28,28,28,28,28,28,28,28,28,28,29,29,29,29,29,29,29,29,29,29,29,29,29,29,29,29,29,29,29,29,29,29,29},
 {15,15,15,15,15,15,15,15,15,15,15,15,15,15,15,15,15,15,15,15,15,15,15,15,15,15,15,15,15,15,14,14,14,14,14,14,14,14,14,14,14,14,14,14,14,13,13,13,13,13,13,13,13,13,12,12,12,12,12,11,11,10,10,9,0,25,26,26,27,27,28,28,28,28,28,29,29,29,29,29,29,29,29,29,30,30,30,30,30,30,30,30,30,30,30,30,30,30,30,31,31,31,31,31,31,31,31,31,31,31,31,31,31,31,31,31,31,31,31,31,31,31,31,31,31,31,31,31,31}};

#define RLX_AGENT __ATOMIC_RELAXED, __HIP_MEMORY_SCOPE_AGENT
#define LDS_WAIT() asm volatile("s_waitcnt lgkmcnt(0)" ::: "memory")
#define VM_WAIT() asm volatile("s_waitcnt vmcnt(0)" ::: "memory")
__device__ __forceinline__ unsigned f2bf(float f) { unsigned u = __builtin_bit_cast(unsigned, f); return (u + 0x7fffu + ((u >> 16) & 1u)) >> 16; }
__device__ __forceinline__ unsigned pk2(float lo, float hi) { return f2bf(lo) | (f2bf(hi) << 16); }
__device__ __forceinline__ unsigned pk4_fp8(float a, float b, float c, float d) { unsigned w = 0; w = __builtin_amdgcn_cvt_pk_fp8_f32(a, b, w, false); w = __builtin_amdgcn_cvt_pk_fp8_f32(c, d, w, true); return w; }
__device__ __forceinline__ float bf2f(unsigned b) { return __builtin_bit_cast(float, b << 16); }
__device__ __forceinline__ float bflo(unsigned u) { return __builtin_bit_cast(float, u << 16); }
__device__ __forceinline__ float bfhi(unsigned u) { return __builtin_bit_cast(float, u & 0xffff0000u); }
__device__ __forceinline__ float wave_sum(float v) {
#pragma unroll
    for (int o = 1; o < 64; o <<= 1) v += __shfl_xor(v, o);
    return v;
}
__device__ __forceinline__ float sigm(float x) { return __builtin_amdgcn_rcpf(1.f + __builtin_amdgcn_exp2f(-1.4426950408889634f * x)); }

struct Tabs { float biasA[16][257]; float biasB[3][4][129]; };

namespace pg8 {
#define PG8_LAS __attribute__((address_space(3)))
typedef unsigned short bf16_t;
constexpr int BM = 256, BK = 64, HALF = 128, HTB = HALF * BK * 2, STAGE_BYTES = 8 * HTB, NXCD = 8, WGM = 8;
__host__ __device__ __forceinline__ int lds_byte(int r, int c) { const int st = (r >> 4) * 2 + (c >> 5), rr = r & 15, cc = c & 31, ob = rr * 64 + cc * 2; return st * 1024 + (ob ^ (((ob >> 9) & 1) << 5)); }
__host__ __device__ __forceinline__ void stage_rc(int b, int& R, int& C) { const int st = b / 1024, sb = b % 1024, swz = sb ^ (((sb >> 9) & 1) << 5); R = (st >> 1) * 16 + swz / 64; C = (st & 1) * 32 + (swz % 64) / 2; }
__host__ __device__ __forceinline__ int perm32(int rho) { const int n = rho >> 4, i = rho & 15; return 8 * (i >> 2) + 4 * n + (i & 3); }

struct Unit { int arow, brow, nrows, e, swap, aidx; };
struct Gemm { const bf16_t* A; const bf16_t* Bt; int K; const int* gidx; };

struct StaticOrder {
    int nM, nN, nwg, G, c;
    __device__ void init(int M, int N, int G_, int c_) { nM = M / BM; nN = N / BM; nwg = nM * nN; G = G_; c = c_; }
    __device__ bool next(int i, Unit& u) const {
        const long L = (long)i * G + c; if (L >= nwg) return false;
        int wgid = (int)L; { const int q = nwg / NXCD, r = nwg % NXCD, xcd = wgid % NXCD, off = wgid / NXCD; wgid = (xcd < r ? xcd * (q + 1) : r * (q + 1) + (xcd - r) * q) + off; }
        const int nig = WGM * nN, gid = wgid / nig, fm = gid * WGM, gsz = (nM - fm) < WGM ? (nM - fm) : WGM;
        u.arow = BM * (fm + ((wgid % nig) % gsz)); u.brow = BM * ((wgid % nig) / gsz); u.nrows = BM; u.e = 0; u.swap = 0; u.aidx = 0; return true;
    }
    __device__ __forceinline__ void a_ready(const Unit&) const {}
    __device__ __forceinline__ void done(const Unit&) const {}
};
constexpr int XNP_ROW0 = (int)((WS_XNP - WS_XN) / D);
struct ProjOrder {
    StaticOrder so;
    __device__ bool next(int i, Unit& u) const { if (!so.next(i, u)) return false;
        if (u.brow == C_VA || (u.brow >= C_VB && u.brow < NQKV)) { const int a = u.arow; u.arow = u.brow; u.brow = a; u.swap = 1; u.e = a;
            if (u.arow == C_VB + 256) u.brow += XNP_ROW0; else if (u.arow == C_VB + 512) u.brow += XNP_ROW0 + T; } return true; }
    __device__ __forceinline__ void a_ready(const Unit&) const {}
    __device__ __forceinline__ void done(const Unit&) const {}
};
struct GroupOrder {
    const PG8_LAS int* toff; const PG8_LAS int* off; int NT, G, c, nunits, cap;
    __device__ bool next(int i, Unit& u) const {
        int L;
        if (G & 7) { L = i * G + c; }
        else { const int q = (nunits + 7) >> 3, j = i * (G >> 3) + (c >> 3); if (j >= q) return false; L = (c & 7) * q + j; }
        if (L >= nunits) return false;
        const int mtg = L / NT, pn = L - mtg * NT;
        int e = 0;
        for (int j = 1; j < NE; ++j) e += (toff[j] <= mtg) ? 1 : 0;
        e = __builtin_amdgcn_readfirstlane(e);
        const int mt = mtg - __builtin_amdgcn_readfirstlane(toff[e]); const int o0 = __builtin_amdgcn_readfirstlane(off[e]), o1 = __builtin_amdgcn_readfirstlane(off[e + 1]);
        u.arow = o0 + BM * mt; const int rem = o1 - u.arow; u.nrows = rem < BM ? rem : BM; u.brow = (e * NT + pn) * BM; u.e = e; u.swap = 0; u.aidx = e * cap + BM * mt; return true;
    }
    __device__ __forceinline__ void a_ready(const Unit&) const {}
    __device__ __forceinline__ void done(const Unit&) const {}
};

__device__ __forceinline__ void st16_wt(void* p, u32x4 v) { asm volatile("global_store_dwordx4 %0, %1, off sc1\n\ts_nop 2" :: "v"(p), "v"(v) : "memory"); }
__device__ __forceinline__ void st8_wt(void* p, u32x2 v) { asm volatile("global_store_dwordx2 %0, %1, off sc1\n\ts_nop 2" :: "v"(p), "v"(v) : "memory"); }
__device__ __forceinline__ unsigned cvt_pk_bf16(float lo, float hi) { unsigned r; asm volatile("v_cvt_pk_bf16_f32 %0, %1, %2" : "=v"(r) : "v"(lo), "v"(hi)); return r; }

struct EpiProj {
    static constexpr bool PERM = true, AFTER_DRAIN = false; static constexpr int TAG = 1;
    bf16_t* qkv; bf16_t* gates; const float* bias; bf16_t* vta; bf16_t* vtb; unsigned char* k2;
    __device__ __forceinline__ void prefetch(const Unit& u, PG8_LAS unsigned char* slot, int wid, int lane) const {
        if (wid == 0) { int l4 = 4 * lane; asm volatile("" : "+v"(l4));
            __builtin_amdgcn_global_load_lds((const unsigned*)(bias + (u.swap ? u.arow : u.brow) + l4), (PG8_LAS unsigned*)slot, 16, 0, 0); } }
    __device__ __forceinline__ void operator()(const f32x4 (&acc)[2][2][4][2], const Unit& u, int wr, int wc, int fr, int fq, const PG8_LAS unsigned char* slot) const {
        if (!u.swap) {
            const int colt = u.brow; const bool isq = colt < NQKV; unsigned char* base = isq ? (unsigned char*)qkv : (unsigned char*)gates; const int ldc = isq ? NQKV : NGATE; const int cb = isq ? colt : colt - NQKV;
            const int row0 = u.arow + wr * 64 + fr, col0 = cb + wc * 32 + 8 * fq;
            const PG8_LAS f32x4* bl = (const PG8_LAS f32x4*)(slot + (wc * 32 + 8 * fq) * 4);
            const float qs = (colt < C_KA || (colt >= C_QB && colt < C_KB)) ? 0.125f * 1.4426950408889634f : 1.f;
            const bool isk = (colt == C_KA) || (colt >= C_KB && colt < C_VB);
            if (!isk) {
#pragma unroll
            for (int ai = 0; ai < 2; ++ai)
#pragma unroll
                for (int m = 0; m < 4; ++m) { unsigned char* rowp = base + (size_t)(row0 + ai * HALF + m * 16) * ldc + col0;
#pragma unroll
                    for (int bj = 0; bj < 2; ++bj) { const f32x4 v0 = (acc[ai][bj][m][0] + bl[bj * 32]) * qs, v1 = (acc[ai][bj][m][1] + bl[bj * 32 + 1]) * qs;
                        u32x2 w; w.x = pk4_fp8(v0[0], v0[1], v0[2], v0[3]); w.y = pk4_fp8(v1[0], v1[1], v1[2], v1[3]); *(u32x2*)(rowp + bj * HALF) = w; }
                    asm volatile("" ::: "memory"); }
            } else {
                const int gsel = (colt == C_KA) ? -1 : ((colt - C_KB) >> 8); const int sh = (gsel <= 0) ? 0 : (gsel == 1 ? 2 : 4);
                unsigned char* kb = k2 + (size_t)(gsel + 1) * (2 * 4 * 8192 * 64);
                int c0 = wc * 32 + 8 * fq; asm volatile("" : "+v"(c0));
#pragma unroll
                for (int ai = 0; ai < 2; ++ai)
#pragma unroll
                    for (int m = 0; m < 4; ++m) { const int row = row0 + ai * HALF + m * 16, b = row >> 13, sq = row & 8191; const int pos = ((sq & ((1 << sh) - 1)) << (13 - sh)) + (sq >> sh);
#pragma unroll
                        for (int bj = 0; bj < 2; ++bj) { const int c = c0 + bj * HALF; const f32x4 v0 = acc[ai][bj][m][0] + bl[bj * 32], v1 = acc[ai][bj][m][1] + bl[bj * 32 + 1];
                            u32x2 w; w.x = pk4_fp8(v0[0], v0[1], v0[2], v0[3]); w.y = pk4_fp8(v1[0], v1[1], v1[2], v1[3]);
                            *(u32x2*)(kb + ((size_t)((b * 4 + (c >> 6)) * 8192 + pos)) * 64 + (c & 63)) = w; }
                        asm volatile("" ::: "memory"); }
            }
        } else {
            const int colt = u.arow, tok0 = u.e; const int gsel = (colt == C_VA) ? -1 : ((colt - C_VB) >> 8); const int sh = (gsel <= 0) ? 0 : (gsel == 1 ? 2 : 4);
            bf16_t* vb = ((gsel < 0) ? vta : vtb + (size_t)gsel * (2 * 256 * 8192)) + (size_t)((tok0 >> 13) * 256) * 8192;
            const int mub = (tok0 & 8191) >> sh;
#pragma unroll
            for (int ai = 0; ai < 2; ++ai)
#pragma unroll
                for (int m = 0; m < 4; ++m) { const int c = ai * HALF + wr * 64 + m * 16 + fr; const float bvr = *(const PG8_LAS float*)(slot + c * 4); bf16_t* vrow = vb + (size_t)(c >> 6) * (64 * 8192) + (c & 63) * 32;
#pragma unroll
                    for (int bj = 0; bj < 2; ++bj) { const int j0 = bj * HALF + wc * 32 + 8 * fq;
                        const int rho = j0 >> (8 - sh), mu = mub + (j0 & ((256 >> sh) - 1));
                        const int p0 = ((rho << (8 - sh)) + (mu >> 5)) * 2048 + (((mu & 15) >> 2) << 3) + (((mu >> 4) & 1) << 2);
                        const f32x4 v0 = acc[ai][bj][m][0] + bvr, v1 = acc[ai][bj][m][1] + bvr;
                        u32x2 w0, w1; w0.x = cvt_pk_bf16(v0[0], v0[1]); w0.y = cvt_pk_bf16(v0[2], v0[3]); w1.x = cvt_pk_bf16(v1[0], v1[1]); w1.y = cvt_pk_bf16(v1[2], v1[3]);
                        *(u32x2*)(vrow + p0) = w0; *(u32x2*)(vrow + p0 + 8) = w1; }
                    asm volatile("" ::: "memory"); }
        }
    }
};
template <int MODE> struct EpiGate {
    static constexpr bool PERM = true, AFTER_DRAIN = false; static constexpr int TAG = 3;
    bf16_t* out; const bf16_t* gates; int gcol0; unsigned char* out8;
    __device__ __forceinline__ void prefetch(const Unit&, PG8_LAS unsigned char*, int, int) const {}
    __device__ __forceinline__ void operator()(const f32x4 (&acc)[2][2][4][2], const Unit& u, int wr, int wc, int fr, int fq, const PG8_LAS unsigned char*) const {
        const int row0 = u.arow + wr * 64 + fr, col0 = u.brow + wc * 32 + 8 * fq;
        u32x2 gv[8][2];
#pragma unroll
        for (int gi = 0; gi < 4; ++gi) { const size_t r = (size_t)(row0 + (gi >> 2) * HALF + (gi & 3) * 16);
#pragma unroll
            for (int bj = 0; bj < 2; ++bj) gv[gi][bj] = *(const u32x2*)((const unsigned char*)gates + r * NGATE + gcol0 + col0 + bj * HALF); }
        u32x4 mv[2], mn[2];
        if (MODE == 1) {
#pragma unroll
            for (int bj = 0; bj < 2; ++bj) mv[bj] = *(const u32x4*)(out + (size_t)row0 * D + col0 + bj * HALF); }
#pragma unroll
        for (int gi = 0; gi < 8; ++gi) { const int ai = gi >> 2, m = gi & 3; const size_t r = (size_t)(row0 + ai * HALF + m * 16);
            if (gi == 1) {
#pragma unroll
                for (int g2 = 4; g2 < 8; ++g2) { const size_t r2 = (size_t)(row0 + (g2 >> 2) * HALF + (g2 & 3) * 16);
#pragma unroll
                    for (int bj = 0; bj < 2; ++bj) gv[g2][bj] = *(const u32x2*)((const unsigned char*)gates + r2 * NGATE + gcol0 + col0 + bj * HALF); } }
            if (MODE == 1 && gi + 1 < 8) { const size_t rn = (size_t)(row0 + ((gi + 1) >> 2) * HALF + ((gi + 1) & 3) * 16);
#pragma unroll
                for (int bj = 0; bj < 2; ++bj) mn[bj] = *(const u32x4*)(out + rn * D + col0 + bj * HALF); }
#pragma unroll
            for (int bj = 0; bj < 2; ++bj) { const int c = col0 + bj * HALF; const u32x2 g4 = gv[gi][bj]; const f32x4 a0 = acc[ai][bj][m][0], a1 = acc[ai][bj][m][1];
                const f32x2 ga = __builtin_amdgcn_cvt_pk_f32_fp8(g4.x, false), gb = __builtin_amdgcn_cvt_pk_f32_fp8(g4.x, true), gc = __builtin_amdgcn_cvt_pk_f32_fp8(g4.y, false), gd = __builtin_amdgcn_cvt_pk_f32_fp8(g4.y, true);
                float o[8]; o[0] = sigm(ga.x) * a0[0]; o[1] = sigm(ga.y) * a0[1]; o[2] = sigm(gb.x) * a0[2]; o[3] = sigm(gb.y) * a0[3];
                o[4] = sigm(gc.x) * a1[0]; o[5] = sigm(gc.y) * a1[1]; o[6] = sigm(gd.x) * a1[2]; o[7] = sigm(gd.y) * a1[3];
                if (MODE == 1) { const u32x4 m4 = mv[bj];
                    o[0] += bflo(m4.x); o[1] += bfhi(m4.x); o[2] += bflo(m4.y); o[3] += bfhi(m4.y); o[4] += bflo(m4.z); o[5] += bfhi(m4.z); o[6] += bflo(m4.w); o[7] += bfhi(m4.w); }
                if (MODE == 1) { u32x2 w8; w8.x = pk4_fp8(o[0], o[1], o[2], o[3]); w8.y = pk4_fp8(o[4], o[5], o[6], o[7]); *(u32x2*)(out8 + r * D + c) = w8; }
                else { u32x4 w; w.x = cvt_pk_bf16(o[0], o[1]); w.y = cvt_pk_bf16(o[2], o[3]); w.z = cvt_pk_bf16(o[4], o[5]); w.w = cvt_pk_bf16(o[6], o[7]);
                    *(u32x4*)(out + r * D + c) = w; } }
            asm volatile("" ::: "memory");
            if (MODE == 1) {
#pragma unroll
                for (int bj = 0; bj < 2; ++bj) mv[bj] = mn[bj]; } }
    }
};
struct EpiX1 {
    static constexpr bool PERM = true, AFTER_DRAIN = false; static constexpr int TAG = 4;
    const float* x; float* out;
    __device__ __forceinline__ void prefetch(const Unit&, PG8_LAS unsigned char*, int, int) const {}
    __device__ __forceinline__ void operator()(const f32x4 (&acc)[2][2][4][2], const Unit& u, int wr, int wc, int fr, int fq, const PG8_LAS unsigned char*) const {
        const int row0 = u.arow + wr * 64 + fr, col0 = u.brow + wc * 32 + 8 * fq;
        f32x4 xv[2][2], xn[2][2];
#pragma unroll
        for (int bj = 0; bj < 2; ++bj) { const size_t o = (size_t)row0 * D + col0 + bj * HALF; xv[bj][0] = *(const f32x4*)(x + o); xv[bj][1] = *(const f32x4*)(x + o + 4); }
#pragma unroll
        for (int gi = 0; gi < 8; ++gi) { const int ai = gi >> 2, m = gi & 3; const size_t r = (size_t)(row0 + ai * HALF + m * 16);
            if (gi + 1 < 8) { const size_t rn = (size_t)(row0 + ((gi + 1) >> 2) * HALF + ((gi + 1) & 3) * 16);
#pragma unroll
                for (int bj = 0; bj < 2; ++bj) { const size_t o = rn * D + col0 + bj * HALF; xn[bj][0] = *(const f32x4*)(x + o); xn[bj][1] = *(const f32x4*)(x + o + 4); } }
#pragma unroll
            for (int bj = 0; bj < 2; ++bj) { const size_t o = r * D + col0 + bj * HALF;
                *(f32x4*)(out + o) = xv[bj][0] + acc[ai][bj][m][0]; *(f32x4*)(out + o + 4) = xv[bj][1] + acc[ai][bj][m][1]; }
            asm volatile("" ::: "memory");
#pragma unroll
            for (int bj = 0; bj < 2; ++bj) { xv[bj][0] = xn[bj][0]; xv[bj][1] = xn[bj][1]; } }
    }
};
struct EpiSwiglu {
    static constexpr bool PERM = true, AFTER_DRAIN = false; static constexpr int TAG = 7;
    unsigned char* act; const float* bg; const float* bu;
    __device__ __forceinline__ void prefetch(const Unit& u, PG8_LAS unsigned char* slot, int wid, int lane) const {
        if (wid == 0) { const int pn = (u.brow >> 8) & 7; const float* src = ((lane < 32) ? bg : bu) + (size_t)u.e * D + pn * HALF + 4 * (lane & 31);
            __builtin_amdgcn_global_load_lds((const unsigned*)src, (PG8_LAS unsigned*)slot, 16, 0, 0); } }
    __device__ __forceinline__ void operator()(const f32x4 (&acc)[2][2][4][2], const Unit& u, int wr, int wc, int fr, int fq, const PG8_LAS unsigned char* slot) const {
        const int pn = (u.brow >> 8) & 7; const int col0 = pn * HALF + wc * 32 + 8 * fq; const int rl0 = wr * 64 + fr;
        const PG8_LAS f32x4* bl = (const PG8_LAS f32x4*)(slot + (wc * 32 + 8 * fq) * 4);
        const f32x4 g0 = bl[0], g1 = bl[1], u0 = bl[32], u1 = bl[33];
#pragma unroll
        for (int ai = 0; ai < 2; ++ai)
#pragma unroll
            for (int m = 0; m < 4; ++m) { const int rl = rl0 + ai * HALF + m * 16;
                const f32x4 ga = acc[ai][0][m][0] + g0, gb = acc[ai][0][m][1] + g1, ua = acc[ai][1][m][0] + u0, ub = acc[ai][1][m][1] + u1;
                float o[8];
#pragma unroll
                for (int j = 0; j < 4; ++j) { const float gt = fminf(ga[j], 7.f), up = fminf(fmaxf(ua[j], -7.f), 7.f); o[j] = gt * sigm(1.702f * gt) * (up + 1.f);
                    const float gt2 = fminf(gb[j], 7.f), up2 = fminf(fmaxf(ub[j], -7.f), 7.f); o[4 + j] = gt2 * sigm(1.702f * gt2) * (up2 + 1.f); }
                u32x2 w; w.x = pk4_fp8(o[0], o[1], o[2], o[3]); w.y = pk4_fp8(o[4], o[5], o[6], o[7]);
                if (rl < u.nrows) *(u32x2*)(act + (size_t)(u.arow + rl) * D + col0) = w; }
    }
};
struct EpiDown {
    static constexpr bool PERM = true, AFTER_DRAIN = false; static constexpr int TAG = 8;
    unsigned char* ys; const float* bd;
    __device__ __forceinline__ void prefetch(const Unit& u, PG8_LAS unsigned char* slot, int wid, int lane) const {
        if (wid == 0) { const int pn = (u.brow >> 8) & 3; __builtin_amdgcn_global_load_lds((const unsigned*)(bd + (size_t)u.e * D + pn * BM + 4 * lane), (PG8_LAS unsigned*)slot, 16, 0, 0); } }
    __device__ __forceinline__ void operator()(const f32x4 (&acc)[2][2][4][2], const Unit& u, int wr, int wc, int fr, int fq, const PG8_LAS unsigned char* slot) const {
        const int pn = (u.brow >> 8) & 3; const int col0 = pn * BM + wc * 32 + 8 * fq; const int rl0 = wr * 64 + fr;
        f32x4 bv[2][2];
#pragma unroll
        for (int bj = 0; bj < 2; ++bj)
#pragma unroll
            for (int n = 0; n < 2; ++n) bv[bj][n] = *(const PG8_LAS f32x4*)(slot + (wc * 32 + 8 * fq + bj * HALF + 4 * n) * 4);
#pragma unroll
        for (int ai = 0; ai < 2; ++ai)
#pragma unroll
            for (int m = 0; m < 4; ++m) { const int rl = rl0 + ai * HALF + m * 16; unsigned char* rowp = ys + (size_t)(u.arow + rl) * D + col0;
#pragma unroll
                for (int bj = 0; bj < 2; ++bj) { const f32x4 v0 = acc[ai][bj][m][0] + bv[bj][0], v1 = acc[ai][bj][m][1] + bv[bj][1];
                    u32x2 w; w.x = pk4_fp8(v0[0], v0[1], v0[2], v0[3]); w.y = pk4_fp8(v1[0], v1[1], v1[2], v1[3]);
                    if (rl < u.nrows) *(u32x2*)(rowp + bj * HALF) = w; } }
    }
};

typedef int i32x4_t __attribute__((ext_vector_type(4))); typedef int i32x8_t __attribute__((ext_vector_type(8)));
template <bool FP8> struct Frag;
template <> struct Frag<false> { bf16x8 v[2];
    __device__ __forceinline__ void ld(const PG8_LAS unsigned char* p) { v[0] = *(const PG8_LAS bf16x8*)p; v[1] = *(const PG8_LAS bf16x8*)(p + 1024); } };
template <> struct Frag<true> { i32x8_t v;
    __device__ __forceinline__ void ld(const PG8_LAS unsigned char* p) { const i32x4_t lo = *(const PG8_LAS i32x4_t*)p, hi = *(const PG8_LAS i32x4_t*)(p + 1024); v = __builtin_shufflevector(lo, hi, 0, 1, 2, 3, 4, 5, 6, 7); } };
__device__ __forceinline__ f32x4 mma_frag(const Frag<false>& w, const Frag<false>& x, f32x4 c) {
    c = __builtin_amdgcn_mfma_f32_16x16x32_bf16(w.v[0], x.v[0], c, 0, 0, 0); return __builtin_amdgcn_mfma_f32_16x16x32_bf16(w.v[1], x.v[1], c, 0, 0, 0); }
__device__ __forceinline__ f32x4 mma_frag(const Frag<true>& w, const Frag<true>& x, f32x4 c) {
    const int sa = 0x7A7A7A7A, sb = 0x7F7F7F7F;
    asm volatile("v_mfma_scale_f32_16x16x128_f8f6f4 %0, %1, %2, %0, %3, %4 op_sel_hi:[0,0,0]" : "+v"(c) : "v"(w.v), "v"(x.v), "v"(sa), "v"(sb));
    return c; }
template <class Epi, class Sched, bool ALIGN_EPI = false, bool SP2 = false, bool FP8 = false, bool GA = false>
__device__ __forceinline__ void gemm_phase(PG8_LAS unsigned char* lds, const Gemm g, const Sched& S, const Epi& E) {
    const int tid = threadIdx.x, wid = __builtin_amdgcn_readfirstlane(tid >> 6), lane = tid & 63, wr = wid >> 2, wc = wid & 3, fr = lane & 15, fq = lane >> 4;
    const int K = g.K, nt = K / BK;
    unsigned voffA[2], voffB[2];
#pragma unroll
    for (int i = 0; i < 2; ++i) { int R, C; stage_rc(tid * 16 + i * 8192, R, C); const int Rb = Epi::PERM ? ((R & ~31) + perm32(R & 31)) : R;
        voffA[i] = (unsigned)(R * K + C) * 2u; voffB[i] = (unsigned)(Rb * K + C) * 2u; }
    static_assert(!GA || SP2, "gather is wired into the two-super-phase loop only");
    unsigned vAc[2][2], vAn[2][2];
#pragma unroll
    for (int h = 0; h < 2; ++h)
#pragma unroll
        for (int i = 0; i < 2; ++i) { vAc[h][i] = voffA[i]; vAn[h][i] = voffA[i]; }
    PG8_LAS unsigned char* const ilds = lds + 131072 + 4096 + 2048;
    auto gather_off = [&](int i, unsigned idx) -> unsigned { int R, C; stage_rc(tid * 16 + i * 8192, R, C); idx = idx < (unsigned)T ? idx : (unsigned)(T - 1); return idx * (unsigned)(K * 2) + (unsigned)C * 2u; };
    auto piece_row = [&](int i) -> int { int R, C; stage_rc(tid * 16 + i * 8192, R, C); return R; };
    const size_t kstep = (size_t)(BK * 2);
    const size_t hstep = (size_t)HALF * K * 2;
    const size_t rowb = (size_t)K * 2;
    const size_t hstepA = GA ? 0 : hstep;
    const unsigned ldsw = (unsigned)wid * 1024u;
    const int aoff = lds_byte(wr * 64 + fr, fq * 8), boff = lds_byte(wc * 32 + fr, fq * 8);
#define PG8_SA(b, h) (((b) * 2 + (h)) * HTB)
#define PG8_SB(b, h) ((4 + (b) * 2 + (h)) * HTB)
#define PG8_STAGE(bufoff, gbase, voff) do { _Pragma("unroll") for (int _i = 0; _i < 2; ++_i) \
        __builtin_amdgcn_global_load_lds((const unsigned*)((const char*)(gbase) + (voff)[_i]), (PG8_LAS unsigned*)(lds + (bufoff) + ldsw + _i * 8192), 16, 0, 0); } while (0)
#define PG8_LDA(dst, b, h) do { _Pragma("unroll") for (int m = 0; m < 4; ++m) dst[m].ld(lds + PG8_SA(b, h) + aoff + m * 2048); } while (0)
#define PG8_LDB(dst, b, h) do { _Pragma("unroll") for (int n = 0; n < 2; ++n) dst[n].ld(lds + PG8_SB(b, h) + boff + n * 2048); } while (0)
#define PG8_MMA(ai, bj, At, Bt) do { __builtin_amdgcn_s_setprio(1); _Pragma("unroll") for (int m = 0; m < 4; ++m) _Pragma("unroll") for (int n = 0; n < 2; ++n) \
        acc[ai][bj][m][n] = mma_frag(Bt[n], At[m], acc[ai][bj][m][n]); __builtin_amdgcn_s_setprio(0); } while (0)
#define PG8_WAIT_V(n) asm volatile("s_waitcnt vmcnt(" #n ")" ::: "memory")
#define PG8_WAIT_L(n) asm volatile("s_waitcnt lgkmcnt(" #n ")" ::: "memory")
#define PG8_BAR __builtin_amdgcn_s_barrier()
#define PG8_SCHED __builtin_amdgcn_sched_barrier(0)
    Unit cur, nxt; int ui = 0;
    if (!S.next(0, cur)) return;
    f32x4 acc[2][2][4][2];
#pragma unroll
    for (int a = 0; a < 2; ++a)
#pragma unroll
        for (int b = 0; b < 2; ++b)
#pragma unroll
            for (int m = 0; m < 4; ++m)
#pragma unroll
                for (int n = 0; n < 2; ++n) acc[a][b][m][n] = (f32x4){0.f, 0.f, 0.f, 0.f};
    Frag<FP8> At[4], B0[2], B1[2];
    const char* cA = (const char*)(cur.swap ? g.Bt : g.A) + (size_t)cur.arow * rowb; const char* cB = (const char*)(cur.swap ? g.A : g.Bt) + (size_t)cur.brow * rowb;
    if constexpr (GA) { cA = (const char*)g.A;
#pragma unroll
        for (int h = 0; h < 2; ++h)
#pragma unroll
            for (int i = 0; i < 2; ++i) { vAc[h][i] = gather_off(i, (unsigned)g.gidx[cur.aidx + h * HALF + piece_row(i)]); vAn[h][i] = vAc[h][i]; } }
    S.a_ready(cur);
    PG8_LAS unsigned char* const blds = lds + 131072 + 4096;
    E.prefetch(cur, blds, wid, lane);
    if constexpr (SP2) {
        PG8_STAGE(PG8_SB(0, 0), cB, voffB); PG8_STAGE(PG8_SB(0, 1), cB + hstep, voffB); PG8_STAGE(PG8_SA(0, 0), cA, vAc[0]); PG8_STAGE(PG8_SA(0, 1), cA + hstepA, vAc[1]);
        if (wr == 1) PG8_BAR;
        PG8_WAIT_V(2); PG8_BAR;
        PG8_STAGE(PG8_SB(1, 0), cB + kstep, voffB); PG8_STAGE(PG8_SA(1, 0), cA + kstep, vAc[0]); PG8_STAGE(PG8_SB(1, 1), cB + hstep + kstep, voffB);
        PG8_WAIT_V(6); PG8_BAR;
    } else {
        PG8_STAGE(PG8_SB(0, 0), cB, voffB); PG8_STAGE(PG8_SA(0, 0), cA, voffA); PG8_STAGE(PG8_SB(0, 1), cB + hstep, voffB); PG8_STAGE(PG8_SA(0, 1), cA + hstep, voffA);
        if (wr == 1) PG8_BAR;
        PG8_WAIT_V(4); PG8_BAR;
        PG8_STAGE(PG8_SB(1, 0), cB + kstep, voffB); PG8_STAGE(PG8_SA(1, 0), cA + kstep, voffA); PG8_STAGE(PG8_SB(1, 1), cB + hstep + kstep, voffB);
        PG8_WAIT_V(6); PG8_BAR;
    }
    for (;;) {
        const bool has_next = S.next(ui + 1, nxt);
        const char* nA = (has_next && !GA) ? (const char*)(nxt.swap ? g.Bt : g.A) + (size_t)nxt.arow * rowb : cA; const char* nB = has_next ? (const char*)(nxt.swap ? g.A : g.Bt) + (size_t)nxt.brow * rowb : cB;
        for (int t = 0; t < nt; t += 2) {
            const bool last = (t == nt - 2);
            const char* a1 = cA + (size_t)(t + 1) * kstep;
            const char* a2 = last ? nA : cA + (size_t)(t + 2) * kstep; const char* b2 = last ? nB : cB + (size_t)(t + 2) * kstep;
            const char* a3 = a2 + kstep; const char* b3 = b2 + kstep;
            if (last && has_next) { S.a_ready(nxt); E.prefetch(nxt, blds + (((ui + 1) & 1) << 10), wid, lane); }
            if constexpr (GA) {
                if (t == nt - 4 && has_next && wid == 0) { int l4 = 4 * lane; asm volatile("" : "+v"(l4));
                    __builtin_amdgcn_global_load_lds((const unsigned*)(g.gidx + nxt.aidx + l4), (PG8_LAS unsigned*)(ilds + (((ui + 1) & 1) << 10)), 16, 0, 0); }
                if (last && has_next) { const PG8_LAS unsigned* il = (const PG8_LAS unsigned*)(ilds + (((ui + 1) & 1) << 10));
#pragma unroll
                    for (int h = 0; h < 2; ++h)
#pragma unroll
                        for (int i = 0; i < 2; ++i) vAn[h][i] = gather_off(i, il[h * HALF + piece_row(i)]); }
            }
            unsigned v2[2][2];
#pragma unroll
            for (int h = 0; h < 2; ++h)
#pragma unroll
                for (int i = 0; i < 2; ++i) v2[h][i] = last ? vAn[h][i] : vAc[h][i];
            if constexpr (SP2) {
            PG8_LDB(B0, 0, 0); PG8_LDB(B1, 0, 1); PG8_SCHED; PG8_LDA(At, 0, 0); PG8_STAGE(PG8_SA(1, 1), a1 + hstepA, vAc[1]);
            PG8_WAIT_V(8); PG8_WAIT_L(0); PG8_BAR; PG8_MMA(0, 0, At, B0); PG8_MMA(0, 1, At, B1); PG8_BAR; PG8_SCHED;
            PG8_LDA(At, 0, 1); PG8_STAGE(PG8_SB(0, 0), b2, voffB); PG8_STAGE(PG8_SB(0, 1), b2 + hstep, voffB); PG8_STAGE(PG8_SA(0, 0), a2, v2[0]);
            PG8_WAIT_V(8); PG8_WAIT_L(0); PG8_BAR; PG8_MMA(1, 0, At, B0); PG8_MMA(1, 1, At, B1); PG8_BAR; PG8_SCHED;
            PG8_LDB(B0, 1, 0); PG8_LDB(B1, 1, 1); PG8_SCHED; PG8_LDA(At, 1, 0); PG8_STAGE(PG8_SA(0, 1), a2 + hstepA, v2[1]);
            PG8_WAIT_V(8); PG8_WAIT_L(0); PG8_BAR; PG8_MMA(0, 0, At, B0); PG8_MMA(0, 1, At, B1); PG8_BAR; PG8_SCHED;
            PG8_LDA(At, 1, 1); PG8_STAGE(PG8_SB(1, 0), b3, voffB); PG8_STAGE(PG8_SB(1, 1), b3 + hstep, voffB); PG8_STAGE(PG8_SA(1, 0), a3, v2[0]);
            PG8_WAIT_V(8); PG8_WAIT_L(0); PG8_BAR; PG8_MMA(1, 0, At, B0); PG8_MMA(1, 1, At, B1); PG8_BAR; PG8_SCHED;
            } else {
            PG8_LDB(B0, 0, 0); PG8_SCHED; PG8_LDA(At, 0, 0); PG8_STAGE(PG8_SA(1, 1), a1 + hstep, voffA);
            PG8_WAIT_L(8); PG8_BAR; PG8_WAIT_L(0); PG8_MMA(0, 0, At, B0); PG8_BAR; PG8_SCHED;
            PG8_LDB(B1, 0, 1); PG8_STAGE(PG8_SB(0, 0), b2, voffB);
            PG8_BAR; PG8_WAIT_L(0); PG8_MMA(0, 1, At, B1); PG8_BAR;
            PG8_LDA(At, 0, 1); PG8_STAGE(PG8_SA(0, 0), a2, voffA);
            PG8_BAR; PG8_WAIT_L(0); PG8_MMA(1, 0, At, B0); PG8_BAR; PG8_SCHED;
            PG8_STAGE(PG8_SB(0, 1), b2 + hstep, voffB);
            PG8_WAIT_V(6); PG8_BAR; PG8_MMA(1, 1, At, B1); PG8_BAR;
            PG8_LDB(B0, 1, 0); PG8_SCHED; PG8_LDA(At, 1, 0); PG8_STAGE(PG8_SA(0, 1), a2 + hstep, voffA);
            PG8_WAIT_L(8); PG8_BAR; PG8_WAIT_L(0); PG8_MMA(0, 0, At, B0); PG8_BAR; PG8_SCHED;
            PG8_LDB(B1, 1, 1); PG8_STAGE(PG8_SB(1, 0), b3, voffB);
            PG8_BAR; PG8_WAIT_L(0); PG8_MMA(0, 1, At, B1); PG8_BAR;
            PG8_LDA(At, 1, 1); PG8_STAGE(PG8_SA(1, 0), a3, voffA);
            PG8_BAR; PG8_WAIT_L(0); PG8_MMA(1, 0, At, B0); PG8_BAR; PG8_SCHED;
            PG8_STAGE(PG8_SB(1, 1), b3 + hstep, voffB);
            PG8_WAIT_V(6); PG8_BAR; PG8_MMA(1, 1, At, B1); PG8_BAR;
            }
        }
        if constexpr (ALIGN_EPI) { if (wr == 0) PG8_BAR; }
        if constexpr (FP8) {
#define PG8_ACC8(a, b) "+v"(acc[a][b][0][0]), "+v"(acc[a][b][0][1]), "+v"(acc[a][b][1][0]), "+v"(acc[a][b][1][1]), "+v"(acc[a][b][2][0]), "+v"(acc[a][b][2][1]), "+v"(acc[a][b][3][0]), "+v"(acc[a][b][3][1])
            asm volatile("s_nop 15\n\ts_nop 15" : PG8_ACC8(0, 0), PG8_ACC8(0, 1) :: "memory");
            asm volatile("" : PG8_ACC8(1, 0), PG8_ACC8(1, 1) :: "memory");
#undef PG8_ACC8
        }
#ifdef MK_EPI2
        if constexpr (Epi::TAG == MK_EPI2) { E(acc, cur, wr, wc, fr, fq, blds + ((ui & 1) << 10)); asm volatile("" ::: "memory"); }
#endif
        if constexpr (!Epi::AFTER_DRAIN) { E(acc, cur, wr, wc, fr, fq, blds + ((ui & 1) << 10)); S.done(cur); }
        if (!has_next) break;
#pragma unroll
        for (int a = 0; a < 2; ++a)
#pragma unroll
            for (int b = 0; b < 2; ++b)
#pragma unroll
                for (int m = 0; m < 4; ++m)
#pragma unroll
                    for (int n = 0; n < 2; ++n) acc[a][b][m][n] = (f32x4){0.f, 0.f, 0.f, 0.f};
        cur = nxt; cA = nA; cB = nB; ++ui;
        if constexpr (GA) {
#pragma unroll
            for (int h = 0; h < 2; ++h)
#pragma unroll
                for (int i = 0; i < 2; ++i) vAc[h][i] = vAn[h][i]; }
        if constexpr (ALIGN_EPI) { if (wr == 1) PG8_BAR; }
    }
    PG8_WAIT_V(0);
    if constexpr (!ALIGN_EPI) { if (wr == 0) PG8_BAR; }
    PG8_BAR;
    if constexpr (Epi::AFTER_DRAIN) { E.fused(acc, cur, wr, wc, fr, fq, lds, wid, lane); S.done(cur); }
#undef PG8_SA
#undef PG8_SB
#undef PG8_STAGE
#undef PG8_LDA
#undef PG8_LDB
#undef PG8_MMA
#undef PG8_WAIT_V
#undef PG8_WAIT_L
#undef PG8_BAR
#undef PG8_SCHED
}

}

#define XB_TMO      128
#define XB_XCNT(j)  (256  + 64 * (j))
#define XB_XSUB(j)  (1280 + 64 * (j))
#define XB_XGEN(j)  (2304 + 64 * (j))
#define XB_TOP      3328
#define XB_TOPGEN   3392
#define XCD_BAR_WORDS 3456
#define XB_SPIN_CAP (1u << 18)
__device__ __forceinline__ unsigned xb_ld(unsigned* p)              { return __hip_atomic_load(p, __ATOMIC_RELAXED, __HIP_MEMORY_SCOPE_AGENT); }
__device__ __forceinline__ unsigned xb_add(unsigned* p, unsigned v) { return __hip_atomic_fetch_add(p, v, __ATOMIC_RELAXED, __HIP_MEMORY_SCOPE_AGENT); }
__device__ __forceinline__ unsigned xb_xcc_id() { return (unsigned)__builtin_amdgcn_s_getreg((3 << 11) | 20) & 0xFu; }
#define XB_SPIN(cond, bar) do { unsigned _sp = 0; while (cond) { __builtin_amdgcn_s_sleep(1); \
    if ((++_sp & 255u) == 0u) { if (xb_ld(&(bar)[XB_TMO])) break; if (_sp > XB_SPIN_CAP) { atomicAdd(&(bar)[XB_TMO], 1u); break; } } } } while (0)
struct XcdBarrier { unsigned* bar; unsigned x; volatile LAS unsigned* st; };
__device__ __forceinline__ XcdBarrier xcd_barrier_post(unsigned* bar, volatile LAS unsigned* st) {
    XcdBarrier b; b.bar = bar; b.x = xb_xcc_id(); b.st = st;
    if (threadIdx.x == 0) (void)xb_add(&bar[XB_XCNT(b.x)], 1u);
    return b;
}
__device__ __forceinline__ void xcd_barrier_complete(unsigned* bar, unsigned x, unsigned& nloc, unsigned& nx) {
    const unsigned G = gridDim.x * gridDim.y * gridDim.z;
    unsigned sum, cnt, mine, sp = 0u;
    for (;;) {
        sum = 0u; cnt = 0u; mine = 0u;
#pragma unroll
        for (unsigned j = 0; j < 16; ++j) { const unsigned c = xb_ld(&bar[XB_XCNT(j)]); sum += c; cnt += (c > 0u) ? 1u : 0u; mine = (j == x) ? c : mine; }
        if (sum == G) break;
        __builtin_amdgcn_s_sleep(1);
        if ((++sp & 255u) == 0u) { if (xb_ld(&bar[XB_TMO])) break; if (sp > XB_SPIN_CAP) { atomicAdd(&bar[XB_TMO], 1u); break; } }
    }
    nloc = mine > 0u ? mine : 1u; nx = cnt > 0u ? cnt : 1u;
}
__device__ __forceinline__ void xcd_barrier(const XcdBarrier& b) {
    asm volatile("s_waitcnt vmcnt(0)" ::: "memory");
    __syncthreads();
    if (threadIdx.x == 0) {
        unsigned* bar = b.bar;
        __builtin_amdgcn_s_waitcnt(0);
        unsigned nloc = b.st[0], nx = b.st[1];
        if (nloc == 0u) { xcd_barrier_complete(bar, b.x, nloc, nx); b.st[0] = nloc; b.st[1] = nx; }
        const unsigned old = xb_add(&bar[XB_XSUB(b.x)], 1u);
        const unsigned gen = old / nloc;
        if (old + 1u == (gen + 1u) * nloc) {
            __builtin_amdgcn_fence(__ATOMIC_RELEASE, "agent");
            asm volatile("s_waitcnt vmcnt(0)" ::: "memory");
            const unsigned og = xb_add(&bar[XB_TOP], 1u);
            const unsigned tg = og / nx;
            if (og + 1u == (tg + 1u) * nx) xb_add(&bar[XB_TOPGEN], 1u);
            else XB_SPIN(xb_ld(&bar[XB_TOPGEN]) == tg, bar);
            __builtin_amdgcn_fence(__ATOMIC_ACQUIRE, "agent");
            xb_add(&bar[XB_XGEN(b.x)], 1u);
            asm volatile("s_waitcnt vmcnt(0)" ::: "memory");
        } else {
            XB_SPIN(xb_ld(&bar[XB_XGEN(b.x)]) == gen, bar);
            __builtin_amdgcn_fence(__ATOMIC_ACQUIRE, "agent");
            asm volatile("s_waitcnt vmcnt(0)" ::: "memory");
        }
    }
    __syncthreads();
}

constexpr int NWAVES = 8;
constexpr int RING_OFF = 0, RING_BYTES = 131072;
constexpr int LDSCTL_OFF = RING_BYTES, MISC_OFF = LDSCTL_OFF + 320;
constexpr int TBL_OFF = LDSCTL_OFF + 1024;
constexpr int LDS_BYTES = 147456;

struct Frame {
    LAS unsigned char* lds; volatile LAS unsigned* MISC; LAS int* tbl; gu32* ctl;
    int tid, lane, wave, vcu, G;
};

__device__ __forceinline__ void p0_transpose_item(const float* W, int K, int N, bf16* WT, int k0, int n0, int orow0, LAS float* scr, int lane) {
#pragma unroll 8
    for (int i = 0; i < 32; ++i) { const int kk = 2 * i + (lane >> 5); scr[kk * 33 + (lane & 31)] = W[(size_t)(k0 + kk) * N + n0 + (lane & 31)]; }
    LDS_WAIT(); asm volatile("" ::: "memory");
    const int c = lane & 7;
#pragma unroll
    for (int j = 0; j < 4; ++j) { const int n = (lane >> 3) + 8 * j; const LAS float* s = scr + (8 * c) * 33 + n;
        u32x4 o; o.x = pk2(s[0 * 33], s[1 * 33]); o.y = pk2(s[2 * 33], s[3 * 33]); o.z = pk2(s[4 * 33], s[5 * 33]); o.w = pk2(s[6 * 33], s[7 * 33]);
        *(GAS u32x4*)(WT + (size_t)(orow0 + n) * K + k0 + 8 * c) = o; }
    LDS_WAIT(); asm volatile("" ::: "memory");
}
__device__ __forceinline__ void p0_transpose_item_fp8(const float* W, int K, int N, unsigned char* WT, int k0, int n0, int orow0, LAS float* scr, int lane) {
#pragma unroll 8
    for (int i = 0; i < 32; ++i) { const int kk = 2 * i + (lane >> 5); scr[kk * 33 + (lane & 31)] = W[(size_t)(k0 + kk) * N + n0 + (lane & 31)]; }
    LDS_WAIT(); asm volatile("" ::: "memory");
    const int c = lane & 7;
#pragma unroll
    for (int j = 0; j < 4; ++j) { const int n = (lane >> 3) + 8 * j; const LAS float* sp = scr + (8 * c) * 33 + n;
        u32x2 o; o.x = pk4_fp8(sp[0 * 33] * 32.f, sp[1 * 33] * 32.f, sp[2 * 33] * 32.f, sp[3 * 33] * 32.f); o.y = pk4_fp8(sp[4 * 33] * 32.f, sp[5 * 33] * 32.f, sp[6 * 33] * 32.f, sp[7 * 33] * 32.f);
        *(GAS u32x2*)(WT + (size_t)(orow0 + n) * K + k0 + 8 * c) = o; }
    LDS_WAIT(); asm volatile("" ::: "memory");
}
__device__ __forceinline__ void rms_row_to_bf16(const float* xrow, const float* g, bf16* orow, int lane) {
    const GAS f32x4* xr = (const GAS f32x4*)xrow + lane; f32x4 v[4]; float s = 0.f;
#pragma unroll
    for (int j = 0; j < 4; ++j) { v[j] = xr[64 * j]; s += (v[j].x * v[j].x + v[j].y * v[j].y) + (v[j].z * v[j].z + v[j].w * v[j].w); }
    const float rstd = 1.f / sqrtf(wave_sum(s) * (1.f / D) + EPS);
    GAS unsigned long long* o8 = (GAS unsigned long long*)orow + lane;
#pragma unroll
    for (int j = 0; j < 4; ++j) { const f32x4 gg = ((const GAS f32x4*)g)[lane + 64 * j];
        o8[64 * j] = (unsigned long long)pk2(v[j].x * rstd * gg.x, v[j].y * rstd * gg.y) | ((unsigned long long)pk2(v[j].z * rstd * gg.z, v[j].w * rstd * gg.w) << 32); }
}

__device__ __forceinline__ void rms_row_to_fp8(const float* xrow, const float* g, unsigned char* orow, unsigned char* orow4, unsigned char* orow16, int lane) {
    const GAS f32x4* xr = (const GAS f32x4*)xrow + lane; f32x4 v[4]; float s = 0.f;
#pragma unroll
    for (int j = 0; j < 4; ++j) { v[j] = xr[64 * j]; s += (v[j].x * v[j].x + v[j].y * v[j].y) + (v[j].z * v[j].z + v[j].w * v[j].w); }
    const float rstd = 1.f / sqrtf(wave_sum(s) * (1.f / D) + EPS);
    GAS unsigned* o4 = (GAS unsigned*)orow + lane; GAS unsigned* p4 = (GAS unsigned*)orow4 + lane; GAS unsigned* p16 = (GAS unsigned*)orow16 + lane;
#pragma unroll
    for (int j = 0; j < 4; ++j) { const f32x4 gg = ((const GAS f32x4*)g)[lane + 64 * j]; const unsigned w = pk4_fp8(v[j].x * rstd * gg.x, v[j].y * rstd * gg.y, v[j].z * rstd * gg.z, v[j].w * rstd * gg.w);
        o4[64 * j] = w; p4[64 * j] = w; p16[64 * j] = w; }
}
constexpr float LOG2E = 1.4426950408889634f;
typedef __bf16 bf16x2_t __attribute__((ext_vector_type(2)));
__device__ __forceinline__ unsigned cvtpk_v(float lo, float hi) { const f32x2 v = {lo, hi}; const bf16x2_t b = __builtin_convertvector(v, bf16x2_t); return __builtin_bit_cast(unsigned, b); }
typedef long longx2 __attribute__((ext_vector_type(2)));
struct AttFrags { longx2 k0, k1; bf16x8 v[4]; };
__device__ __forceinline__ float gmax4(float m) {
    { auto rr = __builtin_amdgcn_permlane16_swap(__float_as_uint(m), __float_as_uint(m), false, false); m = fmaxf(__uint_as_float(rr[0]), __uint_as_float(rr[1])); }
    { auto rr = __builtin_amdgcn_permlane32_swap(__float_as_uint(m), __float_as_uint(m), false, false); m = fmaxf(__uint_as_float(rr[0]), __uint_as_float(rr[1])); }
    return m;
}
constexpr int RB_A = 160, RB_B = 320;
template <int NH, int RB>
__device__ __forceinline__ void band_group(f32x4 (&o)[NH][4], float (&mrun)[NH], float (&lrun)[NH], const unsigned char* qkvb, const int (&qcol)[NH], const int (&qmu0)[NH], const unsigned char* kh, const bf16* vt,
                                           int dil, int rho, int L, int qstep, int P0, int npairs, const LAS float* const (&tab)[NH], int lane) {
    const int t = lane & 15, g = lane >> 4;
    longx2 qf[NH]; int mu_t[NH];
#pragma unroll
    for (int h = 0; h < NH; ++h) { mu_t[h] = qmu0[h] + qstep * t; qf[h] = *(const longx2*)(qkvb + (size_t)(mu_t[h] * dil + rho) * NQKV + 16 * g + qcol[h]); }
    const int npr = L >> 5;
    const unsigned char* kbase = kh + ((size_t)rho * L) * 64 + 16 * g;
    const bf16* vtl = vt + (size_t)(rho * npr) * 2048 + t * 32 + 8 * g;
    auto load = [&](int P, AttFrags& f) {
        const int Pc = min(max(P, 0), npr - 1);
        const unsigned char* k0p = kbase + (size_t)(32 * Pc + t) * 64; const unsigned char* k1p = k0p + 16 * 64;
        f.k0 = *(const longx2*)k0p; f.k1 = *(const longx2*)k1p;
#pragma unroll
        for (int db = 0; db < 4; ++db) f.v[db] = *(const bf16x8*)(vtl + (size_t)Pc * 2048 + db * 512);
    };
    AttFrags cur; load(P0, cur);
    for (int pp = 0; pp < npairs; ++pp) {
        const int P = P0 + pp;
        AttFrags nxt; load(P0 + min(pp + 1, npairs - 1), nxt);
        if (P >= 0 && P < npr) {
            const int kap0 = 32 * P + 4 * g;
#pragma unroll
            for (int h = 0; h < NH; ++h) {
                const LAS float* tb_ = tab[h] + (kap0 - mu_t[h] + RB);
                f32x4 s0 = (f32x4){tb_[0], tb_[1], tb_[2], tb_[3]}, s1 = (f32x4){tb_[16], tb_[17], tb_[18], tb_[19]};
                s0 = __builtin_amdgcn_mfma_f32_16x16x32_fp8_fp8(cur.k0.x, qf[h].x, s0, 0, 0, 0); s0 = __builtin_amdgcn_mfma_f32_16x16x32_fp8_fp8(cur.k0.y, qf[h].y, s0, 0, 0, 0);
                s1 = __builtin_amdgcn_mfma_f32_16x16x32_fp8_fp8(cur.k1.x, qf[h].x, s1, 0, 0, 0); s1 = __builtin_amdgcn_mfma_f32_16x16x32_fp8_fp8(cur.k1.y, qf[h].y, s1, 0, 0, 0);
                float mx = fmaxf(fmaxf(fmaxf(s0[0], s0[1]), fmaxf(s0[2], s0[3])), fmaxf(fmaxf(s1[0], s1[1]), fmaxf(s1[2], s1[3])));
                mx = gmax4(mx);
                if (__any(mx > mrun[h])) { const float mn = fmaxf(mrun[h], mx), alpha = __builtin_amdgcn_exp2f(mrun[h] - mn); mrun[h] = mn; lrun[h] *= alpha;
#pragma unroll
                    for (int db = 0; db < 4; ++db) o[h][db] = o[h][db] * alpha; }
                const float mn = mrun[h]; float p[8], ps = 0.f;
#pragma unroll
                for (int j = 0; j < 8; ++j) { p[j] = __builtin_amdgcn_exp2f(((j < 4) ? s0[j & 3] : s1[j & 3]) - mn); ps += p[j]; }
                lrun[h] += ps;
                u32x4 pw; pw.x = cvtpk_v(p[0], p[1]); pw.y = cvtpk_v(p[2], p[3]); pw.z = cvtpk_v(p[4], p[5]); pw.w = cvtpk_v(p[6], p[7]);
                const bf16x8 pf = __builtin_bit_cast(bf16x8, pw);
#pragma unroll
                for (int db = 0; db < 4; ++db) o[h][db] = __builtin_amdgcn_mfma_f32_16x16x32_bf16(cur.v[db], pf, o[h][db], 0, 0, 0);
                if (NH > 2 && h + 1 < NH) __builtin_amdgcn_sched_barrier(0);
            }
        }
        cur = nxt;
    }
}
template <int NH>
__device__ __forceinline__ void band_store(const f32x4 (&o)[NH][4], const float (&lrun)[NH], unsigned char* const (&yrow)[NH], int lane) {
    const int g = lane >> 4;
#pragma unroll
    for (int h = 0; h < NH; ++h) { float l = lrun[h]; l += __shfl_xor(l, 16); l += __shfl_xor(l, 32); const float inv = 1.f / l;
#pragma unroll
        for (int db = 0; db < 4; ++db) *(unsigned*)(yrow[h] + 16 * db + 4 * g) = pk4_fp8(o[h][db][0] * inv, o[h][db][1] * inv, o[h][db][2] * inv, o[h][db][3] * inv); }
}

struct Args { const float* in[19]; float* out; unsigned char* ws; int ph_lo, ph_hi, li, pad; };
constexpr int NPHASE = 10;

__global__ void __launch_bounds__(NWAVES * 64, 2) mk_fwd(Args args) {
    extern __shared__ __attribute__((aligned(16))) unsigned char lds[];
    Frame F;
    F.lds = (LAS unsigned char*)lds; F.MISC = (volatile LAS unsigned*)(F.lds + MISC_OFF); F.tbl = (LAS int*)(F.lds + TBL_OFF);
    F.tid = threadIdx.x; F.lane = F.tid & 63; F.wave = __builtin_amdgcn_readfirstlane(F.tid >> 6);
    F.G = gridDim.x; { const int bx = blockIdx.x; F.vcu = (F.G % 8 == 0) ? (bx % 8) * (F.G / 8) + bx / 8 : bx; }
    unsigned char* ws = args.ws; F.ctl = (gu32*)(ws + WS_CTL);
    const float* x = args.in[0]; const float* norm_mix = args.in[1]; const float* w_in = args.in[2]; const float* b_in = args.in[3];
    const float* sinks = args.in[4]; const float* rel_bias = args.in[5]; const float* w_a = args.in[6]; const float* w_b = args.in[7];
    const float* w_out = args.in[8]; const float* norm_ffn = args.in[9]; const float* router_w = args.in[10]; const float* router_b = args.in[11];
    const float* w_gate = args.in[12]; const float* b_gate = args.in[13]; const float* w_up = args.in[14]; const float* b_up = args.in[15];
    const float* w_down = args.in[16]; const float* b_down = args.in[17]; const float* norm_final = args.in[18];
    float* out = args.out;
    Tabs* tb = (Tabs*)(ws + WS_TAB);
    bf16* Win_t = (bf16*)(ws + WS_WIN); bf16* Wa_t = (bf16*)(ws + WS_WA); bf16* Wb_t = (bf16*)(ws + WS_WB); bf16* Wout_t = (bf16*)(ws + WS_WOUT);
    unsigned char* Wgu8 = ws + WS_WGU; unsigned char* Wd8 = ws + WS_WD; unsigned char* H28 = ws + WS_H2; unsigned char* HS8 = ws + WS_HS; unsigned char* ACT8 = ws + WS_ACT; unsigned char* YS = ws + WS_YS;
    int* topi = (int*)(ws + WS_RT); float* topp = (float*)(ws + WS_RT + 256 * 1024); int* slot = (int*)(ws + WS_RT + 512 * 1024); int* pos = (int*)(ws + WS_RT + 768 * 1024);
    bf16* XN = (bf16*)(ws + WS_XN); bf16* QKV = (bf16*)(ws + WS_QKV); bf16* GATES = (bf16*)(ws + WS_GATES); bf16* YA = (bf16*)(ws + WS_YA); bf16* YB = (bf16*)(ws + WS_YB);
    bf16* MERGED = (bf16*)(ws + WS_MERGED);
    gu32* cnt = F.ctl + CW_CNT; int* rtc = (int*)(ws + WS_RTC);

    for (int u = F.tid; u < (LDS_BYTES - LDSCTL_OFF) / 4; u += NWAVES * 64) ((LAS unsigned*)(F.lds + LDSCTL_OFF))[u] = 0u;
    __syncthreads();
    XcdBarrier bar = xcd_barrier_post((unsigned*)(F.ctl + CW_BAR) + args.li * XCD_BAR_WORDS, F.MISC + 8);
    const int lo = args.ph_lo, hi = args.ph_hi;
#ifndef MK_SKIP
#define MK_SKIP 0
#endif
#define IN(k) (!((MK_SKIP >> (k)) & 1) && lo <= (k) && (k) < hi)
#ifndef MK_DUP
#define MK_DUP 0
#endif
#define REP(k) _Pragma("unroll") for (int rep_ = 0; rep_ < 1 + ((MK_DUP >> (k)) & 1); ++rep_)
#ifdef MK_TSTAMP
    unsigned long long ts_a = __builtin_amdgcn_s_memrealtime(), ts_b = ts_a;
#define SEAM(k) do { if (IN(k) && IN((k) + 1)) xcd_barrier(bar); if ((k) + 1 == MK_TSTAMP) ts_a = __builtin_amdgcn_s_memrealtime(); if ((k) == MK_TSTAMP) ts_b = __builtin_amdgcn_s_memrealtime(); } while (0)
#else
#define SEAM(k) do { if (IN(k) && IN((k) + 1)) xcd_barrier(bar); } while (0)
#endif
    const int gw = F.vcu * NWAVES + F.wave, NGW = F.G * NWAVES;

    LAS float* scr = (LAS float*)(F.lds + RING_OFF + F.wave * 16384);
    constexpr int I_IN = (D / 64) * (NPROJ / 32), I_A = (D / 64) * (D / 32), I_B = (256 / 64) * (D / 32), I_E = (D / 64) * (D / 32);
    constexpr int NITEMS = I_IN + 2 * I_A + I_B + 3 * NE * I_E;
    auto transpose_items = [&](int first, int last) {
    for (int it = first + gw; it < last; it += NGW) {
        int r = it;
        if (r < I_IN) { const int nb = NPROJ / 32; p0_transpose_item_fp8(w_in, D, NPROJ, (unsigned char*)Win_t, 64 * (r / nb), 32 * (r % nb), 32 * (r % nb), scr, F.lane); continue; } r -= I_IN;
        if (r < I_A) { const int nb = D / 32; p0_transpose_item_fp8(w_a, D, D, (unsigned char*)Wa_t, 64 * (r / nb), 32 * (r % nb), 32 * (r % nb), scr, F.lane); continue; } r -= I_A;
        if (r < I_A) { const int nb = D / 32; p0_transpose_item_fp8(w_out, D, D, (unsigned char*)Wout_t, 64 * (r / nb), 32 * (r % nb), 32 * (r % nb), scr, F.lane); continue; } r -= I_A;
        if (r < I_B) { const int nb = D / 32; p0_transpose_item_fp8(w_b, 256, D, (unsigned char*)Wb_t, 64 * (r / nb), 32 * (r % nb), 32 * (r % nb), scr, F.lane); continue; } r -= I_B;
        { const int e = r / (3 * I_E), q = r % (3 * I_E), which = q / I_E, ii = q % I_E, nb = D / 32, k0 = 64 * (ii / nb), n0 = 32 * (ii % nb);
          if (which == 0) p0_transpose_item_fp8(w_gate + (size_t)e * D * D, D, D, Wgu8, k0, n0, e * 2048 + (n0 >> 7) * 256 + (n0 & 127), scr, F.lane);
          else if (which == 1) p0_transpose_item_fp8(w_up + (size_t)e * D * D, D, D, Wgu8, k0, n0, e * 2048 + (n0 >> 7) * 256 + 128 + (n0 & 127), scr, F.lane);
          else p0_transpose_item_fp8(w_down + (size_t)e * D * D, D, D, Wd8, k0, n0, e * 1024 + n0, scr, F.lane); }
    }
    };
    if (IN(0)) REP(0) {
        { const int i = blockIdx.x * (NWAVES * 64) + F.tid;
          if (i < 16 * 257) { const int h = i / 257, r = i % 257; tb->biasA[h][r] = rel_bias[BKT_A[r] * 28 + h]; }
          if (i < 12 * 129) { const int g = i / (4 * 129), hs = (i / 129) % 4, r = i % 129; tb->biasB[g][hs][r] = rel_bias[BKT_B[g][r] * 28 + 16 + 4 * g + hs]; } }
        transpose_items(0, I_IN + 2 * I_A + I_B);
        for (int m = gw; m < T; m += NGW) { const int t0 = m & ~255, tl = m & 255;
            rms_row_to_fp8(x + (size_t)m * D, norm_mix, (unsigned char*)XN + (size_t)m * D, ws + WS_XNP + (size_t)(t0 + (tl & 3) * 64 + (tl >> 2)) * D,
                           ws + WS_XNP + (size_t)(T + t0 + (tl & 15) * 16 + (tl >> 4)) * D, F.lane); }
    }
    SEAM(0);
    if (IN(1)) REP(1) {
        int k512 = D / 2; asm volatile("" : "+s"(k512));
        pg8::Gemm g{XN, Win_t, k512}; pg8::ProjOrder So; So.so.init(T, NPROJ, F.G, (int)blockIdx.x);
        pg8::EpiProj E{QKV, GATES, b_in, (bf16*)(ws + WS_VT), (bf16*)(ws + WS_VT) + (size_t)2 * 4 * 64 * 8192, ws + WS_K2};
        pg8::gemm_phase<pg8::EpiProj, pg8::ProjOrder, true, true, true>(F.lds + RING_OFF, g, So, E);
    }
    SEAM(1);
    int nrep2 = 1 + ((MK_DUP >> 2) & 1); asm volatile("" : "+s"(nrep2));
    if (IN(2)) for (int rep_ = 0; rep_ < nrep2; ++rep_) {
        LAS float* lb = (LAS float*)(F.lds + RING_OFF);
        constexpr int TA = 2 * RB_A + 1, TB = 2 * RB_B + 1;
        for (int i = F.tid; i < 16 * TA; i += NWAVES * 64) { const int h = i / TA, rel = i % TA - RB_A; lb[i] = (rel >= -128 && rel <= 128) ? tb->biasA[h][rel + 128] * LOG2E : -3.0e38f; }
        for (int i = F.tid; i < 12 * TB; i += NWAVES * 64) { const int gh = i / TB, rel = i % TB - RB_B; lb[16 * TA + i] = (rel >= -64 && rel <= 64) ? tb->biasB[gh >> 2][gh & 3][rel + 64] * LOG2E : -3.0e38f; }
        __syncthreads();
        const bf16* VTA = (const bf16*)(ws + WS_VT); const bf16* VTB = VTA + (size_t)2 * 4 * 64 * 8192; const unsigned char* K2 = ws + WS_K2;
        for (int it = gw; it < 4096 + 2048; it += NGW) {
            const int t = F.lane & 15;
            if (it < 4096) {
                const int b = it >> 11, kvh = (it >> 9) & 3, qb = it & 511;
                f32x4 o[4][4]; float mr[4], lr[4];
#pragma unroll
                for (int h = 0; h < 4; ++h) { mr[h] = sinks[kvh * 4 + h] * LOG2E; lr[h] = (F.lane < 16) ? 1.f : 0.f;
#pragma unroll
                    for (int db = 0; db < 4; ++db) o[h][db] = (f32x4){0.f, 0.f, 0.f, 0.f}; }
                const int qcol[4] = {C_QA + (kvh * 4 + 0) * 64, C_QA + (kvh * 4 + 1) * 64, C_QA + (kvh * 4 + 2) * 64, C_QA + (kvh * 4 + 3) * 64};
                const int qmu[4] = {16 * qb, 16 * qb, 16 * qb, 16 * qb};
                const LAS float* const bias[4] = {lb + (kvh * 4 + 0) * TA, lb + (kvh * 4 + 1) * TA, lb + (kvh * 4 + 2) * TA, lb + (kvh * 4 + 3) * TA};
                band_group<4, RB_A>(o, mr, lr, (const unsigned char*)QKV + (size_t)b * S * NQKV, qcol, qmu, K2 + (size_t)((b * 4 + kvh) * 8192) * 64, VTA + (size_t)((b * 4 + kvh) * 64) * 8192, 1, 0, S, 1, (qb - 8) >> 1, 9, bias, F.lane);
                unsigned char* yr = (unsigned char*)YA + (size_t)(b * S + 16 * qb + t) * D + kvh * 256; unsigned char* const yrow[4] = {yr, yr + 64, yr + 128, yr + 192};
                band_store<4>(o, lr, yrow, F.lane);
            } else {
                const int j = it - 4096, r = j & 7, un = j >> 3, blk = un & 31, hs = (un >> 5) & 3, b = un >> 7, i0 = blk * 256;
                f32x4 o[2][4]; float mr[2], lr[2];
#pragma unroll
                for (int h = 0; h < 2; ++h) { mr[h] = -1.0e30f; lr[h] = 0.f;
#pragma unroll
                    for (int db = 0; db < 4; ++db) o[h][db] = (f32x4){0.f, 0.f, 0.f, 0.f}; }
                const unsigned char* qb_ = (const unsigned char*)QKV + (size_t)b * S * NQKV;
                { const int qcol[2] = {C_QB + 0 * 256 + hs * 64, C_QB + 0 * 256 + hs * 64}; const int qmu[2] = {i0 + r, i0 + r + 8}; const LAS float* const bias[2] = {lb + 16 * TA + (0 * 4 + hs) * TB, lb + 16 * TA + (0 * 4 + hs) * TB};
                  band_group<2, RB_B>(o, mr, lr, qb_, qcol, qmu, K2 + (size_t)((((0 + 1) * 2 + b) * 4 + hs) * 8192) * 64, VTB + (size_t)(((0 * 2 + b) * 4 + hs) * 64) * 8192, 1, 0, S, 16, (i0 >> 5) - 2, 12, bias, F.lane); }
                { const int qcol[2] = {C_QB + 1 * 256 + hs * 64, C_QB + 1 * 256 + hs * 64}; const int qmu[2] = {(i0 + r) >> 2, (i0 + r + 8) >> 2}; const LAS float* const bias[2] = {lb + 16 * TA + (1 * 4 + hs) * TB, lb + 16 * TA + (1 * 4 + hs) * TB};
                  band_group<2, RB_B>(o, mr, lr, qb_, qcol, qmu, K2 + (size_t)((((1 + 1) * 2 + b) * 4 + hs) * 8192) * 64, VTB + (size_t)(((1 * 2 + b) * 4 + hs) * 64) * 8192, 4, r & 3, S / 4, 4, (i0 >> 7) - 2, 6, bias, F.lane); }
#pragma unroll
                for (int h = 0; h < 2; ++h) { const int qcol[1] = {C_QB + 2 * 256 + hs * 64}; const int qmu[1] = {i0 >> 4}; const LAS float* const bias[1] = {lb + 16 * TA + (2 * 4 + hs) * TB};
                  band_group<1, RB_B>(*(f32x4(*)[1][4])&o[h], *(float(*)[1])&mr[h], *(float(*)[1])&lr[h], qb_, qcol, qmu, K2 + (size_t)((((2 + 1) * 2 + b) * 4 + hs) * 8192) * 64, VTB + (size_t)(((2 * 2 + b) * 4 + hs) * 64) * 8192,
                                    16, r + 8 * h, S / 16, 1, (blk - 4) >> 1, 5, bias, F.lane); }
                unsigned char* yr = (unsigned char*)YB + (size_t)(b * S + i0 + r + 16 * t) * 256 + hs * 64; unsigned char* const yrow[2] = {yr, yr + 8 * 256};
                band_store<2>(o, lr, yrow, F.lane);
            }
        }
        __syncthreads();
    }
    SEAM(2);
    if (IN(3)) REP(3) {
#ifndef NO_P3A
        { int k256 = 128; asm volatile("" : "+s"(k256)); pg8::Gemm g{YB, Wb_t, k256};   pg8::StaticOrder So; So.init(T, D, F.G, (int)blockIdx.x);
          pg8::EpiGate<0> E{MERGED, GATES, 1024, nullptr};
          pg8::gemm_phase<pg8::EpiGate<0>, pg8::StaticOrder, true, true, true>(F.lds + RING_OFF, g, So, E); }
#endif
        VM_WAIT(); __syncthreads();
#ifndef NO_P3B
        { int k512 = D / 2; asm volatile("" : "+s"(k512)); pg8::Gemm g{YA, Wa_t, k512}; pg8::StaticOrder So; So.init(T, D, F.G, (int)blockIdx.x);
          pg8::EpiGate<1> E{MERGED, GATES, 0, (unsigned char*)YA + (size_t)16 * MiB};
          pg8::gemm_phase<pg8::EpiGate<1>, pg8::StaticOrder, true, true, true>(F.lds + RING_OFF, g, So, E); }
#endif
    }
    SEAM(3);
    if (IN(4)) REP(4) {
        int k512 = D / 2; asm volatile("" : "+s"(k512)); pg8::Gemm g{(const bf16*)((unsigned char*)YA + (size_t)16 * MiB), Wout_t, k512}; pg8::StaticOrder So; So.init(T, D, F.G, (int)blockIdx.x);
        pg8::EpiX1 E{x, out};
        pg8::gemm_phase<pg8::EpiX1, pg8::StaticOrder, true, true, true>(F.lds + RING_OFF, g, So, E);
    }
    SEAM(4);
    if (IN(5)) REP(5) {
        const bool lastrep5 = (rep_ + 1 == 1 + ((MK_DUP >> 5) & 1));
        LAS int* lcnt = F.tbl + 72; LAS int* lbase = F.tbl + 104; LAS int* ebuf = F.tbl + 136; LAS int* pbuf = F.tbl + 392;
        LAS float* plog = (LAS float*)(F.lds + RING_OFF);
        LAS float* psq = plog + 8 * 64 * 32;
        LAS float* rstd_s = psq + 512;
        const int g = F.lane >> 4, e16 = F.lane & 15, w = F.wave;
        float wB[32][2];
#pragma unroll
        for (int sc = 0; sc < 32; ++sc) { const int k = 128 * w + 32 * (sc >> 3) + 8 * g + (sc & 7); const float gm = norm_ffn[k];
            wB[sc][0] = gm * router_w[(size_t)k * NE + e16]; wB[sc][1] = gm * router_w[(size_t)k * NE + 16 + e16]; }
        for (int tblk = F.vcu; tblk < T / 64; tblk += F.G) {
            if (F.tid < 32) lcnt[F.tid] = 0;
            f32x4 v[4][2];
            { const GAS float* xr = (const GAS float*)out + (size_t)(tblk * 64 + e16) * D + 128 * w + 8 * g;
#pragma unroll
              for (int s4 = 0; s4 < 4; ++s4) { v[s4][0] = *(const GAS f32x4*)(xr + 32 * s4); v[s4][1] = *(const GAS f32x4*)(xr + 32 * s4 + 4); } }
#pragma unroll 1
            for (int tile = 0; tile < 4; ++tile) {
                f32x4 vn[4][2];
                { const int tn = tile < 3 ? tile + 1 : 3; const GAS float* xr = (const GAS float*)out + (size_t)(tblk * 64 + tn * 16 + e16) * D + 128 * w + 8 * g;
#pragma unroll
                  for (int s4 = 0; s4 < 4; ++s4) { vn[s4][0] = *(const GAS f32x4*)(xr + 32 * s4); vn[s4][1] = *(const GAS f32x4*)(xr + 32 * s4 + 4); } }
                float sq = 0.f;
#pragma unroll
                for (int s4 = 0; s4 < 4; ++s4) sq += (v[s4][0].x * v[s4][0].x + v[s4][0].y * v[s4][0].y) + (v[s4][0].z * v[s4][0].z + v[s4][0].w * v[s4][0].w)
                                                   + (v[s4][1].x * v[s4][1].x + v[s4][1].y * v[s4][1].y) + (v[s4][1].z * v[s4][1].z + v[s4][1].w * v[s4][1].w);
                sq += __shfl_xor(sq, 16); sq += __shfl_xor(sq, 32);
                if (g == 0) psq[w * 64 + tile * 16 + e16] = sq;
                f32x4 a0 = (f32x4){0.f, 0.f, 0.f, 0.f}, a1 = (f32x4){0.f, 0.f, 0.f, 0.f};
#pragma unroll
                for (int s4 = 0; s4 < 4; ++s4)
#pragma unroll
                    for (int c = 0; c < 8; ++c) { const float av = v[s4][c >> 2][c & 3];
                        a0 = __builtin_amdgcn_mfma_f32_16x16x4f32(av, wB[s4 * 8 + c][0], a0, 0, 0, 0); a1 = __builtin_amdgcn_mfma_f32_16x16x4f32(av, wB[s4 * 8 + c][1], a1, 0, 0, 0); }
#pragma unroll
                for (int r = 0; r < 4; ++r) { LAS float* pr = plog + (size_t)(w * 64 + tile * 16 + 4 * g + r) * 32 + e16; pr[0] = a0[r]; pr[16] = a1[r]; }
#pragma unroll
                for (int s4 = 0; s4 < 4; ++s4) { v[s4][0] = vn[s4][0]; v[s4][1] = vn[s4][1]; }
            }
            __syncthreads();
            if (F.tid < 64) { float s = 0.f;
#pragma unroll
                for (int ww = 0; ww < 8; ++ww) s += psq[ww * 64 + F.tid];
                rstd_s[F.tid] = 1.f / sqrtf(s * (1.f / D) + EPS); }
            __syncthreads();
            { const int e = F.tid & 31; const float rbv = router_b[e];
#pragma unroll 1
              for (int i = 0; i < 4; ++i) { const int tl = (F.tid >> 5) + 16 * i; float lg = 0.f;
#pragma unroll
                for (int ww = 0; ww < 8; ++ww) lg += plog[(size_t)(ww * 64 + tl) * 32 + e];
                float val = lg * rstd_s[tl] + rbv; float tv[4]; int ti[4];
#pragma unroll
                for (int r = 0; r < 4; ++r) {
                    float bv = val; int bi = e;
#pragma unroll
                    for (int o = 1; o < 32; o <<= 1) { const float ov = __shfl_xor(bv, o); const int oi = __shfl_xor(bi, o); if (ov > bv || (ov == bv && oi < bi)) { bv = ov; bi = oi; } }
                    tv[r] = bv; ti[r] = bi; if (bi == e) val = -3.0e38f;
                }
                const float e1 = __expf(tv[1] - tv[0]), e2 = __expf(tv[2] - tv[0]), e3 = __expf(tv[3] - tv[0]); const float inv = 1.f / (1.f + e1 + e2 + e3);
                if (e < 4) { const float p = (e == 0 ? 1.f : e == 1 ? e1 : e == 2 ? e2 : e3) * inv; const int ex = (e == 0 ? ti[0] : e == 1 ? ti[1] : e == 2 ? ti[2] : ti[3]);
                    const int m = tblk * 64 + tl; topi[m * 4 + e] = ex; topp[m * 4 + e] = p;
                    const int li = tl * 4 + e; ebuf[li] = ex; pbuf[li] = __hip_atomic_fetch_add(&lcnt[ex], 1, __ATOMIC_RELAXED, __HIP_MEMORY_SCOPE_WORKGROUP); } } }
#pragma unroll 1
            for (int rb = 0; rb < 8; rb += 4) { f32x4 xv[4][4];
#pragma unroll
                for (int r = 0; r < 4; ++r) { const GAS f32x4* xr4 = (const GAS f32x4*)(out + ((size_t)tblk * 64 + w * 8 + rb + r) * D) + F.lane;
#pragma unroll
                    for (int j = 0; j < 4; ++j) xv[r][j] = xr4[64 * j]; }
#pragma unroll
                for (int r = 0; r < 4; ++r) { const int tl = w * 8 + rb + r; const float rstd = rstd_s[tl]; GAS unsigned* o4 = (GAS unsigned*)(H28 + ((size_t)tblk * 64 + tl) * D) + F.lane;
#pragma unroll
                    for (int j = 0; j < 4; ++j) { const f32x4 gg = ((const GAS f32x4*)norm_ffn)[F.lane + 64 * j];
                        o4[64 * j] = pk4_fp8(xv[r][j].x * rstd * gg.x, xv[r][j].y * rstd * gg.y, xv[r][j].z * rstd * gg.z, xv[r][j].w * rstd * gg.w); } } }
            __syncthreads();
            if (F.tid < 32) lbase[F.tid] = lastrep5 ? (int)__hip_atomic_fetch_add(cnt + F.tid, (unsigned)lcnt[F.tid], RLX_AGENT) : 0;
            __syncthreads();
            if (F.tid < 256) { const int ex = ebuf[F.tid], ps = lbase[ex] + pbuf[F.tid]; pos[tblk * 256 + F.tid] = ps; rtc[(size_t)ex * T + ps] = tblk * 64 + (F.tid >> 2); }
            __syncthreads();
        }
    }
    if (IN(5)) transpose_items(I_IN + 2 * I_A + I_B, NITEMS);
    SEAM(5);
    if (IN(7) || IN(8) || IN(9)) {
        LAS int* loff = F.tbl; LAS int* ltoff = F.tbl + 36; LAS int* lc = F.tbl + 72;
        if (F.tid < 32) lc[F.tid] = (int)__hip_atomic_load(cnt + F.tid, RLX_AGENT);
        __syncthreads();
        if (F.tid == 0) { int a = 0, ta = 0; for (int e = 0; e < NE; ++e) { loff[e] = a; ltoff[e] = ta; const int c = lc[e]; a += c; ta += (c + 255) >> 8; } loff[NE] = a; ltoff[NE] = ta; }
        __syncthreads();
    }
    if (IN(7)) REP(7) {
        int k512 = D / 2; asm volatile("" : "+s"(k512));
        pg8::Gemm g{(const bf16*)H28, (const bf16*)Wgu8, k512, rtc}; pg8::GroupOrder So{F.tbl + 36, F.tbl, 8, F.G, (int)blockIdx.x, 0, T};   So.nunits = __builtin_amdgcn_readfirstlane(F.tbl[36 + NE]) * 8;
        pg8::EpiSwiglu E{ACT8, b_gate, b_up};
        pg8::gemm_phase<pg8::EpiSwiglu, pg8::GroupOrder, true, FP8_SP2, true, true>(F.lds + RING_OFF, g, So, E);
    }
    SEAM(7);
    if (IN(8)) REP(8) {
        int k512 = D / 2; asm volatile("" : "+s"(k512));
        pg8::Gemm g{(const bf16*)ACT8, (const bf16*)Wd8, k512}; pg8::GroupOrder So{F.tbl + 36, F.tbl, 4, F.G, (int)blockIdx.x, 0, 0}; So.nunits = __builtin_amdgcn_readfirstlane(F.tbl[36 + NE]) * 4;
        pg8::EpiDown E{YS, b_down};
        pg8::gemm_phase<pg8::EpiDown, pg8::GroupOrder, true, FP8_SP2, true>(F.lds + RING_OFF, g, So, E);
    }
    SEAM(8);
#ifdef MK_XBAR
    for (int xb_ = 0; xb_ < MK_XBAR; ++xb_) xcd_barrier(bar);
#endif
    if (IN(9)) REP(9) {
        const unsigned char* ys = YS;
        const int lane9 = (int)__builtin_amdgcn_mbcnt_hi(~0u, __builtin_amdgcn_mbcnt_lo(~0u, 0u));
        float* dst9 = (rep_ + 1 < 1 + ((MK_DUP >> 9) & 1)) ? (float*)(ws + WS_ACT) : out;
        for (int m0 = gw; m0 < T; m0 += 2 * NGW) {
            f32x4 v[2][4]; int sl[2][4]; float pr[2][4]; unsigned yv[2][4][4]; bool ok[2];
#pragma unroll
            for (int q = 0; q < 2; ++q) { const int m = m0 + q * NGW; ok[q] = m < T; const int mc = ok[q] ? m : m0; const GAS f32x4* xr = (const GAS f32x4*)(out + (size_t)mc * D) + lane9;
#pragma unroll
                for (int j = 0; j < 4; ++j) v[q][j] = xr[64 * j];
#pragma unroll
                for (int k = 0; k < 4; ++k) { sl[q][k] = F.tbl[topi[mc * 4 + k]] + pos[mc * 4 + k]; pr[q][k] = topp[mc * 4 + k]; } }
#pragma unroll
            for (int q = 0; q < 2; ++q)
#pragma unroll
                for (int k = 0; k < 4; ++k) { const GAS unsigned* yr = (const GAS unsigned*)(ys + (size_t)sl[q][k] * D) + lane9;
#pragma unroll
                    for (int j = 0; j < 4; ++j) yv[q][k][j] = yr[64 * j]; }
#pragma unroll
            for (int q = 0; q < 2; ++q) { if (!ok[q]) continue; const int m = m0 + q * NGW;
#pragma unroll
                for (int k = 0; k < 4; ++k) { const float p = pr[q][k];
#pragma unroll
                    for (int j = 0; j < 4; ++j) { const unsigned u = yv[q][k][j]; const f32x2 lo = __builtin_amdgcn_cvt_pk_f32_fp8(u, false), hi = __builtin_amdgcn_cvt_pk_f32_fp8(u, true);
                        v[q][j].x += p * lo.x; v[q][j].y += p * lo.y; v[q][j].z += p * hi.x; v[q][j].w += p * hi.y; } }
                float s = 0.f;
#pragma unroll
                for (int j = 0; j < 4; ++j) s += (v[q][j].x * v[q][j].x + v[q][j].y * v[q][j].y) + (v[q][j].z * v[q][j].z + v[q][j].w * v[q][j].w);
                const float rstd = 1.f / sqrtf(wave_sum(s) * (1.f / D) + EPS);
#pragma unroll
                for (int j = 0; j < 4; ++j) { const f32x4 gg = ((const GAS f32x4*)norm_final)[lane9 + 64 * j]; f32x4 y; y.x = v[q][j].x * rstd * gg.x; y.y = v[q][j].y * rstd * gg.y; y.z = v[q][j].z * rstd * gg.z; y.w = v[q][j].w * rstd * gg.w;
                    ((GAS f32x4*)(dst9 + (size_t)m * D) + lane9)[64 * j] = y; } }
        }
    }
#ifdef MK_TSTAMP
    if (MK_TSTAMP == 9) ts_b = __builtin_amdgcn_s_memrealtime();
    if (blockIdx.x == 0) { const unsigned long long dt = ts_b - ts_a, t0_ = __builtin_amdgcn_s_memrealtime();
        while (__builtin_amdgcn_s_memrealtime() - t0_ < 2 * dt) __builtin_amdgcn_s_sleep(8); }
#endif
#undef IN
#undef SEAM
}

extern "C" void kernel_launch(void* const* d_in, const int* in_sizes, int n_in, void* d_out, int out_size, void* d_ws, size_t ws_size, hipStream_t stream) {
    static int grid = 0;
    if (grid == 0) {
        if (n_in != 19 || in_sizes[0] != T * D || out_size != T * D || ws_size < WS_END) { fprintf(stderr, "kernel_launch: unexpected shapes (n_in %d, ws %zu); nothing launched\n", n_in, ws_size); grid = -1; return; }
        int dev = 0, cus = 0, per_cu = 0;
        if (hipGetDevice(&dev) != hipSuccess || hipDeviceGetAttribute(&cus, hipDeviceAttributeMultiprocessorCount, dev) != hipSuccess) { grid = -1; return; }
        if (hipFuncSetAttribute((const void*)mk_fwd, hipFuncAttributeMaxDynamicSharedMemorySize, LDS_BYTES) != hipSuccess) { fprintf(stderr, "kernel_launch: hipFuncSetAttribute failed\n"); grid = -1; return; }
        if (hipOccupancyMaxActiveBlocksPerMultiprocessor(&per_cu, (const void*)mk_fwd, NWAVES * 64, LDS_BYTES) != hipSuccess || per_cu < 1) { fprintf(stderr, "kernel_launch: occupancy query says %d blocks per CU\n", per_cu); }
        (void)hipGetLastError();
        grid = cus;
        if (grid != 256) fprintf(stderr, "kernel_launch: %d CUs (built and tuned for 256)\n", grid);
    }
    if (grid < 0) return;
    if (hipMemsetAsync((char*)d_ws + WS_CTL, 0, CTL_ZERO_BYTES, stream) != hipSuccess) return;
    Args a{};
    for (int i = 0; i < 19; ++i) a.in[i] = (const float*)d_in[i];
    a.out = (float*)d_out; a.ws = (unsigned char*)d_ws;
#if MK_MODE == 2
    a.ph_lo = 0; a.ph_hi = NPHASE; a.li = 0;
    hipLaunchKernelGGL(mk_fwd, dim3(grid), dim3(NWAVES * 64), LDS_BYTES, stream, a);
#else
    for (int ph = 0; ph < NPHASE; ++ph) { a.ph_lo = ph; a.ph_hi = ph + 1; a.li = ph; hipLaunchKernelGGL(mk_fwd, dim3(grid), dim3(NWAVES * 64), LDS_BYTES, stream, a); }
#endif
}
```

```cpp
#include <hip/hip_runtime.h>
#include <stdint.h>
#include <stdio.h>

#ifndef FP8_SP2
#define FP8_SP2 true
#endif
#ifndef MK_MODE
#define MK_MODE 2
#endif

typedef unsigned short bf16;
typedef short bf16x8 __attribute__((ext_vector_type(8)));
typedef float f32x4 __attribute__((ext_vector_type(4)));
typedef float f32x2 __attribute__((ext_vector_type(2)));
typedef unsigned u32x4 __attribute__((ext_vector_type(4)));
typedef unsigned u32x2 __attribute__((ext_vector_type(2)));
#define GAS __attribute__((address_space(1)))
#define LAS __attribute__((address_space(3)))
typedef GAS unsigned gu32;

constexpr int T = 16384, S = 8192, D = 1024, NPROJ = 5888, NQKV = 3840, NGATE = 2048, NE = 32, TOPK = 4;
constexpr int C_QA = 0, C_KA = 1024, C_VA = 1280, C_QB = 1536, C_KB = 2304, C_VB = 3072;
constexpr float EPS = 1e-5f;
constexpr size_t MiB = 1u << 20;
constexpr size_t WS_CTL = 0, CTL_ZERO_BYTES = 1 * MiB;
constexpr size_t WS_TAB = 1 * MiB;
constexpr size_t WS_WIN = 2 * MiB;
constexpr size_t WS_WA = 14 * MiB;
constexpr size_t WS_WB = 16 * MiB;
constexpr size_t WS_WOUT = 17 * MiB;
constexpr size_t WS_RT = 19 * MiB;
constexpr size_t WS_RTC = 20 * MiB;
constexpr size_t WS_WGU = 24 * MiB;
constexpr size_t WS_WD = 88 * MiB;
constexpr size_t WS_H2 = 120 * MiB;
constexpr size_t WS_HS = 136 * MiB;
constexpr size_t WS_ACT = 201 * MiB;
constexpr size_t WS_YS = 272 * MiB;
constexpr size_t WS_XN = 216 * MiB;
constexpr size_t WS_XNP = 312 * MiB;
constexpr size_t WS_K2 = 344 * MiB;
constexpr size_t WS_QKV = 248 * MiB;
constexpr size_t WS_GATES = 368 * MiB;
constexpr size_t WS_YA = 432 * MiB;
constexpr size_t WS_YB = 464 * MiB;
constexpr size_t WS_MERGED = 472 * MiB;
constexpr size_t WS_VT = 472 * MiB;
constexpr size_t WS_END = 506 * MiB;
constexpr int CW_CNT = 0;
constexpr int CW_BAR = 4096;

__device__ const unsigned char BKT_A[257] = {12,12,12,12,12,12,12,12,12,12,12,12,12,12,12,12,12,12,12,12,12,12,12,12,12,12,12,12,12,12,12,12,12,12,12,12,12,12,11,11,11,11,11,11,11,11,11,11,11,11,11,11,11,11,11,11,11,11,11,11,11,11,11,11,11,11,11,11,11,11,11,11,11,11,11,11,11,11,11,10,10,10,10,10,10,10,10,10,10,10,10,10,10,10,10,10,10,10,10,10,10,10,9,9,9,9,9,9,9,9,9,9,9,9,8,8,8,8,8,8,8,7,6,5,4,3,2,1,0,17,18,19,20,21,22,23,24,24,24,24,24,24,24,25,25,25,25,25,25,25,25,25,25,25,25,26,26,26,26,26,26,26,26,26,26,26,26,26,26,26,26,26,26,26,26,26,26,26,27,27,27,27,27,27,27,27,27,27,27,27,27,27,27,27,27,27,27,27,27,27,27,27,27,27,27,27,27,27,27,27,27,27,27,27,27,27,27,27,27,28,28,28,28,28,28,28,28,28,28,28,28,28,28,28,28,28,28,28,28,28,28,28,28,28,28,28,28,28,28,28,28,28,28,28,28,28,28};
__device__ const unsigned char BKT_B[3][129] = {
 {11,11,11,11,11,11,11,11,11,11,11,11,11,11,11,10,10,10,10,10,10,10,10,10,10,10,10,10,10,10,10,10,10,10,10,10,10,10,9,9,9,9,9,9,9,9,9,9,9,9,8,8,8,8,8,8,8,7,6,5,4,3,2,1,0,17,18,19,20,21,22,23,24,24,24,24,24,24,24,25,25,25,25,25,25,25,25,25,25,25,25,26,26,26,26,26,26,26,26,26,26,26,26,26,26,26,26,26,26,26,26,26,26,26,27,27,27,27,27,27,27,27,27,27,27,27,27,27,27},
 {13,13,13,13,13,13,13,13,13,13,13,13,13,13,13,13,13,13,13,13,13,13,13,12,12,12,12,12,12,12,12,12,12,12,12,12,12,12,12,12,12,12,11,11,11,11,11,11,11,11,11,11,10,10,10,10,10,10,9,9,9,8,8,4,0,20,24,24,25,25,25,26,26,26,26,26,26,27,27,27,27,27,27,27,27,27,27,28,28,28,28,28,28,28,28,28,28,28,28,28,28,28,28,28,28,28,29,29,29,29,29,29,29,29,29,29,29,29,29,29,29,29,29,29,29,29,29,29,29},
 {15,15,15,15,15,15,15,15,15,15,15,15,15,15,15,15,15,15,15,15,15,15,15,15,15,15,15,15,15,15,14,14,14,14,14,14,14,14,14,14,14,14,14,14,14,13,13,13,13,13,13,13,13,13,12,12,12,12,12,11,11,10,10,9,0,25,26,26,27,27,28,28,28,28,28,29,29,29,29,29,29,29,29,29,30,30,30,30,30,30,30,30,30,30,30,30,30,30,30,31,31,31,31,31,31,31,31,31,31,31,31,31,31,31,31,31,31,31,31,31,31,31,31,31,31,31,31,31,31}};

#define RLX_AGENT __ATOMIC_RELAXED, __HIP_MEMORY_SCOPE_AGENT
#define LDS_WAIT() asm volatile("s_waitcnt lgkmcnt(0)" ::: "memory")
#define VM_WAIT() asm volatile("s_waitcnt vmcnt(0)" ::: "memory")
__device__ __forceinline__ unsigned f2bf(float f) { unsigned u = __builtin_bit_cast(unsigned, f); return (u + 0x7fffu + ((u >> 16) & 1u)) >> 16; }
__device__ __forceinline__ unsigned pk2(float lo, float hi) { return f2bf(lo) | (f2bf(hi) << 16); }
__device__ __forceinline__ unsigned pk4_fp8(float a, float b, float c, float d) { unsigned w = 0; w = __builtin_amdgcn_cvt_pk_fp8_f32(a, b, w, false); w = __builtin_amdgcn_cvt_pk_fp8_f32(c, d, w, true); return w; }
__device__ __forceinline__ float bf2f(unsigned b) { return __builtin_bit_cast(float, b << 16); }
__device__ __forceinline__ float bflo(unsigned u) { return __builtin_bit_cast(float, u << 16); }
__device__ __forceinline__ float bfhi(unsigned u) { return __builtin_bit_cast(float, u & 0xffff0000u); }
__device__ __forceinline__ float wave_sum(float v) {
#pragma unroll
    for (int o = 1; o < 64; o <<= 1) v += __shfl_xor(v, o);
    return v;
}
__device__ __forceinline__ float sigm(float x) { return __builtin_amdgcn_rcpf(1.f + __builtin_amdgcn_exp2f(-1.4426950408889634f * x)); }

struct Tabs { float biasA[16][257]; float biasB[3][4][129]; };

namespace pg8 {
#define PG8_LAS __attribute__((address_space(3)))
typedef unsigned short bf16_t;
constexpr int BM = 256, BK = 64, HALF = 128, HTB = HALF * BK * 2, STAGE_BYTES = 8 * HTB, NXCD = 8, WGM = 8;
__host__ __device__ __forceinline__ int lds_byte(int r, int c) { const int st = (r >> 4) * 2 + (c >> 5), rr = r & 15, cc = c & 31, ob = rr * 64 + cc * 2; return st * 1024 + (ob ^ (((ob >> 9) & 1) << 5)); }
__host__ __device__ __forceinline__ void stage_rc(int b, int& R, int& C) { const int st = b / 1024, sb = b % 1024, swz = sb ^ (((sb >> 9) & 1) << 5); R = (st >> 1) * 16 + swz / 64; C = (st & 1) * 32 + (swz % 64) / 2; }
__host__ __device__ __forceinline__ int perm32(int rho) { const int n = rho >> 4, i = rho & 15; return 8 * (i >> 2) + 4 * n + (i & 3); }

struct Unit { int arow, brow, nrows, e, swap, aidx; };
struct Gemm { const bf16_t* A; const bf16_t* Bt; int K; const int* gidx; };

struct StaticOrder {
    int nM, nN, nwg, G, c;
    __device__ void init(int M, int N, int G_, int c_) { nM = M / BM; nN = N / BM; nwg = nM * nN; G = G_; c = c_; }
    __device__ bool next(int i, Unit& u) const {
        const long L = (long)i * G + c; if (L >= nwg) return false;
        int wgid = (int)L; { const int q = nwg / NXCD, r = nwg % NXCD, xcd = wgid % NXCD, off = wgid / NXCD; wgid = (xcd < r ? xcd * (q + 1) : r * (q + 1) + (xcd - r) * q) + off; }
        const int nig = WGM * nN, gid = wgid / nig, fm = gid * WGM, gsz = (nM - fm) < WGM ? (nM - fm) : WGM;
        u.arow = BM * (fm + ((wgid % nig) % gsz)); u.brow = BM * ((wgid % nig) / gsz); u.nrows = BM; u.e = 0; u.swap = 0; u.aidx = 0; return true;
    }
    __device__ __forceinline__ void a_ready(const Unit&) const {}
    __device__ __forceinline__ void done(const Unit&) const {}
};
constexpr int XNP_ROW0 = (int)((WS_XNP - WS_XN) / D);
struct ProjOrder {
    StaticOrder so;
    __device__ bool next(int i, Unit& u) const { if (!so.next(i, u)) return false;
        if (u.brow == C_VA || (u.brow >= C_VB && u.brow < NQKV)) { const int a = u.arow; u.arow = u.brow; u.brow = a; u.swap = 1; u.e = a;
            if (u.arow == C_VB + 256) u.brow += XNP_ROW0; else if (u.arow == C_VB + 512) u.brow += XNP_ROW0 + T; } return true; }
    __device__ __forceinline__ void a_ready(const Unit&) const {}
    __device__ __forceinline__ void done(const Unit&) const {}
};
struct GroupOrder {
    const PG8_LAS int* toff; const PG8_LAS int* off; int NT, G, c, nunits, cap;
    __device__ bool next(int i, Unit& u) const {
        int L;
        if (G & 7) { L = i * G + c; }
        else { const int q = (nunits + 7) >> 3, j = i * (G >> 3) + (c >> 3); if (j >= q) return false; L = (c & 7) * q + j; }
        if (L >= nunits) return false;
        const int mtg = L / NT, pn = L - mtg * NT;
        int e = 0;
        for (int j = 1; j < NE; ++j) e += (toff[j] <= mtg) ? 1 : 0;
        e = __builtin_amdgcn_readfirstlane(e);
        const int mt = mtg - __builtin_amdgcn_readfirstlane(toff[e]); const int o0 = __builtin_amdgcn_readfirstlane(off[e]), o1 = __builtin_amdgcn_readfirstlane(off[e + 1]);
        u.arow = o0 + BM * mt; const int rem = o1 - u.arow; u.nrows = rem < BM ? rem : BM; u.brow = (e * NT + pn) * BM; u.e = e; u.swap = 0; u.aidx = e * cap + BM * mt; return true;
    }
    __device__ __forceinline__ void a_ready(const Unit&) const {}
    __device__ __forceinline__ void done(const Unit&) const {}
};

__device__ __forceinline__ void st16_wt(void* p, u32x4 v) { asm volatile("global_store_dwordx4 %0, %1, off sc1\n\ts_nop 2" :: "v"(p), "v"(v) : "memory"); }
__device__ __forceinline__ void st8_wt(void* p, u32x2 v) { asm volatile("global_store_dwordx2 %0, %1, off sc1\n\ts_nop 2" :: "v"(p), "v"(v) : "memory"); }
__device__ __forceinline__ unsigned cvt_pk_bf16(float lo, float hi) { unsigned r; asm volatile("v_cvt_pk_bf16_f32 %0, %1, %2" : "=v"(r) : "v"(lo), "v"(hi)); return r; }

struct EpiProj {
    static constexpr bool PERM = true, AFTER_DRAIN = false; static constexpr int TAG = 1;
    bf16_t* qkv; bf16_t* gates; const float* bias; bf16_t* vta; bf16_t* vtb; unsigned char* k2;
    __device__ __forceinline__ void prefetch(const Unit& u, PG8_LAS unsigned char* slot, int wid, int lane) const {
        if (wid == 0) { int l4 = 4 * lane; asm volatile("" : "+v"(l4));
            __builtin_amdgcn_global_load_lds((const unsigned*)(bias + (u.swap ? u.arow : u.brow) + l4), (PG8_LAS unsigned*)slot, 16, 0, 0); } }
    __device__ __forceinline__ void operator()(const f32x4 (&acc)[2][2][4][2], const Unit& u, int wr, int wc, int fr, int fq, const PG8_LAS unsigned char* slot) const {
        if (!u.swap) {
            const int colt = u.brow; const bool isq = colt < NQKV; unsigned char* base = isq ? (unsigned char*)qkv : (unsigned char*)gates; const int ldc = isq ? NQKV : NGATE; const int cb = isq ? colt : colt - NQKV;
            const int row0 = u.arow + wr * 64 + fr, col0 = cb + wc * 32 + 8 * fq;
            const PG8_LAS f32x4* bl = (const PG8_LAS f32x4*)(slot + (wc * 32 + 8 * fq) * 4);
            const float qs = (colt < C_KA || (colt >= C_QB && colt < C_KB)) ? 0.125f * 1.4426950408889634f : 1.f;
            const bool isk = (colt == C_KA) || (colt >= C_KB && colt < C_VB);
            if (!isk) {
#pragma unroll
            for (int ai = 0; ai < 2; ++ai)
#pragma unroll
                for (int m = 0; m < 4; ++m) { unsigned char* rowp = base + (size_t)(row0 + ai * HALF + m * 16) * ldc + col0;
#pragma unroll
                    for (int bj = 0; bj < 2; ++bj) { const f32x4 v0 = (acc[ai][bj][m][0] + bl[bj * 32]) * qs, v1 = (acc[ai][bj][m][1] + bl[bj * 32 + 1]) * qs;
                        u32x2 w; w.x = pk4_fp8(v0[0], v0[1], v0[2], v0[3]); w.y = pk4_fp8(v1[0], v1[1], v1[2], v1[3]); *(u32x2*)(rowp + bj * HALF) = w; }
                    asm volatile("" ::: "memory"); }
            } else {
                const int gsel = (colt == C_KA) ? -1 : ((colt - C_KB) >> 8); const int sh = (gsel <= 0) ? 0 : (gsel == 1 ? 2 : 4);
                unsigned char* kb = k2 + (size_t)(gsel + 1) * (2 * 4 * 8192 * 64);
                int c0 = wc * 32 + 8 * fq; asm volatile("" : "+v"(c0));
#pragma unroll
                for (int ai = 0; ai < 2; ++ai)
#pragma unroll
                    for (int m = 0; m < 4; ++m) { const int row = row0 + ai * HALF + m * 16, b = row >> 13, sq = row & 8191; const int pos = ((sq & ((1 << sh) - 1)) << (13 - sh)) + (sq >> sh);
#pragma unroll
                        for (int bj = 0; bj < 2; ++bj) { const int c = c0 + bj * HALF; const f32x4 v0 = acc[ai][bj][m][0] + bl[bj * 32], v1 = acc[ai][bj][m][1] + bl[bj * 32 + 1];
                            u32x2 w; w.x = pk4_fp8(v0[0], v0[1], v0[2], v0[3]); w.y = pk4_fp8(v1[0], v1[1], v1[2], v1[3]);
                            *(u32x2*)(kb + ((size_t)((b * 4 + (c >> 6)) * 8192 + pos)) * 64 + (c & 63)) = w; }
                        asm volatile("" ::: "memory"); }
            }
        } else {
            const int colt = u.arow, tok0 = u.e; const int gsel = (colt == C_VA) ? -1 : ((colt - C_VB) >> 8); const int sh = (gsel <= 0) ? 0 : (gsel == 1 ? 2 : 4);
            bf16_t* vb = ((gsel < 0) ? vta : vtb + (size_t)gsel * (2 * 256 * 8192)) + (size_t)((tok0 >> 13) * 256) * 8192;
            const int mub = (tok0 & 8191) >> sh;
#pragma unroll
            for (int ai = 0; ai < 2; ++ai)
#pragma unroll
                for (int m = 0; m < 4; ++m) { const int c = ai * HALF + wr * 64 + m * 16 + fr; const float bvr = *(const PG8_LAS float*)(slot + c * 4); bf16_t* vrow = vb + (size_t)(c >> 6) * (64 * 8192) + (c & 63) * 32;
#pragma unroll
                    for (int bj = 0; bj < 2; ++bj) { const int j0 = bj * HALF + wc * 32 + 8 * fq;
                        const int rho = j0 >> (8 - sh), mu = mub + (j0 & ((256 >> sh) - 1));
                        const int p0 = ((rho << (8 - sh)) + (mu >> 5)) * 2048 + (((mu & 15) >> 2) << 3) + (((mu >> 4) & 1) << 2);
                        const f32x4 v0 = acc[ai][bj][m][0] + bvr, v1 = acc[ai][bj][m][1] + bvr;
                        u32x2 w0, w1; w0.x = cvt_pk_bf16(v0[0], v0[1]); w0.y = cvt_pk_bf16(v0[2], v0[3]); w1.x = cvt_pk_bf16(v1[0], v1[1]); w1.y = cvt_pk_bf16(v1[2], v1[3]);
                        *(u32x2*)(vrow + p0) = w0; *(u32x2*)(vrow + p0 + 8) = w1; }
                    asm volatile("" ::: "memory"); }
        }
    }
};
template <int MODE> struct EpiGate {
    static constexpr bool PERM = true, AFTER_DRAIN = false; static constexpr int TAG = 3;
    bf16_t* out; const bf16_t* gates; int gcol0; unsigned char* out8;
    __device__ __forceinline__ void prefetch(const Unit&, PG8_LAS unsigned char*, int, int) const {}
    __device__ __forceinline__ void operator()(const f32x4 (&acc)[2][2][4][2], const Unit& u, int wr, int wc, int fr, int fq, const PG8_LAS unsigned char*) const {
        const int row0 = u.arow + wr * 64 + fr, col0 = u.brow + wc * 32 + 8 * fq;
        u32x2 gv[8][2];
#pragma unroll
        for (int gi = 0; gi < 4; ++gi) { const size_t r = (size_t)(row0 + (gi >> 2) * HALF + (gi & 3) * 16);
#pragma unroll
            for (int bj = 0; bj < 2; ++bj) gv[gi][bj] = *(const u32x2*)((const unsigned char*)gates + r * NGATE + gcol0 + col0 + bj * HALF); }
        u32x4 mv[2], mn[2];
        if (MODE == 1) {
#pragma unroll
            for (int bj = 0; bj < 2; ++bj) mv[bj] = *(const u32x4*)(out + (size_t)row0 * D + col0 + bj * HALF); }
#pragma unroll
        for (int gi = 0; gi < 8; ++gi) { const int ai = gi >> 2, m = gi & 3; const size_t r = (size_t)(row0 + ai * HALF + m * 16);
            if (gi == 1) {
#pragma unroll
                for (int g2 = 4; g2 < 8; ++g2) { const size_t r2 = (size_t)(row0 + (g2 >> 2) * HALF + (g2 & 3) * 16);
#pragma unroll
                    for (int bj = 0; bj < 2; ++bj) gv[g2][bj] = *(const u32x2*)((const unsigned char*)gates + r2 * NGATE + gcol0 + col0 + bj * HALF); } }
            if (MODE == 1 && gi + 1 < 8) { const size_t rn = (size_t)(row0 + ((gi + 1) >> 2) * HALF + ((gi + 1) & 3) * 16);
#pragma unroll
                for (int bj = 0; bj < 2; ++bj) mn[bj] = *(const u32x4*)(out + rn * D + col0 + bj * HALF); }
#pragma unroll
            for (int bj = 0; bj < 2; ++bj) { const int c = col0 + bj * HALF; const u32x2 g4 = gv[gi][bj]; const f32x4 a0 = acc[ai][bj][m][0], a1 = acc[ai][bj][m][1];
                const f32x2 ga = __builtin_amdgcn_cvt_pk_f32_fp8(g4.x, false), gb = __builtin_amdgcn_cvt_pk_f32_fp8(g4.x, true), gc = __builtin_amdgcn_cvt_pk_f32_fp8(g4.y, false), gd = __builtin_amdgcn_cvt_pk_f32_fp8(g4.y, true);
                float o[8]; o[0] = sigm(ga.x) * a0[0]; o[1] = sigm(ga.y) * a0[1]; o[2] = sigm(gb.x) * a0[2]; o[3] = sigm(gb.y) * a0[3];
                o[4] = sigm(gc.x) * a1[0]; o[5] = sigm(gc.y) * a1[1]; o[6] = sigm(gd.x) * a1[2]; o[7] = sigm(gd.y) * a1[3];
                if (MODE == 1) { const u32x4 m4 = mv[bj];
                    o[0] += bflo(m4.x); o[1] += bfhi(m4.x); o[2] += bflo(m4.y); o[3] += bfhi(m4.y); o[4] += bflo(m4.z); o[5] += bfhi(m4.z); o[6] += bflo(m4.w); o[7] += bfhi(m4.w); }
                if (MODE == 1) { u32x2 w8; w8.x = pk4_fp8(o[0], o[1], o[2], o[3]); w8.y = pk4_fp8(o[4], o[5], o[6], o[7]); *(u32x2*)(out8 + r * D + c) = w8; }
                else { u32x4 w; w.x = cvt_pk_bf16(o[0], o[1]); w.y = cvt_pk_bf16(o[2], o[3]); w.z = cvt_pk_bf16(o[4], o[5]); w.w = cvt_pk_bf16(o[6], o[7]);
                    *(u32x4*)(out + r * D + c) = w; } }
            asm volatile("" ::: "memory");
            if (MODE == 1) {
#pragma unroll
                for (int bj = 0; bj < 2; ++bj) mv[bj] = mn[bj]; } }
    }
};
struct EpiX1 {
    static constexpr bool PERM = true, AFTER_DRAIN = false; static constexpr int TAG = 4;
    const float* x; float* out;
    __device__ __forceinline__ void prefetch(const Unit&, PG8_LAS unsigned char*, int, int) const {}
    __device__ __forceinline__ void operator()(const f32x4 (&acc)[2][2][4][2], const Unit& u, int wr, int wc, int fr, int fq, const PG8_LAS unsigned char*) const {
        const int row0 = u.arow + wr * 64 + fr, col0 = u.brow + wc * 32 + 8 * fq;
        f32x4 xv[2][2], xn[2][2];
#pragma unroll
        for (int bj = 0; bj < 2; ++bj) { const size_t o = (size_t)row0 * D + col0 + bj * HALF; xv[bj][0] = *(const f32x4*)(x + o); xv[bj][1] = *(const f32x4*)(x + o + 4); }
#pragma unroll
        for (int gi = 0; gi < 8; ++gi) { const int ai = gi >> 2, m = gi & 3; const size_t r = (size_t)(row0 + ai * HALF + m * 16);
            if (gi + 1 < 8) { const size_t rn = (size_t)(row0 + ((gi + 1) >> 2) * HALF + ((gi + 1) & 3) * 16);
#pragma unroll
                for (int bj = 0; bj < 2; ++bj) { const size_t o = rn * D + col0 + bj * HALF; xn[bj][0] = *(const f32x4*)(x + o); xn[bj][1] = *(const f32x4*)(x + o + 4); } }
#pragma unroll
            for (int bj = 0; bj < 2; ++bj) { const size_t o = r * D + col0 + bj * HALF;
                *(f32x4*)(out + o) = xv[bj][0] + acc[ai][bj][m][0]; *(f32x4*)(out + o + 4) = xv[bj][1] + acc[ai][bj][m][1]; }
            asm volatile("" ::: "memory");
#pragma unroll
            for (int bj = 0; bj < 2; ++bj) { xv[bj][0] = xn[bj][0]; xv[bj][1] = xn[bj][1]; } }
    }
};
struct EpiSwiglu {
    static constexpr bool PERM = true, AFTER_DRAIN = false; static constexpr int TAG = 7;
    unsigned char* act; const float* bg; const float* bu;
    __device__ __forceinline__ void prefetch(const Unit& u, PG8_LAS unsigned char* slot, int wid, int lane) const {
        if (wid == 0) { const int pn = (u.brow >> 8) & 7; const float* src = ((lane < 32) ? bg : bu) + (size_t)u.e * D + pn * HALF + 4 * (lane & 31);
            __builtin_amdgcn_global_load_lds((const unsigned*)src, (PG8_LAS unsigned*)slot, 16, 0, 0); } }
    __device__ __forceinline__ void operator()(const f32x4 (&acc)[2][2][4][2], const Unit& u, int wr, int wc, int fr, int fq, const PG8_LAS unsigned char* slot) const {
        const int pn = (u.brow >> 8) & 7; const int col0 = pn * HALF + wc * 32 + 8 * fq; const int rl0 = wr * 64 + fr;
        const PG8_LAS f32x4* bl = (const PG8_LAS f32x4*)(slot + (wc * 32 + 8 * fq) * 4);
        const f32x4 g0 = bl[0], g1 = bl[1], u0 = bl[32], u1 = bl[33];
#pragma unroll
        for (int ai = 0; ai < 2; ++ai)
#pragma unroll
            for (int m = 0; m < 4; ++m) { const int rl = rl0 + ai * HALF + m * 16;
                const f32x4 ga = acc[ai][0][m][0] + g0, gb = acc[ai][0][m][1] + g1, ua = acc[ai][1][m][0] + u0, ub = acc[ai][1][m][1] + u1;
                float o[8];
#pragma unroll
                for (int j = 0; j < 4; ++j) { const float gt = fminf(ga[j], 7.f), up = fminf(fmaxf(ua[j], -7.f), 7.f); o[j] = gt * sigm(1.702f * gt) * (up + 1.f);
                    const float gt2 = fminf(gb[j], 7.f), up2 = fminf(fmaxf(ub[j], -7.f), 7.f); o[4 + j] = gt2 * sigm(1.702f * gt2) * (up2 + 1.f); }
                u32x2 w; w.x = pk4_fp8(o[0], o[1], o[2], o[3]); w.y = pk4_fp8(o[4], o[5], o[6], o[7]);
                if (rl < u.nrows) *(u32x2*)(act + (size_t)(u.arow + rl) * D + col0) = w; }
    }
};
struct EpiDown {
    static constexpr bool PERM = true, AFTER_DRAIN = false; static constexpr int TAG = 8;
    unsigned char* ys; const float* bd;
    __device__ __forceinline__ void prefetch(const Unit& u, PG8_LAS unsigned char* slot, int wid, int lane) const {
        if (wid == 0) { const int pn = (u.brow >> 8) & 3; __builtin_amdgcn_global_load_lds((const unsigned*)(bd + (size_t)u.e * D + pn * BM + 4 * lane), (PG8_LAS unsigned*)slot, 16, 0, 0); } }
    __device__ __forceinline__ void operator()(const f32x4 (&acc)[2][2][4][2], const Unit& u, int wr, int wc, int fr, int fq, const PG8_LAS unsigned char* slot) const {
        const int pn = (u.brow >> 8) & 3; const int col0 = pn * BM + wc * 32 + 8 * fq; const int rl0 = wr * 64 + fr;
        f32x4 bv[2][2];
#pragma unroll
        for (int bj = 0; bj < 2; ++bj)
#pragma unroll
            for (int n = 0; n < 2; ++n) bv[bj][n] = *(const PG8_LAS f32x4*)(slot + (wc * 32 + 8 * fq + bj * HALF + 4 * n) * 4);
#pragma unroll
        for (int ai = 0; ai < 2; ++ai)
#pragma unroll
            for (int m = 0; m < 4; ++m) { const int rl = rl0 + ai * HALF + m * 16; unsigned char* rowp = ys + (size_t)(u.arow + rl) * D + col0;
#pragma unroll
                for (int bj = 0; bj < 2; ++bj) { const f32x4 v0 = acc[ai][bj][m][0] + bv[bj][0], v1 = acc[ai][bj][m][1] + bv[bj][1];
                    u32x2 w; w.x = pk4_fp8(v0[0], v0[1], v0[2], v0[3]); w.y = pk4_fp8(v1[0], v1[1], v1[2], v1[3]);
                    if (rl < u.nrows) *(u32x2*)(rowp + bj * HALF) = w; } }
    }
};

typedef int i32x4_t __attribute__((ext_vector_type(4))); typedef int i32x8_t __attribute__((ext_vector_type(8)));
template <bool FP8> struct Frag;
template <> struct Frag<false> { bf16x8 v[2];
    __device__ __forceinline__ void ld(const PG8_LAS unsigned char* p) { v[0] = *(const PG8_LAS bf16x8*)p; v[1] = *(const PG8_LAS bf16x8*)(p + 1024); } };
template <> struct Frag<true> { i32x8_t v;
    __device__ __forceinline__ void ld(const PG8_LAS unsigned char* p) { const i32x4_t lo = *(const PG8_LAS i32x4_t*)p, hi = *(const PG8_LAS i32x4_t*)(p + 1024); v = __builtin_shufflevector(lo, hi, 0, 1, 2, 3, 4, 5, 6, 7); } };
__device__ __forceinline__ f32x4 mma_frag(const Frag<false>& w, const Frag<false>& x, f32x4 c) {
    c = __builtin_amdgcn_mfma_f32_16x16x32_bf16(w.v[0], x.v[0], c, 0, 0, 0); return __builtin_amdgcn_mfma_f32_16x16x32_bf16(w.v[1], x.v[1], c, 0, 0, 0); }
__device__ __forceinline__ f32x4 mma_frag(const Frag<true>& w, const Frag<true>& x, f32x4 c) {
    const int sa = 0x7A7A7A7A, sb = 0x7F7F7F7F;
    asm volatile("v_mfma_scale_f32_16x16x128_f8f6f4 %0, %1, %2, %0, %3, %4 op_sel_hi:[0,0,0]" : "+v"(c) : "v"(w.v), "v"(x.v), "v"(sa), "v"(sb));
    return c; }
template <class Epi, class Sched, bool ALIGN_EPI = false, bool SP2 = false, bool FP8 = false, bool GA = false>
__device__ __forceinline__ void gemm_phase(PG8_LAS unsigned char* lds, const Gemm g, const Sched& S, const Epi& E) {
    const int tid = threadIdx.x, wid = __builtin_amdgcn_readfirstlane(tid >> 6), lane = tid & 63, wr = wid >> 2, wc = wid & 3, fr = lane & 15, fq = lane >> 4;
    const int K = g.K, nt = K / BK;
    unsigned voffA[2], voffB[2];
#pragma unroll
    for (int i = 0; i < 2; ++i) { int R, C; stage_rc(tid * 16 + i * 8192, R, C); const int Rb = Epi::PERM ? ((R & ~31) + perm32(R & 31)) : R;
        voffA[i] = (unsigned)(R * K + C) * 2u; voffB[i] = (unsigned)(Rb * K + C) * 2u; }
    static_assert(!GA || SP2, "gather is wired into the two-super-phase loop only");
    unsigned vAc[2][2], vAn[2][2];
#pragma unroll
    for (int h = 0; h < 2; ++h)
#pragma unroll
        for (int i = 0; i < 2; ++i) { vAc[h][i] = voffA[i]; vAn[h][i] = voffA[i]; }
    PG8_LAS unsigned char* const ilds = lds + 131072 + 4096 + 2048;
    auto gather_off = [&](int i, unsigned idx) -> unsigned { int R, C; stage_rc(tid * 16 + i * 8192, R, C); idx = idx < (unsigned)T ? idx : (unsigned)(T - 1); return idx * (unsigned)(K * 2) + (unsigned)C * 2u; };
    auto piece_row = [&](int i) -> int { int R, C; stage_rc(tid * 16 + i * 8192, R, C); return R; };
    const size_t kstep = (size_t)(BK * 2);
    const size_t hstep = (size_t)HALF * K * 2;
    const size_t rowb = (size_t)K * 2;
    const size_t hstepA = GA ? 0 : hstep;
    const unsigned ldsw = (unsigned)wid * 1024u;
    const int aoff = lds_byte(wr * 64 + fr, fq * 8), boff = lds_byte(wc * 32 + fr, fq * 8);
#define PG8_SA(b, h) (((b) * 2 + (h)) * HTB)
#define PG8_SB(b, h) ((4 + (b) * 2 + (h)) * HTB)
#define PG8_STAGE(bufoff, gbase, voff) do { _Pragma("unroll") for (int _i = 0; _i < 2; ++_i) \
        __builtin_amdgcn_global_load_lds((const unsigned*)((const char*)(gbase) + (voff)[_i]), (PG8_LAS unsigned*)(lds + (bufoff) + ldsw + _i * 8192), 16, 0, 0); } while (0)
#define PG8_LDA(dst, b, h) do { _Pragma("unroll") for (int m = 0; m < 4; ++m) dst[m].ld(lds + PG8_SA(b, h) + aoff + m * 2048); } while (0)
#define PG8_LDB(dst, b, h) do { _Pragma("unroll") for (int n = 0; n < 2; ++n) dst[n].ld(lds + PG8_SB(b, h) + boff + n * 2048); } while (0)
#define PG8_MMA(ai, bj, At, Bt) do { __builtin_amdgcn_s_setprio(1); _Pragma("unroll") for (int m = 0; m < 4; ++m) _Pragma("unroll") for (int n = 0; n < 2; ++n) \
        acc[ai][bj][m][n] = mma_frag(Bt[n], At[m], acc[ai][bj][m][n]); __builtin_amdgcn_s_setprio(0); } while (0)
#define PG8_WAIT_V(n) asm volatile("s_waitcnt vmcnt(" #n ")" ::: "memory")
#define PG8_WAIT_L(n) asm volatile("s_waitcnt lgkmcnt(" #n ")" ::: "memory")
#define PG8_BAR __builtin_amdgcn_s_barrier()
#define PG8_SCHED __builtin_amdgcn_sched_barrier(0)
    Unit cur, nxt; int ui = 0;
    if (!S.next(0, cur)) return;
    f32x4 acc[2][2][4][2];
#pragma unroll
    for (int a = 0; a < 2; ++a)
#pragma unroll
        for (int b = 0; b < 2; ++b)
#pragma unroll
            for (int m = 0; m < 4; ++m)
#pragma unroll
                for (int n = 0; n < 2; ++n) acc[a][b][m][n] = (f32x4){0.f, 0.f, 0.f, 0.f};
    Frag<FP8> At[4], B0[2], B1[2];
    const char* cA = (const char*)(cur.swap ? g.Bt : g.A) + (size_t)cur.arow * rowb; const char* cB = (const char*)(cur.swap ? g.A : g.Bt) + (size_t)cur.brow * rowb;
    if constexpr (GA) { cA = (const char*)g.A;
#pragma unroll
        for (int h = 0; h < 2; ++h)
#pragma unroll
            for (int i = 0; i < 2; ++i) { vAc[h][i] = gather_off(i, (unsigned)g.gidx[cur.aidx + h * HALF + piece_row(i)]); vAn[h][i] = vAc[h][i]; } }
    S.a_ready(cur);
    PG8_LAS unsigned char* const blds = lds + 131072 + 4096;
    E.prefetch(cur, blds, wid, lane);
    if constexpr (SP2) {
        PG8_STAGE(PG8_SB(0, 0), cB, voffB); PG8_STAGE(PG8_SB(0, 1), cB + hstep, voffB); PG8_STAGE(PG8_SA(0, 0), cA, vAc[0]); PG8_STAGE(PG8_SA(0, 1), cA + hstepA, vAc[1]);
        if (wr == 1) PG8_BAR;
        PG8_WAIT_V(2); PG8_BAR;
        PG8_STAGE(PG8_SB(1, 0), cB + kstep, voffB); PG8_STAGE(PG8_SA(1, 0), cA + kstep, vAc[0]); PG8_STAGE(PG8_SB(1, 1), cB + hstep + kstep, voffB);
        PG8_WAIT_V(6); PG8_BAR;
    } else {
        PG8_STAGE(PG8_SB(0, 0), cB, voffB); PG8_STAGE(PG8_SA(0, 0), cA, voffA); PG8_STAGE(PG8_SB(0, 1), cB + hstep, voffB); PG8_STAGE(PG8_SA(0, 1), cA + hstep, voffA);
        if (wr == 1) PG8_BAR;
        PG8_WAIT_V(4); PG8_BAR;
        PG8_STAGE(PG8_SB(1, 0), cB + kstep, voffB); PG8_STAGE(PG8_SA(1, 0), cA + kstep, voffA); PG8_STAGE(PG8_SB(1, 1), cB + hstep + kstep, voffB);
        PG8_WAIT_V(6); PG8_BAR;
    }
    for (;;) {
        const bool has_next = S.next(ui + 1, nxt);
        const char* nA = (has_next && !GA) ? (const char*)(nxt.swap ? g.Bt : g.A) + (size_t)nxt.arow * rowb : cA; const char* nB = has_next ? (const char*)(nxt.swap ? g.A : g.Bt) + (size_t)nxt.brow * rowb : cB;
        for (int t = 0; t < nt; t += 2) {
            const bool last = (t == nt - 2);
            const char* a1 = cA + (size_t)(t + 1) * kstep;
            const char* a2 = last ? nA : cA + (size_t)(t + 2) * kstep; const char* b2 = last ? nB : cB + (size_t)(t + 2) * kstep;
            const char* a3 = a2 + kstep; const char* b3 = b2 + kstep;
            if (last && has_next) { S.a_ready(nxt); E.prefetch(nxt, blds + (((ui + 1) & 1) << 10), wid, lane); }
            if constexpr (GA) {
                if (t == nt - 4 && has_next && wid == 0) { int l4 = 4 * lane; asm volatile("" : "+v"(l4));
                    __builtin_amdgcn_global_load_lds((const unsigned*)(g.gidx + nxt.aidx + l4), (PG8_LAS unsigned*)(ilds + (((ui + 1) & 1) << 10)), 16, 0, 0); }
                if (last && has_next) { const PG8_LAS unsigned* il = (const PG8_LAS unsigned*)(ilds + (((ui + 1) & 1) << 10));
#pragma unroll
                    for (int h = 0; h < 2; ++h)
#pragma unroll
                        for (int i = 0; i < 2; ++i) vAn[h][i] = gather_off(i, il[h * HALF + piece_row(i)]); }
            }
            unsigned v2[2][2];
#pragma unroll
            for (int h = 0; h < 2; ++h)
#pragma unroll
                for (int i = 0; i < 2; ++i) v2[h][i] = last ? vAn[h][i] : vAc[h][i];
            if constexpr (SP2) {
            PG8_LDB(B0, 0, 0); PG8_LDB(B1, 0, 1); PG8_SCHED; PG8_LDA(At, 0, 0); PG8_STAGE(PG8_SA(1, 1), a1 + hstepA, vAc[1]);
            PG8_WAIT_V(8); PG8_WAIT_L(0); PG8_BAR; PG8_MMA(0, 0, At, B0); PG8_MMA(0, 1, At, B1); PG8_BAR; PG8_SCHED;
            PG8_LDA(At, 0, 1); PG8_STAGE(PG8_SB(0, 0), b2, voffB); PG8_STAGE(PG8_SB(0, 1), b2 + hstep, voffB); PG8_STAGE(PG8_SA(0, 0), a2, v2[0]);
            PG8_WAIT_V(8); PG8_WAIT_L(0); PG8_BAR; PG8_MMA(1, 0, At, B0); PG8_MMA(1, 1, At, B1); PG8_BAR; PG8_SCHED;
            PG8_LDB(B0, 1, 0); PG8_LDB(B1, 1, 1); PG8_SCHED; PG8_LDA(At, 1, 0); PG8_STAGE(PG8_SA(0, 1), a2 + hstepA, v2[1]);
            PG8_WAIT_V(8); PG8_WAIT_L(0); PG8_BAR; PG8_MMA(0, 0, At, B0); PG8_MMA(0, 1, At, B1); PG8_BAR; PG8_SCHED;
            PG8_LDA(At, 1, 1); PG8_STAGE(PG8_SB(1, 0), b3, voffB); PG8_STAGE(PG8_SB(1, 1), b3 + hstep, voffB); PG8_STAGE(PG8_SA(1, 0), a3, v2[0]);
            PG8_WAIT_V(8); PG8_WAIT_L(0); PG8_BAR; PG8_MMA(1, 0, At, B0); PG8_MMA(1, 1, At, B1); PG8_BAR; PG8_SCHED;
            } else {
            PG8_LDB(B0, 0, 0); PG8_SCHED; PG8_LDA(At, 0, 0); PG8_STAGE(PG8_SA(1, 1), a1 + hstep, voffA);
            PG8_WAIT_L(8); PG8_BAR; PG8_WAIT_L(0); PG8_MMA(0, 0, At, B0); PG8_BAR; PG8_SCHED;
            PG8_LDB(B1, 0, 1); PG8_STAGE(PG8_SB(0, 0), b2, voffB);
            PG8_BAR; PG8_WAIT_L(0); PG8_MMA(0, 1, At, B1); PG8_BAR;
            PG8_LDA(At, 0, 1); PG8_STAGE(PG8_SA(0, 0), a2, voffA);
            PG8_BAR; PG8_WAIT_L(0); PG8_MMA(1, 0, At, B0); PG8_BAR; PG8_SCHED;
            PG8_STAGE(PG8_SB(0, 1), b2 + hstep, voffB);
            PG8_WAIT_V(6); PG8_BAR; PG8_MMA(1, 1, At, B1); PG8_BAR;
            PG8_LDB(B0, 1, 0); PG8_SCHED; PG8_LDA(At, 1, 0); PG8_STAGE(PG8_SA(0, 1), a2 + hstep, voffA);
            PG8_WAIT_L(8); PG8_BAR; PG8_WAIT_L(0); PG8_MMA(0, 0, At, B0); PG8_BAR; PG8_SCHED;
            PG8_LDB(B1, 1, 1); PG8_STAGE(PG8_SB(1, 0), b3, voffB);
            PG8_BAR; PG8_WAIT_L(0); PG8_MMA(0, 1, At, B1); PG8_BAR;
            PG8_LDA(At, 1, 1); PG8_STAGE(PG8_SA(1, 0), a3, voffA);
            PG8_BAR; PG8_WAIT_L(0); PG8_MMA(1, 0, At, B0); PG8_BAR; PG8_SCHED;
            PG8_STAGE(PG8_SB(1, 1), b3 + hstep, voffB);
            PG8_WAIT_V(6); PG8_BAR; PG8_MMA(1, 1, At, B1); PG8_BAR;
            }
        }
        if constexpr (ALIGN_EPI) { if (wr == 0) PG8_BAR; }
        if constexpr (FP8) {
#define PG8_ACC8(a, b) "+v"(acc[a][b][0][0]), "+v"(acc[a][b][0][1]), "+v"(acc[a][b][1][0]), "+v"(acc[a][b][1][1]), "+v"(acc[a][b][2][0]), "+v"(acc[a][b][2][1]), "+v"(acc[a][b][3][0]), "+v"(acc[a][b][3][1])
            asm volatile("s_nop 15\n\ts_nop 15" : PG8_ACC8(0, 0), PG8_ACC8(0, 1) :: "memory");
            asm volatile("" : PG8_ACC8(1, 0), PG8_ACC8(1, 1) :: "memory");
#undef PG8_ACC8
        }
#ifdef MK_EPI2
        if constexpr (Epi::TAG == MK_EPI2) { E(acc, cur, wr, wc, fr, fq, blds + ((ui & 1) << 10)); asm volatile("" ::: "memory"); }
#endif
        if constexpr (!Epi::AFTER_DRAIN) { E(acc, cur, wr, wc, fr, fq, blds + ((ui & 1) << 10)); S.done(cur); }
        if (!has_next) break;
#pragma unroll
        for (int a = 0; a < 2; ++a)
#pragma unroll
            for (int b = 0; b < 2; ++b)
#pragma unroll
                for (int m = 0; m < 4; ++m)
#pragma unroll
                    for (int n = 0; n < 2; ++n) acc[a][b][m][n] = (f32x4){0.f, 0.f, 0.f, 0.f};
        cur = nxt; cA = nA; cB = nB; ++ui;
        if constexpr (GA) {
#pragma unroll
            for (int h = 0; h < 2; ++h)
#pragma unroll
                for (int i = 0; i < 2; ++i) vAc[h][i] = vAn[h][i]; }
        if constexpr (ALIGN_EPI) { if (wr == 1) PG8_BAR; }
    }
    PG8_WAIT_V(0);
    if constexpr (!ALIGN_EPI) { if (wr == 0) PG8_BAR; }
    PG8_BAR;
    if constexpr (Epi::AFTER_DRAIN) { E.fused(acc, cur, wr, wc, fr, fq, lds, wid, lane); S.done(cur); }
#undef PG8_SA
#undef PG8_SB
#undef PG8_STAGE
#undef PG8_LDA
#undef PG8_LDB
#undef PG8_MMA
#undef PG8_WAIT_V
#undef PG8_WAIT_L
#undef PG8_BAR
#undef PG8_SCHED
}

}

#define XB_TMO      128
#define XB_XCNT(j)  (256  + 64 * (j))
#define XB_XSUB(j)  (1280 + 64 * (j))
#define XB_XGEN(j)  (2304 + 64 * (j))
#define XB_TOP      3328
#define XB_TOPGEN   3392
#define XCD_BAR_WORDS 3456
#define XB_SPIN_CAP (1u << 18)
__device__ __forceinline__ unsigned xb_ld(unsigned* p)              { return __hip_atomic_load(p, __ATOMIC_RELAXED, __HIP_MEMORY_SCOPE_AGENT); }
__device__ __forceinline__ unsigned xb_add(unsigned* p, unsigned v) { return __hip_atomic_fetch_add(p, v, __ATOMIC_RELAXED, __HIP_MEMORY_SCOPE_AGENT); }
__device__ __forceinline__ unsigned xb_xcc_id() { return (unsigned)__builtin_amdgcn_s_getreg((3 << 11) | 20) & 0xFu; }
#define XB_SPIN(cond, bar) do { unsigned _sp = 0; while (cond) { __builtin_amdgcn_s_sleep(1); \
    if ((++_sp & 255u) == 0u) { if (xb_ld(&(bar)[XB_TMO])) break; if (_sp > XB_SPIN_CAP) { atomicAdd(&(bar)[XB_TMO], 1u); break; } } } } while (0)
struct XcdBarrier { unsigned* bar; unsigned x; volatile LAS unsigned* st; };
__device__ __forceinline__ XcdBarrier xcd_barrier_post(unsigned* bar, volatile LAS unsigned* st) {
    XcdBarrier b; b.bar = bar; b.x = xb_xcc_id(); b.st = st;
    if (threadIdx.x == 0) (void)xb_add(&bar[XB_XCNT(b.x)], 1u);
    return b;
}
__device__ __forceinline__ void xcd_barrier_complete(unsigned* bar, unsigned x, unsigned& nloc, unsigned& nx) {
    const unsigned G = gridDim.x * gridDim.y * gridDim.z;
    unsigned sum, cnt, mine, sp = 0u;
    for (;;) {
        sum = 0u; cnt = 0u; mine = 0u;
#pragma unroll
        for (unsigned j = 0; j < 16; ++j) { const unsigned c = xb_ld(&bar[XB_XCNT(j)]); sum += c; cnt += (c > 0u) ? 1u : 0u; mine = (j == x) ? c : mine; }
        if (sum == G) break;
        __builtin_amdgcn_s_sleep(1);
        if ((++sp & 255u) == 0u) { if (xb_ld(&bar[XB_TMO])) break; if (sp > XB_SPIN_CAP) { atomicAdd(&bar[XB_TMO], 1u); break; } }
    }
    nloc = mine > 0u ? mine : 1u; nx = cnt > 0u ? cnt : 1u;
}
__device__ __forceinline__ void xcd_barrier(const XcdBarrier& b) {
    asm volatile("s_waitcnt vmcnt(0)" ::: "memory");
    __syncthreads();
    if (threadIdx.x == 0) {
        unsigned* bar = b.bar;
        __builtin_amdgcn_s_waitcnt(0);
        unsigned nloc = b.st[0], nx = b.st[1];
        if (nloc == 0u) { xcd_barrier_complete(bar, b.x, nloc, nx); b.st[0] = nloc; b.st[1] = nx; }
        const unsigned old = xb_add(&bar[XB_XSUB(b.x)], 1u);
        const unsigned gen = old / nloc;
        if (old + 1u == (gen + 1u) * nloc) {
            __builtin_amdgcn_fence(__ATOMIC_RELEASE, "agent");
            asm volatile("s_waitcnt vmcnt(0)" ::: "memory");
            const unsigned og = xb_add(&bar[XB_TOP], 1u);
            const unsigned tg = og / nx;
            if (og + 1u == (tg + 1u) * nx) xb_add(&bar[XB_TOPGEN], 1u);
            else XB_SPIN(xb_ld(&bar[XB_TOPGEN]) == tg, bar);
            __builtin_amdgcn_fence(__ATOMIC_ACQUIRE, "agent");
            xb_add(&bar[XB_XGEN(b.x)], 1u);
            asm volatile("s_waitcnt vmcnt(0)" ::: "memory");
        } else {
            XB_SPIN(xb_ld(&bar[XB_XGEN(b.x)]) == gen, bar);
            __builtin_amdgcn_fence(__ATOMIC_ACQUIRE, "agent");
            asm volatile("s_waitcnt vmcnt(0)" ::: "memory");
        }
    }
    __syncthreads();
}

constexpr int NWAVES = 8;
constexpr int RING_OFF = 0, RING_BYTES = 131072;
constexpr int LDSCTL_OFF = RING_BYTES, MISC_OFF = LDSCTL_OFF + 320;
constexpr int TBL_OFF = LDSCTL_OFF + 1024;
constexpr int LDS_BYTES = 147456;

struct Frame {
    LAS unsigned char* lds; volatile LAS unsigned* MISC; LAS int* tbl; gu32* ctl;
    int tid, lane, wave, vcu, G;
};

__device__ __forceinline__ void p0_transpose_item(const float* W, int K, int N, bf16* WT, int k0, int n0, int orow0, LAS float* scr, int lane) {
#pragma unroll 8
    for (int i = 0; i < 32; ++i) { const int kk = 2 * i + (lane >> 5); scr[kk * 33 + (lane & 31)] = W[(size_t)(k0 + kk) * N + n0 + (lane & 31)]; }
    LDS_WAIT(); asm volatile("" ::: "memory");
    const int c = lane & 7;
#pragma unroll
    for (int j = 0; j < 4; ++j) { const int n = (lane >> 3) + 8 * j; const LAS float* s = scr + (8 * c) * 33 + n;
        u32x4 o; o.x = pk2(s[0 * 33], s[1 * 33]); o.y = pk2(s[2 * 33], s[3 * 33]); o.z = pk2(s[4 * 33], s[5 * 33]); o.w = pk2(s[6 * 33], s[7 * 33]);
        *(GAS u32x4*)(WT + (size_t)(orow0 + n) * K + k0 + 8 * c) = o; }
    LDS_WAIT(); asm volatile("" ::: "memory");
}
__device__ __forceinline__ void p0_transpose_item_fp8(const float* W, int K, int N, unsigned char* WT, int k0, int n0, int orow0, LAS float* scr, int lane) {
#pragma unroll 8
    for (int i = 0; i < 32; ++i) { const int kk = 2 * i + (lane >> 5); scr[kk * 33 + (lane & 31)] = W[(size_t)(k0 + kk) * N + n0 + (lane & 31)]; }
    LDS_WAIT(); asm volatile("" ::: "memory");
    const int c = lane & 7;
#pragma unroll
    for (int j = 0; j < 4; ++j) { const int n = (lane >> 3) + 8 * j; const LAS float* sp = scr + (8 * c) * 33 + n;
        u32x2 o; o.x = pk4_fp8(sp[0 * 33] * 32.f, sp[1 * 33] * 32.f, sp[2 * 33] * 32.f, sp[3 * 33] * 32.f); o.y = pk4_fp8(sp[4 * 33] * 32.f, sp[5 * 33] * 32.f, sp[6 * 33] * 32.f, sp[7 * 33] * 32.f);
        *(GAS u32x2*)(WT + (size_t)(orow0 + n) * K + k0 + 8 * c) = o; }
    LDS_WAIT(); asm volatile("" ::: "memory");
}
__device__ __forceinline__ void rms_row_to_bf16(const float* xrow, const float* g, bf16* orow, int lane) {
    const GAS f32x4* xr = (const GAS f32x4*)xrow + lane; f32x4 v[4]; float s = 0.f;
#pragma unroll
    for (int j = 0; j < 4; ++j) { v[j] = xr[64 * j]; s += (v[j].x * v[j].x + v[j].y * v[j].y) + (v[j].z * v[j].z + v[j].w * v[j].w); }
    const float rstd = 1.f / sqrtf(wave_sum(s) * (1.f / D) + EPS);
    GAS unsigned long long* o8 = (GAS unsigned long long*)orow + lane;
#pragma unroll
    for (int j = 0; j < 4; ++j) { const f32x4 gg = ((const GAS f32x4*)g)[lane + 64 * j];
        o8[64 * j] = (unsigned long long)pk2(v[j].x * rstd * gg.x, v[j].y * rstd * gg.y) | ((unsigned long long)pk2(v[j].z * rstd * gg.z, v[j].w * rstd * gg.w) << 32); }
}

__device__ __forceinline__ void rms_row_to_fp8(const float* xrow, const float* g, unsigned char* orow, unsigned char* orow4, unsigned char* orow16, int lane) {
    const GAS f32x4* xr = (const GAS f32x4*)xrow + lane; f32x4 v[4]; float s = 0.f;
#pragma unroll
    for (int j = 0; j < 4; ++j) { v[j] = xr[64 * j]; s += (v[j].x * v[j].x + v[j].y * v[j].y) + (v[j].z * v[j].z + v[j].w * v[j].w); }
    const float rstd = 1.f / sqrtf(wave_sum(s) * (1.f / D) + EPS);
    GAS unsigned* o4 = (GAS unsigned*)orow + lane; GAS unsigned* p4 = (GAS unsigned*)orow4 + lane; GAS unsigned* p16 = (GAS unsigned*)orow16 + lane;
#pragma unroll
    for (int j = 0; j < 4; ++j) { const f32x4 gg = ((const GAS f32x4*)g)[lane + 64 * j]; const unsigned w = pk4_fp8(v[j].x * rstd * gg.x, v[j].y * rstd * gg.y, v[j].z * rstd * gg.z, v[j].w * rstd * gg.w);
        o4[64 * j] = w; p4[64 * j] = w; p16[64 * j] = w; }
}
constexpr float LOG2E = 1.4426950408889634f;
typedef __bf16 bf16x2_t __attribute__((ext_vector_type(2)));
__device__ __forceinline__ unsigned cvtpk_v(float lo, float hi) { const f32x2 v = {lo, hi}; const bf16x2_t b = __builtin_convertvector(v, bf16x2_t); return __builtin_bit_cast(unsigned, b); }
typedef long longx2 __attribute__((ext_vector_type(2)));
struct AttFrags { longx2 k0, k1; bf16x8 v[4]; };
__device__ __forceinline__ float gmax4(float m) {
    { auto rr = __builtin_amdgcn_permlane16_swap(__float_as_uint(m), __float_as_uint(m), false, false); m = fmaxf(__uint_as_float(rr[0]), __uint_as_float(rr[1])); }
    { auto rr = __builtin_amdgcn_permlane32_swap(__float_as_uint(m), __float_as_uint(m), false, false); m = fmaxf(__uint_as_float(rr[0]), __uint_as_float(rr[1])); }
    return m;
}
constexpr int RB_A = 160, RB_B = 320;
template <int NH, int RB>
__device__ __forceinline__ void band_group(f32x4 (&o)[NH][4], float (&mrun)[NH], float (&lrun)[NH], const unsigned char* qkvb, const int (&qcol)[NH], const int (&qmu0)[NH], const unsigned char* kh, const bf16* vt,
                                           int dil, int rho, int L, int qstep, int P0, int npairs, const LAS float* const (&tab)[NH], int lane) {
    const int t = lane & 15, g = lane >> 4;
    longx2 qf[NH]; int mu_t[NH];
#pragma unroll
    for (int h = 0; h < NH; ++h) { mu_t[h] = qmu0[h] + qstep * t; qf[h] = *(const longx2*)(qkvb + (size_t)(mu_t[h] * dil + rho) * NQKV + 16 * g + qcol[h]); }
    const int npr = L >> 5;
    const unsigned char* kbase = kh + ((size_t)rho * L) * 64 + 16 * g;
    const bf16* vtl = vt + (size_t)(rho * npr) * 2048 + t * 32 + 8 * g;
    auto load = [&](int P, AttFrags& f) {
        const int Pc = min(max(P, 0), npr - 1);
        const unsigned char* k0p = kbase + (size_t)(32 * Pc + t) * 64; const unsigned char* k1p = k0p + 16 * 64;
        f.k0 = *(const longx2*)k0p; f.k1 = *(const longx2*)k1p;
#pragma unroll
        for (int db = 0; db < 4; ++db) f.v[db] = *(const bf16x8*)(vtl + (size_t)Pc * 2048 + db * 512);
    };
    AttFrags cur; load(P0, cur);
    for (int pp = 0; pp < npairs; ++pp) {
        const int P = P0 + pp;
        AttFrags nxt; load(P0 + min(pp + 1, npairs - 1), nxt);
        if (P >= 0 && P < npr) {
            const int kap0 = 32 * P + 4 * g;
#pragma unroll
            for (int h = 0; h < NH; ++h) {
                const LAS float* tb_ = tab[h] + (kap0 - mu_t[h] + RB);
                f32x4 s0 = (f32x4){tb_[0], tb_[1], tb_[2], tb_[3]}, s1 = (f32x4){tb_[16], tb_[17], tb_[18], tb_[19]};
                s0 = __builtin_amdgcn_mfma_f32_16x16x32_fp8_fp8(cur.k0.x, qf[h].x, s0, 0, 0, 0); s0 = __builtin_amdgcn_mfma_f32_16x16x32_fp8_fp8(cur.k0.y, qf[h].y, s0, 0, 0, 0);
                s1 = __builtin_amdgcn_mfma_f32_16x16x32_fp8_fp8(cur.k1.x, qf[h].x, s1, 0, 0, 0); s1 = __builtin_amdgcn_mfma_f32_16x16x32_fp8_fp8(cur.k1.y, qf[h].y, s1, 0, 0, 0);
                float mx = fmaxf(fmaxf(fmaxf(s0[0], s0[1]), fmaxf(s0[2], s0[3])), fmaxf(fmaxf(s1[0], s1[1]), fmaxf(s1[2], s1[3])));
                mx = gmax4(mx);
                if (__any(mx > mrun[h])) { const float mn = fmaxf(mrun[h], mx), alpha = __builtin_amdgcn_exp2f(mrun[h] - mn); mrun[h] = mn; lrun[h] *= alpha;
#pragma unroll
                    for (int db = 0; db < 4; ++db) o[h][db] = o[h][db] * alpha; }
                const float mn = mrun[h]; float p[8], ps = 0.f;
#pragma unroll
                for (int j = 0; j < 8; ++j) { p[j] = __builtin_amdgcn_exp2f(((j < 4) ? s0[j & 3] : s1[j & 3]) - mn); ps += p[j]; }
                lrun[h] += ps;
                u32x4 pw; pw.x = cvtpk_v(p[0], p[1]); pw.y = cvtpk_v(p[2], p[3]); pw.z = cvtpk_v(p[4], p[5]); pw.w = cvtpk_v(p[6], p[7]);
                const bf16x8 pf = __builtin_bit_cast(bf16x8, pw);
#pragma unroll
                for (int db = 0; db < 4; ++db) o[h][db] = __builtin_amdgcn_mfma_f32_16x16x32_bf16(cur.v[db], pf, o[h][db], 0, 0, 0);
                if (NH > 2 && h + 1 < NH) __builtin_amdgcn_sched_barrier(0);
            }
        }
        cur = nxt;
    }
}
template <int NH>
__device__ __forceinline__ void band_store(const f32x4 (&o)[NH][4], const float (&lrun)[NH], unsigned char* const (&yrow)[NH], int lane) {
    const int g = lane >> 4;
#pragma unroll
    for (int h = 0; h < NH; ++h) { float l = lrun[h]; l += __shfl_xor(l, 16); l += __shfl_xor(l, 32); const float inv = 1.f / l;
#pragma unroll
        for (int db = 0; db < 4; ++db) *(unsigned*)(yrow[h] + 16 * db + 4 * g) = pk4_fp8(o[h][db][0] * inv, o[h][db][1] * inv, o[h][db][2] * inv, o[h][db][3] * inv); }
}

struct Args { const float* in[19]; float* out; unsigned char* ws; int ph_lo, ph_hi, li, pad; };
constexpr int NPHASE = 10;

__global__ void __launch_bounds__(NWAVES * 64, 2) mk_fwd(Args args) {
    extern __shared__ __attribute__((aligned(16))) unsigned char lds[];
    Frame F;
    F.lds = (LAS unsigned char*)lds; F.MISC = (volatile LAS unsigned*)(F.lds + MISC_OFF); F.tbl = (LAS int*)(F.lds + TBL_OFF);
    F.tid = threadIdx.x; F.lane = F.tid & 63; F.wave = __builtin_amdgcn_readfirstlane(F.tid >> 6);
    F.G = gridDim.x; { const int bx = blockIdx.x; F.vcu = (F.G % 8 == 0) ? (bx % 8) * (F.G / 8) + bx / 8 : bx; }
    unsigned char* ws = args.ws; F.ctl = (gu32*)(ws + WS_CTL);
    const float* x = args.in[0]; const float* norm_mix = args.in[1]; const float* w_in = args.in[2]; const float* b_in = args.in[3];
    const float* sinks = args.in[4]; const float* rel_bias = args.in[5]; const float* w_a = args.in[6]; const float* w_b = args.in[7];
    const float* w_out = args.in[8]; const float* norm_ffn = args.in[9]; const float* router_w = args.in[10]; const float* router_b = args.in[11];
    const float* w_gate = args.in[12]; const float* b_gate = args.in[13]; const float* w_up = args.in[14]; const float* b_up = args.in[15];
    const float* w_down = args.in[16]; const float* b_down = args.in[17]; const float* norm_final = args.in[18];
    float* out = args.out;
    Tabs* tb = (Tabs*)(ws + WS_TAB);
    bf16* Win_t = (bf16*)(ws + WS_WIN); bf16* Wa_t = (bf16*)(ws + WS_WA); bf16* Wb_t = (bf16*)(ws + WS_WB); bf16* Wout_t = (bf16*)(ws + WS_WOUT);
    unsigned char* Wgu8 = ws + WS_WGU; unsigned char* Wd8 = ws + WS_WD; unsigned char* H28 = ws + WS_H2; unsigned char* HS8 = ws + WS_HS; unsigned char* ACT8 = ws + WS_ACT; unsigned char* YS = ws + WS_YS;
    int* topi = (int*)(ws + WS_RT); float* topp = (float*)(ws + WS_RT + 256 * 1024); int* slot = (int*)(ws + WS_RT + 512 * 1024); int* pos = (int*)(ws + WS_RT + 768 * 1024);
    bf16* XN = (bf16*)(ws + WS_XN); bf16* QKV = (bf16*)(ws + WS_QKV); bf16* GATES = (bf16*)(ws + WS_GATES); bf16* YA = (bf16*)(ws + WS_YA); bf16* YB = (bf16*)(ws + WS_YB);
    bf16* MERGED = (bf16*)(ws + WS_MERGED);
    gu32* cnt = F.ctl + CW_CNT; int* rtc = (int*)(ws + WS_RTC);

    for (int u = F.tid; u < (LDS_BYTES - LDSCTL_OFF) / 4; u += NWAVES * 64) ((LAS unsigned*)(F.lds + LDSCTL_OFF))[u] = 0u;
    __syncthreads();
    XcdBarrier bar = xcd_barrier_post((unsigned*)(F.ctl + CW_BAR) + args.li * XCD_BAR_WORDS, F.MISC + 8);
    const int lo = args.ph_lo, hi = args.ph_hi;
#ifndef MK_SKIP
#define MK_SKIP 0
#endif
#define IN(k) (!((MK_SKIP >> (k)) & 1) && lo <= (k) && (k) < hi)
#ifndef MK_DUP
#define MK_DUP 0
#endif
#define REP(k) _Pragma("unroll") for (int rep_ = 0; rep_ < 1 + ((MK_DUP >> (k)) & 1); ++rep_)
#ifdef MK_TSTAMP
    unsigned long long ts_a = __builtin_amdgcn_s_memrealtime(), ts_b = ts_a;
#define SEAM(k) do { if (IN(k) && IN((k) + 1)) xcd_barrier(bar); if ((k) + 1 == MK_TSTAMP) ts_a = __builtin_amdgcn_s_memrealtime(); if ((k) == MK_TSTAMP) ts_b = __builtin_amdgcn_s_memrealtime(); } while (0)
#else
#define SEAM(k) do { if (IN(k) && IN((k) + 1)) xcd_barrier(bar); } while (0)
#endif
    const int gw = F.vcu * NWAVES + F.wave, NGW = F.G * NWAVES;

    LAS float* scr = (LAS float*)(F.lds + RING_OFF + F.wave * 16384);
    constexpr int I_IN = (D / 64) * (NPROJ / 32), I_A = (D / 64) * (D / 32), I_B = (256 / 64) * (D / 32), I_E = (D / 64) * (D / 32);
    constexpr int NITEMS = I_IN + 2 * I_A + I_B + 3 * NE * I_E;
    auto transpose_items = [&](int first, int last) {
    for (int it = first + gw; it < last; it += NGW) {
        int r = it;
        if (r < I_IN) { const int nb = NPROJ / 32; p0_transpose_item_fp8(w_in, D, NPROJ, (unsigned char*)Win_t, 64 * (r / nb), 32 * (r % nb), 32 * (r % nb), scr, F.lane); continue; } r -= I_IN;
        if (r < I_A) { const int nb = D / 32; p0_transpose_item_fp8(w_a, D, D, (unsigned char*)Wa_t, 64 * (r / nb), 32 * (r % nb), 32 * (r % nb), scr, F.lane); continue; } r -= I_A;
        if (r < I_A) { const int nb = D / 32; p0_transpose_item_fp8(w_out, D, D, (unsigned char*)Wout_t, 64 * (r / nb), 32 * (r % nb), 32 * (r % nb), scr, F.lane); continue; } r -= I_A;
        if (r < I_B) { const int nb = D / 32; p0_transpose_item_fp8(w_b, 256, D, (unsigned char*)Wb_t, 64 * (r / nb), 32 * (r % nb), 32 * (r % nb), scr, F.lane); continue; } r -= I_B;
        { const int e = r / (3 * I_E), q = r % (3 * I_E), which = q / I_E, ii = q % I_E, nb = D / 32, k0 = 64 * (ii / nb), n0 = 32 * (ii % nb);
          if (which == 0) p0_transpose_item_fp8(w_gate + (size_t)e * D * D, D, D, Wgu8, k0, n0, e * 2048 + (n0 >> 7) * 256 + (n0 & 127), scr, F.lane);
          else if (which == 1) p0_transpose_item_fp8(w_up + (size_t)e * D * D, D, D, Wgu8, k0, n0, e * 2048 + (n0 >> 7) * 256 + 128 + (n0 & 127), scr, F.lane);
          else p0_transpose_item_fp8(w_down + (size_t)e * D * D, D, D, Wd8, k0, n0, e * 1024 + n0, scr, F.lane); }
    }
    };
    if (IN(0)) REP(0) {
        { const int i = blockIdx.x * (NWAVES * 64) + F.tid;
          if (i < 16 * 257) { const int h = i / 257, r = i % 257; tb->biasA[h][r] = rel_bias[BKT_A[r] * 28 + h]; }
          if (i < 12 * 129) { const int g = i / (4 * 129), hs = (i / 129) % 4, r = i % 129; tb->biasB[g][hs][r] = rel_bias[BKT_B[g][r] * 28 + 16 + 4 * g + hs]; } }
        transpose_items(0, I_IN + 2 * I_A + I_B);
        for (int m = gw; m < T; m += NGW) { const int t0 = m & ~255, tl = m & 255;
            rms_row_to_fp8(x + (size_t)m * D, norm_mix, (unsigned char*)XN + (size_t)m * D, ws + WS_XNP + (size_t)(t0 + (tl & 3) * 64 + (tl >> 2)) * D,
                           ws + WS_XNP + (size_t)(T + t0 + (tl & 15) * 16 + (tl >> 4)) * D, F.lane); }
    }
    SEAM(0);
    if (IN(1)) REP(1) {
        int k512 = D / 2; asm volatile("" : "+s"(k512));
        pg8::Gemm g{XN, Win_t, k512}; pg8::ProjOrder So; So.so.init(T, NPROJ, F.G, (int)blockIdx.x);
        pg8::EpiProj E{QKV, GATES, b_in, (bf16*)(ws + WS_VT), (bf16*)(ws + WS_VT) + (size_t)2 * 4 * 64 * 8192, ws + WS_K2};
        pg8::gemm_phase<pg8::EpiProj, pg8::ProjOrder, true, true, true>(F.lds + RING_OFF, g, So, E);
    }
    SEAM(1);
    int nrep2 = 1 + ((MK_DUP >> 2) & 1); asm volatile("" : "+s"(nrep2));
    if (IN(2)) for (int rep_ = 0; rep_ < nrep2; ++rep_) {
        LAS float* lb = (LAS float*)(F.lds + RING_OFF);
        constexpr int TA = 2 * RB_A + 1, TB = 2 * RB_B + 1;
        for (int i = F.tid; i < 16 * TA; i += NWAVES * 64) { const int h = i / TA, rel = i % TA - RB_A; lb[i] = (rel >= -128 && rel <= 128) ? tb->biasA[h][rel + 128] * LOG2E : -3.0e38f; }
        for (int i = F.tid; i < 12 * TB; i += NWAVES * 64) { const int gh = i / TB, rel = i % TB - RB_B; lb[16 * TA + i] = (rel >= -64 && rel <= 64) ? tb->biasB[gh >> 2][gh & 3][rel + 64] * LOG2E : -3.0e38f; }
        __syncthreads();
        const bf16* VTA = (const bf16*)(ws + WS_VT); const bf16* VTB = VTA + (size_t)2 * 4 * 64 * 8192; const unsigned char* K2 = ws + WS_K2;
        for (int it = gw; it < 4096 + 2048; it += NGW) {
            const int t = F.lane & 15;
            if (it < 4096) {
                const int b = it >> 11, kvh = (it >> 9) & 3, qb = it & 511;
                f32x4 o[4][4]; float mr[4], lr[4];
#pragma unroll
                for (int h = 0; h < 4; ++h) { mr[h] = sinks[kvh * 4 + h] * LOG2E; lr[h] = (F.lane < 16) ? 1.f : 0.f;
#pragma unroll
                    for (int db = 0; db < 4; ++db) o[h][db] = (f32x4){0.f, 0.f, 0.f, 0.f}; }
                const int qcol[4] = {C_QA + (kvh * 4 + 0) * 64, C_QA + (kvh * 4 + 1) * 64, C_QA + (kvh * 4 + 2) * 64, C_QA + (kvh * 4 + 3) * 64};
                const int qmu[4] = {16 * qb, 16 * qb, 16 * qb, 16 * qb};
                const LAS float* const bias[4] = {lb + (kvh * 4 + 0) * TA, lb + (kvh * 4 + 1) * TA, lb + (kvh * 4 + 2) * TA, lb + (kvh * 4 + 3) * TA};
                band_group<4, RB_A>(o, mr, lr, (const unsigned char*)QKV + (size_t)b * S * NQKV, qcol, qmu, K2 + (size_t)((b * 4 + kvh) * 8192) * 64, VTA + (size_t)((b * 4 + kvh) * 64) * 8192, 1, 0, S, 1, (qb - 8) >> 1, 9, bias, F.lane);
                unsigned char* yr = (unsigned char*)YA + (size_t)(b * S + 16 * qb + t) * D + kvh * 256; unsigned char* const yrow[4] = {yr, yr + 64, yr + 128, yr + 192};
                band_store<4>(o, lr, yrow, F.lane);
            } else {
                const int j = it - 4096, r = j & 7, un = j >> 3, blk = un & 31, hs = (un >> 5) & 3, b = un >> 7, i0 = blk * 256;
                f32x4 o[2][4]; float mr[2], lr[2];
#pragma unroll
                for (int h = 0; h < 2; ++h) { mr[h] = -1.0e30f; lr[h] = 0.f;
#pragma unroll
                    for (int db = 0; db < 4; ++db) o[h][db] = (f32x4){0.f, 0.f, 0.f, 0.f}; }
                const unsigned char* qb_ = (const unsigned char*)QKV + (size_t)b * S * NQKV;
                { const int qcol[2] = {C_QB + 0 * 256 + hs * 64, C_QB + 0 * 256 + hs * 64}; const int qmu[2] = {i0 + r, i0 + r + 8}; const LAS float* const bias[2] = {lb + 16 * TA + (0 * 4 + hs) * TB, lb + 16 * TA + (0 * 4 + hs) * TB};
                  band_group<2, RB_B>(o, mr, lr, qb_, qcol, qmu, K2 + (size_t)((((0 + 1) * 2 + b) * 4 + hs) * 8192) * 64, VTB + (size_t)(((0 * 2 + b) * 4 + hs) * 64) * 8192, 1, 0, S, 16, (i0 >> 5) - 2, 12, bias, F.lane); }
                { const int qcol[2] = {C_QB + 1 * 256 + hs * 64, C_QB + 1 * 256 + hs * 64}; const int qmu[2] = {(i0 + r) >> 2, (i0 + r + 8) >> 2}; const LAS float* const bias[2] = {lb + 16 * TA + (1 * 4 + hs) * TB, lb + 16 * TA + (1 * 4 + hs) * TB};
                  band_group<2, RB_B>(o, mr, lr, qb_, qcol, qmu, K2 + (size_t)((((1 + 1) * 2 + b) * 4 + hs) * 8192) * 64, VTB + (size_t)(((1 * 2 + b) * 4 + hs) * 64) * 8192, 4, r & 3, S / 4, 4, (i0 >> 7) - 2, 6, bias, F.lane); }
#pragma unroll
                for (int h = 0; h < 2; ++h) { const int qcol[1] = {C_QB + 2 * 256 + hs * 64}; const int qmu[1] = {i0 >> 4}; const LAS float* const bias[1] = {lb + 16 * TA + (2 * 4 + hs) * TB};
                  band_group<1, RB_B>(*(f32x4(*)[1][4])&o[h], *(float(*)[1])&mr[h], *(float(*)[1])&lr[h], qb_, qcol, qmu, K2 + (size_t)((((2 + 1) * 2 + b) * 4 + hs) * 8192) * 64, VTB + (size_t)(((2 * 2 + b) * 4 + hs) * 64) * 8192,
                                    16, r + 8 * h, S / 16, 1, (blk - 4) >> 1, 5, bias, F.lane); }
                unsigned char* yr = (unsigned char*)YB + (size_t)(b * S + i0 + r + 16 * t) * 256 + hs * 64; unsigned char* const yrow[2] = {yr, yr + 8 * 256};
                band_store<2>(o, lr, yrow, F.lane);
            }
        }
        __syncthreads();
    }
    SEAM(2);
    if (IN(3)) REP(3) {
#ifndef NO_P3A
        { int k256 = 128; asm volatile("" : "+s"(k256)); pg8::Gemm g{YB, Wb_t, k256};   pg8::StaticOrder So; So.init(T, D, F.G, (int)blockIdx.x);
          pg8::EpiGate<0> E{MERGED, GATES, 1024, nullptr};
          pg8::gemm_phase<pg8::EpiGate<0>, pg8::StaticOrder, true, true, true>(F.lds + RING_OFF, g, So, E); }
#endif
        VM_WAIT(); __syncthreads();
#ifndef NO_P3B
        { int k512 = D / 2; asm volatile("" : "+s"(k512)); pg8::Gemm g{YA, Wa_t, k512}; pg8::StaticOrder So; So.init(T, D, F.G, (int)blockIdx.x);
          pg8::EpiGate<1> E{MERGED, GATES, 0, (unsigned char*)YA + (size_t)16 * MiB};
          pg8::gemm_phase<pg8::EpiGate<1>, pg8::StaticOrder, true, true, true>(F.lds + RING_OFF, g, So, E); }
#endif
    }
    SEAM(3);
    if (IN(4)) REP(4) {
        int k512 = D / 2; asm volatile("" : "+s"(k512)); pg8::Gemm g{(const bf16*)((unsigned char*)YA + (size_t)16 * MiB), Wout_t, k512}; pg8::StaticOrder So; So.init(T, D, F.G, (int)blockIdx.x);
        pg8::EpiX1 E{x, out};
        pg8::gemm_phase<pg8::EpiX1, pg8::StaticOrder, true, true, true>(F.lds + RING_OFF, g, So, E);
    }
    SEAM(4);
    if (IN(5)) REP(5) {
        const bool lastrep5 = (rep_ + 1 == 1 + ((MK_DUP >> 5) & 1));
        LAS int* lcnt = F.tbl + 72; LAS int* lbase = F.tbl + 104; LAS int* ebuf = F.tbl + 136; LAS int* pbuf = F.tbl + 392;
        LAS float* plog = (LAS float*)(F.lds + RING_OFF);
        LAS float* psq = plog + 8 * 64 * 32;
        LAS float* rstd_s = psq + 512;
        const int g = F.lane >> 4, e16 = F.lane & 15, w = F.wave;
        float wB[32][2];
#pragma unroll
        for (int sc = 0; sc < 32; ++sc) { const int k = 128 * w + 32 * (sc >> 3) + 8 * g + (sc & 7); const float gm = norm_ffn[k];
            wB[sc][0] = gm * router_w[(size_t)k * NE + e16]; wB[sc][1] = gm * router_w[(size_t)k * NE + 16 + e16]; }
        for (int tblk = F.vcu; tblk < T / 64; tblk += F.G) {
            if (F.tid < 32) lcnt[F.tid] = 0;
            f32x4 v[4][2];
            { const GAS float* xr = (const GAS float*)out + (size_t)(tblk * 64 + e16) * D + 128 * w + 8 * g;
#pragma unroll
              for (int s4 = 0; s4 < 4; ++s4) { v[s4][0] = *(const GAS f32x4*)(xr + 32 * s4); v[s4][1] = *(const GAS f32x4*)(xr + 32 * s4 + 4); } }
#pragma unroll 1
            for (int tile = 0; tile < 4; ++tile) {
                f32x4 vn[4][2];
                { const int tn = tile < 3 ? tile + 1 : 3; const GAS float* xr = (const GAS float*)out + (size_t)(tblk * 64 + tn * 16 + e16) * D + 128 * w + 8 * g;
#pragma unroll
                  for (int s4 = 0; s4 < 4; ++s4) { vn[s4][0] = *(const GAS f32x4*)(xr + 32 * s4); vn[s4][1] = *(const GAS f32x4*)(xr + 32 * s4 + 4); } }
                float sq = 0.f;
#pragma unroll
                for (int s4 = 0; s4 < 4; ++s4) sq += (v[s4][0].x * v[s4][0].x + v[s4][0].y * v[s4][0].y) + (v[s4][0].z * v[s4][0].z + v[s4][0].w * v[s4][0].w)
                                                   + (v[s4][1].x * v[s4][1].x + v[s4][1].y * v[s4][1].y) + (v[s4][1].z * v[s4][1].z + v[s4][1].w * v[s4][1].w);
                sq += __shfl_xor(sq, 16); sq += __shfl_xor(sq, 32);
                if (g == 0) psq[w * 64 + tile * 16 + e16] = sq;
                f32x4 a0 = (f32x4){0.f, 0.f, 0.f, 0.f}, a1 = (f32x4){0.f, 0.f, 0.f, 0.f};
#pragma unroll
                for (int s4 = 0; s4 < 4; ++s4)
#pragma unroll
                    for (int c = 0; c < 8; ++c) { const float av = v[s4][c >> 2][c & 3];
                        a0 = __builtin_amdgcn_mfma_f32_16x16x4f32(av, wB[s4 * 8 + c][0], a0, 0, 0, 0); a1 = __builtin_amdgcn_mfma_f32_16x16x4f32(av, wB[s4 * 8 + c][1], a1, 0, 0, 0); }
#pragma unroll
                for (int r = 0; r < 4; ++r) { LAS float* pr = plog + (size_t)(w * 64 + tile * 16 + 4 * g + r) * 32 + e16; pr[0] = a0[r]; pr[16] = a1[r]; }
#pragma unroll
                for (int s4 = 0; s4 < 4; ++s4) { v[s4][0] = vn[s4][0]; v[s4][1] = vn[s4][1]; }
            }
            __syncthreads();
            if (F.tid < 64) { float s = 0.f;
#pragma unroll
                for (int ww = 0; ww < 8; ++ww) s += psq[ww * 64 + F.tid];
                rstd_s[F.tid] = 1.f / sqrtf(s * (1.f / D) + EPS); }
            __syncthreads();
            { const int e = F.tid & 31; const float rbv = router_b[e];
#pragma unroll 1
              for (int i = 0; i < 4; ++i) { const int tl = (F.tid >> 5) + 16 * i; float lg = 0.f;
#pragma unroll
                for (int ww = 0; ww < 8; ++ww) lg += plog[(size_t)(ww * 64 + tl) * 32 + e];
                float val = lg * rstd_s[tl] + rbv; float tv[4]; int ti[4];
#pragma unroll
                for (int r = 0; r < 4; ++r) {
                    float bv = val; int bi = e;
#pragma unroll
                    for (int o = 1; o < 32; o <<= 1) { const float ov = __shfl_xor(bv, o); const int oi = __shfl_xor(bi, o); if (ov > bv || (ov == bv && oi < bi)) { bv = ov; bi = oi; } }
                    tv[r] = bv; ti[r] = bi; if (bi == e) val = -3.0e38f;
                }
                const float e1 = __expf(tv[1] - tv[0]), e2 = __expf(tv[2] - tv[0]), e3 = __expf(tv[3] - tv[0]); const float inv = 1.f / (1.f + e1 + e2 + e3);
                if (e < 4) { const float p = (e == 0 ? 1.f : e == 1 ? e1 : e == 2 ? e2 : e3) * inv; const int ex = (e == 0 ? ti[0] : e == 1 ? ti[1] : e == 2 ? ti[2] : ti[3]);
                    const int m = tblk * 64 + tl; topi[m * 4 + e] = ex; topp[m * 4 + e] = p;
                    const int li = tl * 4 + e; ebuf[li] = ex; pbuf[li] = __hip_atomic_fetch_add(&lcnt[ex], 1, __ATOMIC_RELAXED, __HIP_MEMORY_SCOPE_WORKGROUP); } } }
#pragma unroll 1
            for (int rb = 0; rb < 8; rb += 4) { f32x4 xv[4][4];
#pragma unroll
                for (int r = 0; r < 4; ++r) { const GAS f32x4* xr4 = (const GAS f32x4*)(out + ((size_t)tblk * 64 + w * 8 + rb + r) * D) + F.lane;
#pragma unroll
                    for (int j = 0; j < 4; ++j) xv[r][j] = xr4[64 * j]; }
#pragma unroll
                for (int r = 0; r < 4; ++r) { const int tl = w * 8 + rb + r; const float rstd = rstd_s[tl]; GAS unsigned* o4 = (GAS unsigned*)(H28 + ((size_t)tblk * 64 + tl) * D) + F.lane;
#pragma unroll
                    for (int j = 0; j < 4; ++j) { const f32x4 gg = ((const GAS f32x4*)norm_ffn)[F.lane + 64 * j];
                        o4[64 * j] = pk4_fp8(xv[r][j].x * rstd * gg.x, xv[r][j].y * rstd * gg.y, xv[r][j].z * rstd * gg.z, xv[r][j].w * rstd * gg.w); } } }
            __syncthreads();
            if (F.tid < 32) lbase[F.tid] = lastrep5 ? (int)__hip_atomic_fetch_add(cnt + F.tid, (unsigned)lcnt[F.tid], RLX_AGENT) : 0;
            __syncthreads();
            if (F.tid < 256) { const int ex = ebuf[F.tid], ps = lbase[ex] + pbuf[F.tid]; pos[tblk * 256 + F.tid] = ps; rtc[(size_t)ex * T + ps] = tblk * 64 + (F.tid >> 2); }
            __syncthreads();
        }
    }
    if (IN(5)) transpose_items(I_IN + 2 * I_A + I_B, NITEMS);
    SEAM(5);
    if (IN(7) || IN(8) || IN(9)) {
        LAS int* loff = F.tbl; LAS int* ltoff = F.tbl + 36; LAS int* lc = F.tbl + 72;
        if (F.tid < 32) lc[F.tid] = (int)__hip_atomic_load(cnt + F.tid, RLX_AGENT);
        __syncthreads();
        if (F.tid == 0) { int a = 0, ta = 0; for (int e = 0; e < NE; ++e) { loff[e] = a; ltoff[e] = ta; const int c = lc[e]; a += c; ta += (c + 255) >> 8; } loff[NE] = a; ltoff[NE] = ta; }
        __syncthreads();
    }
    if (IN(7)) REP(7) {
        int k512 = D / 2; asm volatile("" : "+s"(k512));
        pg8::Gemm g{(const bf16*)H28, (const bf16*)Wgu8, k512, rtc}; pg8::GroupOrder So{F.tbl + 36, F.tbl, 8, F.G, (int)blockIdx.x, 0, T};   So.nunits = __builtin_amdgcn_readfirstlane(F.tbl[36 + NE]) * 8;
        pg8::EpiSwiglu E{ACT8, b_gate, b_up};
        pg8::gemm_phase<pg8::EpiSwiglu, pg8::GroupOrder, true, FP8_SP2, true, true>(F.lds + RING_OFF, g, So, E);
    }
    SEAM(7);
    if (IN(8)) REP(8) {
        int k512 = D / 2; asm volatile("" : "+s"(k512));
        pg8::Gemm g{(const bf16*)ACT8, (const bf16*)Wd8, k512}; pg8::GroupOrder So{F.tbl + 36, F.tbl, 4, F.G, (int)blockIdx.x, 0, 0}; So.nunits = __builtin_amdgcn_readfirstlane(F.tbl[36 + NE]) * 4;
        pg8::EpiDown E{YS, b_down};
        pg8::gemm_phase<pg8::EpiDown, pg8::GroupOrder, true, FP8_SP2, true>(F.lds + RING_OFF, g, So, E);
    }
    SEAM(8);
#ifdef MK_XBAR
    for (int xb_ = 0; xb_ < MK_XBAR; ++xb_) xcd_barrier(bar);
#endif
    if (IN(9)) REP(9) {
        const unsigned char* ys = YS;
        const int lane9 = (int)__builtin_amdgcn_mbcnt_hi(~0u, __builtin_amdgcn_mbcnt_lo(~0u, 0u));
        float* dst9 = (rep_ + 1 < 1 + ((MK_DUP >> 9) & 1)) ? (float*)(ws + WS_ACT) : out;
        for (int m0 = gw; m0 < T; m0 += 2 * NGW) {
            f32x4 v[2][4]; int sl[2][4]; float pr[2][4]; unsigned yv[2][4][4]; bool ok[2];
#pragma unroll
            for (int q = 0; q < 2; ++q) { const int m = m0 + q * NGW; ok[q] = m < T; const int mc = ok[q] ? m : m0; const GAS f32x4* xr = (const GAS f32x4*)(out + (size_t)mc * D) + lane9;
#pragma unroll
                for (int j = 0; j < 4; ++j) v[q][j] = xr[64 * j];
#pragma unroll
                for (int k = 0; k < 4; ++k) { sl[q][k] = F.tbl[topi[mc * 4 + k]] + pos[mc * 4 + k]; pr[q][k] = topp[mc * 4 + k]; } }
#pragma unroll
            for (int q = 0; q < 2; ++q)
#pragma unroll
                for (int k = 0; k < 4; ++k) { const GAS unsigned* yr = (const GAS unsigned*)(ys + (size_t)sl[q][k] * D) + lane9;
#pragma unroll
                    for (int j = 0; j < 4; ++j) yv[q][k][j] = yr[64 * j]; }
#pragma unroll
            for (int q = 0; q < 2; ++q) { if (!ok[q]) continue; const int m = m0 + q * NGW;
#pragma unroll
                for (int k = 0; k < 4; ++k) { const float p = pr[q][k];
#pragma unroll
                    for (int j = 0; j < 4; ++j) { const unsigned u = yv[q][k][j]; const f32x2 lo = __builtin_amdgcn_cvt_pk_f32_fp8(u, false), hi = __builtin_amdgcn_cvt_pk_f32_fp8(u, true);
                        v[q][j].x += p * lo.x; v[q][j].y += p * lo.y; v[q][j].z += p * hi.x; v[q][j].w += p * hi.y; } }
                float s = 0.f;
#pragma unroll
                for (int j = 0; j < 4; ++j) s += (v[q][j].x * v[q][j].x + v[q][j].y * v[q][j].y) + (v[q][j].z * v[q][j].z + v[q][j].w * v[q][j].w);
                const float rstd = 1.f / sqrtf(wave_sum(s) * (1.f / D) + EPS);
#pragma unroll
                for (int j = 0; j < 4; ++j) { const f32x4 gg = ((const GAS f32x4*)norm_final)[lane9 + 64 * j]; f32x4 y; y.x = v[q][j].x * rstd * gg.x; y.y = v[q][j].y * rstd * gg.y; y.z = v[q][j].z * rstd * gg.z; y.w = v[q][j].w * rstd * gg.w;
                    ((GAS f32x4*)(dst9 + (size_t)m * D) + lane9)[64 * j] = y; } }
        }
    }
#ifdef MK_TSTAMP
    if (MK_TSTAMP == 9) ts_b = __builtin_amdgcn_s_memrealtime();
    if (blockIdx.x == 0) { const unsigned long long dt = ts_b - ts_a, t0_ = __builtin_amdgcn_s_memrealtime();
        while (__builtin_amdgcn_s_memrealtime() - t0_ < 2 * dt) __builtin_amdgcn_s_sleep(8); }
#endif
#undef IN
#undef SEAM
}

extern "C" void kernel_launch(void* const* d_in, const int* in_sizes, int n_in, void* d_out, int out_size, void* d_ws, size_t ws_size, hipStream_t stream) {
    static int grid = 0;
    if (grid == 0) {
        if (n_in != 19 || in_sizes[0] != T * D || out_size != T * D || ws_size < WS_END) { fprintf(stderr, "kernel_launch: unexpected shapes (n_in %d, ws %zu); nothing launched\n", n_in, ws_size); grid = -1; return; }
        int dev = 0, cus = 0, per_cu = 0;
        if (hipGetDevice(&dev) != hipSuccess || hipDeviceGetAttribute(&cus, hipDeviceAttributeMultiprocessorCount, dev) != hipSuccess) { grid = -1; return; }
        if (hipFuncSetAttribute((const void*)mk_fwd, hipFuncAttributeMaxDynamicSharedMemorySize, LDS_BYTES) != hipSuccess) { fprintf(stderr, "kernel_launch: hipFuncSetAttribute failed\n"); grid = -1; return; }
        if (hipOccupancyMaxActiveBlocksPerMultiprocessor(&per_cu, (const void*)mk_fwd, NWAVES * 64, LDS_BYTES) != hipSuccess || per_cu < 1) { fprintf(stderr, "kernel_launch: occupancy query says %d blocks per CU\n", per_cu); }
        (void)hipGetLastError();
        grid = cus;
        if (grid != 256) fprintf(stderr, "kernel_launch: %d CUs (built and tuned for 256)\n", grid);
    }
    if (grid < 0) return;
    if (hipMemsetAsync((char*)d_ws + WS_CTL, 0, CTL_ZERO_BYTES, stream) != hipSuccess) return;
    Args a{};
    for (int i = 0; i < 19; ++i) a.in[i] = (const float*)d_in[i];
    a.out = (float*)d_out; a.ws = (unsigned char*)d_ws;
#if MK_MODE == 2
    a.ph_lo = 0; a.ph_hi = NPHASE; a.li = 0;
    hipLaunchKernelGGL(mk_fwd, dim3(grid), dim3(NWAVES * 64), LDS_BYTES, stream, a);
#else
    for (int ph = 0; ph < NPHASE; ++ph) { a.ph_lo = ph; a.ph_hi = ph + 1; a.li = ph; hipLaunchKernelGGL(mk_fwd, dim3(grid), dim3(NWAVES * 64), LDS_BYTES, stream, a); }
#endif
}
```

```cpp
#define MK_DUP 0
#include <hip/hip_runtime.h>
#include <stdint.h>
#include <stdio.h>

#ifndef FP8_SP2
#define FP8_SP2 true
#endif
#ifndef MK_MODE
#define MK_MODE 2
#endif

typedef unsigned short bf16;
typedef short bf16x8 __attribute__((ext_vector_type(8)));
typedef float f32x4 __attribute__((ext_vector_type(4)));
typedef float f32x2 __attribute__((ext_vector_type(2)));
typedef unsigned u32x4 __attribute__((ext_vector_type(4)));
typedef unsigned u32x2 __attribute__((ext_vector_type(2)));
#define GAS __attribute__((address_space(1)))
#define LAS __attribute__((address_space(3)))
typedef GAS unsigned gu32;

constexpr int T = 16384, S = 8192, D = 1024, NPROJ = 5888, NQKV = 3840, NGATE = 2048, NE = 32, TOPK = 4;
constexpr int C_QA = 0, C_KA = 1024, C_VA = 1280, C_QB = 1536, C_KB = 2304, C_VB = 3072;
constexpr float EPS = 1e-5f;
constexpr size_t MiB = 1u << 20;
constexpr size_t WS_CTL = 0, CTL_ZERO_BYTES = 1 * MiB;
constexpr size_t WS_TAB = 1 * MiB;
constexpr size_t WS_WIN = 2 * MiB;
constexpr size_t WS_WA = 14 * MiB;
constexpr size_t WS_WB = 16 * MiB;
constexpr size_t WS_WOUT = 17 * MiB;
constexpr size_t WS_RT = 19 * MiB;
constexpr size_t WS_RTC = 20 * MiB;
constexpr size_t WS_WGU = 24 * MiB;
constexpr size_t WS_WD = 88 * MiB;
constexpr size_t WS_H2 = 120 * MiB;
constexpr size_t WS_HS = 136 * MiB;
constexpr size_t WS_ACT = 201 * MiB;
constexpr size_t WS_YS = 272 * MiB;
constexpr size_t WS_XN = 216 * MiB;
constexpr size_t WS_XNP = 312 * MiB;
constexpr size_t WS_K2 = 344 * MiB;
constexpr size_t WS_QKV = 248 * MiB;
constexpr size_t WS_GATES = 368 * MiB;
constexpr size_t WS_YA = 432 * MiB;
constexpr size_t WS_YB = 464 * MiB;
constexpr size_t WS_MERGED = 472 * MiB;
constexpr size_t WS_VT = 472 * MiB;
constexpr size_t WS_END = 506 * MiB;
constexpr int CW_CNT = 0;
constexpr int CW_BAR = 4096;

__device__ const unsigned char BKT_A[257] = {12,12,12,12,12,12,12,12,12,12,12,12,12,12,12,12,12,12,12,12,12,12,12,12,12,12,12,12,12,12,12,12,12,12,12,12,12,12,11,11,11,11,11,11,11,11,11,11,11,11,11,11,11,11,11,11,11,11,11,11,11,11,11,11,11,11,11,11,11,11,11,11,11,11,11,11,11,11,11,10,10,10,10,10,10,10,10,10,10,10,10,10,10,10,10,10,10,10,10,10,10,10,9,9,9,9,9,9,9,9,9,9,9,9,8,8,8,8,8,8,8,7,6,5,4,3,2,1,0,17,18,19,20,21,22,23,24,24,24,24,24,24,24,25,25,25,25,25,25,25,25,25,25,25,25,26,26,26,26,26,26,26,26,26,26,26,26,26,26,26,26,26,26,26,26,26,26,26,27,27,27,27,27,27,27,27,27,27,27,27,27,27,27,27,27,27,27,27,27,27,27,27,27,27,27,27,27,27,27,27,27,27,27,27,27,27,27,27,27,28,28,28,28,28,28,28,28,28,28,28,28,28,28,28,28,28,28,28,28,28,28,28,28,28,28,28,28,28,28,28,28,28,28,28,28,28,28};
__device__ const unsigned char BKT_B[3][129] = {
 {11,11,11,11,11,11,11,11,11,11,11,11,11,11,11,10,10,10,10,10,10,10,10,10,10,10,10,10,10,10,10,10,10,10,10,10,10,10,9,9,9,9,9,9,9,9,9,9,9,9,8,8,8,8,8,8,8,7,6,5,4,3,2,1,0,17,18,19,20,21,22,23,24,24,24,24,24,24,24,25,25,25,25,25,25,25,25,25,25,25,25,26,26,26,26,26,26,26,26,26,26,26,26,26,26,26,26,26,26,26,26,26,26,26,27,27,27,27,27,27,27,27,27,27,27,27,27,27,27},
 {13,13,13,13,13,13,13,13,13,13,13,13,13,13,13,13,13,13,13,13,13,13,13,12,12,12,12,12,12,12,12,12,12,12,12,12,12,12,12,12,12,12,11,11,11,11,11,11,11,11,11,11,10,10,10,10,10,10,9,9,9,8,8,4,0,20,24,24,25,25,25,26,26,26,26,26,26,27,27,27,27,27,27,27,27,27,27,28,28,28,28,28,28,28,28,28,28,28,28,28,28,28,28,28,28,28,29,29,29,29,29,29,29,29,29,29,29,29,29,29,29,29,29,29,29,29,29,29,29},
 {15,15,15,15,15,15,15,15,15,15,15,15,15,15,15,15,15,15,15,15,15,15,15,15,15,15,15,15,15,15,14,14,14,14,14,14,14,14,14,14,14,14,14,14,14,13,13,13,13,13,13,13,13,13,12,12,12,12,12,11,11,10,10,9,0,25,26,26,27,27,28,28,28,28,28,29,29,29,29,29,29,29,29,29,30,30,30,30,30,30,30,30,30,30,30,30,30,30,30,31,31,31,31,31,31,31,31,31,31,31,31,31,31,31,31,31,31,31,31,31,31,31,31,31,31,31,31,31,31}};

#define RLX_AGENT __ATOMIC_RELAXED, __HIP_MEMORY_SCOPE_AGENT
#define LDS_WAIT() asm volatile("s_waitcnt lgkmcnt(0)" ::: "memory")
#define VM_WAIT() asm volatile("s_waitcnt vmcnt(0)" ::: "memory")
__device__ __forceinline__ unsigned f2bf(float f) { unsigned u = __builtin_bit_cast(unsigned, f); return (u + 0x7fffu + ((u >> 16) & 1u)) >> 16; }
__device__ __forceinline__ unsigned pk2(float lo, float hi) { return f2bf(lo) | (f2bf(hi) << 16); }
__device__ __forceinline__ unsigned pk4_fp8(float a, float b, float c, float d) { unsigned w = 0; w = __builtin_amdgcn_cvt_pk_fp8_f32(a, b, w, false); w = __builtin_amdgcn_cvt_pk_fp8_f32(c, d, w, true); return w; }
__device__ __forceinline__ float bf2f(unsigned b) { return __builtin_bit_cast(float, b << 16); }
__device__ __forceinline__ float bflo(unsigned u) { return __builtin_bit_cast(float, u << 16); }
__device__ __forceinline__ float bfhi(unsigned u) { return __builtin_bit_cast(float, u & 0xffff0000u); }
__device__ __forceinline__ float wave_sum(float v) {
#pragma unroll
    for (int o = 1; o < 64; o <<= 1) v += __shfl_xor(v, o);
    return v;
}
__device__ __forceinline__ float sigm(float x) { return __builtin_amdgcn_rcpf(1.f + __builtin_amdgcn_exp2f(-1.4426950408889634f * x)); }

struct Tabs { float biasA[16][257]; float biasB[3][4][129]; };

namespace pg8 {
#define PG8_LAS __attribute__((address_space(3)))
typedef unsigned short bf16_t;
constexpr int BM = 256, BK = 64, HALF = 128, HTB = HALF * BK * 2, STAGE_BYTES = 8 * HTB, NXCD = 8, WGM = 8;
__host__ __device__ __forceinline__ int lds_byte(int r, int c) { const int st = (r >> 4) * 2 + (c >> 5), rr = r & 15, cc = c & 31, ob = rr * 64 + cc * 2; return st * 1024 + (ob ^ (((ob >> 9) & 1) << 5)); }
__host__ __device__ __forceinline__ void stage_rc(int b, int& R, int& C) { const int st = b / 1024, sb = b % 1024, swz = sb ^ (((sb >> 9) & 1) << 5); R = (st >> 1) * 16 + swz / 64; C = (st & 1) * 32 + (swz % 64) / 2; }
__host__ __device__ __forceinline__ int perm32(int rho) { const int n = rho >> 4, i = rho & 15; return 8 * (i >> 2) + 4 * n + (i & 3); }

struct Unit { int arow, brow, nrows, e, swap, aidx; };
struct Gemm { const bf16_t* A; const bf16_t* Bt; int K; const int* gidx; };

struct StaticOrder {
    int nM, nN, nwg, G, c;
    __device__ void init(int M, int N, int G_, int c_) { nM = M / BM; nN = N / BM; nwg = nM * nN; G = G_; c = c_; }
    __device__ bool next(int i, Unit& u) const {
        const long L = (long)i * G + c; if (L >= nwg) return false;
        int wgid = (int)L; { const int q = nwg / NXCD, r = nwg % NXCD, xcd = wgid % NXCD, off = wgid / NXCD; wgid = (xcd < r ? xcd * (q + 1) : r * (q + 1) + (xcd - r) * q) + off; }
        const int nig = WGM * nN, gid = wgid / nig, fm = gid * WGM, gsz = (nM - fm) < WGM ? (nM - fm) : WGM;
        u.arow = BM * (fm + ((wgid % nig) % gsz)); u.brow = BM * ((wgid % nig) / gsz); u.nrows = BM; u.e = 0; u.swap = 0; u.aidx = 0; return true;
    }
    __device__ __forceinline__ void a_ready(const Unit&) const {}
    __device__ __forceinline__ void done(const Unit&) const {}
};
constexpr int XNP_ROW0 = (int)((WS_XNP - WS_XN) / D);
struct ProjOrder {
    StaticOrder so;
    __device__ bool next(int i, Unit& u) const { if (!so.next(i, u)) return false;
        if (u.brow == C_VA || (u.brow >= C_VB && u.brow < NQKV)) { const int a = u.arow; u.arow = u.brow; u.brow = a; u.swap = 1; u.e = a;
            if (u.arow == C_VB + 256) u.brow += XNP_ROW0; else if (u.arow == C_VB + 512) u.brow += XNP_ROW0 + T; } return true; }
    __device__ __forceinline__ void a_ready(const Unit&) const {}
    __device__ __forceinline__ void done(const Unit&) const {}
};
struct GroupOrder {
    const PG8_LAS int* toff; const PG8_LAS int* off; int NT, G, c, nunits, cap;
    __device__ bool next(int i, Unit& u) const {
        int L;
        if (G & 7) { L = i * G + c; }
        else { const int q = (nunits + 7) >> 3, j = i * (G >> 3) + (c >> 3); if (j >= q) return false; L = (c & 7) * q + j; }
        if (L >= nunits) return false;
        const int mtg = L / NT, pn = L - mtg * NT;
        int e = 0;
        for (int j = 1; j < NE; ++j) e += (toff[j] <= mtg) ? 1 : 0;
        e = __builtin_amdgcn_readfirstlane(e);
        const int mt = mtg - __builtin_amdgcn_readfirstlane(toff[e]); const int o0 = __builtin_amdgcn_readfirstlane(off[e]), o1 = __builtin_amdgcn_readfirstlane(off[e + 1]);
        u.arow = o0 + BM * mt; const int rem = o1 - u.arow; u.nrows = rem < BM ? rem : BM; u.brow = (e * NT + pn) * BM; u.e = e; u.swap = 0; u.aidx = e * cap + BM * mt; return true;
    }
    __device__ __forceinline__ void a_ready(const Unit&) const {}
    __device__ __forceinline__ void done(const Unit&) const {}
};

__device__ __forceinline__ void st16_wt(void* p, u32x4 v) { asm volatile("global_store_dwordx4 %0, %1, off sc1\n\ts_nop 2" :: "v"(p), "v"(v) : "memory"); }
__device__ __forceinline__ void st8_wt(void* p, u32x2 v) { asm volatile("global_store_dwordx2 %0, %1, off sc1\n\ts_nop 2" :: "v"(p), "v"(v) : "memory"); }
__device__ __forceinline__ u32x4 pair16(u32x2 xa, u32x2 xb) {
    const auto a = __builtin_amdgcn_permlane16_swap(xa.x, xb.x, false, false), b = __builtin_amdgcn_permlane16_swap(xa.y, xb.y, false, false);
    u32x4 r; r.x = a[0]; r.y = b[0]; r.z = a[1]; r.w = b[1]; return r; }
__device__ __forceinline__ unsigned cvt_pk_bf16(float lo, float hi) { unsigned r; asm volatile("v_cvt_pk_bf16_f32 %0, %1, %2" : "=v"(r) : "v"(lo), "v"(hi)); return r; }

struct EpiProj {
    static constexpr bool PERM = true, AFTER_DRAIN = false; static constexpr int TAG = 1;
    bf16_t* qkv; bf16_t* gates; const float* bias; bf16_t* vta; bf16_t* vtb; unsigned char* k2;
    __device__ __forceinline__ void prefetch(const Unit& u, PG8_LAS unsigned char* slot, int wid, int lane) const {
        if (wid == 0) { int l4 = 4 * lane; asm volatile("" : "+v"(l4));
            __builtin_amdgcn_global_load_lds((const unsigned*)(bias + (u.swap ? u.arow : u.brow) + l4), (PG8_LAS unsigned*)slot, 16, 0, 0); } }
    __device__ __forceinline__ void operator()(const f32x4 (&acc)[2][2][4][2], const Unit& u, int wr, int wc, int fr, int fq, const PG8_LAS unsigned char* slot) const {
        if (!u.swap) {
            const int colt = u.brow; const bool isq = colt < NQKV; unsigned char* base = isq ? (unsigned char*)qkv : (unsigned char*)gates; const int ldc = isq ? NQKV : NGATE; const int cb = isq ? colt : colt - NQKV;
            const int row0 = u.arow + wr * 64 + fr, col0 = cb + wc * 32 + 8 * fq;
            const PG8_LAS f32x4* bl = (const PG8_LAS f32x4*)(slot + (wc * 32 + 8 * fq) * 4);
            const float qs = (colt < C_KA || (colt >= C_QB && colt < C_KB)) ? 0.125f * 1.4426950408889634f : 1.f;
            const bool isk = (colt == C_KA) || (colt >= C_KB && colt < C_VB);
            if (!isk) {
            int odd = fq & 1; asm volatile("" : "+v"(odd)); const int colp = col0 - 8 * odd;
#pragma unroll
            for (int ai = 0; ai < 2; ++ai)
#pragma unroll
                for (int mp = 0; mp < 4; mp += 2) { unsigned char* rowp = base + (size_t)(row0 + ai * HALF + (mp + odd) * 16) * ldc + colp;
#pragma unroll
                    for (int bj = 0; bj < 2; ++bj) { u32x2 w[2];
#pragma unroll
                        for (int q = 0; q < 2; ++q) { const f32x4 v0 = (acc[ai][bj][mp + q][0] + bl[bj * 32]) * qs, v1 = (acc[ai][bj][mp + q][1] + bl[bj * 32 + 1]) * qs;
                            w[q].x = pk4_fp8(v0[0], v0[1], v0[2], v0[3]); w[q].y = pk4_fp8(v1[0], v1[1], v1[2], v1[3]); }
                        *(u32x4*)(rowp + bj * HALF) = pair16(w[0], w[1]); }
                    asm volatile("" ::: "memory"); }
            } else {
                const int gsel = (colt == C_KA) ? -1 : ((colt - C_KB) >> 8); const int sh = (gsel <= 0) ? 0 : (gsel == 1 ? 2 : 4);
                unsigned char* kb = k2 + (size_t)(gsel + 1) * (2 * 4 * 8192 * 64);
                int c0 = wc * 32 + 8 * fq; asm volatile("" : "+v"(c0));
#pragma unroll
                for (int ai = 0; ai < 2; ++ai)
#pragma unroll
                    for (int m = 0; m < 4; ++m) { const int row = row0 + ai * HALF + m * 16, b = row >> 13, sq = row & 8191; const int pos = ((sq & ((1 << sh) - 1)) << (13 - sh)) + (sq >> sh);
#pragma unroll
                        for (int bj = 0; bj < 2; ++bj) { const int c = c0 + bj * HALF; const f32x4 v0 = acc[ai][bj][m][0] + bl[bj * 32], v1 = acc[ai][bj][m][1] + bl[bj * 32 + 1];
                            u32x2 w; w.x = pk4_fp8(v0[0], v0[1], v0[2], v0[3]); w.y = pk4_fp8(v1[0], v1[1], v1[2], v1[3]);
                            *(u32x2*)(kb + ((size_t)((b * 4 + (c >> 6)) * 8192 + pos)) * 64 + (c & 63)) = w; }
                        asm volatile("" ::: "memory"); }
            }
        } else {
            const int colt = u.arow, tok0 = u.e; const int gsel = (colt == C_VA) ? -1 : ((colt - C_VB) >> 8); const int sh = (gsel <= 0) ? 0 : (gsel == 1 ? 2 : 4);
            bf16_t* vb = ((gsel < 0) ? vta : vtb + (size_t)gsel * (2 * 256 * 8192)) + (size_t)((tok0 >> 13) * 256) * 8192;
            const int mub = (tok0 & 8191) >> sh;
#pragma unroll
            for (int ai = 0; ai < 2; ++ai)
#pragma unroll
                for (int m = 0; m < 4; ++m) { const int c = ai * HALF + wr * 64 + m * 16 + fr; const float bvr = *(const PG8_LAS float*)(slot + c * 4); bf16_t* vrow = vb + (size_t)(c >> 6) * (64 * 8192) + (c & 63) * 32;
#pragma unroll
                    for (int bj = 0; bj < 2; ++bj) { const int j0 = bj * HALF + wc * 32 + 8 * fq;
                        const int rho = j0 >> (8 - sh), mu = mub + (j0 & ((256 >> sh) - 1));
                        const int p0 = ((rho << (8 - sh)) + (mu >> 5)) * 2048 + (((mu & 15) >> 2) << 3) + (((mu >> 4) & 1) << 2);
                        const f32x4 v0 = acc[ai][bj][m][0] + bvr, v1 = acc[ai][bj][m][1] + bvr;
                        u32x2 w0, w1; w0.x = cvt_pk_bf16(v0[0], v0[1]); w0.y = cvt_pk_bf16(v0[2], v0[3]); w1.x = cvt_pk_bf16(v1[0], v1[1]); w1.y = cvt_pk_bf16(v1[2], v1[3]);
                        *(u32x2*)(vrow + p0) = w0; *(u32x2*)(vrow + p0 + 8) = w1; }
                    asm volatile("" ::: "memory"); }
        }
    }
};
template <int MODE> struct EpiGate {
    static constexpr bool PERM = true, AFTER_DRAIN = false; static constexpr int TAG = 3;
    bf16_t* out; const bf16_t* gates; int gcol0; unsigned char* out8;
    __device__ __forceinline__ void prefetch(const Unit&, PG8_LAS unsigned char*, int, int) const {}
    __device__ __forceinline__ void operator()(const f32x4 (&acc)[2][2][4][2], const Unit& u, int wr, int wc, int fr, int fq, const PG8_LAS unsigned char*) const {
        const int row0 = u.arow + wr * 64 + fr, col0 = u.brow + wc * 32 + 8 * fq;
        u32x2 gv[8][2];
#pragma unroll
        for (int gi = 0; gi < 4; ++gi) { const size_t r = (size_t)(row0 + (gi >> 2) * HALF + (gi & 3) * 16);
#pragma unroll
            for (int bj = 0; bj < 2; ++bj) gv[gi][bj] = *(const u32x2*)((const unsigned char*)gates + r * NGATE + gcol0 + col0 + bj * HALF); }
        u32x4 mv[2], mn[2];
        if (MODE == 1) {
#pragma unroll
            for (int bj = 0; bj < 2; ++bj) mv[bj] = *(const u32x4*)(out + (size_t)row0 * D + col0 + bj * HALF); }
#pragma unroll
        for (int gi = 0; gi < 8; ++gi) { const int ai = gi >> 2, m = gi & 3; const size_t r = (size_t)(row0 + ai * HALF + m * 16);
            if (gi == 1) {
#pragma unroll
                for (int g2 = 4; g2 < 8; ++g2) { const size_t r2 = (size_t)(row0 + (g2 >> 2) * HALF + (g2 & 3) * 16);
#pragma unroll
                    for (int bj = 0; bj < 2; ++bj) gv[g2][bj] = *(const u32x2*)((const unsigned char*)gates + r2 * NGATE + gcol0 + col0 + bj * HALF); } }
            if (MODE == 1 && gi + 1 < 8) { const size_t rn = (size_t)(row0 + ((gi + 1) >> 2) * HALF + ((gi + 1) & 3) * 16);
#pragma unroll
                for (int bj = 0; bj < 2; ++bj) mn[bj] = *(const u32x4*)(out + rn * D + col0 + bj * HALF); }
#pragma unroll
            for (int bj = 0; bj < 2; ++bj) { const int c = col0 + bj * HALF; const u32x2 g4 = gv[gi][bj]; const f32x4 a0 = acc[ai][bj][m][0], a1 = acc[ai][bj][m][1];
                const f32x2 ga = __builtin_amdgcn_cvt_pk_f32_fp8(g4.x, false), gb = __builtin_amdgcn_cvt_pk_f32_fp8(g4.x, true), gc = __builtin_amdgcn_cvt_pk_f32_fp8(g4.y, false), gd = __builtin_amdgcn_cvt_pk_f32_fp8(g4.y, true);
                float o[8]; o[0] = sigm(ga.x) * a0[0]; o[1] = sigm(ga.y) * a0[1]; o[2] = sigm(gb.x) * a0[2]; o[3] = sigm(gb.y) * a0[3];
                o[4] = sigm(gc.x) * a1[0]; o[5] = sigm(gc.y) * a1[1]; o[6] = sigm(gd.x) * a1[2]; o[7] = sigm(gd.y) * a1[3];
                if (MODE == 1) { const u32x4 m4 = mv[bj];
                    o[0] += bflo(m4.x); o[1] += bfhi(m4.x); o[2] += bflo(m4.y); o[3] += bfhi(m4.y); o[4] += bflo(m4.z); o[5] += bfhi(m4.z); o[6] += bflo(m4.w); o[7] += bfhi(m4.w); }
                if (MODE == 1) { u32x2 w8; w8.x = pk4_fp8(o[0], o[1], o[2], o[3]); w8.y = pk4_fp8(o[4], o[5], o[6], o[7]); *(u32x2*)(out8 + r * D + c) = w8; }
                else { u32x4 w; w.x = cvt_pk_bf16(o[0], o[1]); w.y = cvt_pk_bf16(o[2], o[3]); w.z = cvt_pk_bf16(o[4], o[5]); w.w = cvt_pk_bf16(o[6], o[7]);
                    *(u32x4*)(out + r * D + c) = w; } }
            asm volatile("" ::: "memory");
            if (MODE == 1) {
#pragma unroll
                for (int bj = 0; bj < 2; ++bj) mv[bj] = mn[bj]; } }
    }
};
struct EpiX1 {
    static constexpr bool PERM = true, AFTER_DRAIN = false; static constexpr int TAG = 4;
    const float* x; float* out;
    __device__ __forceinline__ void prefetch(const Unit&, PG8_LAS unsigned char*, int, int) const {}
    __device__ __forceinline__ void operator()(const f32x4 (&acc)[2][2][4][2], const Unit& u, int wr, int wc, int fr, int fq, const PG8_LAS unsigned char*) const {
        const int row0 = u.arow + wr * 64 + fr, col0 = u.brow + wc * 32 + 8 * fq;
        f32x4 xv[2][2], xn[2][2];
#pragma unroll
        for (int bj = 0; bj < 2; ++bj) { const size_t o = (size_t)row0 * D + col0 + bj * HALF; xv[bj][0] = *(const f32x4*)(x + o); xv[bj][1] = *(const f32x4*)(x + o + 4); }
#pragma unroll
        for (int gi = 0; gi < 8; ++gi) { const int ai = gi >> 2, m = gi & 3; const size_t r = (size_t)(row0 + ai * HALF + m * 16);
            if (gi + 1 < 8) { const size_t rn = (size_t)(row0 + ((gi + 1) >> 2) * HALF + ((gi + 1) & 3) * 16);
#pragma unroll
                for (int bj = 0; bj < 2; ++bj) { const size_t o = rn * D + col0 + bj * HALF; xn[bj][0] = *(const f32x4*)(x + o); xn[bj][1] = *(const f32x4*)(x + o + 4); } }
#pragma unroll
            for (int bj = 0; bj < 2; ++bj) { const size_t o = r * D + col0 + bj * HALF;
                *(f32x4*)(out + o) = xv[bj][0] + acc[ai][bj][m][0]; *(f32x4*)(out + o + 4) = xv[bj][1] + acc[ai][bj][m][1]; }
            asm volatile("" ::: "memory");
#pragma unroll
            for (int bj = 0; bj < 2; ++bj) { xv[bj][0] = xn[bj][0]; xv[bj][1] = xn[bj][1]; } }
    }
};
struct EpiSwiglu {
    static constexpr bool PERM = true, AFTER_DRAIN = false; static constexpr int TAG = 7;
    unsigned char* act; const float* bg; const float* bu;
    __device__ __forceinline__ void prefetch(const Unit& u, PG8_LAS unsigned char* slot, int wid, int lane) const {
        if (wid == 0) { const int pn = (u.brow >> 8) & 7; const float* src = ((lane < 32) ? bg : bu) + (size_t)u.e * D + pn * HALF + 4 * (lane & 31);
            __builtin_amdgcn_global_load_lds((const unsigned*)src, (PG8_LAS unsigned*)slot, 16, 0, 0); } }
    __device__ __forceinline__ void operator()(const f32x4 (&acc)[2][2][4][2], const Unit& u, int wr, int wc, int fr, int fq, const PG8_LAS unsigned char* slot) const {
        const int pn = (u.brow >> 8) & 7; const int col0 = pn * HALF + wc * 32 + 8 * fq; const int rl0 = wr * 64 + fr;
        const PG8_LAS f32x4* bl = (const PG8_LAS f32x4*)(slot + (wc * 32 + 8 * fq) * 4);
        const f32x4 g0 = bl[0], g1 = bl[1], u0 = bl[32], u1 = bl[33];
#pragma unroll
        for (int ai = 0; ai < 2; ++ai)
#pragma unroll
            for (int m = 0; m < 4; ++m) { const int rl = rl0 + ai * HALF + m * 16;
                const f32x4 ga = acc[ai][0][m][0] + g0, gb = acc[ai][0][m][1] + g1, ua = acc[ai][1][m][0] + u0, ub = acc[ai][1][m][1] + u1;
                float o[8];
#pragma unroll
                for (int j = 0; j < 4; ++j) { const float gt = fminf(ga[j], 7.f), up = fminf(fmaxf(ua[j], -7.f), 7.f); o[j] = gt * sigm(1.702f * gt) * (up + 1.f);
                    const float gt2 = fminf(gb[j], 7.f), up2 = fminf(fmaxf(ub[j], -7.f), 7.f); o[4 + j] = gt2 * sigm(1.702f * gt2) * (up2 + 1.f); }
                u32x2 w; w.x = pk4_fp8(o[0], o[1], o[2], o[3]); w.y = pk4_fp8(o[4], o[5], o[6], o[7]);
                if (rl < u.nrows) *(u32x2*)(act + (size_t)(u.arow + rl) * D + col0) = w; }
    }
};
struct EpiDown {
    static constexpr bool PERM = true, AFTER_DRAIN = false; static constexpr int TAG = 8;
    unsigned char* ys; const float* bd;
    __device__ __forceinline__ void prefetch(const Unit& u, PG8_LAS unsigned char* slot, int wid, int lane) const {
        if (wid == 0) { const int pn = (u.brow >> 8) & 3; __builtin_amdgcn_global_load_lds((const unsigned*)(bd + (size_t)u.e * D + pn * BM + 4 * lane), (PG8_LAS unsigned*)slot, 16, 0, 0); } }
    __device__ __forceinline__ void operator()(const f32x4 (&acc)[2][2][4][2], const Unit& u, int wr, int wc, int fr, int fq, const PG8_LAS unsigned char* slot) const {
        const int pn = (u.brow >> 8) & 3; const int col0 = pn * BM + wc * 32 + 8 * fq; const int rl0 = wr * 64 + fr;
        f32x4 bv[2][2];
#pragma unroll
        for (int bj = 0; bj < 2; ++bj)
#pragma unroll
            for (int n = 0; n < 2; ++n) bv[bj][n] = *(const PG8_LAS f32x4*)(slot + (wc * 32 + 8 * fq + bj * HALF + 4 * n) * 4);
        int odd = fq & 1; asm volatile("" : "+v"(odd));
#pragma unroll
        for (int ai = 0; ai < 2; ++ai)
#pragma unroll
            for (int mp = 0; mp < 4; mp += 2) { const int rl = rl0 + ai * HALF + (mp + odd) * 16; unsigned char* rowp = ys + (size_t)(u.arow + rl) * D + col0 - 8 * odd;
#pragma unroll
                for (int bj = 0; bj < 2; ++bj) { u32x2 w[2];
#pragma unroll
                    for (int q = 0; q < 2; ++q) { const f32x4 v0 = acc[ai][bj][mp + q][0] + bv[bj][0], v1 = acc[ai][bj][mp + q][1] + bv[bj][1];
                        w[q].x = pk4_fp8(v0[0], v0[1], v0[2], v0[3]); w[q].y = pk4_fp8(v1[0], v1[1], v1[2], v1[3]); }
                    const u32x4 w16 = pair16(w[0], w[1]);
                    if (rl < u.nrows) *(u32x4*)(rowp + bj * HALF) = w16; } }
    }
};

typedef int i32x4_t __attribute__((ext_vector_type(4))); typedef int i32x8_t __attribute__((ext_vector_type(8)));
template <bool FP8> struct Frag;
template <> struct Frag<false> { bf16x8 v[2];
    __device__ __forceinline__ void ld(const PG8_LAS unsigned char* p) { v[0] = *(const PG8_LAS bf16x8*)p; v[1] = *(const PG8_LAS bf16x8*)(p + 1024); } };
template <> struct Frag<true> { i32x8_t v;
    __device__ __forceinline__ void ld(const PG8_LAS unsigned char* p) { const i32x4_t lo = *(const PG8_LAS i32x4_t*)p, hi = *(const PG8_LAS i32x4_t*)(p + 1024); v = __builtin_shufflevector(lo, hi, 0, 1, 2, 3, 4, 5, 6, 7); } };
__device__ __forceinline__ f32x4 mma_frag(const Frag<false>& w, const Frag<false>& x, f32x4 c) {
    c = __builtin_amdgcn_mfma_f32_16x16x32_bf16(w.v[0], x.v[0], c, 0, 0, 0); return __builtin_amdgcn_mfma_f32_16x16x32_bf16(w.v[1], x.v[1], c, 0, 0, 0); }
__device__ __forceinline__ f32x4 mma_frag(const Frag<true>& w, const Frag<true>& x, f32x4 c) {
    const int sa = 0x7A7A7A7A, sb = 0x7F7F7F7F;
    asm volatile("v_mfma_scale_f32_16x16x128_f8f6f4 %0, %1, %2, %0, %3, %4 op_sel_hi:[0,0,0]" : "+v"(c) : "v"(w.v), "v"(x.v), "v"(sa), "v"(sb));
    return c; }
template <class Epi, class Sched, bool ALIGN_EPI = false, bool SP2 = false, bool FP8 = false, bool GA = false>
__device__ __forceinline__ void gemm_phase(PG8_LAS unsigned char* lds, const Gemm g, const Sched& S, const Epi& E) {
    const int tid = threadIdx.x, wid = __builtin_amdgcn_readfirstlane(tid >> 6), lane = tid & 63, wr = wid >> 2, wc = wid & 3, fr = lane & 15, fq = lane >> 4;
    const int K = g.K, nt = K / BK;
    unsigned voffA[2], voffB[2];
#pragma unroll
    for (int i = 0; i < 2; ++i) { int R, C; stage_rc(tid * 16 + i * 8192, R, C); const int Rb = Epi::PERM ? ((R & ~31) + perm32(R & 31)) : R;
        voffA[i] = (unsigned)(R * K + C) * 2u; voffB[i] = (unsigned)(Rb * K + C) * 2u; }
    static_assert(!GA || SP2, "gather is wired into the two-super-phase loop only");
    unsigned vAc[2][2], vAn[2][2];
#pragma unroll
    for (int h = 0; h < 2; ++h)
#pragma unroll
        for (int i = 0; i < 2; ++i) { vAc[h][i] = voffA[i]; vAn[h][i] = voffA[i]; }
    PG8_LAS unsigned char* const ilds = lds + 131072 + 4096 + 2048;
    auto gather_off = [&](int i, unsigned idx) -> unsigned { int R, C; stage_rc(tid * 16 + i * 8192, R, C); idx = idx < (unsigned)T ? idx : (unsigned)(T - 1); return idx * (unsigned)(K * 2) + (unsigned)C * 2u; };
    auto piece_row = [&](int i) -> int { int R, C; stage_rc(tid * 16 + i * 8192, R, C); return R; };
    const size_t kstep = (size_t)(BK * 2);
    const size_t hstep = (size_t)HALF * K * 2;
    const size_t rowb = (size_t)K * 2;
    const size_t hstepA = GA ? 0 : hstep;
    const unsigned ldsw = (unsigned)wid * 1024u;
    const int aoff = lds_byte(wr * 64 + fr, fq * 8), boff = lds_byte(wc * 32 + fr, fq * 8);
#define PG8_SA(b, h) (((b) * 2 + (h)) * HTB)
#define PG8_SB(b, h) ((4 + (b) * 2 + (h)) * HTB)
#define PG8_STAGE(bufoff, gbase, voff) do { _Pragma("unroll") for (int _i = 0; _i < 2; ++_i) \
        __builtin_amdgcn_global_load_lds((const unsigned*)((const char*)(gbase) + (voff)[_i]), (PG8_LAS unsigned*)(lds + (bufoff) + ldsw + _i * 8192), 16, 0, 0); } while (0)
#define PG8_LDA(dst, b, h) do { _Pragma("unroll") for (int m = 0; m < 4; ++m) dst[m].ld(lds + PG8_SA(b, h) + aoff + m * 2048); } while (0)
#define PG8_LDB(dst, b, h) do { _Pragma("unroll") for (int n = 0; n < 2; ++n) dst[n].ld(lds + PG8_SB(b, h) + boff + n * 2048); } while (0)
#define PG8_MMA(ai, bj, At, Bt) do { __builtin_amdgcn_s_setprio(1); _Pragma("unroll") for (int m = 0; m < 4; ++m) _Pragma("unroll") for (int n = 0; n < 2; ++n) \
        acc[ai][bj][m][n] = mma_frag(Bt[n], At[m], acc[ai][bj][m][n]); __builtin_amdgcn_s_setprio(0); } while (0)
#define PG8_WAIT_V(n) asm volatile("s_waitcnt vmcnt(" #n ")" ::: "memory")
#define PG8_WAIT_L(n) asm volatile("s_waitcnt lgkmcnt(" #n ")" ::: "memory")
#define PG8_BAR __builtin_amdgcn_s_barrier()
#define PG8_SCHED __builtin_amdgcn_sched_barrier(0)
    Unit cur, nxt; int ui = 0;
    if (!S.next(0, cur)) return;
    f32x4 acc[2][2][4][2];
#pragma unroll
    for (int a = 0; a < 2; ++a)
#pragma unroll
        for (int b = 0; b < 2; ++b)
#pragma unroll
            for (int m = 0; m < 4; ++m)
#pragma unroll
                for (int n = 0; n < 2; ++n) acc[a][b][m][n] = (f32x4){0.f, 0.f, 0.f, 0.f};
    Frag<FP8> At[4], B0[2], B1[2];
    const char* cA = (const char*)(cur.swap ? g.Bt : g.A) + (size_t)cur.arow * rowb; const char* cB = (const char*)(cur.swap ? g.A : g.Bt) + (size_t)cur.brow * rowb;
    if constexpr (GA) { cA = (const char*)g.A;
#pragma unroll
        for (int h = 0; h < 2; ++h)
#pragma unroll
            for (int i = 0; i < 2; ++i) { vAc[h][i] = gather_off(i, (unsigned)g.gidx[cur.aidx + h * HALF + piece_row(i)]); vAn[h][i] = vAc[h][i]; } }
    S.a_ready(cur);
    PG8_LAS unsigned char* const blds = lds + 131072 + 4096;
    E.prefetch(cur, blds, wid, lane);
    if constexpr (SP2) {
        PG8_STAGE(PG8_SB(0, 0), cB, voffB); PG8_STAGE(PG8_SB(0, 1), cB + hstep, voffB); PG8_STAGE(PG8_SA(0, 0), cA, vAc[0]); PG8_STAGE(PG8_SA(0, 1), cA + hstepA, vAc[1]);
        if (wr == 1) PG8_BAR;
        PG8_WAIT_V(2); PG8_BAR;
        PG8_STAGE(PG8_SB(1, 0), cB + kstep, voffB); PG8_STAGE(PG8_SA(1, 0), cA + kstep, vAc[0]); PG8_STAGE(PG8_SB(1, 1), cB + hstep + kstep, voffB);
        PG8_WAIT_V(6); PG8_BAR;
    } else {
        PG8_STAGE(PG8_SB(0, 0), cB, voffB); PG8_STAGE(PG8_SA(0, 0), cA, voffA); PG8_STAGE(PG8_SB(0, 1), cB + hstep, voffB); PG8_STAGE(PG8_SA(0, 1), cA + hstep, voffA);
        if (wr == 1) PG8_BAR;
        PG8_WAIT_V(4); PG8_BAR;
        PG8_STAGE(PG8_SB(1, 0), cB + kstep, voffB); PG8_STAGE(PG8_SA(1, 0), cA + kstep, voffA); PG8_STAGE(PG8_SB(1, 1), cB + hstep + kstep, voffB);
        PG8_WAIT_V(6); PG8_BAR;
    }
    for (;;) {
        const bool has_next = S.next(ui + 1, nxt);
        const char* nA = (has_next && !GA) ? (const char*)(nxt.swap ? g.Bt : g.A) + (size_t)nxt.arow * rowb : cA; const char* nB = has_next ? (const char*)(nxt.swap ? g.A : g.Bt) + (size_t)nxt.brow * rowb : cB;
        for (int t = 0; t < nt; t += 2) {
            const bool last = (t == nt - 2);
            const char* a1 = cA + (size_t)(t + 1) * kstep;
            const char* a2 = last ? nA : cA + (size_t)(t + 2) * kstep; const char* b2 = last ? nB : cB + (size_t)(t + 2) * kstep;
            const char* a3 = a2 + kstep; const char* b3 = b2 + kstep;
            if (last && has_next) { S.a_ready(nxt); E.prefetch(nxt, blds + (((ui + 1) & 1) << 10), wid, lane); }
            if constexpr (GA) {
                if (t == nt - 4 && has_next && wid == 0) { int l4 = 4 * lane; asm volatile("" : "+v"(l4));
                    __builtin_amdgcn_global_load_lds((const unsigned*)(g.gidx + nxt.aidx + l4), (PG8_LAS unsigned*)(ilds + (((ui + 1) & 1) << 10)), 16, 0, 0); }
                if (last && has_next) { const PG8_LAS unsigned* il = (const PG8_LAS unsigned*)(ilds + (((ui + 1) & 1) << 10));
#pragma unroll
                    for (int h = 0; h < 2; ++h)
#pragma unroll
                        for (int i = 0; i < 2; ++i) vAn[h][i] = gather_off(i, il[h * HALF + piece_row(i)]); }
            }
            unsigned v2[2][2];
#pragma unroll
            for (int h = 0; h < 2; ++h)
#pragma unroll
                for (int i = 0; i < 2; ++i) v2[h][i] = last ? vAn[h][i] : vAc[h][i];
            if constexpr (SP2) {
            PG8_LDB(B0, 0, 0); PG8_LDB(B1, 0, 1); PG8_SCHED; PG8_LDA(At, 0, 0); PG8_STAGE(PG8_SA(1, 1), a1 + hstepA, vAc[1]);
            PG8_WAIT_V(8); PG8_WAIT_L(0); PG8_BAR; PG8_MMA(0, 0, At, B0); PG8_MMA(0, 1, At, B1); PG8_BAR; PG8_SCHED;
            PG8_LDA(At, 0, 1); PG8_STAGE(PG8_SB(0, 0), b2, voffB); PG8_STAGE(PG8_SB(0, 1), b2 + hstep, voffB); PG8_STAGE(PG8_SA(0, 0), a2, v2[0]);
            PG8_WAIT_V(8); PG8_WAIT_L(0); PG8_BAR; PG8_MMA(1, 0, At, B0); PG8_MMA(1, 1, At, B1); PG8_BAR; PG8_SCHED;
            PG8_LDB(B0, 1, 0); PG8_LDB(B1, 1, 1); PG8_SCHED; PG8_LDA(At, 1, 0); PG8_STAGE(PG8_SA(0, 1), a2 + hstepA, v2[1]);
            PG8_WAIT_V(8); PG8_WAIT_L(0); PG8_BAR; PG8_MMA(0, 0, At, B0); PG8_MMA(0, 1, At, B1); PG8_BAR; PG8_SCHED;
            PG8_LDA(At, 1, 1); PG8_STAGE(PG8_SB(1, 0), b3, voffB); PG8_STAGE(PG8_SB(1, 1), b3 + hstep, voffB); PG8_STAGE(PG8_SA(1, 0), a3, v2[0]);
            PG8_WAIT_V(8); PG8_WAIT_L(0); PG8_BAR; PG8_MMA(1, 0, At, B0); PG8_MMA(1, 1, At, B1); PG8_BAR; PG8_SCHED;
            } else {
            PG8_LDB(B0, 0, 0); PG8_SCHED; PG8_LDA(At, 0, 0); PG8_STAGE(PG8_SA(1, 1), a1 + hstep, voffA);
            PG8_WAIT_L(8); PG8_BAR; PG8_WAIT_L(0); PG8_MMA(0, 0, At, B0); PG8_BAR; PG8_SCHED;
            PG8_LDB(B1, 0, 1); PG8_STAGE(PG8_SB(0, 0), b2, voffB);
            PG8_BAR; PG8_WAIT_L(0); PG8_MMA(0, 1, At, B1); PG8_BAR;
            PG8_LDA(At, 0, 1); PG8_STAGE(PG8_SA(0, 0), a2, voffA);
            PG8_BAR; PG8_WAIT_L(0); PG8_MMA(1, 0, At, B0); PG8_BAR; PG8_SCHED;
            PG8_STAGE(PG8_SB(0, 1), b2 + hstep, voffB);
            PG8_WAIT_V(6); PG8_BAR; PG8_MMA(1, 1, At, B1); PG8_BAR;
            PG8_LDB(B0, 1, 0); PG8_SCHED; PG8_LDA(At, 1, 0); PG8_STAGE(PG8_SA(0, 1), a2 + hstep, voffA);
            PG8_WAIT_L(8); PG8_BAR; PG8_WAIT_L(0); PG8_MMA(0, 0, At, B0); PG8_BAR; PG8_SCHED;
            PG8_LDB(B1, 1, 1); PG8_STAGE(PG8_SB(1, 0), b3, voffB);
            PG8_BAR; PG8_WAIT_L(0); PG8_MMA(0, 1, At, B1); PG8_BAR;
            PG8_LDA(At, 1, 1); PG8_STAGE(PG8_SA(1, 0), a3, voffA);
            PG8_BAR; PG8_WAIT_L(0); PG8_MMA(1, 0, At, B0); PG8_BAR; PG8_SCHED;
            PG8_STAGE(PG8_SB(1, 1), b3 + hstep, voffB);
            PG8_WAIT_V(6); PG8_BAR; PG8_MMA(1, 1, At, B1); PG8_BAR;
            }
        }
        if constexpr (ALIGN_EPI) { if (wr == 0) PG8_BAR; }
        if constexpr (FP8) {
#define PG8_ACC8(a, b) "+v"(acc[a][b][0][0]), "+v"(acc[a][b][0][1]), "+v"(acc[a][b][1][0]), "+v"(acc[a][b][1][1]), "+v"(acc[a][b][2][0]), "+v"(acc[a][b][2][1]), "+v"(acc[a][b][3][0]), "+v"(acc[a][b][3][1])
            asm volatile("s_nop 15\n\ts_nop 15" : PG8_ACC8(0, 0), PG8_ACC8(0, 1) :: "memory");
            asm volatile("" : PG8_ACC8(1, 0), PG8_ACC8(1, 1) :: "memory");
#undef PG8_ACC8
        }
#ifdef MK_EPI2
        if constexpr (Epi::TAG == MK_EPI2) { E(acc, cur, wr, wc, fr, fq, blds + ((ui & 1) << 10)); asm volatile("" ::: "memory"); }
#endif
        if constexpr (!Epi::AFTER_DRAIN) { E(acc, cur, wr, wc, fr, fq, blds + ((ui & 1) << 10)); S.done(cur); }
        if (!has_next) break;
#pragma unroll
        for (int a = 0; a < 2; ++a)
#pragma unroll
            for (int b = 0; b < 2; ++b)
#pragma unroll
                for (int m = 0; m < 4; ++m)
#pragma unroll
                    for (int n = 0; n < 2; ++n) acc[a][b][m][n] = (f32x4){0.f, 0.f, 0.f, 0.f};
        cur = nxt; cA = nA; cB = nB; ++ui;
        if constexpr (GA) {
#pragma unroll
            for (int h = 0; h < 2; ++h)
#pragma unroll
                for (int i = 0; i < 2; ++i) vAc[h][i] = vAn[h][i]; }
        if constexpr (ALIGN_EPI) { if (wr == 1) PG8_BAR; }
    }
    PG8_WAIT_V(0);
    if constexpr (!ALIGN_EPI) { if (wr == 0) PG8_BAR; }
    PG8_BAR;
    if constexpr (Epi::AFTER_DRAIN) { E.fused(acc, cur, wr, wc, fr, fq, lds, wid, lane); S.done(cur); }
#undef PG8_SA
#undef PG8_SB
#undef PG8_STAGE
#undef PG8_LDA
#undef PG8_LDB
#undef PG8_MMA
#undef PG8_WAIT_V
#undef PG8_WAIT_L
#undef PG8_BAR
#undef PG8_SCHED
}

}

#define XB_TMO      128
#define XB_XCNT(j)  (256  + 64 * (j))
#define XB_XSUB(j)  (1280 + 64 * (j))
#define XB_XGEN(j)  (2304 + 64 * (j))
#define XB_TOP      3328
#define XB_TOPGEN   3392
#define XCD_BAR_WORDS 3456
#define XB_SPIN_CAP (1u << 18)
__device__ __forceinline__ unsigned xb_ld(unsigned* p)              { return __hip_atomic_load(p, __ATOMIC_RELAXED, __HIP_MEMORY_SCOPE_AGENT); }
__device__ __forceinline__ unsigned xb_add(unsigned* p, unsigned v) { return __hip_atomic_fetch_add(p, v, __ATOMIC_RELAXED, __HIP_MEMORY_SCOPE_AGENT); }
__device__ __forceinline__ unsigned xb_xcc_id() { return (unsigned)__builtin_amdgcn_s_getreg((3 << 11) | 20) & 0xFu; }
#define XB_SPIN(cond, bar) do { unsigned _sp = 0; while (cond) { __builtin_amdgcn_s_sleep(1); \
    if ((++_sp & 255u) == 0u) { if (xb_ld(&(bar)[XB_TMO])) break; if (_sp > XB_SPIN_CAP) { atomicAdd(&(bar)[XB_TMO], 1u); break; } } } } while (0)
struct XcdBarrier { unsigned* bar; unsigned x; volatile LAS unsigned* st; };
__device__ __forceinline__ XcdBarrier xcd_barrier_post(unsigned* bar, volatile LAS unsigned* st) {
    XcdBarrier b; b.bar = bar; b.x = xb_xcc_id(); b.st = st;
    if (threadIdx.x == 0) (void)xb_add(&bar[XB_XCNT(b.x)], 1u);
    return b;
}
__device__ __forceinline__ void xcd_barrier_complete(unsigned* bar, unsigned x, unsigned& nloc, unsigned& nx) {
    const unsigned G = gridDim.x * gridDim.y * gridDim.z;
    unsigned sum, cnt, mine, sp = 0u;
    for (;;) {
        sum = 0u; cnt = 0u; mine = 0u;
#pragma unroll
        for (unsigned j = 0; j < 16; ++j) { const unsigned c = xb_ld(&bar[XB_XCNT(j)]); sum += c; cnt += (c > 0u) ? 1u : 0u; mine = (j == x) ? c : mine; }
        if (sum == G) break;
        __builtin_amdgcn_s_sleep(1);
        if ((++sp & 255u) == 0u) { if (xb_ld(&bar[XB_TMO])) break; if (sp > XB_SPIN_CAP) { atomicAdd(&bar[XB_TMO], 1u); break; } }
    }
    nloc = mine > 0u ? mine : 1u; nx = cnt > 0u ? cnt : 1u;
}
__device__ __forceinline__ void xcd_barrier(const XcdBarrier& b) {
    asm volatile("s_waitcnt vmcnt(0)" ::: "memory");
    __syncthreads();
    if (threadIdx.x == 0) {
        unsigned* bar = b.bar;
        __builtin_amdgcn_s_waitcnt(0);
        unsigned nloc = b.st[0], nx = b.st[1];
        if (nloc == 0u) { xcd_barrier_complete(bar, b.x, nloc, nx); b.st[0] = nloc; b.st[1] = nx; }
        const unsigned old = xb_add(&bar[XB_XSUB(b.x)], 1u);
        const unsigned gen = old / nloc;
        if (old + 1u == (gen + 1u) * nloc) {
            __builtin_amdgcn_fence(__ATOMIC_RELEASE, "agent");
            asm volatile("s_waitcnt vmcnt(0)" ::: "memory");
            const unsigned og = xb_add(&bar[XB_TOP], 1u);
            const unsigned tg = og / nx;
            if (og + 1u == (tg + 1u) * nx) xb_add(&bar[XB_TOPGEN], 1u);
            else XB_SPIN(xb_ld(&bar[XB_TOPGEN]) == tg, bar);
            __builtin_amdgcn_fence(__ATOMIC_ACQUIRE, "agent");
            xb_add(&bar[XB_XGEN(b.x)], 1u);
            asm volatile("s_waitcnt vmcnt(0)" ::: "memory");
        } else {
            XB_SPIN(xb_ld(&bar[XB_XGEN(b.x)]) == gen, bar);
            __builtin_amdgcn_fence(__ATOMIC_ACQUIRE, "agent");
            asm volatile("s_waitcnt vmcnt(0)" ::: "memory");
        }
    }
    __syncthreads();
}

constexpr int NWAVES = 8;
constexpr int RING_OFF = 0, RING_BYTES = 131072;
constexpr int LDSCTL_OFF = RING_BYTES, MISC_OFF = LDSCTL_OFF + 320;
constexpr int TBL_OFF = LDSCTL_OFF + 1024;
constexpr int LDS_BYTES = 147456;

struct Frame {
    LAS unsigned char* lds; volatile LAS unsigned* MISC; LAS int* tbl; gu32* ctl;
    int tid, lane, wave, vcu, G;
};

__device__ __forceinline__ void p0_transpose_item(const float* W, int K, int N, bf16* WT, int k0, int n0, int orow0, LAS float* scr, int lane) {
#pragma unroll 8
    for (int i = 0; i < 32; ++i) { const int kk = 2 * i + (lane >> 5); scr[kk * 33 + (lane & 31)] = W[(size_t)(k0 + kk) * N + n0 + (lane & 31)]; }
    LDS_WAIT(); asm volatile("" ::: "memory");
    const int c = lane & 7;
#pragma unroll
    for (int j = 0; j < 4; ++j) { const int n = (lane >> 3) + 8 * j; const LAS float* s = scr + (8 * c) * 33 + n;
        u32x4 o; o.x = pk2(s[0 * 33], s[1 * 33]); o.y = pk2(s[2 * 33], s[3 * 33]); o.z = pk2(s[4 * 33], s[5 * 33]); o.w = pk2(s[6 * 33], s[7 * 33]);
        *(GAS u32x4*)(WT + (size_t)(orow0 + n) * K + k0 + 8 * c) = o; }
    LDS_WAIT(); asm volatile("" ::: "memory");
}
__device__ __forceinline__ void p0_transpose_item_fp8(const float* W, int K, int N, unsigned char* WT, int k0, int n0, int orow0, LAS float* scr, int lane) {
#pragma unroll 8
    for (int i = 0; i < 32; ++i) { const int kk = 2 * i + (lane >> 5); scr[kk * 33 + (lane & 31)] = W[(size_t)(k0 + kk) * N + n0 + (lane & 31)]; }
    LDS_WAIT(); asm volatile("" ::: "memory");
    const int c = lane & 7;
#pragma unroll
    for (int j = 0; j < 4; ++j) { const int n = (lane >> 3) + 8 * j; const LAS float* sp = scr + (8 * c) * 33 + n;
        u32x2 o; o.x = pk4_fp8(sp[0 * 33] * 32.f, sp[1 * 33] * 32.f, sp[2 * 33] * 32.f, sp[3 * 33] * 32.f); o.y = pk4_fp8(sp[4 * 33] * 32.f, sp[5 * 33] * 32.f, sp[6 * 33] * 32.f, sp[7 * 33] * 32.f);
        *(GAS u32x2*)(WT + (size_t)(orow0 + n) * K + k0 + 8 * c) = o; }
    LDS_WAIT(); asm volatile("" ::: "memory");
}
__device__ __forceinline__ void rms_row_to_bf16(const float* xrow, const float* g, bf16* orow, int lane) {
    const GAS f32x4* xr = (const GAS f32x4*)xrow + lane; f32x4 v[4]; float s = 0.f;
#pragma unroll
    for (int j = 0; j < 4; ++j) { v[j] = xr[64 * j]; s += (v[j].x * v[j].x + v[j].y * v[j].y) + (v[j].z * v[j].z + v[j].w * v[j].w); }
    const float rstd = 1.f / sqrtf(wave_sum(s) * (1.f / D) + EPS);
    GAS unsigned long long* o8 = (GAS unsigned long long*)orow + lane;
#pragma unroll
    for (int j = 0; j < 4; ++j) { const f32x4 gg = ((const GAS f32x4*)g)[lane + 64 * j];
        o8[64 * j] = (unsigned long long)pk2(v[j].x * rstd * gg.x, v[j].y * rstd * gg.y) | ((unsigned long long)pk2(v[j].z * rstd * gg.z, v[j].w * rstd * gg.w) << 32); }
}

__device__ __forceinline__ void rms_row_to_fp8(const float* xrow, const float* g, unsigned char* orow, unsigned char* orow4, unsigned char* orow16, int lane) {
    const GAS f32x4* xr = (const GAS f32x4*)xrow + lane; f32x4 v[4]; float s = 0.f;
#pragma unroll
    for (int j = 0; j < 4; ++j) { v[j] = xr[64 * j]; s += (v[j].x * v[j].x + v[j].y * v[j].y) + (v[j].z * v[j].z + v[j].w * v[j].w); }
    const float rstd = 1.f / sqrtf(wave_sum(s) * (1.f / D) + EPS);
    GAS unsigned* o4 = (GAS unsigned*)orow + lane; GAS unsigned* p4 = (GAS unsigned*)orow4 + lane; GAS unsigned* p16 = (GAS unsigned*)orow16 + lane;
#pragma unroll
    for (int j = 0; j < 4; ++j) { const f32x4 gg = ((const GAS f32x4*)g)[lane + 64 * j]; const unsigned w = pk4_fp8(v[j].x * rstd * gg.x, v[j].y * rstd * gg.y, v[j].z * rstd * gg.z, v[j].w * rstd * gg.w);
        o4[64 * j] = w; p4[64 * j] = w; p16[64 * j] = w; }
}
constexpr float LOG2E = 1.4426950408889634f;
typedef __bf16 bf16x2_t __attribute__((ext_vector_type(2)));
__device__ __forceinline__ unsigned cvtpk_v(float lo, float hi) { const f32x2 v = {lo, hi}; const bf16x2_t b = __builtin_convertvector(v, bf16x2_t); return __builtin_bit_cast(unsigned, b); }
typedef long longx2 __attribute__((ext_vector_type(2)));
struct AttFrags { longx2 k0, k1; bf16x8 v[4]; };
__device__ __forceinline__ float gmax4(float m) {
    { auto rr = __builtin_amdgcn_permlane16_swap(__float_as_uint(m), __float_as_uint(m), false, false); m = fmaxf(__uint_as_float(rr[0]), __uint_as_float(rr[1])); }
    { auto rr = __builtin_amdgcn_permlane32_swap(__float_as_uint(m), __float_as_uint(m), false, false); m = fmaxf(__uint_as_float(rr[0]), __uint_as_float(rr[1])); }
    return m;
}
constexpr int RB_A = 160, RB_B = 320;
template <int NH, int RB>
__device__ __forceinline__ void band_group(f32x4 (&o)[NH][4], float (&mrun)[NH], float (&lrun)[NH], const unsigned char* qkvb, const int (&qcol)[NH], const int (&qmu0)[NH], const unsigned char* kh, const bf16* vt,
                                           int dil, int rho, int L, int qstep, int P0, int npairs, const LAS float* const (&tab)[NH], int lane) {
    const int t = lane & 15, g = lane >> 4;
    longx2 qf[NH]; int mu_t[NH];
#pragma unroll
    for (int h = 0; h < NH; ++h) { mu_t[h] = qmu0[h] + qstep * t; qf[h] = *(const longx2*)(qkvb + (size_t)(mu_t[h] * dil + rho) * NQKV + 16 * g + qcol[h]); }
    const int npr = L >> 5;
    const unsigned char* kbase = kh + ((size_t)rho * L) * 64 + 16 * g;
    const bf16* vtl = vt + (size_t)(rho * npr) * 2048 + t * 32 + 8 * g;
    auto load = [&](int P, AttFrags& f) {
        const int Pc = min(max(P, 0), npr - 1);
        const unsigned char* k0p = kbase + (size_t)(32 * Pc + t) * 64; const unsigned char* k1p = k0p + 16 * 64;
        f.k0 = *(const longx2*)k0p; f.k1 = *(const longx2*)k1p;
#pragma unroll
        for (int db = 0; db < 4; ++db) f.v[db] = *(const bf16x8*)(vtl + (size_t)Pc * 2048 + db * 512);
    };
    AttFrags cur; load(P0, cur);
    for (int pp = 0; pp < npairs; ++pp) {
        const int P = P0 + pp;
        AttFrags nxt; load(P0 + min(pp + 1, npairs - 1), nxt);
        if (P >= 0 && P < npr) {
            const int kap0 = 32 * P + 4 * g;
#pragma unroll
            for (int h = 0; h < NH; ++h) {
                const LAS float* tb_ = tab[h] + (kap0 - mu_t[h] + RB);
                f32x4 s0 = (f32x4){tb_[0], tb_[1], tb_[2], tb_[3]}, s1 = (f32x4){tb_[16], tb_[17], tb_[18], tb_[19]};
                s0 = __builtin_amdgcn_mfma_f32_16x16x32_fp8_fp8(cur.k0.x, qf[h].x, s0, 0, 0, 0); s0 = __builtin_amdgcn_mfma_f32_16x16x32_fp8_fp8(cur.k0.y, qf[h].y, s0, 0, 0, 0);
                s1 = __builtin_amdgcn_mfma_f32_16x16x32_fp8_fp8(cur.k1.x, qf[h].x, s1, 0, 0, 0); s1 = __builtin_amdgcn_mfma_f32_16x16x32_fp8_fp8(cur.k1.y, qf[h].y, s1, 0, 0, 0);
                float mx = fmaxf(fmaxf(fmaxf(s0[0], s0[1]), fmaxf(s0[2], s0[3])), fmaxf(fmaxf(s1[0], s1[1]), fmaxf(s1[2], s1[3])));
                mx = gmax4(mx);
                if (__any(mx > mrun[h])) { const float mn = fmaxf(mrun[h], mx), alpha = __builtin_amdgcn_exp2f(mrun[h] - mn); mrun[h] = mn; lrun[h] *= alpha;
#pragma unroll
                    for (int db = 0; db < 4; ++db) o[h][db] = o[h][db] * alpha; }
                const float mn = mrun[h]; float p[8], ps = 0.f;
#pragma unroll
                for (int j = 0; j < 8; ++j) { p[j] = __builtin_amdgcn_exp2f(((j < 4) ? s0[j & 3] : s1[j & 3]) - mn); ps += p[j]; }
                lrun[h] += ps;
                u32x4 pw; pw.x = cvtpk_v(p[0], p[1]); pw.y = cvtpk_v(p[2], p[3]); pw.z = cvtpk_v(p[4], p[5]); pw.w = cvtpk_v(p[6], p[7]);
                const bf16x8 pf = __builtin_bit_cast(bf16x8, pw);
#pragma unroll
                for (int db = 0; db < 4; ++db) o[h][db] = __builtin_amdgcn_mfma_f32_16x16x32_bf16(cur.v[db], pf, o[h][db], 0, 0, 0);
                if (NH > 2 && h + 1 < NH) __builtin_amdgcn_sched_barrier(0);
            }
        }
        cur = nxt;
    }
}
template <int NH>
__device__ __forceinline__ void band_store(const f32x4 (&o)[NH][4], const float (&lrun)[NH], unsigned char* const (&yrow)[NH], int lane) {
    const int g = lane >> 4;
#pragma unroll
    for (int h = 0; h < NH; ++h) { float l = lrun[h]; l += __shfl_xor(l, 16); l += __shfl_xor(l, 32); const float inv = 1.f / l;
#pragma unroll
        for (int db = 0; db < 4; ++db) *(unsigned*)(yrow[h] + 16 * db + 4 * g) = pk4_fp8(o[h][db][0] * inv, o[h][db][1] * inv, o[h][db][2] * inv, o[h][db][3] * inv); }
}

struct Args { const float* in[19]; float* out; unsigned char* ws; int ph_lo, ph_hi, li, pad; };
constexpr int NPHASE = 10;

__global__ void __launch_bounds__(NWAVES * 64, 2) mk_fwd(Args args) {
    extern __shared__ __attribute__((aligned(16))) unsigned char lds[];
    Frame F;
    F.lds = (LAS unsigned char*)lds; F.MISC = (volatile LAS unsigned*)(F.lds + MISC_OFF); F.tbl = (LAS int*)(F.lds + TBL_OFF);
    F.tid = threadIdx.x; F.lane = F.tid & 63; F.wave = __builtin_amdgcn_readfirstlane(F.tid >> 6);
    F.G = gridDim.x; { const int bx = blockIdx.x; F.vcu = (F.G % 8 == 0) ? (bx % 8) * (F.G / 8) + bx / 8 : bx; }
    unsigned char* ws = args.ws; F.ctl = (gu32*)(ws + WS_CTL);
    const float* x = args.in[0]; const float* norm_mix = args.in[1]; const float* w_in = args.in[2]; const float* b_in = args.in[3];
    const float* sinks = args.in[4]; const float* rel_bias = args.in[5]; const float* w_a = args.in[6]; const float* w_b = args.in[7];
    const float* w_out = args.in[8]; const float* norm_ffn = args.in[9]; const float* router_w = args.in[10]; const float* router_b = args.in[11];
    const float* w_gate = args.in[12]; const float* b_gate = args.in[13]; const float* w_up = args.in[14]; const float* b_up = args.in[15];
    const float* w_down = args.in[16]; const float* b_down = args.in[17]; const float* norm_final = args.in[18];
    float* out = args.out;
    Tabs* tb = (Tabs*)(ws + WS_TAB);
    bf16* Win_t = (bf16*)(ws + WS_WIN); bf16* Wa_t = (bf16*)(ws + WS_WA); bf16* Wb_t = (bf16*)(ws + WS_WB); bf16* Wout_t = (bf16*)(ws + WS_WOUT);
    unsigned char* Wgu8 = ws + WS_WGU; unsigned char* Wd8 = ws + WS_WD; unsigned char* H28 = ws + WS_H2; unsigned char* HS8 = ws + WS_HS; unsigned char* ACT8 = ws + WS_ACT; unsigned char* YS = ws + WS_YS;
    int* topi = (int*)(ws + WS_RT); float* topp = (float*)(ws + WS_RT + 256 * 1024); int* slot = (int*)(ws + WS_RT + 512 * 1024); int* pos = (int*)(ws + WS_RT + 768 * 1024);
    bf16* XN = (bf16*)(ws + WS_XN); bf16* QKV = (bf16*)(ws + WS_QKV); bf16* GATES = (bf16*)(ws + WS_GATES); bf16* YA = (bf16*)(ws + WS_YA); bf16* YB = (bf16*)(ws + WS_YB);
    bf16* MERGED = (bf16*)(ws + WS_MERGED);
    gu32* cnt = F.ctl + CW_CNT; int* rtc = (int*)(ws + WS_RTC);

    for (int u = F.tid; u < (LDS_BYTES - LDSCTL_OFF) / 4; u += NWAVES * 64) ((LAS unsigned*)(F.lds + LDSCTL_OFF))[u] = 0u;
    __syncthreads();
    XcdBarrier bar = xcd_barrier_post((unsigned*)(F.ctl + CW_BAR) + args.li * XCD_BAR_WORDS, F.MISC + 8);
    const int lo = args.ph_lo, hi = args.ph_hi;
#ifndef MK_SKIP
#define MK_SKIP 0
#endif
#define IN(k) (!((MK_SKIP >> (k)) & 1) && lo <= (k) && (k) < hi)
#ifndef MK_DUP
#define MK_DUP 0
#endif
#define REP(k) _Pragma("unroll") for (int rep_ = 0; rep_ < 1 + ((MK_DUP >> (k)) & 1); ++rep_)
#ifdef MK_TSTAMP
    unsigned long long ts_a = __builtin_amdgcn_s_memrealtime(), ts_b = ts_a;
#define SEAM(k) do { if (IN(k) && IN((k) + 1)) xcd_barrier(bar); if ((k) + 1 == MK_TSTAMP) ts_a = __builtin_amdgcn_s_memrealtime(); if ((k) == MK_TSTAMP) ts_b = __builtin_amdgcn_s_memrealtime(); } while (0)
#else
#define SEAM(k) do { if (IN(k) && IN((k) + 1)) xcd_barrier(bar); } while (0)
#endif
    const int gw = F.vcu * NWAVES + F.wave, NGW = F.G * NWAVES;

    LAS float* scr = (LAS float*)(F.lds + RING_OFF + F.wave * 16384);
    constexpr int I_IN = (D / 64) * (NPROJ / 32), I_A = (D / 64) * (D / 32), I_B = (256 / 64) * (D / 32), I_E = (D / 64) * (D / 32);
    constexpr int NITEMS = I_IN + 2 * I_A + I_B + 3 * NE * I_E;
    auto transpose_items = [&](int first, int last) {
    for (int it = first + gw; it < last; it += NGW) {
        int r = it;
        if (r < I_IN) { const int nb = NPROJ / 32; p0_transpose_item_fp8(w_in, D, NPROJ, (unsigned char*)Win_t, 64 * (r / nb), 32 * (r % nb), 32 * (r % nb), scr, F.lane); continue; } r -= I_IN;
        if (r < I_A) { const int nb = D / 32; p0_transpose_item_fp8(w_a, D, D, (unsigned char*)Wa_t, 64 * (r / nb), 32 * (r % nb), 32 * (r % nb), scr, F.lane); continue; } r -= I_A;
        if (r < I_A) { const int nb = D / 32; p0_transpose_item_fp8(w_out, D, D, (unsigned char*)Wout_t, 64 * (r / nb), 32 * (r % nb), 32 * (r % nb), scr, F.lane); continue; } r -= I_A;
        if (r < I_B) { const int nb = D / 32; p0_transpose_item_fp8(w_b, 256, D, (unsigned char*)Wb_t, 64 * (r / nb), 32 * (r % nb), 32 * (r % nb), scr, F.lane); continue; } r -= I_B;
        { const int e = r / (3 * I_E), q = r % (3 * I_E), which = q / I_E, ii = q % I_E, nb = D / 32, k0 = 64 * (ii / nb), n0 = 32 * (ii % nb);
          if (which == 0) p0_transpose_item_fp8(w_gate + (size_t)e * D * D, D, D, Wgu8, k0, n0, e * 2048 + (n0 >> 7) * 256 + (n0 & 127), scr, F.lane);
          else if (which == 1) p0_transpose_item_fp8(w_up + (size_t)e * D * D, D, D, Wgu8, k0, n0, e * 2048 + (n0 >> 7) * 256 + 128 + (n0 & 127), scr, F.lane);
          else p0_transpose_item_fp8(w_down + (size_t)e * D * D, D, D, Wd8, k0, n0, e * 1024 + n0, scr, F.lane); }
    }
    };
    if (IN(0)) REP(0) {
        { const int i = blockIdx.x * (NWAVES * 64) + F.tid;
          if (i < 16 * 257) { const int h = i / 257, r = i % 257; tb->biasA[h][r] = rel_bias[BKT_A[r] * 28 + h]; }
          if (i < 12 * 129) { const int g = i / (4 * 129), hs = (i / 129) % 4, r = i % 129; tb->biasB[g][hs][r] = rel_bias[BKT_B[g][r] * 28 + 16 + 4 * g + hs]; } }
        transpose_items(0, I_IN + 2 * I_A + I_B);
        for (int m = gw; m < T; m += NGW) { const int t0 = m & ~255, tl = m & 255;
            rms_row_to_fp8(x + (size_t)m * D, norm_mix, (unsigned char*)XN + (size_t)m * D, ws + WS_XNP + (size_t)(t0 + (tl & 3) * 64 + (tl >> 2)) * D,
                           ws + WS_XNP + (size_t)(T + t0 + (tl & 15) * 16 + (tl >> 4)) * D, F.lane); }
    }
    SEAM(0);
    if (IN(1)) REP(1) {
        int k512 = D / 2; asm volatile("" : "+s"(k512));
        pg8::Gemm g{XN, Win_t, k512}; pg8::ProjOrder So; So.so.init(T, NPROJ, F.G, (int)blockIdx.x);
        pg8::EpiProj E{QKV, GATES, b_in, (bf16*)(ws + WS_VT), (bf16*)(ws + WS_VT) + (size_t)2 * 4 * 64 * 8192, ws + WS_K2};
        pg8::gemm_phase<pg8::EpiProj, pg8::ProjOrder, true, true, true>(F.lds + RING_OFF, g, So, E);
    }
    SEAM(1);
    int nrep2 = 1 + ((MK_DUP >> 2) & 1); asm volatile("" : "+s"(nrep2));
    if (IN(2)) for (int rep_ = 0; rep_ < nrep2; ++rep_) {
        LAS float* lb = (LAS float*)(F.lds + RING_OFF);
        constexpr int TA = 2 * RB_A + 1, TB = 2 * RB_B + 1;
        for (int i = F.tid; i < 16 * TA; i += NWAVES * 64) { const int h = i / TA, rel = i % TA - RB_A; lb[i] = (rel >= -128 && rel <= 128) ? tb->biasA[h][rel + 128] * LOG2E : -3.0e38f; }
        for (int i = F.tid; i < 12 * TB; i += NWAVES * 64) { const int gh = i / TB, rel = i % TB - RB_B; lb[16 * TA + i] = (rel >= -64 && rel <= 64) ? tb->biasB[gh >> 2][gh & 3][rel + 64] * LOG2E : -3.0e38f; }
        __syncthreads();
        const bf16* VTA = (const bf16*)(ws + WS_VT); const bf16* VTB = VTA + (size_t)2 * 4 * 64 * 8192; const unsigned char* K2 = ws + WS_K2;
        for (int it = gw; it < 4096 + 2048; it += NGW) {
            const int t = F.lane & 15;
            if (it < 4096) {
                const int b = it >> 11, kvh = (it >> 9) & 3, qb = it & 511;
                f32x4 o[4][4]; float mr[4], lr[4];
#pragma unroll
                for (int h = 0; h < 4; ++h) { mr[h] = sinks[kvh * 4 + h] * LOG2E; lr[h] = (F.lane < 16) ? 1.f : 0.f;
#pragma unroll
                    for (int db = 0; db < 4; ++db) o[h][db] = (f32x4){0.f, 0.f, 0.f, 0.f}; }
                const int qcol[4] = {C_QA + (kvh * 4 + 0) * 64, C_QA + (kvh * 4 + 1) * 64, C_QA + (kvh * 4 + 2) * 64, C_QA + (kvh * 4 + 3) * 64};
                const int qmu[4] = {16 * qb, 16 * qb, 16 * qb, 16 * qb};
                const LAS float* const bias[4] = {lb + (kvh * 4 + 0) * TA, lb + (kvh * 4 + 1) * TA, lb + (kvh * 4 + 2) * TA, lb + (kvh * 4 + 3) * TA};
                band_group<4, RB_A>(o, mr, lr, (const unsigned char*)QKV + (size_t)b * S * NQKV, qcol, qmu, K2 + (size_t)((b * 4 + kvh) * 8192) * 64, VTA + (size_t)((b * 4 + kvh) * 64) * 8192, 1, 0, S, 1, (qb - 8) >> 1, 9, bias, F.lane);
                unsigned char* yr = (unsigned char*)YA + (size_t)(b * S + 16 * qb + t) * D + kvh * 256; unsigned char* const yrow[4] = {yr, yr + 64, yr + 128, yr + 192};
                band_store<4>(o, lr, yrow, F.lane);
            } else {
                const int j = it - 4096, r = j & 7, un = j >> 3, blk = un & 31, hs = (un >> 5) & 3, b = un >> 7, i0 = blk * 256;
                f32x4 o[2][4]; float mr[2], lr[2];
#pragma unroll
                for (int h = 0; h < 2; ++h) { mr[h] = -1.0e30f; lr[h] = 0.f;
#pragma unroll
                    for (int db = 0; db < 4; ++db) o[h][db] = (f32x4){0.f, 0.f, 0.f, 0.f}; }
                const unsigned char* qb_ = (const unsigned char*)QKV + (size_t)b * S * NQKV;
                { const int qcol[2] = {C_QB + 0 * 256 + hs * 64, C_QB + 0 * 256 + hs * 64}; const int qmu[2] = {i0 + r, i0 + r + 8}; const LAS float* const bias[2] = {lb + 16 * TA + (0 * 4 + hs) * TB, lb + 16 * TA + (0 * 4 + hs) * TB};
                  band_group<2, RB_B>(o, mr, lr, qb_, qcol, qmu, K2 + (size_t)((((0 + 1) * 2 + b) * 4 + hs) * 8192) * 64, VTB + (size_t)(((0 * 2 + b) * 4 + hs) * 64) * 8192, 1, 0, S, 16, (i0 >> 5) - 2, 12, bias, F.lane); }
                { const int qcol[2] = {C_QB + 1 * 256 + hs * 64, C_QB + 1 * 256 + hs * 64}; const int qmu[2] = {(i0 + r) >> 2, (i0 + r + 8) >> 2}; const LAS float* const bias[2] = {lb + 16 * TA + (1 * 4 + hs) * TB, lb + 16 * TA + (1 * 4 + hs) * TB};
                  band_group<2, RB_B>(o, mr, lr, qb_, qcol, qmu, K2 + (size_t)((((1 + 1) * 2 + b) * 4 + hs) * 8192) * 64, VTB + (size_t)(((1 * 2 + b) * 4 + hs) * 64) * 8192, 4, r & 3, S / 4, 4, (i0 >> 7) - 2, 6, bias, F.lane); }
#pragma unroll
                for (int h = 0; h < 2; ++h) { const int qcol[1] = {C_QB + 2 * 256 + hs * 64}; const int qmu[1] = {i0 >> 4}; const LAS float* const bias[1] = {lb + 16 * TA + (2 * 4 + hs) * TB};
                  band_group<1, RB_B>(*(f32x4(*)[1][4])&o[h], *(float(*)[1])&mr[h], *(float(*)[1])&lr[h], qb_, qcol, qmu, K2 + (size_t)((((2 + 1) * 2 + b) * 4 + hs) * 8192) * 64, VTB + (size_t)(((2 * 2 + b) * 4 + hs) * 64) * 8192,
                                    16, r + 8 * h, S / 16, 1, (blk - 4) >> 1, 5, bias, F.lane); }
                unsigned char* yr = (unsigned char*)YB + (size_t)(b * S + i0 + r + 16 * t) * 256 + hs * 64; unsigned char* const yrow[2] = {yr, yr + 8 * 256};
                band_store<2>(o, lr, yrow, F.lane);
            }
        }
        __syncthreads();
    }
    SEAM(2);
    if (IN(3)) REP(3) {
#ifndef NO_P3A
        { int k256 = 128; asm volatile("" : "+s"(k256)); pg8::Gemm g{YB, Wb_t, k256};   pg8::StaticOrder So; So.init(T, D, F.G, (int)blockIdx.x);
          pg8::EpiGate<0> E{MERGED, GATES, 1024, nullptr};
          pg8::gemm_phase<pg8::EpiGate<0>, pg8::StaticOrder, true, true, true>(F.lds + RING_OFF, g, So, E); }
#endif
        VM_WAIT(); __syncthreads();
#ifndef NO_P3B
        { int k512 = D / 2; asm volatile("" : "+s"(k512)); pg8::Gemm g{YA, Wa_t, k512}; pg8::StaticOrder So; So.init(T, D, F.G, (int)blockIdx.x);
          pg8::EpiGate<1> E{MERGED, GATES, 0, (unsigned char*)YA + (size_t)16 * MiB};
          pg8::gemm_phase<pg8::EpiGate<1>, pg8::StaticOrder, true, true, true>(F.lds + RING_OFF, g, So, E); }
#endif
    }
    SEAM(3);
    if (IN(4)) REP(4) {
        int k512 = D / 2; asm volatile("" : "+s"(k512)); pg8::Gemm g{(const bf16*)((unsigned char*)YA + (size_t)16 * MiB), Wout_t, k512}; pg8::StaticOrder So; So.init(T, D, F.G, (int)blockIdx.x);
        pg8::EpiX1 E{x, out};
        pg8::gemm_phase<pg8::EpiX1, pg8::StaticOrder, true, true, true>(F.lds + RING_OFF, g, So, E);
    }
    SEAM(4);
    if (IN(5)) REP(5) {
        const bool lastrep5 = (rep_ + 1 == 1 + ((MK_DUP >> 5) & 1));
        LAS int* lcnt = F.tbl + 72; LAS int* lbase = F.tbl + 104; LAS int* ebuf = F.tbl + 136; LAS int* pbuf = F.tbl + 392;
        LAS float* plog = (LAS float*)(F.lds + RING_OFF);
        LAS float* psq = plog + 8 * 64 * 32;
        LAS float* rstd_s = psq + 512;
        const int g = F.lane >> 4, e16 = F.lane & 15, w = F.wave;
        float wB[32][2];
#pragma unroll
        for (int sc = 0; sc < 32; ++sc) { const int k = 128 * w + 32 * (sc >> 3) + 8 * g + (sc & 7); const float gm = norm_ffn[k];
            wB[sc][0] = gm * router_w[(size_t)k * NE + e16]; wB[sc][1] = gm * router_w[(size_t)k * NE + 16 + e16]; }
        for (int tblk = F.vcu; tblk < T / 64; tblk += F.G) {
            if (F.tid < 32) lcnt[F.tid] = 0;
            f32x4 v[4][2];
            { const GAS float* xr = (const GAS float*)out + (size_t)(tblk * 64 + e16) * D + 128 * w + 8 * g;
#pragma unroll
              for (int s4 = 0; s4 < 4; ++s4) { v[s4][0] = *(const GAS f32x4*)(xr + 32 * s4); v[s4][1] = *(const GAS f32x4*)(xr + 32 * s4 + 4); } }
#pragma unroll 1
            for (int tile = 0; tile < 4; ++tile) {
                f32x4 vn[4][2];
                { const int tn = tile < 3 ? tile + 1 : 3; const GAS float* xr = (const GAS float*)out + (size_t)(tblk * 64 + tn * 16 + e16) * D + 128 * w + 8 * g;
#pragma unroll
                  for (int s4 = 0; s4 < 4; ++s4) { vn[s4][0] = *(const GAS f32x4*)(xr + 32 * s4); vn[s4][1] = *(const GAS f32x4*)(xr + 32 * s4 + 4); } }
                float sq = 0.f;
#pragma unroll
                for (int s4 = 0; s4 < 4; ++s4) sq += (v[s4][0].x * v[s4][0].x + v[s4][0].y * v[s4][0].y) + (v[s4][0].z * v[s4][0].z + v[s4][0].w * v[s4][0].w)
                                                   + (v[s4][1].x * v[s4][1].x + v[s4][1].y * v[s4][1].y) + (v[s4][1].z * v[s4][1].z + v[s4][1].w * v[s4][1].w);
                sq += __shfl_xor(sq, 16); sq += __shfl_xor(sq, 32);
                if (g == 0) psq[w * 64 + tile * 16 + e16] = sq;
                f32x4 a0 = (f32x4){0.f, 0.f, 0.f, 0.f}, a1 = (f32x4){0.f, 0.f, 0.f, 0.f};
#pragma unroll
                for (int s4 = 0; s4 < 4; ++s4)
#pragma unroll
                    for (int c = 0; c < 8; ++c) { const float av = v[s4][c >> 2][c & 3];
                        a0 = __builtin_amdgcn_mfma_f32_16x16x4f32(av, wB[s4 * 8 + c][0], a0, 0, 0, 0); a1 = __builtin_amdgcn_mfma_f32_16x16x4f32(av, wB[s4 * 8 + c][1], a1, 0, 0, 0); }
#pragma unroll
                for (int r = 0; r < 4; ++r) { LAS float* pr = plog + (size_t)(w * 64 + tile * 16 + 4 * g + r) * 32 + e16; pr[0] = a0[r]; pr[16] = a1[r]; }
#pragma unroll
                for (int s4 = 0; s4 < 4; ++s4) { v[s4][0] = vn[s4][0]; v[s4][1] = vn[s4][1]; }
            }
            __syncthreads();
            if (F.tid < 64) { float s = 0.f;
#pragma unroll
                for (int ww = 0; ww < 8; ++ww) s += psq[ww * 64 + F.tid];
                rstd_s[F.tid] = 1.f / sqrtf(s * (1.f / D) + EPS); }
            __syncthreads();
            { const int e = F.tid & 31; const float rbv = router_b[e];
#pragma unroll 1
              for (int i = 0; i < 4; ++i) { const int tl = (F.tid >> 5) + 16 * i; float lg = 0.f;
#pragma unroll
                for (int ww = 0; ww < 8; ++ww) lg += plog[(size_t)(ww * 64 + tl) * 32 + e];
                float val = lg * rstd_s[tl] + rbv; float tv[4]; int ti[4];
#pragma unroll
                for (int r = 0; r < 4; ++r) {
                    float bv = val; int bi = e;
#pragma unroll
                    for (int o = 1; o < 32; o <<= 1) { const float ov = __shfl_xor(bv, o); const int oi = __shfl_xor(bi, o); if (ov > bv || (ov == bv && oi < bi)) { bv = ov; bi = oi; } }
                    tv[r] = bv; ti[r] = bi; if (bi == e) val = -3.0e38f;
                }
                const float e1 = __expf(tv[1] - tv[0]), e2 = __expf(tv[2] - tv[0]), e3 = __expf(tv[3] - tv[0]); const float inv = 1.f / (1.f + e1 + e2 + e3);
                if (e < 4) { const float p = (e == 0 ? 1.f : e == 1 ? e1 : e == 2 ? e2 : e3) * inv; const int ex = (e == 0 ? ti[0] : e == 1 ? ti[1] : e == 2 ? ti[2] : ti[3]);
                    const int m = tblk * 64 + tl; topi[m * 4 + e] = ex; topp[m * 4 + e] = p;
                    const int li = tl * 4 + e; ebuf[li] = ex; pbuf[li] = __hip_atomic_fetch_add(&lcnt[ex], 1, __ATOMIC_RELAXED, __HIP_MEMORY_SCOPE_WORKGROUP); } } }
#pragma unroll 1
            for (int rb = 0; rb < 8; rb += 4) { f32x4 xv[4][4];
#pragma unroll
                for (int r = 0; r < 4; ++r) { const GAS f32x4* xr4 = (const GAS f32x4*)(out + ((size_t)tblk * 64 + w * 8 + rb + r) * D) + F.lane;
#pragma unroll
                    for (int j = 0; j < 4; ++j) xv[r][j] = xr4[64 * j]; }
#pragma unroll
                for (int r = 0; r < 4; ++r) { const int tl = w * 8 + rb + r; const float rstd = rstd_s[tl]; GAS unsigned* o4 = (GAS unsigned*)(H28 + ((size_t)tblk * 64 + tl) * D) + F.lane;
#pragma unroll
                    for (int j = 0; j < 4; ++j) { const f32x4 gg = ((const GAS f32x4*)norm_ffn)[F.lane + 64 * j];
                        o4[64 * j] = pk4_fp8(xv[r][j].x * rstd * gg.x, xv[r][j].y * rstd * gg.y, xv[r][j].z * rstd * gg.z, xv[r][j].w * rstd * gg.w); } } }
            __syncthreads();
            if (F.tid < 32) lbase[F.tid] = lastrep5 ? (int)__hip_atomic_fetch_add(cnt + F.tid, (unsigned)lcnt[F.tid], RLX_AGENT) : 0;
            __syncthreads();
            if (F.tid < 256) { const int ex = ebuf[F.tid], ps = lbase[ex] + pbuf[F.tid]; pos[tblk * 256 + F.tid] = ps; rtc[(size_t)ex * T + ps] = tblk * 64 + (F.tid >> 2); }
            __syncthreads();
        }
    }
    if (IN(5)) transpose_items(I_IN + 2 * I_A + I_B, NITEMS);
    SEAM(5);
    if (IN(7) || IN(8) || IN(9)) {
        LAS int* loff = F.tbl; LAS int* ltoff = F.tbl + 36; LAS int* lc = F.tbl + 72;
        if (F.tid < 32) lc[F.tid] = (int)__hip_atomic_load(cnt + F.tid, RLX_AGENT);
        __syncthreads();
        if (F.tid == 0) { int a = 0, ta = 0; for (int e = 0; e < NE; ++e) { loff[e] = a; ltoff[e] = ta; const int c = lc[e]; a += c; ta += (c + 255) >> 8; } loff[NE] = a; ltoff[NE] = ta; }
        __syncthreads();
    }
    if (IN(7)) REP(7) {
        int k512 = D / 2; asm volatile("" : "+s"(k512));
        pg8::Gemm g{(const bf16*)H28, (const bf16*)Wgu8, k512, rtc}; pg8::GroupOrder So{F.tbl + 36, F.tbl, 8, F.G, (int)blockIdx.x, 0, T};   So.nunits = __builtin_amdgcn_readfirstlane(F.tbl[36 + NE]) * 8;
        pg8::EpiSwiglu E{ACT8, b_gate, b_up};
        pg8::gemm_phase<pg8::EpiSwiglu, pg8::GroupOrder, true, FP8_SP2, true, true>(F.lds + RING_OFF, g, So, E);
    }
    SEAM(7);
    if (IN(8)) REP(8) {
        int k512 = D / 2; asm volatile("" : "+s"(k512));
        pg8::Gemm g{(const bf16*)ACT8, (const bf16*)Wd8, k512}; pg8::GroupOrder So{F.tbl + 36, F.tbl, 4, F.G, (int)blockIdx.x, 0, 0}; So.nunits = __builtin_amdgcn_readfirstlane(F.tbl[36 + NE]) * 4;
        pg8::EpiDown E{YS, b_down};
        pg8::gemm_phase<pg8::EpiDown, pg8::GroupOrder, true, FP8_SP2, true>(F.lds + RING_OFF, g, So, E);
    }
    SEAM(8);
#ifdef MK_XBAR
    for (int xb_ = 0; xb_ < MK_XBAR; ++xb_) xcd_barrier(bar);
#endif
    if (IN(9)) REP(9) {
        const unsigned char* ys = YS;
        const int lane9 = (int)__builtin_amdgcn_mbcnt_hi(~0u, __builtin_amdgcn_mbcnt_lo(~0u, 0u));
        float* dst9 = (rep_ + 1 < 1 + ((MK_DUP >> 9) & 1)) ? (float*)(ws + WS_ACT) : out;
        for (int m0 = gw; m0 < T; m0 += 2 * NGW) {
            f32x4 v[2][4]; int sl[2][4]; float pr[2][4]; unsigned yv[2][4][4]; bool ok[2];
#pragma unroll
            for (int q = 0; q < 2; ++q) { const int m = m0 + q * NGW; ok[q] = m < T; const int mc = ok[q] ? m : m0; const GAS f32x4* xr = (const GAS f32x4*)(out + (size_t)mc * D) + lane9;
#pragma unroll
                for (int j = 0; j < 4; ++j) v[q][j] = xr[64 * j];
#pragma unroll
                for (int k = 0; k < 4; ++k) { sl[q][k] = F.tbl[topi[mc * 4 + k]] + pos[mc * 4 + k]; pr[q][k] = topp[mc * 4 + k]; } }
#pragma unroll
            for (int q = 0; q < 2; ++q)
#pragma unroll
                for (int k = 0; k < 4; ++k) { const GAS unsigned* yr = (const GAS unsigned*)(ys + (size_t)sl[q][k] * D) + lane9;
#pragma unroll
                    for (int j = 0; j < 4; ++j) yv[q][k][j] = yr[64 * j]; }
#pragma unroll
            for (int q = 0; q < 2; ++q) { if (!ok[q]) continue; const int m = m0 + q * NGW;
#pragma unroll
                for (int k = 0; k < 4; ++k) { const float p = pr[q][k];
#pragma unroll
                    for (int j = 0; j < 4; ++j) { const unsigned u = yv[q][k][j]; const f32x2 lo = __builtin_amdgcn_cvt_pk_f32_fp8(u, false), hi = __builtin_amdgcn_cvt_pk_f32_fp8(u, true);
                        v[q][j].x += p * lo.x; v[q][j].y += p * lo.y; v[q][j].z += p * hi.x; v[q][j].w += p * hi.y; } }
                float s = 0.f;
#pragma unroll
                for (int j = 0; j < 4; ++j) s += (v[q][j].x * v[q][j].x + v[q][j].y * v[q][j].y) + (v[q][j].z * v[q][j].z + v[q][j].w * v[q][j].w);
                const float rstd = 1.f / sqrtf(wave_sum(s) * (1.f / D) + EPS);
#pragma unroll
                for (int j = 0; j < 4; ++j) { const f32x4 gg = ((const GAS f32x4*)norm_final)[lane9 + 64 * j]; f32x4 y; y.x = v[q][j].x * rstd * gg.x; y.y = v[q][j].y * rstd * gg.y; y.z = v[q][j].z * rstd * gg.z; y.w = v[q][j].w * rstd * gg.w;
                    ((GAS f32x4*)(dst9 + (size_t)m * D) + lane9)[64 * j] = y; } }
        }
    }
#ifdef MK_TSTAMP
    if (MK_TSTAMP == 9) ts_b = __builtin_amdgcn_s_memrealtime();
    if (blockIdx.x == 0) { const unsigned long long dt = ts_b - ts_a, t0_ = __builtin_amdgcn_s_memrealtime();
        while (__builtin_amdgcn_s_memrealtime() - t0_ < 2 * dt) __builtin_amdgcn_s_sleep(8); }
#endif
#undef IN
#undef SEAM
}

extern "C" void kernel_launch(void* const* d_in, const int* in_sizes, int n_in, void* d_out, int out_size, void* d_ws, size_t ws_size, hipStream_t stream) {
    static int grid = 0;
    if (grid == 0) {
        if (n_in != 19 || in_sizes[0] != T * D || out_size != T * D || ws_size < WS_END) { fprintf(stderr, "kernel_launch: unexpected shapes (n_in %d, ws %zu); nothing launched\n", n_in, ws_size); grid = -1; return; }
        int dev = 0, cus = 0, per_cu = 0;
        if (hipGetDevice(&dev) != hipSuccess || hipDeviceGetAttribute(&cus, hipDeviceAttributeMultiprocessorCount, dev) != hipSuccess) { grid = -1; return; }
        if (hipFuncSetAttribute((const void*)mk_fwd, hipFuncAttributeMaxDynamicSharedMemorySize, LDS_BYTES) != hipSuccess) { fprintf(stderr, "kernel_launch: hipFuncSetAttribute failed\n"); grid = -1; return; }
        if (hipOccupancyMaxActiveBlocksPerMultiprocessor(&per_cu, (const void*)mk_fwd, NWAVES * 64, LDS_BYTES) != hipSuccess || per_cu < 1) { fprintf(stderr, "kernel_launch: occupancy query says %d blocks per CU\n", per_cu); }
        (void)hipGetLastError();
        grid = cus;
        if (grid != 256) fprintf(stderr, "kernel_launch: %d CUs (built and tuned for 256)\n", grid);
    }
    if (grid < 0) return;
    if (hipMemsetAsync((char*)d_ws + WS_CTL, 0, CTL_ZERO_BYTES, stream) != hipSuccess) return;
    Args a{};
    for (int i = 0; i < 19; ++i) a.in[i] = (const float*)d_in[i];
    a.out = (float*)d_out; a.ws = (unsigned char*)d_ws;
#if MK_MODE == 2
    a.ph_lo = 0; a.ph_hi = NPHASE; a.li = 0;
    hipLaunchKernelGGL(mk_fwd, dim3(grid), dim3(NWAVES * 64), LDS_BYTES, stream, a);
#else
    for (int ph = 0; ph < NPHASE; ++ph) { a.ph_lo = ph; a.ph_hi = ph + 1; a.li = ph; hipLaunchKernelGGL(mk_fwd, dim3(grid), dim3(NWAVES * 64), LDS_BYTES, stream, a); }
#endif
}
```

```cpp
#ifndef MK_FUSE78
#define MK_FUSE78 0
#endif
#ifndef MK_NO_NT
#define MK_NTLOAD 1
#define MK_NTSTORE 1
#endif
#include <hip/hip_runtime.h>
#include <stdint.h>
#include <stdio.h>

#ifndef FP8_SP2
#define FP8_SP2 true
#endif
#ifndef MK_MODE
#define MK_MODE 2
#endif

typedef unsigned short bf16;
typedef short bf16x8 __attribute__((ext_vector_type(8)));
typedef float f32x4 __attribute__((ext_vector_type(4)));
typedef float f32x2 __attribute__((ext_vector_type(2)));
typedef unsigned u32x4 __attribute__((ext_vector_type(4)));
typedef unsigned u32x2 __attribute__((ext_vector_type(2)));
#define GAS __attribute__((address_space(1)))
#define LAS __attribute__((address_space(3)))
typedef GAS unsigned gu32;

constexpr int T = 16384, S = 8192, D = 1024, NPROJ = 5888, NQKV = 3840, NGATE = 2048, NE = 32, TOPK = 4;
constexpr int C_QA = 0, C_KA = 1024, C_VA = 1280, C_QB = 1536, C_KB = 2304, C_VB = 3072;
constexpr float EPS = 1e-5f;
constexpr int KC = 1280;
constexpr size_t MiB = 1u << 20;
constexpr size_t WS_CTL = 0, CTL_ZERO_BYTES = 1 * MiB;
constexpr size_t WS_TAB = 1 * MiB;
constexpr size_t WS_WIN = 2 * MiB;
constexpr size_t WS_WA = 14 * MiB;
constexpr size_t WS_WB = 16 * MiB;
constexpr size_t WS_WOUT = 17 * MiB;
constexpr size_t WS_RT = 19 * MiB;
constexpr size_t WS_RTC = 20 * MiB;
constexpr size_t WS_WGU = 24 * MiB;
constexpr size_t WS_WD = 88 * MiB;
constexpr size_t WS_H2 = 120 * MiB;
constexpr size_t WS_HS = 136 * MiB;
constexpr size_t WS_ACT = 201 * MiB;
constexpr size_t WS_YS = 272 * MiB;
constexpr size_t WS_XN = 216 * MiB;
constexpr size_t WS_XNP = 312 * MiB;
constexpr size_t WS_K2 = 344 * MiB;
constexpr size_t WS_QKV = 248 * MiB;
constexpr size_t WS_GATES = 368 * MiB;
constexpr size_t WS_YA = 432 * MiB;
constexpr size_t WS_YB = 464 * MiB;
constexpr size_t WS_MERGED = 472 * MiB;
constexpr size_t WS_VT = 472 * MiB;
constexpr size_t WS_END = 506 * MiB;
constexpr int CW_CNT = 0;
constexpr int CW_RDY = 65536;
constexpr int CW_TMO = 48;
constexpr int CW_BAR = 4096;

__device__ const unsigned char BKT_A[257] = {12,12,12,12,12,12,12,12,12,12,12,12,12,12,12,12,12,12,12,12,12,12,12,12,12,12,12,12,12,12,12,12,12,12,12,12,12,12,11,11,11,11,11,11,11,11,11,11,11,11,11,11,11,11,11,11,11,11,11,11,11,11,11,11,11,11,11,11,11,11,11,11,11,11,11,11,11,11,11,10,10,10,10,10,10,10,10,10,10,10,10,10,10,10,10,10,10,10,10,10,10,10,9,9,9,9,9,9,9,9,9,9,9,9,8,8,8,8,8,8,8,7,6,5,4,3,2,1,0,17,18,19,20,21,22,23,24,24,24,24,24,24,24,25,25,25,25,25,25,25,25,25,25,25,25,26,26,26,26,26,26,26,26,26,26,26,26,26,26,26,26,26,26,26,26,26,26,26,27,27,27,27,27,27,27,27,27,27,27,27,27,27,27,27,27,27,27,27,27,27,27,27,27,27,27,27,27,27,27,27,27,27,27,27,27,27,27,27,27,28,28,28,28,28,28,28,28,28,28,28,28,28,28,28,28,28,28,28,28,28,28,28,28,28,28,28,28,28,28,28,28,28,28,28,28,28,28};
__device__ const unsigned char BKT_B[3][129] = {
 {11,11,11,11,11,11,11,11,11,11,11,11,11,11,11,10,10,10,10,10,10,10,10,10,10,10,10,10,10,10,10,10,10,10,10,10,10,10,9,9,9,9,9,9,9,9,9,9,9,9,8,8,8,8,8,8,8,7,6,5,4,3,2,1,0,17,18,19,20,21,22,23,24,24,24,24,24,24,24,25,25,25,25,25,25,25,25,25,25,25,25,26,26,26,26,26,26,26,26,26,26,26,26,26,26,26,26,26,26,26,26,26,26,26,27,27,27,27,27,27,27,27,27,27,27,27,27,27,27},
 {13,13,13,13,13,13,13,13,13,13,13,13,13,13,13,13,13,13,13,13,13,13,13,12,12,12,12,12,12,12,12,12,12,12,12,12,12,12,12,12,12,12,11,11,11,11,11,11,11,11,11,11,10,10,10,10,10,10,9,9,9,8,8,4,0,20,24,24,25,25,25,26,26,26,26,26,26,27,27,27,27,27,27,27,27,27,27,28,28,28,28,28,28,28,28,28,28,28,28,28,28,28,28,28,28,28,29,29,29,29,29,29,29,29,29,29,29,29,29,29,29,29,29,29,29,29,29,29,29},
 {15,15,15,15,15,15,15,15,15,15,15,15,15,15,15,15,15,15,15,15,15,15,15,15,15,15,15,15,15,15,14,14,14,14,14,14,14,14,14,14,14,14,14,14,14,13,13,13,13,13,13,13,13,13,12,12,12,12,12,11,11,10,10,9,0,25,26,26,27,27,28,28,28,28,28,29,29,29,29,29,29,29,29,29,30,30,30,30,30,30,30,30,30,30,30,30,30,30,30,31,31,31,31,31,31,31,31,31,31,31,31,31,31,31,31,31,31,31,31,31,31,31,31,31,31,31,31,31,31}};

#define RLX_AGENT __ATOMIC_RELAXED, __HIP_MEMORY_SCOPE_AGENT
#define LDS_WAIT() asm volatile("s_waitcnt lgkmcnt(0)" ::: "memory")
#define VM_WAIT() asm volatile("s_waitcnt vmcnt(0)" ::: "memory")
__device__ __forceinline__ unsigned f2bf(float f) { unsigned u = __builtin_bit_cast(unsigned, f); return (u + 0x7fffu + ((u >> 16) & 1u)) >> 16; }
__device__ __forceinline__ unsigned pk2(float lo, float hi) { return f2bf(lo) | (f2bf(hi) << 16); }
__device__ __forceinline__ unsigned pk4_fp8(float a, float b, float c, float d) { unsigned w = 0; w = __builtin_amdgcn_cvt_pk_fp8_f32(a, b, w, false); w = __builtin_amdgcn_cvt_pk_fp8_f32(c, d, w, true); return w; }
__device__ __forceinline__ float bf2f(unsigned b) { return __builtin_bit_cast(float, b << 16); }
__device__ __forceinline__ float bflo(unsigned u) { return __builtin_bit_cast(float, u << 16); }
__device__ __forceinline__ float bfhi(unsigned u) { return __builtin_bit_cast(float, u & 0xffff0000u); }
__device__ __forceinline__ float wave_sum(float v) {
#pragma unroll
    for (int o = 1; o < 64; o <<= 1) v += __shfl_xor(v, o);
    return v;
}
__device__ __forceinline__ float sigm(float x) { return __builtin_amdgcn_rcpf(1.f + __builtin_amdgcn_exp2f(-1.4426950408889634f * x)); }

struct Tabs { float biasA[16][257]; float biasB[3][4][129]; };

namespace pg8 {
#define PG8_LAS __attribute__((address_space(3)))
typedef unsigned short bf16_t;
constexpr int BM = 256, BK = 64, HALF = 128, HTB = HALF * BK * 2, STAGE_BYTES = 8 * HTB, NXCD = 8, WGM = 8;
__host__ __device__ __forceinline__ int lds_byte(int r, int c) { const int st = (r >> 4) * 2 + (c >> 5), rr = r & 15, cc = c & 31, ob = rr * 64 + cc * 2; return st * 1024 + (ob ^ (((ob >> 9) & 1) << 5)); }
__host__ __device__ __forceinline__ void stage_rc(int b, int& R, int& C) { const int st = b / 1024, sb = b % 1024, swz = sb ^ (((sb >> 9) & 1) << 5); R = (st >> 1) * 16 + swz / 64; C = (st & 1) * 32 + (swz % 64) / 2; }
__host__ __device__ __forceinline__ int perm32(int rho) { const int n = rho >> 4, i = rho & 15; return 8 * (i >> 2) + 4 * n + (i & 3); }

struct Unit { int arow, brow, nrows, e, swap, aidx, mt; };
struct Gemm { const bf16_t* A; const bf16_t* Bt; int K; const int* gidx; };

struct StaticOrder {
    static constexpr bool BPERM = false;
    int nM, nN, nwg, G, c;
    __device__ void init(int M, int N, int G_, int c_) { nM = M / BM; nN = N / BM; nwg = nM * nN; G = G_; c = c_; }
    __device__ bool next(int i, Unit& u) const {
        const long L = (long)i * G + c; if (L >= nwg) return false;
        int wgid = (int)L; { const int q = nwg / NXCD, r = nwg % NXCD, xcd = wgid % NXCD, off = wgid / NXCD; wgid = (xcd < r ? xcd * (q + 1) : r * (q + 1) + (xcd - r) * q) + off; }
        const int nig = WGM * nN, gid = wgid / nig, fm = gid * WGM, gsz = (nM - fm) < WGM ? (nM - fm) : WGM;
        u.arow = BM * (fm + ((wgid % nig) % gsz)); u.brow = BM * ((wgid % nig) / gsz); u.nrows = BM; u.e = 0; u.swap = 0; u.aidx = 0; return true;
    }
    __device__ __forceinline__ void a_ready(const Unit&) const {}
    __device__ __forceinline__ void done(const Unit&) const {}
    __device__ __forceinline__ bool defer() const { return false; }
    __device__ __forceinline__ void publish(int) const {}
};
constexpr int XNP_ROW0 = (int)((WS_XNP - WS_XN) / D);
struct ProjOrder {
    static constexpr bool BPERM = true;
    StaticOrder so;
    __device__ bool next(int i, Unit& u) const { if (!so.next(i, u)) return false;
        if (u.brow == C_VA || (u.brow >= C_VB && u.brow < NQKV)) { const int a = u.arow; u.arow = u.brow; u.brow = a; u.swap = 1; u.e = a;
            if (u.arow == C_VB + 256) u.aidx = 1; else if (u.arow == C_VB + 512) u.aidx = 2; } return true; }
    __device__ __forceinline__ void a_ready(const Unit&) const {}
    __device__ __forceinline__ void done(const Unit&) const {}
    __device__ __forceinline__ bool defer() const { return false; }
    __device__ __forceinline__ void publish(int) const {}
};
struct GroupOrder {
    static constexpr bool BPERM = false;
    const PG8_LAS int* toff; const PG8_LAS int* off; int NT, G, c, nunits, cap;
    unsigned* ready = nullptr; int mode = 0; unsigned need = 0; unsigned* tmo = nullptr;
    __device__ bool next(int i, Unit& u) const {
        int L;
        if (G & 7) { L = i * G + c; }
        else { const int q = (nunits + 7) >> 3, j = i * (G >> 3) + (c >> 3); if (j >= q) return false; L = (c & 7) * q + j; }
        if (L >= nunits) return false;
        const int mtg = L / NT, pn = L - mtg * NT;
        int e = 0;
        for (int j = 1; j < NE; ++j) e += (toff[j] <= mtg) ? 1 : 0;
        e = __builtin_amdgcn_readfirstlane(e);
        const int mt = mtg - __builtin_amdgcn_readfirstlane(toff[e]); const int o0 = __builtin_amdgcn_readfirstlane(off[e]), o1 = __builtin_amdgcn_readfirstlane(off[e + 1]);
        u.arow = o0 + BM * mt; const int rem = o1 - u.arow; u.nrows = rem < BM ? rem : BM; u.brow = (e * NT + pn) * BM; u.e = e; u.swap = 0; u.aidx = e * cap + BM * mt; u.mt = mtg; return true;
    }
    __device__ __forceinline__ void a_ready(const Unit& u) const {
        if (mode != 2) return;
        if (threadIdx.x < 64) {
            const unsigned long long t0 = __builtin_amdgcn_s_memrealtime(); unsigned polls = 0;
            while ((unsigned)__builtin_amdgcn_readfirstlane(__hip_atomic_load(ready + 64 * u.mt, __ATOMIC_RELAXED, __HIP_MEMORY_SCOPE_AGENT)) < need) {
                if ((++polls & 255u) == 0u && __builtin_amdgcn_readfirstlane(__hip_atomic_load(tmo, __ATOMIC_RELAXED, __HIP_MEMORY_SCOPE_AGENT)) != 0u) break;
                if (__builtin_amdgcn_s_memrealtime() - t0 > 2000000ull) { if (threadIdx.x == 0) __hip_atomic_store(tmo, 1u, __ATOMIC_RELAXED, __HIP_MEMORY_SCOPE_AGENT); break; }
                __builtin_amdgcn_s_sleep(2); }
            __builtin_amdgcn_fence(__ATOMIC_ACQUIRE, "agent");
            asm volatile("s_waitcnt vmcnt(0)" ::: "memory");
        }
        asm volatile("" ::: "memory"); __builtin_amdgcn_s_barrier(); asm volatile("" ::: "memory");
    }
    __device__ __forceinline__ void done(const Unit& u) const {
        if (mode != 1) return;
        asm volatile("s_waitcnt vmcnt(0)" ::: "memory");
        if ((threadIdx.x & 63) == 0) __hip_atomic_fetch_add(ready + 64 * u.mt, 1u, __ATOMIC_RELAXED, __HIP_MEMORY_SCOPE_AGENT);
    }
    __device__ __forceinline__ bool defer() const { return mode == 1; }
    __device__ __forceinline__ void publish(int mt) const {
        if ((threadIdx.x & 63) == 0) __hip_atomic_fetch_add(ready + 64 * mt, 1u, __ATOMIC_RELAXED, __HIP_MEMORY_SCOPE_AGENT);
    }
};

__device__ __forceinline__ void st16_wt(void* p, u32x4 v) { asm volatile("global_store_dwordx4 %0, %1, off sc1\n\ts_nop 2" :: "v"(p), "v"(v) : "memory"); }
__device__ __forceinline__ void st8_wt(void* p, u32x2 v) { asm volatile("global_store_dwordx2 %0, %1, off sc1\n\ts_nop 2" :: "v"(p), "v"(v) : "memory"); }
__device__ __forceinline__ u32x4 pair16(u32x2 xa, u32x2 xb) {
    const auto a = __builtin_amdgcn_permlane16_swap(xa.x, xb.x, false, false), b = __builtin_amdgcn_permlane16_swap(xa.y, xb.y, false, false);
    u32x4 r; r.x = a[0]; r.y = b[0]; r.z = a[1]; r.w = b[1]; return r; }
__device__ __forceinline__ unsigned cvt_pk_bf16(float lo, float hi) { unsigned r; asm volatile("v_cvt_pk_bf16_f32 %0, %1, %2" : "=v"(r) : "v"(lo), "v"(hi)); return r; }

struct EpiProj {
    static constexpr bool PERM = true, AFTER_DRAIN = false; static constexpr int MID_T = 0; static constexpr int TAG = 1;
    bf16_t* qkv; bf16_t* gates; const float* bias; bf16_t* vta; bf16_t* vtb; unsigned char* k2;
    __device__ __forceinline__ void prefetch(const Unit& u, PG8_LAS unsigned char* slot, int wid, int lane) const {
        if (wid == 0) { int l4 = 4 * lane; asm volatile("" : "+v"(l4));
            __builtin_amdgcn_global_load_lds((const unsigned*)(bias + (u.swap ? u.arow : u.brow) + l4), (PG8_LAS unsigned*)slot, 16, 0, 0); } }
    __device__ __forceinline__ void operator()(const f32x4 (&acc)[2][2][4][2], const Unit& u, int wr, int wc, int fr, int fq, const PG8_LAS unsigned char* slot) const {
        if (!u.swap) {
            const int colt = u.brow; const bool isq = colt < NQKV; unsigned char* base = isq ? (unsigned char*)qkv : (unsigned char*)gates; const int ldc = isq ? NQKV : NGATE; const int cb = isq ? colt : colt - NQKV;
            const int row0 = u.arow + wr * 64 + fr, col0 = cb + wc * 32 + 8 * fq;
            const PG8_LAS f32x4* bl = (const PG8_LAS f32x4*)(slot + (wc * 32 + 8 * fq) * 4);
            const float qs = (colt < C_KA || (colt >= C_QB && colt < C_KB)) ? 0.125f * 1.4426950408889634f : 1.f;
            const bool isk = (colt == C_KA) || (colt >= C_KB && colt < C_VB);
            if (!isk) {
            int odd; asm volatile("v_mbcnt_lo_u32_b32 %0, -1, 0\n\tv_mbcnt_hi_u32_b32 %0, -1, %0" : "=v"(odd)); odd = (odd >> 4) & 1; const int colp = col0 - 8 * odd;
#pragma unroll
            for (int ai = 0; ai < 2; ++ai)
#pragma unroll
                for (int mp = 0; mp < 4; mp += 2) { unsigned char* rowp = base + (size_t)(row0 + ai * HALF + (mp + odd) * 16) * ldc + colp;
#pragma unroll
                    for (int bj = 0; bj < 2; ++bj) { u32x2 w[2];
#pragma unroll
                        for (int q = 0; q < 2; ++q) { const f32x4 v0 = (acc[ai][bj][mp + q][0] + bl[bj * 32]) * qs, v1 = (acc[ai][bj][mp + q][1] + bl[bj * 32 + 1]) * qs;
                            w[q].x = pk4_fp8(v0[0], v0[1], v0[2], v0[3]); w[q].y = pk4_fp8(v1[0], v1[1], v1[2], v1[3]); }
                        *(u32x4*)(rowp + bj * HALF) = pair16(w[0], w[1]); }
                    asm volatile("" ::: "memory"); }
            } else {
                const int gsel = (colt == C_KA) ? -1 : ((colt - C_KB) >> 8); const int sh = (gsel <= 0) ? 0 : (gsel == 1 ? 2 : 4);
                unsigned char* kb = k2 + (size_t)(gsel + 1) * (2 * 4 * 8192 * 64);
                int c0 = wc * 32 + 8 * fq; asm volatile("" : "+v"(c0));
#pragma unroll
                for (int ai = 0; ai < 2; ++ai)
#pragma unroll
                    for (int m = 0; m < 4; ++m) { const int row = row0 + ai * HALF + m * 16, b = row >> 13, sq = row & 8191; const int pos = ((sq & ((1 << sh) - 1)) << (13 - sh)) + (sq >> sh);
#pragma unroll
                        for (int bj = 0; bj < 2; ++bj) { const int c = c0 + bj * HALF; const f32x4 v0 = acc[ai][bj][m][0] + bl[bj * 32], v1 = acc[ai][bj][m][1] + bl[bj * 32 + 1];
                            u32x2 w; w.x = pk4_fp8(v0[0], v0[1], v0[2], v0[3]); w.y = pk4_fp8(v1[0], v1[1], v1[2], v1[3]);
                            *(u32x2*)(kb + ((size_t)((b * 4 + (c >> 6)) * 8192 + pos)) * 64 + (c & 63)) = w; }
                        asm volatile("" ::: "memory"); }
            }
        } else {
            const int colt = u.arow, tok0 = u.e; const int gsel = (colt == C_VA) ? -1 : ((colt - C_VB) >> 8); const int sh = (gsel <= 0) ? 0 : (gsel == 1 ? 2 : 4);
            bf16_t* vb = ((gsel < 0) ? vta : vtb + (size_t)gsel * (2 * 256 * 8192)) + (size_t)((tok0 >> 13) * 256) * 8192;
            const int mub = (tok0 & 8191) >> sh;
#pragma unroll
            for (int ai = 0; ai < 2; ++ai)
#pragma unroll
                for (int m = 0; m < 4; ++m) { const int c = ai * HALF + wr * 64 + m * 16 + fr; const float bvr = *(const PG8_LAS float*)(slot + c * 4); bf16_t* vrow = vb + (size_t)(c >> 6) * (64 * 8192) + (c & 63) * 32;
#pragma unroll
                    for (int bj = 0; bj < 2; ++bj) { const int j0 = bj * HALF + wc * 32 + 8 * fq;
                        const int rho = j0 >> (8 - sh), mu = mub + (j0 & ((256 >> sh) - 1));
                        const int p0 = ((rho << (8 - sh)) + (mu >> 5)) * 2048 + (((mu & 15) >> 2) << 3) + (((mu >> 4) & 1) << 2);
                        const f32x4 v0 = acc[ai][bj][m][0] + bvr, v1 = acc[ai][bj][m][1] + bvr;
                        u32x2 w0, w1; w0.x = cvt_pk_bf16(v0[0], v0[1]); w0.y = cvt_pk_bf16(v0[2], v0[3]); w1.x = cvt_pk_bf16(v1[0], v1[1]); w1.y = cvt_pk_bf16(v1[2], v1[3]);
                        *(u32x2*)(vrow + p0) = w0; *(u32x2*)(vrow + p0 + 8) = w1; }
                    asm volatile("" ::: "memory"); }
        }
    }
};
template <int MODE> struct EpiGate {
    static constexpr bool PERM = true, AFTER_DRAIN = false; static constexpr int MID_T = 0; static constexpr int TAG = 3;
    bf16_t* out; const bf16_t* gates; int gcol0; unsigned char* out8;
    __device__ __forceinline__ void prefetch(const Unit&, PG8_LAS unsigned char*, int, int) const {}
    __device__ __forceinline__ void operator()(const f32x4 (&acc)[2][2][4][2], const Unit& u, int wr, int wc, int fr, int fq, const PG8_LAS unsigned char*) const {
        const int row0 = u.arow + wr * 64 + fr, col0 = u.brow + wc * 32 + 8 * fq;
        u32x2 gv[8][2];
#pragma unroll
        for (int gi = 0; gi < 4; ++gi) { const size_t r = (size_t)(row0 + (gi >> 2) * HALF + (gi & 3) * 16);
#pragma unroll
            for (int bj = 0; bj < 2; ++bj) gv[gi][bj] = *(const u32x2*)((const unsigned char*)gates + r * NGATE + gcol0 + col0 + bj * HALF); }
        u32x4 mv[2], mn[2];
        if (MODE == 1) {
#pragma unroll
            for (int bj = 0; bj < 2; ++bj) mv[bj] = *(const u32x4*)(out + (size_t)row0 * D + col0 + bj * HALF); }
#pragma unroll
        for (int gi = 0; gi < 8; ++gi) { const int ai = gi >> 2, m = gi & 3; const size_t r = (size_t)(row0 + ai * HALF + m * 16);
            if (gi == 1) {
#pragma unroll
                for (int g2 = 4; g2 < 8; ++g2) { const size_t r2 = (size_t)(row0 + (g2 >> 2) * HALF + (g2 & 3) * 16);
#pragma unroll
                    for (int bj = 0; bj < 2; ++bj) gv[g2][bj] = *(const u32x2*)((const unsigned char*)gates + r2 * NGATE + gcol0 + col0 + bj * HALF); } }
            if (MODE == 1 && gi + 1 < 8) { const size_t rn = (size_t)(row0 + ((gi + 1) >> 2) * HALF + ((gi + 1) & 3) * 16);
#pragma unroll
                for (int bj = 0; bj < 2; ++bj) mn[bj] = *(const u32x4*)(out + rn * D + col0 + bj * HALF); }
#pragma unroll
            for (int bj = 0; bj < 2; ++bj) { const int c = col0 + bj * HALF; const u32x2 g4 = gv[gi][bj]; const f32x4 a0 = acc[ai][bj][m][0], a1 = acc[ai][bj][m][1];
                const f32x2 ga = __builtin_amdgcn_cvt_pk_f32_fp8(g4.x, false), gb = __builtin_amdgcn_cvt_pk_f32_fp8(g4.x, true), gc = __builtin_amdgcn_cvt_pk_f32_fp8(g4.y, false), gd = __builtin_amdgcn_cvt_pk_f32_fp8(g4.y, true);
                float o[8]; o[0] = sigm(ga.x) * a0[0]; o[1] = sigm(ga.y) * a0[1]; o[2] = sigm(gb.x) * a0[2]; o[3] = sigm(gb.y) * a0[3];
                o[4] = sigm(gc.x) * a1[0]; o[5] = sigm(gc.y) * a1[1]; o[6] = sigm(gd.x) * a1[2]; o[7] = sigm(gd.y) * a1[3];
                if (MODE == 1) { const u32x4 m4 = mv[bj];
                    o[0] += bflo(m4.x); o[1] += bfhi(m4.x); o[2] += bflo(m4.y); o[3] += bfhi(m4.y); o[4] += bflo(m4.z); o[5] += bfhi(m4.z); o[6] += bflo(m4.w); o[7] += bfhi(m4.w); }
                if (MODE == 1) { u32x2 w8; w8.x = pk4_fp8(o[0], o[1], o[2], o[3]); w8.y = pk4_fp8(o[4], o[5], o[6], o[7]); *(u32x2*)(out8 + r * D + c) = w8; }
                else { u32x4 w; w.x = cvt_pk_bf16(o[0], o[1]); w.y = cvt_pk_bf16(o[2], o[3]); w.z = cvt_pk_bf16(o[4], o[5]); w.w = cvt_pk_bf16(o[6], o[7]);
                    *(u32x4*)(out + r * D + c) = w; } }
            asm volatile("" ::: "memory");
            if (MODE == 1) {
#pragma unroll
                for (int bj = 0; bj < 2; ++bj) mv[bj] = mn[bj]; } }
    }
};
struct EpiGate2 {
    static constexpr bool PERM = true, AFTER_DRAIN = false; static constexpr int TAG = 3; static constexpr int MID_T = 8;
    const bf16_t* gates; unsigned char* out8;
    __device__ __forceinline__ void prefetch(const Unit&, PG8_LAS unsigned char*, int, int) const {}
    static __device__ __forceinline__ void e8(u32x2 g4, float (&e)[8]) {
        const f32x2 a = __builtin_amdgcn_cvt_pk_f32_fp8(g4.x, false), b = __builtin_amdgcn_cvt_pk_f32_fp8(g4.x, true), c = __builtin_amdgcn_cvt_pk_f32_fp8(g4.y, false), d = __builtin_amdgcn_cvt_pk_f32_fp8(g4.y, true);
        const float gv[8] = {a.x, a.y, b.x, b.y, c.x, c.y, d.x, d.y};
#pragma unroll
        for (int j = 0; j < 8; ++j) e[j] = __builtin_amdgcn_exp2f(fminf(-1.4426950408889634f * gv[j], 60.f)); }
    __device__ __forceinline__ void mid(f32x4 (&acc)[2][2][4][2], const Unit& u, int wr, int wc) const {
        int ln; asm volatile("v_mbcnt_lo_u32_b32 %0, -1, 0\n\tv_mbcnt_hi_u32_b32 %0, -1, %0" : "=v"(ln)); const int fr = ln & 15, fq = ln >> 4;
        const int row0 = u.arow + wr * 64 + fr, col0 = u.brow + wc * 32 + 8 * fq;
        const unsigned char* gp = (const unsigned char*)gates + (size_t)row0 * NGATE + col0;
#pragma unroll
        for (int ai = 0; ai < 2; ++ai) { u32x2 ga[4][2], gb[4][2];
#pragma unroll
            for (int m = 0; m < 4; ++m)
#pragma unroll
                for (int bj = 0; bj < 2; ++bj) { const unsigned char* q = gp + (size_t)(ai * HALF + m * 16) * NGATE + bj * HALF; ga[m][bj] = __builtin_nontemporal_load((const u32x2*)q); gb[m][bj] = *(const u32x2*)(q + 1024); }
#pragma unroll
            for (int m = 0; m < 4; ++m)
#pragma unroll
                for (int bj = 0; bj < 2; ++bj) { float ea[8], eb[8]; e8(ga[m][bj], ea); e8(gb[m][bj], eb);
#pragma unroll
                    for (int j = 0; j < 8; ++j) { const float rt = (1.f + eb[j]) * __builtin_amdgcn_rcpf(1.f + ea[j]); acc[ai][bj][m][j >> 2][j & 3] *= rt; } } }
    }
    __device__ __forceinline__ void operator()(const f32x4 (&acc)[2][2][4][2], const Unit& u, int wr, int wc, int fr, int fq, const PG8_LAS unsigned char*) const {
        const int row0 = u.arow + wr * 64 + fr, col0 = u.brow + wc * 32 + 8 * fq;
        const unsigned char* gp = (const unsigned char*)gates + (size_t)row0 * NGATE + 1024 + col0;
#pragma unroll
        for (int ai = 0; ai < 2; ++ai) { u32x2 gb[4][2];
#pragma unroll
            for (int m = 0; m < 4; ++m)
#pragma unroll
                for (int bj = 0; bj < 2; ++bj) gb[m][bj] = __builtin_nontemporal_load((const u32x2*)(gp + (size_t)(ai * HALF + m * 16) * NGATE + bj * HALF));
#pragma unroll
            for (int m = 0; m < 4; ++m) { const size_t r = (size_t)(row0 + ai * HALF + m * 16);
#pragma unroll
                for (int bj = 0; bj < 2; ++bj) { float eb[8], o[8]; e8(gb[m][bj], eb);
#pragma unroll
                    for (int j = 0; j < 8; ++j) o[j] = acc[ai][bj][m][j >> 2][j & 3] * __builtin_amdgcn_rcpf(1.f + eb[j]);
                    u32x2 w8; w8.x = pk4_fp8(o[0], o[1], o[2], o[3]); w8.y = pk4_fp8(o[4], o[5], o[6], o[7]); *(u32x2*)(out8 + r * D + col0 + bj * HALF) = w8; }
                asm volatile("" ::: "memory"); } }
    }
};
typedef __bf16 bf16x2e_t __attribute__((ext_vector_type(2)));
__device__ __forceinline__ unsigned cvtpk_e(float lo, float hi) { typedef float f32x2e __attribute__((ext_vector_type(2))); const f32x2e v = {lo, hi}; const bf16x2e_t b = __builtin_convertvector(v, bf16x2e_t); return __builtin_bit_cast(unsigned, b); }
struct EpiX1 {
    static constexpr bool PERM = true, AFTER_DRAIN = false; static constexpr int MID_T = 0; static constexpr int TAG = 4;
    const float* x; unsigned short* x1b;
    __device__ __forceinline__ void prefetch(const Unit&, PG8_LAS unsigned char*, int, int) const {}
    __device__ __forceinline__ void operator()(const f32x4 (&acc)[2][2][4][2], const Unit& u, int wr, int wc, int fr, int fq, const PG8_LAS unsigned char*) const {
        const int row0 = u.arow + wr * 64 + fr, col0 = u.brow + wc * 32 + 8 * fq;
        f32x4 xv[2][2], xn[2][2];
#pragma unroll
        for (int bj = 0; bj < 2; ++bj) { const size_t o = (size_t)row0 * D + col0 + bj * HALF; xv[bj][0] = __builtin_nontemporal_load((const f32x4*)(x + o)); xv[bj][1] = __builtin_nontemporal_load((const f32x4*)(x + o + 4)); }
#pragma unroll
        for (int gi = 0; gi < 8; ++gi) { const int ai = gi >> 2, m = gi & 3; const size_t r = (size_t)(row0 + ai * HALF + m * 16);
            if (gi + 1 < 8) { const size_t rn = (size_t)(row0 + ((gi + 1) >> 2) * HALF + ((gi + 1) & 3) * 16);
#pragma unroll
                for (int bj = 0; bj < 2; ++bj) { const size_t o = rn * D + col0 + bj * HALF; xn[bj][0] = __builtin_nontemporal_load((const f32x4*)(x + o)); xn[bj][1] = __builtin_nontemporal_load((const f32x4*)(x + o + 4)); } }
#pragma unroll
            for (int bj = 0; bj < 2; ++bj) { const size_t o = r * D + col0 + bj * HALF;
                const f32x4 s0 = xv[bj][0] + acc[ai][bj][m][0], s1 = xv[bj][1] + acc[ai][bj][m][1];
                u32x4 ow; ow.x = cvtpk_e(s0.x, s0.y); ow.y = cvtpk_e(s0.z, s0.w); ow.z = cvtpk_e(s1.x, s1.y); ow.w = cvtpk_e(s1.z, s1.w);
                *(u32x4*)(x1b + o) = ow; }
            asm volatile("" ::: "memory");
#pragma unroll
            for (int bj = 0; bj < 2; ++bj) { xv[bj][0] = xn[bj][0]; xv[bj][1] = xn[bj][1]; } }
    }
};
struct EpiSwiglu {
    static constexpr bool PERM = true, AFTER_DRAIN = false; static constexpr int MID_T = 0; static constexpr int TAG = 7;
    unsigned char* act; const float* bg; const float* bu;
    __device__ __forceinline__ void prefetch(const Unit& u, PG8_LAS unsigned char* slot, int wid, int lane) const {
        if (wid == 0) { const int pn = (u.brow >> 8) & 7; const float* src = ((lane < 32) ? bg : bu) + (size_t)u.e * D + pn * HALF + 4 * (lane & 31);
            __builtin_amdgcn_global_load_lds((const unsigned*)src, (PG8_LAS unsigned*)slot, 16, 0, 0); } }
    __device__ __forceinline__ void operator()(const f32x4 (&acc)[2][2][4][2], const Unit& u, int wr, int wc, int fr_, int fq_, const PG8_LAS unsigned char* slot) const {
        int ln; asm volatile("v_mbcnt_lo_u32_b32 %0, -1, 0\n\tv_mbcnt_hi_u32_b32 %0, -1, %0" : "=v"(ln));
        const int fr = ln & 15, fq = ln >> 4;
        const int pn = (u.brow >> 8) & 7; const int col0 = pn * HALF + wc * 32 + 8 * fq; const int rl0 = wr * 64 + fr;
        const PG8_LAS f32x4* bl = (const PG8_LAS f32x4*)(slot + (wc * 32 + 8 * fq) * 4);
        const f32x4 g0 = bl[0], g1 = bl[1], u0 = bl[32] + 1.f, u1 = bl[33] + 1.f;
        int odd = fq & 1; asm volatile("" : "+v"(odd));
        auto sw2 = [](f32x2 g, f32x2 u) -> f32x2 {
            f32x2 gt; gt.x = fminf(g.x, 7.f); gt.y = fminf(g.y, 7.f);
            const f32x2 kz = {-1.702f * 1.4426950408889634f, -1.702f * 1.4426950408889634f}, one = {1.f, 1.f};
            const f32x2 z = gt * kz; f32x2 e; e.x = __builtin_amdgcn_exp2f(z.x); e.y = __builtin_amdgcn_exp2f(z.y);
            const f32x2 d = e + one; f32x2 r; r.x = __builtin_amdgcn_rcpf(d.x); r.y = __builtin_amdgcn_rcpf(d.y);
            f32x2 uc; uc.x = fminf(fmaxf(u.x, -6.f), 8.f); uc.y = fminf(fmaxf(u.y, -6.f), 8.f);
            return (gt * uc) * r; };
#pragma unroll
        for (int ai = 0; ai < 2; ++ai)
#pragma unroll
            for (int mp = 0; mp < 4; mp += 2) { u32x2 w[2];
#pragma unroll
                for (int q = 0; q < 2; ++q) { const int m = mp + q;
                    const f32x4 ga = acc[ai][0][m][0] + g0, gb = acc[ai][0][m][1] + g1, ua = acc[ai][1][m][0] + u0, ub = acc[ai][1][m][1] + u1;
                    const f32x2 o0 = sw2((f32x2){ga.x, ga.y}, (f32x2){ua.x, ua.y}), o1 = sw2((f32x2){ga.z, ga.w}, (f32x2){ua.z, ua.w});
                    const f32x2 o2 = sw2((f32x2){gb.x, gb.y}, (f32x2){ub.x, ub.y}), o3 = sw2((f32x2){gb.z, gb.w}, (f32x2){ub.z, ub.w});
                    w[q].x = pk4_fp8(o0.x, o0.y, o1.x, o1.y); w[q].y = pk4_fp8(o2.x, o2.y, o3.x, o3.y); }
                const u32x4 w16 = pair16(w[0], w[1]);
                const int rl = rl0 + ai * HALF + (mp + odd) * 16;
#if MK_FUSE78
                if (rl < u.nrows) st16_wt(act + (size_t)(u.arow + rl) * D + col0 - 8 * odd, w16); }
#else
                if (rl < u.nrows) *(u32x4*)(act + (size_t)(u.arow + rl) * D + col0 - 8 * odd) = w16; }
#endif
    }
};
struct EpiDown {
    static constexpr bool PERM = true, AFTER_DRAIN = false; static constexpr int MID_T = 0; static constexpr int TAG = 8;
    unsigned char* ys; const float* bd;
    __device__ __forceinline__ void prefetch(const Unit& u, PG8_LAS unsigned char* slot, int wid, int lane) const {
        if (wid == 0) { const int pn = (u.brow >> 8) & 3; __builtin_amdgcn_global_load_lds((const unsigned*)(bd + (size_t)u.e * D + pn * BM + 4 * lane), (PG8_LAS unsigned*)slot, 16, 0, 0); } }
    __device__ __forceinline__ void operator()(const f32x4 (&acc)[2][2][4][2], const Unit& u, int wr, int wc, int fr, int fq, const PG8_LAS unsigned char* slot) const {
        const int pn = (u.brow >> 8) & 3; const int col0 = pn * BM + wc * 32 + 8 * fq; const int rl0 = wr * 64 + fr;
        f32x4 bv[2][2];
#pragma unroll
        for (int bj = 0; bj < 2; ++bj)
#pragma unroll
            for (int n = 0; n < 2; ++n) bv[bj][n] = *(const PG8_LAS f32x4*)(slot + (wc * 32 + 8 * fq + bj * HALF + 4 * n) * 4);
        int odd = fq & 1; asm volatile("" : "+v"(odd));
#pragma unroll
        for (int ai = 0; ai < 2; ++ai)
#pragma unroll
            for (int mp = 0; mp < 4; mp += 2) { const int rl = rl0 + ai * HALF + (mp + odd) * 16; unsigned char* rowp = ys + (size_t)(u.arow + rl) * D + col0 - 8 * odd;
#pragma unroll
                for (int bj = 0; bj < 2; ++bj) { u32x2 w[2];
#pragma unroll
                    for (int q = 0; q < 2; ++q) { const f32x4 v0 = acc[ai][bj][mp + q][0] + bv[bj][0], v1 = acc[ai][bj][mp + q][1] + bv[bj][1];
                        w[q].x = pk4_fp8(v0[0], v0[1], v0[2], v0[3]); w[q].y = pk4_fp8(v1[0], v1[1], v1[2], v1[3]); }
                    const u32x4 w16 = pair16(w[0], w[1]);
                    if (rl < u.nrows) *(u32x4*)(rowp + bj * HALF) = w16; } }
    }
};

typedef int i32x4_t __attribute__((ext_vector_type(4))); typedef int i32x8_t __attribute__((ext_vector_type(8)));
template <bool FP8> struct Frag;
template <> struct Frag<false> { bf16x8 v[2];
    __device__ __forceinline__ void ld(const PG8_LAS unsigned char* p) { v[0] = *(const PG8_LAS bf16x8*)p; v[1] = *(const PG8_LAS bf16x8*)(p + 1024); } };
template <> struct Frag<true> { i32x8_t v;
    __device__ __forceinline__ void ld(const PG8_LAS unsigned char* p) { const i32x4_t lo = *(const PG8_LAS i32x4_t*)p, hi = *(const PG8_LAS i32x4_t*)(p + 1024); v = __builtin_shufflevector(lo, hi, 0, 1, 2, 3, 4, 5, 6, 7); } };
__device__ __forceinline__ f32x4 mma_frag(const Frag<false>& w, const Frag<false>& x, f32x4 c) {
    c = __builtin_amdgcn_mfma_f32_16x16x32_bf16(w.v[0], x.v[0], c, 0, 0, 0); return __builtin_amdgcn_mfma_f32_16x16x32_bf16(w.v[1], x.v[1], c, 0, 0, 0); }
__device__ __forceinline__ f32x4 mma_frag(const Frag<true>& w, const Frag<true>& x, f32x4 c) {
    const int sa = 0x7A7A7A7A, sb = 0x7F7F7F7F;
    asm volatile("v_mfma_scale_f32_16x16x128_f8f6f4 %0, %1, %2, %0, %3, %4 op_sel_hi:[0,0,0]" : "+v"(c) : "v"(w.v), "v"(x.v), "v"(sa), "v"(sb));
    return c; }
template <class Epi, class Sched, bool ALIGN_EPI = false, bool SP2 = false, bool FP8 = false, bool GA = false>
__device__ __forceinline__ void gemm_phase(PG8_LAS unsigned char* lds, const Gemm g, const Sched& S, const Epi& E) {
    const int tid = threadIdx.x, wid = __builtin_amdgcn_readfirstlane(tid >> 6), lane = tid & 63, wr = wid >> 2, wc = wid & 3, fr = lane & 15, fq = lane >> 4;
    const int K = g.K, nt = K / BK;
    unsigned voffA[2], voffB[2];
#pragma unroll
    for (int i = 0; i < 2; ++i) { int R, C; stage_rc(tid * 16 + i * 8192, R, C); const int Rb = Epi::PERM ? ((R & ~31) + perm32(R & 31)) : R;
        voffA[i] = (unsigned)(R * K + C) * 2u; voffB[i] = (unsigned)(Rb * K + C) * 2u; }
    static_assert(!GA || SP2, "gather is wired into the two-super-phase loop only");
    unsigned vAc[2][2], vAn[2][2];
#pragma unroll
    for (int h = 0; h < 2; ++h)
#pragma unroll
        for (int i = 0; i < 2; ++i) { vAc[h][i] = voffA[i]; vAn[h][i] = voffA[i]; }
    unsigned vBc[2]; unsigned hBc = (unsigned)HALF * (unsigned)K * 2u;
#pragma unroll
    for (int i = 0; i < 2; ++i) vBc[i] = voffB[i];
    auto bperm_off = [&](int type, unsigned (&vo)[2], unsigned& hs) {
        int ln; asm volatile("v_mbcnt_lo_u32_b32 %0, -1, 0\n\tv_mbcnt_hi_u32_b32 %0, -1, %0" : "=v"(ln)); const int tid_ = wid * 64 + ln;
#pragma unroll
        for (int i = 0; i < 2; ++i) { int R, C; stage_rc(tid_ * 16 + i * 8192, R, C); const int Rb = Epi::PERM ? ((R & ~31) + perm32(R & 31)) : R;
            const int Rp = (type == 1) ? 4 * (Rb & 63) + (Rb >> 6) : (type == 2) ? 16 * (Rb & 15) + (Rb >> 4) : Rb;
            vo[i] = (unsigned)(Rp * K + C) * 2u; }
        hs = (unsigned)((type == 1) ? 2 : (type == 2) ? 8 : HALF) * (unsigned)K * 2u; };
    PG8_LAS unsigned char* const ilds = lds + 131072 + 4096 + 2048;
    auto gather_off = [&](int i, unsigned idx) -> unsigned { int R, C; stage_rc(tid * 16 + i * 8192, R, C); idx = idx < (unsigned)T ? idx : (unsigned)(T - 1); return idx * (unsigned)(K * 2) + (unsigned)C * 2u; };
    auto piece_row = [&](int i) -> int { int R, C; stage_rc(tid * 16 + i * 8192, R, C); return R; };
    const size_t kstep = (size_t)(BK * 2);
    const size_t hstep = (size_t)HALF * K * 2;
    const size_t rowb = (size_t)K * 2;
    const size_t hstepA = GA ? 0 : hstep;
    const unsigned ldsw = (unsigned)wid * 1024u;
    const int aoff = lds_byte(wr * 64 + fr, fq * 8), boff = lds_byte(wc * 32 + fr, fq * 8);
#define PG8_SA(b, h) (((b) * 2 + (h)) * HTB)
#define PG8_SB(b, h) ((4 + (b) * 2 + (h)) * HTB)
#define PG8_STAGE(bufoff, gbase, voff) do { _Pragma("unroll") for (int _i = 0; _i < 2; ++_i) \
        __builtin_amdgcn_global_load_lds((const unsigned*)((const char*)(gbase) + (voff)[_i]), (PG8_LAS unsigned*)(lds + (bufoff) + ldsw + _i * 8192), 16, 0, 0); } while (0)
#define PG8_LDA(dst, b, h) do { _Pragma("unroll") for (int m = 0; m < 4; ++m) dst[m].ld(lds + PG8_SA(b, h) + aoff + m * 2048); } while (0)
#define PG8_LDB(dst, b, h) do { _Pragma("unroll") for (int n = 0; n < 2; ++n) dst[n].ld(lds + PG8_SB(b, h) + boff + n * 2048); } while (0)
#define PG8_MMA(ai, bj, At, Bt) do { __builtin_amdgcn_s_setprio(1); _Pragma("unroll") for (int m = 0; m < 4; ++m) _Pragma("unroll") for (int n = 0; n < 2; ++n) \
        acc[ai][bj][m][n] = mma_frag(Bt[n], At[m], acc[ai][bj][m][n]); __builtin_amdgcn_s_setprio(0); } while (0)
#define PG8_WAIT_V(n) asm volatile("s_waitcnt vmcnt(" #n ")" ::: "memory")
#define PG8_WAIT_L(n) asm volatile("s_waitcnt lgkmcnt(" #n ")" ::: "memory")
#define PG8_BAR __builtin_amdgcn_s_barrier()
#define PG8_SCHED __builtin_amdgcn_sched_barrier(0)
    Unit cur, nxt; int ui = 0; int pend_mt = -1;
    if (!S.next(0, cur)) return;
    f32x4 acc[2][2][4][2];
#pragma unroll
    for (int a = 0; a < 2; ++a)
#pragma unroll
        for (int b = 0; b < 2; ++b)
#pragma unroll
            for (int m = 0; m < 4; ++m)
#pragma unroll
                for (int n = 0; n < 2; ++n) acc[a][b][m][n] = (f32x4){0.f, 0.f, 0.f, 0.f};
    Frag<FP8> At[4], B0[2], B1[2];
    const char* cA = (const char*)(cur.swap ? g.Bt : g.A) + (size_t)cur.arow * rowb; const char* cB = (const char*)(cur.swap ? g.A : g.Bt) + (size_t)cur.brow * rowb;
    if constexpr (GA) { cA = (const char*)g.A;
#pragma unroll
        for (int h = 0; h < 2; ++h)
#pragma unroll
            for (int i = 0; i < 2; ++i) { vAc[h][i] = gather_off(i, (unsigned)g.gidx[cur.aidx + h * HALF + piece_row(i)]); vAn[h][i] = vAc[h][i]; } }
    if constexpr (Sched::BPERM) bperm_off(cur.aidx, vBc, hBc);
    S.a_ready(cur);
    PG8_LAS unsigned char* const blds = lds + 131072 + 4096;
    E.prefetch(cur, blds, wid, lane);
    if constexpr (SP2) {
        PG8_STAGE(PG8_SB(0, 0), cB, vBc); PG8_STAGE(PG8_SB(0, 1), cB + hBc, vBc); PG8_STAGE(PG8_SA(0, 0), cA, vAc[0]); PG8_STAGE(PG8_SA(0, 1), cA + hstepA, vAc[1]);
        if (wr == 1) PG8_BAR;
        PG8_WAIT_V(2); PG8_BAR;
        PG8_STAGE(PG8_SB(1, 0), cB + kstep, vBc); PG8_STAGE(PG8_SA(1, 0), cA + kstep, vAc[0]); PG8_STAGE(PG8_SB(1, 1), cB + hBc + kstep, vBc);
        PG8_WAIT_V(6); PG8_BAR;
    } else {
        PG8_STAGE(PG8_SB(0, 0), cB, voffB); PG8_STAGE(PG8_SA(0, 0), cA, voffA); PG8_STAGE(PG8_SB(0, 1), cB + hstep, voffB); PG8_STAGE(PG8_SA(0, 1), cA + hstep, voffA);
        if (wr == 1) PG8_BAR;
        PG8_WAIT_V(4); PG8_BAR;
        PG8_STAGE(PG8_SB(1, 0), cB + kstep, voffB); PG8_STAGE(PG8_SA(1, 0), cA + kstep, voffA); PG8_STAGE(PG8_SB(1, 1), cB + hstep + kstep, voffB);
        PG8_WAIT_V(6); PG8_BAR;
    }
    for (;;) {
        const bool has_next = S.next(ui + 1, nxt);
        const char* nA = (has_next && !GA) ? (const char*)(nxt.swap ? g.Bt : g.A) + (size_t)nxt.arow * rowb : cA; const char* nB = has_next ? (const char*)(nxt.swap ? g.A : g.Bt) + (size_t)nxt.brow * rowb : cB;
        for (int t = 0; t < nt; t += 2) {
            const bool last = (t == nt - 2);
            const char* a1 = cA + (size_t)(t + 1) * kstep;
            const char* a2 = last ? nA : cA + (size_t)(t + 2) * kstep; const char* b2 = last ? nB : cB + (size_t)(t + 2) * kstep;
            const char* a3 = a2 + kstep; const char* b3 = b2 + kstep;
            if constexpr (Epi::MID_T > 0) { if (t == Epi::MID_T) {
#define PG8_ACC8M(a, b) "+v"(acc[a][b][0][0]), "+v"(acc[a][b][0][1]), "+v"(acc[a][b][1][0]), "+v"(acc[a][b][1][1]), "+v"(acc[a][b][2][0]), "+v"(acc[a][b][2][1]), "+v"(acc[a][b][3][0]), "+v"(acc[a][b][3][1])
                asm volatile("s_nop 15\n\ts_nop 15" : PG8_ACC8M(0, 0), PG8_ACC8M(0, 1) :: "memory");
                asm volatile("" : PG8_ACC8M(1, 0), PG8_ACC8M(1, 1) :: "memory");
                E.mid(acc, cur, wr, wc);
                asm volatile("" : PG8_ACC8M(0, 0), PG8_ACC8M(0, 1) :: "memory");
                asm volatile("" : PG8_ACC8M(1, 0), PG8_ACC8M(1, 1) :: "memory");
#undef PG8_ACC8M
            } }
            if (last && pend_mt >= 0) { S.publish(pend_mt); pend_mt = -1; }
            if (last && has_next) { S.a_ready(nxt); E.prefetch(nxt, blds + (((ui + 1) & 1) << 10), wid, lane); }
            if constexpr (GA) {
                if (t == nt - 4 && has_next && wid == 0) { int l4 = 4 * lane; asm volatile("" : "+v"(l4));
                    __builtin_amdgcn_global_load_lds((const unsigned*)(g.gidx + nxt.aidx + l4), (PG8_LAS unsigned*)(ilds + (((ui + 1) & 1) << 10)), 16, 0, 0); }
                if (last && has_next) { const PG8_LAS unsigned* il = (const PG8_LAS unsigned*)(ilds + (((ui + 1) & 1) << 10));
#pragma unroll
                    for (int h = 0; h < 2; ++h)
#pragma unroll
                        for (int i = 0; i < 2; ++i) vAn[h][i] = gather_off(i, il[h * HALF + piece_row(i)]); }
            }
            unsigned v2[2][2];
#pragma unroll
            for (int h = 0; h < 2; ++h)
#pragma unroll
                for (int i = 0; i < 2; ++i) v2[h][i] = last ? vAn[h][i] : vAc[h][i];
            if constexpr (Sched::BPERM) { if (last && has_next) bperm_off(nxt.aidx, vBc, hBc); }
#define vb2 vBc
#define hb2 ((size_t)hBc)
            if constexpr (SP2) {
            PG8_LDB(B0, 0, 0); PG8_LDB(B1, 0, 1); PG8_SCHED; PG8_LDA(At, 0, 0); PG8_STAGE(PG8_SA(1, 1), a1 + hstepA, vAc[1]);
            PG8_WAIT_V(8); PG8_WAIT_L(0); PG8_BAR; PG8_MMA(0, 0, At, B0); PG8_MMA(0, 1, At, B1); PG8_BAR; PG8_SCHED;
            PG8_LDA(At, 0, 1); PG8_STAGE(PG8_SB(0, 0), b2, vb2); PG8_STAGE(PG8_SB(0, 1), b2 + hb2, vb2); PG8_STAGE(PG8_SA(0, 0), a2, v2[0]);
            PG8_WAIT_V(8); PG8_WAIT_L(0); PG8_BAR; PG8_MMA(1, 0, At, B0); PG8_MMA(1, 1, At, B1); PG8_BAR; PG8_SCHED;
            PG8_LDB(B0, 1, 0); PG8_LDB(B1, 1, 1); PG8_SCHED; PG8_LDA(At, 1, 0); PG8_STAGE(PG8_SA(0, 1), a2 + hstepA, v2[1]);
            PG8_WAIT_V(8); PG8_WAIT_L(0); PG8_BAR; PG8_MMA(0, 0, At, B0); PG8_MMA(0, 1, At, B1); PG8_BAR; PG8_SCHED;
            PG8_LDA(At, 1, 1); PG8_STAGE(PG8_SB(1, 0), b3, vb2); PG8_STAGE(PG8_SB(1, 1), b3 + hb2, vb2); PG8_STAGE(PG8_SA(1, 0), a3, v2[0]);
            PG8_WAIT_V(8); PG8_WAIT_L(0); PG8_BAR; PG8_MMA(1, 0, At, B0); PG8_MMA(1, 1, At, B1); PG8_BAR; PG8_SCHED;
            } else {
            PG8_LDB(B0, 0, 0); PG8_SCHED; PG8_LDA(At, 0, 0); PG8_STAGE(PG8_SA(1, 1), a1 + hstep, voffA);
            PG8_WAIT_L(8); PG8_BAR; PG8_WAIT_L(0); PG8_MMA(0, 0, At, B0); PG8_BAR; PG8_SCHED;
            PG8_LDB(B1, 0, 1); PG8_STAGE(PG8_SB(0, 0), b2, voffB);
            PG8_BAR; PG8_WAIT_L(0); PG8_MMA(0, 1, At, B1); PG8_BAR;
            PG8_LDA(At, 0, 1); PG8_STAGE(PG8_SA(0, 0), a2, voffA);
            PG8_BAR; PG8_WAIT_L(0); PG8_MMA(1, 0, At, B0); PG8_BAR; PG8_SCHED;
            PG8_STAGE(PG8_SB(0, 1), b2 + hstep, voffB);
            PG8_WAIT_V(6); PG8_BAR; PG8_MMA(1, 1, At, B1); PG8_BAR;
            PG8_LDB(B0, 1, 0); PG8_SCHED; PG8_LDA(At, 1, 0); PG8_STAGE(PG8_SA(0, 1), a2 + hstep, voffA);
            PG8_WAIT_L(8); PG8_BAR; PG8_WAIT_L(0); PG8_MMA(0, 0, At, B0); PG8_BAR; PG8_SCHED;
            PG8_LDB(B1, 1, 1); PG8_STAGE(PG8_SB(1, 0), b3, voffB);
            PG8_BAR; PG8_WAIT_L(0); PG8_MMA(0, 1, At, B1); PG8_BAR;
            PG8_LDA(At, 1, 1); PG8_STAGE(PG8_SA(1, 0), a3, voffA);
            PG8_BAR; PG8_WAIT_L(0); PG8_MMA(1, 0, At, B0); PG8_BAR; PG8_SCHED;
            PG8_STAGE(PG8_SB(1, 1), b3 + hstep, voffB);
            PG8_WAIT_V(6); PG8_BAR; PG8_MMA(1, 1, At, B1); PG8_BAR;
            }
        }
        if constexpr (ALIGN_EPI) { if (wr == 0) PG8_BAR; }
        if constexpr (FP8) {
#define PG8_ACC8(a, b) "+v"(acc[a][b][0][0]), "+v"(acc[a][b][0][1]), "+v"(acc[a][b][1][0]), "+v"(acc[a][b][1][1]), "+v"(acc[a][b][2][0]), "+v"(acc[a][b][2][1]), "+v"(acc[a][b][3][0]), "+v"(acc[a][b][3][1])
            asm volatile("s_nop 15\n\ts_nop 15" : PG8_ACC8(0, 0), PG8_ACC8(0, 1) :: "memory");
            asm volatile("" : PG8_ACC8(1, 0), PG8_ACC8(1, 1) :: "memory");
#undef PG8_ACC8
        }
#ifdef MK_EPI2
        if constexpr (Epi::TAG == MK_EPI2) { E(acc, cur, wr, wc, fr, fq, blds + ((ui & 1) << 10)); asm volatile("" ::: "memory"); }
#endif
        if constexpr (!Epi::AFTER_DRAIN) { E(acc, cur, wr, wc, fr, fq, blds + ((ui & 1) << 10)); if (S.defer()) pend_mt = cur.mt; else S.done(cur); }
        if (!has_next) break;
#pragma unroll
        for (int a = 0; a < 2; ++a)
#pragma unroll
            for (int b = 0; b < 2; ++b)
#pragma unroll
                for (int m = 0; m < 4; ++m)
#pragma unroll
                    for (int n = 0; n < 2; ++n) acc[a][b][m][n] = (f32x4){0.f, 0.f, 0.f, 0.f};
        cur = nxt; cA = nA; cB = nB; ++ui;
        if constexpr (GA) {
#pragma unroll
            for (int h = 0; h < 2; ++h)
#pragma unroll
                for (int i = 0; i < 2; ++i) vAc[h][i] = vAn[h][i]; }
        if constexpr (ALIGN_EPI) { if (wr == 1) PG8_BAR; }
    }
    PG8_WAIT_V(0);
    if (pend_mt >= 0) S.publish(pend_mt);
    if constexpr (!ALIGN_EPI) { if (wr == 0) PG8_BAR; }
    PG8_BAR;
    if constexpr (Epi::AFTER_DRAIN) { E.fused(acc, cur, wr, wc, fr, fq, lds, wid, lane); S.done(cur); }
#undef vb2
#undef hb2
#undef PG8_SA
#undef PG8_SB
#undef PG8_STAGE
#undef PG8_LDA
#undef PG8_LDB
#undef PG8_MMA
#undef PG8_WAIT_V
#undef PG8_WAIT_L
#undef PG8_BAR
#undef PG8_SCHED
}

}

#define XB_TMO      128
#define XB_XCNT(j)  (256  + 64 * (j))
#define XB_XSUB(j)  (1280 + 64 * (j))
#define XB_XGEN(j)  (2304 + 64 * (j))
#define XB_TOP      3328
#define XB_TOPGEN   3392
#define XCD_BAR_WORDS 3456
#define XB_SPIN_CAP (1u << 18)
__device__ __forceinline__ unsigned xb_ld(unsigned* p)              { return __hip_atomic_load(p, __ATOMIC_RELAXED, __HIP_MEMORY_SCOPE_AGENT); }
__device__ __forceinline__ unsigned xb_add(unsigned* p, unsigned v) { return __hip_atomic_fetch_add(p, v, __ATOMIC_RELAXED, __HIP_MEMORY_SCOPE_AGENT); }
__device__ __forceinline__ unsigned xb_xcc_id() { return (unsigned)__builtin_amdgcn_s_getreg((3 << 11) | 20) & 0xFu; }
#define XB_SPIN(cond, bar) do { unsigned _sp = 0; while (cond) { __builtin_amdgcn_s_sleep(1); \
    if ((++_sp & 255u) == 0u) { if (xb_ld(&(bar)[XB_TMO])) break; if (_sp > XB_SPIN_CAP) { atomicAdd(&(bar)[XB_TMO], 1u); break; } } } } while (0)
struct XcdBarrier { unsigned* bar; unsigned x; volatile LAS unsigned* st; };
__device__ __forceinline__ XcdBarrier xcd_barrier_post(unsigned* bar, volatile LAS unsigned* st) {
    XcdBarrier b; b.bar = bar; b.x = xb_xcc_id(); b.st = st;
    if (threadIdx.x == 0) (void)xb_add(&bar[XB_XCNT(b.x)], 1u);
    return b;
}
__device__ __forceinline__ void xcd_barrier_complete(unsigned* bar, unsigned x, unsigned& nloc, unsigned& nx) {
    const unsigned G = gridDim.x * gridDim.y * gridDim.z;
    unsigned sum, cnt, mine, sp = 0u;
    for (;;) {
        sum = 0u; cnt = 0u; mine = 0u;
#pragma unroll
        for (unsigned j = 0; j < 16; ++j) { const unsigned c = xb_ld(&bar[XB_XCNT(j)]); sum += c; cnt += (c > 0u) ? 1u : 0u; mine = (j == x) ? c : mine; }
        if (sum == G) break;
        __builtin_amdgcn_s_sleep(1);
        if ((++sp & 255u) == 0u) { if (xb_ld(&bar[XB_TMO])) break; if (sp > XB_SPIN_CAP) { atomicAdd(&bar[XB_TMO], 1u); break; } }
    }
    nloc = mine > 0u ? mine : 1u; nx = cnt > 0u ? cnt : 1u;
}
__device__ __forceinline__ void xcd_barrier(const XcdBarrier& b) {
    asm volatile("s_waitcnt vmcnt(0)" ::: "memory");
    __syncthreads();
    if (threadIdx.x == 0) {
        unsigned* bar = b.bar;
        __builtin_amdgcn_s_waitcnt(0);
        unsigned nloc = b.st[0], nx = b.st[1];
        if (nloc == 0u) { xcd_barrier_complete(bar, b.x, nloc, nx); b.st[0] = nloc; b.st[1] = nx; }
        const unsigned old = xb_add(&bar[XB_XSUB(b.x)], 1u);
        const unsigned gen = old / nloc;
        if (old + 1u == (gen + 1u) * nloc) {
            __builtin_amdgcn_fence(__ATOMIC_RELEASE, "agent");
            asm volatile("s_waitcnt vmcnt(0)" ::: "memory");
            const unsigned og = xb_add(&bar[XB_TOP], 1u);
            const unsigned tg = og / nx;
            if (og + 1u == (tg + 1u) * nx) xb_add(&bar[XB_TOPGEN], 1u);
            else XB_SPIN(xb_ld(&bar[XB_TOPGEN]) == tg, bar);
            __builtin_amdgcn_fence(__ATOMIC_ACQUIRE, "agent");
            asm volatile("s_waitcnt vmcnt(0)" ::: "memory");
        } else {
            XB_SPIN(xb_ld(&bar[XB_TOPGEN]) == gen, bar);
            __builtin_amdgcn_fence(__ATOMIC_ACQUIRE, "agent");
            asm volatile("s_waitcnt vmcnt(0)" ::: "memory");
        }
    }
    __syncthreads();
}

constexpr int NWAVES = 8;
constexpr int RING_OFF = 0, RING_BYTES = 131072;
constexpr int LDSCTL_OFF = RING_BYTES, MISC_OFF = LDSCTL_OFF + 320;
constexpr int TBL_OFF = LDSCTL_OFF + 1024;
constexpr int LDS_BYTES = 147456;

struct Frame {
    LAS unsigned char* lds; volatile LAS unsigned* MISC; LAS int* tbl; gu32* ctl;
    int tid, lane, wave, vcu, G;
};

__device__ __forceinline__ void p0_transpose_item(const float* W, int K, int N, bf16* WT, int k0, int n0, int orow0, LAS float* scr, int lane) {
#pragma unroll 8
    for (int i = 0; i < 32; ++i) { const int kk = 2 * i + (lane >> 5); scr[kk * 33 + (lane & 31)] = W[(size_t)(k0 + kk) * N + n0 + (lane & 31)]; }
    LDS_WAIT(); asm volatile("" ::: "memory");
    const int c = lane & 7;
#pragma unroll
    for (int j = 0; j < 4; ++j) { const int n = (lane >> 3) + 8 * j; const LAS float* s = scr + (8 * c) * 33 + n;
        u32x4 o; o.x = pk2(s[0 * 33], s[1 * 33]); o.y = pk2(s[2 * 33], s[3 * 33]); o.z = pk2(s[4 * 33], s[5 * 33]); o.w = pk2(s[6 * 33], s[7 * 33]);
        *(GAS u32x4*)(WT + (size_t)(orow0 + n) * K + k0 + 8 * c) = o; }
    LDS_WAIT(); asm volatile("" ::: "memory");
}
__device__ __forceinline__ void p0_transpose_item_fp8(const float* W, int K, int N, unsigned char* WT, int k0, int n0, int orow0, LAS float* scr, int lane) {
#pragma unroll 8
    for (int i = 0; i < 32; ++i) { const int kk = 2 * i + (lane >> 5); scr[kk * 33 + (lane & 31)] = W[(size_t)(k0 + kk) * N + n0 + (lane & 31)]; }
    LDS_WAIT(); asm volatile("" ::: "memory");
    const int c = lane & 7;
#pragma unroll
    for (int j = 0; j < 4; ++j) { const int n = (lane >> 3) + 8 * j; const LAS float* sp = scr + (8 * c) * 33 + n;
        u32x2 o; o.x = pk4_fp8(sp[0 * 33] * 32.f, sp[1 * 33] * 32.f, sp[2 * 33] * 32.f, sp[3 * 33] * 32.f); o.y = pk4_fp8(sp[4 * 33] * 32.f, sp[5 * 33] * 32.f, sp[6 * 33] * 32.f, sp[7 * 33] * 32.f);
        *(GAS u32x2*)(WT + (size_t)(orow0 + n) * K + k0 + 8 * c) = o; }
    LDS_WAIT(); asm volatile("" ::: "memory");
}
struct CvItem { const float* W; unsigned char* WT; int k0, n0, orow0, N, K, nt; };
__device__ __forceinline__ void cv_load(const CvItem& c, float (&v)[32], int lane) {
    const GAS float* w = (const GAS float*)c.W + (size_t)(c.k0 + (lane >> 5)) * c.N + c.n0 + (lane & 31);
    const size_t st = (size_t)2 * c.N;
#pragma unroll
    for (int i = 0; i < 32; ++i) {
#ifdef MK_NTLOAD
        v[i] = __builtin_nontemporal_load(w + i * st);
#else
        v[i] = w[i * st];
#endif
    }
}
__device__ __forceinline__ void cv_finish(const CvItem& c, const float (&v)[32], LAS float* scr, int lane) {
#pragma unroll
    for (int i = 0; i < 32; ++i) scr[(2 * i + (lane >> 5)) * 33 + (lane & 31)] = v[i];
    LDS_WAIT(); asm volatile("" ::: "memory");
    const int cc = lane & 7;
#pragma unroll
    for (int j = 0; j < 4; ++j) { const int n = (lane >> 3) + 8 * j; const LAS float* sp = scr + (8 * cc) * 33 + n;
        u32x2 o; o.x = pk4_fp8(sp[0 * 33] * 32.f, sp[1 * 33] * 32.f, sp[2 * 33] * 32.f, sp[3 * 33] * 32.f); o.y = pk4_fp8(sp[4 * 33] * 32.f, sp[5 * 33] * 32.f, sp[6 * 33] * 32.f, sp[7 * 33] * 32.f);
#ifdef MK_NTSTORE
        if (c.nt) __builtin_nontemporal_store(o, (GAS u32x2*)(c.WT + (size_t)(c.orow0 + n) * c.K + c.k0 + 8 * cc));
        else
#endif
        *(GAS u32x2*)(c.WT + (size_t)(c.orow0 + n) * c.K + c.k0 + 8 * cc) = o; }
    LDS_WAIT(); asm volatile("" ::: "memory");
}
struct CvIt { const float* src; unsigned char* dst; int N, K, nt; };
__device__ __forceinline__ void cv_load4(const CvIt& c, f32x4 (&v)[8], int lane) {
    const GAS float* w = (const GAS float*)c.src + (size_t)(lane >> 3) * c.N + 4 * (lane & 7);
    const size_t st = (size_t)8 * c.N;
#pragma unroll
    for (int i = 0; i < 8; ++i) {
#ifdef MK_NTLOAD
        v[i] = __builtin_nontemporal_load((const GAS f32x4*)(w + i * st));
#else
        v[i] = *(const GAS f32x4*)(w + i * st);
#endif
    }
    __builtin_amdgcn_sched_barrier(0);
}
__device__ __forceinline__ void cv_finish4(const CvIt& c, const f32x4 (&v)[8], LAS float* scr, int lane) {
    __builtin_amdgcn_sched_barrier(0);
    LAS float* wbase = scr + (lane >> 3) * 33 + 4 * (lane & 7);
#pragma unroll
    for (int i = 0; i < 8; ++i) { LAS float* wp = wbase + (8 * i) * 33; wp[0] = v[i].x; wp[1] = v[i].y; wp[2] = v[i].z; wp[3] = v[i].w; }
    LDS_WAIT(); asm volatile("" ::: "memory");
    const int cc = lane & 7;
#pragma unroll
    for (int j = 0; j < 4; ++j) { const int n = (lane >> 3) + 8 * j; const LAS float* sp = scr + (8 * cc) * 33 + n;
        u32x2 o; o.x = pk4_fp8(sp[0 * 33] * 32.f, sp[1 * 33] * 32.f, sp[2 * 33] * 32.f, sp[3 * 33] * 32.f); o.y = pk4_fp8(sp[4 * 33] * 32.f, sp[5 * 33] * 32.f, sp[6 * 33] * 32.f, sp[7 * 33] * 32.f);
#ifdef MK_NTSTORE
        if (c.nt) __builtin_nontemporal_store(o, (GAS u32x2*)(c.dst + (size_t)n * c.K + 8 * cc));
        else
#endif
        *(GAS u32x2*)(c.dst + (size_t)n * c.K + 8 * cc) = o; }
    LDS_WAIT(); asm volatile("" ::: "memory");
}
__device__ __forceinline__ void rms_row_to_bf16(const float* xrow, const float* g, bf16* orow, int lane) {
    const GAS f32x4* xr = (const GAS f32x4*)xrow + lane; f32x4 v[4]; float s = 0.f;
#pragma unroll
    for (int j = 0; j < 4; ++j) { v[j] = xr[64 * j]; s += (v[j].x * v[j].x + v[j].y * v[j].y) + (v[j].z * v[j].z + v[j].w * v[j].w); }
    const float rstd = 1.f / sqrtf(wave_sum(s) * (1.f / D) + EPS);
    GAS unsigned long long* o8 = (GAS unsigned long long*)orow + lane;
#pragma unroll
    for (int j = 0; j < 4; ++j) { const f32x4 gg = ((const GAS f32x4*)g)[lane + 64 * j];
        o8[64 * j] = (unsigned long long)pk2(v[j].x * rstd * gg.x, v[j].y * rstd * gg.y) | ((unsigned long long)pk2(v[j].z * rstd * gg.z, v[j].w * rstd * gg.w) << 32); }
}

__device__ __forceinline__ void rms_row_to_fp8(const float* xrow, const float* g, unsigned char* orow, unsigned char* orow4, unsigned char* orow16, int lane) {
    const GAS f32x4* xr = (const GAS f32x4*)xrow + lane; f32x4 v[4]; float s = 0.f;
#pragma unroll
    for (int j = 0; j < 4; ++j) { v[j] = xr[64 * j]; s += (v[j].x * v[j].x + v[j].y * v[j].y) + (v[j].z * v[j].z + v[j].w * v[j].w); }
    const float rstd = 1.f / sqrtf(wave_sum(s) * (1.f / D) + EPS);
    GAS unsigned* o4 = (GAS unsigned*)orow + lane; GAS unsigned* p4 = (GAS unsigned*)orow4 + lane; GAS unsigned* p16 = (GAS unsigned*)orow16 + lane;
#pragma unroll
    for (int j = 0; j < 4; ++j) { const f32x4 gg = ((const GAS f32x4*)g)[lane + 64 * j]; const unsigned w = pk4_fp8(v[j].x * rstd * gg.x, v[j].y * rstd * gg.y, v[j].z * rstd * gg.z, v[j].w * rstd * gg.w);
        o4[64 * j] = w; p4[64 * j] = w; p16[64 * j] = w; }
}
__device__ __forceinline__ void rms_rows4_to_fp8(const float* x, const float* g, int m0, unsigned char* XN8, unsigned char* XNP4, unsigned char* XNP16, int lane) {
    f32x4 v[4][4]; float rstd[4];
#pragma unroll
    for (int r = 0; r < 4; ++r) { const GAS f32x4* xr = (const GAS f32x4*)(x + (size_t)(m0 + r) * D) + lane;
#pragma unroll
        for (int j = 0; j < 4; ++j) v[r][j] = __builtin_nontemporal_load(xr + 64 * j); }
#pragma unroll
    for (int r = 0; r < 4; ++r) { float s = 0.f;
#pragma unroll
        for (int j = 0; j < 4; ++j) s += (v[r][j].x * v[r][j].x + v[r][j].y * v[r][j].y) + (v[r][j].z * v[r][j].z + v[r][j].w * v[r][j].w);
        rstd[r] = 1.f / sqrtf(wave_sum(s) * (1.f / D) + EPS); }
#pragma unroll
    for (int j = 0; j < 4; ++j) { const f32x4 gg = ((const GAS f32x4*)g)[lane + 64 * j];
#pragma unroll
        for (int r = 0; r < 4; ++r) { const int m = m0 + r, t0 = m & ~255, tl = m & 255;
            const unsigned w = pk4_fp8(v[r][j].x * rstd[r] * gg.x, v[r][j].y * rstd[r] * gg.y, v[r][j].z * rstd[r] * gg.z, v[r][j].w * rstd[r] * gg.w);
            ((GAS unsigned*)(XN8 + (size_t)m * D))[lane + 64 * j] = w; (void)t0; (void)tl; (void)XNP4; (void)XNP16; } }
}
constexpr float LOG2E = 1.4426950408889634f;
typedef __bf16 bf16x2_t __attribute__((ext_vector_type(2)));
__device__ __forceinline__ unsigned cvtpk_v(float lo, float hi) { const f32x2 v = {lo, hi}; const bf16x2_t b = __builtin_convertvector(v, bf16x2_t); return __builtin_bit_cast(unsigned, b); }
typedef long longx2 __attribute__((ext_vector_type(2)));
struct AttFrags { longx2 k0, k1; bf16x8 v[4]; };
__device__ __forceinline__ float gmax4(float m) {
    { auto rr = __builtin_amdgcn_permlane16_swap(__float_as_uint(m), __float_as_uint(m), false, false); m = fmaxf(__uint_as_float(rr[0]), __uint_as_float(rr[1])); }
    { auto rr = __builtin_amdgcn_permlane32_swap(__float_as_uint(m), __float_as_uint(m), false, false); m = fmaxf(__uint_as_float(rr[0]), __uint_as_float(rr[1])); }
    return m;
}
constexpr int RB_A = 160, RB_B = 320;
template <int NH, int RB>
__device__ __forceinline__ void band_group(f32x4 (&o)[NH][4], float (&mrun)[NH], float (&lrun)[NH], const unsigned char* qkvb, const int (&qcol)[NH], const int (&qmu0)[NH], const unsigned char* kh, const bf16* vt,
                                           int dil, int rho, int L, int qstep, int P0, int npairs, const LAS float* const (&tab)[NH], int lane) {
    const int t = lane & 15, g = lane >> 4;
    longx2 qf[NH]; int mu_t[NH];
#pragma unroll
    for (int h = 0; h < NH; ++h) { mu_t[h] = qmu0[h] + qstep * t; qf[h] = __builtin_nontemporal_load((const longx2*)(qkvb + (size_t)(mu_t[h] * dil + rho) * NQKV + 16 * g + qcol[h])); }
    const int npr = L >> 5;
    const unsigned char* kbase = kh + ((size_t)rho * L) * 64 + 16 * g;
    const bf16* vtl = vt + (size_t)(rho * npr) * 2048 + t * 32 + 8 * g;
    auto load = [&](int P, AttFrags& f) {
        const int Pc = min(max(P, 0), npr - 1);
        const unsigned char* k0p = kbase + (size_t)(32 * Pc + t) * 64; const unsigned char* k1p = k0p + 16 * 64;
        f.k0 = *(const longx2*)k0p; f.k1 = *(const longx2*)k1p;
#pragma unroll
        for (int db = 0; db < 4; ++db) f.v[db] = *(const bf16x8*)(vtl + (size_t)Pc * 2048 + db * 512);
    };
    AttFrags cur; load(P0, cur);
    for (int pp = 0; pp < npairs; ++pp) {
        const int P = P0 + pp;
        AttFrags nxt; load(P0 + min(pp + 1, npairs - 1), nxt);
        if (P >= 0 && P < npr) {
            const int kap0 = 32 * P + 4 * g;
#pragma unroll
            for (int h = 0; h < NH; ++h) {
                const LAS float* tb_ = tab[h] + (kap0 - mu_t[h] + RB);
                f32x4 s0 = (f32x4){tb_[0], tb_[1], tb_[2], tb_[3]}, s1 = (f32x4){tb_[16], tb_[17], tb_[18], tb_[19]};
                s0 = __builtin_amdgcn_mfma_f32_16x16x32_fp8_fp8(cur.k0.x, qf[h].x, s0, 0, 0, 0); s0 = __builtin_amdgcn_mfma_f32_16x16x32_fp8_fp8(cur.k0.y, qf[h].y, s0, 0, 0, 0);
                s1 = __builtin_amdgcn_mfma_f32_16x16x32_fp8_fp8(cur.k1.x, qf[h].x, s1, 0, 0, 0); s1 = __builtin_amdgcn_mfma_f32_16x16x32_fp8_fp8(cur.k1.y, qf[h].y, s1, 0, 0, 0);
                float mx = fmaxf(fmaxf(fmaxf(s0[0], s0[1]), fmaxf(s0[2], s0[3])), fmaxf(fmaxf(s1[0], s1[1]), fmaxf(s1[2], s1[3])));
                mx = gmax4(mx);
                if (__any(mx > mrun[h])) { const float mn = fmaxf(mrun[h], mx), alpha = __builtin_amdgcn_exp2f(mrun[h] - mn); mrun[h] = mn; lrun[h] *= alpha;
#pragma unroll
                    for (int db = 0; db < 4; ++db) o[h][db] = o[h][db] * alpha; }
                const float mn = mrun[h]; float p[8], ps = 0.f;
#pragma unroll
                for (int j = 0; j < 8; ++j) { p[j] = __builtin_amdgcn_exp2f(((j < 4) ? s0[j & 3] : s1[j & 3]) - mn); ps += p[j]; }
                lrun[h] += ps;
                u32x4 pw; pw.x = cvtpk_v(p[0], p[1]); pw.y = cvtpk_v(p[2], p[3]); pw.z = cvtpk_v(p[4], p[5]); pw.w = cvtpk_v(p[6], p[7]);
                const bf16x8 pf = __builtin_bit_cast(bf16x8, pw);
#pragma unroll
                for (int db = 0; db < 4; ++db) o[h][db] = __builtin_amdgcn_mfma_f32_16x16x32_bf16(cur.v[db], pf, o[h][db], 0, 0, 0);
                if (NH > 2 && h + 1 < NH) __builtin_amdgcn_sched_barrier(0);
            }
        }
        cur = nxt;
    }
}
template <int NH>
__device__ __forceinline__ void band_store(const f32x4 (&o)[NH][4], const float (&lrun)[NH], unsigned char* const (&yrow)[NH], int lane) {
    const int g = lane >> 4;
#pragma unroll
    for (int h = 0; h < NH; ++h) { float l = lrun[h]; l += __shfl_xor(l, 16); l += __shfl_xor(l, 32); const float inv = 1.f / l;
#pragma unroll
        for (int db = 0; db < 4; ++db) *(unsigned*)(yrow[h] + 16 * db + 4 * g) = pk4_fp8(o[h][db][0] * inv, o[h][db][1] * inv, o[h][db][2] * inv, o[h][db][3] * inv); }
}

template <int CTRL> __device__ __forceinline__ void argmax_dpp(float& bv, int& bi) {
    const float ov = __uint_as_float(__builtin_amdgcn_update_dpp(0u, __float_as_uint(bv), CTRL, 0xF, 0xF, true)); const int oi = (int)__builtin_amdgcn_update_dpp(0u, (unsigned)bi, CTRL, 0xF, 0xF, true);
    if (ov > bv || (ov == bv && oi < bi)) { bv = ov; bi = oi; }
}
__device__ __forceinline__ void argmax32(float& bv, int& bi) {
    argmax_dpp<0xB1>(bv, bi);
    argmax_dpp<0x4E>(bv, bi);
    argmax_dpp<0x141>(bv, bi);
    argmax_dpp<0x140>(bv, bi);
    const auto rv = __builtin_amdgcn_permlane16_swap(__float_as_uint(bv), __float_as_uint(bv), false, false); const auto ri = __builtin_amdgcn_permlane16_swap((unsigned)bi, (unsigned)bi, false, false);
    const float v0 = __uint_as_float(rv[0]), v1 = __uint_as_float(rv[1]); const int i0 = (int)ri[0], i1 = (int)ri[1];
    if (v1 > v0 || (v1 == v0 && i1 < i0)) { bv = v1; bi = i1; } else { bv = v0; bi = i0; }
}
struct Args { const float* in[19]; float* out; unsigned char* ws; int ph_lo, ph_hi, li, pad; };
constexpr int NPHASE = 10;

__global__ void __launch_bounds__(NWAVES * 64, 2) mk_fwd(Args args) {
    extern __shared__ __attribute__((aligned(16))) unsigned char lds[];
    Frame F;
    F.lds = (LAS unsigned char*)lds; F.MISC = (volatile LAS unsigned*)(F.lds + MISC_OFF); F.tbl = (LAS int*)(F.lds + TBL_OFF);
    F.tid = threadIdx.x; F.lane = F.tid & 63; F.wave = __builtin_amdgcn_readfirstlane(F.tid >> 6);
    F.G = gridDim.x; { const int bx = blockIdx.x; F.vcu = (F.G % 8 == 0) ? (bx % 8) * (F.G / 8) + bx / 8 : bx; }
    unsigned char* ws = args.ws; F.ctl = (gu32*)(ws + WS_CTL);
    const float* x = args.in[0]; const float* norm_mix = args.in[1]; const float* w_in = args.in[2]; const float* b_in = args.in[3];
    const float* sinks = args.in[4]; const float* rel_bias = args.in[5]; const float* w_a = args.in[6]; const float* w_b = args.in[7];
    const float* w_out = args.in[8]; const float* norm_ffn = args.in[9]; const float* router_w = args.in[10]; const float* router_b = args.in[11];
    const float* w_gate = args.in[12]; const float* b_gate = args.in[13]; const float* w_up = args.in[14]; const float* b_up = args.in[15];
    const float* w_down = args.in[16]; const float* b_down = args.in[17]; const float* norm_final = args.in[18];
    float* out = args.out;
    Tabs* tb = (Tabs*)(ws + WS_TAB);
    bf16* Win_t = (bf16*)(ws + WS_WIN); bf16* Wa_t = (bf16*)(ws + WS_WA); bf16* Wb_t = (bf16*)(ws + WS_WB); bf16* Wout_t = (bf16*)(ws + WS_WOUT);
    unsigned char* Wgu8 = ws + WS_WGU; unsigned char* Wd8 = ws + WS_WD; unsigned char* H28 = ws + WS_H2; unsigned char* HS8 = ws + WS_HS; unsigned char* ACT8 = ws + WS_ACT; unsigned char* YS = ws + WS_YS;
    int* topi = (int*)(ws + WS_RT); float* topp = (float*)(ws + WS_RT + 256 * 1024); int* slot = (int*)(ws + WS_RT + 512 * 1024); int* pos = (int*)(ws + WS_RT + 768 * 1024);
    bf16* XN = (bf16*)(ws + WS_XN); bf16* QKV = (bf16*)(ws + WS_QKV); bf16* GATES = (bf16*)(ws + WS_GATES); bf16* YA = (bf16*)(ws + WS_YA); bf16* YB = (bf16*)(ws + WS_YB);
    bf16* MERGED = (bf16*)(ws + WS_MERGED);
    gu32* cnt = F.ctl + CW_CNT; int* rtc = (int*)(ws + WS_RTC);

    for (int u = F.tid; u < (LDS_BYTES - LDSCTL_OFF) / 4; u += NWAVES * 64) ((LAS unsigned*)(F.lds + LDSCTL_OFF))[u] = 0u;
    __syncthreads();
    XcdBarrier bar = xcd_barrier_post((unsigned*)(F.ctl + CW_BAR) + args.li * XCD_BAR_WORDS, F.MISC + 8);
    const int lo = args.ph_lo, hi = args.ph_hi;
#ifndef MK_SKIP
#define MK_SKIP 0
#endif
#ifndef MK_NCONV
#define MK_NCONV 3
#endif
#define IN(k) (!((MK_SKIP >> (k)) & 1) && lo <= (k) && (k) < hi)
#ifndef MK_DUP
#define MK_DUP 0
#endif
#define REP(k) _Pragma("unroll") for (int rep_ = 0; rep_ < 1 + ((MK_DUP >> (k)) & 1); ++rep_)
#ifdef MK_TSTAMP
    unsigned long long ts_a = __builtin_amdgcn_s_memrealtime(), ts_b = ts_a;
#define SEAM(k) do { if (IN(k) && IN((k) + 1)) xcd_barrier(bar); if ((k) + 1 == MK_TSTAMP) ts_a = __builtin_amdgcn_s_memrealtime(); if ((k) == MK_TSTAMP) ts_b = __builtin_amdgcn_s_memrealtime(); } while (0)
#else
#define SEAM(k) do { if (IN(k) && IN((k) + 1)) xcd_barrier(bar); } while (0)
#endif
    const int gw = F.vcu * NWAVES + F.wave, NGW = F.G * NWAVES;

    constexpr int I_IN = (D / 64) * (NPROJ / 32), I_A = (D / 64) * (D / 32), I_B = (256 / 64) * (D / 32), I_E = (D / 64) * (D / 32);
    constexpr int NDENSE = I_IN + 2 * I_A + I_B, NEXP = 3 * NE * I_E;
    const int ND = (NDENSE + F.G - 1) / F.G, NX = (NEXP + F.G - 1) / F.G;
    auto cv_desc = [&](int i) -> CvItem {
        CvItem c; c.nt = (i >= ND);
        if (i < ND) { int r = min(F.vcu * ND + i, NDENSE - 1);
            if (r < I_IN) { const int nb = NPROJ / 32; c.W = w_in; c.WT = (unsigned char*)Win_t; c.N = NPROJ; c.K = D; c.k0 = 64 * (r / nb); c.n0 = 32 * (r % nb); c.orow0 = c.n0; return c; } r -= I_IN;
            if (r < I_A) { const int nb = D / 32; c.W = w_a; c.WT = (unsigned char*)Wa_t; c.N = D; c.K = KC; c.k0 = 64 * (r / nb); c.n0 = 32 * (r % nb); c.orow0 = c.n0; return c; } r -= I_A;
            if (r < I_A) { const int nb = D / 32; c.W = w_out; c.WT = (unsigned char*)Wout_t; c.N = D; c.K = D; c.k0 = 64 * (r / nb); c.n0 = 32 * (r % nb); c.orow0 = c.n0; return c; } r -= I_A;
            { const int nb = D / 32; c.W = w_b; c.WT = (unsigned char*)Wa_t + 1024; c.N = D; c.K = KC; c.k0 = 64 * (r / nb); c.n0 = 32 * (r % nb); c.orow0 = c.n0; return c; } }
        const int r = min(F.vcu * NX + (i - ND), NEXP - 1);
        const int e = r / (3 * I_E), q = r % (3 * I_E), which = q / I_E, ii = q % I_E, nb = D / 32, k0 = 64 * (ii / nb), n0 = 32 * (ii % nb);
        c.k0 = k0; c.n0 = n0; c.N = D; c.K = D;
        if (which == 0) { c.W = w_gate + (size_t)e * D * D; c.WT = Wgu8; c.orow0 = e * 2048 + (n0 >> 7) * 256 + (n0 & 127); }
        else if (which == 1) { c.W = w_up + (size_t)e * D * D; c.WT = Wgu8; c.orow0 = e * 2048 + (n0 >> 7) * 256 + 128 + (n0 & 127); }
        else { c.W = w_down + (size_t)e * D * D; c.WT = Wd8; c.orow0 = e * 1024 + n0; }
        return c; };
    auto run_queues = [&](int ntask, auto&& task, int cv_lo, int cv_hi, int nconv) {
        LAS unsigned* qc = (LAS unsigned*)(F.lds + LDSCTL_OFF + 640);
        if (F.tid == 0) { qc[0] = 0u; qc[1] = (unsigned)cv_lo; }
        __syncthreads();
        auto take = [&](int q) -> int { unsigned v = 0; if (F.lane == 0) v = __hip_atomic_fetch_add(qc + q, 1u, __ATOMIC_RELAXED, __HIP_MEMORY_SCOPE_WORKGROUP); return (int)__builtin_amdgcn_readfirstlane(v); };
        LAS float* scr2 = (LAS float*)(F.lds + RING_OFF + 53248 + F.wave * 8448);
        bool task_left = ntask > 0, conv_left = cv_hi > cv_lo; const bool prefer_conv = F.wave >= NWAVES - nconv;
        while (task_left || conv_left) {
            if (conv_left && (prefer_conv || !task_left)) {
                {
                    CvIt ia, ib, ic; f32x4 A[8], B[8], C[8]; bool va, vb, vc;
                    auto fetch = [&](CvIt& it, f32x4 (&buf)[8], bool& valid) { const int i = take(1); valid = i < cv_hi;
                        if (valid) { const CvItem d = cv_desc(i); it.src = d.W + (size_t)d.k0 * d.N + d.n0; it.dst = d.WT + (size_t)d.orow0 * d.K + d.k0; it.N = d.N; it.K = d.K; it.nt = d.nt; }
                        else { it.src = w_gate; it.dst = nullptr; it.N = 0; it.K = 0; it.nt = 0; }
                        cv_load4(it, buf, F.lane); };
                    fetch(ia, A, va); fetch(ib, B, vb); fetch(ic, C, vc);
                    do {
                        if (va) cv_finish4(ia, A, scr2, F.lane); fetch(ia, A, va);
                        if (vb) cv_finish4(ib, B, scr2, F.lane); fetch(ib, B, vb);
                        if (vc) cv_finish4(ic, C, scr2, F.lane); fetch(ic, C, vc);
                    } while (va);
                }
                conv_left = false; continue;
            }
            const int tq = take(0);
            if (tq >= ntask) { task_left = false; continue; }
            task(tq);
        }
        __syncthreads();
    };
#ifndef MK_N0
#define MK_N0 0
#endif
#ifndef MK_NCONV0
#define MK_NCONV0 4
#endif
    const int CV0 = ND + min(MK_N0, NX);
    if (IN(0)) REP(0) {
        { const int i = blockIdx.x * (NWAVES * 64) + F.tid;
          if (i < 16 * 257) { const int h = i / 257, r = i % 257; tb->biasA[h][r] = rel_bias[BKT_A[r] * 28 + h]; }
          if (i < 12 * 129) { const int g = i / (4 * 129), hs = (i / 129) % 4, r = i % 129; tb->biasB[g][hs][r] = rel_bias[BKT_B[g][r] * 28 + 16 + 4 * g + hs]; } }
        const int RPC = 4 * ((T + 4 * F.G - 1) / (4 * F.G));
        run_queues(RPC / 4, [&](int q) {
            const int m0 = F.vcu * RPC + 4 * q; if (m0 >= T) return;
            rms_rows4_to_fp8(x, norm_mix, m0, (unsigned char*)XN, ws + WS_XNP, ws + WS_XNP + (size_t)T * D, F.lane); },
            0, CV0, MK_NCONV0);
    }
    SEAM(0);
    if (IN(1)) REP(1) {
        int k512 = D / 2; asm volatile("" : "+s"(k512));
        pg8::Gemm g{XN, Win_t, k512}; pg8::ProjOrder So; So.so.init(T, NPROJ, F.G, (int)blockIdx.x);
        pg8::EpiProj E{QKV, GATES, b_in, (bf16*)(ws + WS_VT), (bf16*)(ws + WS_VT) + (size_t)2 * 4 * 64 * 8192, ws + WS_K2};
        pg8::gemm_phase<pg8::EpiProj, pg8::ProjOrder, true, true, true>(F.lds + RING_OFF, g, So, E);
    }
    SEAM(1);
    int nrep2 = 1 + ((MK_DUP >> 2) & 1); asm volatile("" : "+s"(nrep2));
    if (IN(2)) for (int rep_ = 0; rep_ < nrep2; ++rep_) {
        LAS float* lb = (LAS float*)(F.lds + RING_OFF);
        constexpr int TA = 2 * RB_A + 1, TB = 2 * RB_B + 1;
        for (int i = F.tid; i < 16 * TA; i += NWAVES * 64) { const int h = i / TA, rel = i % TA - RB_A; lb[i] = (rel >= -128 && rel <= 128) ? tb->biasA[h][rel + 128] * LOG2E : -3.0e38f; }
        for (int i = F.tid; i < 12 * TB; i += NWAVES * 64) { const int gh = i / TB, rel = i % TB - RB_B; lb[16 * TA + i] = (rel >= -64 && rel <= 64) ? tb->biasB[gh >> 2][gh & 3][rel + 64] * LOG2E : -3.0e38f; }
        __syncthreads();
        const bf16* VTA = (const bf16*)(ws + WS_VT); const bf16* VTB = VTA + (size_t)2 * 4 * 64 * 8192; const unsigned char* K2 = ws + WS_K2;
        const int nTB = (2048 + F.G - 1) / F.G, nTA = (4096 + F.G - 1) / F.G;
        run_queues(nTB + nTA, [&](int tq) {
          {
            const int it = (tq < nTB) ? 4096 + F.vcu * nTB + tq : F.vcu * nTA + (tq - nTB);
            if ((tq < nTB) ? (it >= 4096 + 2048) : (it >= 4096)) return;
            const int t = F.lane & 15;
            if (it < 4096) {
                const int b = it >> 11, kvh = (it >> 9) & 3, qb = it & 511;
                f32x4 o[4][4]; float mr[4], lr[4];
#pragma unroll
                for (int h = 0; h < 4; ++h) { mr[h] = sinks[kvh * 4 + h] * LOG2E; lr[h] = (F.lane < 16) ? 1.f : 0.f;
#pragma unroll
                    for (int db = 0; db < 4; ++db) o[h][db] = (f32x4){0.f, 0.f, 0.f, 0.f}; }
                const int qcol[4] = {C_QA + (kvh * 4 + 0) * 64, C_QA + (kvh * 4 + 1) * 64, C_QA + (kvh * 4 + 2) * 64, C_QA + (kvh * 4 + 3) * 64};
                const int qmu[4] = {16 * qb, 16 * qb, 16 * qb, 16 * qb};
                const LAS float* const bias[4] = {lb + (kvh * 4 + 0) * TA, lb + (kvh * 4 + 1) * TA, lb + (kvh * 4 + 2) * TA, lb + (kvh * 4 + 3) * TA};
                band_group<4, RB_A>(o, mr, lr, (const unsigned char*)QKV + (size_t)b * S * NQKV, qcol, qmu, K2 + (size_t)((b * 4 + kvh) * 8192) * 64, VTA + (size_t)((b * 4 + kvh) * 64) * 8192, 1, 0, S, 1, (qb - 8) >> 1, 9, bias, F.lane);
                unsigned char* yr = (unsigned char*)YA + (size_t)(b * S + 16 * qb + t) * KC + kvh * 256; unsigned char* const yrow[4] = {yr, yr + 64, yr + 128, yr + 192};
                band_store<4>(o, lr, yrow, F.lane);
            } else {
                const int j = it - 4096, r = j & 7, un = j >> 3, blk = un & 31, hs = (un >> 5) & 3, b = un >> 7, i0 = blk * 256;
                f32x4 o[2][4]; float mr[2], lr[2];
#pragma unroll
                for (int h = 0; h < 2; ++h) { mr[h] = -1.0e30f; lr[h] = 0.f;
#pragma unroll
                    for (int db = 0; db < 4; ++db) o[h][db] = (f32x4){0.f, 0.f, 0.f, 0.f}; }
                const unsigned char* qb_ = (const unsigned char*)QKV + (size_t)b * S * NQKV;
                { const int qcol[2] = {C_QB + 0 * 256 + hs * 64, C_QB + 0 * 256 + hs * 64}; const int qmu[2] = {i0 + r, i0 + r + 8}; const LAS float* const bias[2] = {lb + 16 * TA + (0 * 4 + hs) * TB, lb + 16 * TA + (0 * 4 + hs) * TB};
                  band_group<2, RB_B>(o, mr, lr, qb_, qcol, qmu, K2 + (size_t)((((0 + 1) * 2 + b) * 4 + hs) * 8192) * 64, VTB + (size_t)(((0 * 2 + b) * 4 + hs) * 64) * 8192, 1, 0, S, 16, (i0 >> 5) - 2, 12, bias, F.lane); }
                { const int qcol[2] = {C_QB + 1 * 256 + hs * 64, C_QB + 1 * 256 + hs * 64}; const int qmu[2] = {(i0 + r) >> 2, (i0 + r + 8) >> 2}; const LAS float* const bias[2] = {lb + 16 * TA + (1 * 4 + hs) * TB, lb + 16 * TA + (1 * 4 + hs) * TB};
                  band_group<2, RB_B>(o, mr, lr, qb_, qcol, qmu, K2 + (size_t)((((1 + 1) * 2 + b) * 4 + hs) * 8192) * 64, VTB + (size_t)(((1 * 2 + b) * 4 + hs) * 64) * 8192, 4, r & 3, S / 4, 4, (i0 >> 7) - 2, 6, bias, F.lane); }
#pragma unroll
                for (int h = 0; h < 2; ++h) { const int qcol[1] = {C_QB + 2 * 256 + hs * 64}; const int qmu[1] = {i0 >> 4}; const LAS float* const bias[1] = {lb + 16 * TA + (2 * 4 + hs) * TB};
                  band_group<1, RB_B>(*(f32x4(*)[1][4])&o[h], *(float(*)[1])&mr[h], *(float(*)[1])&lr[h], qb_, qcol, qmu, K2 + (size_t)((((2 + 1) * 2 + b) * 4 + hs) * 8192) * 64, VTB + (size_t)(((2 * 2 + b) * 4 + hs) * 64) * 8192,
                                    16, r + 8 * h, S / 16, 1, (blk - 4) >> 1, 5, bias, F.lane); }
                unsigned char* yr = (unsigned char*)YA + (size_t)(b * S + i0 + r + 16 * t) * KC + 1024 + hs * 64; unsigned char* const yrow[2] = {yr, yr + 8 * KC};
                band_store<2>(o, lr, yrow, F.lane);
            }
          }
        }, (rep_ == 0) ? CV0 : ND + NX, ND + NX, MK_NCONV);
    }
    SEAM(2);
    if (IN(3)) REP(3) {
        { int k640 = KC / 2; asm volatile("" : "+s"(k640)); pg8::Gemm g{YA, Wa_t, k640};   pg8::StaticOrder So; So.init(T, D, F.G, (int)blockIdx.x);
          pg8::EpiGate2 E{GATES, ws + WS_MERGED};
          pg8::gemm_phase<pg8::EpiGate2, pg8::StaticOrder, true, true, true>(F.lds + RING_OFF, g, So, E); }
    }
    SEAM(3);
    if (IN(4)) REP(4) {
        int k512 = D / 2; asm volatile("" : "+s"(k512)); pg8::Gemm g{(const bf16*)(ws + WS_MERGED), Wout_t, k512}; pg8::StaticOrder So; So.init(T, D, F.G, (int)blockIdx.x);
        pg8::EpiX1 E{x, (unsigned short*)(ws + WS_HS)};
        pg8::gemm_phase<pg8::EpiX1, pg8::StaticOrder, true, true, true>(F.lds + RING_OFF, g, So, E);
    }
    bf16x8 wH[4][2], wL[4][2];
    if (IN(5)) { const int g = F.lane >> 4, e16 = F.lane & 15, w = F.wave;
#pragma unroll
        for (int s4 = 0; s4 < 4; ++s4)
#pragma unroll
            for (int hf = 0; hf < 2; ++hf) { unsigned hb[8], lb[8];
#pragma unroll
                for (int j = 0; j < 8; ++j) { const int k = 128 * w + 32 * s4 + 8 * g + j; const float wv = norm_ffn[k] * router_w[(size_t)k * NE + 16 * hf + e16];
                    hb[j] = f2bf(wv); lb[j] = f2bf(wv - bf2f(hb[j])); }
                u32x4 hv, lv; hv.x = hb[0] | (hb[1] << 16); hv.y = hb[2] | (hb[3] << 16); hv.z = hb[4] | (hb[5] << 16); hv.w = hb[6] | (hb[7] << 16);
                lv.x = lb[0] | (lb[1] << 16); lv.y = lb[2] | (lb[3] << 16); lv.z = lb[4] | (lb[5] << 16); lv.w = lb[6] | (lb[7] << 16);
                wH[s4][hf] = __builtin_bit_cast(bf16x8, hv); wL[s4][hf] = __builtin_bit_cast(bf16x8, lv); } }
    SEAM(4);
    if (IN(5)) REP(5) {
        const bool lastrep5 = (rep_ + 1 == 1 + ((MK_DUP >> 5) & 1));
        LAS int* lcnt = F.tbl + 72; LAS int* lbase = F.tbl + 104; LAS int* ebuf = F.tbl + 136; LAS int* pbuf = F.tbl + 392;
        LAS float* plog = (LAS float*)(F.lds + RING_OFF);
        LAS float* psq = plog + 8 * 64 * 32;
        LAS float* rstd_s = psq + 512;
        const int g = F.lane >> 4, e16 = F.lane & 15, w = F.wave;
        for (int tblk = F.vcu; tblk < T / 64; tblk += F.G) {
            if (F.tid < 32) lcnt[F.tid] = 0;
            u32x4 xr[4][4];
#pragma unroll
            for (int tile = 0; tile < 4; ++tile) { const GAS unsigned short* xp = (const GAS unsigned short*)(ws + WS_HS) + (size_t)(tblk * 64 + tile * 16 + e16) * D + 128 * w + 8 * g;
#pragma unroll
              for (int s4 = 0; s4 < 4; ++s4) xr[tile][s4] = __builtin_nontemporal_load((const GAS u32x4*)(xp + 32 * s4)); }
#pragma unroll
            for (int tile = 0; tile < 4; ++tile) {
                float sq = 0.f;
#pragma unroll
                for (int s4 = 0; s4 < 4; ++s4) { const u32x4 pk = xr[tile][s4];
                    const float f0 = bflo(pk.x), f1 = bfhi(pk.x), f2 = bflo(pk.y), f3 = bfhi(pk.y), f4 = bflo(pk.z), f5 = bfhi(pk.z), f6 = bflo(pk.w), f7 = bfhi(pk.w);
                    sq += (f0 * f0 + f1 * f1) + (f2 * f2 + f3 * f3) + (f4 * f4 + f5 * f5) + (f6 * f6 + f7 * f7); }
                sq += __shfl_xor(sq, 16); sq += __shfl_xor(sq, 32);
                if (g == 0) psq[w * 64 + tile * 16 + e16] = sq;
                f32x4 a0 = (f32x4){0.f, 0.f, 0.f, 0.f}, a1 = (f32x4){0.f, 0.f, 0.f, 0.f};
#pragma unroll
                for (int s4 = 0; s4 < 4; ++s4) { const bf16x8 av = __builtin_bit_cast(bf16x8, xr[tile][s4]);
                    a0 = __builtin_amdgcn_mfma_f32_16x16x32_bf16(av, wH[s4][0], a0, 0, 0, 0); a1 = __builtin_amdgcn_mfma_f32_16x16x32_bf16(av, wH[s4][1], a1, 0, 0, 0);
                    a0 = __builtin_amdgcn_mfma_f32_16x16x32_bf16(av, wL[s4][0], a0, 0, 0, 0); a1 = __builtin_amdgcn_mfma_f32_16x16x32_bf16(av, wL[s4][1], a1, 0, 0, 0); }
#pragma unroll
                for (int r = 0; r < 4; ++r) { LAS float* pr = plog + (size_t)(w * 64 + tile * 16 + 4 * g + r) * 32 + e16; pr[0] = a0[r]; pr[16] = a1[r]; }
            }
            __syncthreads();
            if (F.tid < 64) { float s = 0.f;
#pragma unroll
                for (int ww = 0; ww < 8; ++ww) s += psq[ww * 64 + F.tid];
                rstd_s[F.tid] = 1.f / sqrtf(s * (1.f / D) + EPS); }
            __syncthreads();
            { const int e = F.tid & 31; const float rbv = router_b[e];
#pragma unroll 1
              for (int i = 0; i < 4; ++i) { const int tl = (F.tid >> 5) + 16 * i; float lg = 0.f;
#pragma unroll
                for (int ww = 0; ww < 8; ++ww) lg += plog[(size_t)(ww * 64 + tl) * 32 + e];
                float val = lg * rstd_s[tl] + rbv; float tv[4]; int ti[4];
#pragma unroll
                for (int r = 0; r < 4; ++r) {
                    float bv = val; int bi = e;
                    argmax32(bv, bi);
                    tv[r] = bv; ti[r] = bi; if (bi == e) val = -3.0e38f;
                }
                const float e1 = __expf(tv[1] - tv[0]), e2 = __expf(tv[2] - tv[0]), e3 = __expf(tv[3] - tv[0]); const float inv = 1.f / (1.f + e1 + e2 + e3);
                if (e < 4) { const float p = (e == 0 ? 1.f : e == 1 ? e1 : e == 2 ? e2 : e3) * inv; const int ex = (e == 0 ? ti[0] : e == 1 ? ti[1] : e == 2 ? ti[2] : ti[3]);
                    const int m = tblk * 64 + tl; topi[m * 4 + e] = ex; topp[m * 4 + e] = p;
                    const int li = tl * 4 + e; ebuf[li] = ex; pbuf[li] = __hip_atomic_fetch_add(&lcnt[ex], 1, __ATOMIC_RELAXED, __HIP_MEMORY_SCOPE_WORKGROUP); } } }
#pragma unroll
            for (int s4 = 0; s4 < 4; ++s4) { const f32x4 g0 = *(const GAS f32x4*)(norm_ffn + 128 * w + 32 * s4 + 8 * g), g1 = *(const GAS f32x4*)(norm_ffn + 128 * w + 32 * s4 + 8 * g + 4);
#pragma unroll
                for (int tile = 0; tile < 4; ++tile) { const float rstd = rstd_s[tile * 16 + e16]; const u32x4 pk = xr[tile][s4]; const f32x4 x0 = (f32x4){bflo(pk.x), bfhi(pk.x), bflo(pk.y), bfhi(pk.y)}, x1v = (f32x4){bflo(pk.z), bfhi(pk.z), bflo(pk.w), bfhi(pk.w)};
                    u32x2 o; o.x = pk4_fp8(x0.x * rstd * g0.x, x0.y * rstd * g0.y, x0.z * rstd * g0.z, x0.w * rstd * g0.w); o.y = pk4_fp8(x1v.x * rstd * g1.x, x1v.y * rstd * g1.y, x1v.z * rstd * g1.z, x1v.w * rstd * g1.w);
                    *(GAS u32x2*)(H28 + ((size_t)tblk * 64 + tile * 16 + e16) * D + 128 * w + 32 * s4 + 8 * g) = o; } }
            __syncthreads();
            if (F.tid < 32) lbase[F.tid] = lastrep5 ? (int)__hip_atomic_fetch_add(cnt + F.tid, (unsigned)lcnt[F.tid], RLX_AGENT) : 0;
            __syncthreads();
            if (F.tid < 256) { const int ex = ebuf[F.tid], ps = lbase[ex] + pbuf[F.tid]; pos[tblk * 256 + F.tid] = ps; rtc[(size_t)ex * T + ps] = tblk * 64 + (F.tid >> 2); }
            __syncthreads();
        }
    }
    SEAM(5);
    if (IN(7) || IN(8) || IN(9)) {
        LAS int* loff = F.tbl; LAS int* ltoff = F.tbl + 36; LAS int* lc = F.tbl + 72;
        if (F.tid < 32) lc[F.tid] = (int)__hip_atomic_load(cnt + F.tid, RLX_AGENT);
        __syncthreads();
        if (F.tid == 0) { int a = 0, ta = 0; for (int e = 0; e < NE; ++e) { loff[e] = a; ltoff[e] = ta; const int c = lc[e]; a += c; ta += (c + 255) >> 8; } loff[NE] = a; ltoff[NE] = ta; }
        __syncthreads();
    }
    if (IN(7)) REP(7) {
        int k512 = D / 2; asm volatile("" : "+s"(k512));
        pg8::Gemm g{(const bf16*)H28, (const bf16*)Wgu8, k512, rtc}; pg8::GroupOrder So{F.tbl + 36, F.tbl, 8, F.G, (int)blockIdx.x, 0, T};   So.nunits = __builtin_amdgcn_readfirstlane(F.tbl[36 + NE]) * 8;
        pg8::EpiSwiglu E{ACT8, b_gate, b_up};
#if MK_FUSE78
        So.ready = (unsigned*)(F.ctl + CW_RDY); So.mode = 1;
#endif
        pg8::gemm_phase<pg8::EpiSwiglu, pg8::GroupOrder, true, FP8_SP2, true, true>(F.lds + RING_OFF, g, So, E);
    }
#if MK_FUSE78
    if (IN(7) && IN(8)) { VM_WAIT(); __syncthreads(); }
#else
    SEAM(7);
#endif
    if (IN(8)) REP(8) {
        int k512 = D / 2; asm volatile("" : "+s"(k512));
        pg8::Gemm g{(const bf16*)ACT8, (const bf16*)Wd8, k512}; pg8::GroupOrder So{F.tbl + 36, F.tbl, 4, F.G, (int)blockIdx.x, 0, 0}; So.nunits = __builtin_amdgcn_readfirstlane(F.tbl[36 + NE]) * 4;
#if MK_FUSE78
        So.ready = (unsigned*)(F.ctl + CW_RDY); So.mode = 2; So.need = 8u * NWAVES; So.tmo = (unsigned*)(F.ctl + CW_TMO);
        if ((F.G & 7) == 0) So.c = ((int)blockIdx.x & 7) + 8 * ((F.G >> 3) - 1 - ((int)blockIdx.x >> 3));
#endif
        pg8::EpiDown E{YS, b_down};
        pg8::gemm_phase<pg8::EpiDown, pg8::GroupOrder, true, FP8_SP2, true>(F.lds + RING_OFF, g, So, E);
    }
    SEAM(8);
#ifdef MK_XBAR
    for (int xb_ = 0; xb_ < MK_XBAR; ++xb_) xcd_barrier(bar);
#endif
    if (IN(9)) REP(9) {
        const unsigned char* ys = YS;
        const int lane9 = (int)__builtin_amdgcn_mbcnt_hi(~0u, __builtin_amdgcn_mbcnt_lo(~0u, 0u));
        float* dst9 = (rep_ + 1 < 1 + ((MK_DUP >> 9) & 1)) ? (float*)(ws + WS_ACT) : out;
        for (int m0 = gw; m0 < T; m0 += 2 * NGW) {
            f32x4 v[2][4]; int sl[2][4]; float pr[2][4]; unsigned yv[2][4][4]; bool ok[2];
#pragma unroll
            for (int q = 0; q < 2; ++q) { const int m = m0 + q * NGW; ok[q] = m < T; const int mc = ok[q] ? m : m0; const GAS u32x2* xr = (const GAS u32x2*)((const unsigned short*)(ws + WS_HS) + (size_t)mc * D) + lane9;
#pragma unroll
                for (int j = 0; j < 4; ++j) { const u32x2 pk = __builtin_nontemporal_load(xr + 64 * j); v[q][j] = (f32x4){bf2f(pk.x & 0xffffu), __builtin_bit_cast(float, pk.x & 0xffff0000u), bf2f(pk.y & 0xffffu), __builtin_bit_cast(float, pk.y & 0xffff0000u)}; }
#pragma unroll
                for (int k = 0; k < 4; ++k) { sl[q][k] = F.tbl[topi[mc * 4 + k]] + pos[mc * 4 + k]; pr[q][k] = topp[mc * 4 + k]; } }
#pragma unroll
            for (int q = 0; q < 2; ++q)
#pragma unroll
                for (int k = 0; k < 4; ++k) { const GAS unsigned* yr = (const GAS unsigned*)(ys + (size_t)sl[q][k] * D) + lane9;
#pragma unroll
                    for (int j = 0; j < 4; ++j) yv[q][k][j] = __builtin_nontemporal_load(yr + 64 * j); }
#pragma unroll
            for (int q = 0; q < 2; ++q) { if (!ok[q]) continue; const int m = m0 + q * NGW;
#pragma unroll
                for (int k = 0; k < 4; ++k) { const float p = pr[q][k];
#pragma unroll
                    for (int j = 0; j < 4; ++j) { const unsigned u = yv[q][k][j]; const f32x2 lo = __builtin_amdgcn_cvt_pk_f32_fp8(u, false), hi = __builtin_amdgcn_cvt_pk_f32_fp8(u, true);
                        v[q][j].x += p * lo.x; v[q][j].y += p * lo.y; v[q][j].z += p * hi.x; v[q][j].w += p * hi.y; } }
                float s = 0.f;
#pragma unroll
                for (int j = 0; j < 4; ++j) s += (v[q][j].x * v[q][j].x + v[q][j].y * v[q][j].y) + (v[q][j].z * v[q][j].z + v[q][j].w * v[q][j].w);
                const float rstd = 1.f / sqrtf(wave_sum(s) * (1.f / D) + EPS);
#pragma unroll
                for (int j = 0; j < 4; ++j) { const f32x4 gg = ((const GAS f32x4*)norm_final)[lane9 + 64 * j]; f32x4 y; y.x = v[q][j].x * rstd * gg.x; y.y = v[q][j].y * rstd * gg.y; y.z = v[q][j].z * rstd * gg.z; y.w = v[q][j].w * rstd * gg.w;
                    __builtin_nontemporal_store(y, (GAS f32x4*)(dst9 + (size_t)m * D) + lane9 + 64 * j); } }
        }
    }
#ifdef MK_TSTAMP
    if (MK_TSTAMP == 9) ts_b = __builtin_amdgcn_s_memrealtime();
#ifndef MK_TBLK
#define MK_TBLK 0
#endif
    if (blockIdx.x == MK_TBLK) { const unsigned long long dt = ts_b - ts_a, t0_ = __builtin_amdgcn_s_memrealtime();
        while (__builtin_amdgcn_s_memrealtime() - t0_ < 2 * dt) __builtin_amdgcn_s_sleep(8); }
#endif
#undef IN
#undef SEAM
}

extern "C" void kernel_launch(void* const* d_in, const int* in_sizes, int n_in, void* d_out, int out_size, void* d_ws, size_t ws_size, hipStream_t stream) {
    static int grid = 0;
    if (grid == 0) {
        if (n_in != 19 || in_sizes[0] != T * D || out_size != T * D || ws_size < WS_END) { fprintf(stderr, "kernel_launch: unexpected shapes (n_in %d, ws %zu); nothing launched\n", n_in, ws_size); grid = -1; return; }
        int dev = 0, cus = 0, per_cu = 0;
        if (hipGetDevice(&dev) != hipSuccess || hipDeviceGetAttribute(&cus, hipDeviceAttributeMultiprocessorCount, dev) != hipSuccess) { grid = -1; return; }
        if (hipFuncSetAttribute((const void*)mk_fwd, hipFuncAttributeMaxDynamicSharedMemorySize, LDS_BYTES) != hipSuccess) { fprintf(stderr, "kernel_launch: hipFuncSetAttribute failed\n"); grid = -1; return; }
        if (hipOccupancyMaxActiveBlocksPerMultiprocessor(&per_cu, (const void*)mk_fwd, NWAVES * 64, LDS_BYTES) != hipSuccess || per_cu < 1) { fprintf(stderr, "kernel_launch: occupancy query says %d blocks per CU\n", per_cu); }
        (void)hipGetLastError();
        grid = cus;
        if (grid != 256) fprintf(stderr, "kernel_launch: %d CUs (built and tuned for 256)\n", grid);
    }
    if (grid < 0) return;
#if MK_MODE == 2 && !MK_FUSE78
    const size_t zero_bytes = 64 * 1024;
#else
    const size_t zero_bytes = CTL_ZERO_BYTES;
#endif
    static_assert((size_t)(CW_BAR + XCD_BAR_WORDS) * 4 <= 64 * 1024, "the barrier region must lie inside the zeroed bytes");
    if (hipMemsetAsync((char*)d_ws + WS_CTL, 0, zero_bytes, stream) != hipSuccess) return;
    Args a{};
    for (int i = 0; i < 19; ++i) a.in[i] = (const float*)d_in[i];
    a.out = (float*)d_out; a.ws = (unsigned char*)d_ws;
#if MK_MODE == 2
    a.ph_lo = 0; a.ph_hi = NPHASE; a.li = 0;
    hipLaunchKernelGGL(mk_fwd, dim3(grid), dim3(NWAVES * 64), LDS_BYTES, stream, a);
#else
    for (int ph = 0; ph < NPHASE; ++ph) { a.ph_lo = ph; a.ph_hi = ph + 1; a.li = ph; hipLaunchKernelGGL(mk_fwd, dim3(grid), dim3(NWAVES * 64), LDS_BYTES, stream, a); }
#endif
}
```
